# Optimizing an MI355X kernel written in HIP

```python
import math
import jax, jax.numpy as jnp
from jax import lax
import numpy as np

D_MODEL = 2048
BATCH = 2
SEQ = 8192
DEPTH = 1

HEAD_DIM = 128
MIX_WIDTH = D_MODEL
FOX_HEADS = MIX_WIDTH // 2 // HEAD_DIM
DIFF_HEADS = MIX_WIDTH // 2 // (2 * HEAD_DIM)
FOX_WIDTH = FOX_HEADS * HEAD_DIM
DIFF_WIDTH = DIFF_HEADS * 2 * HEAD_DIM
IN_SPLIT_SIZES = (FOX_WIDTH, FOX_WIDTH, FOX_WIDTH, FOX_HEADS, DIFF_WIDTH, DIFF_WIDTH, DIFF_WIDTH)
IN_COLS = sum(IN_SPLIT_SIZES)
Q_BLOCK = 128
N_GROUPS = 8
EXPERTS_PER_GROUP = 8
N_EXPERTS = N_GROUPS * EXPERTS_PER_GROUP
TOP_K_IN_GROUP = 2
D_FF = D_MODEL // 2
MOE_BLOCK = 128
NORM_EPS = 1e-6
SUBLN_EPS = 1e-5
FORGET_BIAS_CENTER = 3.0

kernel_name = "hybrid_fox_diffattn_hiermoe"


def rms_norm(x, g, eps=NORM_EPS):
    xf = x.astype(jnp.float32)
    y = xf * lax.rsqrt(jnp.mean(xf * xf, axis=-1, keepdims=True) + eps)
    return (y * g.astype(jnp.float32)).astype(x.dtype)


def alibi_slopes(n_heads):
    return jnp.asarray(2.0 ** (-8.0 * np.arange(1, n_heads + 1) / n_heads), dtype=jnp.float32)


def forgetting_attention(q, k, v, log_f):
    S = q.shape[2]
    scale = HEAD_DIM ** -0.5
    c = jnp.cumsum(log_f, axis=-1)
    outs = []
    for blk in range(S // Q_BLOCK):
        q0, q1 = blk * Q_BLOCK, (blk + 1) * Q_BLOCK
        logits = jnp.einsum('bhqd,bhkd->bhqk', q[:, :, q0:q1], k[:, :, :q1],
                            preferred_element_type=jnp.float32) * scale
        logits = logits + c[:, :, q0:q1, None] - c[:, :, None, :q1]
        mask = (q0 + jnp.arange(Q_BLOCK))[:, None] >= jnp.arange(q1)[None, :]
        p = jax.nn.softmax(jnp.where(mask, logits, -jnp.inf), axis=-1)
        outs.append(jnp.einsum('bhqk,bhkd->bhqd', p.astype(v.dtype), v[:, :, :q1]))
    return jnp.concatenate(outs, axis=2)


def differential_attention(q, k, v, lam, slopes):
    S = q.shape[3]
    scale = HEAD_DIM ** -0.5
    outs = []
    for blk in range(S // Q_BLOCK):
        q0, q1 = blk * Q_BLOCK, (blk + 1) * Q_BLOCK
        logits = jnp.einsum('bhiqd,bhikd->bhiqk', q[:, :, :, q0:q1], k[:, :, :, :q1],
                            preferred_element_type=jnp.float32) * scale
        dist = ((q0 + jnp.arange(Q_BLOCK))[:, None] - jnp.arange(q1)[None, :]).astype(jnp.float32)
        logits = logits - slopes[None, :, None, None, None] * dist
        p = jax.nn.softmax(jnp.where(dist >= 0, logits, -jnp.inf), axis=-1)
        w = p[:, :, 0] - lam * p[:, :, 1]
        outs.append(jnp.einsum('bhqk,bhkd->bhqd', w.astype(v.dtype), v[:, :, :q1]))
    return jnp.concatenate(outs, axis=2)


def hierarchical_moe(x, wg, bg, we, be, w_gate, w_up, w_down):
    B, S, D = x.shape
    N = B * S
    xf = x.reshape(N, D)
    group_probs = jax.nn.softmax((xf @ wg + bg).astype(jnp.float32), axis=-1)
    g_prob, g_idx = lax.top_k(group_probs, 1)
    exp_logits = (xf @ we + be).astype(jnp.float32).reshape(N, N_GROUPS, EXPERTS_PER_GROUP)
    idx = jnp.broadcast_to(g_idx[:, :, None], (N, 1, EXPERTS_PER_GROUP))
    in_group = jnp.take_along_axis(exp_logits, idx, axis=1)[:, 0]
    e_prob, e_local = lax.top_k(jax.nn.softmax(in_group, axis=-1), TOP_K_IN_GROUP)
    gates = g_prob * e_prob / jnp.sum(e_prob, axis=-1, keepdims=True)
    expert_id = g_idx * EXPERTS_PER_GROUP + e_local

    A = N * TOP_K_IN_GROUP
    e_flat = expert_id.reshape(A)
    tok_flat = jnp.repeat(jnp.arange(N, dtype=jnp.int32), TOP_K_IN_GROUP)
    gate_flat = gates.reshape(A)
    order = jnp.argsort(e_flat)
    e_sorted = e_flat[order]
    counts = jnp.bincount(e_flat, length=N_EXPERTS)
    starts = jnp.cumsum(counts) - counts
    padded = ((counts + MOE_BLOCK - 1) // MOE_BLOCK) * MOE_BLOCK
    pends = jnp.cumsum(padded)
    pstarts = pends - padded
    dest = pstarts[e_sorted] + (jnp.arange(A) - starts[e_sorted])
    n_rows = ((A + N_EXPERTS * (MOE_BLOCK - 1) + MOE_BLOCK - 1) // MOE_BLOCK) * MOE_BLOCK
    n_blocks = n_rows // MOE_BLOCK
    row_tok = jnp.full((n_rows,), N, jnp.int32).at[dest].set(tok_flat[order])
    row_gate = jnp.zeros((n_rows,), jnp.float32).at[dest].set(gate_flat[order])
    block_expert = jnp.minimum(
        jnp.searchsorted(pends, jnp.arange(n_blocks) * MOE_BLOCK, side='right'), N_EXPERTS - 1)
    x_pad = jnp.concatenate([xf, jnp.zeros((1, D), xf.dtype)], axis=0)
    x_rows = x_pad[row_tok].reshape(n_blocks, MOE_BLOCK, D)

    def expert_block(args):
        xb, e = args
        hdn = jax.nn.silu(xb @ w_gate[e]) * (xb @ w_up[e])
        return hdn @ w_down[e]

    y_rows = lax.map(expert_block, (x_rows, block_expert)).reshape(n_rows, D)
    y = jnp.zeros((N + 1, D), jnp.float32).at[row_tok].add(
        y_rows.astype(jnp.float32) * row_gate[:, None])
    return y[:N].astype(x.dtype).reshape(B, S, D)


def setup_inputs(seed: int = 0) -> dict:
    key = jax.random.key(seed)
    ks = jax.random.split(key, 20)
    L, D = DEPTH, D_MODEL
    nrm = lambda k, shape, s: jax.random.normal(k, shape, jnp.float32) * s
    return {
        "x": nrm(ks[0], (BATCH, SEQ, D), 1.0),
        "attn_norm_g": 1.0 + nrm(ks[1], (L, D), 0.02),
        "w_in": nrm(ks[2], (L, D, IN_COLS), D ** -0.5),
        "forget_bias": FORGET_BIAS_CENTER + nrm(ks[3], (L, FOX_HEADS), 0.5),
        "lambda_q1": nrm(ks[4], (L, HEAD_DIM), 0.1),
        "lambda_k1": nrm(ks[5], (L, HEAD_DIM), 0.1),
        "lambda_q2": nrm(ks[6], (L, HEAD_DIM), 0.1),
        "lambda_k2": nrm(ks[7], (L, HEAD_DIM), 0.1),
        "diff_subln_g": 1.0 + nrm(ks[8], (L, 2 * HEAD_DIM), 0.02),
        "w_out": nrm(ks[9], (L, MIX_WIDTH, D), MIX_WIDTH ** -0.5),
        "ffn_norm_g": 1.0 + nrm(ks[10], (L, D), 0.02),
        "router_group_w": nrm(ks[11], (L, D, N_GROUPS), D ** -0.5),
        "router_group_b": nrm(ks[12], (L, N_GROUPS), 0.01),
        "router_expert_w": nrm(ks[13], (L, D, N_EXPERTS), D ** -0.5),
        "router_expert_b": nrm(ks[14], (L, N_EXPERTS), 0.01),
        "w_gate": nrm(ks[15], (L, N_EXPERTS, D, D_FF), D ** -0.5),
        "w_up": nrm(ks[16], (L, N_EXPERTS, D, D_FF), D ** -0.5),
        "w_down": nrm(ks[17], (L, N_EXPERTS, D_FF, D), D_FF ** -0.5),
        "final_norm_g": 1.0 + nrm(ks[18], (D,), 0.02),
    }


def reference(x, attn_norm_g, w_in, forget_bias, lambda_q1, lambda_k1, lambda_q2, lambda_k2,
              diff_subln_g, w_out, ffn_norm_g, router_group_w, router_group_b,
              router_expert_w, router_expert_b, w_gate, w_up, w_down, final_norm_g):
    B, S, _ = x.shape
    slopes = alibi_slopes(DIFF_HEADS)
    split_points = [int(v) for v in np.cumsum(IN_SPLIT_SIZES)[:-1]]
    h = x
    for l in range(DEPTH):
        a = rms_norm(h, attn_norm_g[l])
        proj = a @ w_in[l]
        fq, fk, fv, ff, dq, dk, dv = jnp.split(proj, split_points, axis=-1)
        to_heads = lambda t: t.reshape(B, S, FOX_HEADS, HEAD_DIM).transpose(0, 2, 1, 3)
        log_f = jax.nn.log_sigmoid((ff + forget_bias[l]).astype(jnp.float32)).transpose(0, 2, 1)
        fox = forgetting_attention(to_heads(fq), to_heads(fk), to_heads(fv), log_f)
        fox = fox.transpose(0, 2, 1, 3).reshape(B, S, FOX_WIDTH)

        to_pair = lambda t: t.reshape(B, S, DIFF_HEADS, 2, HEAD_DIM).transpose(0, 2, 3, 1, 4)
        dvh = dv.reshape(B, S, DIFF_HEADS, 2 * HEAD_DIM).transpose(0, 2, 1, 3)
        lam_init = 0.8 - 0.6 * math.exp(-0.3 * l)
        f32 = lambda t: t.astype(jnp.float32)
        lam = (jnp.exp(jnp.sum(f32(lambda_q1[l]) * f32(lambda_k1[l])))
               - jnp.exp(jnp.sum(f32(lambda_q2[l]) * f32(lambda_k2[l]))) + lam_init)
        diff = differential_attention(to_pair(dq), to_pair(dk), dvh, lam, slopes)
        diff = rms_norm(diff, diff_subln_g[l], SUBLN_EPS) * (1.0 - lam_init)
        diff = diff.transpose(0, 2, 1, 3).reshape(B, S, DIFF_WIDTH)

        h = h + jnp.concatenate([fox, diff], axis=-1) @ w_out[l]
        h = h + hierarchical_moe(rms_norm(h, ffn_norm_g[l]), router_group_w[l], router_group_b[l],
                                 router_expert_w[l], router_expert_b[l],
                                 w_gate[l], w_up[l], w_down[l])
    return rms_norm(h, final_norm_g)
```

```cpp
#include <hip/hip_runtime.h>
#include <hip/hip_bf16.h>
#include <cstdio>
#include <cstdint>
#include <cmath>

#ifndef NAIVE_MASK
#define NAIVE_MASK 0u
#endif

typedef unsigned short bf16_t;
constexpr int NB = 2, S = 8192, DM = 2048, M = NB * S;
constexpr int NCOL = 6152, NQKV = 6144;
constexpr int FCOL = 3072;
constexpr int NE = 64, DFF = 1024;
constexpr int YROWS = 49152, NTILE_MAX = YROWS / 256;
constexpr int C_FQ = 0, C_FK = 1024, C_FV = 2048, C_DQ = 3072, C_DK = 4096, C_DV = 5120;
constexpr float ATT_SCALE = 0.08838834764831845f, ATT_ISCALE = 11.313708498984761f;
constexpr int NPHASE = 10;

constexpr size_t MiB = 1u << 20;
constexpr size_t WS_CTL = 0, CTL_ZERO_BYTES = 1 * MiB;
constexpr size_t WS_A1 = 1 * MiB;
constexpr size_t WS_WIN = 65 * MiB;
constexpr size_t WS_WOUT = 89 * MiB;
constexpr size_t WS_BIAS = 97 * MiB;
constexpr size_t WS_QKV = 98 * MiB;
constexpr size_t WS_A2 = 290 * MiB;
constexpr size_t WS_DT = 354 * MiB;
constexpr size_t WS_H1 = 418 * MiB;
constexpr size_t WS_ROUTE = 546 * MiB;
constexpr size_t WS_WR = 547 * MiB;
constexpr size_t WS_XG = 548 * MiB;
constexpr size_t WS_HBUF = 740 * MiB;
constexpr size_t WS_Y = 836 * MiB;
constexpr size_t WS_WGU = 1028 * MiB;
constexpr size_t WS_WD = 1540 * MiB;
constexpr size_t WS_END = 1796 * MiB;
constexpr int CW_CNT = 1024;
constexpr int CW_BAR = 4096;

namespace pg8 {
#define PG8_LAS __attribute__((address_space(3)))
typedef unsigned short bf16_t;
typedef short bf16x8 __attribute__((ext_vector_type(8)));
typedef float f32x4 __attribute__((ext_vector_type(4)));
typedef unsigned u32x4 __attribute__((ext_vector_type(4)));
constexpr int BM = 256, BK = 64, HALF = 128, HTB = HALF * BK * 2  , STAGE_BYTES = 8 * HTB, NXCD = 8, WGM = 8;

__host__ __device__ __forceinline__ int lds_byte(int r, int c) { const int st = (r >> 4) * 2 + (c >> 5), rr = r & 15, cc = c & 31, ob = rr * 64 + cc * 2; return st * 1024 + (ob ^ (((ob >> 9) & 1) << 5)); }
__host__ __device__ __forceinline__ void stage_rc(int b, int& R, int& C) { const int st = b / 1024, sb = b % 1024, swz = sb ^ (((sb >> 9) & 1) << 5); R = (st >> 1) * 16 + swz / 64; C = (st & 1) * 32 + (swz % 64) / 2; }
__host__ __device__ __forceinline__ int perm32(int rho) { const int n = rho >> 4, i = rho & 15; return 8 * (i >> 2) + 4 * n + (i & 3); }

struct Unit { int pm, pn; };
struct Gemm { const bf16_t* A; const bf16_t* Bt; int M, N, K; };

struct StaticOrder {
    int nM, nN, nwg, G, c;
    __host__ __device__ void init(int M, int N, int G_, int c_) { nM = M / BM; nN = N / BM; nwg = nM * nN; G = G_; c = c_; }
    __host__ __device__ bool next(int i, Unit& u) const {
        const long L = (long)i * G + c; if (L >= nwg) return false;
        int wgid = (int)L; { const int q = nwg / NXCD, r = nwg % NXCD, xcd = wgid % NXCD, off = wgid / NXCD; wgid = (xcd < r ? xcd * (q + 1) : r * (q + 1) + (xcd - r) * q) + off; }
        const int nig = WGM * nN, gid = wgid / nig, fm = gid * WGM, gsz = (nM - fm) < WGM ? (nM - fm) : WGM;
        u.pm = fm + ((wgid % nig) % gsz); u.pn = (wgid % nig) / gsz; return true;
    }
    __device__ __forceinline__ void a_ready(const Unit&) const {}
    __device__ __forceinline__ void done(const Unit&) const {}
};

__device__ __forceinline__ unsigned cvt_pk_bf16(float lo, float hi) { unsigned r; asm volatile("v_cvt_pk_bf16_f32 %0, %1, %2" : "=v"(r) : "v"(lo), "v"(hi)); return r; }
typedef float f32x2 __attribute__((ext_vector_type(2)));
__device__ __forceinline__ f32x2 gelu_pk(f32x2 v) {
    const f32x2 av = __builtin_elementwise_abs(v), d = av * 0.2316418882f + 1.0f;
    f32x2 t; t.x = __builtin_amdgcn_rcpf(d.x); t.y = __builtin_amdgcn_rcpf(d.y);
    f32x2 q = t * 0.5307027145f + (-0.7265760135f); q = q * t + 0.7107068705f; q = q * t + (-0.142248368f); q = q * t + 0.127414796f; q = q * t;
    const f32x2 s = (v * v) * (-0.72134752044f);
    f32x2 e; e.x = __builtin_amdgcn_exp2f(s.x); e.y = __builtin_amdgcn_exp2f(s.y);
    const f32x2 m = v * (q * e), r = v - m;
    f32x2 o; o.x = v.x < 0.f ? m.x : r.x; o.y = v.y < 0.f ? m.y : r.y; return o;
}

template <int ACT  > struct EpiBf16 {
    static constexpr bool PERM = true, AFTER_DRAIN = false; static_assert(ACT == 0 || ACT == 1, "EpiBf16: ACT is 0 (none) or 1 (gelu_pk)");
    bf16_t* O; int ldc; const float* bias; int split_cols; size_t split_stride; float scale0;
    __device__ __forceinline__ void operator()(const f32x4 (&acc)[2][2][4][2], const Unit& u, int wr, int wc, int fr, int fq) const {
        const int row0 = u.pm * BM + wr * 64 + fr; int colt = u.pn * BM; bf16_t* base = O;
        float sc = 1.f; if (split_cols) { const int t = colt / split_cols; base += (size_t)t * split_stride; colt -= t * split_cols; if (t == 0) sc = scale0; }
        const int col0 = colt + wc * 32 + 8 * fq, bcol0 = u.pn * BM + wc * 32 + 8 * fq;
        f32x4 bv[2][2];
#pragma unroll
        for (int bj = 0; bj < 2; ++bj)
#pragma unroll
            for (int n = 0; n < 2; ++n) bv[bj][n] = bias ? *(const f32x4*)(bias + bcol0 + bj * HALF + 4 * n) : (f32x4){0.f, 0.f, 0.f, 0.f};
#pragma unroll
        for (int ai = 0; ai < 2; ++ai)
#pragma unroll
            for (int m = 0; m < 4; ++m) { bf16_t* rowp = base + (size_t)(row0 + ai * HALF + m * 16) * ldc + col0;
#pragma unroll
                for (int bj = 0; bj < 2; ++bj) { f32x4 v0 = acc[ai][bj][m][0] + bv[bj][0], v1 = acc[ai][bj][m][1] + bv[bj][1];
                    if (ACT == 1) { f32x2 a = gelu_pk((f32x2){v0[0], v0[1]}), b = gelu_pk((f32x2){v0[2], v0[3]}), c = gelu_pk((f32x2){v1[0], v1[1]}), d = gelu_pk((f32x2){v1[2], v1[3]});
                        v0 = (f32x4){a.x, a.y, b.x, b.y}; v1 = (f32x4){c.x, c.y, d.x, d.y}; }
                    v0 = v0 * sc; v1 = v1 * sc; u32x4 w; w.x = cvt_pk_bf16(v0[0], v0[1]); w.y = cvt_pk_bf16(v0[2], v0[3]); w.z = cvt_pk_bf16(v1[0], v1[1]); w.w = cvt_pk_bf16(v1[2], v1[3]);
                    *(u32x4*)(rowp + bj * HALF) = w; } }
    }
};

struct EpiResF32 {
    static constexpr bool PERM = false, AFTER_DRAIN = false;
    const float* base; float* out; int ldc;
    __device__ __forceinline__ void operator()(const f32x4 (&acc)[2][2][4][2], const Unit& u, int wr, int wc, int fr, int fq) const {
        const int col0 = u.pn * BM + wc * 32 + 4 * fq;
#pragma unroll
        for (int ai = 0; ai < 2; ++ai)
#pragma unroll
            for (int m = 0; m < 4; ++m) { const size_t off = (size_t)(u.pm * BM + ai * HALF + wr * 64 + m * 16 + fr) * ldc + col0;
#pragma unroll
                for (int bj = 0; bj < 2; ++bj)
#pragma unroll
                    for (int n = 0; n < 2; ++n) { const f32x4 bs = *(const f32x4*)(base + off + bj * HALF + n * 16); *(f32x4*)(out + off + bj * HALF + n * 16) = bs + acc[ai][bj][m][n]; }
                if (m & 1) asm volatile("" ::: "memory"); }
    }
};
struct EpiSwiglu {
    static constexpr bool PERM = true, AFTER_DRAIN = false;
    bf16_t* H;
    __device__ __forceinline__ void operator()(const f32x4 (&acc)[2][2][4][2], const Unit& u, int wr, int wc, int fr, int fq) const {
        const int col0 = (u.pn & 7) * HALF + wc * 32 + 8 * fq;
#pragma unroll
        for (int ai = 0; ai < 2; ++ai)
#pragma unroll
            for (int m = 0; m < 4; ++m) { bf16_t* rowp = H + (size_t)(u.pm * BM + ai * HALF + wr * 64 + m * 16 + fr) * 1024 + col0;
                float hv[8];
#pragma unroll
                for (int n = 0; n < 2; ++n)
#pragma unroll
                    for (int c = 0; c < 4; ++c) { const float g = acc[ai][0][m][n][c], uu = acc[ai][1][m][n][c];
                        hv[n * 4 + c] = g * __builtin_amdgcn_rcpf(1.f + __builtin_amdgcn_exp2f(-1.4426950408889634f * g)) * uu; }
                u32x4 w; w.x = cvt_pk_bf16(hv[0], hv[1]); w.y = cvt_pk_bf16(hv[2], hv[3]); w.z = cvt_pk_bf16(hv[4], hv[5]); w.w = cvt_pk_bf16(hv[6], hv[7]);
                *(u32x4*)rowp = w; }
    }
};
struct EpiDown {
    static constexpr bool PERM = true, AFTER_DRAIN = false;
    bf16_t* Y; const float* rowgate;
    __device__ __forceinline__ void operator()(const f32x4 (&acc)[2][2][4][2], const Unit& u, int wr, int wc, int fr, int fq) const {
        const int col0 = (u.pn & 7) * BM + wc * 32 + 8 * fq;
#pragma unroll
        for (int ai = 0; ai < 2; ++ai)
#pragma unroll
            for (int m = 0; m < 4; ++m) { const int row = u.pm * BM + ai * HALF + wr * 64 + m * 16 + fr; const float gt = rowgate[row]; bf16_t* rowp = Y + (size_t)row * 2048 + col0;
#pragma unroll
                for (int bj = 0; bj < 2; ++bj) { const f32x4 v0 = acc[ai][bj][m][0] * gt, v1 = acc[ai][bj][m][1] * gt;
                    u32x4 w; w.x = cvt_pk_bf16(v0[0], v0[1]); w.y = cvt_pk_bf16(v0[2], v0[3]); w.z = cvt_pk_bf16(v1[0], v1[1]); w.w = cvt_pk_bf16(v1[2], v1[3]);
                    *(u32x4*)(rowp + bj * HALF) = w; } }
    }
};
struct GroupedOrder {
    int total, G, c; const PG8_LAS int* tile_e;
    __device__ __forceinline__ bool next(int i, Unit& u) const {
        const int L = i * G + c; if (L >= total) return false;
        u.pm = L >> 3; u.pn = __builtin_amdgcn_readfirstlane(tile_e[L >> 3]) * 8 + (L & 7); return true;
    }
    __device__ __forceinline__ void a_ready(const Unit&) const {}
    __device__ __forceinline__ void done(const Unit&) const {}
};

template <class Epi, class Sched, bool ALIGN_EPI = false, bool SP2 = false>
__device__ __forceinline__ void gemm_phase(PG8_LAS unsigned char* lds, const Gemm g, const Sched& S, const Epi& E) {
    const int tid = threadIdx.x, wid = __builtin_amdgcn_readfirstlane(tid >> 6), lane = tid & 63, wr = wid >> 2, wc = wid & 3, fr = lane & 15, fq = lane >> 4;
    const int K = g.K, nt = K / BK;
    unsigned voffA[2], voffB[2];
#pragma unroll
    for (int i = 0; i < 2; ++i) { int R, C; stage_rc(tid * 16 + i * 8192, R, C); const int Rb = Epi::PERM ? ((R & ~31) + perm32(R & 31)) : R;
        voffA[i] = (unsigned)(R * K + C) * 2u; voffB[i] = (unsigned)(Rb * K + C) * 2u; }
    const size_t kstep = (size_t)(BK * 2);
    const size_t hstep = (size_t)HALF * K * 2;
    const size_t tstep = 2 * hstep;
    const unsigned ldsw = (unsigned)wid * 1024u;
    const int aoff = lds_byte(wr * 64 + fr, fq * 8), boff = lds_byte(wc * 32 + fr, fq * 8);
#define PG8_SA(b, h) (((b) * 2 + (h)) * HTB)
#define PG8_SB(b, h) ((4 + (b) * 2 + (h)) * HTB)
#define PG8_STAGE(bufoff, gbase, voff) do { _Pragma("unroll") for (int _i = 0; _i < 2; ++_i) \
        __builtin_amdgcn_global_load_lds((const unsigned*)((const char*)(gbase) + (voff)[_i]), (PG8_LAS unsigned*)(lds + (bufoff) + ldsw + _i * 8192), 16, 0, 0); } while (0)
#define PG8_LDA(dst, b, h) do { _Pragma("unroll") for (int m = 0; m < 4; ++m) _Pragma("unroll") for (int k = 0; k < 2; ++k) dst[m][k] = *(const PG8_LAS bf16x8*)(lds + PG8_SA(b, h) + aoff + m * 2048 + k * 1024); } while (0)
#define PG8_LDB(dst, b, h) do { _Pragma("unroll") for (int n = 0; n < 2; ++n) _Pragma("unroll") for (int k = 0; k < 2; ++k) dst[n][k] = *(const PG8_LAS bf16x8*)(lds + PG8_SB(b, h) + boff + n * 2048 + k * 1024); } while (0)
#define PG8_MMA(ai, bj, At, Bt) do { __builtin_amdgcn_s_setprio(1); _Pragma("unroll") for (int m = 0; m < 4; ++m) _Pragma("unroll") for (int n = 0; n < 2; ++n) _Pragma("unroll") for (int k = 0; k < 2; ++k) \
        acc[ai][bj][m][n] = __builtin_amdgcn_mfma_f32_16x16x32_bf16(Bt[n][k], At[m][k], acc[ai][bj][m][n], 0, 0, 0); __builtin_amdgcn_s_setprio(0); } while (0)
#define PG8_WAIT_V(n) asm volatile("s_waitcnt vmcnt(" #n ")" ::: "memory")
#define PG8_WAIT_L(n) asm volatile("s_waitcnt lgkmcnt(" #n ")" ::: "memory")
#define PG8_BAR __builtin_amdgcn_s_barrier()
#define PG8_SCHED __builtin_amdgcn_sched_barrier(0)
    Unit cur, nxt; int ui = 0;
    if (!S.next(0, cur)) return;
    f32x4 acc[2][2][4][2];
#pragma unroll
    for (int a = 0; a < 2; ++a)
#pragma unroll
        for (int b = 0; b < 2; ++b)
#pragma unroll
            for (int m = 0; m < 4; ++m)
#pragma unroll
                for (int n = 0; n < 2; ++n) acc[a][b][m][n] = (f32x4){0.f, 0.f, 0.f, 0.f};
    bf16x8 At[4][2], B0[2][2], B1[2][2];
    const char* cA = (const char*)g.A + (size_t)cur.pm * tstep; const char* cB = (const char*)g.Bt + (size_t)cur.pn * tstep;
    S.a_ready(cur);
    if constexpr (SP2) {
        PG8_STAGE(PG8_SB(0, 0), cB, voffB); PG8_STAGE(PG8_SB(0, 1), cB + hstep, voffB); PG8_STAGE(PG8_SA(0, 0), cA, voffA); PG8_STAGE(PG8_SA(0, 1), cA + hstep, voffA);
        if (wr == 1) PG8_BAR;
        PG8_WAIT_V(2); PG8_BAR;
        PG8_STAGE(PG8_SB(1, 0), cB + kstep, voffB); PG8_STAGE(PG8_SA(1, 0), cA + kstep, voffA); PG8_STAGE(PG8_SB(1, 1), cB + hstep + kstep, voffB);
        PG8_WAIT_V(6); PG8_BAR;
    } else {
        PG8_STAGE(PG8_SB(0, 0), cB, voffB); PG8_STAGE(PG8_SA(0, 0), cA, voffA); PG8_STAGE(PG8_SB(0, 1), cB + hstep, voffB); PG8_STAGE(PG8_SA(0, 1), cA + hstep, voffA);
        if (wr == 1) PG8_BAR;
        PG8_WAIT_V(4); PG8_BAR;
        PG8_STAGE(PG8_SB(1, 0), cB + kstep, voffB); PG8_STAGE(PG8_SA(1, 0), cA + kstep, voffA); PG8_STAGE(PG8_SB(1, 1), cB + hstep + kstep, voffB);
        PG8_WAIT_V(6); PG8_BAR;
    }
    for (;;) {
        const bool has_next = S.next(ui + 1, nxt);
        const char* nA = has_next ? (const char*)g.A + (size_t)nxt.pm * tstep : cA; const char* nB = has_next ? (const char*)g.Bt + (size_t)nxt.pn * tstep : cB;
        for (int t = 0; t < nt; t += 2) {
            const bool last = (t == nt - 2);
            const char* a1 = cA + (size_t)(t + 1) * kstep;
            const char* a2 = last ? nA : cA + (size_t)(t + 2) * kstep; const char* b2 = last ? nB : cB + (size_t)(t + 2) * kstep;
            const char* a3 = a2 + kstep; const char* b3 = b2 + kstep;
            if (last && has_next) S.a_ready(nxt);
            if constexpr (SP2) {
            PG8_LDB(B0, 0, 0); PG8_LDB(B1, 0, 1); PG8_SCHED; PG8_LDA(At, 0, 0); PG8_STAGE(PG8_SA(1, 1), a1 + hstep, voffA);
            PG8_WAIT_V(8); PG8_WAIT_L(0); PG8_BAR; PG8_MMA(0, 0, At, B0); PG8_MMA(0, 1, At, B1); PG8_BAR; PG8_SCHED;
            PG8_LDA(At, 0, 1); PG8_STAGE(PG8_SB(0, 0), b2, voffB); PG8_STAGE(PG8_SB(0, 1), b2 + hstep, voffB); PG8_STAGE(PG8_SA(0, 0), a2, voffA);
            PG8_WAIT_V(8); PG8_WAIT_L(0); PG8_BAR; PG8_MMA(1, 0, At, B0); PG8_MMA(1, 1, At, B1); PG8_BAR; PG8_SCHED;
            PG8_LDB(B0, 1, 0); PG8_LDB(B1, 1, 1); PG8_SCHED; PG8_LDA(At, 1, 0); PG8_STAGE(PG8_SA(0, 1), a2 + hstep, voffA);
            PG8_WAIT_V(8); PG8_WAIT_L(0); PG8_BAR; PG8_MMA(0, 0, At, B0); PG8_MMA(0, 1, At, B1); PG8_BAR; PG8_SCHED;
            PG8_LDA(At, 1, 1); PG8_STAGE(PG8_SB(1, 0), b3, voffB); PG8_STAGE(PG8_SB(1, 1), b3 + hstep, voffB); PG8_STAGE(PG8_SA(1, 0), a3, voffA);
            PG8_WAIT_V(8); PG8_WAIT_L(0); PG8_BAR; PG8_MMA(1, 0, At, B0); PG8_MMA(1, 1, At, B1); PG8_BAR; PG8_SCHED;
            } else {
            PG8_LDB(B0, 0, 0); PG8_SCHED; PG8_LDA(At, 0, 0); PG8_STAGE(PG8_SA(1, 1), a1 + hstep, voffA);
            PG8_WAIT_L(8); PG8_BAR; PG8_WAIT_L(0); PG8_MMA(0, 0, At, B0); PG8_BAR; PG8_SCHED;
            PG8_LDB(B1, 0, 1); PG8_STAGE(PG8_SB(0, 0), b2, voffB);
            PG8_BAR; PG8_WAIT_L(0); PG8_MMA(0, 1, At, B1); PG8_BAR;
            PG8_LDA(At, 0, 1); PG8_STAGE(PG8_SA(0, 0), a2, voffA);
            PG8_BAR; PG8_WAIT_L(0); PG8_MMA(1, 0, At, B0); PG8_BAR; PG8_SCHED;
            PG8_STAGE(PG8_SB(0, 1), b2 + hstep, voffB);
            PG8_WAIT_V(6); PG8_BAR; PG8_MMA(1, 1, At, B1); PG8_BAR;
            PG8_LDB(B0, 1, 0); PG8_SCHED; PG8_LDA(At, 1, 0); PG8_STAGE(PG8_SA(0, 1), a2 + hstep, voffA);
            PG8_WAIT_L(8); PG8_BAR; PG8_WAIT_L(0); PG8_MMA(0, 0, At, B0); PG8_BAR; PG8_SCHED;
            PG8_LDB(B1, 1, 1); PG8_STAGE(PG8_SB(1, 0), b3, voffB);
            PG8_BAR; PG8_WAIT_L(0); PG8_MMA(0, 1, At, B1); PG8_BAR;
            PG8_LDA(At, 1, 1); PG8_STAGE(PG8_SA(1, 0), a3, voffA);
            PG8_BAR; PG8_WAIT_L(0); PG8_MMA(1, 0, At, B0); PG8_BAR; PG8_SCHED;
            PG8_STAGE(PG8_SB(1, 1), b3 + hstep, voffB);
            PG8_WAIT_V(6); PG8_BAR; PG8_MMA(1, 1, At, B1); PG8_BAR;
            }
        }
        if constexpr (ALIGN_EPI) { if (wr == 0) PG8_BAR; }
        if constexpr (!Epi::AFTER_DRAIN) { E(acc, cur, wr, wc, fr, fq); S.done(cur); }
        if (!has_next) break;
#pragma unroll
        for (int a = 0; a < 2; ++a)
#pragma unroll
            for (int b = 0; b < 2; ++b)
#pragma unroll
                for (int m = 0; m < 4; ++m)
#pragma unroll
                    for (int n = 0; n < 2; ++n) acc[a][b][m][n] = (f32x4){0.f, 0.f, 0.f, 0.f};
        cur = nxt; cA = nA; cB = nB; ++ui;
        if constexpr (ALIGN_EPI) { if (wr == 1) PG8_BAR; }
    }
    PG8_WAIT_V(0);
    if constexpr (!ALIGN_EPI) { if (wr == 0) PG8_BAR; }
    PG8_BAR;
    if constexpr (Epi::AFTER_DRAIN) { E.fused(acc, cur, wr, wc, fr, fq, lds, wid, lane); S.done(cur); }
#undef PG8_SA
#undef PG8_SB
#undef PG8_STAGE
#undef PG8_LDA
#undef PG8_LDB
#undef PG8_MMA
#undef PG8_WAIT_V
#undef PG8_WAIT_L
#undef PG8_BAR
#undef PG8_SCHED
}
}

namespace att {
using TIN = __hip_bfloat16; using TOUT = __hip_bfloat16;
constexpr int B = 2, H = 1, HKV = 1, SQ = 8192, SKV = 8192, D = 128, QOFF = 0, WINDOW = SKV;
constexpr float THR = 8.f;
constexpr bool WSKIP = false;
constexpr int LDQ = 6144, LDO = 2048;
constexpr int W_INF = 1 << 30;
constexpr float SCALE = 0.08838834764831845f;
constexpr int NW = 8, QBLK = 32, KVBLK = 64, QB = NW * QBLK;
constexpr int SHM_V = KVBLK * D * 2, SHM_K = KVBLK * D * 2;
constexpr int OFF_WS = 2 * SHM_V + 2 * SHM_K, OFF_CB = OFF_WS + NW * 64 * 4, LDS_BYTES = OFF_CB + 2 * 64 * 4;
static_assert(D == 128 && SQ % QB == 0 && SKV % KVBLK == 0 && H % HKV == 0 && QOFF >= 0 && QOFF + SQ <= SKV && WINDOW >= 1, "geometry");

using bf16 = __hip_bfloat16;
typedef short bf16x8 __attribute__((ext_vector_type(8)));
typedef short s16x4 __attribute__((ext_vector_type(4)));
typedef float f32x16 __attribute__((ext_vector_type(16)));
typedef float f32x4 __attribute__((ext_vector_type(4)));
typedef unsigned u32x4 __attribute__((ext_vector_type(4)));
template <class A, class Bt> struct same_t { static constexpr bool v = false; };
template <class A> struct same_t<A, A> { static constexpr bool v = true; };

#define KSWZ(row, colB) ((row) * 256 + ((colB) ^ (((row) & 7) << 4)))
#define SBAR() __builtin_amdgcn_sched_barrier(0)
__device__ __forceinline__ int v_st(int k, int c) { const int kk = (k & ~0xC) | ((k & 4) << 1) | ((k & 8) >> 1); return ((kk >> 3) * 4 + (c >> 5)) * 512 + ((kk & 7) * 32 + (c & 31)) * 2; }
__device__ __forceinline__ int v_rd_base(int lane) { return ((lane & 3) << 3) | (((lane >> 2) & 3) << 6) | (((lane >> 4) & 1) << 5) | (((lane >> 5) & 1) << 8); }
constexpr int v_rd_off(int d0, int ks, int half) { return d0 * 512 + ks * 4096 + half * 2048; }
__device__ __forceinline__ int crow(int r, int hi) { return (r & 3) + 8 * (r >> 2) + 4 * hi; }
__device__ __forceinline__ unsigned cvtpk(float lo, float hi) {
    unsigned r; asm volatile("v_cvt_pk_bf16_f32 %0, %1, %2" : "=v"(r) : "v"(lo), "v"(hi)); return r;
}
__device__ __forceinline__ bf16x8 pack8(f32x4 a, f32x4 b) {
    u32x4 w = {cvtpk(a[0], a[1]), cvtpk(a[2], a[3]), cvtpk(b[0], b[1]), cvtpk(b[2], b[3])};
    return *reinterpret_cast<bf16x8*>(&w);
}
template <class T> __device__ __forceinline__ bf16x8 load8(const T* p) {
    if constexpr (same_t<T, float>::v) { return pack8(*(const f32x4*)p, *(const f32x4*)(p + 4)); }
    else { return *reinterpret_cast<const bf16x8*>(p); }
}
__device__ __forceinline__ void mask_tile(f32x16& p0, f32x16& p1, int dq, unsigned W) {
    const float NEG = -__builtin_inff();
#pragma unroll
    for (int r = 0; r < 16; ++r) {
        const int c = (r & 3) + 8 * (r >> 2);
        if ((unsigned)(dq - c) >= W) p0[r] = NEG;
        if ((unsigned)(dq - c - 32) >= W) p1[r] = NEG;
    }
}
__device__ __forceinline__ void partialSM(f32x16& p0, f32x16& p1, float& m_reg, float& mn, float& alpha) {
    float pmax = p0[0]; for (int r = 1; r < 16; ++r) pmax = fmaxf(pmax, p0[r]); for (int r = 0; r < 16; ++r) pmax = fmaxf(pmax, p1[r]);
    { auto rr = __builtin_amdgcn_permlane32_swap(__float_as_uint(pmax), __float_as_uint(pmax), false, false);
      pmax = fmaxf(__uint_as_float(rr[0]), __uint_as_float(rr[1])); }
    constexpr float C2 = 1.4426950408889634f * SCALE;
    if (__builtin_expect(__all((pmax - m_reg) * SCALE <= THR), 1)) { mn = m_reg; alpha = 1.f; }
    else { mn = fmaxf(m_reg, pmax); alpha = __builtin_amdgcn_exp2f((m_reg - mn) * C2); m_reg = mn; }
    const float mnL = -mn * C2;
    for (int r = 0; r < 16; ++r) p0[r] = fmaf(p0[r], C2, mnL); for (int r = 0; r < 16; ++r) p1[r] = fmaf(p1[r], C2, mnL);
    for (int r = 0; r < 16; ++r) p0[r] = __builtin_amdgcn_exp2f(p0[r]);
}
__device__ __forceinline__ void finishSM(f32x16& p0, f32x16& p1, float alpha, float& l_reg, bf16x8& pa0, bf16x8& pa1, bf16x8& pa2, bf16x8& pa3) {
    for (int r = 0; r < 16; ++r) p1[r] = __builtin_amdgcn_exp2f(p1[r]);
    float ps = 0; for (int r = 0; r < 16; ++r) ps += p0[r]; for (int r = 0; r < 16; ++r) ps += p1[r];
    { auto rr = __builtin_amdgcn_permlane32_swap(__float_as_uint(ps), __float_as_uint(ps), false, false);
      ps = __uint_as_float(rr[0]) + __uint_as_float(rr[1]); }
    l_reg = l_reg * alpha + ps;
#define PK4(P, B_, OUT) do { unsigned a0 = cvtpk(P[B_+0], P[B_+1]), a1 = cvtpk(P[B_+2], P[B_+3]);                          \
        unsigned b0 = cvtpk(P[B_+4], P[B_+5]), b1 = cvtpk(P[B_+6], P[B_+7]);                                             \
        auto r0 = __builtin_amdgcn_permlane32_swap(a0, b0, false, false); auto r1 = __builtin_amdgcn_permlane32_swap(a1, b1, false, false); \
        u32x4 w = {r0[0], r1[0], r0[1], r1[1]}; OUT = *reinterpret_cast<bf16x8*>(&w); } while (0)
    PK4(p0, 0, pa0); PK4(p0, 8, pa1); PK4(p1, 0, pa2); PK4(p1, 8, pa3);
#undef PK4
}
template <int KB, bool SK>
__device__ __forceinline__ void qkt(f32x16& p0, f32x16& p1, const char* K_lds, int r32, int hi, const bf16x8* qr, bool act, const float* cbt, float cqs) {
    if (SK && !act) { const float NEG = -__builtin_inff();
#pragma unroll
        for (int r = 0; r < 16; ++r) { p0[r] = NEG; p1[r] = NEG; } return; }
    { const f32x4* c4 = (const f32x4*)(cbt + KB * 64);
#pragma unroll
      for (int g = 0; g < 4; ++g) { const f32x4 a = c4[2 * g], b = c4[8 + 2 * g];
#pragma unroll
          for (int i = 0; i < 4; ++i) { p0[4 * g + i] = cqs - a[i]; p1[4 * g + i] = cqs - b[i]; } } }
    const char* kb[4];
#pragma unroll
    for (int dd = 0; dd < 4; ++dd) kb[dd] = K_lds + KB * SHM_K + KSWZ(r32, (dd * 16 + hi * 8) * 2);
#pragma unroll
    for (int d0 = 0; d0 < 8; ++d0) { const char* a = kb[d0 & 3] + (d0 >> 2) * 128;
        bf16x8 b0 = *reinterpret_cast<const bf16x8*>(a);
        bf16x8 b1 = *reinterpret_cast<const bf16x8*>(a + 32 * 256);
        p0 = __builtin_amdgcn_mfma_f32_32x32x16_bf16(b0, qr[d0], p0, 0, 0, 0);
        p1 = __builtin_amdgcn_mfma_f32_32x32x16_bf16(b1, qr[d0], p1, 0, 0, 0); }
}
template <int VB, bool SK>
__device__ __forceinline__ void pv_tile(f32x16* o, int vb0, bf16x8 pa0, bf16x8 pa1, bf16x8 pa2, bf16x8 pa3, bool act) {
    if (SK && !act) return;
#define TRRD(dst, off) asm volatile("ds_read_b64_tr_b16 %0, %1 offset:%2" : "=&v"(dst) : "v"(vb0), "i"(off) : "memory")
#define PV_D0(d0) do { s16x4 l0, l1, l2, l3, h0, h1, h2, h3; constexpr int b_ = VB * SHM_V + v_rd_off(d0, 0, 0);     \
        TRRD(l0, b_); TRRD(h0, b_ + 2048); TRRD(l1, b_ + 4096); TRRD(h1, b_ + 6144); TRRD(l2, b_ + 8192); TRRD(h2, b_ + 10240); TRRD(l3, b_ + 12288); TRRD(h3, b_ + 14336); \
        asm volatile("s_waitcnt lgkmcnt(0)" ::: "memory"); SBAR();                 \
        o[d0] = __builtin_amdgcn_mfma_f32_32x32x16_bf16(pa0, (bf16x8){l0[0], l0[1], l0[2], l0[3], h0[0], h0[1], h0[2], h0[3]}, o[d0], 0, 0, 0);   \
        o[d0] = __builtin_amdgcn_mfma_f32_32x32x16_bf16(pa1, (bf16x8){l1[0], l1[1], l1[2], l1[3], h1[0], h1[1], h1[2], h1[3]}, o[d0], 0, 0, 0);   \
        o[d0] = __builtin_amdgcn_mfma_f32_32x32x16_bf16(pa2, (bf16x8){l2[0], l2[1], l2[2], l2[3], h2[0], h2[1], h2[2], h2[3]}, o[d0], 0, 0, 0);   \
        o[d0] = __builtin_amdgcn_mfma_f32_32x32x16_bf16(pa3, (bf16x8){l3[0], l3[1], l3[2], l3[3], h3[0], h3[1], h3[2], h3[3]}, o[d0], 0, 0, 0); } while (0)
    PV_D0(0); PV_D0(1); PV_D0(2); PV_D0(3);
#undef PV_D0
#undef TRRD
}
template <class TIn, class TOut> struct BlockRef { const TIn* Q; const TIn* K; const TIn* V; TOut* O; const float* C; int P0; };
template <class TIn> struct Seam {
    bf16x8 qr[8];
    bf16x8 st_v0, st_v1, st_k0, st_k1; f32x4 sf0, sf1, sf2, sf3;
    float cq, st_c;
    f32x4 tq[16];
};
__device__ __forceinline__ int swa_jlo(int P0, int W) { const int lowk = P0 - W + 1; return lowk > 0 ? lowk / KVBLK : 0; }
#define ROW(p, k0, rr) ((p) + (size_t)((k0) + (rr)) * LDQ + sc)
#define VMW() asm volatile("s_waitcnt vmcnt(0)" ::: "memory")
#define VMWN(n) asm volatile("s_waitcnt vmcnt(%0)" :: "i"(n) : "memory")
#define SLOAD_H(Kp, Vp, Cp, k0) do { S.st_v0 = load8<TIn>(ROW(Vp, k0, sr)); S.st_v1 = load8<TIn>(ROW(Vp, k0, 32 + sr));              \
                         S.st_k0 = load8<TIn>(ROW(Kp, k0, sr)); S.st_k1 = load8<TIn>(ROW(Kp, k0, 32 + sr)); S.st_c = (Cp)[(k0) + (tid & 63)]; } while (0)
#define SWRITE_HK(bf) do { *(bf16x8*)(K_lds + (bf) * SHM_K + kws) = S.st_k0; *(bf16x8*)(K_lds + (bf) * SHM_K + kws + 32 * 256) = S.st_k1; \
                           if (tid < 64) cbw[(bf) * 64 + tid] = S.st_c; } while (0)
#define SWRITE_HV(bf) do { *(bf16x8*)(V_lds + (bf) * SHM_V + vst0) = S.st_v0; *(bf16x8*)(V_lds + (bf) * SHM_V + vst1) = S.st_v1; } while (0)
#define SWRITE_H(bf) do { SWRITE_HV(bf); SWRITE_HK(bf); } while (0)
#define SLOAD_F(p, k0) do { S.sf0 = *(const f32x4*)ROW(p, k0, sr); S.sf1 = *(const f32x4*)(ROW(p, k0, sr) + 4);                \
                            S.sf2 = *(const f32x4*)ROW(p, k0, 32 + sr); S.sf3 = *(const f32x4*)(ROW(p, k0, 32 + sr) + 4); } while (0)
#define SWRITE_KF(bf) do { *(bf16x8*)(K_lds + (bf) * SHM_K + kws) = pack8(S.sf0, S.sf1); *(bf16x8*)(K_lds + (bf) * SHM_K + kws + 32 * 256) = pack8(S.sf2, S.sf3); } while (0)
#define SWRITE_VF(bf) do { *(bf16x8*)(V_lds + (bf) * SHM_V + vst0) = pack8(S.sf0, S.sf1); *(bf16x8*)(V_lds + (bf) * SHM_V + vst1) = pack8(S.sf2, S.sf3); } while (0)
template <class TIn, class TOut>
__device__ __forceinline__ void causal_swa_prime(const BlockRef<TIn, TOut>& cur, int W, char* lds, Seam<TIn>& S) {
    constexpr bool F32 = same_t<TIn, float>::v;
    const int tid = threadIdx.x, wid = __builtin_amdgcn_readfirstlane(tid >> 6), lane = tid & 63, r32 = lane & 31, hi = lane >> 5;
    const int sr = tid >> 4, sc = (tid & 15) * 8, kws = KSWZ(sr, sc * 2); char* K_lds = lds + 2 * SHM_V; float* cbw = (float*)(lds + OFF_CB);
    const int kb0 = swa_jlo(cur.P0, W) * KVBLK;
    for (int d0 = 0; d0 < 8; ++d0) S.qr[d0] = load8<TIn>(cur.Q + (size_t)(wid * QBLK + r32) * LDQ + d0 * 16 + hi * 8);
    S.cq = cur.C[cur.P0 + wid * QBLK + r32];
    if constexpr (F32) { SLOAD_F((const float*)cur.K, kb0); VMW(); SWRITE_KF(0); SBAR(); SLOAD_F((const float*)cur.V, kb0); }
    else { SLOAD_H(cur.K, cur.V, cur.C, kb0); VMW(); SWRITE_HK(0); }
    __syncthreads();
}
template <class TIn, class TOut>
__device__ __forceinline__ void causal_swa_block(const BlockRef<TIn, TOut>& cur, const BlockRef<TIn, TOut>& nxt, int skv, int W, char* lds, Seam<TIn>& S) {
    constexpr bool F32 = same_t<TIn, float>::v;
    const int tid = threadIdx.x, wid = __builtin_amdgcn_readfirstlane(tid >> 6), lane = tid & 63, r32 = lane & 31, hi = lane >> 5;
    const int j_lo = swa_jlo(cur.P0, W);
    int j_hi = (cur.P0 + QB - 1) / KVBLK + 1; if (j_hi > skv / KVBLK) j_hi = skv / KVBLK;
    const int NT = j_hi - j_lo;
    const int kbn = swa_jlo(nxt.P0, W) * KVBLK;
    const int qlo = cur.P0 + wid * QBLK, qm = qlo + r32 - 4 * hi;
    char* V_lds = lds; char* K_lds = lds + 2 * SHM_V; float* cbw = (float*)(lds + OFF_CB); const float* cbt = cbw + 4 * hi; const float* Ch = cur.C;
    float* ws = (float*)(lds + 2 * SHM_V + 2 * SHM_K) + wid * 64; float* li_l = ws, * al_l = ws + 32;
    float m_reg = -1e30f, l_reg = 0; f32x16 o[4] = {};
    const int sr = tid >> 4, sc = (tid & 15) * 8, vst0 = v_st(sr, sc), vst1 = v_st(32 + sr, sc), kws = KSWZ(sr, sc * 2);
    const int vb0 = (int)(uintptr_t)V_lds + v_rd_base(lane);
    const TIn* Kh = cur.K; const TIn* Vh = cur.V;
#define RESC(a) do { if (__any((a) < 1.f)) { if (hi == 0) al_l[r32] = (a); asm volatile("s_waitcnt lgkmcnt(0)" ::: "memory");              \
                     for (int d_ = 0; d_ < 4; ++d_) for (int r = 0; r < 16; ++r) o[d_][r] *= al_l[crow(r, hi)]; } } while (0)
#define KBASE(t) ((j_lo + (t)) * KVBLK)
#define ACT(t) (KBASE(t) <= qlo + QBLK - 1 && KBASE(t) + KVBLK - 1 >= qlo - W + 1)
#define MASKT(P0_, P1_, t) do { const int kb_ = KBASE(t); if ((!SK || ACT(t)) && (kb_ + KVBLK - 1 > qlo || kb_ <= qlo + QBLK - 1 - W)) mask_tile(P0_, P1_, qm - kb_, (unsigned)W); } while (0)
    constexpr int NQL = F32 ? 16 : 9;
    constexpr bool SK = WSKIP && !F32;
#define SEAM_K0() do { VMWN(NQL); if constexpr (F32) { SWRITE_KF(0); SBAR(); SLOAD_F((const float*)nxt.V, kbn); } else { SWRITE_HK(0); } SBAR(); } while (0)
    f32x16 pA0, pA1, pB0, pB1; float mnA, mnB, alA, alB; bf16x8 pa0, pa1, pa2, pa3;
    if constexpr (F32) { VMW(); SWRITE_VF(0); SBAR(); } else { SWRITE_HV(0); SBAR(); }
    if (NT > 1) { if constexpr (F32) SLOAD_F((const float*)Kh, KBASE(1)); else SLOAD_H(Kh, Vh, Ch, KBASE(1)); }
    SBAR(); qkt<0, SK>(pA0, pA1, K_lds, r32, hi, S.qr, ACT(0), cbt, S.cq);
    if constexpr (F32) { if (NT > 1) { VMW(); SWRITE_KF(1); SBAR(); SLOAD_F((const float*)Vh, KBASE(1)); } }
    MASKT(pA0, pA1, 0); partialSM(pA0, pA1, m_reg, mnA, alA);
    if (NT > 1) { VMW(); if constexpr (F32) { SWRITE_VF(1); SBAR(); if (NT > 2) SLOAD_F((const float*)Kh, KBASE(2)); } else SWRITE_H(1); }
    __syncthreads();
#define HALF_STEP(PX0, PX1, mnX, alX, PY0, PY1, alY, t, KB, VB, SB) do {                                                      \
        SBAR(); qkt<KB, SK>(PX0, PX1, K_lds, r32, hi, S.qr, ACT(t), cbt, S.cq);                                  \
        finishSM(PY0, PY1, alY, l_reg, pa0, pa1, pa2, pa3); SBAR();                                                           \
        if ((t) + 1 < NT) { if constexpr (F32) { VMW(); SWRITE_KF(SB); SBAR(); SLOAD_F((const float*)Vh, KBASE((t) + 1)); }  \
                            else { SLOAD_H(Kh, Vh, Ch, KBASE((t) + 1)); } SBAR(); }                                           \
        pv_tile<VB, SK>(o, vb0, pa0, pa1, pa2, pa3, ACT((t) - 1)); MASKT(PX0, PX1, (t)); partialSM(PX0, PX1, m_reg, mnX, alX);                                        \
        __syncthreads();                                                                                                      \
        if ((t) + 1 < NT) { VMW(); if constexpr (F32) { SWRITE_VF(SB); SBAR(); if ((t) + 2 < NT) SLOAD_F((const float*)Kh, KBASE((t) + 2)); } \
                            else { SWRITE_H(SB); } }                                                                          \
        RESC(alX); __syncthreads(); } while (0)
    for (int t = 1; t + 1 < NT; t += 2) {
        HALF_STEP(pB0, pB1, mnB, alB, pA0, pA1, alA, t, 1, 0, 0);
        HALF_STEP(pA0, pA1, mnA, alA, pB0, pB1, alB, t + 1, 0, 1, 1);
    }
    const bool even = (NT & 1) == 0;
    if (even) { SBAR(); qkt<1, SK>(pB0, pB1, K_lds, r32, hi, S.qr, ACT(NT - 1), cbt, S.cq); SBAR(); }
#define QROW(e) (nxt.Q + (size_t)(wid * QBLK + r32) * LDQ + ((e) >> 1) * 16 + hi * 8 + ((e) & 1) * 4)
    if constexpr (F32) { SLOAD_F((const float*)nxt.K, kbn); SBAR();
#pragma unroll
        for (int e = 0; e < 8; ++e) S.tq[e] = *(const f32x4*)QROW(e); }
    else { SLOAD_H(nxt.K, nxt.V, nxt.C, kbn); SBAR();
#pragma unroll
        for (int d0 = 0; d0 < 8; ++d0) S.qr[d0] = load8<TIn>(nxt.Q + (size_t)(wid * QBLK + r32) * LDQ + d0 * 16 + hi * 8);
        S.cq = nxt.C[nxt.P0 + wid * QBLK + r32]; }
    SBAR();
    finishSM(pA0, pA1, alA, l_reg, pa0, pa1, pa2, pa3); SBAR();
    if constexpr (F32) {
#pragma unroll
        for (int e = 8; e < 16; ++e) S.tq[e] = *(const f32x4*)QROW(e); SBAR(); }
#undef QROW
    pv_tile<0, SK>(o, vb0, pa0, pa1, pa2, pa3, ACT(even ? NT - 2 : NT - 1));
    if (even) { MASKT(pB0, pB1, NT - 1); partialSM(pB0, pB1, m_reg, mnB, alB); __syncthreads(); RESC(alB);
        finishSM(pB0, pB1, alB, l_reg, pa0, pa1, pa2, pa3); SBAR(); pv_tile<1, SK>(o, vb0, pa0, pa1, pa2, pa3, ACT(NT - 1)); }
    SBAR(); SEAM_K0();
    if (hi == 0) li_l[r32] = l_reg; asm volatile("s_waitcnt lgkmcnt(0)" ::: "memory");
    float rli[16];
#pragma unroll
    for (int r = 0; r < 16; ++r) rli[r] = __builtin_amdgcn_rcpf(li_l[crow(r, hi)]);
    TOut* Ow = cur.O + (size_t)(wid * QBLK) * LDO;
#pragma unroll
    for (int r = 0; r < 16; ++r) { const int orow = crow(r, hi);
#pragma unroll
        for (int d0 = 0; d0 < 4; ++d0) { const float v = o[d0][r] * rli[r];
            if constexpr (same_t<TOut, float>::v) { Ow[(size_t)orow * LDO + d0 * 32 + r32] = v; }
            else { const float vn = __shfl_xor(v, 1);
                   if ((r32 & 1) == 0) *(unsigned*)(Ow + (size_t)orow * LDO + d0 * 32 + r32) = cvtpk(v, vn); } } }
    if constexpr (F32) {
#pragma unroll
        for (int d0 = 0; d0 < 8; ++d0) S.qr[d0] = pack8(S.tq[2 * d0], S.tq[2 * d0 + 1]); }
    __syncthreads();
#undef RESC
#undef KBASE
#undef ACT
#undef MASKT
#undef SEAM_K0
#undef HALF_STEP
}
#undef ROW
#undef VMW
#undef VMWN
#undef SLOAD_H
#undef SWRITE_HK
#undef SWRITE_HV
#undef SWRITE_H
#undef SLOAD_F
#undef SWRITE_KF
#undef SWRITE_VF


struct Tensors { const bf16* QKV; bf16* A2; bf16* DT; const float* BIAS; };
typedef BlockRef<bf16, bf16> BRef;
__device__ __forceinline__ BRef item_ref(const Tensors& T, int L, int pass) {
    const int i = L >> 8, c = L & 255, prob = i * 16 + 2 * (c & 7) + (c >> 7), x = (c >> 3) & 15, qb = pass ? 31 - x : x;
    BRef r; int b, qc, kc, vc;
    if (prob < 16) { b = prob >> 3; const int h = prob & 7; qc = C_FQ + h * 128; kc = C_FK + h * 128; vc = C_FV + h * 128;
        r.O = T.A2 + ((size_t)b * S + (size_t)qb * QB) * LDO + h * 128; r.C = T.BIAS + (size_t)(b * 8 + h) * S; }
    else { const int q = prob - 16; b = q >> 4; const int h = (q >> 2) & 3, mp = (q >> 1) & 1, vh = q & 1; qc = C_DQ + h * 256 + mp * 128; kc = C_DK + h * 256 + mp * 128; vc = C_DV + h * 256 + vh * 128;
        r.O = T.DT + ((size_t)b * S + (size_t)qb * QB) * LDO + h * 512 + mp * 256 + vh * 128; r.C = T.BIAS + (size_t)(16 + h) * S; }
    const bf16* base = T.QKV + (size_t)b * S * LDQ;
    r.Q = base + (size_t)qb * QB * LDQ + qc; r.K = base + kc; r.V = base + vc; r.P0 = qb * QB;
    return r;
}
__device__ __forceinline__ void attn_phase(char* lds, const Tensors& T) {
    const int total = 768, stride = gridDim.x;
    int L = blockIdx.x; if (L >= total) return;
    int pass = 0;
    BRef cur = item_ref(T, L, 0);
    Seam<bf16> Sm;
    causal_swa_prime<bf16, bf16>(cur, W_INF, lds, Sm);
    for (;;) {
        const bool more_pass = pass == 0, more_item = L + stride < total, last = !more_pass && !more_item;
        int passn = pass + 1, Ln = L;
        if (!more_pass) { passn = 0; Ln = more_item ? L + stride : L; }
        const BRef nxt = last ? cur : item_ref(T, Ln, passn);
        causal_swa_block<bf16, bf16>(cur, nxt, S, W_INF, lds, Sm);
        if (last) break;
        cur = nxt; pass = passn; L = Ln;
    }
}
#undef KSWZ
#undef SBAR
}

#define GAS __attribute__((address_space(1)))
#define LAS __attribute__((address_space(3)))
typedef unsigned short bf16;
typedef unsigned v4u __attribute__((ext_vector_type(4)));
typedef float f32x4 __attribute__((ext_vector_type(4)));
typedef short bf16x8 __attribute__((ext_vector_type(8)));
typedef GAS unsigned gu32;
typedef GAS unsigned long long gu64;
#define RLX_AGENT __ATOMIC_RELAXED, __HIP_MEMORY_SCOPE_AGENT
#define LDS_WAIT() asm volatile("s_waitcnt lgkmcnt(0)" ::: "memory")
#define VM_WAIT() asm volatile("s_waitcnt vmcnt(0)" ::: "memory")
__device__ __forceinline__ unsigned long long rt() { return __builtin_amdgcn_s_memrealtime(); }
__device__ __forceinline__ unsigned f2bf(float f) { unsigned u = __builtin_bit_cast(unsigned, f); return (u + 0x7fffu + ((u >> 16) & 1u)) >> 16; }
__device__ __forceinline__ unsigned pk2(float lo, float hi) { return f2bf(lo) | (f2bf(hi) << 16); }

#define XB_TMO      128
#define XB_XCNT(j)  (256  + 64 * (j))
#define XB_XSUB(j)  (1280 + 64 * (j))
#define XB_XGEN(j)  (2304 + 64 * (j))
#define XB_TOP      3328
#define XB_TOPGEN   3392
#define XCD_BAR_WORDS 3456
#define XB_SPIN_CAP (1u << 18)

__device__ __forceinline__ unsigned xb_ld(unsigned* p)              { return __hip_atomic_load(p, __ATOMIC_RELAXED, __HIP_MEMORY_SCOPE_AGENT); }
__device__ __forceinline__ unsigned xb_add(unsigned* p, unsigned v) { return __hip_atomic_fetch_add(p, v, __ATOMIC_RELAXED, __HIP_MEMORY_SCOPE_AGENT); }
__device__ __forceinline__ unsigned xb_xcc_id() { return (unsigned)__builtin_amdgcn_s_getreg((3 << 11) | 20) & 0xFu; }
#define XB_SPIN(cond, bar) do { unsigned _sp = 0; while (cond) { __builtin_amdgcn_s_sleep(1); \
    if ((++_sp & 255u) == 0u) { if (xb_ld(&(bar)[XB_TMO])) break; if (_sp > XB_SPIN_CAP) { atomicAdd(&(bar)[XB_TMO], 1u); break; } } } } while (0)

struct XcdBarrier {
    unsigned* bar; unsigned x;
    volatile LAS unsigned* st;
};

__device__ __forceinline__ XcdBarrier xcd_barrier_post(unsigned* bar, volatile LAS unsigned* st) {
    XcdBarrier b; b.bar = bar; b.x = xb_xcc_id(); b.st = st;
    if (threadIdx.x == 0) (void)xb_add(&bar[XB_XCNT(b.x)], 1u);
    return b;
}
__device__ __forceinline__ void xcd_barrier_complete(unsigned* bar, unsigned x, unsigned& nloc, unsigned& nx) {
    const unsigned G = gridDim.x * gridDim.y * gridDim.z;
    unsigned sum, cnt, mine, sp = 0u;
    for (;;) {
        sum = 0u; cnt = 0u; mine = 0u;
#pragma unroll
        for (unsigned j = 0; j < 16; ++j) { const unsigned c = xb_ld(&bar[XB_XCNT(j)]); sum += c; cnt += (c > 0u) ? 1u : 0u; mine = (j == x) ? c : mine; }
        if (sum == G) break;
        __builtin_amdgcn_s_sleep(1);
        if ((++sp & 255u) == 0u) { if (xb_ld(&bar[XB_TMO])) break; if (sp > XB_SPIN_CAP) { atomicAdd(&bar[XB_TMO], 1u); break; } }
    }
    nloc = mine > 0u ? mine : 1u; nx = cnt > 0u ? cnt : 1u;
}

__device__ __forceinline__ void xcd_barrier(const XcdBarrier& b) {
    asm volatile("s_waitcnt vmcnt(0)" ::: "memory");
    __syncthreads();
    if (threadIdx.x == 0) {
        unsigned* bar = b.bar;
        __builtin_amdgcn_s_waitcnt(0);
        unsigned nloc = b.st[0], nx = b.st[1];
        if (nloc == 0u) { xcd_barrier_complete(bar, b.x, nloc, nx); b.st[0] = nloc; b.st[1] = nx; }
        const unsigned old = xb_add(&bar[XB_XSUB(b.x)], 1u);
        const unsigned gen = old / nloc;
        if (old + 1u == (gen + 1u) * nloc) {
            __builtin_amdgcn_fence(__ATOMIC_RELEASE, "agent");
            asm volatile("s_waitcnt vmcnt(0)" ::: "memory");
            const unsigned og = xb_add(&bar[XB_TOP], 1u);
            const unsigned tg = og / nx;
            if (og + 1u == (tg + 1u) * nx) xb_add(&bar[XB_TOPGEN], 1u);
            else XB_SPIN(xb_ld(&bar[XB_TOPGEN]) == tg, bar);
            __builtin_amdgcn_fence(__ATOMIC_ACQUIRE, "agent");
            xb_add(&bar[XB_XGEN(b.x)], 1u);
            asm volatile("s_waitcnt vmcnt(0)" ::: "memory");
        } else {
            XB_SPIN(xb_ld(&bar[XB_XGEN(b.x)]) == gen, bar);
            __builtin_amdgcn_fence(__ATOMIC_ACQUIRE, "agent");
            asm volatile("s_waitcnt vmcnt(0)" ::: "memory");
        }
    }
    __syncthreads();
}

constexpr int NWAVES = 8;
constexpr int RING_OFF = 0, RING_BYTES = 131072;
constexpr int LDSCTL_OFF = RING_BYTES, MISC_OFF = LDSCTL_OFF + 320;
constexpr int SEG_OFF = LDSCTL_OFF + 1024;
constexpr int TILE_E_OFF = LDSCTL_OFF + 2048;
constexpr int LDS_BYTES = 147456;
static_assert(att::LDS_BYTES <= RING_BYTES && TILE_E_OFF + NTILE_MAX * 4 <= LDS_BYTES, "LDS map");

struct Args { const float* in[19]; float* out; unsigned char* ws; int ph_lo, ph_hi, li, pad; };

struct Ctx {
    LAS unsigned char* lds; int tid, lane, wave, G, gw, NGW;
    const float *x, *attn_g, *w_in, *fbias, *lq1, *lk1, *lq2, *lk2, *subg, *w_out, *ffn_g, *wg, *bg, *we, *be, *wgate, *wup, *wdown, *fin_g;
    float* out;
    bf16* A1; bf16* WIN; bf16* WOUT; float* BIAS; bf16* QKV; bf16* A2; bf16* DT; float* H1;
    int* tok_e; int* tok_pos; float* tok_gate; float* rstd; float* rowgate; float* WR; bf16* XG; bf16* HB; bf16* Y; bf16* WGU; bf16* WD; unsigned* cnt;
};
__device__ __forceinline__ float wave_sum(float v) {
#pragma unroll
    for (int o = 1; o < 64; o <<= 1) v += __shfl_xor(v, o);
    return v;
}
typedef unsigned v2u __attribute__((ext_vector_type(2)));

__device__ __forceinline__ void p0_row(const Ctx& C, int t) {
    const int lane = C.lane; const float* xr = C.x + (size_t)t * DM;
    f32x4 v[8]; float ss = 0.f;
#pragma unroll
    for (int j = 0; j < 8; ++j) { v[j] = *(const f32x4*)(xr + j * 256 + lane * 4); ss += (v[j].x * v[j].x + v[j].y * v[j].y) + (v[j].z * v[j].z + v[j].w * v[j].w); }
    const float r = 1.f / sqrtf(wave_sum(ss) * (1.f / DM) + 1e-6f);
    float fl[8] = {0.f, 0.f, 0.f, 0.f, 0.f, 0.f, 0.f, 0.f};
#pragma unroll
    for (int j = 0; j < 8; ++j) {
        const f32x4 gg = *(const f32x4*)(C.attn_g + j * 256 + lane * 4);
        v[j] = v[j] * r * gg;
        v2u o; o.x = pk2(v[j].x, v[j].y); o.y = pk2(v[j].z, v[j].w);
        *(v2u*)(C.A1 + (size_t)t * DM + j * 256 + lane * 4) = o;
#pragma unroll
        for (int c = 0; c < 4; ++c) { const float a = v[j][c]; const float* wr = C.w_in + (size_t)(j * 256 + lane * 4 + c) * NCOL + FCOL;
            const f32x4 w0 = *(const f32x4*)wr, w1 = *(const f32x4*)(wr + 4);
            fl[0] += a * w0.x; fl[1] += a * w0.y; fl[2] += a * w0.z; fl[3] += a * w0.w; fl[4] += a * w1.x; fl[5] += a * w1.y; fl[6] += a * w1.z; fl[7] += a * w1.w; }
    }
#pragma unroll
    for (int h = 0; h < 8; ++h) fl[h] = wave_sum(fl[h]);
    float z = fl[0];
#pragma unroll
    for (int h = 1; h < 8; ++h) z = (lane == h) ? fl[h] : z;
    if (lane < 8) { z += C.fbias[lane]; const float ls = fminf(z, 0.f) - log1pf(expf(-fabsf(z)));
        C.BIAS[(size_t)((t / S) * 8 + lane) * S + (t % S)] = ls; }
}
__device__ __forceinline__ void tr_item(const float* src, int ld, int k0, int c0, bf16* dst, int K, int r0, LAS float* scr, int lane) {
#pragma unroll 8
    for (int i = 0; i < 32; ++i) { const int kk = 2 * i + (lane >> 5); scr[kk * 33 + (lane & 31)] = src[(size_t)(k0 + kk) * ld + c0 + (lane & 31)]; }
    LDS_WAIT(); asm volatile("" ::: "memory");
    const int c = lane & 7;
#pragma unroll
    for (int j = 0; j < 4; ++j) { const int n = (lane >> 3) + 8 * j; const LAS float* s = scr + (8 * c) * 33 + n;
        v4u o; o.x = pk2(s[0 * 33], s[1 * 33]); o.y = pk2(s[2 * 33], s[3 * 33]); o.z = pk2(s[4 * 33], s[5 * 33]); o.w = pk2(s[6 * 33], s[7 * 33]);
        *(GAS v4u*)(dst + (size_t)(r0 + n) * K + k0 + 8 * c) = o; }
    LDS_WAIT(); asm volatile("" ::: "memory");
}
__device__ __forceinline__ void p0_prologue(const Ctx& C) {
    LAS float* scr = (LAS float*)(C.lds + RING_OFF + C.wave * 16384);
    constexpr int I_WIN = 32 * 192, I_WOUT = 32 * 64, I_GU = NE * 2 * 32 * 32, I_D = NE * 16 * 64, I_ALL = I_WIN + I_WOUT + I_GU + I_D;
    for (int it = C.gw; it < I_ALL; it += C.NGW) {
        int r = it;
        if (r < I_WIN) { const int kb = r / 192, nb = r % 192; tr_item(C.w_in, NCOL, 64 * kb, nb < 96 ? 32 * nb : 32 * nb + 8, C.WIN, DM, 32 * nb, scr, C.lane); continue; } r -= I_WIN;
        if (r < I_WOUT) { const int kb = r / 64, nb = r % 64; tr_item(C.w_out, DM, 64 * kb, 32 * nb, C.WOUT, DM, 32 * nb, scr, C.lane); continue; } r -= I_WOUT;
        if (r < I_GU) { const int e = r >> 11, up = (r >> 10) & 1, kb = (r >> 5) & 31, nb = r & 31;
            tr_item((up ? C.wup : C.wgate) + (size_t)e * DM * DFF, DFF, 64 * kb, 32 * nb, C.WGU + (size_t)e * 2048 * DM, DM, 256 * (nb >> 2) + 128 * up + 32 * (nb & 3), scr, C.lane); continue; } r -= I_GU;
        { const int e = r >> 10, kb = (r >> 6) & 15, nb = r & 63; tr_item(C.wdown + (size_t)e * DFF * DM, DM, 64 * kb, 32 * nb, C.WD + (size_t)e * DM * DFF, DFF, 32 * nb, scr, C.lane); }
    }
    for (int t = C.gw; t < M; t += C.NGW) p0_row(C, t);
    const int gt = C.gw * 64 + C.lane, NGT = C.NGW * 64;
    for (int i = gt; i < 4 * S; i += NGT) { const int h = i / S, s = i % S; C.BIAS[(size_t)(16 + h) * S + s] = -exp2f(-2.f * (float)(h + 1)) * (float)s * ATT_ISCALE; }
    for (int i = gt; i < 128 * 4 * 5 * 64; i += NGT) { const int ln = i & 63, blk = (i >> 6) % 5, sj = (i >> 6) / 5, k = 16 * (sj >> 2) + 4 * (ln >> 4) + (sj & 3), c = 16 * blk + (ln & 15);
        const float w = c < 8 ? C.wg[(size_t)k * 8 + c] : (c < 72 ? C.we[(size_t)k * NE + c - 8] : 0.f); C.WR[i] = w * C.ffn_g[k]; }
}
__device__ __forceinline__ void p1_cumsum(const Ctx& C) {
    if (blockIdx.x >= 16) return;
    float* p = C.BIAS + (size_t)blockIdx.x * S + C.tid * 16; LAS float* wt = (LAS float*)(C.lds + RING_OFF);
    float loc[16]; float s = 0.f;
    { const f32x4 a = *(const f32x4*)p, b = *(const f32x4*)(p + 4), c = *(const f32x4*)(p + 8), d = *(const f32x4*)(p + 12);
      loc[0] = a.x; loc[1] = a.y; loc[2] = a.z; loc[3] = a.w; loc[4] = b.x; loc[5] = b.y; loc[6] = b.z; loc[7] = b.w; loc[8] = c.x; loc[9] = c.y; loc[10] = c.z; loc[11] = c.w; loc[12] = d.x; loc[13] = d.y; loc[14] = d.z; loc[15] = d.w; }
#pragma unroll
    for (int i = 0; i < 16; ++i) { s += loc[i]; loc[i] = s; }
    float inc = s;
#pragma unroll
    for (int o = 1; o < 64; o <<= 1) { const float q = __shfl_up(inc, o); if (C.lane >= o) inc += q; }
    if (C.lane == 63) wt[C.wave] = inc;
    __syncthreads();
    float base = inc - s;
    for (int w = 0; w < C.wave; ++w) base += wt[w];
#pragma unroll
    for (int i = 0; i < 16; ++i) loc[i] = (base + loc[i]) * ATT_ISCALE;
    *(f32x4*)p = (f32x4){loc[0], loc[1], loc[2], loc[3]}; *(f32x4*)(p + 4) = (f32x4){loc[4], loc[5], loc[6], loc[7]};
    *(f32x4*)(p + 8) = (f32x4){loc[8], loc[9], loc[10], loc[11]}; *(f32x4*)(p + 12) = (f32x4){loc[12], loc[13], loc[14], loc[15]};
    __syncthreads();
}
__device__ __forceinline__ void p3_combine(const Ctx& C) {
    const int lane = C.lane;
    const float s1 = wave_sum(C.lq1[lane] * C.lk1[lane] + C.lq1[lane + 64] * C.lk1[lane + 64]);
    const float s2 = wave_sum(C.lq2[lane] * C.lk2[lane] + C.lq2[lane + 64] * C.lk2[lane + 64]);
    const float lam = expf(s1) - expf(s2) + 0.2f;
    const f32x4 gg = *(const f32x4*)(C.subg + lane * 4);
    for (int idx = C.gw; idx < M * 4; idx += C.NGW) {
        const int t = idx >> 2, h = idx & 3;
        const bf16* p = C.DT + (size_t)t * DM + h * 512 + lane * 4;
        const v2u a = *(const v2u*)p, b = *(const v2u*)(p + 256);
        f32x4 d;
        d.x = __uint_as_float(a.x << 16) - lam * __uint_as_float(b.x << 16); d.y = __uint_as_float(a.x & 0xffff0000u) - lam * __uint_as_float(b.x & 0xffff0000u);
        d.z = __uint_as_float(a.y << 16) - lam * __uint_as_float(b.y << 16); d.w = __uint_as_float(a.y & 0xffff0000u) - lam * __uint_as_float(b.y & 0xffff0000u);
        const float ss = wave_sum((d.x * d.x + d.y * d.y) + (d.z * d.z + d.w * d.w));
        const float r = 0.8f / sqrtf(ss * (1.f / 256.f) + 1e-5f);
        v2u o; o.x = pk2(d.x * r * gg.x, d.y * r * gg.y); o.y = pk2(d.z * r * gg.z, d.w * r * gg.w);
        *(v2u*)(C.A2 + (size_t)t * DM + 1024 + h * 256 + lane * 4) = o;
    }
}
__device__ __forceinline__ void p5a_router(const Ctx& C) {
    const int lane = C.lane, r = lane & 15, g = lane >> 4;
    LAS float* lg = (LAS float*)(C.lds + RING_OFF + C.wave * 8192);
    for (int tl = C.wave * C.G + (int)blockIdx.x; tl < M / 16; tl += NWAVES * C.G) {
        const int t0 = tl * 16;
        f32x4 acc[5];
#pragma unroll
        for (int b = 0; b < 5; ++b) acc[b] = (f32x4){0.f, 0.f, 0.f, 0.f};
        float ss = 0.f;
        const float* hp = C.H1 + (size_t)(t0 + r) * DM + 4 * g; const float* wp = C.WR + lane;
#pragma unroll 2
        for (int s = 0; s < 128; ++s) {
            const f32x4 a = *(const f32x4*)(hp + 16 * s);
            ss += (a.x * a.x + a.y * a.y) + (a.z * a.z + a.w * a.w);
#pragma unroll
            for (int j = 0; j < 4; ++j)
#pragma unroll
                for (int b = 0; b < 5; ++b) acc[b] = __builtin_amdgcn_mfma_f32_16x16x4f32(a[j], wp[((s * 4 + j) * 5 + b) * 64], acc[b], 0, 0, 0);
        }
        ss += __shfl_xor(ss, 16); ss += __shfl_xor(ss, 32);
        const float rs = 1.f / sqrtf(ss * (1.f / DM) + 1e-6f);
#pragma unroll
        for (int i = 0; i < 4; ++i) { const float rsi = __shfl(rs, 4 * g + i);
#pragma unroll
            for (int b = 0; b < 5; ++b) lg[(4 * g + i) * 81 + 16 * b + r] = acc[b][i] * rsi; }
        LDS_WAIT(); asm volatile("" ::: "memory");
        if (lane < 16) {
            const int t = t0 + lane; const LAS float* row = lg + lane * 81;
            float gmax = -__builtin_inff(); int gi = 0; float gl[8];
#pragma unroll
            for (int j = 0; j < 8; ++j) { gl[j] = row[j] + C.bg[j]; if (gl[j] > gmax) { gmax = gl[j]; gi = j; } }
            float gs = 0.f;
#pragma unroll
            for (int j = 0; j < 8; ++j) gs += expf(gl[j] - gmax);
            const float gprob = 1.f / gs;
            float l1 = -__builtin_inff(), l2 = -__builtin_inff(); int i1 = 0, i2 = 0;
#pragma unroll
            for (int j = 0; j < 8; ++j) { const float q = row[8 + gi * 8 + j] + C.be[gi * 8 + j];
                if (q > l1) { l2 = l1; i2 = i1; l1 = q; i1 = j; } else if (q > l2) { l2 = q; i2 = j; } }
            const float e2 = expf(l2 - l1), g1 = gprob / (1.f + e2), g2 = gprob * e2 / (1.f + e2);
            const int ea = gi * 8 + i1, eb = gi * 8 + i2;
            const unsigned pa = atomicAdd(C.cnt + ea, 1u), pb = atomicAdd(C.cnt + eb, 1u);
            C.tok_e[t * 2] = ea; C.tok_e[t * 2 + 1] = eb; C.tok_pos[t * 2] = (int)pa; C.tok_pos[t * 2 + 1] = (int)pb; C.tok_gate[t * 2] = g1; C.tok_gate[t * 2 + 1] = g2;
            C.rstd[t] = rs;
        }
        LDS_WAIT(); asm volatile("" ::: "memory");
    }
}
__device__ __forceinline__ void build_seg(const Ctx& C) {
    LAS int* seg = (LAS int*)(C.lds + SEG_OFF); LAS int* tile_e = (LAS int*)(C.lds + TILE_E_OFF);
    if (C.tid == 0) { int o = 0; for (int e = 0; e < NE; ++e) { seg[e] = o; o += (int)((C.cnt[e] + 255u) & ~255u); } seg[NE] = o; }
    __syncthreads();
    if (C.tid < NTILE_MAX) { const int row = C.tid * 256; int e = 0; for (int j = 1; j < NE; ++j) if (seg[j] <= row) e = j; tile_e[C.tid] = e; }
    __syncthreads();
}
__device__ __forceinline__ void p5b_dispatch(const Ctx& C) {
    const LAS int* seg = (const LAS int*)(C.lds + SEG_OFF); const int lane = C.lane;
    for (int t = C.gw; t < M; t += C.NGW) {
        const float* xr = C.H1 + (size_t)t * DM; const float rs = C.rstd[t];
        const int ra = seg[C.tok_e[t * 2]] + C.tok_pos[t * 2], rb = seg[C.tok_e[t * 2 + 1]] + C.tok_pos[t * 2 + 1];
#pragma unroll
        for (int j = 0; j < 8; ++j) { const f32x4 v = *(const f32x4*)(xr + j * 256 + lane * 4) * rs * *(const f32x4*)(C.ffn_g + j * 256 + lane * 4);
            v2u o; o.x = pk2(v.x, v.y); o.y = pk2(v.z, v.w);
            *(v2u*)(C.XG + (size_t)ra * DM + j * 256 + lane * 4) = o; *(v2u*)(C.XG + (size_t)rb * DM + j * 256 + lane * 4) = o; }
        if (lane == 0) { C.rowgate[ra] = C.tok_gate[t * 2]; C.rowgate[rb] = C.tok_gate[t * 2 + 1]; }
    }
}
__device__ __forceinline__ void p8_final(const Ctx& C) {
    const LAS int* seg = (const LAS int*)(C.lds + SEG_OFF); const int lane = C.lane;
    for (int t = C.gw; t < M; t += C.NGW) {
        const int ra = seg[C.tok_e[t * 2]] + C.tok_pos[t * 2], rb = seg[C.tok_e[t * 2 + 1]] + C.tok_pos[t * 2 + 1];
        const float* xr = C.H1 + (size_t)t * DM; const bf16* ya = C.Y + (size_t)ra * DM; const bf16* yb = C.Y + (size_t)rb * DM;
        f32x4 v[8]; float ss = 0.f;
#pragma unroll
        for (int j = 0; j < 8; ++j) { v[j] = *(const f32x4*)(xr + j * 256 + lane * 4); const v2u a = *(const v2u*)(ya + j * 256 + lane * 4), b = *(const v2u*)(yb + j * 256 + lane * 4);
            v[j].x += __uint_as_float(a.x << 16) + __uint_as_float(b.x << 16); v[j].y += __uint_as_float(a.x & 0xffff0000u) + __uint_as_float(b.x & 0xffff0000u);
            v[j].z += __uint_as_float(a.y << 16) + __uint_as_float(b.y << 16); v[j].w += __uint_as_float(a.y & 0xffff0000u) + __uint_as_float(b.y & 0xffff0000u);
            ss += (v[j].x * v[j].x + v[j].y * v[j].y) + (v[j].z * v[j].z + v[j].w * v[j].w); }
        const float r = 1.f / sqrtf(wave_sum(ss) * (1.f / DM) + 1e-6f);
#pragma unroll
        for (int j = 0; j < 8; ++j) *(f32x4*)(C.out + (size_t)t * DM + j * 256 + lane * 4) = v[j] * r * *(const f32x4*)(C.fin_g + j * 256 + lane * 4);
    }
}

__global__ void __launch_bounds__(NWAVES * 64, 2) mk_fwd(Args args) {
    extern __shared__ __attribute__((aligned(16))) unsigned char lds[];
    Ctx C;
    C.lds = (LAS unsigned char*)lds; C.tid = threadIdx.x; C.lane = C.tid & 63; C.wave = __builtin_amdgcn_readfirstlane(C.tid >> 6);
    C.G = gridDim.x; C.gw = (int)blockIdx.x * NWAVES + C.wave; C.NGW = C.G * NWAVES;
    C.x = args.in[0]; C.attn_g = args.in[1]; C.w_in = args.in[2]; C.fbias = args.in[3]; C.lq1 = args.in[4]; C.lk1 = args.in[5]; C.lq2 = args.in[6]; C.lk2 = args.in[7];
    C.subg = args.in[8]; C.w_out = args.in[9]; C.ffn_g = args.in[10]; C.wg = args.in[11]; C.bg = args.in[12]; C.we = args.in[13]; C.be = args.in[14];
    C.wgate = args.in[15]; C.wup = args.in[16]; C.wdown = args.in[17]; C.fin_g = args.in[18]; C.out = args.out;
    unsigned char* ws = args.ws;
    C.A1 = (bf16*)(ws + WS_A1); C.WIN = (bf16*)(ws + WS_WIN); C.WOUT = (bf16*)(ws + WS_WOUT); C.BIAS = (float*)(ws + WS_BIAS); C.QKV = (bf16*)(ws + WS_QKV);
    C.A2 = (bf16*)(ws + WS_A2); C.DT = (bf16*)(ws + WS_DT); C.H1 = (float*)(ws + WS_H1);
    C.tok_e = (int*)(ws + WS_ROUTE); C.tok_pos = C.tok_e + 2 * M; C.tok_gate = (float*)(C.tok_pos + 2 * M); C.rstd = C.tok_gate + 2 * M; C.rowgate = C.rstd + M;
    C.WR = (float*)(ws + WS_WR); C.XG = (bf16*)(ws + WS_XG); C.HB = (bf16*)(ws + WS_HBUF); C.Y = (bf16*)(ws + WS_Y); C.WGU = (bf16*)(ws + WS_WGU); C.WD = (bf16*)(ws + WS_WD);
    C.cnt = (unsigned*)(ws + WS_CTL) + CW_CNT;
    volatile LAS unsigned* MISC = (volatile LAS unsigned*)(C.lds + MISC_OFF);
    for (int u = C.tid; u < (LDS_BYTES - LDSCTL_OFF) / 4; u += NWAVES * 64) ((LAS unsigned*)(C.lds + LDSCTL_OFF))[u] = 0u;
    __syncthreads();
    XcdBarrier bar = xcd_barrier_post((unsigned*)(ws + WS_CTL) + CW_BAR + args.li * XCD_BAR_WORDS, MISC + 8);
    const int lo = args.ph_lo, hi = args.ph_hi;
#define IN(k) (lo <= (k) && (k) < hi)
#define SEAM(k) do { if (IN(k) && IN((k) + 1)) xcd_barrier(bar); } while (0)

    if (IN(0)) { p0_prologue(C); } SEAM(0);
    if (IN(1)) {
        p1_cumsum(C);
        pg8::Gemm g{C.A1, C.WIN, M, NQKV, DM}; pg8::StaticOrder So; So.init(M, NQKV, C.G, (int)blockIdx.x);
        pg8::EpiBf16<0> E{C.QKV, NQKV, nullptr, 0, 0, 1.f};
        pg8::gemm_phase<pg8::EpiBf16<0>, pg8::StaticOrder, true, true>(C.lds + RING_OFF, g, So, E);
    } SEAM(1);
    if (IN(2)) { const att::Tensors T{(const att::bf16*)C.QKV, (att::bf16*)C.A2, (att::bf16*)C.DT, C.BIAS}; att::attn_phase((char*)lds + RING_OFF, T); } SEAM(2);
    if (IN(3)) { p3_combine(C); } SEAM(3);
    if (IN(4)) {
        pg8::Gemm g{C.A2, C.WOUT, M, DM, DM}; pg8::StaticOrder So; So.init(M, DM, C.G, (int)blockIdx.x);
        pg8::EpiResF32 E{C.x, C.H1, DM};
        pg8::gemm_phase<pg8::EpiResF32, pg8::StaticOrder, true, true>(C.lds + RING_OFF, g, So, E);
    } SEAM(4);
    if (IN(5)) { p5a_router(C); } SEAM(5);
    if (hi > 6) build_seg(C);
    if (IN(6)) { p5b_dispatch(C); } SEAM(6);
    if (IN(7)) {
        const PG8_LAS int* tile_e = (const PG8_LAS int*)(C.lds + TILE_E_OFF); const int ntile = ((const LAS int*)(C.lds + SEG_OFF))[NE] >> 8;
        pg8::Gemm g{C.XG, C.WGU, YROWS, 2048, DM}; pg8::GroupedOrder So{ntile * 8, C.G, (int)blockIdx.x, tile_e};
        pg8::EpiSwiglu E{C.HB};
        pg8::gemm_phase<pg8::EpiSwiglu, pg8::GroupedOrder, true, true>(C.lds + RING_OFF, g, So, E);
    } SEAM(7);
    if (IN(8)) {
        const PG8_LAS int* tile_e = (const PG8_LAS int*)(C.lds + TILE_E_OFF); const int ntile = ((const LAS int*)(C.lds + SEG_OFF))[NE] >> 8;
        pg8::Gemm g{C.HB, C.WD, YROWS, 2048, DFF}; pg8::GroupedOrder So{ntile * 8, C.G, (int)blockIdx.x, tile_e};
        pg8::EpiDown E{C.Y, C.rowgate};
        pg8::gemm_phase<pg8::EpiDown, pg8::GroupedOrder, true, true>(C.lds + RING_OFF, g, So, E);
    } SEAM(8);
    if (IN(9)) { p8_final(C); }
#undef IN
#undef SEAM
}

#if NAIVE_MASK
namespace nv {
__device__ __forceinline__ float bf2f(bf16_t v) { return __uint_as_float((unsigned)v << 16); }
__device__ __forceinline__ bf16_t f2b(float f) { return (bf16_t)f2bf(f); }
__global__ void __launch_bounds__(256) k_cumsum(float* __restrict__ bias) {
    __shared__ float part[256];
    float* p = bias + (size_t)blockIdx.x * S; const int tid = threadIdx.x;
    float loc[32]; float s = 0.f;
#pragma unroll
    for (int i = 0; i < 32; ++i) { s += p[tid * 32 + i]; loc[i] = s; }
    part[tid] = s; __syncthreads();
    if (tid == 0) { float a = 0.f; for (int i = 0; i < 256; ++i) { const float q = part[i]; part[i] = a; a += q; } }
    __syncthreads();
    const float base = part[tid];
#pragma unroll
    for (int i = 0; i < 32; ++i) p[tid * 32 + i] = (base + loc[i]) * ATT_ISCALE;
}
template <class FA, class FB>
__device__ __forceinline__ void ngemm_tile(int K, FA fa, FB fb, float (&acc)[4][4], float (*As)[65], float (*Bs)[65]) {
    const int tid = threadIdx.x, tx = tid & 15, ty = tid >> 4;
#pragma unroll
    for (int r = 0; r < 4; ++r)
#pragma unroll
        for (int c = 0; c < 4; ++c) acc[r][c] = 0.f;
    for (int k0 = 0; k0 < K; k0 += 16) {
        for (int e = tid; e < 1024; e += 256) { const int i = e >> 4, kk = e & 15; As[kk][i] = fa(i, k0 + kk); Bs[kk][i] = fb(k0 + kk, i); }
        __syncthreads();
#pragma unroll
        for (int kk = 0; kk < 16; ++kk) { float a[4], b[4];
#pragma unroll
            for (int r = 0; r < 4; ++r) a[r] = As[kk][ty * 4 + r];
#pragma unroll
            for (int c = 0; c < 4; ++c) b[c] = Bs[kk][tx * 4 + c];
#pragma unroll
            for (int r = 0; r < 4; ++r)
#pragma unroll
                for (int c = 0; c < 4; ++c) acc[r][c] += a[r] * b[c]; }
        __syncthreads();
    }
}
__global__ void __launch_bounds__(256) k_inproj(const bf16_t* __restrict__ A, const bf16_t* __restrict__ Bt, bf16_t* __restrict__ Cq) {
    __shared__ float As[16][65], Bs[16][65];
    const int m0 = blockIdx.y * 64, n0 = blockIdx.x * 64; float acc[4][4];
    ngemm_tile(DM, [&](int i, int k) { return bf2f(A[(size_t)(m0 + i) * DM + k]); }, [&](int k, int j) { return bf2f(Bt[(size_t)(n0 + j) * DM + k]); }, acc, As, Bs);
    const int tx = threadIdx.x & 15, ty = threadIdx.x >> 4;
#pragma unroll
    for (int r = 0; r < 4; ++r)
#pragma unroll
        for (int c = 0; c < 4; ++c) Cq[(size_t)(m0 + ty * 4 + r) * NQKV + n0 + tx * 4 + c] = f2b(acc[r][c]);
}
__global__ void __launch_bounds__(256) k_outproj(const bf16_t* __restrict__ A, const bf16_t* __restrict__ Bt, const float* __restrict__ x, float* __restrict__ H1) {
    __shared__ float As[16][65], Bs[16][65];
    const int m0 = blockIdx.y * 64, n0 = blockIdx.x * 64; float acc[4][4];
    ngemm_tile(DM, [&](int i, int k) { return bf2f(A[(size_t)(m0 + i) * DM + k]); }, [&](int k, int j) { return bf2f(Bt[(size_t)(n0 + j) * DM + k]); }, acc, As, Bs);
    const int tx = threadIdx.x & 15, ty = threadIdx.x >> 4;
#pragma unroll
    for (int r = 0; r < 4; ++r)
#pragma unroll
        for (int c = 0; c < 4; ++c) { const size_t o = (size_t)(m0 + ty * 4 + r) * DM + n0 + tx * 4 + c; H1[o] = x[o] + acc[r][c]; }
}
__global__ void __launch_bounds__(256) k_attn(const bf16_t* __restrict__ QKV, const float* __restrict__ bias, bf16_t* __restrict__ A2, bf16_t* __restrict__ DT) {
    __shared__ bf16_t Qs[64][130];
    __shared__ float Ks[32][129];
    __shared__ float Vs[32][128];
    __shared__ float Ps[64][33];
    const int tid = threadIdx.x, r = tid >> 2, c4 = tid & 3;
    const int qb = (int)gridDim.x - 1 - (int)blockIdx.x, p = blockIdx.y;
    int b, qcol, kcol, vcol, h, map = 0, vh = 0; const float* cc; const bool fox = p < 16;
    if (fox) { b = p >> 3; h = p & 7; qcol = C_FQ + h * 128; kcol = C_FK + h * 128; vcol = C_FV + h * 128; cc = bias + ((size_t)b * 8 + h) * S; }
    else { const int q = p - 16; b = q >> 4; h = (q >> 2) & 3; map = (q >> 1) & 1; vh = q & 1; qcol = C_DQ + h * 256 + map * 128; kcol = C_DK + h * 256 + map * 128; vcol = C_DV + h * 256 + vh * 128; cc = bias + (size_t)(16 + h) * S; }
    const int q0 = qb * 64; const size_t rowb = (size_t)b * S;
    for (int e = tid; e < 64 * 128; e += 256) { const int i = e >> 7, d = e & 127; Qs[i][d] = QKV[(rowb + q0 + i) * NQKV + qcol + d]; }
    const int t = q0 + r; const float ct = cc[t];
    float m = -1e30f, l = 0.f; float o[32];
#pragma unroll
    for (int j = 0; j < 32; ++j) o[j] = 0.f;
    const int nkt = (q0 + 63) / 32 + 1;
    for (int kt = 0; kt < nkt; ++kt) {
        const int k0 = kt * 32;
        __syncthreads();
        for (int e = tid; e < 32 * 128; e += 256) { const int i = e >> 7, d = e & 127; const size_t ro = (rowb + k0 + i) * NQKV; Ks[i][d] = bf2f(QKV[ro + kcol + d]); Vs[i][d] = bf2f(QKV[ro + vcol + d]); }
        __syncthreads();
        float sc[8];
#pragma unroll
        for (int j = 0; j < 8; ++j) sc[j] = 0.f;
        for (int d = 0; d < 128; ++d) { const float qv = bf2f(Qs[r][d]);
#pragma unroll
            for (int j = 0; j < 8; ++j) sc[j] += qv * Ks[c4 * 8 + j][d]; }
        float tmax = -__builtin_inff();
#pragma unroll
        for (int j = 0; j < 8; ++j) { const int s = k0 + c4 * 8 + j; float v = (sc[j] + (ct - cc[s])) * ATT_SCALE;
            if (s > t) v = -__builtin_inff();
            sc[j] = v; tmax = fmaxf(tmax, v); }
        tmax = fmaxf(tmax, __shfl_xor(tmax, 1)); tmax = fmaxf(tmax, __shfl_xor(tmax, 2));
        const float mn = fmaxf(m, tmax), alpha = __expf(m - mn); m = mn;
        float ps = 0.f;
#pragma unroll
        for (int j = 0; j < 8; ++j) { const float pv = __expf(sc[j] - mn); ps += pv; Ps[r][c4 * 8 + j] = pv; }
        ps += __shfl_xor(ps, 1); ps += __shfl_xor(ps, 2);
        l = l * alpha + ps;
        __syncthreads();
#pragma unroll
        for (int j = 0; j < 32; ++j) o[j] *= alpha;
        for (int kk = 0; kk < 32; ++kk) { const float pv = Ps[r][kk];
#pragma unroll
            for (int j = 0; j < 32; ++j) o[j] += pv * Vs[kk][c4 + 4 * j]; }
    }
    const float il = 1.f / l;
    bf16_t* op = fox ? A2 + (rowb + t) * DM + h * 128 : DT + (rowb + t) * DM + h * 512 + map * 256 + vh * 128;
#pragma unroll
    for (int j = 0; j < 32; ++j) op[c4 + 4 * j] = f2b(o[j] * il);
}
__global__ void __launch_bounds__(256) k_diff_combine(const bf16_t* __restrict__ DT, const float* __restrict__ lq1, const float* __restrict__ lk1, const float* __restrict__ lq2,
                                                      const float* __restrict__ lk2, const float* __restrict__ sg, bf16_t* __restrict__ A2) {
    const int lane = threadIdx.x & 63, wv = threadIdx.x >> 6;
    const int idx = blockIdx.x * 4 + wv, t = idx >> 2, h = idx & 3;
    const float s1 = wave_sum(lq1[lane] * lk1[lane] + lq1[lane + 64] * lk1[lane + 64]);
    const float s2 = wave_sum(lq2[lane] * lk2[lane] + lq2[lane + 64] * lk2[lane + 64]);
    const float lam = expf(s1) - expf(s2) + 0.2f;
    const bf16_t* p = DT + (size_t)t * DM + h * 512;
    float d[4]; float ss = 0.f;
#pragma unroll
    for (int c = 0; c < 4; ++c) { d[c] = bf2f(p[lane * 4 + c]) - lam * bf2f(p[256 + lane * 4 + c]); ss += d[c] * d[c]; }
    ss = wave_sum(ss);
    const float r = rsqrtf(ss * (1.f / 256.f) + 1e-5f) * 0.8f;
    bf16_t* o = A2 + (size_t)t * DM + 1024 + h * 256 + lane * 4;
#pragma unroll
    for (int c = 0; c < 4; ++c) o[c] = f2b(d[c] * r * sg[lane * 4 + c]);
}
__global__ void __launch_bounds__(256) k_route(const float* __restrict__ H1, const float* __restrict__ g, const float* __restrict__ wg, const float* __restrict__ bg,
                                               const float* __restrict__ we, const float* __restrict__ be, int* __restrict__ tok_e, int* __restrict__ tok_pos,
                                               float* __restrict__ tok_gate, float* __restrict__ rstd, unsigned* __restrict__ cnt) {
    __shared__ float xs[4][DM];
    const int lane = threadIdx.x & 63, wv = threadIdx.x >> 6;
    const int t = blockIdx.x * 4 + wv;
    const float* xr = H1 + (size_t)t * DM;
    f32x4 v[8]; float ss = 0.f;
#pragma unroll
    for (int j = 0; j < 8; ++j) { v[j] = *(const f32x4*)(xr + j * 256 + lane * 4); ss += v[j].x * v[j].x + v[j].y * v[j].y + v[j].z * v[j].z + v[j].w * v[j].w; }
    ss = wave_sum(ss);
    const float r = 1.f / sqrtf(ss * (1.f / DM) + 1e-6f);
#pragma unroll
    for (int j = 0; j < 8; ++j) { const f32x4 gg = *(const f32x4*)(g + j * 256 + lane * 4); *(f32x4*)(&xs[wv][j * 256 + lane * 4]) = v[j] * r * gg; }
    __syncthreads();
    float el = 0.f;
    for (int k = 0; k < DM; ++k) el += xs[wv][k] * we[(size_t)k * NE + lane];
    el += be[lane];
    float gl = 0.f;
    for (int k = (lane >> 3); k < DM; k += 8) gl += xs[wv][k] * wg[(size_t)k * 8 + (lane & 7)];
    gl += __shfl_xor(gl, 8); gl += __shfl_xor(gl, 16); gl += __shfl_xor(gl, 32);
    gl += bg[lane & 7];
    float gmax = -__builtin_inff(); int gi = 0;
#pragma unroll
    for (int j = 0; j < 8; ++j) { const float q = __shfl(gl, j); if (q > gmax) { gmax = q; gi = j; } }
    float gs = 0.f;
#pragma unroll
    for (int j = 0; j < 8; ++j) gs += expf(__shfl(gl, j) - gmax);
    const float gprob = 1.f / gs;
    float l1 = -__builtin_inff(), l2 = -__builtin_inff(); int i1 = 0, i2 = 0;
#pragma unroll
    for (int j = 0; j < 8; ++j) { const float q = __shfl(el, gi * 8 + j);
        if (q > l1) { l2 = l1; i2 = i1; l1 = q; i1 = j; } else if (q > l2) { l2 = q; i2 = j; } }
    const float e2 = expf(l2 - l1), g1 = gprob / (1.f + e2), g2 = gprob * e2 / (1.f + e2);
    if (lane == 0) {
        const int ea = gi * 8 + i1, eb = gi * 8 + i2;
        const unsigned pa = atomicAdd(cnt + ea, 1u), pb = atomicAdd(cnt + eb, 1u);
        tok_e[t * 2] = ea; tok_e[t * 2 + 1] = eb; tok_pos[t * 2] = (int)pa; tok_pos[t * 2 + 1] = (int)pb; tok_gate[t * 2] = g1; tok_gate[t * 2 + 1] = g2; rstd[t] = r;
    }
}
__device__ __forceinline__ int seg_off(const unsigned* cnt, int e) { int o = 0; for (int i = 0; i < e; ++i) o += (int)((cnt[i] + 255u) & ~255u); return o; }
__global__ void __launch_bounds__(256) k_dispatch(const float* __restrict__ H1, const float* __restrict__ g, const float* __restrict__ rstd, const int* __restrict__ tok_e,
                                                  const int* __restrict__ tok_pos, const float* __restrict__ tok_gate, const unsigned* __restrict__ cnt, bf16_t* __restrict__ XG, float* __restrict__ rowgate) {
    const int lane = threadIdx.x & 63, wv = threadIdx.x >> 6; const int t = blockIdx.x * 4 + wv;
    const int ra = seg_off(cnt, tok_e[t * 2]) + tok_pos[t * 2], rb = seg_off(cnt, tok_e[t * 2 + 1]) + tok_pos[t * 2 + 1];
    const float rs = rstd[t];
    for (int k = lane; k < DM; k += 64) { const bf16_t v = f2b(H1[(size_t)t * DM + k] * rs * g[k]); XG[(size_t)ra * DM + k] = v; XG[(size_t)rb * DM + k] = v; }
    if (lane == 0) { rowgate[ra] = tok_gate[t * 2]; rowgate[rb] = tok_gate[t * 2 + 1]; }
}
__global__ void __launch_bounds__(256) k_moe_up(const bf16_t* __restrict__ XG, const bf16_t* __restrict__ WGU, const unsigned* __restrict__ cnt, bf16_t* __restrict__ HB) {
    __shared__ float As[16][65], Bs[16][65];
    const int m0 = blockIdx.y * 64, n0 = blockIdx.x * 64;
    int e = 0, tot = 0; { int o = 0; for (int i = 0; i < NE; ++i) { if (o <= m0) e = i; o += (int)((cnt[i] + 255u) & ~255u); } tot = o; }
    if (m0 >= tot) return;
    const bf16_t* W = WGU + (size_t)e * 2048 * DM; const int rg = 256 * (n0 >> 7) + (n0 & 127), ru = rg + 128;
    float ag[4][4], au[4][4];
    ngemm_tile(DM, [&](int i, int k) { return bf2f(XG[(size_t)(m0 + i) * DM + k]); }, [&](int k, int j) { return bf2f(W[(size_t)(rg + j) * DM + k]); }, ag, As, Bs);
    ngemm_tile(DM, [&](int i, int k) { return bf2f(XG[(size_t)(m0 + i) * DM + k]); }, [&](int k, int j) { return bf2f(W[(size_t)(ru + j) * DM + k]); }, au, As, Bs);
    const int tx = threadIdx.x & 15, ty = threadIdx.x >> 4;
#pragma unroll
    for (int r = 0; r < 4; ++r)
#pragma unroll
        for (int c = 0; c < 4; ++c) { const float gv = ag[r][c]; HB[(size_t)(m0 + ty * 4 + r) * DFF + n0 + tx * 4 + c] = f2b(gv / (1.f + expf(-gv)) * au[r][c]); }
}
__global__ void __launch_bounds__(256) k_moe_down(const bf16_t* __restrict__ HB, const bf16_t* __restrict__ WD, const unsigned* __restrict__ cnt, const float* __restrict__ rowgate, bf16_t* __restrict__ Y) {
    __shared__ float As[16][65], Bs[16][65];
    const int m0 = blockIdx.y * 64, n0 = blockIdx.x * 64;
    int e = 0, tot = 0; { int o = 0; for (int i = 0; i < NE; ++i) { if (o <= m0) e = i; o += (int)((cnt[i] + 255u) & ~255u); } tot = o; }
    if (m0 >= tot) return;
    const bf16_t* W = WD + (size_t)e * DM * DFF; float acc[4][4];
    ngemm_tile(DFF, [&](int i, int k) { return bf2f(HB[(size_t)(m0 + i) * DFF + k]); }, [&](int k, int j) { return bf2f(W[(size_t)(n0 + j) * DFF + k]); }, acc, As, Bs);
    const int tx = threadIdx.x & 15, ty = threadIdx.x >> 4;
#pragma unroll
    for (int r = 0; r < 4; ++r) { const int row = m0 + ty * 4 + r; const float gt = rowgate[row];
#pragma unroll
        for (int c = 0; c < 4; ++c) Y[(size_t)row * DM + n0 + tx * 4 + c] = f2b(acc[r][c] * gt); }
}
__global__ void __launch_bounds__(256) k_final(const float* __restrict__ H1, const bf16_t* __restrict__ Y, const unsigned* __restrict__ cnt, const int* __restrict__ tok_e,
                                               const int* __restrict__ tok_pos, const float* __restrict__ g, float* __restrict__ out) {
    const int lane = threadIdx.x & 63, wv = threadIdx.x >> 6; const int t = blockIdx.x * 4 + wv;
    const int ra = seg_off(cnt, tok_e[t * 2]) + tok_pos[t * 2], rb = seg_off(cnt, tok_e[t * 2 + 1]) + tok_pos[t * 2 + 1];
    float v[32]; float ss = 0.f;
#pragma unroll
    for (int i = 0; i < 32; ++i) { const int k = lane + 64 * i; v[i] = H1[(size_t)t * DM + k] + bf2f(Y[(size_t)ra * DM + k]) + bf2f(Y[(size_t)rb * DM + k]); ss += v[i] * v[i]; }
    ss = wave_sum(ss);
    const float r = 1.f / sqrtf(ss * (1.f / DM) + 1e-6f);
#pragma unroll
    for (int i = 0; i < 32; ++i) { const int k = lane + 64 * i; out[(size_t)t * DM + k] = v[i] * r * g[k]; }
}
}
static void naive_phase(int k, const Args& a, hipStream_t stream) {
    unsigned char* ws = a.ws;
    bf16_t* A1 = (bf16_t*)(ws + WS_A1); bf16_t* WIN = (bf16_t*)(ws + WS_WIN); bf16_t* WOUT = (bf16_t*)(ws + WS_WOUT); float* BIAS = (float*)(ws + WS_BIAS); bf16_t* QKV = (bf16_t*)(ws + WS_QKV);
    bf16_t* A2 = (bf16_t*)(ws + WS_A2); bf16_t* DT = (bf16_t*)(ws + WS_DT); float* H1 = (float*)(ws + WS_H1);
    int* tok_e = (int*)(ws + WS_ROUTE); int* tok_pos = tok_e + 2 * M; float* tok_gate = (float*)(tok_pos + 2 * M); float* rstd = tok_gate + 2 * M; float* rowgate = rstd + M;
    bf16_t* XG = (bf16_t*)(ws + WS_XG); bf16_t* HB = (bf16_t*)(ws + WS_HBUF); bf16_t* Y = (bf16_t*)(ws + WS_Y); bf16_t* WGU = (bf16_t*)(ws + WS_WGU); bf16_t* WD = (bf16_t*)(ws + WS_WD);
    unsigned* cnt = (unsigned*)(ws + WS_CTL) + CW_CNT;
    switch (k) {
    case 1: nv::k_cumsum<<<16, 256, 0, stream>>>(BIAS); nv::k_inproj<<<dim3(NQKV / 64, M / 64), 256, 0, stream>>>(A1, WIN, QKV); break;
    case 2: nv::k_attn<<<dim3(S / 64, 48), 256, 0, stream>>>(QKV, BIAS, A2, DT); break;
    case 3: nv::k_diff_combine<<<M, 256, 0, stream>>>(DT, a.in[4], a.in[5], a.in[6], a.in[7], a.in[8], A2); break;
    case 4: nv::k_outproj<<<dim3(DM / 64, M / 64), 256, 0, stream>>>(A2, WOUT, a.in[0], H1); break;
    case 5: nv::k_route<<<M / 4, 256, 0, stream>>>(H1, a.in[10], a.in[11], a.in[12], a.in[13], a.in[14], tok_e, tok_pos, tok_gate, rstd, cnt); break;
    case 6: nv::k_dispatch<<<M / 4, 256, 0, stream>>>(H1, a.in[10], rstd, tok_e, tok_pos, tok_gate, cnt, XG, rowgate); break;
    case 7: nv::k_moe_up<<<dim3(DFF / 64, YROWS / 64), 256, 0, stream>>>(XG, WGU, cnt, HB); break;
    case 8: nv::k_moe_down<<<dim3(DM / 64, YROWS / 64), 256, 0, stream>>>(HB, WD, cnt, rowgate, Y); break;
    case 9: nv::k_final<<<M / 4, 256, 0, stream>>>(H1, Y, cnt, tok_e, tok_pos, a.in[18], a.out); break;
    default: break;
    }
}
#endif


extern "C" void kernel_launch(void* const* d_in, const int* in_sizes, int n_in, void* d_out, int out_size, void* d_ws, size_t ws_size, hipStream_t stream) {
    static int grid = 0;
    if (grid == 0) {
        if (n_in != 19 || in_sizes[0] != M * DM || out_size != M * DM || ws_size < WS_END) {
            fprintf(stderr, "kernel_launch: built for 19 inputs, x and out of %d floats, >= %zu bytes of workspace; got n_in %d, in0 %d, out %d, ws %zu; nothing launched\n", M * DM, (size_t)WS_END, n_in, n_in > 0 ? in_sizes[0] : -1, out_size, ws_size); grid = -1; return; }
        int dev = 0, cus = 0, per_cu = 0;
        if (hipGetDevice(&dev) != hipSuccess || hipDeviceGetAttribute(&cus, hipDeviceAttributeMultiprocessorCount, dev) != hipSuccess) { fprintf(stderr, "kernel_launch: device query failed\n"); grid = -1; return; }
        if (hipFuncSetAttribute((const void*)mk_fwd, hipFuncAttributeMaxDynamicSharedMemorySize, LDS_BYTES) != hipSuccess) { fprintf(stderr, "kernel_launch: hipFuncSetAttribute failed\n"); grid = -1; return; }
        if (hipOccupancyMaxActiveBlocksPerMultiprocessor(&per_cu, (const void*)mk_fwd, NWAVES * 64, LDS_BYTES) != hipSuccess || per_cu < 1)
            fprintf(stderr, "kernel_launch: note: occupancy query reports %d workgroups per CU\n", per_cu);
        (void)hipGetLastError();
        grid = cus;
    }
    if (grid < 0) return;
    if (hipMemsetAsync((char*)d_ws + WS_CTL, 0, CTL_ZERO_BYTES, stream) != hipSuccess) { fprintf(stderr, "kernel_launch: memset failed\n"); return; }
    Args a{};
    for (int i = 0; i < 19; ++i) a.in[i] = (const float*)d_in[i];
    a.out = (float*)d_out; a.ws = (unsigned char*)d_ws;
    int k = 0, li = 0;
    while (k < NPHASE) {
#if NAIVE_MASK
        if (k > 0 && ((NAIVE_MASK >> k) & 1u)) { naive_phase(k, a, stream); ++k; continue; }
#endif
        const int lo = k; ++k;
        while (k < NPHASE && !((NAIVE_MASK >> k) & 1u)) ++k;
        a.ph_lo = lo; a.ph_hi = k; a.li = li++;
        hipLaunchKernelGGL(mk_fwd, dim3(grid), dim3(NWAVES * 64), LDS_BYTES, stream, a);
        const hipError_t le = hipPeekAtLastError();
        if (le != hipSuccess) { fprintf(stderr, "kernel_launch: launch failed: %s\n", hipGetErrorName(le)); break; }
    }
}
```

```cpp
#include <hip/hip_runtime.h>
#include <hip/hip_bf16.h>
#include <cstdio>
#include <cstdint>
#include <cmath>

#ifndef NAIVE_MASK
#define NAIVE_MASK 0u
#endif

typedef unsigned short bf16_t;
constexpr int NB = 2, S = 8192, DM = 2048, M = NB * S;
constexpr int NCOL = 6152, NQKV = 6144;
constexpr int FCOL = 3072;
constexpr int NE = 64, DFF = 1024;
constexpr int YROWS = 49152, NTILE_MAX = YROWS / 256;
constexpr int C_FQ = 0, C_FK = 1024, C_FV = 2048, C_DQ = 3072, C_DK = 4096, C_DV = 5120;
constexpr float ATT_SCALE = 0.08838834764831845f, ATT_ISCALE = 11.313708498984761f;
constexpr int NPHASE = 11;

constexpr size_t MiB = 1u << 20;
constexpr size_t WS_CTL = 0, CTL_ZERO_BYTES = 1 * MiB;
constexpr size_t WS_A1 = 1 * MiB;
constexpr size_t WS_WIN = 65 * MiB;
constexpr size_t WS_WOUT = 89 * MiB;
constexpr size_t WS_BIAS = 97 * MiB;
constexpr size_t WS_QKV = 98 * MiB;
constexpr size_t WS_A2 = 290 * MiB;
constexpr size_t WS_DT = 354 * MiB;
constexpr size_t WS_H1 = 418 * MiB;
constexpr size_t WS_ROUTE = 546 * MiB;
constexpr size_t WS_WR = 547 * MiB;
constexpr size_t WS_XG = 548 * MiB;
constexpr size_t WS_HBUF = 740 * MiB;
constexpr size_t WS_Y = 836 * MiB;
constexpr size_t WS_WGU = 1028 * MiB;
constexpr size_t WS_WD = 1540 * MiB;
constexpr size_t WS_END = 1796 * MiB;
constexpr int CW_CNT = 1024;
constexpr int CW_NRM = 2048;
constexpr int CW_QHEAD = 3072;
constexpr int CW_BAR = 4096;

namespace pg8 {
#define PG8_LAS __attribute__((address_space(3)))
typedef unsigned short bf16_t;
typedef short bf16x8 __attribute__((ext_vector_type(8)));
typedef float f32x4 __attribute__((ext_vector_type(4)));
typedef unsigned u32x4 __attribute__((ext_vector_type(4)));
constexpr int BM = 256, BK = 64, HALF = 128, HTB = HALF * BK * 2  , STAGE_BYTES = 8 * HTB, NXCD = 8, WGM = 8;

__host__ __device__ __forceinline__ int lds_byte(int r, int c) { const int st = (r >> 4) * 2 + (c >> 5), rr = r & 15, cc = c & 31, ob = rr * 64 + cc * 2; return st * 1024 + (ob ^ (((ob >> 9) & 1) << 5)); }
__host__ __device__ __forceinline__ void stage_rc(int b, int& R, int& C) { const int st = b / 1024, sb = b % 1024, swz = sb ^ (((sb >> 9) & 1) << 5); R = (st >> 1) * 16 + swz / 64; C = (st & 1) * 32 + (swz % 64) / 2; }
__host__ __device__ __forceinline__ int perm32(int rho) { const int n = rho >> 4, i = rho & 15; return 8 * (i >> 2) + 4 * n + (i & 3); }

struct Unit { int pm, pn; };
struct Gemm { const bf16_t* A; const bf16_t* Bt; int M, N, K; };

struct StaticOrder {
    int nM, nN, nwg, G, c;
    __host__ __device__ void init(int M, int N, int G_, int c_) { nM = M / BM; nN = N / BM; nwg = nM * nN; G = G_; c = c_; }
    __host__ __device__ bool next(int i, Unit& u) const {
        const long L = (long)i * G + c; if (L >= nwg) return false;
        int wgid = (int)L; { const int q = nwg / NXCD, r = nwg % NXCD, xcd = wgid % NXCD, off = wgid / NXCD; wgid = (xcd < r ? xcd * (q + 1) : r * (q + 1) + (xcd - r) * q) + off; }
        const int nig = WGM * nN, gid = wgid / nig, fm = gid * WGM, gsz = (nM - fm) < WGM ? (nM - fm) : WGM;
        u.pm = fm + ((wgid % nig) % gsz); u.pn = (wgid % nig) / gsz; return true;
    }
    __device__ __forceinline__ void a_ready(const Unit&) const {}
    __device__ __forceinline__ void done(const Unit&) const {}
};

__device__ __forceinline__ unsigned cvt_pk_bf16(float lo, float hi) { unsigned r; asm volatile("v_cvt_pk_bf16_f32 %0, %1, %2" : "=v"(r) : "v"(lo), "v"(hi)); return r; }
typedef float f32x2 __attribute__((ext_vector_type(2)));
__device__ __forceinline__ f32x2 gelu_pk(f32x2 v) {
    const f32x2 av = __builtin_elementwise_abs(v), d = av * 0.2316418882f + 1.0f;
    f32x2 t; t.x = __builtin_amdgcn_rcpf(d.x); t.y = __builtin_amdgcn_rcpf(d.y);
    f32x2 q = t * 0.5307027145f + (-0.7265760135f); q = q * t + 0.7107068705f; q = q * t + (-0.142248368f); q = q * t + 0.127414796f; q = q * t;
    const f32x2 s = (v * v) * (-0.72134752044f);
    f32x2 e; e.x = __builtin_amdgcn_exp2f(s.x); e.y = __builtin_amdgcn_exp2f(s.y);
    const f32x2 m = v * (q * e), r = v - m;
    f32x2 o; o.x = v.x < 0.f ? m.x : r.x; o.y = v.y < 0.f ? m.y : r.y; return o;
}

template <int ACT  > struct EpiBf16 {
    static constexpr bool PERM = true, AFTER_DRAIN = false; static_assert(ACT == 0 || ACT == 1, "EpiBf16: ACT is 0 (none) or 1 (gelu_pk)");
    bf16_t* O; int ldc; const float* bias; int split_cols; size_t split_stride; float scale0;
    __device__ __forceinline__ void operator()(const f32x4 (&acc)[2][2][4][2], const Unit& u, int wr, int wc, int fr, int fq) const {
        const int row0 = u.pm * BM + wr * 64 + fr; int colt = u.pn * BM; bf16_t* base = O;
        float sc = 1.f; if (split_cols) { const int t = colt / split_cols; base += (size_t)t * split_stride; colt -= t * split_cols; if (t == 0) sc = scale0; }
        const int col0 = colt + wc * 32 + 8 * fq, bcol0 = u.pn * BM + wc * 32 + 8 * fq;
        f32x4 bv[2][2];
#pragma unroll
        for (int bj = 0; bj < 2; ++bj)
#pragma unroll
            for (int n = 0; n < 2; ++n) bv[bj][n] = bias ? *(const f32x4*)(bias + bcol0 + bj * HALF + 4 * n) : (f32x4){0.f, 0.f, 0.f, 0.f};
#pragma unroll
        for (int ai = 0; ai < 2; ++ai)
#pragma unroll
            for (int m = 0; m < 4; ++m) { bf16_t* rowp = base + (size_t)(row0 + ai * HALF + m * 16) * ldc + col0;
#pragma unroll
                for (int bj = 0; bj < 2; ++bj) { f32x4 v0 = acc[ai][bj][m][0] + bv[bj][0], v1 = acc[ai][bj][m][1] + bv[bj][1];
                    if (ACT == 1) { f32x2 a = gelu_pk((f32x2){v0[0], v0[1]}), b = gelu_pk((f32x2){v0[2], v0[3]}), c = gelu_pk((f32x2){v1[0], v1[1]}), d = gelu_pk((f32x2){v1[2], v1[3]});
                        v0 = (f32x4){a.x, a.y, b.x, b.y}; v1 = (f32x4){c.x, c.y, d.x, d.y}; }
                    v0 = v0 * sc; v1 = v1 * sc; u32x4 w; w.x = cvt_pk_bf16(v0[0], v0[1]); w.y = cvt_pk_bf16(v0[2], v0[3]); w.z = cvt_pk_bf16(v1[0], v1[1]); w.w = cvt_pk_bf16(v1[2], v1[3]);
                    *(u32x4*)(rowp + bj * HALF) = w; } }
    }
};

struct EpiResF32 {
    static constexpr bool PERM = false, AFTER_DRAIN = false;
    const float* base; float* out; int ldc;
    __device__ __forceinline__ void operator()(const f32x4 (&acc)[2][2][4][2], const Unit& u, int wr, int wc, int fr, int fq) const {
        const int col0 = u.pn * BM + wc * 32 + 4 * fq;
#pragma unroll
        for (int ai = 0; ai < 2; ++ai)
#pragma unroll
            for (int m = 0; m < 4; ++m) { const size_t off = (size_t)(u.pm * BM + ai * HALF + wr * 64 + m * 16 + fr) * ldc + col0;
#pragma unroll
                for (int bj = 0; bj < 2; ++bj)
#pragma unroll
                    for (int n = 0; n < 2; ++n) { const f32x4 bs = *(const f32x4*)(base + off + bj * HALF + n * 16); *(f32x4*)(out + off + bj * HALF + n * 16) = bs + acc[ai][bj][m][n]; }
                if (m & 1) asm volatile("" ::: "memory"); }
    }
};
struct EpiResBf16 {
    static constexpr bool PERM = true, AFTER_DRAIN = false;
    const float* base; bf16_t* out; int ldc;
    __device__ __forceinline__ void operator()(const f32x4 (&acc)[2][2][4][2], const Unit& u, int wr, int wc, int fr, int fq) const {
        const int col0 = u.pn * BM + wc * 32 + 8 * fq;
#pragma unroll
        for (int ai = 0; ai < 2; ++ai)
#pragma unroll
            for (int m = 0; m < 4; ++m) { const size_t off = (size_t)(u.pm * BM + ai * HALF + wr * 64 + m * 16 + fr) * ldc + col0;
#pragma unroll
                for (int bj = 0; bj < 2; ++bj) { const f32x4 v0 = *(const f32x4*)(base + off + bj * HALF) + acc[ai][bj][m][0], v1 = *(const f32x4*)(base + off + bj * HALF + 4) + acc[ai][bj][m][1];
                    u32x4 w; w.x = cvt_pk_bf16(v0[0], v0[1]); w.y = cvt_pk_bf16(v0[2], v0[3]); w.z = cvt_pk_bf16(v1[0], v1[1]); w.w = cvt_pk_bf16(v1[2], v1[3]);
                    *(u32x4*)(out + off + bj * HALF) = w; }
                if (m & 1) asm volatile("" ::: "memory"); }
    }
};
struct EpiQKV {
    static constexpr bool PERM = true, AFTER_DRAIN = false;
    bf16_t* O; int ldc; PG8_LAS float* part; unsigned* nrm;
    __device__ __forceinline__ void operator()(const f32x4 (&acc)[2][2][4][2], const Unit& u, int wr, int wc, int fr, int fq) const {
        const int row0 = u.pm * BM + wr * 64 + fr, col0 = u.pn * BM + wc * 32 + 8 * fq;
        const bool track = u.pn < 8 || (u.pn >= 12 && u.pn < 20);
#pragma unroll
        for (int ai = 0; ai < 2; ++ai)
#pragma unroll
            for (int m = 0; m < 4; ++m) { bf16_t* rowp = O + (size_t)(row0 + ai * HALF + m * 16) * ldc + col0;
#pragma unroll
                for (int bj = 0; bj < 2; ++bj) { const f32x4 v0 = acc[ai][bj][m][0], v1 = acc[ai][bj][m][1];
                    u32x4 w; w.x = cvt_pk_bf16(v0[0], v0[1]); w.y = cvt_pk_bf16(v0[2], v0[3]); w.z = cvt_pk_bf16(v1[0], v1[1]); w.w = cvt_pk_bf16(v1[2], v1[3]);
                    *(u32x4*)(rowp + bj * HALF) = w;
                    if (track) { float ss = ((v0[0] * v0[0] + v0[1] * v0[1]) + (v0[2] * v0[2] + v0[3] * v0[3])) + ((v1[0] * v1[0] + v1[1] * v1[1]) + (v1[2] * v1[2] + v1[3] * v1[3]));
                        ss += __shfl_xor(ss, 16); ss += __shfl_xor(ss, 32);
                        if (fq == 0) part[(wc * 2 + bj) * 256 + ai * HALF + wr * 64 + m * 16 + fr] = ss; } } }
        if (track) {
            asm volatile("s_waitcnt lgkmcnt(0)" ::: "memory"); __builtin_amdgcn_s_barrier(); asm volatile("" ::: "memory");
            const int tid = threadIdx.x, row = tid & 255, bj = tid >> 8;
            float v = (part[(0 * 2 + bj) * 256 + row] + part[(1 * 2 + bj) * 256 + row]) + (part[(2 * 2 + bj) * 256 + row] + part[(3 * 2 + bj) * 256 + row]);
#pragma unroll
            for (int o = 1; o < 64; o <<= 1) v = fmaxf(v, __shfl_xor(v, o));
            const int slice = (u.pn < 8 ? 2 * u.pn : 16 + 2 * (u.pn - 12)) + bj;
            if ((tid & 63) == 0) atomicMax(nrm + (u.pm >> 5) * 32 + slice, __float_as_uint(v));
            asm volatile("s_waitcnt lgkmcnt(0)" ::: "memory");
        }
    }
};
struct EpiSwiglu {
    static constexpr bool PERM = true, AFTER_DRAIN = false;
    bf16_t* H;
    __device__ __forceinline__ void operator()(const f32x4 (&acc)[2][2][4][2], const Unit& u, int wr, int wc, int fr, int fq) const {
        const int col0 = (u.pn & 7) * HALF + wc * 32 + 8 * fq;
#pragma unroll
        for (int ai = 0; ai < 2; ++ai)
#pragma unroll
            for (int m = 0; m < 4; ++m) { bf16_t* rowp = H + (size_t)(u.pm * BM + ai * HALF + wr * 64 + m * 16 + fr) * 1024 + col0;
                float hv[8];
#pragma unroll
                for (int n = 0; n < 2; ++n)
#pragma unroll
                    for (int c = 0; c < 4; ++c) { const float g = acc[ai][0][m][n][c], uu = acc[ai][1][m][n][c];
                        hv[n * 4 + c] = g * __builtin_amdgcn_rcpf(1.f + __builtin_amdgcn_exp2f(-1.4426950408889634f * g)) * uu; }
                u32x4 w; w.x = cvt_pk_bf16(hv[0], hv[1]); w.y = cvt_pk_bf16(hv[2], hv[3]); w.z = cvt_pk_bf16(hv[4], hv[5]); w.w = cvt_pk_bf16(hv[6], hv[7]);
                *(u32x4*)rowp = w; }
    }
};
struct EpiDown {
    static constexpr bool PERM = true, AFTER_DRAIN = false;
    bf16_t* Y;
    __device__ __forceinline__ void operator()(const f32x4 (&acc)[2][2][4][2], const Unit& u, int wr, int wc, int fr, int fq) const {
        const int col0 = (u.pn & 7) * BM + wc * 32 + 8 * fq;
#pragma unroll
        for (int ai = 0; ai < 2; ++ai)
#pragma unroll
            for (int m = 0; m < 4; ++m) { const int row = u.pm * BM + ai * HALF + wr * 64 + m * 16 + fr; bf16_t* rowp = Y + (size_t)row * 2048 + col0;
#pragma unroll
                for (int bj = 0; bj < 2; ++bj) { const f32x4 v0 = acc[ai][bj][m][0], v1 = acc[ai][bj][m][1];
                    u32x4 w; w.x = cvt_pk_bf16(v0[0], v0[1]); w.y = cvt_pk_bf16(v0[2], v0[3]); w.z = cvt_pk_bf16(v1[0], v1[1]); w.w = cvt_pk_bf16(v1[2], v1[3]);
                    *(u32x4*)(rowp + bj * HALF) = w; } }
    }
};
struct GroupedOrder {
    int total, G, c; const PG8_LAS int* tile_e;
    __device__ __forceinline__ bool next(int i, Unit& u) const {
        const int L = i * G + c; if (L >= total) return false;
        u.pm = L >> 3; u.pn = __builtin_amdgcn_readfirstlane(tile_e[L >> 3]) * 8 + (L & 7); return true;
    }
    __device__ __forceinline__ void a_ready(const Unit&) const {}
    __device__ __forceinline__ void done(const Unit&) const {}
};

template <class Epi, class Sched, bool ALIGN_EPI = false, bool SP2 = false>
__device__ __forceinline__ void gemm_phase(PG8_LAS unsigned char* lds, const Gemm g, const Sched& S, const Epi& E) {
    const int tid = threadIdx.x, wid = __builtin_amdgcn_readfirstlane(tid >> 6), lane = tid & 63, wr = wid >> 2, wc = wid & 3, fr = lane & 15, fq = lane >> 4;
    const int K = g.K, nt = K / BK;
    unsigned voffA[2], voffB[2];
#pragma unroll
    for (int i = 0; i < 2; ++i) { int R, C; stage_rc(tid * 16 + i * 8192, R, C); const int Rb = Epi::PERM ? ((R & ~31) + perm32(R & 31)) : R;
        voffA[i] = (unsigned)(R * K + C) * 2u; voffB[i] = (unsigned)(Rb * K + C) * 2u; }
    const size_t kstep = (size_t)(BK * 2);
    const size_t hstep = (size_t)HALF * K * 2;
    const size_t tstep = 2 * hstep;
    const unsigned ldsw = (unsigned)wid * 1024u;
    const int aoff = lds_byte(wr * 64 + fr, fq * 8), boff = lds_byte(wc * 32 + fr, fq * 8);
#define PG8_SA(b, h) (((b) * 2 + (h)) * HTB)
#define PG8_SB(b, h) ((4 + (b) * 2 + (h)) * HTB)
#define PG8_STAGE(bufoff, gbase, voff) do { _Pragma("unroll") for (int _i = 0; _i < 2; ++_i) \
        __builtin_amdgcn_global_load_lds((const unsigned*)((const char*)(gbase) + (voff)[_i]), (PG8_LAS unsigned*)(lds + (bufoff) + ldsw + _i * 8192), 16, 0, 0); } while (0)
#define PG8_LDA(dst, b, h) do { _Pragma("unroll") for (int m = 0; m < 4; ++m) _Pragma("unroll") for (int k = 0; k < 2; ++k) dst[m][k] = *(const PG8_LAS bf16x8*)(lds + PG8_SA(b, h) + aoff + m * 2048 + k * 1024); } while (0)
#define PG8_LDB(dst, b, h) do { _Pragma("unroll") for (int n = 0; n < 2; ++n) _Pragma("unroll") for (int k = 0; k < 2; ++k) dst[n][k] = *(const PG8_LAS bf16x8*)(lds + PG8_SB(b, h) + boff + n * 2048 + k * 1024); } while (0)
#define PG8_MMA(ai, bj, At, Bt) do { __builtin_amdgcn_s_setprio(1); _Pragma("unroll") for (int m = 0; m < 4; ++m) _Pragma("unroll") for (int n = 0; n < 2; ++n) _Pragma("unroll") for (int k = 0; k < 2; ++k) \
        acc[ai][bj][m][n] = __builtin_amdgcn_mfma_f32_16x16x32_bf16(Bt[n][k], At[m][k], acc[ai][bj][m][n], 0, 0, 0); __builtin_amdgcn_s_setprio(0); } while (0)
#define PG8_WAIT_V(n) asm volatile("s_waitcnt vmcnt(" #n ")" ::: "memory")
#define PG8_WAIT_L(n) asm volatile("s_waitcnt lgkmcnt(" #n ")" ::: "memory")
#define PG8_BAR __builtin_amdgcn_s_barrier()
#define PG8_SCHED __builtin_amdgcn_sched_barrier(0)
    Unit cur, nxt; int ui = 0;
    if (!S.next(0, cur)) return;
    f32x4 acc[2][2][4][2];
#pragma unroll
    for (int a = 0; a < 2; ++a)
#pragma unroll
        for (int b = 0; b < 2; ++b)
#pragma unroll
            for (int m = 0; m < 4; ++m)
#pragma unroll
                for (int n = 0; n < 2; ++n) acc[a][b][m][n] = (f32x4){0.f, 0.f, 0.f, 0.f};
    bf16x8 At[4][2], B0[2][2], B1[2][2];
    const char* cA = (const char*)g.A + (size_t)cur.pm * tstep; const char* cB = (const char*)g.Bt + (size_t)cur.pn * tstep;
    S.a_ready(cur);
    if constexpr (SP2) {
        PG8_STAGE(PG8_SB(0, 0), cB, voffB); PG8_STAGE(PG8_SB(0, 1), cB + hstep, voffB); PG8_STAGE(PG8_SA(0, 0), cA, voffA); PG8_STAGE(PG8_SA(0, 1), cA + hstep, voffA);
        if (wr == 1) PG8_BAR;
        PG8_WAIT_V(2); PG8_BAR;
        PG8_STAGE(PG8_SB(1, 0), cB + kstep, voffB); PG8_STAGE(PG8_SA(1, 0), cA + kstep, voffA); PG8_STAGE(PG8_SB(1, 1), cB + hstep + kstep, voffB);
        PG8_WAIT_V(6); PG8_BAR;
    } else {
        PG8_STAGE(PG8_SB(0, 0), cB, voffB); PG8_STAGE(PG8_SA(0, 0), cA, voffA); PG8_STAGE(PG8_SB(0, 1), cB + hstep, voffB); PG8_STAGE(PG8_SA(0, 1), cA + hstep, voffA);
        if (wr == 1) PG8_BAR;
        PG8_WAIT_V(4); PG8_BAR;
        PG8_STAGE(PG8_SB(1, 0), cB + kstep, voffB); PG8_STAGE(PG8_SA(1, 0), cA + kstep, voffA); PG8_STAGE(PG8_SB(1, 1), cB + hstep + kstep, voffB);
        PG8_WAIT_V(6); PG8_BAR;
    }
    for (;;) {
        const bool has_next = S.next(ui + 1, nxt);
        const char* nA = has_next ? (const char*)g.A + (size_t)nxt.pm * tstep : cA; const char* nB = has_next ? (const char*)g.Bt + (size_t)nxt.pn * tstep : cB;
        for (int t = 0; t < nt; t += 2) {
            const bool last = (t == nt - 2);
            const char* a1 = cA + (size_t)(t + 1) * kstep;
            const char* a2 = last ? nA : cA + (size_t)(t + 2) * kstep; const char* b2 = last ? nB : cB + (size_t)(t + 2) * kstep;
            const char* a3 = a2 + kstep; const char* b3 = b2 + kstep;
            if (last && has_next) S.a_ready(nxt);
            if constexpr (SP2) {
            PG8_LDB(B0, 0, 0); PG8_LDB(B1, 0, 1); PG8_SCHED; PG8_LDA(At, 0, 0); PG8_STAGE(PG8_SA(1, 1), a1 + hstep, voffA);
            PG8_WAIT_V(8); PG8_WAIT_L(0); PG8_BAR; PG8_MMA(0, 0, At, B0); PG8_MMA(0, 1, At, B1); PG8_BAR; PG8_SCHED;
            PG8_LDA(At, 0, 1); PG8_STAGE(PG8_SB(0, 0), b2, voffB); PG8_STAGE(PG8_SB(0, 1), b2 + hstep, voffB); PG8_STAGE(PG8_SA(0, 0), a2, voffA);
            PG8_WAIT_V(8); PG8_WAIT_L(0); PG8_BAR; PG8_MMA(1, 0, At, B0); PG8_MMA(1, 1, At, B1); PG8_BAR; PG8_SCHED;
            PG8_LDB(B0, 1, 0); PG8_LDB(B1, 1, 1); PG8_SCHED; PG8_LDA(At, 1, 0); PG8_STAGE(PG8_SA(0, 1), a2 + hstep, voffA);
            PG8_WAIT_V(8); PG8_WAIT_L(0); PG8_BAR; PG8_MMA(0, 0, At, B0); PG8_MMA(0, 1, At, B1); PG8_BAR; PG8_SCHED;
            PG8_LDA(At, 1, 1); PG8_STAGE(PG8_SB(1, 0), b3, voffB); PG8_STAGE(PG8_SB(1, 1), b3 + hstep, voffB); PG8_STAGE(PG8_SA(1, 0), a3, voffA);
            PG8_WAIT_V(8); PG8_WAIT_L(0); PG8_BAR; PG8_MMA(1, 0, At, B0); PG8_MMA(1, 1, At, B1); PG8_BAR; PG8_SCHED;
            } else {
            PG8_LDB(B0, 0, 0); PG8_SCHED; PG8_LDA(At, 0, 0); PG8_STAGE(PG8_SA(1, 1), a1 + hstep, voffA);
            PG8_WAIT_L(8); PG8_BAR; PG8_WAIT_L(0); PG8_MMA(0, 0, At, B0); PG8_BAR; PG8_SCHED;
            PG8_LDB(B1, 0, 1); PG8_STAGE(PG8_SB(0, 0), b2, voffB);
            PG8_BAR; PG8_WAIT_L(0); PG8_MMA(0, 1, At, B1); PG8_BAR;
            PG8_LDA(At, 0, 1); PG8_STAGE(PG8_SA(0, 0), a2, voffA);
            PG8_BAR; PG8_WAIT_L(0); PG8_MMA(1, 0, At, B0); PG8_BAR; PG8_SCHED;
            PG8_STAGE(PG8_SB(0, 1), b2 + hstep, voffB);
            PG8_WAIT_V(6); PG8_BAR; PG8_MMA(1, 1, At, B1); PG8_BAR;
            PG8_LDB(B0, 1, 0); PG8_SCHED; PG8_LDA(At, 1, 0); PG8_STAGE(PG8_SA(0, 1), a2 + hstep, voffA);
            PG8_WAIT_L(8); PG8_BAR; PG8_WAIT_L(0); PG8_MMA(0, 0, At, B0); PG8_BAR; PG8_SCHED;
            PG8_LDB(B1, 1, 1); PG8_STAGE(PG8_SB(1, 0), b3, voffB);
            PG8_BAR; PG8_WAIT_L(0); PG8_MMA(0, 1, At, B1); PG8_BAR;
            PG8_LDA(At, 1, 1); PG8_STAGE(PG8_SA(1, 0), a3, voffA);
            PG8_BAR; PG8_WAIT_L(0); PG8_MMA(1, 0, At, B0); PG8_BAR; PG8_SCHED;
            PG8_STAGE(PG8_SB(1, 1), b3 + hstep, voffB);
            PG8_WAIT_V(6); PG8_BAR; PG8_MMA(1, 1, At, B1); PG8_BAR;
            }
        }
        if constexpr (ALIGN_EPI) { if (wr == 0) PG8_BAR; }
        if constexpr (!Epi::AFTER_DRAIN) { E(acc, cur, wr, wc, fr, fq); S.done(cur); }
        if (!has_next) break;
#pragma unroll
        for (int a = 0; a < 2; ++a)
#pragma unroll
            for (int b = 0; b < 2; ++b)
#pragma unroll
                for (int m = 0; m < 4; ++m)
#pragma unroll
                    for (int n = 0; n < 2; ++n) acc[a][b][m][n] = (f32x4){0.f, 0.f, 0.f, 0.f};
        cur = nxt; cA = nA; cB = nB; ++ui;
        if constexpr (ALIGN_EPI) { if (wr == 1) PG8_BAR; }
    }
    PG8_WAIT_V(0);
    if constexpr (!ALIGN_EPI) { if (wr == 0) PG8_BAR; }
    PG8_BAR;
    if constexpr (Epi::AFTER_DRAIN) { E.fused(acc, cur, wr, wc, fr, fq, lds, wid, lane); S.done(cur); }
#undef PG8_SA
#undef PG8_SB
#undef PG8_STAGE
#undef PG8_LDA
#undef PG8_LDB
#undef PG8_MMA
#undef PG8_WAIT_V
#undef PG8_WAIT_L
#undef PG8_BAR
#undef PG8_SCHED
}

struct UnitW { int pm, cn; const float* w0; const float* w1; };
struct GemmW { const bf16_t* A; int K, ldw; const int* rowtok; int tokmask; const PG8_LAS int* rowbase; };
__device__ __forceinline__ void wload1(f32x4& r0, unsigned voff, const char* sbase) { asm volatile("global_load_dwordx4 %0, %1, %2" : "=&v"(r0) : "v"(voff), "s"(sbase) : "memory"); }
template <class Epi, class Sched, bool ALIGN_EPI, bool GATHER>
__device__ __forceinline__ void gemm_phase_wf32(PG8_LAS unsigned char* lds, const GemmW g, const Sched& S, const Epi& E) {
    static_assert(Epi::PERM && !Epi::AFTER_DRAIN, "gemm_phase_wf32: PERM epilogues that run inside the unit loop only");
    const int tid = threadIdx.x, wid = __builtin_amdgcn_readfirstlane(tid >> 6), lane = tid & 63, wr = wid >> 2, wc = wid & 3, fr = lane & 15, fq = lane >> 4;
    const int K = g.K, nt = K / BK;
    const size_t kstep = (size_t)(BK * 2), hstep = (size_t)HALF * K * 2, tstep = 2 * hstep;
    const unsigned ldsw = (unsigned)wid * 1024u;
    const int aoff = lds_byte(wr * 64 + fr, fq * 8), boff = lds_byte(wc * 32 + fr, fq * 8);
    const int cq = lane & 7, sj = lane >> 3;
    #if defined(PROBE_HOT) && (PROBE_HOT == 2 || PROBE_HOT == 4)
    const size_t wrow = (size_t)g.ldw * 4u, wkt = S.hot ? 0 : wrow * BK;
#else
    const size_t wrow = (size_t)g.ldw * 4u, wkt = wrow * BK;
#endif
#if defined(PROBE_HOT) && PROBE_HOT == 5
    const int cqg = S.hot ? (lane & 7) : cq, sjg = S.hot ? (lane >> 3) : sj;
    const size_t wsrc = (size_t)(8 * sjg) * wrow + (size_t)(32 * (wid & 3) + 4 * cqg) * 4u;
#else
    const size_t wsrc = (size_t)(8 * sj) * wrow + (size_t)(32 * (wid & 3) + 4 * cq) * 4u;
#endif
    const int wrho = 16 * (cq & 1) + 4 * (cq >> 1);
    const int wdst = (4 + (wid >> 2)) * HTB + lds_byte(32 * (wid & 3) + wrho, 8 * sj);
#define PG8_SA(b, h) (((b) * 2 + (h)) * HTB)
#define PG8_SB(b, h) ((4 + (b) * 2 + (h)) * HTB)
#define PG8_STAGE(bufoff, gbase, voff) do { _Pragma("unroll") for (int _i = 0; _i < 2; ++_i) \
        __builtin_amdgcn_global_load_lds((const unsigned*)((const char*)(gbase) + (voff)[_i]), (PG8_LAS unsigned*)(lds + (bufoff) + ldsw + _i * 8192), 16, 0, 0); } while (0)
#define PG8_STAGEA(bufoff, h, kb, nx) do { const char* b_ = ((nx) ? nAb : cAb) + (kb); unsigned v_[2]; v_[0] = (nx) ? voN[h][0] : voC[h][0]; v_[1] = (nx) ? voN[h][1] : voC[h][1]; PG8_STAGE(bufoff, b_, v_); } while (0)
#define PG8_LDA(dst, b, h) do { _Pragma("unroll") for (int m = 0; m < 4; ++m) _Pragma("unroll") for (int k = 0; k < 2; ++k) dst[m][k] = *(const PG8_LAS bf16x8*)(lds + PG8_SA(b, h) + aoff + m * 2048 + k * 1024); } while (0)
#define PG8_LDB(dst, b, h) do { _Pragma("unroll") for (int n = 0; n < 2; ++n) _Pragma("unroll") for (int k = 0; k < 2; ++k) dst[n][k] = *(const PG8_LAS bf16x8*)(lds + PG8_SB(b, h) + boff + n * 2048 + k * 1024); } while (0)
#define PG8_MMA(ai, bj, At, Bt) do { __builtin_amdgcn_s_setprio(1); _Pragma("unroll") for (int m = 0; m < 4; ++m) _Pragma("unroll") for (int n = 0; n < 2; ++n) _Pragma("unroll") for (int k = 0; k < 2; ++k) \
        acc[ai][bj][m][n] = __builtin_amdgcn_mfma_f32_16x16x32_bf16(Bt[n][k], At[m][k], acc[ai][bj][m][n], 0, 0, 0); __builtin_amdgcn_s_setprio(0); } while (0)
#define PG8_WAIT_V(n) asm volatile("s_waitcnt vmcnt(" #n ")" ::: "memory")
#define PG8_WAIT_L(n) asm volatile("s_waitcnt lgkmcnt(" #n ")" ::: "memory")
#define PG8_BAR __builtin_amdgcn_s_barrier()
#define PG8_SCHED __builtin_amdgcn_sched_barrier(0)
#define PG8_WLOAD(kk) do { const int kk_ = (kk); const bool in_ = kk_ < nt; const char* q_ = (in_ ? cW : nW) + (size_t)(in_ ? kk_ : kk_ - nt) * wkt; \
        _Pragma("unroll") for (int r_ = 0; r_ < 8; ++r_) wload1(RB[r_], (unsigned)wsrc, q_ + (size_t)r_ * wrow); } while (0)
#define PG8_WWAIT(n) asm volatile("s_waitcnt vmcnt(" #n ")" : "+v"(RB[0]), "+v"(RB[1]), "+v"(RB[2]), "+v"(RB[3]), "+v"(RB[4]), "+v"(RB[5]), "+v"(RB[6]), "+v"(RB[7]) :: "memory")
#define PG8_WWRITE(b) do { _Pragma("unroll") for (int i_ = 0; i_ < 4; ++i_) { u32x4 w_; \
        w_.x = cvt_pk_bf16(RB[0][i_], RB[1][i_]); w_.y = cvt_pk_bf16(RB[2][i_], RB[3][i_]); w_.z = cvt_pk_bf16(RB[4][i_], RB[5][i_]); w_.w = cvt_pk_bf16(RB[6][i_], RB[7][i_]); \
        *(PG8_LAS u32x4*)(lds + (b) * 2 * HTB + wdst + i_ * 64) = w_; } } while (0)
#ifdef PROBE_ABL
    const int abl = S.hot ? PROBE_ABL : 0;
#define PG8_ABL(bit, stmt) do { if (!(abl & (bit))) { stmt; } } while (0)
#else
#define PG8_ABL(bit, stmt) do { stmt; } while (0)
#endif
    UnitW cur, nxt; int ui = 0;
    if (!S.next(0, cur)) return;
    f32x4 acc[2][2][4][2];
#pragma unroll
    for (int a = 0; a < 2; ++a)
#pragma unroll
        for (int b = 0; b < 2; ++b)
#pragma unroll
            for (int m = 0; m < 4; ++m)
#pragma unroll
                for (int n = 0; n < 2; ++n) acc[a][b][m][n] = (f32x4){0.f, 0.f, 0.f, 0.f};
    bf16x8 At[4][2], B0[2][2], B1[2][2]; f32x4 RB[8];
    const bool whalf = wid >= 4;
    const char* cAb; const char* nAb; unsigned voC[2][2], voN[2][2];
#define PG8_UNIT_A(base, vo, pm_) do { int t_ = tid; asm volatile("" : "+v"(t_)); int R_[2], C_[2]; stage_rc(t_ * 16, R_[0], C_[0]); stage_rc(t_ * 16 + 8192, R_[1], C_[1]); \
        if constexpr (GATHER) { base = (const char*)g.A; const int rb_ = __builtin_amdgcn_readfirstlane(g.rowbase[pm_]); _Pragma("unroll") for (int h_ = 0; h_ < 2; ++h_) _Pragma("unroll") for (int i_ = 0; i_ < 2; ++i_) \
            vo[h_][i_] = (unsigned)(g.rowtok[rb_ + (pm_) * BM + h_ * HALF + R_[i_]] & g.tokmask) * (unsigned)(K * 2) + (unsigned)C_[i_] * 2u; } \
        else { base = (const char*)g.A + (size_t)(pm_) * tstep; _Pragma("unroll") for (int h_ = 0; h_ < 2; ++h_) _Pragma("unroll") for (int i_ = 0; i_ < 2; ++i_) vo[h_][i_] = (unsigned)(h_ * HALF + R_[i_]) * (unsigned)(K * 2) + (unsigned)C_[i_] * 2u; } } while (0)
    PG8_UNIT_A(cAb, voC, cur.pm); nAb = cAb;
#pragma unroll
    for (int h_ = 0; h_ < 2; ++h_) { voN[h_][0] = voC[h_][0]; voN[h_][1] = voC[h_][1]; }
    const char* cW = (const char*)(whalf ? cur.w1 : cur.w0);
    const char* nW = cW;
    PG8_WLOAD(0); PG8_STAGEA(PG8_SA(0, 0), 0, 0, false); PG8_STAGEA(PG8_SA(0, 1), 1, 0, false);
    PG8_WWAIT(4); PG8_WWRITE(0);
    PG8_WLOAD(1);
    PG8_WWAIT(0); PG8_WWRITE(1);
    PG8_STAGEA(PG8_SA(1, 0), 0, kstep, false);
    PG8_WLOAD(2);
    PG8_WAIT_L(0);
    if (wr == 1) PG8_BAR;
    PG8_BAR; PG8_BAR;
    for (;;) {
        const bool has_next = S.next(ui + 1, nxt);
        if (has_next) PG8_UNIT_A(nAb, voN, nxt.pm);
        nW = has_next ? (const char*)(whalf ? nxt.w1 : nxt.w0) : cW;
        for (int t = 0; t < nt; t += 2) {
            const bool last = (t == nt - 2);
            const size_t k1 = (size_t)(t + 1) * kstep, k2 = last ? 0 : (size_t)(t + 2) * kstep, k3 = k2 + kstep;
            PG8_LDB(B0, 0, 0); PG8_LDB(B1, 0, 1); PG8_SCHED; PG8_LDA(At, 0, 0); PG8_STAGEA(PG8_SA(1, 1), 1, k1, false);
            PG8_WAIT_V(12); PG8_WAIT_L(0); PG8_BAR; PG8_MMA(0, 0, At, B0); PG8_MMA(0, 1, At, B1); PG8_BAR; PG8_SCHED;
            PG8_WWAIT(2); PG8_ABL(1, PG8_WWRITE(0)); PG8_LDA(At, 0, 1); PG8_STAGEA(PG8_SA(0, 0), 0, k2, last); PG8_ABL(2, PG8_WLOAD(t + 3));
            PG8_WAIT_L(0); PG8_BAR; PG8_MMA(1, 0, At, B0); PG8_MMA(1, 1, At, B1); PG8_BAR; PG8_SCHED;
            PG8_LDB(B0, 1, 0); PG8_LDB(B1, 1, 1); PG8_SCHED; PG8_LDA(At, 1, 0); PG8_STAGEA(PG8_SA(0, 1), 1, k2, last);
            PG8_WAIT_V(12); PG8_WAIT_L(0); PG8_BAR; PG8_MMA(0, 0, At, B0); PG8_MMA(0, 1, At, B1); PG8_BAR; PG8_SCHED;
            PG8_WWAIT(2); PG8_ABL(1, PG8_WWRITE(1)); PG8_LDA(At, 1, 1); PG8_STAGEA(PG8_SA(1, 0), 0, k3, last); PG8_ABL(2, PG8_WLOAD(t + 4));
            PG8_WAIT_L(0); PG8_BAR; PG8_MMA(1, 0, At, B0); PG8_MMA(1, 1, At, B1); PG8_BAR; PG8_SCHED;
        }
        if (!has_next) PG8_WWAIT(0);
        if constexpr (ALIGN_EPI) { if (wr == 0) PG8_BAR; }
        { Unit eu; eu.pm = cur.pm; eu.pn = cur.cn; E(acc, eu, wr, wc, fr, fq); }
        if (!has_next) break;
#pragma unroll
        for (int a = 0; a < 2; ++a)
#pragma unroll
            for (int b = 0; b < 2; ++b)
#pragma unroll
                for (int m = 0; m < 4; ++m)
#pragma unroll
                    for (int n = 0; n < 2; ++n) acc[a][b][m][n] = (f32x4){0.f, 0.f, 0.f, 0.f};
        cur = nxt; cAb = nAb; cW = nW; ++ui;
#pragma unroll
        for (int h_ = 0; h_ < 2; ++h_) { voC[h_][0] = voN[h_][0]; voC[h_][1] = voN[h_][1]; }
        if constexpr (ALIGN_EPI) { if (wr == 1) PG8_BAR; }
    }
    PG8_WAIT_V(0);
    if constexpr (!ALIGN_EPI) { if (wr == 0) PG8_BAR; }
    PG8_BAR;
#undef PG8_SA
#undef PG8_SB
#undef PG8_STAGE
#undef PG8_LDA
#undef PG8_STAGEA
#undef PG8_UNIT_A
#undef PG8_LDB
#undef PG8_MMA
#undef PG8_WAIT_V
#undef PG8_WAIT_L
#undef PG8_BAR
#undef PG8_SCHED
#undef PG8_WLOAD
#undef PG8_ABL
#undef PG8_WWAIT
#undef PG8_WWRITE
}
template <int MODE> struct GroupedOrderW {
    int total, G, c; const PG8_LAS int* tile_e; const float* wa; const float* wb; int hot;
    __device__ __forceinline__ bool next(int i, UnitW& u) const {
        const int L = i * G + c; if (L >= total) return false;
        int e = __builtin_amdgcn_readfirstlane(tile_e[L >> 3]), nt = L & 7;
        u.pm = L >> 3; u.cn = nt;
#if defined(PROBE_HOT) && PROBE_HOT == 1
        if (hot) { e = 0; nt = 0; }
#endif
        if (MODE == 0) { u.w0 = wa + (size_t)e * 2048 * 1024 + 128 * nt; u.w1 = wb + (size_t)e * 2048 * 1024 + 128 * nt; }
        else { u.w0 = wa + (size_t)e * 1024 * 2048 + 256 * nt; u.w1 = u.w0 + 128; }
        return true;
    }
};
}

namespace att {
using TIN = __hip_bfloat16; using TOUT = __hip_bfloat16;
constexpr int B = 2, H = 1, HKV = 1, SQ = 8192, SKV = 8192, D = 128, QOFF = 0, WINDOW = SKV;
constexpr float THR = 8.f;
constexpr bool WSKIP = false;
constexpr int LDQ = 6144, LDO = 2048;
constexpr int W_INF = 1 << 30;
#ifdef PROF_SECT
#define PROF_T0(sect) unsigned long long pt0_##sect = 0; if (PROF_SECT == (sect) && blockIdx.x == 0) pt0_##sect = __builtin_amdgcn_s_memtime()
#define PROF_T1(sect) do { if (PROF_SECT == (sect) && blockIdx.x == 0) { const unsigned long long d_ = __builtin_amdgcn_s_memtime() - pt0_##sect; if (threadIdx.x == 0) { PROFW[0] += (unsigned)d_; } } } while (0)
#else
#define PROF_T0(sect) do {} while (0)
#define PROF_T1(sect) do {} while (0)
#endif
constexpr float SCALE = 0.08838834764831845f;
constexpr int NW = 8, QBLK = 32, KVBLK = 64, QB = NW * QBLK;
constexpr int SHM_V = KVBLK * D * 2, SHM_K = KVBLK * D * 2;
constexpr int OFF_WS = 2 * SHM_V + 2 * SHM_K, OFF_CB = OFF_WS + NW * 64 * 4, LDS_BYTES = OFF_CB + 2 * 64 * 4;
static_assert(D == 128 && SQ % QB == 0 && SKV % KVBLK == 0 && H % HKV == 0 && QOFF >= 0 && QOFF + SQ <= SKV && WINDOW >= 1, "geometry");

using bf16 = __hip_bfloat16;
typedef short bf16x8 __attribute__((ext_vector_type(8)));
typedef short s16x4 __attribute__((ext_vector_type(4)));
typedef float f32x16 __attribute__((ext_vector_type(16)));
typedef float f32x4 __attribute__((ext_vector_type(4)));
typedef unsigned u32x4 __attribute__((ext_vector_type(4)));
template <class A, class Bt> struct same_t { static constexpr bool v = false; };
template <class A> struct same_t<A, A> { static constexpr bool v = true; };

#define KSWZ(row, colB) ((row) * 256 + ((colB) ^ (((row) & 7) << 4)))
#define SBAR() __builtin_amdgcn_sched_barrier(0)
__device__ __forceinline__ int v_st(int k, int c) { const int kk = (k & ~0xC) | ((k & 4) << 1) | ((k & 8) >> 1); return ((kk >> 3) * 4 + (c >> 5)) * 512 + ((kk & 7) * 32 + (c & 31)) * 2; }
__device__ __forceinline__ int v_rd_base(int lane) { return ((lane & 3) << 3) | (((lane >> 2) & 3) << 6) | (((lane >> 4) & 1) << 5) | (((lane >> 5) & 1) << 8); }
constexpr int v_rd_off(int d0, int ks, int half) { return d0 * 512 + ks * 4096 + half * 2048; }
__device__ __forceinline__ int crow(int r, int hi) { return (r & 3) + 8 * (r >> 2) + 4 * hi; }
__device__ __forceinline__ unsigned cvtpk(float lo, float hi) {
    unsigned r; asm volatile("v_cvt_pk_bf16_f32 %0, %1, %2" : "=v"(r) : "v"(lo), "v"(hi)); return r;
}
__device__ __forceinline__ bf16x8 pack8(f32x4 a, f32x4 b) {
    u32x4 w = {cvtpk(a[0], a[1]), cvtpk(a[2], a[3]), cvtpk(b[0], b[1]), cvtpk(b[2], b[3])};
    return *reinterpret_cast<bf16x8*>(&w);
}
template <class T> __device__ __forceinline__ bf16x8 load8(const T* p) {
    if constexpr (same_t<T, float>::v) { return pack8(*(const f32x4*)p, *(const f32x4*)(p + 4)); }
    else { return *reinterpret_cast<const bf16x8*>(p); }
}
__device__ __forceinline__ void mask_tile(f32x16& p0, f32x16& p1, int dq, unsigned W) {
    const float NEG = -__builtin_inff();
#pragma unroll
    for (int r = 0; r < 16; ++r) {
        const int c = (r & 3) + 8 * (r >> 2);
        if ((unsigned)(dq - c) >= W) p0[r] = NEG;
        if ((unsigned)(dq - c - 32) >= W) p1[r] = NEG;
    }
}
__device__ __forceinline__ void partialSM(f32x16& p0, f32x16& p1, float& m_reg, float& mn, float& alpha) {
    constexpr float C2 = 1.4426950408889634f * SCALE;
    mn = m_reg; alpha = 1.f;
    const float mnL = -m_reg * C2;
    for (int r = 0; r < 16; ++r) p0[r] = fmaf(p0[r], C2, mnL); for (int r = 0; r < 16; ++r) p1[r] = fmaf(p1[r], C2, mnL);
    for (int r = 0; r < 16; ++r) p0[r] = __builtin_amdgcn_exp2f(p0[r]);
}
__device__ __forceinline__ void finishSM(f32x16& p0, f32x16& p1, float alpha, float& l_reg, bf16x8& pa0, bf16x8& pa1, bf16x8& pa2, bf16x8& pa3) {
    for (int r = 0; r < 16; ++r) p1[r] = __builtin_amdgcn_exp2f(p1[r]);
    float ps = 0; for (int r = 0; r < 16; ++r) ps += p0[r]; for (int r = 0; r < 16; ++r) ps += p1[r];
    { auto rr = __builtin_amdgcn_permlane32_swap(__float_as_uint(ps), __float_as_uint(ps), false, false);
      ps = __uint_as_float(rr[0]) + __uint_as_float(rr[1]); }
    l_reg += ps; (void)alpha;
#define PK4(P, B_, OUT) do { unsigned a0 = cvtpk(P[B_+0], P[B_+1]), a1 = cvtpk(P[B_+2], P[B_+3]);                          \
        unsigned b0 = cvtpk(P[B_+4], P[B_+5]), b1 = cvtpk(P[B_+6], P[B_+7]);                                             \
        auto r0 = __builtin_amdgcn_permlane32_swap(a0, b0, false, false); auto r1 = __builtin_amdgcn_permlane32_swap(a1, b1, false, false); \
        u32x4 w = {r0[0], r1[0], r0[1], r1[1]}; OUT = *reinterpret_cast<bf16x8*>(&w); } while (0)
    PK4(p0, 0, pa0); PK4(p0, 8, pa1); PK4(p1, 0, pa2); PK4(p1, 8, pa3);
#undef PK4
}
template <int KB, bool SK>
__device__ __forceinline__ void qkt(f32x16& p0, f32x16& p1, const char* K_lds, int r32, int hi, const bf16x8* qr, bool act, const float* cbt, float cqs) {
    if (SK && !act) { const float NEG = -__builtin_inff();
#pragma unroll
        for (int r = 0; r < 16; ++r) { p0[r] = NEG; p1[r] = NEG; } return; }
    { const f32x4* c4 = (const f32x4*)(cbt + KB * 64);
#pragma unroll
      for (int g = 0; g < 4; ++g) { const f32x4 a = c4[2 * g], b = c4[8 + 2 * g];
#pragma unroll
          for (int i = 0; i < 4; ++i) { p0[4 * g + i] = cqs - a[i]; p1[4 * g + i] = cqs - b[i]; } } }
    const char* kb[4];
#pragma unroll
    for (int dd = 0; dd < 4; ++dd) kb[dd] = K_lds + KB * SHM_K + KSWZ(r32, (dd * 16 + hi * 8) * 2);
#pragma unroll
    for (int d0 = 0; d0 < 8; ++d0) { const char* a = kb[d0 & 3] + (d0 >> 2) * 128;
        bf16x8 b0 = *reinterpret_cast<const bf16x8*>(a);
        bf16x8 b1 = *reinterpret_cast<const bf16x8*>(a + 32 * 256);
        p0 = __builtin_amdgcn_mfma_f32_32x32x16_bf16(b0, qr[d0], p0, 0, 0, 0);
        p1 = __builtin_amdgcn_mfma_f32_32x32x16_bf16(b1, qr[d0], p1, 0, 0, 0); }
}
template <int VB, bool SK>
__device__ __forceinline__ void pv_tile(f32x16* o, int vb0, bf16x8 pa0, bf16x8 pa1, bf16x8 pa2, bf16x8 pa3, bool act) {
    if (SK && !act) return;
#define TRRD(dst, off) asm volatile("ds_read_b64_tr_b16 %0, %1 offset:%2" : "=&v"(dst) : "v"(vb0), "i"(off) : "memory")
#define PV_D0(d0) do { s16x4 l0, l1, l2, l3, h0, h1, h2, h3; constexpr int b_ = VB * SHM_V + v_rd_off(d0, 0, 0);     \
        TRRD(l0, b_); TRRD(h0, b_ + 2048); TRRD(l1, b_ + 4096); TRRD(h1, b_ + 6144); TRRD(l2, b_ + 8192); TRRD(h2, b_ + 10240); TRRD(l3, b_ + 12288); TRRD(h3, b_ + 14336); \
        asm volatile("s_waitcnt lgkmcnt(0)" ::: "memory"); SBAR();                 \
        o[d0] = __builtin_amdgcn_mfma_f32_32x32x16_bf16(pa0, (bf16x8){l0[0], l0[1], l0[2], l0[3], h0[0], h0[1], h0[2], h0[3]}, o[d0], 0, 0, 0);   \
        o[d0] = __builtin_amdgcn_mfma_f32_32x32x16_bf16(pa1, (bf16x8){l1[0], l1[1], l1[2], l1[3], h1[0], h1[1], h1[2], h1[3]}, o[d0], 0, 0, 0);   \
        o[d0] = __builtin_amdgcn_mfma_f32_32x32x16_bf16(pa2, (bf16x8){l2[0], l2[1], l2[2], l2[3], h2[0], h2[1], h2[2], h2[3]}, o[d0], 0, 0, 0);   \
        o[d0] = __builtin_amdgcn_mfma_f32_32x32x16_bf16(pa3, (bf16x8){l3[0], l3[1], l3[2], l3[3], h3[0], h3[1], h3[2], h3[3]}, o[d0], 0, 0, 0); } while (0)
    PV_D0(0); PV_D0(1); PV_D0(2); PV_D0(3);
#undef PV_D0
#undef TRRD
}
template <class TIn, class TOut> struct BlockRef { const TIn* Q; const TIn* K; const TIn* V; TOut* O; const float* C; int P0, jlo; float mref; };
template <class TIn> struct Seam {
    bf16x8 qr[8];
    bf16x8 st_v0, st_v1, st_k0, st_k1; f32x4 sf0, sf1, sf2, sf3;
    float cq, st_c;
    f32x4 tq[16];
};
__device__ __forceinline__ int swa_jlo(int P0, int W) { const int lowk = P0 - W + 1; return lowk > 0 ? lowk / KVBLK : 0; }
#define ROW(p, k0, rr) ((p) + (size_t)((k0) + (rr)) * LDQ + sc)
#define VMW() asm volatile("s_waitcnt vmcnt(0)" ::: "memory")
#define VMWN(n) asm volatile("s_waitcnt vmcnt(%0)" :: "i"(n) : "memory")
#define SLOAD_H(Kp, Vp, Cp, k0) do { S.st_v0 = load8<TIn>(ROW(Vp, k0, sr)); S.st_v1 = load8<TIn>(ROW(Vp, k0, 32 + sr));              \
                         S.st_k0 = load8<TIn>(ROW(Kp, k0, sr)); S.st_k1 = load8<TIn>(ROW(Kp, k0, 32 + sr)); S.st_c = (Cp)[(k0) + (tid & 63)]; } while (0)
#define SWRITE_HK(bf) do { *(bf16x8*)(K_lds + (bf) * SHM_K + kws) = S.st_k0; *(bf16x8*)(K_lds + (bf) * SHM_K + kws + 32 * 256) = S.st_k1; \
                           if (tid < 64) cbw[(bf) * 64 + tid] = S.st_c; } while (0)
#define SWRITE_HV(bf) do { *(bf16x8*)(V_lds + (bf) * SHM_V + vst0) = S.st_v0; *(bf16x8*)(V_lds + (bf) * SHM_V + vst1) = S.st_v1; } while (0)
#define SWRITE_H(bf) do { SWRITE_HV(bf); SWRITE_HK(bf); } while (0)
#define SLOAD_F(p, k0) do { S.sf0 = *(const f32x4*)ROW(p, k0, sr); S.sf1 = *(const f32x4*)(ROW(p, k0, sr) + 4);                \
                            S.sf2 = *(const f32x4*)ROW(p, k0, 32 + sr); S.sf3 = *(const f32x4*)(ROW(p, k0, 32 + sr) + 4); } while (0)
#define SWRITE_KF(bf) do { *(bf16x8*)(K_lds + (bf) * SHM_K + kws) = pack8(S.sf0, S.sf1); *(bf16x8*)(K_lds + (bf) * SHM_K + kws + 32 * 256) = pack8(S.sf2, S.sf3); } while (0)
#define SWRITE_VF(bf) do { *(bf16x8*)(V_lds + (bf) * SHM_V + vst0) = pack8(S.sf0, S.sf1); *(bf16x8*)(V_lds + (bf) * SHM_V + vst1) = pack8(S.sf2, S.sf3); } while (0)
template <class TIn, class TOut>
__device__ __forceinline__ void causal_swa_prime(const BlockRef<TIn, TOut>& cur, int W, char* lds, Seam<TIn>& S) {
    constexpr bool F32 = same_t<TIn, float>::v;
    const int tid = threadIdx.x, wid = __builtin_amdgcn_readfirstlane(tid >> 6), lane = tid & 63, r32 = lane & 31, hi = lane >> 5;
    const int sr = tid >> 4, sc = (tid & 15) * 8, kws = KSWZ(sr, sc * 2); char* K_lds = lds + 2 * SHM_V; float* cbw = (float*)(lds + OFF_CB);
    const int kb0 = cur.jlo * KVBLK;
    for (int d0 = 0; d0 < 8; ++d0) S.qr[d0] = load8<TIn>(cur.Q + (size_t)(wid * QBLK + r32) * LDQ + d0 * 16 + hi * 8);
    S.cq = cur.C[cur.P0 + wid * QBLK + r32];
    if constexpr (F32) { SLOAD_F((const float*)cur.K, kb0); VMW(); SWRITE_KF(0); SBAR(); SLOAD_F((const float*)cur.V, kb0); }
    else { SLOAD_H(cur.K, cur.V, cur.C, kb0); VMW(); SWRITE_HK(0); }
    __syncthreads();
}
template <class TIn, class TOut>
__device__ __forceinline__ void causal_swa_block(const BlockRef<TIn, TOut>& cur, const BlockRef<TIn, TOut>& nxt, int skv, int W, char* lds, Seam<TIn>& S, unsigned* qhead, volatile __attribute__((address_space(3))) int* qw, bool qmore) {
    constexpr bool F32 = same_t<TIn, float>::v;
    const int tid = threadIdx.x, wid = __builtin_amdgcn_readfirstlane(tid >> 6), lane = tid & 63, r32 = lane & 31, hi = lane >> 5;
    int pop_ = 1 << 30; if (threadIdx.x == 0 && qmore) pop_ = (int)atomicAdd(qhead, 1u);
    const int j_lo = cur.jlo;
    int j_hi = (cur.P0 + QB - 1) / KVBLK + 1; if (j_hi > skv / KVBLK) j_hi = skv / KVBLK;
    const int NT = j_hi - j_lo;
    const int kbn = nxt.jlo * KVBLK;
    const int qlo = cur.P0 + wid * QBLK, qm = qlo + r32 - 4 * hi;
    char* V_lds = lds; char* K_lds = lds + 2 * SHM_V; float* cbw = (float*)(lds + OFF_CB); const float* cbt = cbw + 4 * hi; const float* Ch = cur.C;
    float* ws = (float*)(lds + 2 * SHM_V + 2 * SHM_K) + wid * 64; float* li_l = ws, * al_l = ws + 32;
    float m_reg = cur.mref, l_reg = 0; f32x16 o[4] = {};
    const int sr = tid >> 4, sc = (tid & 15) * 8, vst0 = v_st(sr, sc), vst1 = v_st(32 + sr, sc), kws = KSWZ(sr, sc * 2);
    const int vb0 = (int)(uintptr_t)V_lds + v_rd_base(lane);
    const TIn* Kh = cur.K; const TIn* Vh = cur.V;
#define RESC(a) do { (void)(a); (void)al_l; } while (0)
#define KBASE(t) ((j_lo + (t)) * KVBLK)
#define ACT(t) (KBASE(t) <= qlo + QBLK - 1 && KBASE(t) + KVBLK - 1 >= qlo - W + 1)
#define MASKT(P0_, P1_, t) do { const int kb_ = KBASE(t); if ((!SK || ACT(t)) && (kb_ + KVBLK - 1 > qlo || kb_ <= qlo + QBLK - 1 - W)) mask_tile(P0_, P1_, qm - kb_, (unsigned)W); } while (0)
    constexpr int NQL = F32 ? 16 : 9;
    constexpr bool SK = WSKIP && !F32;
#define SEAM_K0() do { VMWN(NQL); if constexpr (F32) { SWRITE_KF(0); SBAR(); SLOAD_F((const float*)nxt.V, kbn); } else { SWRITE_HK(0); } SBAR(); } while (0)
    f32x16 pA0, pA1, pB0, pB1; float mnA, mnB, alA, alB; bf16x8 pa0, pa1, pa2, pa3;
    if constexpr (F32) { VMW(); SWRITE_VF(0); SBAR(); } else { SWRITE_HV(0); SBAR(); }
    if (NT > 1) { if constexpr (F32) SLOAD_F((const float*)Kh, KBASE(1)); else SLOAD_H(Kh, Vh, Ch, KBASE(1)); }
    SBAR(); qkt<0, SK>(pA0, pA1, K_lds, r32, hi, S.qr, ACT(0), cbt, S.cq);
    if constexpr (F32) { if (NT > 1) { VMW(); SWRITE_KF(1); SBAR(); SLOAD_F((const float*)Vh, KBASE(1)); } }
    MASKT(pA0, pA1, 0); partialSM(pA0, pA1, m_reg, mnA, alA);
    if (NT > 1) { VMW(); if constexpr (F32) { SWRITE_VF(1); SBAR(); if (NT > 2) SLOAD_F((const float*)Kh, KBASE(2)); } else SWRITE_H(1); }
    if (tid == 0) qw[0] = pop_;
    __syncthreads();
#define HALF_STEP(PX0, PX1, mnX, alX, PY0, PY1, alY, t, KB, VB, SB) do {                                                      \
        SBAR(); qkt<KB, SK>(PX0, PX1, K_lds, r32, hi, S.qr, ACT(t), cbt, S.cq);                                  \
        finishSM(PY0, PY1, alY, l_reg, pa0, pa1, pa2, pa3); SBAR();                                                           \
        if ((t) + 1 < NT) { if constexpr (F32) { VMW(); SWRITE_KF(SB); SBAR(); SLOAD_F((const float*)Vh, KBASE((t) + 1)); }  \
                            else { SLOAD_H(Kh, Vh, Ch, KBASE((t) + 1)); } SBAR(); }                                           \
        pv_tile<VB, SK>(o, vb0, pa0, pa1, pa2, pa3, ACT((t) - 1)); MASKT(PX0, PX1, (t)); partialSM(PX0, PX1, m_reg, mnX, alX);                                        \
        __syncthreads();                                                                                                      \
        if ((t) + 1 < NT) { VMW(); if constexpr (F32) { SWRITE_VF(SB); SBAR(); if ((t) + 2 < NT) SLOAD_F((const float*)Kh, KBASE((t) + 2)); } \
                            else { SWRITE_H(SB); } }                                                                          \
        RESC(alX); __syncthreads(); } while (0)
    for (int t = 1; t + 1 < NT; t += 2) {
        HALF_STEP(pB0, pB1, mnB, alB, pA0, pA1, alA, t, 1, 0, 0);
        HALF_STEP(pA0, pA1, mnA, alA, pB0, pB1, alB, t + 1, 0, 1, 1);
    }
    int r32s = r32, his = hi; asm volatile("" : "+v"(r32s), "+v"(his));
    const bool even = (NT & 1) == 0;
    if (even) { SBAR(); qkt<1, SK>(pB0, pB1, K_lds, r32, hi, S.qr, ACT(NT - 1), cbt, S.cq); SBAR(); }
#define QROW(e) (nxt.Q + (size_t)(wid * QBLK + r32) * LDQ + ((e) >> 1) * 16 + hi * 8 + ((e) & 1) * 4)
    if constexpr (F32) { SLOAD_F((const float*)nxt.K, kbn); SBAR();
#pragma unroll
        for (int e = 0; e < 8; ++e) S.tq[e] = *(const f32x4*)QROW(e); }
    else { SLOAD_H(nxt.K, nxt.V, nxt.C, kbn); SBAR();
#pragma unroll
        for (int d0 = 0; d0 < 8; ++d0) S.qr[d0] = load8<TIn>(nxt.Q + (size_t)(wid * QBLK + r32s) * LDQ + d0 * 16 + his * 8);
        S.cq = nxt.C[nxt.P0 + wid * QBLK + r32s]; }
    SBAR();
    finishSM(pA0, pA1, alA, l_reg, pa0, pa1, pa2, pa3); SBAR();
    if constexpr (F32) {
#pragma unroll
        for (int e = 8; e < 16; ++e) S.tq[e] = *(const f32x4*)QROW(e); SBAR(); }
#undef QROW
    pv_tile<0, SK>(o, vb0, pa0, pa1, pa2, pa3, ACT(even ? NT - 2 : NT - 1));
    if (even) { MASKT(pB0, pB1, NT - 1); partialSM(pB0, pB1, m_reg, mnB, alB); __syncthreads(); RESC(alB);
        finishSM(pB0, pB1, alB, l_reg, pa0, pa1, pa2, pa3); SBAR(); pv_tile<1, SK>(o, vb0, pa0, pa1, pa2, pa3, ACT(NT - 1)); }
    SBAR(); SEAM_K0();
    if (his == 0) li_l[r32s] = l_reg; asm volatile("s_waitcnt lgkmcnt(0)" ::: "memory");
    float rli[16];
#pragma unroll
    for (int r = 0; r < 16; ++r) rli[r] = __builtin_amdgcn_rcpf(li_l[crow(r, his)]);
    TOut* Ow = cur.O + (size_t)(wid * QBLK) * LDO;
#pragma unroll
    for (int r = 0; r < 16; ++r) { const int orow = crow(r, his);
#pragma unroll
        for (int d0 = 0; d0 < 4; ++d0) { const float v = o[d0][r] * rli[r];
            if constexpr (same_t<TOut, float>::v) { Ow[(size_t)orow * LDO + d0 * 32 + r32] = v; }
            else { const float vn = __shfl_xor(v, 1);
                   if ((r32s & 1) == 0) *(unsigned*)(Ow + (size_t)orow * LDO + d0 * 32 + r32s) = cvtpk(v, vn); } } }
    if constexpr (F32) {
#pragma unroll
        for (int d0 = 0; d0 < 8; ++d0) S.qr[d0] = pack8(S.tq[2 * d0], S.tq[2 * d0 + 1]); }
    __syncthreads();
#undef RESC
#undef KBASE
#undef ACT
#undef MASKT
#undef SEAM_K0
#undef HALF_STEP
}
#undef ROW
#undef VMW
#undef VMWN
#undef SLOAD_H
#undef SWRITE_HK
#undef SWRITE_HV
#undef SWRITE_H
#undef SLOAD_F
#undef SWRITE_KF
#undef SWRITE_VF


constexpr int QB2 = 128, NQB2 = SQ / QB2, SHM_V2 = 2 * SHM_V;
constexpr int P_OFF_K = 2 * SHM_V2, P_OFF_X = P_OFF_K + 2 * SHM_K, PAIR_RING = P_OFF_X + 2 * NW * 2048;
constexpr int P_OFF_L = PAIR_RING + 2048, P_OFF_CB = P_OFF_L + NW * 64 * 4, PAIR_LDS = P_OFF_CB + 2 * 64 * 4;
struct PRef { const bf16* Q; const bf16* K; const bf16* V; bf16* O; const float* C; int P0, jlo; float mref; };
template <int BUF, int NV>
__device__ __forceinline__ void pair_pv(f32x16* o, int vb0, bf16x8 pa0, bf16x8 pa1, bf16x8 pa2, bf16x8 pa3) {
#define TRRD(dst, off) asm volatile("ds_read_b64_tr_b16 %0, %1 offset:%2" : "=&v"(dst) : "v"(vb0), "i"(off) : "memory")
#define PV_D0(d0) do { s16x4 l0, l1, l2, l3, h0, h1, h2, h3; constexpr int b_ = BUF * SHM_V2 + v_rd_off(d0, 0, 0); \
        TRRD(l0, b_); TRRD(h0, b_ + 2048); TRRD(l1, b_ + 4096); TRRD(h1, b_ + 6144); TRRD(l2, b_ + 8192); TRRD(h2, b_ + 10240); TRRD(l3, b_ + 12288); TRRD(h3, b_ + 14336); \
        asm volatile("s_waitcnt lgkmcnt(0)" ::: "memory"); SBAR(); \
        o[d0] = __builtin_amdgcn_mfma_f32_32x32x16_bf16(pa0, (bf16x8){l0[0], l0[1], l0[2], l0[3], h0[0], h0[1], h0[2], h0[3]}, o[d0], 0, 0, 0); \
        o[d0] = __builtin_amdgcn_mfma_f32_32x32x16_bf16(pa1, (bf16x8){l1[0], l1[1], l1[2], l1[3], h1[0], h1[1], h1[2], h1[3]}, o[d0], 0, 0, 0); \
        o[d0] = __builtin_amdgcn_mfma_f32_32x32x16_bf16(pa2, (bf16x8){l2[0], l2[1], l2[2], l2[3], h2[0], h2[1], h2[2], h2[3]}, o[d0], 0, 0, 0); \
        o[d0] = __builtin_amdgcn_mfma_f32_32x32x16_bf16(pa3, (bf16x8){l3[0], l3[1], l3[2], l3[3], h3[0], h3[1], h3[2], h3[3]}, o[d0], 0, 0, 0); } while (0)
    PV_D0(0); PV_D0(1); if constexpr (NV == 4) { PV_D0(2); PV_D0(3); }
#undef PV_D0
#undef TRRD
}
struct PStage { bf16x8 k0, k1, v0, v1, v2, v3; float c; };
template <int NV>
__device__ __forceinline__ void pair_block(const PRef& B, char* lds, volatile __attribute__((address_space(3))) unsigned* PROFW) {
    PROF_T0(2);
    PROF_T0(8);
    const int tid = threadIdx.x, wid = __builtin_amdgcn_readfirstlane(tid >> 6), lane = tid & 63, r32 = lane & 31, hi = lane >> 5, pr = wid & 3, kh = wid >> 2;
    char* V_lds = lds; char* K_lds = lds + P_OFF_K; char* X_lds = lds + P_OFF_X; float* L_lds = (float*)(lds + P_OFF_L); float* cbw = (float*)(lds + P_OFF_CB);
    const int j_lo = B.jlo, NT = (B.P0 >> 6) + 2 - j_lo;
    const int sr = tid >> 4, sc = (tid & 15) * 8, vst0 = v_st(sr, sc), vst1 = v_st(32 + sr, sc), kws = KSWZ(sr, sc * 2);
    const int vb0 = (int)(uintptr_t)V_lds + kh * (NV == 4 ? SHM_V : 1024) + v_rd_base(lane);
    int ka[4];
#pragma unroll
    for (int dd = 0; dd < 4; ++dd) ka[dd] = (int)(uintptr_t)K_lds + kh * (32 * 256) + KSWZ(r32, (dd * 16 + hi * 8) * 2);
    constexpr float C2 = 1.4426950408889634f * SCALE;
    const float mnL = -B.mref * C2;
    const int qrow = B.P0 + pr * 32 + r32;
    bf16x8 qr[8];
#pragma unroll
    for (int d0 = 0; d0 < 8; ++d0) qr[d0] = load8<bf16>(B.Q + (size_t)(pr * 32 + r32) * LDQ + d0 * 16 + hi * 8);
    const float cq = B.C[qrow];
    f32x16 o[NV] = {}; float l_reg = 0.f;
    PStage stA, stB;
#define TCL(t) ((t) < NT ? (t) : NT - 1)
#define PLOADK(st, t) do { const int k0_ = (j_lo + TCL(t)) * KVBLK; const bf16* kp_ = B.K + (size_t)(k0_ + sr) * LDQ + sc; st.k0 = load8<bf16>(kp_); st.k1 = load8<bf16>(kp_ + (size_t)32 * LDQ); st.c = B.C[k0_ + (tid & 63)]; } while (0)
#define PLOADV(st, t) do { const int k0_ = (j_lo + TCL(t)) * KVBLK; const bf16* vp_ = B.V + (size_t)(k0_ + sr) * LDQ + sc; st.v0 = load8<bf16>(vp_); st.v1 = load8<bf16>(vp_ + (size_t)32 * LDQ); \
        if constexpr (NV == 4) { st.v2 = load8<bf16>(vp_ + 128); st.v3 = load8<bf16>(vp_ + (size_t)32 * LDQ + 128); } } while (0)
#define PWRITEK(st, bf) do { *(bf16x8*)(K_lds + (bf) * SHM_K + kws) = st.k0; *(bf16x8*)(K_lds + (bf) * SHM_K + kws + 32 * 256) = st.k1; if (tid < 64) cbw[(bf) * 64 + tid] = st.c; } while (0)
#define PWRITEV(st, bf) do { *(bf16x8*)(V_lds + (bf) * SHM_V2 + vst0) = st.v0; *(bf16x8*)(V_lds + (bf) * SHM_V2 + vst1) = st.v1; \
        if constexpr (NV == 4) { *(bf16x8*)(V_lds + (bf) * SHM_V2 + SHM_V + vst0) = st.v2; *(bf16x8*)(V_lds + (bf) * SHM_V2 + SHM_V + vst1) = st.v3; } } while (0)
#define KRD_(dst, d0, KB) asm volatile("ds_read_b128 %0, %1 offset:%2" : "=&v"(dst) : "v"(ka[(d0) & 3]), "i"((KB) * SHM_K + ((d0) >> 2) * 128) : "memory")
#define KWT_(n, r) asm volatile("s_waitcnt lgkmcnt(" #n ")" : "+v"(r) :: "memory")
#define ASTAGE(t, KB, XB) do { \
        f32x16 p; { const f32x4* c4 = (const f32x4*)(cbw + (KB) * 64 + 32 * kh + 4 * hi); \
            _Pragma("unroll") for (int g = 0; g < 4; ++g) { const f32x4 a = c4[2 * g]; _Pragma("unroll") for (int i = 0; i < 4; ++i) p[4 * g + i] = cq - a[i]; } } \
        { bf16x8 kf0, kf1, kf2, kf3;     \
          KRD_(kf0, 0, KB); KRD_(kf1, 1, KB); KRD_(kf2, 2, KB); KRD_(kf3, 3, KB); \
          KWT_(3, kf0); p = __builtin_amdgcn_mfma_f32_32x32x16_bf16(kf0, qr[0], p, 0, 0, 0); KRD_(kf0, 4, KB); \
          KWT_(3, kf1); p = __builtin_amdgcn_mfma_f32_32x32x16_bf16(kf1, qr[1], p, 0, 0, 0); KRD_(kf1, 5, KB); \
          KWT_(3, kf2); p = __builtin_amdgcn_mfma_f32_32x32x16_bf16(kf2, qr[2], p, 0, 0, 0); KRD_(kf2, 6, KB); \
          KWT_(3, kf3); p = __builtin_amdgcn_mfma_f32_32x32x16_bf16(kf3, qr[3], p, 0, 0, 0); KRD_(kf3, 7, KB); \
          KWT_(3, kf0); p = __builtin_amdgcn_mfma_f32_32x32x16_bf16(kf0, qr[4], p, 0, 0, 0); \
          KWT_(2, kf1); p = __builtin_amdgcn_mfma_f32_32x32x16_bf16(kf1, qr[5], p, 0, 0, 0); \
          KWT_(1, kf2); p = __builtin_amdgcn_mfma_f32_32x32x16_bf16(kf2, qr[6], p, 0, 0, 0); \
          KWT_(0, kf3); p = __builtin_amdgcn_mfma_f32_32x32x16_bf16(kf3, qr[7], p, 0, 0, 0); } \
        { const int kb = (j_lo + (t)) * KVBLK + 32 * kh; if (kb + 31 > B.P0 + pr * 32) { const int dq = qrow - kb - 4 * hi; const float NEG = -__builtin_inff(); \
            _Pragma("unroll") for (int r = 0; r < 16; ++r) { const int c = (r & 3) + 8 * (r >> 2); if (dq - c < 0) p[r] = NEG; } } } \
        _Pragma("unroll") for (int r = 0; r < 16; ++r) p[r] = __builtin_amdgcn_exp2f(fmaf(p[r], C2, mnL)); \
        { float ps = 0.f; _Pragma("unroll") for (int r = 0; r < 16; ++r) ps += p[r]; \
          auto rr = __builtin_amdgcn_permlane32_swap(__float_as_uint(ps), __float_as_uint(ps), false, false); l_reg += __uint_as_float(rr[0]) + __uint_as_float(rr[1]); } \
        { unsigned a0 = cvtpk(p[0], p[1]), a1 = cvtpk(p[2], p[3]), b0 = cvtpk(p[4], p[5]), b1 = cvtpk(p[6], p[7]); \
          auto r0 = __builtin_amdgcn_permlane32_swap(a0, b0, false, false); auto r1 = __builtin_amdgcn_permlane32_swap(a1, b1, false, false); u32x4 w = {r0[0], r1[0], r0[1], r1[1]}; \
          *(u32x4*)(X_lds + (XB) * (NW * 2048) + wid * 2048 + lane * 16) = w; } \
        { unsigned a0 = cvtpk(p[8], p[9]), a1 = cvtpk(p[10], p[11]), b0 = cvtpk(p[12], p[13]), b1 = cvtpk(p[14], p[15]); \
          auto r0 = __builtin_amdgcn_permlane32_swap(a0, b0, false, false); auto r1 = __builtin_amdgcn_permlane32_swap(a1, b1, false, false); u32x4 w = {r0[0], r1[0], r0[1], r1[1]}; \
          *(u32x4*)(X_lds + (XB) * (NW * 2048) + wid * 2048 + 1024 + lane * 16) = w; } } while (0)
#define BSTAGE(VB, XB) do { const char* xo_ = X_lds + (XB) * (NW * 2048) + wid * 2048 + lane * 16; const char* xp_ = X_lds + (XB) * (NW * 2048) + (wid ^ 4) * 2048 + lane * 16; \
        const bf16x8 own0 = *(const bf16x8*)xo_, own1 = *(const bf16x8*)(xo_ + 1024), oth0 = *(const bf16x8*)xp_, oth1 = *(const bf16x8*)(xp_ + 1024); \
        pair_pv<VB, NV>(o, vb0, kh ? oth0 : own0, kh ? oth1 : own1, kh ? own0 : oth0, kh ? own1 : oth1); } while (0)
    PLOADK(stA, 0); PLOADV(stA, 0); PLOADK(stB, 1); PLOADV(stB, 1);
    __syncthreads();
    PWRITEK(stA, 0); PWRITEV(stA, 0);
    PLOADK(stA, 2);
    __syncthreads();
    PROF_T1(8);
    PROF_T0(9);
    ASTAGE(0, 0, 0);
    PWRITEK(stB, 1);
    PLOADV(stA, 2); PLOADK(stB, 3);
    __syncthreads();
#define PITER(t, P, SV, SK) do {     \
        BSTAGE(P, P); \
        if ((t) + 1 < NT) { ASTAGE((t) + 1, (P) ^ 1, (P) ^ 1); PWRITEV(SV, (P) ^ 1); PWRITEK(SK, P); PLOADV(SV, (t) + 3); PLOADK(SK, (t) + 4); } \
        __syncthreads(); } while (0)
    PROF_T1(9);
    PROF_T1(2);
    { PROF_T0(3);
    int t = 0;
    for (; t + 1 < NT; t += 2) { PITER(t, 0, stB, stA); PITER(t + 1, 1, stA, stB); }
    if (t < NT) PITER(t, 0, stB, stA);
    PROF_T1(3); }
    { PROF_T0(4);
    { PROF_T0(6);
    if (hi == 0) L_lds[wid * 64 + r32] = l_reg;
    __syncthreads();
    PROF_T1(6); }
    PROF_T0(7);
    if (hi == 0) L_lds[wid * 64 + 32 + r32] = l_reg + L_lds[(wid ^ 4) * 64 + r32];
    asm volatile("s_waitcnt lgkmcnt(0)" ::: "memory");
    float rli[16];
#pragma unroll
    for (int r = 0; r < 16; ++r) rli[r] = __builtin_amdgcn_rcpf(L_lds[wid * 64 + 32 + crow(r, hi)]);
    constexpr int OROW = NV * 64 + 16;
    char* ot = lds + wid * (32 * (4 * 64 + 16));
    const bool odd = (r32 & 1) != 0;
#pragma unroll
    for (int r = 0; r < 16; ++r) { const int orow = crow(r, hi);
#pragma unroll
        for (int d0 = 0; d0 < NV; d0 += 2) { const float va = o[d0][r] * rli[r], vb = o[d0 + 1][r] * rli[r];
            const float snd = odd ? va : vb;
            const float rcv = __uint_as_float((unsigned)__builtin_amdgcn_update_dpp(0, (int)__float_as_uint(snd), 0xB1, 0xF, 0xF, true));
            const unsigned pk = cvtpk(odd ? rcv : va, odd ? vb : rcv);
            *(unsigned*)(ot + orow * OROW + ((odd ? d0 + 1 : d0) * 32 + (r32 & ~1)) * 2) = pk; } }
    asm volatile("s_waitcnt lgkmcnt(0)" ::: "memory");
    PROF_T0(10);
    bf16* Ow = B.O + (size_t)(pr * 32) * LDO + kh * (NV * 32);
    constexpr int CPR = NV * 4;
#pragma unroll
    for (int i = 0; i < (32 * CPR) / 64; ++i) { const int idx = i * 64 + lane, row = idx / CPR, ch = idx % CPR;
        const u32x4 w = *(const u32x4*)(ot + row * OROW + ch * 16);
        *(u32x4*)(Ow + (size_t)row * LDO + ch * 8) = w; }
    PROF_T1(10);
    PROF_T1(7);
    PROF_T1(4); }
#undef TCL
#undef PLOADK
#undef PLOADV
#undef PWRITEK
#undef PWRITEV
#undef KRD_
#undef KWT_
#undef ASTAGE
#undef BSTAGE
#undef PITER
}

constexpr float SKIP_T = 20.f;
constexpr int NDIFF = 16 * NQB2, NFOX = 16 * NQB2;
struct Tensors { const bf16* QKV; bf16* A2; bf16* DT; const float* BIAS; const unsigned* NRM; };
__host__ __device__ constexpr int est_diff(int h, int qb2) { const int full = 2 * (qb2 + 1), cap = h == 0 ? 12 : (h == 1 ? 24 : (h == 2 ? 62 : 128)); return full < cap ? full : cap; }
__host__ __device__ constexpr int est_fox(int qb2) { const int full = 2 * (qb2 + 1); return full < 20 ? full : 20; }
struct OrderTab2 { unsigned short v[NDIFF]; };
template <bool FOX> __host__ __device__ constexpr OrderTab2 make_order2() {
    OrderTab2 t{}; int start[130] = {};
    for (int pp = 0; pp < 16; ++pp) for (int qb = 0; qb < NQB2; ++qb) start[128 - (FOX ? est_fox(qb) : est_diff((pp >> 1) & 3, qb)) + 1]++;
    for (int i = 1; i < 130; ++i) start[i] += start[i - 1];
    for (int pp = 0; pp < 16; ++pp) for (int qb = NQB2 - 1; qb >= 0; --qb) { const int b = 128 - (FOX ? est_fox(qb) : est_diff((pp >> 1) & 3, qb)); t.v[start[b]++] = (unsigned short)(pp * 64 + qb); }
    return t;
}
__device__ const OrderTab2 ORDER_D = make_order2<false>();
__device__ const OrderTab2 ORDER_F = make_order2<true>();
constexpr int ORD_OFF = PAIR_LDS, NRMW_OFF = ORD_OFF + NDIFF * 2;
template <bool FOX>
__device__ __forceinline__ PRef make_pref(const Tensors& T, const char* lds, int o, int lane) {
    const int code = __builtin_amdgcn_readfirstlane((int)((const unsigned short*)(lds + ORD_OFF))[o]), pp = code >> 6, qb = code & 63, b = pp >> 3;
    PRef r; int sq, sk;
    const bf16* base = T.QKV + (size_t)b * S * LDQ; r.P0 = qb * QB2;
    if (FOX) { const int h = pp & 7; r.Q = base + (size_t)qb * QB2 * LDQ + C_FQ + h * 128; r.K = base + C_FK + h * 128; r.V = base + C_FV + h * 128; sq = h; sk = 8 + h;
        r.O = T.A2 + ((size_t)b * S + (size_t)qb * QB2) * LDO + h * 128; r.C = T.BIAS + (size_t)(b * 8 + h) * S; }
    else { const int h = (pp >> 1) & 3, mp = pp & 1; r.Q = base + (size_t)qb * QB2 * LDQ + C_DQ + h * 256 + mp * 128; r.K = base + C_DK + h * 256 + mp * 128; r.V = base + C_DV + h * 256; sq = 16 + 2 * h + mp; sk = 24 + 2 * h + mp;
        r.O = T.DT + ((size_t)b * S + (size_t)qb * QB2) * LDO + h * 512 + mp * 256; r.C = T.BIAS + (size_t)(16 + h) * S; }
    const int jd = r.P0 >> 6;
    int ln = lane; asm volatile("" : "+v"(ln));
    const int j0 = ln < jd ? ln : jd, j1 = ln + 64 < jd ? ln + 64 : jd;
    const float cp = r.C[r.P0], c0 = r.C[64 * j0 + 63], c1 = r.C[64 * j1 + 63];
    const float nq = ((const float*)(lds + NRMW_OFF))[b * 32 + sq], nk = ((const float*)(lds + NRMW_OFF))[b * 32 + sk];
    const float qk = 1.015f * sqrtf(nq * nk);
    const float th = (SKIP_T + 2.f * qk * SCALE) * (1.0f / SCALE), lim = cp + th; r.mref = qk;
    const bool k0 = (ln >= jd) | (c0 <= lim), k1 = (ln + 64 >= jd) | (c1 <= lim);
    const unsigned long long b0 = __ballot(k0), b1 = __ballot(k1);
    r.jlo = b0 ? (int)__builtin_ctzll(b0) : 64 + (int)__builtin_ctzll(b1);
    return r;
}
template <bool FOX>
__device__ __forceinline__ void attn_part(char* lds, const Tensors& T, unsigned* head, volatile __attribute__((address_space(3))) int* qw) {
    volatile __attribute__((address_space(3))) unsigned* PROFW = (volatile __attribute__((address_space(3))) unsigned*)(qw + 8);
    PROF_T0(5);
    const int tid = threadIdx.x, lane = tid & 63;
    if (tid == 0) qw[0] = (int)atomicAdd(head, 1u);
    ((unsigned*)(lds + ORD_OFF))[tid] = ((const unsigned*)(FOX ? ORDER_F.v : ORDER_D.v))[tid];
    if (tid < 64) ((unsigned*)(lds + NRMW_OFF))[tid] = T.NRM[tid];
    __syncthreads();
    int k = __builtin_amdgcn_readfirstlane(qw[0]);
    while (k < NDIFF) {
        int kn = 0; if (tid == 0) kn = (int)atomicAdd(head, 1u);
        PROF_T0(1);
        const PRef B = make_pref<FOX>(T, lds, k, lane);
        PROF_T1(1);
        pair_block<FOX ? 2 : 4>(B, lds, PROFW);
        if (tid == 0) qw[1] = kn;
        __syncthreads();
        k = __builtin_amdgcn_readfirstlane(qw[1]);
    }
    __syncthreads();
    PROF_T1(5);
}
#undef KSWZ
#undef SBAR
}

#define GAS __attribute__((address_space(1)))
#define LAS __attribute__((address_space(3)))
typedef unsigned short bf16;
typedef unsigned v4u __attribute__((ext_vector_type(4)));
typedef float f32x4 __attribute__((ext_vector_type(4)));
typedef short bf16x8 __attribute__((ext_vector_type(8)));
typedef GAS unsigned gu32;
typedef GAS unsigned long long gu64;
#define RLX_AGENT __ATOMIC_RELAXED, __HIP_MEMORY_SCOPE_AGENT
#define LDS_WAIT() asm volatile("s_waitcnt lgkmcnt(0)" ::: "memory")
#define VM_WAIT() asm volatile("s_waitcnt vmcnt(0)" ::: "memory")
__device__ __forceinline__ unsigned long long rt() { return __builtin_amdgcn_s_memrealtime(); }
__device__ __forceinline__ unsigned f2bf(float f) { unsigned u = __builtin_bit_cast(unsigned, f); return (u + 0x7fffu + ((u >> 16) & 1u)) >> 16; }
__device__ __forceinline__ unsigned pk2(float lo, float hi) { return f2bf(lo) | (f2bf(hi) << 16); }

#define XB_TMO      128
#define XB_XCNT(j)  (256  + 64 * (j))
#define XB_XSUB(j)  (1280 + 64 * (j))
#define XB_XGEN(j)  (2304 + 64 * (j))
#define XB_TOP      3328
#define XB_TOPGEN   3392
#define XCD_BAR_WORDS 3456
#define XB_SPIN_CAP (1u << 18)

__device__ __forceinline__ unsigned xb_ld(unsigned* p)              { return __hip_atomic_load(p, __ATOMIC_RELAXED, __HIP_MEMORY_SCOPE_AGENT); }
__device__ __forceinline__ unsigned xb_add(unsigned* p, unsigned v) { return __hip_atomic_fetch_add(p, v, __ATOMIC_RELAXED, __HIP_MEMORY_SCOPE_AGENT); }
__device__ __forceinline__ unsigned xb_xcc_id() { return (unsigned)__builtin_amdgcn_s_getreg((3 << 11) | 20) & 0xFu; }
#define XB_SPIN(cond, bar) do { unsigned _sp = 0; while (cond) { __builtin_amdgcn_s_sleep(1); \
    if ((++_sp & 255u) == 0u) { if (xb_ld(&(bar)[XB_TMO])) break; if (_sp > XB_SPIN_CAP) { atomicAdd(&(bar)[XB_TMO], 1u); break; } } } } while (0)

struct XcdBarrier {
    unsigned* bar; unsigned x;
    volatile LAS unsigned* st;
};

__device__ __forceinline__ XcdBarrier xcd_barrier_post(unsigned* bar, volatile LAS unsigned* st) {
    XcdBarrier b; b.bar = bar; b.x = xb_xcc_id(); b.st = st;
    if (threadIdx.x == 0) (void)xb_add(&bar[XB_XCNT(b.x)], 1u);
    return b;
}
__device__ __forceinline__ void xcd_barrier_complete(unsigned* bar, unsigned x, unsigned& nloc, unsigned& nx) {
    const unsigned G = gridDim.x * gridDim.y * gridDim.z;
    unsigned sum, cnt, mine, sp = 0u;
    for (;;) {
        sum = 0u; cnt = 0u; mine = 0u;
#pragma unroll
        for (unsigned j = 0; j < 16; ++j) { const unsigned c = xb_ld(&bar[XB_XCNT(j)]); sum += c; cnt += (c > 0u) ? 1u : 0u; mine = (j == x) ? c : mine; }
        if (sum == G) break;
        __builtin_amdgcn_s_sleep(1);
        if ((++sp & 255u) == 0u) { if (xb_ld(&bar[XB_TMO])) break; if (sp > XB_SPIN_CAP) { atomicAdd(&bar[XB_TMO], 1u); break; } }
    }
    nloc = mine > 0u ? mine : 1u; nx = cnt > 0u ? cnt : 1u;
}

__device__ __forceinline__ void xcd_barrier(const XcdBarrier& b) {
    asm volatile("s_waitcnt vmcnt(0)" ::: "memory");
    __syncthreads();
    if (threadIdx.x == 0) {
        unsigned* bar = b.bar;
        __builtin_amdgcn_s_waitcnt(0);
        unsigned nloc = b.st[0], nx = b.st[1];
        if (nloc == 0u) { xcd_barrier_complete(bar, b.x, nloc, nx); b.st[0] = nloc; b.st[1] = nx; }
        const unsigned old = xb_add(&bar[XB_XSUB(b.x)], 1u);
        const unsigned gen = old / nloc;
        if (old + 1u == (gen + 1u) * nloc) {
            __builtin_amdgcn_fence(__ATOMIC_RELEASE, "agent");
            asm volatile("s_waitcnt vmcnt(0)" ::: "memory");
            const unsigned og = xb_add(&bar[XB_TOP], 1u);
            const unsigned tg = og / nx;
            if (og + 1u == (tg + 1u) * nx) xb_add(&bar[XB_TOPGEN], 1u);
            else XB_SPIN(xb_ld(&bar[XB_TOPGEN]) == tg, bar);
            __builtin_amdgcn_fence(__ATOMIC_ACQUIRE, "agent");
            xb_add(&bar[XB_XGEN(b.x)], 1u);
            asm volatile("s_waitcnt vmcnt(0)" ::: "memory");
        } else {
            XB_SPIN(xb_ld(&bar[XB_XGEN(b.x)]) == gen, bar);
            __builtin_amdgcn_fence(__ATOMIC_ACQUIRE, "agent");
            asm volatile("s_waitcnt vmcnt(0)" ::: "memory");
        }
    }
    __syncthreads();
}

constexpr int NWAVES = 8;
constexpr int RING_OFF = 0, RING_BYTES = 131072;
constexpr int LDSCTL_OFF = RING_BYTES, MISC_OFF = LDSCTL_OFF + 320;
constexpr int SEG_OFF = LDSCTL_OFF + 1024;
constexpr int TILE_E_OFF = LDSCTL_OFF + 2048;
constexpr int TILE_RB_OFF = TILE_E_OFF + 1024;
constexpr int ECAP = M;
constexpr int NRMP_OFF = LDSCTL_OFF + 4096;
constexpr int LDS_BYTES = 147456;
constexpr int ATT_QW_OFF = LDSCTL_OFF + 512;
static_assert(att::PAIR_RING == RING_BYTES && att::PAIR_LDS <= LDS_BYTES && att::P_OFF_L >= ATT_QW_OFF + 64 && att::LDS_BYTES <= RING_BYTES && TILE_E_OFF + NTILE_MAX * 4 <= LDS_BYTES, "LDS map");

struct Args { const float* in[19]; float* out; unsigned char* ws; int ph_lo, ph_hi, li, pad; };

struct Ctx {
    LAS unsigned char* lds; int tid, lane, wave, G, gw, NGW;
    const float *x, *attn_g, *w_in, *fbias, *lq1, *lk1, *lq2, *lk2, *subg, *w_out, *ffn_g, *wg, *bg, *we, *be, *wgate, *wup, *wdown, *fin_g;
    float* out;
    bf16* A1; bf16* WIN; bf16* WOUT; float* BIAS; bf16* QKV; bf16* A2; bf16* DT; bf16* H1;
    int* tok_e; int* tok_pos; float* tok_gate; float* rstd; float* rowgate; int* rowtok; int* etok; float* egate; float* WR; bf16* XG; bf16* HB; bf16* Y; bf16* WGU; bf16* WD; unsigned* cnt; unsigned* nrm;
};
__device__ __forceinline__ float wave_sum(float v) {
#pragma unroll
    for (int o = 1; o < 64; o <<= 1) v += __shfl_xor(v, o);
    return v;
}
typedef unsigned v2u __attribute__((ext_vector_type(2)));

__device__ __forceinline__ void p0_row(const Ctx& C, int t, const LAS float* wf) {
    const int lane = C.lane; const float* xr = C.x + (size_t)t * DM;
    f32x4 v[8]; float ss = 0.f;
#pragma unroll
    for (int j = 0; j < 8; ++j) { v[j] = *(const f32x4*)(xr + j * 256 + lane * 4); ss += (v[j].x * v[j].x + v[j].y * v[j].y) + (v[j].z * v[j].z + v[j].w * v[j].w); }
    const float r = 1.f / sqrtf(wave_sum(ss) * (1.f / DM) + 1e-6f);
    float fl[8] = {0.f, 0.f, 0.f, 0.f, 0.f, 0.f, 0.f, 0.f};
#pragma unroll
    for (int j = 0; j < 8; ++j) {
        const f32x4 gg = *(const f32x4*)(C.attn_g + j * 256 + lane * 4);
        v[j] = v[j] * r * gg;
        v2u o; o.x = pk2(v[j].x, v[j].y); o.y = pk2(v[j].z, v[j].w);
        *(v2u*)(C.A1 + (size_t)t * DM + j * 256 + lane * 4) = o;
#pragma unroll
        for (int h = 0; h < 8; ++h) { const f32x4 w4 = *(const LAS f32x4*)(wf + h * DM + j * 256 + lane * 4); fl[h] += (v[j].x * w4.x + v[j].y * w4.y) + (v[j].z * w4.z + v[j].w * w4.w); }
        asm volatile("" ::: "memory");
    }
#pragma unroll
    for (int h = 0; h < 8; ++h) fl[h] = wave_sum(fl[h]);
    float z = fl[0];
#pragma unroll
    for (int h = 1; h < 8; ++h) z = (lane == h) ? fl[h] : z;
    if (lane < 8) { z += C.fbias[lane]; const float ls = fminf(z, 0.f) - log1pf(expf(-fabsf(z)));
        C.BIAS[(size_t)((t / S) * 8 + lane) * S + (t % S)] = ls; }
}
__device__ __forceinline__ void tr_item(const float* src, int ld, int k0, int c0, bf16* dst, int K, int r0, LAS float* scr, int lane) {
#pragma unroll 8
    for (int i = 0; i < 32; ++i) { const int kk = 2 * i + (lane >> 5); scr[kk * 33 + (lane & 31)] = src[(size_t)(k0 + kk) * ld + c0 + (lane & 31)]; }
    LDS_WAIT(); asm volatile("" ::: "memory");
    const int c = lane & 7;
#pragma unroll
    for (int j = 0; j < 4; ++j) { const int n = (lane >> 3) + 8 * j; const LAS float* s = scr + (8 * c) * 33 + n;
        v4u o; o.x = pk2(s[0 * 33], s[1 * 33]); o.y = pk2(s[2 * 33], s[3 * 33]); o.z = pk2(s[4 * 33], s[5 * 33]); o.w = pk2(s[6 * 33], s[7 * 33]);
        *(GAS v4u*)(dst + (size_t)(r0 + n) * K + k0 + 8 * c) = o; }
    LDS_WAIT(); asm volatile("" ::: "memory");
}
__device__ __forceinline__ void p0_prologue(const Ctx& C) {
    LAS float* scr = (LAS float*)(C.lds + RING_OFF + C.wave * 16384);
    constexpr int I_WIN = 32 * 192, I_WOUT = 32 * 64, I_ALL = I_WIN + I_WOUT;
    for (int it = C.gw; it < I_ALL; it += C.NGW) {
        int r = it;
        if (r < I_WIN) { const int kb = r / 192, nb = r % 192; tr_item(C.w_in, NCOL, 64 * kb, nb < 96 ? 32 * nb : 32 * nb + 8, C.WIN, DM, 32 * nb, scr, C.lane); continue; } r -= I_WIN;
        { const int kb = r / 64, nb = r % 64; tr_item(C.w_out, DM, 64 * kb, 32 * nb, C.WOUT, DM, 32 * nb, scr, C.lane); }
    }
    __syncthreads();
    { LAS float* wf = (LAS float*)(C.lds + RING_OFF);
      for (int k = C.tid; k < DM; k += NWAVES * 64) { const float* wr = C.w_in + (size_t)k * NCOL + FCOL; const f32x4 w0 = *(const f32x4*)wr, w1 = *(const f32x4*)(wr + 4);
          wf[0 * DM + k] = w0.x; wf[1 * DM + k] = w0.y; wf[2 * DM + k] = w0.z; wf[3 * DM + k] = w0.w; wf[4 * DM + k] = w1.x; wf[5 * DM + k] = w1.y; wf[6 * DM + k] = w1.z; wf[7 * DM + k] = w1.w; }
      __syncthreads();
      for (int t = C.gw; t < M; t += C.NGW) p0_row(C, t, wf); }
    const int gt = C.gw * 64 + C.lane, NGT = C.NGW * 64;
    for (int i = gt; i < 4 * S; i += NGT) { const int h = i / S, s = i % S; C.BIAS[(size_t)(16 + h) * S + s] = -exp2f(-2.f * (float)(h + 1)) * (float)s * ATT_ISCALE; }
    for (int i = gt; i < 64 * 5 * 2 * 64; i += NGT) { const int ln = i & 63, hl = (i >> 6) & 1, b = (i >> 7) % 5, kk = (i >> 7) / 5, c = 16 * b + (ln & 15);
        unsigned w[4];
#pragma unroll
        for (int jp = 0; jp < 4; ++jp) { unsigned pk = 0;
#pragma unroll
            for (int q = 0; q < 2; ++q) { const int k = 32 * kk + 8 * (ln >> 4) + 2 * jp + q;
                const float v = (c < 8 ? C.wg[(size_t)k * 8 + c] : (c < 72 ? C.we[(size_t)k * NE + c - 8] : 0.f)) * C.ffn_g[k];
                const unsigned h = f2bf(v); const unsigned l = f2bf(v - __uint_as_float(h << 16));
                pk |= (hl ? l : h) << (16 * q); }
            w[jp] = pk; }
        ((v4u*)C.WR)[i] = (v4u){w[0], w[1], w[2], w[3]}; }
}
__device__ __forceinline__ void p1_cumsum(const Ctx& C) {
    if (blockIdx.x >= 16) return;
    float* p = C.BIAS + (size_t)blockIdx.x * S + C.tid * 16; LAS float* wt = (LAS float*)(C.lds + RING_OFF);
    float loc[16]; float s = 0.f;
    { const f32x4 a = *(const f32x4*)p, b = *(const f32x4*)(p + 4), c = *(const f32x4*)(p + 8), d = *(const f32x4*)(p + 12);
      loc[0] = a.x; loc[1] = a.y; loc[2] = a.z; loc[3] = a.w; loc[4] = b.x; loc[5] = b.y; loc[6] = b.z; loc[7] = b.w; loc[8] = c.x; loc[9] = c.y; loc[10] = c.z; loc[11] = c.w; loc[12] = d.x; loc[13] = d.y; loc[14] = d.z; loc[15] = d.w; }
#pragma unroll
    for (int i = 0; i < 16; ++i) { s += loc[i]; loc[i] = s; }
    float inc = s;
#pragma unroll
    for (int o = 1; o < 64; o <<= 1) { const float q = __shfl_up(inc, o); if (C.lane >= o) inc += q; }
    if (C.lane == 63) wt[C.wave] = inc;
    __syncthreads();
    float base = inc - s;
    for (int w = 0; w < C.wave; ++w) base += wt[w];
#pragma unroll
    for (int i = 0; i < 16; ++i) loc[i] = (base + loc[i]) * ATT_ISCALE;
    *(f32x4*)p = (f32x4){loc[0], loc[1], loc[2], loc[3]}; *(f32x4*)(p + 4) = (f32x4){loc[4], loc[5], loc[6], loc[7]};
    *(f32x4*)(p + 8) = (f32x4){loc[8], loc[9], loc[10], loc[11]}; *(f32x4*)(p + 12) = (f32x4){loc[12], loc[13], loc[14], loc[15]};
    __syncthreads();
}
__device__ __forceinline__ void p_norms(const Ctx& C) {
    const int lane = C.lane, b = C.gw & 1;
    float mx[8] = {0.f, 0.f, 0.f, 0.f, 0.f, 0.f, 0.f, 0.f};
    for (int rr = C.gw >> 1; rr < S; rr += C.NGW >> 1) {
        const bf16* row = C.QKV + (size_t)(b * S + rr) * NQKV + 8 * lane;
#pragma unroll
        for (int i = 0; i < 8; ++i) { const v4u w = *(const v4u*)(row + (i < 4 ? 512 * i : 1024 + 512 * i));
            float ss = 0.f;
#pragma unroll
            for (int c = 0; c < 4; ++c) { const float lo = __uint_as_float(w[c] << 16), hi = __uint_as_float(w[c] & 0xffff0000u); ss += lo * lo + hi * hi; }
            ss += __shfl_xor(ss, 1); ss += __shfl_xor(ss, 2); ss += __shfl_xor(ss, 4); ss += __shfl_xor(ss, 8);
            mx[i] = fmaxf(mx[i], ss); }
    }
    if ((lane & 15) == 0) {
#pragma unroll
        for (int i = 0; i < 8; ++i) atomicMax(C.nrm + b * 32 + 4 * i + (lane >> 4), __float_as_uint(mx[i]));
    }
}
__device__ __forceinline__ void p3_combine(const Ctx& C) {
    const int lane = C.lane;
    const float s1 = wave_sum(C.lq1[lane] * C.lk1[lane] + C.lq1[lane + 64] * C.lk1[lane + 64]);
    const float s2 = wave_sum(C.lq2[lane] * C.lk2[lane] + C.lq2[lane + 64] * C.lk2[lane + 64]);
    const float lam = expf(s1) - expf(s2) + 0.2f;
    const f32x4 gg = *(const f32x4*)(C.subg + lane * 4);
    for (int idx = C.gw; idx < M * 4; idx += C.NGW) {
        const int t = idx >> 2, h = idx & 3;
        const bf16* p = C.DT + (size_t)t * DM + h * 512 + lane * 4;
        const v2u a = *(const v2u*)p, b = *(const v2u*)(p + 256);
        f32x4 d;
        d.x = __uint_as_float(a.x << 16) - lam * __uint_as_float(b.x << 16); d.y = __uint_as_float(a.x & 0xffff0000u) - lam * __uint_as_float(b.x & 0xffff0000u);
        d.z = __uint_as_float(a.y << 16) - lam * __uint_as_float(b.y << 16); d.w = __uint_as_float(a.y & 0xffff0000u) - lam * __uint_as_float(b.y & 0xffff0000u);
        const float ss = wave_sum((d.x * d.x + d.y * d.y) + (d.z * d.z + d.w * d.w));
        const float r = 0.8f / sqrtf(ss * (1.f / 256.f) + 1e-5f);
        v2u o; o.x = pk2(d.x * r * gg.x, d.y * r * gg.y); o.y = pk2(d.z * r * gg.z, d.w * r * gg.w);
        *(v2u*)(C.A2 + (size_t)t * DM + 1024 + h * 256 + lane * 4) = o;
    }
}
__device__ __forceinline__ void p5a_router(const Ctx& C) {
    const int w = C.wave, th = w & 1, ks = w >> 1;
    LAS float* R1 = (LAS float*)(C.lds + RING_OFF);
    LAS float* SS = (LAS float*)(C.lds + RING_OFF + 81920);
    LAS float* RS = SS + 512;
    LAS float* lg = (LAS float*)(C.lds + RING_OFF + 86016);
    for (int tl = (int)blockIdx.x; tl < M / 64; tl += C.G) {
        int lane = C.lane; asm volatile("" : "+v"(lane));
        const int r = lane & 15, g = lane >> 4;
        const int t0 = tl * 64;
        f32x4 acc[2][5];
#pragma unroll
        for (int T = 0; T < 2; ++T)
#pragma unroll
            for (int b = 0; b < 5; ++b) acc[T][b] = (f32x4){0.f, 0.f, 0.f, 0.f};
        float ss[2] = {0.f, 0.f};
        const bf16* hb = C.H1 + (size_t)(t0 + 32 * th) * DM + 512 * ks; const unsigned ho = (unsigned)(r * DM + 8 * g);
        const v4u* wp = (const v4u*)C.WR + (size_t)(16 * ks) * 10 * 64 + lane;
        v4u a[4][2], tb[10];
#define RT_LA(slot, j_) do { _Pragma("unroll") for (int T = 0; T < 2; ++T) a[slot][T] = *(const v4u*)(hb + (ho + (unsigned)(16 * T * DM + 32 * (j_)))); } while (0)
        RT_LA(0, 0);
#pragma unroll
        for (int q = 0; q < 10; ++q) tb[q] = wp[q * 64];
        RT_LA(1, 1); RT_LA(2, 2); RT_LA(3, 3);
#pragma unroll
        for (int j = 0; j < 16; ++j) {
            __builtin_amdgcn_sched_barrier(0);
#pragma unroll
            for (int T = 0; T < 2; ++T)
#pragma unroll
                for (int c = 0; c < 4; ++c) { const unsigned x = a[j & 3][T][c]; const float lo = __uint_as_float(x << 16), hi = __uint_as_float(x & 0xffff0000u); ss[T] += lo * lo + hi * hi; }
#pragma unroll
            for (int b = 0; b < 5; ++b) {
#pragma unroll
                for (int T = 0; T < 2; ++T) acc[T][b] = __builtin_amdgcn_mfma_f32_16x16x32_bf16(__builtin_bit_cast(bf16x8, a[j & 3][T]), __builtin_bit_cast(bf16x8, tb[2 * b]), acc[T][b], 0, 0, 0);
#pragma unroll
                for (int T = 0; T < 2; ++T) acc[T][b] = __builtin_amdgcn_mfma_f32_16x16x32_bf16(__builtin_bit_cast(bf16x8, a[j & 3][T]), __builtin_bit_cast(bf16x8, tb[2 * b + 1]), acc[T][b], 0, 0, 0);
                __builtin_amdgcn_sched_barrier(0);
                if (j + 1 < 16) { tb[2 * b] = wp[((j + 1) * 10 + 2 * b) * 64]; tb[2 * b + 1] = wp[((j + 1) * 10 + 2 * b + 1) * 64]; }
                __builtin_amdgcn_sched_barrier(0);
            }
            if (j + 4 < 16) RT_LA(j & 3, j + 4);
        }
#undef RT_LA
        asm volatile("" ::: "memory");
#pragma unroll
        for (int T = 0; T < 2; ++T) { ss[T] += __int_as_float(__builtin_amdgcn_ds_bpermute((lane ^ 16) << 2, __float_as_int(ss[T]))); ss[T] += __int_as_float(__builtin_amdgcn_ds_bpermute((lane ^ 32) << 2, __float_as_int(ss[T])));
            if (lane < 16) SS[ks * 64 + 16 * (2 * th + T) + lane] = ss[T]; }
        if (ks >= 2) {
#pragma unroll
            for (int T = 0; T < 2; ++T)
#pragma unroll
                for (int b = 0; b < 5; ++b)
#pragma unroll
                    for (int i = 0; i < 4; ++i) R1[((th * 2 + (ks - 2)) * 40 + (T * 5 + b) * 4 + i) * 64 + lane] = acc[T][b][i];
        }
        __syncthreads();
        if (ks < 2) {
#pragma unroll
            for (int T = 0; T < 2; ++T)
#pragma unroll
                for (int b = 0; b < 5; ++b)
#pragma unroll
                    for (int i = 0; i < 4; ++i) { LAS float* q = R1 + ((th * 2 + ks) * 40 + (T * 5 + b) * 4 + i) * 64 + lane; *q = acc[T][b][i] + *q; }
            if (w == 0) { const float s = (SS[lane] + SS[64 + lane]) + (SS[128 + lane] + SS[192 + lane]);
                const float rs = 1.f / sqrtf(s * (1.f / DM) + 1e-6f); RS[lane] = rs; C.rstd[t0 + lane] = rs; }
        }
        __syncthreads();
#pragma unroll
        for (int m = 0; m < 10; ++m) { const int sl = w + 8 * m, T = sl / 20, b = (sl % 20) >> 2, i = sl & 3, tok = 16 * T + 4 * g + i, s2 = sl % 40, hh = sl / 40;
            const float v = R1[((hh * 2 + 0) * 40 + s2) * 64 + lane] + R1[((hh * 2 + 1) * 40 + s2) * 64 + lane];
            lg[tok * 81 + 16 * b + r] = v * RS[tok]; }
        __syncthreads();
        if (w == 0) {
            const int t = t0 + lane; const LAS float* row = lg + lane * 81;
            float gmax = -__builtin_inff(); int gi = 0; float gl[8];
#pragma unroll
            for (int j = 0; j < 8; ++j) { gl[j] = row[j] + C.bg[j]; if (gl[j] > gmax) { gmax = gl[j]; gi = j; } }
            float gs = 0.f;
#pragma unroll
            for (int j = 0; j < 8; ++j) gs += expf(gl[j] - gmax);
            const float gprob = 1.f / gs;
            float l1 = -__builtin_inff(), l2 = -__builtin_inff(); int i1 = 0, i2 = 0;
#pragma unroll
            for (int j = 0; j < 8; ++j) { const float q = row[8 + gi * 8 + j] + C.be[gi * 8 + j];
                if (q > l1) { l2 = l1; i2 = i1; l1 = q; i1 = j; } else if (q > l2) { l2 = q; i2 = j; } }
            const float e2 = expf(l2 - l1), g1 = gprob / (1.f + e2), g2 = gprob * e2 / (1.f + e2);
            const int ea = gi * 8 + i1, eb = gi * 8 + i2;
            const unsigned pa = atomicAdd(C.cnt + ea, 1u), pb = atomicAdd(C.cnt + eb, 1u);
            C.tok_e[t * 2] = ea; C.tok_e[t * 2 + 1] = eb; C.tok_pos[t * 2] = (int)pa; C.tok_pos[t * 2 + 1] = (int)pb; C.etok[ea * ECAP + (int)pa] = t; C.etok[eb * ECAP + (int)pb] = t; C.tok_gate[t * 2] = g1; C.tok_gate[t * 2 + 1] = g2;
        }
        { asm volatile("" ::: "memory"); f32x4 gg[4][2];
#pragma unroll
            for (int j = 0; j < 4; ++j) { gg[j][0] = *(const f32x4*)(C.ffn_g + j * 512 + lane * 8); gg[j][1] = *(const f32x4*)(C.ffn_g + j * 512 + lane * 8 + 4); }
            const int r0 = w ? 9 * (w - 1) : 63, nr = w ? 9 : 1;
#pragma unroll 3
            for (int i = 0; i < nr; ++i) { const int rr = r0 + i; const float rsr = RS[rr]; const bf16* src = C.H1 + (size_t)(t0 + rr) * DM + lane * 8; bf16* dst = C.A1 + (size_t)(t0 + rr) * DM + lane * 8;
#pragma unroll
                for (int j = 0; j < 4; ++j) { const v4u x = *(const v4u*)(src + j * 512); const f32x4 g0 = gg[j][0], g1 = gg[j][1];
                    v4u o; o.x = pk2(__uint_as_float(x.x << 16) * rsr * g0.x, __uint_as_float(x.x & 0xffff0000u) * rsr * g0.y); o.y = pk2(__uint_as_float(x.y << 16) * rsr * g0.z, __uint_as_float(x.y & 0xffff0000u) * rsr * g0.w);
                    o.z = pk2(__uint_as_float(x.z << 16) * rsr * g1.x, __uint_as_float(x.z & 0xffff0000u) * rsr * g1.y); o.w = pk2(__uint_as_float(x.w << 16) * rsr * g1.z, __uint_as_float(x.w & 0xffff0000u) * rsr * g1.w);
                    *(v4u*)(dst + j * 512) = o; } } }
        __syncthreads();
    }
}
__device__ __forceinline__ void build_seg(const Ctx& C) {
    LAS int* seg = (LAS int*)(C.lds + SEG_OFF); LAS int* tile_e = (LAS int*)(C.lds + TILE_E_OFF);
    if (C.tid == 0) { int o = 0; for (int e = 0; e < NE; ++e) { seg[e] = o; o += (int)((C.cnt[e] + 255u) & ~255u); } seg[NE] = o; }
    __syncthreads();
    if (C.tid < NTILE_MAX) { const int row = C.tid * 256; int e = 0; for (int j = 1; j < NE; ++j) if (seg[j] <= row) e = j; tile_e[C.tid] = e; ((LAS int*)(C.lds + TILE_RB_OFF))[C.tid] = e * ECAP - seg[e]; }
    __syncthreads();
}
__device__ __forceinline__ void p5b_dispatch(const Ctx& C) {
    const LAS int* seg = (const LAS int*)(C.lds + SEG_OFF);
    for (int t = C.gw * 64 + C.lane; t < M; t += C.NGW * 64) {
        const int ra = seg[C.tok_e[t * 2]] + C.tok_pos[t * 2], rb = seg[C.tok_e[t * 2 + 1]] + C.tok_pos[t * 2 + 1];
        C.rowgate[ra] = C.tok_gate[t * 2]; C.rowgate[rb] = C.tok_gate[t * 2 + 1]; C.rowtok[ra] = t; C.rowtok[rb] = t;
    }
}
__device__ __forceinline__ void p8_final(const Ctx& C) {
    const LAS int* seg = (const LAS int*)(C.lds + SEG_OFF); const int lane = C.lane;
    for (int t0 = C.gw * 2; t0 < M; t0 += C.NGW * 2) {
        int ra[2], rb[2]; float ga[2], gb[2];
#pragma unroll
        for (int u = 0; u < 2; ++u) { const int t = t0 + u; ra[u] = seg[C.tok_e[t * 2]] + C.tok_pos[t * 2]; rb[u] = seg[C.tok_e[t * 2 + 1]] + C.tok_pos[t * 2 + 1]; ga[u] = C.tok_gate[t * 2]; gb[u] = C.tok_gate[t * 2 + 1]; }
        f32x4 v[2][8]; float ss[2] = {0.f, 0.f};
#pragma unroll
        for (int u = 0; u < 2; ++u) { const bf16* xr = C.H1 + (size_t)(t0 + u) * DM; const bf16* ya = C.Y + (size_t)ra[u] * DM; const bf16* yb = C.Y + (size_t)rb[u] * DM;
#pragma unroll
            for (int j = 0; j < 8; ++j) { const v2u h = *(const v2u*)(xr + j * 256 + lane * 4), a = *(const v2u*)(ya + j * 256 + lane * 4), b = *(const v2u*)(yb + j * 256 + lane * 4);
                v[u][j].x = __uint_as_float(h.x << 16) + (ga[u] * __uint_as_float(a.x << 16) + gb[u] * __uint_as_float(b.x << 16)); v[u][j].y = __uint_as_float(h.x & 0xffff0000u) + (ga[u] * __uint_as_float(a.x & 0xffff0000u) + gb[u] * __uint_as_float(b.x & 0xffff0000u));
                v[u][j].z = __uint_as_float(h.y << 16) + (ga[u] * __uint_as_float(a.y << 16) + gb[u] * __uint_as_float(b.y << 16)); v[u][j].w = __uint_as_float(h.y & 0xffff0000u) + (ga[u] * __uint_as_float(a.y & 0xffff0000u) + gb[u] * __uint_as_float(b.y & 0xffff0000u));
                ss[u] += (v[u][j].x * v[u][j].x + v[u][j].y * v[u][j].y) + (v[u][j].z * v[u][j].z + v[u][j].w * v[u][j].w); } }
#pragma unroll
        for (int u = 0; u < 2; ++u) { const float r = 1.f / sqrtf(wave_sum(ss[u]) * (1.f / DM) + 1e-6f);
#pragma unroll
            for (int j = 0; j < 8; ++j) *(f32x4*)(C.out + (size_t)(t0 + u) * DM + j * 256 + lane * 4) = v[u][j] * r * *(const f32x4*)(C.fin_g + j * 256 + lane * 4); }
    }
}

__global__ void __launch_bounds__(NWAVES * 64, 2) mk_fwd(Args args) {
    extern __shared__ __attribute__((aligned(16))) unsigned char lds[];
    Ctx C;
    C.lds = (LAS unsigned char*)lds; C.tid = threadIdx.x; C.lane = C.tid & 63; C.wave = __builtin_amdgcn_readfirstlane(C.tid >> 6);
    C.G = gridDim.x; C.gw = (int)blockIdx.x * NWAVES + C.wave; C.NGW = C.G * NWAVES;
    C.x = args.in[0]; C.attn_g = args.in[1]; C.w_in = args.in[2]; C.fbias = args.in[3]; C.lq1 = args.in[4]; C.lk1 = args.in[5]; C.lq2 = args.in[6]; C.lk2 = args.in[7];
    C.subg = args.in[8]; C.w_out = args.in[9]; C.ffn_g = args.in[10]; C.wg = args.in[11]; C.bg = args.in[12]; C.we = args.in[13]; C.be = args.in[14];
    C.wgate = args.in[15]; C.wup = args.in[16]; C.wdown = args.in[17]; C.fin_g = args.in[18]; C.out = args.out;
    unsigned char* ws = args.ws;
    C.A1 = (bf16*)(ws + WS_A1); C.WIN = (bf16*)(ws + WS_WIN); C.WOUT = (bf16*)(ws + WS_WOUT); C.BIAS = (float*)(ws + WS_BIAS); C.QKV = (bf16*)(ws + WS_QKV);
    C.A2 = (bf16*)(ws + WS_A2); C.DT = (bf16*)(ws + WS_DT); C.H1 = (bf16*)(ws + WS_H1);
    C.tok_e = (int*)(ws + WS_ROUTE); C.tok_pos = C.tok_e + 2 * M; C.tok_gate = (float*)(C.tok_pos + 2 * M); C.rstd = C.tok_gate + 2 * M; C.rowgate = C.rstd + M; C.rowtok = (int*)(C.rowgate + YROWS);
    C.etok = (int*)(ws + WS_XG); C.egate = (float*)(ws + WS_XG) + (size_t)NE * ECAP;
    C.WR = (float*)(ws + WS_WR); C.XG = (bf16*)(ws + WS_XG); C.HB = (bf16*)(ws + WS_HBUF); C.Y = (bf16*)(ws + WS_Y); C.WGU = (bf16*)(ws + WS_WGU); C.WD = (bf16*)(ws + WS_WD);
    C.cnt = (unsigned*)(ws + WS_CTL) + CW_CNT; C.nrm = (unsigned*)(ws + WS_CTL) + CW_NRM;
    volatile LAS unsigned* MISC = (volatile LAS unsigned*)(C.lds + MISC_OFF);
    for (int u = C.tid; u < (LDS_BYTES - LDSCTL_OFF) / 4; u += NWAVES * 64) ((LAS unsigned*)(C.lds + LDSCTL_OFF))[u] = 0u;
    __syncthreads();
    XcdBarrier bar = xcd_barrier_post((unsigned*)(ws + WS_CTL) + CW_BAR + args.li * XCD_BAR_WORDS, MISC + 8);
    const int lo = args.ph_lo, hi = args.ph_hi;
#define IN(k) (lo <= (k) && (k) < hi)
#define SEAM(k) do { if (IN(k) && IN((k) + 1)) xcd_barrier(bar); } while (0)
#ifndef PROBE_MASK
#define PROBE_MASK 0u
#endif
#ifndef PROBE_REP
#define PROBE_REP 0
#endif
#define TWICE(k) (((PROBE_MASK) >> (k)) & 1u)

    if (IN(0)) { p0_prologue(C); if (TWICE(0)) { xcd_barrier(bar); p0_prologue(C); } } SEAM(0);
    if (IN(1)) {
        p1_cumsum(C);
        pg8::Gemm g{C.A1, C.WIN, M, NQKV, DM}; pg8::StaticOrder So; So.init(M, NQKV, C.G, (int)blockIdx.x);
        pg8::EpiQKV E{C.QKV, NQKV, (PG8_LAS float*)(C.lds + NRMP_OFF), C.nrm};
        pg8::gemm_phase<pg8::EpiQKV, pg8::StaticOrder, true, true>(C.lds + RING_OFF, g, So, E);
        if (TWICE(1)) { xcd_barrier(bar); pg8::gemm_phase<pg8::EpiQKV, pg8::StaticOrder, true, true>(C.lds + RING_OFF, g, So, E); }
    } SEAM(1);
    if (IN(3)) { const att::Tensors T{(const att::bf16*)C.QKV, (att::bf16*)C.A2, (att::bf16*)C.DT, C.BIAS, C.nrm};
        unsigned* qh = (unsigned*)(ws + WS_CTL) + CW_QHEAD; volatile __attribute__((address_space(3))) int* qw = (volatile __attribute__((address_space(3))) int*)(C.lds + RING_OFF + ATT_QW_OFF);
        att::attn_part<false>((char*)lds + RING_OFF, T, qh, qw); att::attn_part<true>((char*)lds + RING_OFF, T, qh + 64, qw); if (TWICE(3)) { xcd_barrier(bar); att::attn_part<false>((char*)lds + RING_OFF, T, qh + 128, qw); att::attn_part<true>((char*)lds + RING_OFF, T, qh + 192, qw); } } SEAM(3);
    if (IN(4)) { p3_combine(C); if (TWICE(4)) { xcd_barrier(bar); p3_combine(C); } } SEAM(4);
    if (IN(5)) {
        pg8::Gemm g{C.A2, C.WOUT, M, DM, DM}; pg8::StaticOrder So; So.init(M, DM, C.G, (int)blockIdx.x);
        pg8::EpiResBf16 E{C.x, C.H1, DM};
        pg8::gemm_phase<pg8::EpiResBf16, pg8::StaticOrder, true, true>(C.lds + RING_OFF, g, So, E);
        if (TWICE(5)) { xcd_barrier(bar); pg8::gemm_phase<pg8::EpiResBf16, pg8::StaticOrder, true, true>(C.lds + RING_OFF, g, So, E); }
    } SEAM(5);
    if (IN(6)) { p5a_router(C); } SEAM(6);
    if (hi > 7) build_seg(C);
#ifdef PROBE_CLK
    unsigned long long ck0 = 0, cr0 = 0, ckd = 0, crd = 1;
    if (IN(PROBE_CLK)) { ck0 = __builtin_amdgcn_s_memtime(); cr0 = __builtin_amdgcn_s_memrealtime(); }
#endif
    if (IN(8)) {
        const PG8_LAS int* tile_e = (const PG8_LAS int*)(C.lds + TILE_E_OFF); const int ntile = ((const LAS int*)(C.lds + SEG_OFF))[NE] >> 8;
        #if defined(PROBE_HOT) && PROBE_HOT >= 3
        pg8::GemmW g{C.A1, DM, DFF, C.etok, args.li > 0 ? 255 : M - 1, (const PG8_LAS int*)(C.lds + TILE_RB_OFF)};
#else
        pg8::GemmW g{C.A1, DM, DFF, C.etok, M - 1, (const PG8_LAS int*)(C.lds + TILE_RB_OFF)};
#endif
        pg8::GroupedOrderW<0> So{ntile * 8, C.G, (int)blockIdx.x, tile_e, C.wgate, C.wup, args.li > 0};
        pg8::EpiSwiglu E{args.li > 0 ? C.XG : C.HB};
        pg8::gemm_phase_wf32<pg8::EpiSwiglu, pg8::GroupedOrderW<0>, true, true>(C.lds + RING_OFF, g, So, E);
    } SEAM(8);
    if (IN(9)) {
        const PG8_LAS int* tile_e = (const PG8_LAS int*)(C.lds + TILE_E_OFF); const int ntile = ((const LAS int*)(C.lds + SEG_OFF))[NE] >> 8;
        pg8::GemmW g{C.HB, DFF, DM, nullptr, 0, nullptr}; pg8::GroupedOrderW<1> So{ntile * 8, C.G, (int)blockIdx.x, tile_e, C.wdown, nullptr};
        pg8::EpiDown E{C.Y};
        pg8::gemm_phase_wf32<pg8::EpiDown, pg8::GroupedOrderW<1>, true, false>(C.lds + RING_OFF, g, So, E);
    } SEAM(9);
#ifdef PROBE_CLK
    if (IN(PROBE_CLK)) { ckd = __builtin_amdgcn_s_memtime() - ck0; crd = __builtin_amdgcn_s_memrealtime() - cr0; }
#endif
    if (IN(10)) { p8_final(C); if (TWICE(10)) { xcd_barrier(bar); p8_final(C); } }
#ifdef PROBE_CLK
    if (blockIdx.x == 0) { const unsigned long long want = ckd * 100ull / (crd ? crd : 1);
        const unsigned long long t0 = __builtin_amdgcn_s_memrealtime(); while (__builtin_amdgcn_s_memrealtime() - t0 < want) __builtin_amdgcn_s_sleep(8); }
#endif
#ifdef PROBE_NT
    if (blockIdx.x == 0) { const int ntile_ = ((const LAS int*)(C.lds + SEG_OFF))[NE] >> 8; const unsigned long long want = (unsigned long long)(ntile_ > 150 ? ntile_ - 150 : 0) * 2000ull;
        const unsigned long long t0 = __builtin_amdgcn_s_memrealtime(); while (__builtin_amdgcn_s_memrealtime() - t0 < want) __builtin_amdgcn_s_sleep(8); }
#endif
#ifdef PROF_SECT
    if (blockIdx.x == 0) { __syncthreads(); const unsigned want = ((volatile LAS unsigned*)(C.lds + ATT_QW_OFF + 32))[0]; const unsigned long long t0 = __builtin_amdgcn_s_memtime(); while (__builtin_amdgcn_s_memtime() - t0 < (unsigned long long)want) __builtin_amdgcn_s_sleep(8); }
#endif
#undef IN
#undef SEAM
#undef TWICE
}

#if NAIVE_MASK
namespace nv {
__device__ __forceinline__ float bf2f(bf16_t v) { return __uint_as_float((unsigned)v << 16); }
__device__ __forceinline__ bf16_t f2b(float f) { return (bf16_t)f2bf(f); }
__global__ void __launch_bounds__(256) k_cumsum(float* __restrict__ bias) {
    __shared__ float part[256];
    float* p = bias + (size_t)blockIdx.x * S; const int tid = threadIdx.x;
    float loc[32]; float s = 0.f;
#pragma unroll
    for (int i = 0; i < 32; ++i) { s += p[tid * 32 + i]; loc[i] = s; }
    part[tid] = s; __syncthreads();
    if (tid == 0) { float a = 0.f; for (int i = 0; i < 256; ++i) { const float q = part[i]; part[i] = a; a += q; } }
    __syncthreads();
    const float base = part[tid];
#pragma unroll
    for (int i = 0; i < 32; ++i) p[tid * 32 + i] = (base + loc[i]) * ATT_ISCALE;
}
template <class FA, class FB>
__device__ __forceinline__ void ngemm_tile(int K, FA fa, FB fb, float (&acc)[4][4], float (*As)[65], float (*Bs)[65]) {
    const int tid = threadIdx.x, tx = tid & 15, ty = tid >> 4;
#pragma unroll
    for (int r = 0; r < 4; ++r)
#pragma unroll
        for (int c = 0; c < 4; ++c) acc[r][c] = 0.f;
    for (int k0 = 0; k0 < K; k0 += 16) {
        for (int e = tid; e < 1024; e += 256) { const int i = e >> 4, kk = e & 15; As[kk][i] = fa(i, k0 + kk); Bs[kk][i] = fb(k0 + kk, i); }
        __syncthreads();
#pragma unroll
        for (int kk = 0; kk < 16; ++kk) { float a[4], b[4];
#pragma unroll
            for (int r = 0; r < 4; ++r) a[r] = As[kk][ty * 4 + r];
#pragma unroll
            for (int c = 0; c < 4; ++c) b[c] = Bs[kk][tx * 4 + c];
#pragma unroll
            for (int r = 0; r < 4; ++r)
#pragma unroll
                for (int c = 0; c < 4; ++c) acc[r][c] += a[r] * b[c]; }
        __syncthreads();
    }
}
__global__ void __launch_bounds__(256) k_inproj(const bf16_t* __restrict__ A, const bf16_t* __restrict__ Bt, bf16_t* __restrict__ Cq) {
    __shared__ float As[16][65], Bs[16][65];
    const int m0 = blockIdx.y * 64, n0 = blockIdx.x * 64; float acc[4][4];
    ngemm_tile(DM, [&](int i, int k) { return bf2f(A[(size_t)(m0 + i) * DM + k]); }, [&](int k, int j) { return bf2f(Bt[(size_t)(n0 + j) * DM + k]); }, acc, As, Bs);
    const int tx = threadIdx.x & 15, ty = threadIdx.x >> 4;
#pragma unroll
    for (int r = 0; r < 4; ++r)
#pragma unroll
        for (int c = 0; c < 4; ++c) Cq[(size_t)(m0 + ty * 4 + r) * NQKV + n0 + tx * 4 + c] = f2b(acc[r][c]);
}
__global__ void __launch_bounds__(256) k_outproj(const bf16_t* __restrict__ A, const bf16_t* __restrict__ Bt, const float* __restrict__ x, float* __restrict__ H1) {
    __shared__ float As[16][65], Bs[16][65];
    const int m0 = blockIdx.y * 64, n0 = blockIdx.x * 64; float acc[4][4];
    ngemm_tile(DM, [&](int i, int k) { return bf2f(A[(size_t)(m0 + i) * DM + k]); }, [&](int k, int j) { return bf2f(Bt[(size_t)(n0 + j) * DM + k]); }, acc, As, Bs);
    const int tx = threadIdx.x & 15, ty = threadIdx.x >> 4;
#pragma unroll
    for (int r = 0; r < 4; ++r)
#pragma unroll
        for (int c = 0; c < 4; ++c) { const size_t o = (size_t)(m0 + ty * 4 + r) * DM + n0 + tx * 4 + c; H1[o] = x[o] + acc[r][c]; }
}
__global__ void __launch_bounds__(256) k_attn(const bf16_t* __restrict__ QKV, const float* __restrict__ bias, bf16_t* __restrict__ A2, bf16_t* __restrict__ DT) {
    __shared__ bf16_t Qs[64][130];
    __shared__ float Ks[32][129];
    __shared__ float Vs[32][128];
    __shared__ float Ps[64][33];
    const int tid = threadIdx.x, r = tid >> 2, c4 = tid & 3;
    const int qb = (int)gridDim.x - 1 - (int)blockIdx.x, p = blockIdx.y;
    int b, qcol, kcol, vcol, h, map = 0, vh = 0; const float* cc; const bool fox = p < 16;
    if (fox) { b = p >> 3; h = p & 7; qcol = C_FQ + h * 128; kcol = C_FK + h * 128; vcol = C_FV + h * 128; cc = bias + ((size_t)b * 8 + h) * S; }
    else { const int q = p - 16; b = q >> 4; h = (q >> 2) & 3; map = (q >> 1) & 1; vh = q & 1; qcol = C_DQ + h * 256 + map * 128; kcol = C_DK + h * 256 + map * 128; vcol = C_DV + h * 256 + vh * 128; cc = bias + (size_t)(16 + h) * S; }
    const int q0 = qb * 64; const size_t rowb = (size_t)b * S;
    for (int e = tid; e < 64 * 128; e += 256) { const int i = e >> 7, d = e & 127; Qs[i][d] = QKV[(rowb + q0 + i) * NQKV + qcol + d]; }
    const int t = q0 + r; const float ct = cc[t];
    float m = -1e30f, l = 0.f; float o[32];
#pragma unroll
    for (int j = 0; j < 32; ++j) o[j] = 0.f;
    const int nkt = (q0 + 63) / 32 + 1;
    for (int kt = 0; kt < nkt; ++kt) {
        const int k0 = kt * 32;
        __syncthreads();
        for (int e = tid; e < 32 * 128; e += 256) { const int i = e >> 7, d = e & 127; const size_t ro = (rowb + k0 + i) * NQKV; Ks[i][d] = bf2f(QKV[ro + kcol + d]); Vs[i][d] = bf2f(QKV[ro + vcol + d]); }
        __syncthreads();
        float sc[8];
#pragma unroll
        for (int j = 0; j < 8; ++j) sc[j] = 0.f;
        for (int d = 0; d < 128; ++d) { const float qv = bf2f(Qs[r][d]);
#pragma unroll
            for (int j = 0; j < 8; ++j) sc[j] += qv * Ks[c4 * 8 + j][d]; }
        float tmax = -__builtin_inff();
#pragma unroll
        for (int j = 0; j < 8; ++j) { const int s = k0 + c4 * 8 + j; float v = (sc[j] + (ct - cc[s])) * ATT_SCALE;
            if (s > t) v = -__builtin_inff();
            sc[j] = v; tmax = fmaxf(tmax, v); }
        tmax = fmaxf(tmax, __shfl_xor(tmax, 1)); tmax = fmaxf(tmax, __shfl_xor(tmax, 2));
        const float mn = fmaxf(m, tmax), alpha = __expf(m - mn); m = mn;
        float ps = 0.f;
#pragma unroll
        for (int j = 0; j < 8; ++j) { const float pv = __expf(sc[j] - mn); ps += pv; Ps[r][c4 * 8 + j] = pv; }
        ps += __shfl_xor(ps, 1); ps += __shfl_xor(ps, 2);
        l = l * alpha + ps;
        __syncthreads();
#pragma unroll
        for (int j = 0; j < 32; ++j) o[j] *= alpha;
        for (int kk = 0; kk < 32; ++kk) { const float pv = Ps[r][kk];
#pragma unroll
            for (int j = 0; j < 32; ++j) o[j] += pv * Vs[kk][c4 + 4 * j]; }
    }
    const float il = 1.f / l;
    bf16_t* op = fox ? A2 + (rowb + t) * DM + h * 128 : DT + (rowb + t) * DM + h * 512 + map * 256 + vh * 128;
#pragma unroll
    for (int j = 0; j < 32; ++j) op[c4 + 4 * j] = f2b(o[j] * il);
}
__global__ void __launch_bounds__(256) k_diff_combine(const bf16_t* __restrict__ DT, const float* __restrict__ lq1, const float* __restrict__ lk1, const float* __restrict__ lq2,
                                                      const float* __restrict__ lk2, const float* __restrict__ sg, bf16_t* __restrict__ A2) {
    const int lane = threadIdx.x & 63, wv = threadIdx.x >> 6;
    const int idx = blockIdx.x * 4 + wv, t = idx >> 2, h = idx & 3;
    const float s1 = wave_sum(lq1[lane] * lk1[lane] + lq1[lane + 64] * lk1[lane + 64]);
    const float s2 = wave_sum(lq2[lane] * lk2[lane] + lq2[lane + 64] * lk2[lane + 64]);
    const float lam = expf(s1) - expf(s2) + 0.2f;
    const bf16_t* p = DT + (size_t)t * DM + h * 512;
    float d[4]; float ss = 0.f;
#pragma unroll
    for (int c = 0; c < 4; ++c) { d[c] = bf2f(p[lane * 4 + c]) - lam * bf2f(p[256 + lane * 4 + c]); ss += d[c] * d[c]; }
    ss = wave_sum(ss);
    const float r = rsqrtf(ss * (1.f / 256.f) + 1e-5f) * 0.8f;
    bf16_t* o = A2 + (size_t)t * DM + 1024 + h * 256 + lane * 4;
#pragma unroll
    for (int c = 0; c < 4; ++c) o[c] = f2b(d[c] * r * sg[lane * 4 + c]);
}
__global__ void __launch_bounds__(256) k_route(const float* __restrict__ H1, const float* __restrict__ g, const float* __restrict__ wg, const float* __restrict__ bg,
                                               const float* __restrict__ we, const float* __restrict__ be, int* __restrict__ tok_e, int* __restrict__ tok_pos,
                                               float* __restrict__ tok_gate, float* __restrict__ rstd, unsigned* __restrict__ cnt) {
    __shared__ float xs[4][DM];
    const int lane = threadIdx.x & 63, wv = threadIdx.x >> 6;
    const int t = blockIdx.x * 4 + wv;
    const float* xr = H1 + (size_t)t * DM;
    f32x4 v[8]; float ss = 0.f;
#pragma unroll
    for (int j = 0; j < 8; ++j) { v[j] = *(const f32x4*)(xr + j * 256 + lane * 4); ss += v[j].x * v[j].x + v[j].y * v[j].y + v[j].z * v[j].z + v[j].w * v[j].w; }
    ss = wave_sum(ss);
    const float r = 1.f / sqrtf(ss * (1.f / DM) + 1e-6f);
#pragma unroll
    for (int j = 0; j < 8; ++j) { const f32x4 gg = *(const f32x4*)(g + j * 256 + lane * 4); *(f32x4*)(&xs[wv][j * 256 + lane * 4]) = v[j] * r * gg; }
    __syncthreads();
    float el = 0.f;
    for (int k = 0; k < DM; ++k) el += xs[wv][k] * we[(size_t)k * NE + lane];
    el += be[lane];
    float gl = 0.f;
    for (int k = (lane >> 3); k < DM; k += 8) gl += xs[wv][k] * wg[(size_t)k * 8 + (lane & 7)];
    gl += __shfl_xor(gl, 8); gl += __shfl_xor(gl, 16); gl += __shfl_xor(gl, 32);
    gl += bg[lane & 7];
    float gmax = -__builtin_inff(); int gi = 0;
#pragma unroll
    for (int j = 0; j < 8; ++j) { const float q = __shfl(gl, j); if (q > gmax) { gmax = q; gi = j; } }
    float gs = 0.f;
#pragma unroll
    for (int j = 0; j < 8; ++j) gs += expf(__shfl(gl, j) - gmax);
    const float gprob = 1.f / gs;
    float l1 = -__builtin_inff(), l2 = -__builtin_inff(); int i1 = 0, i2 = 0;
#pragma unroll
    for (int j = 0; j < 8; ++j) { const float q = __shfl(el, gi * 8 + j);
        if (q > l1) { l2 = l1; i2 = i1; l1 = q; i1 = j; } else if (q > l2) { l2 = q; i2 = j; } }
    const float e2 = expf(l2 - l1), g1 = gprob / (1.f + e2), g2 = gprob * e2 / (1.f + e2);
    if (lane == 0) {
        const int ea = gi * 8 + i1, eb = gi * 8 + i2;
        const unsigned pa = atomicAdd(cnt + ea, 1u), pb = atomicAdd(cnt + eb, 1u);
        tok_e[t * 2] = ea; tok_e[t * 2 + 1] = eb; tok_pos[t * 2] = (int)pa; tok_pos[t * 2 + 1] = (int)pb; tok_gate[t * 2] = g1; tok_gate[t * 2 + 1] = g2; rstd[t] = r;
    }
}
__device__ __forceinline__ int seg_off(const unsigned* cnt, int e) { int o = 0; for (int i = 0; i < e; ++i) o += (int)((cnt[i] + 255u) & ~255u); return o; }
__global__ void __launch_bounds__(256) k_dispatch(const float* __restrict__ H1, const float* __restrict__ g, const float* __restrict__ rstd, const int* __restrict__ tok_e,
                                                  const int* __restrict__ tok_pos, const float* __restrict__ tok_gate, const unsigned* __restrict__ cnt, bf16_t* __restrict__ XG, float* __restrict__ rowgate) {
    const int lane = threadIdx.x & 63, wv = threadIdx.x >> 6; const int t = blockIdx.x * 4 + wv;
    const int ra = seg_off(cnt, tok_e[t * 2]) + tok_pos[t * 2], rb = seg_off(cnt, tok_e[t * 2 + 1]) + tok_pos[t * 2 + 1];
    const float rs = rstd[t];
    for (int k = lane; k < DM; k += 64) { const bf16_t v = f2b(H1[(size_t)t * DM + k] * rs * g[k]); XG[(size_t)ra * DM + k] = v; XG[(size_t)rb * DM + k] = v; }
    if (lane == 0) { rowgate[ra] = tok_gate[t * 2]; rowgate[rb] = tok_gate[t * 2 + 1]; }
}
__global__ void __launch_bounds__(256) k_moe_up(const bf16_t* __restrict__ XG, const bf16_t* __restrict__ WGU, const unsigned* __restrict__ cnt, bf16_t* __restrict__ HB) {
    __shared__ float As[16][65], Bs[16][65];
    const int m0 = blockIdx.y * 64, n0 = blockIdx.x * 64;
    int e = 0, tot = 0; { int o = 0; for (int i = 0; i < NE; ++i) { if (o <= m0) e = i; o += (int)((cnt[i] + 255u) & ~255u); } tot = o; }
    if (m0 >= tot) return;
    const bf16_t* W = WGU + (size_t)e * 2048 * DM; const int rg = 256 * (n0 >> 7) + (n0 & 127), ru = rg + 128;
    float ag[4][4], au[4][4];
    ngemm_tile(DM, [&](int i, int k) { return bf2f(XG[(size_t)(m0 + i) * DM + k]); }, [&](int k, int j) { return bf2f(W[(size_t)(rg + j) * DM + k]); }, ag, As, Bs);
    ngemm_tile(DM, [&](int i, int k) { return bf2f(XG[(size_t)(m0 + i) * DM + k]); }, [&](int k, int j) { return bf2f(W[(size_t)(ru + j) * DM + k]); }, au, As, Bs);
    const int tx = threadIdx.x & 15, ty = threadIdx.x >> 4;
#pragma unroll
    for (int r = 0; r < 4; ++r)
#pragma unroll
        for (int c = 0; c < 4; ++c) { const float gv = ag[r][c]; HB[(size_t)(m0 + ty * 4 + r) * DFF + n0 + tx * 4 + c] = f2b(gv / (1.f + expf(-gv)) * au[r][c]); }
}
__global__ void __launch_bounds__(256) k_moe_down(const bf16_t* __restrict__ HB, const bf16_t* __restrict__ WD, const unsigned* __restrict__ cnt, const float* __restrict__ rowgate, bf16_t* __restrict__ Y) {
    __shared__ float As[16][65], Bs[16][65];
    const int m0 = blockIdx.y * 64, n0 = blockIdx.x * 64;
    int e = 0, tot = 0; { int o = 0; for (int i = 0; i < NE; ++i) { if (o <= m0) e = i; o += (int)((cnt[i] + 255u) & ~255u); } tot = o; }
    if (m0 >= tot) return;
    const bf16_t* W = WD + (size_t)e * DM * DFF; float acc[4][4];
    ngemm_tile(DFF, [&](int i, int k) { return bf2f(HB[(size_t)(m0 + i) * DFF + k]); }, [&](int k, int j) { return bf2f(W[(size_t)(n0 + j) * DFF + k]); }, acc, As, Bs);
    const int tx = threadIdx.x & 15, ty = threadIdx.x >> 4;
#pragma unroll
    for (int r = 0; r < 4; ++r) { const int row = m0 + ty * 4 + r; const float gt = rowgate[row];
#pragma unroll
        for (int c = 0; c < 4; ++c) Y[(size_t)row * DM + n0 + tx * 4 + c] = f2b(acc[r][c] * gt); }
}
__global__ void __launch_bounds__(256) k_final(const float* __restrict__ H1, const bf16_t* __restrict__ Y, const unsigned* __restrict__ cnt, const int* __restrict__ tok_e,
                                               const int* __restrict__ tok_pos, const float* __restrict__ g, float* __restrict__ out) {
    const int lane = threadIdx.x & 63, wv = threadIdx.x >> 6; const int t = blockIdx.x * 4 + wv;
    const int ra = seg_off(cnt, tok_e[t * 2]) + tok_pos[t * 2], rb = seg_off(cnt, tok_e[t * 2 + 1]) + tok_pos[t * 2 + 1];
    float v[32]; float ss = 0.f;
#pragma unroll
    for (int i = 0; i < 32; ++i) { const int k = lane + 64 * i; v[i] = H1[(size_t)t * DM + k] + bf2f(Y[(size_t)ra * DM + k]) + bf2f(Y[(size_t)rb * DM + k]); ss += v[i] * v[i]; }
    ss = wave_sum(ss);
    const float r = 1.f / sqrtf(ss * (1.f / DM) + 1e-6f);
#pragma unroll
    for (int i = 0; i < 32; ++i) { const int k = lane + 64 * i; out[(size_t)t * DM + k] = v[i] * r * g[k]; }
}
}
static void naive_phase(int k, const Args& a, hipStream_t stream) {
    unsigned char* ws = a.ws;
    bf16_t* A1 = (bf16_t*)(ws + WS_A1); bf16_t* WIN = (bf16_t*)(ws + WS_WIN); bf16_t* WOUT = (bf16_t*)(ws + WS_WOUT); float* BIAS = (float*)(ws + WS_BIAS); bf16_t* QKV = (bf16_t*)(ws + WS_QKV);
    bf16_t* A2 = (bf16_t*)(ws + WS_A2); bf16_t* DT = (bf16_t*)(ws + WS_DT); float* H1 = (float*)(ws + WS_H1);
    int* tok_e = (int*)(ws + WS_ROUTE); int* tok_pos = tok_e + 2 * M; float* tok_gate = (float*)(tok_pos + 2 * M); float* rstd = tok_gate + 2 * M; float* rowgate = rstd + M;
    bf16_t* XG = (bf16_t*)(ws + WS_XG); bf16_t* HB = (bf16_t*)(ws + WS_HBUF); bf16_t* Y = (bf16_t*)(ws + WS_Y); bf16_t* WGU = (bf16_t*)(ws + WS_WGU); bf16_t* WD = (bf16_t*)(ws + WS_WD);
    unsigned* cnt = (unsigned*)(ws + WS_CTL) + CW_CNT;
    switch (k) {
    case 1: nv::k_cumsum<<<16, 256, 0, stream>>>(BIAS); nv::k_inproj<<<dim3(NQKV / 64, M / 64), 256, 0, stream>>>(A1, WIN, QKV); break;
    case 3: nv::k_attn<<<dim3(S / 64, 48), 256, 0, stream>>>(QKV, BIAS, A2, DT); break;
    case 4: nv::k_diff_combine<<<M, 256, 0, stream>>>(DT, a.in[4], a.in[5], a.in[6], a.in[7], a.in[8], A2); break;
    case 5: nv::k_outproj<<<dim3(DM / 64, M / 64), 256, 0, stream>>>(A2, WOUT, a.in[0], H1); break;
    case 6: nv::k_route<<<M / 4, 256, 0, stream>>>(H1, a.in[10], a.in[11], a.in[12], a.in[13], a.in[14], tok_e, tok_pos, tok_gate, rstd, cnt); break;
    case 7: nv::k_dispatch<<<M / 4, 256, 0, stream>>>(H1, a.in[10], rstd, tok_e, tok_pos, tok_gate, cnt, XG, rowgate); break;
    case 8: nv::k_moe_up<<<dim3(DFF / 64, YROWS / 64), 256, 0, stream>>>(XG, WGU, cnt, HB); break;
    case 9: nv::k_moe_down<<<dim3(DM / 64, YROWS / 64), 256, 0, stream>>>(HB, WD, cnt, rowgate, Y); break;
    case 10: nv::k_final<<<M / 4, 256, 0, stream>>>(H1, Y, cnt, tok_e, tok_pos, a.in[18], a.out); break;
    default: break;
    }
}
#endif


extern "C" void kernel_launch(void* const* d_in, const int* in_sizes, int n_in, void* d_out, int out_size, void* d_ws, size_t ws_size, hipStream_t stream) {
    static int grid = 0;
    if (grid == 0) {
        if (n_in != 19 || in_sizes[0] != M * DM || out_size != M * DM || ws_size < WS_END) {
            fprintf(stderr, "kernel_launch: built for 19 inputs, x and out of %d floats, >= %zu bytes of workspace; got n_in %d, in0 %d, out %d, ws %zu; nothing launched\n", M * DM, (size_t)WS_END, n_in, n_in > 0 ? in_sizes[0] : -1, out_size, ws_size); grid = -1; return; }
        int dev = 0, cus = 0, per_cu = 0;
        if (hipGetDevice(&dev) != hipSuccess || hipDeviceGetAttribute(&cus, hipDeviceAttributeMultiprocessorCount, dev) != hipSuccess) { fprintf(stderr, "kernel_launch: device query failed\n"); grid = -1; return; }
        if (hipFuncSetAttribute((const void*)mk_fwd, hipFuncAttributeMaxDynamicSharedMemorySize, LDS_BYTES) != hipSuccess) { fprintf(stderr, "kernel_launch: hipFuncSetAttribute failed\n"); grid = -1; return; }
        if (hipOccupancyMaxActiveBlocksPerMultiprocessor(&per_cu, (const void*)mk_fwd, NWAVES * 64, LDS_BYTES) != hipSuccess || per_cu < 1)
            fprintf(stderr, "kernel_launch: note: occupancy query reports %d workgroups per CU\n", per_cu);
        (void)hipGetLastError();
        grid = cus;
    }
    if (grid < 0) return;
    if (hipMemsetAsync((char*)d_ws + WS_CTL, 0, CTL_ZERO_BYTES, stream) != hipSuccess) { fprintf(stderr, "kernel_launch: memset failed\n"); return; }
    Args a{};
    for (int i = 0; i < 19; ++i) a.in[i] = (const float*)d_in[i];
    a.out = (float*)d_out; a.ws = (unsigned char*)d_ws;
    int k = 0, li = 0;
    while (k < NPHASE) {
#if NAIVE_MASK
        if (k > 0 && ((NAIVE_MASK >> k) & 1u)) { naive_phase(k, a, stream); ++k; continue; }
#endif
        const int lo = k; ++k;
        while (k < NPHASE && !((NAIVE_MASK >> k) & 1u)) ++k;
        a.ph_lo = lo; a.ph_hi = k; a.li = li++;
        hipLaunchKernelGGL(mk_fwd, dim3(grid), dim3(NWAVES * 64), LDS_BYTES, stream, a);
        const hipError_t le = hipPeekAtLastError();
        if (le != hipSuccess) { fprintf(stderr, "kernel_launch: launch failed: %s\n", hipGetErrorName(le)); break; }
    }
#if PROBE_REP
    a.ph_lo = PROBE_REP; a.ph_hi = PROBE_REP + 1; a.li = li++;
    hipLaunchKernelGGL(mk_fwd, dim3(grid), dim3(NWAVES * 64), LDS_BYTES, stream, a);
#endif
}
```

```cpp
#include <hip/hip_runtime.h>
#include <hip/hip_bf16.h>
#include <cstdio>
#include <cstdint>
#include <cmath>

#ifndef NAIVE_MASK
#define NAIVE_MASK 0u
#endif

typedef unsigned short bf16_t;
constexpr int NB = 2, S = 8192, DM = 2048, M = NB * S;
constexpr int NCOL = 6152, NQKV = 6144;
constexpr int FCOL = 3072;
constexpr int NE = 64, DFF = 1024;
constexpr int YROWS = 49152, NTILE_MAX = YROWS / 256;
constexpr int C_FQ = 0, C_FK = 1024, C_FV = 2048, C_DQ = 3072, C_DK = 4096, C_DV = 5120;
constexpr float ATT_SCALE = 0.08838834764831845f, ATT_ISCALE = 11.313708498984761f;
constexpr int NPHASE = 11;

constexpr size_t MiB = 1u << 20;
constexpr size_t WS_CTL = 0, CTL_ZERO_BYTES = 1 * MiB;
constexpr size_t WS_A1 = 1 * MiB;
constexpr size_t WS_WIN = 65 * MiB;
constexpr size_t WS_WOUT = 89 * MiB;
constexpr size_t WS_BIAS = 97 * MiB;
constexpr size_t WS_QKV = 98 * MiB;
constexpr size_t WS_A2 = 290 * MiB;
constexpr size_t WS_DT = 354 * MiB;
constexpr size_t WS_H1 = 418 * MiB;
constexpr size_t WS_ROUTE = 546 * MiB;
constexpr size_t WS_WR = 547 * MiB;
constexpr size_t WS_XG = 548 * MiB;
constexpr size_t WS_HBUF = 740 * MiB;
constexpr size_t WS_Y = 836 * MiB;
constexpr size_t WS_WGU = 1028 * MiB;
constexpr size_t WS_WD = 1540 * MiB;
constexpr size_t WS_END = 1796 * MiB;
constexpr int CW_CNT = 65536, CNT_STRIDE = 1056;
constexpr int CW_NRM = 2048;
constexpr int CW_QHEAD = 3072;
constexpr int CW_BAR = 4096;

namespace pg8 {
#define PG8_LAS __attribute__((address_space(3)))
typedef unsigned short bf16_t;
typedef short bf16x8 __attribute__((ext_vector_type(8)));
typedef float f32x4 __attribute__((ext_vector_type(4)));
typedef unsigned u32x4 __attribute__((ext_vector_type(4)));
constexpr int BM = 256, BK = 64, HALF = 128, HTB = HALF * BK * 2  , STAGE_BYTES = 8 * HTB, NXCD = 8, WGM = 8;

__host__ __device__ __forceinline__ int lds_byte(int r, int c) { const int st = (r >> 4) * 2 + (c >> 5), rr = r & 15, cc = c & 31, ob = rr * 64 + cc * 2; return st * 1024 + (ob ^ (((ob >> 9) & 1) << 5)); }
__host__ __device__ __forceinline__ void stage_rc(int b, int& R, int& C) { const int st = b / 1024, sb = b % 1024, swz = sb ^ (((sb >> 9) & 1) << 5); R = (st >> 1) * 16 + swz / 64; C = (st & 1) * 32 + (swz % 64) / 2; }
__host__ __device__ __forceinline__ int perm32(int rho) { const int n = rho >> 4, i = rho & 15; return 8 * (i >> 2) + 4 * n + (i & 3); }

struct Unit { int pm, pn; };
struct Gemm { const bf16_t* A; const bf16_t* Bt; int M, N, K; };

struct StaticOrder {
    int nM, nN, nwg, G, c;
    __host__ __device__ void init(int M, int N, int G_, int c_) { nM = M / BM; nN = N / BM; nwg = nM * nN; G = G_; c = c_; }
    __host__ __device__ bool next(int i, Unit& u) const {
        const long L = (long)i * G + c; if (L >= nwg) return false;
        int wgid = (int)L; { const int q = nwg / NXCD, r = nwg % NXCD, xcd = wgid % NXCD, off = wgid / NXCD; wgid = (xcd < r ? xcd * (q + 1) : r * (q + 1) + (xcd - r) * q) + off; }
        const int nig = WGM * nN, gid = wgid / nig, fm = gid * WGM, gsz = (nM - fm) < WGM ? (nM - fm) : WGM;
        u.pm = fm + ((wgid % nig) % gsz); u.pn = (wgid % nig) / gsz; return true;
    }
    __device__ __forceinline__ void a_ready(const Unit&) const {}
    __device__ __forceinline__ void done(const Unit&) const {}
};

__device__ __forceinline__ unsigned cvt_pk_bf16(float lo, float hi) { unsigned r; asm volatile("v_cvt_pk_bf16_f32 %0, %1, %2" : "=v"(r) : "v"(lo), "v"(hi)); return r; }
typedef float f32x2 __attribute__((ext_vector_type(2)));
__device__ __forceinline__ f32x2 gelu_pk(f32x2 v) {
    const f32x2 av = __builtin_elementwise_abs(v), d = av * 0.2316418882f + 1.0f;
    f32x2 t; t.x = __builtin_amdgcn_rcpf(d.x); t.y = __builtin_amdgcn_rcpf(d.y);
    f32x2 q = t * 0.5307027145f + (-0.7265760135f); q = q * t + 0.7107068705f; q = q * t + (-0.142248368f); q = q * t + 0.127414796f; q = q * t;
    const f32x2 s = (v * v) * (-0.72134752044f);
    f32x2 e; e.x = __builtin_amdgcn_exp2f(s.x); e.y = __builtin_amdgcn_exp2f(s.y);
    const f32x2 m = v * (q * e), r = v - m;
    f32x2 o; o.x = v.x < 0.f ? m.x : r.x; o.y = v.y < 0.f ? m.y : r.y; return o;
}

template <int ACT  > struct EpiBf16 {
    static constexpr bool PERM = true, AFTER_DRAIN = false; static_assert(ACT == 0 || ACT == 1, "EpiBf16: ACT is 0 (none) or 1 (gelu_pk)");
    bf16_t* O; int ldc; const float* bias; int split_cols; size_t split_stride; float scale0;
    __device__ __forceinline__ void operator()(const f32x4 (&acc)[2][2][4][2], const Unit& u, int wr, int wc, int fr, int fq) const {
        const int row0 = u.pm * BM + wr * 64 + fr; int colt = u.pn * BM; bf16_t* base = O;
        float sc = 1.f; if (split_cols) { const int t = colt / split_cols; base += (size_t)t * split_stride; colt -= t * split_cols; if (t == 0) sc = scale0; }
        const int col0 = colt + wc * 32 + 8 * fq, bcol0 = u.pn * BM + wc * 32 + 8 * fq;
        f32x4 bv[2][2];
#pragma unroll
        for (int bj = 0; bj < 2; ++bj)
#pragma unroll
            for (int n = 0; n < 2; ++n) bv[bj][n] = bias ? *(const f32x4*)(bias + bcol0 + bj * HALF + 4 * n) : (f32x4){0.f, 0.f, 0.f, 0.f};
#pragma unroll
        for (int ai = 0; ai < 2; ++ai)
#pragma unroll
            for (int m = 0; m < 4; ++m) { bf16_t* rowp = base + (size_t)(row0 + ai * HALF + m * 16) * ldc + col0;
#pragma unroll
                for (int bj = 0; bj < 2; ++bj) { f32x4 v0 = acc[ai][bj][m][0] + bv[bj][0], v1 = acc[ai][bj][m][1] + bv[bj][1];
                    if (ACT == 1) { f32x2 a = gelu_pk((f32x2){v0[0], v0[1]}), b = gelu_pk((f32x2){v0[2], v0[3]}), c = gelu_pk((f32x2){v1[0], v1[1]}), d = gelu_pk((f32x2){v1[2], v1[3]});
                        v0 = (f32x4){a.x, a.y, b.x, b.y}; v1 = (f32x4){c.x, c.y, d.x, d.y}; }
                    v0 = v0 * sc; v1 = v1 * sc; u32x4 w; w.x = cvt_pk_bf16(v0[0], v0[1]); w.y = cvt_pk_bf16(v0[2], v0[3]); w.z = cvt_pk_bf16(v1[0], v1[1]); w.w = cvt_pk_bf16(v1[2], v1[3]);
                    *(u32x4*)(rowp + bj * HALF) = w; } }
    }
};

struct EpiResF32 {
    static constexpr bool PERM = false, AFTER_DRAIN = false;
    const float* base; float* out; int ldc;
    __device__ __forceinline__ void operator()(const f32x4 (&acc)[2][2][4][2], const Unit& u, int wr, int wc, int fr, int fq) const {
        const int col0 = u.pn * BM + wc * 32 + 4 * fq;
#pragma unroll
        for (int ai = 0; ai < 2; ++ai)
#pragma unroll
            for (int m = 0; m < 4; ++m) { const size_t off = (size_t)(u.pm * BM + ai * HALF + wr * 64 + m * 16 + fr) * ldc + col0;
#pragma unroll
                for (int bj = 0; bj < 2; ++bj)
#pragma unroll
                    for (int n = 0; n < 2; ++n) { const f32x4 bs = *(const f32x4*)(base + off + bj * HALF + n * 16); *(f32x4*)(out + off + bj * HALF + n * 16) = bs + acc[ai][bj][m][n]; }
                if (m & 1) asm volatile("" ::: "memory"); }
    }
};
struct EpiResBf16 {
    static constexpr bool PERM = true, AFTER_DRAIN = false;
    const float* base; bf16_t* out; int ldc;
    __device__ __forceinline__ void operator()(const f32x4 (&acc)[2][2][4][2], const Unit& u, int wr, int wc, int fr, int fq) const {
        const int col0 = u.pn * BM + wc * 32 + 8 * fq;
#pragma unroll
        for (int ai = 0; ai < 2; ++ai)
#pragma unroll
            for (int m = 0; m < 4; ++m) { const size_t off = (size_t)(u.pm * BM + ai * HALF + wr * 64 + m * 16 + fr) * ldc + col0;
#pragma unroll
                for (int bj = 0; bj < 2; ++bj) { const f32x4 v0 = *(const f32x4*)(base + off + bj * HALF) + acc[ai][bj][m][0], v1 = *(const f32x4*)(base + off + bj * HALF + 4) + acc[ai][bj][m][1];
                    u32x4 w; w.x = cvt_pk_bf16(v0[0], v0[1]); w.y = cvt_pk_bf16(v0[2], v0[3]); w.z = cvt_pk_bf16(v1[0], v1[1]); w.w = cvt_pk_bf16(v1[2], v1[3]);
                    *(u32x4*)(out + off + bj * HALF) = w; }
                if (m & 1) asm volatile("" ::: "memory"); }
    }
};
struct EpiQKV {
    static constexpr bool PERM = true, AFTER_DRAIN = false;
    bf16_t* O; int ldc; PG8_LAS float* part; unsigned* nrm;
    __device__ __forceinline__ void operator()(const f32x4 (&acc)[2][2][4][2], const Unit& u, int wr, int wc, int fr, int fq) const {
        const int row0 = u.pm * BM + wr * 64 + fr, col0 = u.pn * BM + wc * 32 + 8 * fq;
        const bool track = u.pn < 8 || (u.pn >= 12 && u.pn < 20);
#pragma unroll
        for (int ai = 0; ai < 2; ++ai)
#pragma unroll
            for (int m = 0; m < 4; ++m) { bf16_t* rowp = O + (size_t)(row0 + ai * HALF + m * 16) * ldc + col0;
#pragma unroll
                for (int bj = 0; bj < 2; ++bj) { const f32x4 v0 = acc[ai][bj][m][0], v1 = acc[ai][bj][m][1];
                    u32x4 w; w.x = cvt_pk_bf16(v0[0], v0[1]); w.y = cvt_pk_bf16(v0[2], v0[3]); w.z = cvt_pk_bf16(v1[0], v1[1]); w.w = cvt_pk_bf16(v1[2], v1[3]);
                    *(u32x4*)(rowp + bj * HALF) = w;
                    if (track) { float ss = ((v0[0] * v0[0] + v0[1] * v0[1]) + (v0[2] * v0[2] + v0[3] * v0[3])) + ((v1[0] * v1[0] + v1[1] * v1[1]) + (v1[2] * v1[2] + v1[3] * v1[3]));
                        ss += __shfl_xor(ss, 16); ss += __shfl_xor(ss, 32);
                        if (fq == 0) part[(wc * 2 + bj) * 256 + ai * HALF + wr * 64 + m * 16 + fr] = ss; } } }
        if (track) {
            asm volatile("s_waitcnt lgkmcnt(0)" ::: "memory"); __builtin_amdgcn_s_barrier(); asm volatile("" ::: "memory");
            const int tid = threadIdx.x, row = tid & 255, bj = tid >> 8;
            float v = (part[(0 * 2 + bj) * 256 + row] + part[(1 * 2 + bj) * 256 + row]) + (part[(2 * 2 + bj) * 256 + row] + part[(3 * 2 + bj) * 256 + row]);
#pragma unroll
            for (int o = 1; o < 64; o <<= 1) v = fmaxf(v, __shfl_xor(v, o));
            const int slice = (u.pn < 8 ? 2 * u.pn : 16 + 2 * (u.pn - 12)) + bj;
            if ((tid & 63) == 0) atomicMax(nrm + (u.pm >> 5) * 32 + slice, __float_as_uint(v));
            asm volatile("s_waitcnt lgkmcnt(0)" ::: "memory");
        }
    }
};
struct EpiSwiglu {
    static constexpr bool PERM = true, AFTER_DRAIN = false;
    bf16_t* H;
    __device__ __forceinline__ void operator()(const f32x4 (&acc)[2][2][4][2], const Unit& u, int wr, int wc, int fr, int fq) const {
        const int col0 = (u.pn & 7) * HALF + wc * 32 + 8 * fq;
#pragma unroll
        for (int ai = 0; ai < 2; ++ai)
#pragma unroll
            for (int m = 0; m < 4; ++m) { bf16_t* rowp = H + (size_t)(u.pm * BM + ai * HALF + wr * 64 + m * 16 + fr) * 1024 + col0;
                float hv[8];
#pragma unroll
                for (int n = 0; n < 2; ++n)
#pragma unroll
                    for (int c = 0; c < 4; ++c) { const float g = acc[ai][0][m][n][c], uu = acc[ai][1][m][n][c];
                        hv[n * 4 + c] = g * __builtin_amdgcn_rcpf(1.f + __builtin_amdgcn_exp2f(-1.4426950408889634f * g)) * uu; }
                u32x4 w; w.x = cvt_pk_bf16(hv[0], hv[1]); w.y = cvt_pk_bf16(hv[2], hv[3]); w.z = cvt_pk_bf16(hv[4], hv[5]); w.w = cvt_pk_bf16(hv[6], hv[7]);
                *(u32x4*)rowp = w; }
    }
};
struct EpiDown {
    static constexpr bool PERM = true, AFTER_DRAIN = false;
    bf16_t* Y;
    __device__ __forceinline__ void operator()(const f32x4 (&acc)[2][2][4][2], const Unit& u, int wr, int wc, int fr, int fq) const {
        const int col0 = (u.pn & 7) * BM + wc * 32 + 8 * fq;
#pragma unroll
        for (int ai = 0; ai < 2; ++ai)
#pragma unroll
            for (int m = 0; m < 4; ++m) { const int row = u.pm * BM + ai * HALF + wr * 64 + m * 16 + fr; bf16_t* rowp = Y + (size_t)row * 2048 + col0;
#pragma unroll
                for (int bj = 0; bj < 2; ++bj) { const f32x4 v0 = acc[ai][bj][m][0], v1 = acc[ai][bj][m][1];
                    u32x4 w; w.x = cvt_pk_bf16(v0[0], v0[1]); w.y = cvt_pk_bf16(v0[2], v0[3]); w.z = cvt_pk_bf16(v1[0], v1[1]); w.w = cvt_pk_bf16(v1[2], v1[3]);
                    *(u32x4*)(rowp + bj * HALF) = w; } }
    }
};
struct GroupedOrder {
    int total, G, c; const PG8_LAS int* tile_e;
    __device__ __forceinline__ bool next(int i, Unit& u) const {
        const int L = i * G + c; if (L >= total) return false;
        u.pm = L >> 3; u.pn = __builtin_amdgcn_readfirstlane(tile_e[L >> 3]) * 8 + (L & 7); return true;
    }
    __device__ __forceinline__ void a_ready(const Unit&) const {}
    __device__ __forceinline__ void done(const Unit&) const {}
};

template <class Epi, class Sched, bool ALIGN_EPI = false, bool SP2 = false>
__device__ __forceinline__ void gemm_phase(PG8_LAS unsigned char* lds, const Gemm g, const Sched& S, const Epi& E) {
    const int tid = threadIdx.x, wid = __builtin_amdgcn_readfirstlane(tid >> 6), lane = tid & 63, wr = wid >> 2, wc = wid & 3, fr = lane & 15, fq = lane >> 4;
    const int K = g.K, nt = K / BK;
    unsigned voffA[2], voffB[2];
#pragma unroll
    for (int i = 0; i < 2; ++i) { int R, C; stage_rc(tid * 16 + i * 8192, R, C); const int Rb = Epi::PERM ? ((R & ~31) + perm32(R & 31)) : R;
        voffA[i] = (unsigned)(R * K + C) * 2u; voffB[i] = (unsigned)(Rb * K + C) * 2u; }
    const size_t kstep = (size_t)(BK * 2);
    const size_t hstep = (size_t)HALF * K * 2;
    const size_t tstep = 2 * hstep;
    const unsigned ldsw = (unsigned)wid * 1024u;
    const int aoff = lds_byte(wr * 64 + fr, fq * 8), boff = lds_byte(wc * 32 + fr, fq * 8);
#define PG8_SA(b, h) (((b) * 2 + (h)) * HTB)
#define PG8_SB(b, h) ((4 + (b) * 2 + (h)) * HTB)
#define PG8_STAGE(bufoff, gbase, voff) do { _Pragma("unroll") for (int _i = 0; _i < 2; ++_i) \
        __builtin_amdgcn_global_load_lds((const unsigned*)((const char*)(gbase) + (voff)[_i]), (PG8_LAS unsigned*)(lds + (bufoff) + ldsw + _i * 8192), 16, 0, 0); } while (0)
#define PG8_LDA(dst, b, h) do { _Pragma("unroll") for (int m = 0; m < 4; ++m) _Pragma("unroll") for (int k = 0; k < 2; ++k) dst[m][k] = *(const PG8_LAS bf16x8*)(lds + PG8_SA(b, h) + aoff + m * 2048 + k * 1024); } while (0)
#define PG8_LDB(dst, b, h) do { _Pragma("unroll") for (int n = 0; n < 2; ++n) _Pragma("unroll") for (int k = 0; k < 2; ++k) dst[n][k] = *(const PG8_LAS bf16x8*)(lds + PG8_SB(b, h) + boff + n * 2048 + k * 1024); } while (0)
#define PG8_MMA(ai, bj, At, Bt) do { __builtin_amdgcn_s_setprio(1); _Pragma("unroll") for (int m = 0; m < 4; ++m) _Pragma("unroll") for (int n = 0; n < 2; ++n) _Pragma("unroll") for (int k = 0; k < 2; ++k) \
        acc[ai][bj][m][n] = __builtin_amdgcn_mfma_f32_16x16x32_bf16(Bt[n][k], At[m][k], acc[ai][bj][m][n], 0, 0, 0); __builtin_amdgcn_s_setprio(0); } while (0)
#define PG8_WAIT_V(n) asm volatile("s_waitcnt vmcnt(" #n ")" ::: "memory")
#define PG8_WAIT_L(n) asm volatile("s_waitcnt lgkmcnt(" #n ")" ::: "memory")
#define PG8_BAR __builtin_amdgcn_s_barrier()
#define PG8_SCHED __builtin_amdgcn_sched_barrier(0)
    Unit cur, nxt; int ui = 0;
    if (!S.next(0, cur)) return;
    f32x4 acc[2][2][4][2];
#pragma unroll
    for (int a = 0; a < 2; ++a)
#pragma unroll
        for (int b = 0; b < 2; ++b)
#pragma unroll
            for (int m = 0; m < 4; ++m)
#pragma unroll
                for (int n = 0; n < 2; ++n) acc[a][b][m][n] = (f32x4){0.f, 0.f, 0.f, 0.f};
    bf16x8 At[4][2], B0[2][2], B1[2][2];
    const char* cA = (const char*)g.A + (size_t)cur.pm * tstep; const char* cB = (const char*)g.Bt + (size_t)cur.pn * tstep;
    S.a_ready(cur);
    if constexpr (SP2) {
        PG8_STAGE(PG8_SB(0, 0), cB, voffB); PG8_STAGE(PG8_SB(0, 1), cB + hstep, voffB); PG8_STAGE(PG8_SA(0, 0), cA, voffA); PG8_STAGE(PG8_SA(0, 1), cA + hstep, voffA);
        if (wr == 1) PG8_BAR;
        PG8_WAIT_V(2); PG8_BAR;
        PG8_STAGE(PG8_SB(1, 0), cB + kstep, voffB); PG8_STAGE(PG8_SA(1, 0), cA + kstep, voffA); PG8_STAGE(PG8_SB(1, 1), cB + hstep + kstep, voffB);
        PG8_WAIT_V(6); PG8_BAR;
    } else {
        PG8_STAGE(PG8_SB(0, 0), cB, voffB); PG8_STAGE(PG8_SA(0, 0), cA, voffA); PG8_STAGE(PG8_SB(0, 1), cB + hstep, voffB); PG8_STAGE(PG8_SA(0, 1), cA + hstep, voffA);
        if (wr == 1) PG8_BAR;
        PG8_WAIT_V(4); PG8_BAR;
        PG8_STAGE(PG8_SB(1, 0), cB + kstep, voffB); PG8_STAGE(PG8_SA(1, 0), cA + kstep, voffA); PG8_STAGE(PG8_SB(1, 1), cB + hstep + kstep, voffB);
        PG8_WAIT_V(6); PG8_BAR;
    }
    for (;;) {
        const bool has_next = S.next(ui + 1, nxt);
        const char* nA = has_next ? (const char*)g.A + (size_t)nxt.pm * tstep : cA; const char* nB = has_next ? (const char*)g.Bt + (size_t)nxt.pn * tstep : cB;
        for (int t = 0; t < nt; t += 2) {
            const bool last = (t == nt - 2);
            const char* a1 = cA + (size_t)(t + 1) * kstep;
            const char* a2 = last ? nA : cA + (size_t)(t + 2) * kstep; const char* b2 = last ? nB : cB + (size_t)(t + 2) * kstep;
            const char* a3 = a2 + kstep; const char* b3 = b2 + kstep;
            if (last && has_next) S.a_ready(nxt);
            if constexpr (SP2) {
            PG8_LDB(B0, 0, 0); PG8_LDB(B1, 0, 1); PG8_SCHED; PG8_LDA(At, 0, 0); PG8_STAGE(PG8_SA(1, 1), a1 + hstep, voffA);
            PG8_WAIT_V(8); PG8_WAIT_L(0); PG8_BAR; PG8_MMA(0, 0, At, B0); PG8_MMA(0, 1, At, B1); PG8_BAR; PG8_SCHED;
            PG8_LDA(At, 0, 1); PG8_STAGE(PG8_SB(0, 0), b2, voffB); PG8_STAGE(PG8_SB(0, 1), b2 + hstep, voffB); PG8_STAGE(PG8_SA(0, 0), a2, voffA);
            PG8_WAIT_V(8); PG8_WAIT_L(0); PG8_BAR; PG8_MMA(1, 0, At, B0); PG8_MMA(1, 1, At, B1); PG8_BAR; PG8_SCHED;
            PG8_LDB(B0, 1, 0); PG8_LDB(B1, 1, 1); PG8_SCHED; PG8_LDA(At, 1, 0); PG8_STAGE(PG8_SA(0, 1), a2 + hstep, voffA);
            PG8_WAIT_V(8); PG8_WAIT_L(0); PG8_BAR; PG8_MMA(0, 0, At, B0); PG8_MMA(0, 1, At, B1); PG8_BAR; PG8_SCHED;
            PG8_LDA(At, 1, 1); PG8_STAGE(PG8_SB(1, 0), b3, voffB); PG8_STAGE(PG8_SB(1, 1), b3 + hstep, voffB); PG8_STAGE(PG8_SA(1, 0), a3, voffA);
            PG8_WAIT_V(8); PG8_WAIT_L(0); PG8_BAR; PG8_MMA(1, 0, At, B0); PG8_MMA(1, 1, At, B1); PG8_BAR; PG8_SCHED;
            } else {
            PG8_LDB(B0, 0, 0); PG8_SCHED; PG8_LDA(At, 0, 0); PG8_STAGE(PG8_SA(1, 1), a1 + hstep, voffA);
            PG8_WAIT_L(8); PG8_BAR; PG8_WAIT_L(0); PG8_MMA(0, 0, At, B0); PG8_BAR; PG8_SCHED;
            PG8_LDB(B1, 0, 1); PG8_STAGE(PG8_SB(0, 0), b2, voffB);
            PG8_BAR; PG8_WAIT_L(0); PG8_MMA(0, 1, At, B1); PG8_BAR;
            PG8_LDA(At, 0, 1); PG8_STAGE(PG8_SA(0, 0), a2, voffA);
            PG8_BAR; PG8_WAIT_L(0); PG8_MMA(1, 0, At, B0); PG8_BAR; PG8_SCHED;
            PG8_STAGE(PG8_SB(0, 1), b2 + hstep, voffB);
            PG8_WAIT_V(6); PG8_BAR; PG8_MMA(1, 1, At, B1); PG8_BAR;
            PG8_LDB(B0, 1, 0); PG8_SCHED; PG8_LDA(At, 1, 0); PG8_STAGE(PG8_SA(0, 1), a2 + hstep, voffA);
            PG8_WAIT_L(8); PG8_BAR; PG8_WAIT_L(0); PG8_MMA(0, 0, At, B0); PG8_BAR; PG8_SCHED;
            PG8_LDB(B1, 1, 1); PG8_STAGE(PG8_SB(1, 0), b3, voffB);
            PG8_BAR; PG8_WAIT_L(0); PG8_MMA(0, 1, At, B1); PG8_BAR;
            PG8_LDA(At, 1, 1); PG8_STAGE(PG8_SA(1, 0), a3, voffA);
            PG8_BAR; PG8_WAIT_L(0); PG8_MMA(1, 0, At, B0); PG8_BAR; PG8_SCHED;
            PG8_STAGE(PG8_SB(1, 1), b3 + hstep, voffB);
            PG8_WAIT_V(6); PG8_BAR; PG8_MMA(1, 1, At, B1); PG8_BAR;
            }
        }
        if constexpr (ALIGN_EPI) { if (wr == 0) PG8_BAR; }
        if constexpr (!Epi::AFTER_DRAIN) { E(acc, cur, wr, wc, fr, fq); S.done(cur); }
        if (!has_next) break;
#pragma unroll
        for (int a = 0; a < 2; ++a)
#pragma unroll
            for (int b = 0; b < 2; ++b)
#pragma unroll
                for (int m = 0; m < 4; ++m)
#pragma unroll
                    for (int n = 0; n < 2; ++n) acc[a][b][m][n] = (f32x4){0.f, 0.f, 0.f, 0.f};
        cur = nxt; cA = nA; cB = nB; ++ui;
        if constexpr (ALIGN_EPI) { if (wr == 1) PG8_BAR; }
    }
    PG8_WAIT_V(0);
    if constexpr (!ALIGN_EPI) { if (wr == 0) PG8_BAR; }
    PG8_BAR;
    if constexpr (Epi::AFTER_DRAIN) { E.fused(acc, cur, wr, wc, fr, fq, lds, wid, lane); S.done(cur); }
#undef PG8_SA
#undef PG8_SB
#undef PG8_STAGE
#undef PG8_LDA
#undef PG8_LDB
#undef PG8_MMA
#undef PG8_WAIT_V
#undef PG8_WAIT_L
#undef PG8_BAR
#undef PG8_SCHED
}

struct UnitW { int pm, cn; const float* w0; const float* w1; };
struct GemmW { const bf16_t* A; int K, ldw; const int* rowtok; int tokmask; const PG8_LAS int* rowbase; };
__device__ __forceinline__ void wload1(f32x4& r0, unsigned voff, const char* sbase) { asm volatile("global_load_dwordx4 %0, %1, %2" : "=&v"(r0) : "v"(voff), "s"(sbase) : "memory"); }
template <class Epi, class Sched, bool ALIGN_EPI, bool GATHER>
__device__ __forceinline__ void gemm_phase_wf32(PG8_LAS unsigned char* lds, const GemmW g, const Sched& S, const Epi& E) {
    static_assert(Epi::PERM && !Epi::AFTER_DRAIN, "gemm_phase_wf32: PERM epilogues that run inside the unit loop only");
    const int tid = threadIdx.x, wid = __builtin_amdgcn_readfirstlane(tid >> 6), lane = tid & 63, wr = wid >> 2, wc = wid & 3, fr = lane & 15, fq = lane >> 4;
    const int K = g.K, nt = K / BK;
    const size_t kstep = (size_t)(BK * 2), hstep = (size_t)HALF * K * 2, tstep = 2 * hstep;
    const unsigned ldsw = (unsigned)wid * 1024u;
    const int aoff = lds_byte(wr * 64 + fr, fq * 8), boff = lds_byte(wc * 32 + fr, fq * 8);
    const int cq = lane & 7, sj = lane >> 3;
    #if defined(PROBE_HOT) && (PROBE_HOT == 2 || PROBE_HOT == 4)
    const size_t wrow = (size_t)g.ldw * 4u, wkt = S.hot ? 0 : wrow * BK;
#else
    const size_t wrow = (size_t)g.ldw * 4u, wkt = wrow * BK;
#endif
#if defined(PROBE_HOT) && PROBE_HOT == 5
    const int cqg = S.hot ? (lane & 7) : cq, sjg = S.hot ? (lane >> 3) : sj;
    const size_t wsrc = (size_t)(8 * sjg) * wrow + (size_t)(32 * (wid & 3) + 4 * cqg) * 4u;
#else
    const size_t wsrc = (size_t)(8 * sj) * wrow + (size_t)(32 * (wid & 3) + 4 * cq) * 4u;
#endif
    const int wrho = 16 * (cq & 1) + 4 * (cq >> 1);
    const int wdst = (4 + (wid >> 2)) * HTB + lds_byte(32 * (wid & 3) + wrho, 8 * sj);
#define PG8_SA(b, h) (((b) * 2 + (h)) * HTB)
#define PG8_SB(b, h) ((4 + (b) * 2 + (h)) * HTB)
#define PG8_STAGE(bufoff, gbase, voff) do { _Pragma("unroll") for (int _i = 0; _i < 2; ++_i) \
        __builtin_amdgcn_global_load_lds((const unsigned*)((const char*)(gbase) + (voff)[_i]), (PG8_LAS unsigned*)(lds + (bufoff) + ldsw + _i * 8192), 16, 0, 0); } while (0)
#define PG8_STAGEA(bufoff, h, kb, nx) do { const char* b_ = ((nx) ? nAb : cAb) + (kb); unsigned v_[2]; v_[0] = (nx) ? voN[h][0] : voC[h][0]; v_[1] = (nx) ? voN[h][1] : voC[h][1]; PG8_STAGE(bufoff, b_, v_); } while (0)
#define PG8_LDA(dst, b, h) do { _Pragma("unroll") for (int m = 0; m < 4; ++m) _Pragma("unroll") for (int k = 0; k < 2; ++k) dst[m][k] = *(const PG8_LAS bf16x8*)(lds + PG8_SA(b, h) + aoff + m * 2048 + k * 1024); } while (0)
#define PG8_LDB(dst, b, h) do { _Pragma("unroll") for (int n = 0; n < 2; ++n) _Pragma("unroll") for (int k = 0; k < 2; ++k) dst[n][k] = *(const PG8_LAS bf16x8*)(lds + PG8_SB(b, h) + boff + n * 2048 + k * 1024); } while (0)
#define PG8_MMA(ai, bj, At, Bt) do { __builtin_amdgcn_s_setprio(1); _Pragma("unroll") for (int m = 0; m < 4; ++m) _Pragma("unroll") for (int n = 0; n < 2; ++n) _Pragma("unroll") for (int k = 0; k < 2; ++k) \
        acc[ai][bj][m][n] = __builtin_amdgcn_mfma_f32_16x16x32_bf16(Bt[n][k], At[m][k], acc[ai][bj][m][n], 0, 0, 0); __builtin_amdgcn_s_setprio(0); } while (0)
#define PG8_WAIT_V(n) asm volatile("s_waitcnt vmcnt(" #n ")" ::: "memory")
#define PG8_WAIT_L(n) asm volatile("s_waitcnt lgkmcnt(" #n ")" ::: "memory")
#define PG8_BAR __builtin_amdgcn_s_barrier()
#define PG8_SCHED __builtin_amdgcn_sched_barrier(0)
#define PG8_WLOAD(kk) do { const int kk_ = (kk); const bool in_ = kk_ < nt; const char* q_ = (in_ ? cW : nW) + (size_t)(in_ ? kk_ : kk_ - nt) * wkt; \
        _Pragma("unroll") for (int r_ = 0; r_ < 8; ++r_) wload1(RB[r_], (unsigned)wsrc, q_ + (size_t)r_ * wrow); } while (0)
#define PG8_WWAIT(n) asm volatile("s_waitcnt vmcnt(" #n ")" : "+v"(RB[0]), "+v"(RB[1]), "+v"(RB[2]), "+v"(RB[3]), "+v"(RB[4]), "+v"(RB[5]), "+v"(RB[6]), "+v"(RB[7]) :: "memory")
#define PG8_WWRITE(b) do { _Pragma("unroll") for (int i_ = 0; i_ < 4; ++i_) { u32x4 w_; \
        w_.x = cvt_pk_bf16(RB[0][i_], RB[1][i_]); w_.y = cvt_pk_bf16(RB[2][i_], RB[3][i_]); w_.z = cvt_pk_bf16(RB[4][i_], RB[5][i_]); w_.w = cvt_pk_bf16(RB[6][i_], RB[7][i_]); \
        *(PG8_LAS u32x4*)(lds + (b) * 2 * HTB + wdst + i_ * 64) = w_; } } while (0)
#ifdef PROBE_ABL
    const int abl = S.hot ? PROBE_ABL : 0;
#define PG8_ABL(bit, stmt) do { if (!(abl & (bit))) { stmt; } } while (0)
#else
#define PG8_ABL(bit, stmt) do { stmt; } while (0)
#endif
    UnitW cur, nxt; int ui = 0;
    if (!S.next(0, cur)) return;
    f32x4 acc[2][2][4][2];
#pragma unroll
    for (int a = 0; a < 2; ++a)
#pragma unroll
        for (int b = 0; b < 2; ++b)
#pragma unroll
            for (int m = 0; m < 4; ++m)
#pragma unroll
                for (int n = 0; n < 2; ++n) acc[a][b][m][n] = (f32x4){0.f, 0.f, 0.f, 0.f};
    bf16x8 At[4][2], B0[2][2], B1[2][2]; f32x4 RB[8];
    const bool whalf = wid >= 4;
    const char* cAb; const char* nAb; unsigned voC[2][2], voN[2][2];
#define PG8_UNIT_A(base, vo, pm_) do { int t_ = tid; asm volatile("" : "+v"(t_)); int R_[2], C_[2]; stage_rc(t_ * 16, R_[0], C_[0]); stage_rc(t_ * 16 + 8192, R_[1], C_[1]); \
        if constexpr (GATHER) { base = (const char*)g.A; const int rb_ = __builtin_amdgcn_readfirstlane(g.rowbase[pm_]); _Pragma("unroll") for (int h_ = 0; h_ < 2; ++h_) _Pragma("unroll") for (int i_ = 0; i_ < 2; ++i_) \
            vo[h_][i_] = (unsigned)(g.rowtok[rb_ + (pm_) * BM + h_ * HALF + R_[i_]] & g.tokmask) * (unsigned)(K * 2) + (unsigned)C_[i_] * 2u; } \
        else { base = (const char*)g.A + (size_t)(pm_) * tstep; _Pragma("unroll") for (int h_ = 0; h_ < 2; ++h_) _Pragma("unroll") for (int i_ = 0; i_ < 2; ++i_) vo[h_][i_] = (unsigned)(h_ * HALF + R_[i_]) * (unsigned)(K * 2) + (unsigned)C_[i_] * 2u; } } while (0)
    PG8_UNIT_A(cAb, voC, cur.pm); nAb = cAb;
#pragma unroll
    for (int h_ = 0; h_ < 2; ++h_) { voN[h_][0] = voC[h_][0]; voN[h_][1] = voC[h_][1]; }
    const char* cW = (const char*)(whalf ? cur.w1 : cur.w0);
    const char* nW = cW;
    PG8_WLOAD(0); PG8_STAGEA(PG8_SA(0, 0), 0, 0, false); PG8_STAGEA(PG8_SA(0, 1), 1, 0, false);
    PG8_WWAIT(4); PG8_WWRITE(0);
    PG8_WLOAD(1);
    PG8_WWAIT(0); PG8_WWRITE(1);
    PG8_STAGEA(PG8_SA(1, 0), 0, kstep, false);
    PG8_WLOAD(2);
    PG8_WAIT_L(0);
    if (wr == 1) PG8_BAR;
    PG8_BAR; PG8_BAR;
    for (;;) {
        const bool has_next = S.next(ui + 1, nxt);
        if (has_next) PG8_UNIT_A(nAb, voN, nxt.pm);
        nW = has_next ? (const char*)(whalf ? nxt.w1 : nxt.w0) : cW;
        for (int t = 0; t < nt; t += 2) {
            const bool last = (t == nt - 2);
            const size_t k1 = (size_t)(t + 1) * kstep, k2 = last ? 0 : (size_t)(t + 2) * kstep, k3 = k2 + kstep;
            PG8_LDB(B0, 0, 0); PG8_LDB(B1, 0, 1); PG8_SCHED; PG8_LDA(At, 0, 0); PG8_STAGEA(PG8_SA(1, 1), 1, k1, false);
            PG8_WAIT_V(12); PG8_WAIT_L(0); PG8_BAR; PG8_MMA(0, 0, At, B0); PG8_MMA(0, 1, At, B1); PG8_BAR; PG8_SCHED;
            PG8_WWAIT(2); PG8_ABL(1, PG8_WWRITE(0)); PG8_LDA(At, 0, 1); PG8_STAGEA(PG8_SA(0, 0), 0, k2, last); PG8_ABL(2, PG8_WLOAD(t + 3));
            PG8_WAIT_L(0); PG8_BAR; PG8_MMA(1, 0, At, B0); PG8_MMA(1, 1, At, B1); PG8_BAR; PG8_SCHED;
            PG8_LDB(B0, 1, 0); PG8_LDB(B1, 1, 1); PG8_SCHED; PG8_LDA(At, 1, 0); PG8_STAGEA(PG8_SA(0, 1), 1, k2, last);
            PG8_WAIT_V(12); PG8_WAIT_L(0); PG8_BAR; PG8_MMA(0, 0, At, B0); PG8_MMA(0, 1, At, B1); PG8_BAR; PG8_SCHED;
            PG8_WWAIT(2); PG8_ABL(1, PG8_WWRITE(1)); PG8_LDA(At, 1, 1); PG8_STAGEA(PG8_SA(1, 0), 0, k3, last); PG8_ABL(2, PG8_WLOAD(t + 4));
            PG8_WAIT_L(0); PG8_BAR; PG8_MMA(1, 0, At, B0); PG8_MMA(1, 1, At, B1); PG8_BAR; PG8_SCHED;
        }
        if (!has_next) PG8_WWAIT(0);
        if constexpr (ALIGN_EPI) { if (wr == 0) PG8_BAR; }
        { Unit eu; eu.pm = cur.pm; eu.pn = cur.cn; E(acc, eu, wr, wc, fr, fq); }
        if (!has_next) break;
#pragma unroll
        for (int a = 0; a < 2; ++a)
#pragma unroll
            for (int b = 0; b < 2; ++b)
#pragma unroll
                for (int m = 0; m < 4; ++m)
#pragma unroll
                    for (int n = 0; n < 2; ++n) acc[a][b][m][n] = (f32x4){0.f, 0.f, 0.f, 0.f};
        cur = nxt; cAb = nAb; cW = nW; ++ui;
#pragma unroll
        for (int h_ = 0; h_ < 2; ++h_) { voC[h_][0] = voN[h_][0]; voC[h_][1] = voN[h_][1]; }
        if constexpr (ALIGN_EPI) { if (wr == 1) PG8_BAR; }
    }
    PG8_WAIT_V(0);
    if constexpr (!ALIGN_EPI) { if (wr == 0) PG8_BAR; }
    PG8_BAR;
#undef PG8_SA
#undef PG8_SB
#undef PG8_STAGE
#undef PG8_LDA
#undef PG8_STAGEA
#undef PG8_UNIT_A
#undef PG8_LDB
#undef PG8_MMA
#undef PG8_WAIT_V
#undef PG8_WAIT_L
#undef PG8_BAR
#undef PG8_SCHED
#undef PG8_WLOAD
#undef PG8_ABL
#undef PG8_WWAIT
#undef PG8_WWRITE
}
template <int MODE> struct GroupedOrderW {
    int total, G, c; const PG8_LAS int* tile_e; const float* wa; const float* wb; int hot;
    __device__ __forceinline__ bool next(int i, UnitW& u) const {
        const int L = i * G + c; if (L >= total) return false;
        int e = __builtin_amdgcn_readfirstlane(tile_e[L >> 3]), nt = L & 7;
        u.pm = L >> 3; u.cn = nt;
#if defined(PROBE_HOT) && PROBE_HOT == 1
        if (hot) { e = 0; nt = 0; }
#endif
        if (MODE == 0) { u.w0 = wa + (size_t)e * 2048 * 1024 + 128 * nt; u.w1 = wb + (size_t)e * 2048 * 1024 + 128 * nt; }
        else { u.w0 = wa + (size_t)e * 1024 * 2048 + 256 * nt; u.w1 = u.w0 + 128; }
        return true;
    }
};
}

namespace att {
using TIN = __hip_bfloat16; using TOUT = __hip_bfloat16;
constexpr int B = 2, H = 1, HKV = 1, SQ = 8192, SKV = 8192, D = 128, QOFF = 0, WINDOW = SKV;
constexpr float THR = 8.f;
constexpr bool WSKIP = false;
constexpr int LDQ = 6144, LDO = 2048;
constexpr int W_INF = 1 << 30;
#ifdef PROF_SECT
#define PROF_T0(sect) unsigned long long pt0_##sect = 0; if (PROF_SECT == (sect) && blockIdx.x == 0) pt0_##sect = __builtin_amdgcn_s_memtime()
#define PROF_T1(sect) do { if (PROF_SECT == (sect) && blockIdx.x == 0) { const unsigned long long d_ = __builtin_amdgcn_s_memtime() - pt0_##sect; if (threadIdx.x == 0) { PROFW[0] += (unsigned)d_; } } } while (0)
#else
#define PROF_T0(sect) do {} while (0)
#define PROF_T1(sect) do {} while (0)
#endif
constexpr float SCALE = 0.08838834764831845f;
constexpr int NW = 8, QBLK = 32, KVBLK = 64, QB = NW * QBLK;
constexpr int SHM_V = KVBLK * D * 2, SHM_K = KVBLK * D * 2;
constexpr int OFF_WS = 2 * SHM_V + 2 * SHM_K, OFF_CB = OFF_WS + NW * 64 * 4, LDS_BYTES = OFF_CB + 2 * 64 * 4;
static_assert(D == 128 && SQ % QB == 0 && SKV % KVBLK == 0 && H % HKV == 0 && QOFF >= 0 && QOFF + SQ <= SKV && WINDOW >= 1, "geometry");

using bf16 = __hip_bfloat16;
typedef short bf16x8 __attribute__((ext_vector_type(8)));
typedef short s16x4 __attribute__((ext_vector_type(4)));
typedef float f32x16 __attribute__((ext_vector_type(16)));
typedef float f32x4 __attribute__((ext_vector_type(4)));
typedef unsigned u32x4 __attribute__((ext_vector_type(4)));
template <class A, class Bt> struct same_t { static constexpr bool v = false; };
template <class A> struct same_t<A, A> { static constexpr bool v = true; };

#define KSWZ(row, colB) ((row) * 256 + ((colB) ^ (((row) & 7) << 4)))
#define SBAR() __builtin_amdgcn_sched_barrier(0)
__device__ __forceinline__ int v_st(int k, int c) { const int kk = (k & ~0xC) | ((k & 4) << 1) | ((k & 8) >> 1); return ((kk >> 3) * 4 + (c >> 5)) * 512 + ((kk & 7) * 32 + (c & 31)) * 2; }
__device__ __forceinline__ int v_rd_base(int lane) { return ((lane & 3) << 3) | (((lane >> 2) & 3) << 6) | (((lane >> 4) & 1) << 5) | (((lane >> 5) & 1) << 8); }
constexpr int v_rd_off(int d0, int ks, int half) { return d0 * 512 + ks * 4096 + half * 2048; }
__device__ __forceinline__ int crow(int r, int hi) { return (r & 3) + 8 * (r >> 2) + 4 * hi; }
__device__ __forceinline__ unsigned cvtpk(float lo, float hi) {
    unsigned r; asm volatile("v_cvt_pk_bf16_f32 %0, %1, %2" : "=v"(r) : "v"(lo), "v"(hi)); return r;
}
__device__ __forceinline__ bf16x8 pack8(f32x4 a, f32x4 b) {
    u32x4 w = {cvtpk(a[0], a[1]), cvtpk(a[2], a[3]), cvtpk(b[0], b[1]), cvtpk(b[2], b[3])};
    return *reinterpret_cast<bf16x8*>(&w);
}
template <class T> __device__ __forceinline__ bf16x8 load8(const T* p) {
    if constexpr (same_t<T, float>::v) { return pack8(*(const f32x4*)p, *(const f32x4*)(p + 4)); }
    else { return *reinterpret_cast<const bf16x8*>(p); }
}
__device__ __forceinline__ void mask_tile(f32x16& p0, f32x16& p1, int dq, unsigned W) {
    const float NEG = -__builtin_inff();
#pragma unroll
    for (int r = 0; r < 16; ++r) {
        const int c = (r & 3) + 8 * (r >> 2);
        if ((unsigned)(dq - c) >= W) p0[r] = NEG;
        if ((unsigned)(dq - c - 32) >= W) p1[r] = NEG;
    }
}
__device__ __forceinline__ void partialSM(f32x16& p0, f32x16& p1, float& m_reg, float& mn, float& alpha) {
    constexpr float C2 = 1.4426950408889634f * SCALE;
    mn = m_reg; alpha = 1.f;
    const float mnL = -m_reg * C2;
    for (int r = 0; r < 16; ++r) p0[r] = fmaf(p0[r], C2, mnL); for (int r = 0; r < 16; ++r) p1[r] = fmaf(p1[r], C2, mnL);
    for (int r = 0; r < 16; ++r) p0[r] = __builtin_amdgcn_exp2f(p0[r]);
}
__device__ __forceinline__ void finishSM(f32x16& p0, f32x16& p1, float alpha, float& l_reg, bf16x8& pa0, bf16x8& pa1, bf16x8& pa2, bf16x8& pa3) {
    for (int r = 0; r < 16; ++r) p1[r] = __builtin_amdgcn_exp2f(p1[r]);
    float ps = 0; for (int r = 0; r < 16; ++r) ps += p0[r]; for (int r = 0; r < 16; ++r) ps += p1[r];
    { auto rr = __builtin_amdgcn_permlane32_swap(__float_as_uint(ps), __float_as_uint(ps), false, false);
      ps = __uint_as_float(rr[0]) + __uint_as_float(rr[1]); }
    l_reg += ps; (void)alpha;
#define PK4(P, B_, OUT) do { unsigned a0 = cvtpk(P[B_+0], P[B_+1]), a1 = cvtpk(P[B_+2], P[B_+3]);                          \
        unsigned b0 = cvtpk(P[B_+4], P[B_+5]), b1 = cvtpk(P[B_+6], P[B_+7]);                                             \
        auto r0 = __builtin_amdgcn_permlane32_swap(a0, b0, false, false); auto r1 = __builtin_amdgcn_permlane32_swap(a1, b1, false, false); \
        u32x4 w = {r0[0], r1[0], r0[1], r1[1]}; OUT = *reinterpret_cast<bf16x8*>(&w); } while (0)
    PK4(p0, 0, pa0); PK4(p0, 8, pa1); PK4(p1, 0, pa2); PK4(p1, 8, pa3);
#undef PK4
}
template <int KB, bool SK>
__device__ __forceinline__ void qkt(f32x16& p0, f32x16& p1, const char* K_lds, int r32, int hi, const bf16x8* qr, bool act, const float* cbt, float cqs) {
    if (SK && !act) { const float NEG = -__builtin_inff();
#pragma unroll
        for (int r = 0; r < 16; ++r) { p0[r] = NEG; p1[r] = NEG; } return; }
    { const f32x4* c4 = (const f32x4*)(cbt + KB * 64);
#pragma unroll
      for (int g = 0; g < 4; ++g) { const f32x4 a = c4[2 * g], b = c4[8 + 2 * g];
#pragma unroll
          for (int i = 0; i < 4; ++i) { p0[4 * g + i] = cqs - a[i]; p1[4 * g + i] = cqs - b[i]; } } }
    const char* kb[4];
#pragma unroll
    for (int dd = 0; dd < 4; ++dd) kb[dd] = K_lds + KB * SHM_K + KSWZ(r32, (dd * 16 + hi * 8) * 2);
#pragma unroll
    for (int d0 = 0; d0 < 8; ++d0) { const char* a = kb[d0 & 3] + (d0 >> 2) * 128;
        bf16x8 b0 = *reinterpret_cast<const bf16x8*>(a);
        bf16x8 b1 = *reinterpret_cast<const bf16x8*>(a + 32 * 256);
        p0 = __builtin_amdgcn_mfma_f32_32x32x16_bf16(b0, qr[d0], p0, 0, 0, 0);
        p1 = __builtin_amdgcn_mfma_f32_32x32x16_bf16(b1, qr[d0], p1, 0, 0, 0); }
}
template <int VB, bool SK>
__device__ __forceinline__ void pv_tile(f32x16* o, int vb0, bf16x8 pa0, bf16x8 pa1, bf16x8 pa2, bf16x8 pa3, bool act) {
    if (SK && !act) return;
#define TRRD(dst, off) asm volatile("ds_read_b64_tr_b16 %0, %1 offset:%2" : "=&v"(dst) : "v"(vb0), "i"(off) : "memory")
#define PV_D0(d0) do { s16x4 l0, l1, l2, l3, h0, h1, h2, h3; constexpr int b_ = VB * SHM_V + v_rd_off(d0, 0, 0);     \
        TRRD(l0, b_); TRRD(h0, b_ + 2048); TRRD(l1, b_ + 4096); TRRD(h1, b_ + 6144); TRRD(l2, b_ + 8192); TRRD(h2, b_ + 10240); TRRD(l3, b_ + 12288); TRRD(h3, b_ + 14336); \
        asm volatile("s_waitcnt lgkmcnt(0)" ::: "memory"); SBAR();                 \
        o[d0] = __builtin_amdgcn_mfma_f32_32x32x16_bf16(pa0, (bf16x8){l0[0], l0[1], l0[2], l0[3], h0[0], h0[1], h0[2], h0[3]}, o[d0], 0, 0, 0);   \
        o[d0] = __builtin_amdgcn_mfma_f32_32x32x16_bf16(pa1, (bf16x8){l1[0], l1[1], l1[2], l1[3], h1[0], h1[1], h1[2], h1[3]}, o[d0], 0, 0, 0);   \
        o[d0] = __builtin_amdgcn_mfma_f32_32x32x16_bf16(pa2, (bf16x8){l2[0], l2[1], l2[2], l2[3], h2[0], h2[1], h2[2], h2[3]}, o[d0], 0, 0, 0);   \
        o[d0] = __builtin_amdgcn_mfma_f32_32x32x16_bf16(pa3, (bf16x8){l3[0], l3[1], l3[2], l3[3], h3[0], h3[1], h3[2], h3[3]}, o[d0], 0, 0, 0); } while (0)
    PV_D0(0); PV_D0(1); PV_D0(2); PV_D0(3);
#undef PV_D0
#undef TRRD
}
template <class TIn, class TOut> struct BlockRef { const TIn* Q; const TIn* K; const TIn* V; TOut* O; const float* C; int P0, jlo; float mref; };
template <class TIn> struct Seam {
    bf16x8 qr[8];
    bf16x8 st_v0, st_v1, st_k0, st_k1; f32x4 sf0, sf1, sf2, sf3;
    float cq, st_c;
    f32x4 tq[16];
};
__device__ __forceinline__ int swa_jlo(int P0, int W) { const int lowk = P0 - W + 1; return lowk > 0 ? lowk / KVBLK : 0; }
#define ROW(p, k0, rr) ((p) + (size_t)((k0) + (rr)) * LDQ + sc)
#define VMW() asm volatile("s_waitcnt vmcnt(0)" ::: "memory")
#define VMWN(n) asm volatile("s_waitcnt vmcnt(%0)" :: "i"(n) : "memory")
#define SLOAD_H(Kp, Vp, Cp, k0) do { S.st_v0 = load8<TIn>(ROW(Vp, k0, sr)); S.st_v1 = load8<TIn>(ROW(Vp, k0, 32 + sr));              \
                         S.st_k0 = load8<TIn>(ROW(Kp, k0, sr)); S.st_k1 = load8<TIn>(ROW(Kp, k0, 32 + sr)); S.st_c = (Cp)[(k0) + (tid & 63)]; } while (0)
#define SWRITE_HK(bf) do { *(bf16x8*)(K_lds + (bf) * SHM_K + kws) = S.st_k0; *(bf16x8*)(K_lds + (bf) * SHM_K + kws + 32 * 256) = S.st_k1; \
                           if (tid < 64) cbw[(bf) * 64 + tid] = S.st_c; } while (0)
#define SWRITE_HV(bf) do { *(bf16x8*)(V_lds + (bf) * SHM_V + vst0) = S.st_v0; *(bf16x8*)(V_lds + (bf) * SHM_V + vst1) = S.st_v1; } while (0)
#define SWRITE_H(bf) do { SWRITE_HV(bf); SWRITE_HK(bf); } while (0)
#define SLOAD_F(p, k0) do { S.sf0 = *(const f32x4*)ROW(p, k0, sr); S.sf1 = *(const f32x4*)(ROW(p, k0, sr) + 4);                \
                            S.sf2 = *(const f32x4*)ROW(p, k0, 32 + sr); S.sf3 = *(const f32x4*)(ROW(p, k0, 32 + sr) + 4); } while (0)
#define SWRITE_KF(bf) do { *(bf16x8*)(K_lds + (bf) * SHM_K + kws) = pack8(S.sf0, S.sf1); *(bf16x8*)(K_lds + (bf) * SHM_K + kws + 32 * 256) = pack8(S.sf2, S.sf3); } while (0)
#define SWRITE_VF(bf) do { *(bf16x8*)(V_lds + (bf) * SHM_V + vst0) = pack8(S.sf0, S.sf1); *(bf16x8*)(V_lds + (bf) * SHM_V + vst1) = pack8(S.sf2, S.sf3); } while (0)
template <class TIn, class TOut>
__device__ __forceinline__ void causal_swa_prime(const BlockRef<TIn, TOut>& cur, int W, char* lds, Seam<TIn>& S) {
    constexpr bool F32 = same_t<TIn, float>::v;
    const int tid = threadIdx.x, wid = __builtin_amdgcn_readfirstlane(tid >> 6), lane = tid & 63, r32 = lane & 31, hi = lane >> 5;
    const int sr = tid >> 4, sc = (tid & 15) * 8, kws = KSWZ(sr, sc * 2); char* K_lds = lds + 2 * SHM_V; float* cbw = (float*)(lds + OFF_CB);
    const int kb0 = cur.jlo * KVBLK;
    for (int d0 = 0; d0 < 8; ++d0) S.qr[d0] = load8<TIn>(cur.Q + (size_t)(wid * QBLK + r32) * LDQ + d0 * 16 + hi * 8);
    S.cq = cur.C[cur.P0 + wid * QBLK + r32];
    if constexpr (F32) { SLOAD_F((const float*)cur.K, kb0); VMW(); SWRITE_KF(0); SBAR(); SLOAD_F((const float*)cur.V, kb0); }
    else { SLOAD_H(cur.K, cur.V, cur.C, kb0); VMW(); SWRITE_HK(0); }
    __syncthreads();
}
template <class TIn, class TOut>
__device__ __forceinline__ void causal_swa_block(const BlockRef<TIn, TOut>& cur, const BlockRef<TIn, TOut>& nxt, int skv, int W, char* lds, Seam<TIn>& S, unsigned* qhead, volatile __attribute__((address_space(3))) int* qw, bool qmore) {
    constexpr bool F32 = same_t<TIn, float>::v;
    const int tid = threadIdx.x, wid = __builtin_amdgcn_readfirstlane(tid >> 6), lane = tid & 63, r32 = lane & 31, hi = lane >> 5;
    int pop_ = 1 << 30; if (threadIdx.x == 0 && qmore) pop_ = (int)atomicAdd(qhead, 1u);
    const int j_lo = cur.jlo;
    int j_hi = (cur.P0 + QB - 1) / KVBLK + 1; if (j_hi > skv / KVBLK) j_hi = skv / KVBLK;
    const int NT = j_hi - j_lo;
    const int kbn = nxt.jlo * KVBLK;
    const int qlo = cur.P0 + wid * QBLK, qm = qlo + r32 - 4 * hi;
    char* V_lds = lds; char* K_lds = lds + 2 * SHM_V; float* cbw = (float*)(lds + OFF_CB); const float* cbt = cbw + 4 * hi; const float* Ch = cur.C;
    float* ws = (float*)(lds + 2 * SHM_V + 2 * SHM_K) + wid * 64; float* li_l = ws, * al_l = ws + 32;
    float m_reg = cur.mref, l_reg = 0; f32x16 o[4] = {};
    const int sr = tid >> 4, sc = (tid & 15) * 8, vst0 = v_st(sr, sc), vst1 = v_st(32 + sr, sc), kws = KSWZ(sr, sc * 2);
    const int vb0 = (int)(uintptr_t)V_lds + v_rd_base(lane);
    const TIn* Kh = cur.K; const TIn* Vh = cur.V;
#define RESC(a) do { (void)(a); (void)al_l; } while (0)
#define KBASE(t) ((j_lo + (t)) * KVBLK)
#define ACT(t) (KBASE(t) <= qlo + QBLK - 1 && KBASE(t) + KVBLK - 1 >= qlo - W + 1)
#define MASKT(P0_, P1_, t) do { const int kb_ = KBASE(t); if ((!SK || ACT(t)) && (kb_ + KVBLK - 1 > qlo || kb_ <= qlo + QBLK - 1 - W)) mask_tile(P0_, P1_, qm - kb_, (unsigned)W); } while (0)
    constexpr int NQL = F32 ? 16 : 9;
    constexpr bool SK = WSKIP && !F32;
#define SEAM_K0() do { VMWN(NQL); if constexpr (F32) { SWRITE_KF(0); SBAR(); SLOAD_F((const float*)nxt.V, kbn); } else { SWRITE_HK(0); } SBAR(); } while (0)
    f32x16 pA0, pA1, pB0, pB1; float mnA, mnB, alA, alB; bf16x8 pa0, pa1, pa2, pa3;
    if constexpr (F32) { VMW(); SWRITE_VF(0); SBAR(); } else { SWRITE_HV(0); SBAR(); }
    if (NT > 1) { if constexpr (F32) SLOAD_F((const float*)Kh, KBASE(1)); else SLOAD_H(Kh, Vh, Ch, KBASE(1)); }
    SBAR(); qkt<0, SK>(pA0, pA1, K_lds, r32, hi, S.qr, ACT(0), cbt, S.cq);
    if constexpr (F32) { if (NT > 1) { VMW(); SWRITE_KF(1); SBAR(); SLOAD_F((const float*)Vh, KBASE(1)); } }
    MASKT(pA0, pA1, 0); partialSM(pA0, pA1, m_reg, mnA, alA);
    if (NT > 1) { VMW(); if constexpr (F32) { SWRITE_VF(1); SBAR(); if (NT > 2) SLOAD_F((const float*)Kh, KBASE(2)); } else SWRITE_H(1); }
    if (tid == 0) qw[0] = pop_;
    __syncthreads();
#define HALF_STEP(PX0, PX1, mnX, alX, PY0, PY1, alY, t, KB, VB, SB) do {                                                      \
        SBAR(); qkt<KB, SK>(PX0, PX1, K_lds, r32, hi, S.qr, ACT(t), cbt, S.cq);                                  \
        finishSM(PY0, PY1, alY, l_reg, pa0, pa1, pa2, pa3); SBAR();                                                           \
        if ((t) + 1 < NT) { if constexpr (F32) { VMW(); SWRITE_KF(SB); SBAR(); SLOAD_F((const float*)Vh, KBASE((t) + 1)); }  \
                            else { SLOAD_H(Kh, Vh, Ch, KBASE((t) + 1)); } SBAR(); }                                           \
        pv_tile<VB, SK>(o, vb0, pa0, pa1, pa2, pa3, ACT((t) - 1)); MASKT(PX0, PX1, (t)); partialSM(PX0, PX1, m_reg, mnX, alX);                                        \
        __syncthreads();                                                                                                      \
        if ((t) + 1 < NT) { VMW(); if constexpr (F32) { SWRITE_VF(SB); SBAR(); if ((t) + 2 < NT) SLOAD_F((const float*)Kh, KBASE((t) + 2)); } \
                            else { SWRITE_H(SB); } }                                                                          \
        RESC(alX); __syncthreads(); } while (0)
    for (int t = 1; t + 1 < NT; t += 2) {
        HALF_STEP(pB0, pB1, mnB, alB, pA0, pA1, alA, t, 1, 0, 0);
        HALF_STEP(pA0, pA1, mnA, alA, pB0, pB1, alB, t + 1, 0, 1, 1);
    }
    int r32s = r32, his = hi; asm volatile("" : "+v"(r32s), "+v"(his));
    const bool even = (NT & 1) == 0;
    if (even) { SBAR(); qkt<1, SK>(pB0, pB1, K_lds, r32, hi, S.qr, ACT(NT - 1), cbt, S.cq); SBAR(); }
#define QROW(e) (nxt.Q + (size_t)(wid * QBLK + r32) * LDQ + ((e) >> 1) * 16 + hi * 8 + ((e) & 1) * 4)
    if constexpr (F32) { SLOAD_F((const float*)nxt.K, kbn); SBAR();
#pragma unroll
        for (int e = 0; e < 8; ++e) S.tq[e] = *(const f32x4*)QROW(e); }
    else { SLOAD_H(nxt.K, nxt.V, nxt.C, kbn); SBAR();
#pragma unroll
        for (int d0 = 0; d0 < 8; ++d0) S.qr[d0] = load8<TIn>(nxt.Q + (size_t)(wid * QBLK + r32s) * LDQ + d0 * 16 + his * 8);
        S.cq = nxt.C[nxt.P0 + wid * QBLK + r32s]; }
    SBAR();
    finishSM(pA0, pA1, alA, l_reg, pa0, pa1, pa2, pa3); SBAR();
    if constexpr (F32) {
#pragma unroll
        for (int e = 8; e < 16; ++e) S.tq[e] = *(const f32x4*)QROW(e); SBAR(); }
#undef QROW
    pv_tile<0, SK>(o, vb0, pa0, pa1, pa2, pa3, ACT(even ? NT - 2 : NT - 1));
    if (even) { MASKT(pB0, pB1, NT - 1); partialSM(pB0, pB1, m_reg, mnB, alB); __syncthreads(); RESC(alB);
        finishSM(pB0, pB1, alB, l_reg, pa0, pa1, pa2, pa3); SBAR(); pv_tile<1, SK>(o, vb0, pa0, pa1, pa2, pa3, ACT(NT - 1)); }
    SBAR(); SEAM_K0();
    if (his == 0) li_l[r32s] = l_reg; asm volatile("s_waitcnt lgkmcnt(0)" ::: "memory");
    float rli[16];
#pragma unroll
    for (int r = 0; r < 16; ++r) rli[r] = __builtin_amdgcn_rcpf(li_l[crow(r, his)]);
    TOut* Ow = cur.O + (size_t)(wid * QBLK) * LDO;
#pragma unroll
    for (int r = 0; r < 16; ++r) { const int orow = crow(r, his);
#pragma unroll
        for (int d0 = 0; d0 < 4; ++d0) { const float v = o[d0][r] * rli[r];
            if constexpr (same_t<TOut, float>::v) { Ow[(size_t)orow * LDO + d0 * 32 + r32] = v; }
            else { const float vn = __shfl_xor(v, 1);
                   if ((r32s & 1) == 0) *(unsigned*)(Ow + (size_t)orow * LDO + d0 * 32 + r32s) = cvtpk(v, vn); } } }
    if constexpr (F32) {
#pragma unroll
        for (int d0 = 0; d0 < 8; ++d0) S.qr[d0] = pack8(S.tq[2 * d0], S.tq[2 * d0 + 1]); }
    __syncthreads();
#undef RESC
#undef KBASE
#undef ACT
#undef MASKT
#undef SEAM_K0
#undef HALF_STEP
}
#undef ROW
#undef VMW
#undef VMWN
#undef SLOAD_H
#undef SWRITE_HK
#undef SWRITE_HV
#undef SWRITE_H
#undef SLOAD_F
#undef SWRITE_KF
#undef SWRITE_VF


constexpr int QB2 = 128, NQB2 = SQ / QB2, SHM_V2 = 2 * SHM_V;
constexpr int P_OFF_K = 2 * SHM_V2, P_OFF_X = P_OFF_K + 2 * SHM_K, PAIR_RING = P_OFF_X + 2 * NW * 2048;
constexpr int P_OFF_L = PAIR_RING + 2048, P_OFF_CB = P_OFF_L + NW * 64 * 4, PAIR_LDS = P_OFF_CB + 2 * 64 * 4;
struct PRef { const bf16* Q; const bf16* K; const bf16* V; bf16* O; const float* C; int P0, jlo; float mref; };
template <int BUF, int NV>
__device__ __forceinline__ void pair_pv(f32x16* o, int vb0, bf16x8 pa0, bf16x8 pa1, bf16x8 pa2, bf16x8 pa3) {
#define TRRD(dst, off) asm volatile("ds_read_b64_tr_b16 %0, %1 offset:%2" : "=&v"(dst) : "v"(vb0), "i"(off) : "memory")
#define PV_D0(d0) do { s16x4 l0, l1, l2, l3, h0, h1, h2, h3; constexpr int b_ = BUF * SHM_V2 + v_rd_off(d0, 0, 0); \
        TRRD(l0, b_); TRRD(h0, b_ + 2048); TRRD(l1, b_ + 4096); TRRD(h1, b_ + 6144); TRRD(l2, b_ + 8192); TRRD(h2, b_ + 10240); TRRD(l3, b_ + 12288); TRRD(h3, b_ + 14336); \
        asm volatile("s_waitcnt lgkmcnt(0)" ::: "memory"); SBAR(); \
        o[d0] = __builtin_amdgcn_mfma_f32_32x32x16_bf16(pa0, (bf16x8){l0[0], l0[1], l0[2], l0[3], h0[0], h0[1], h0[2], h0[3]}, o[d0], 0, 0, 0); \
        o[d0] = __builtin_amdgcn_mfma_f32_32x32x16_bf16(pa1, (bf16x8){l1[0], l1[1], l1[2], l1[3], h1[0], h1[1], h1[2], h1[3]}, o[d0], 0, 0, 0); \
        o[d0] = __builtin_amdgcn_mfma_f32_32x32x16_bf16(pa2, (bf16x8){l2[0], l2[1], l2[2], l2[3], h2[0], h2[1], h2[2], h2[3]}, o[d0], 0, 0, 0); \
        o[d0] = __builtin_amdgcn_mfma_f32_32x32x16_bf16(pa3, (bf16x8){l3[0], l3[1], l3[2], l3[3], h3[0], h3[1], h3[2], h3[3]}, o[d0], 0, 0, 0); } while (0)
    PV_D0(0); PV_D0(1); if constexpr (NV == 4) { PV_D0(2); PV_D0(3); }
#undef PV_D0
#undef TRRD
}
struct PStage { bf16x8 k0, k1, v0, v1, v2, v3; float c; };
template <int NV>
__device__ __forceinline__ void pair_block(const PRef& B, char* lds, volatile __attribute__((address_space(3))) unsigned* PROFW) {
    PROF_T0(2);
    PROF_T0(8);
    const int tid = threadIdx.x, wid = __builtin_amdgcn_readfirstlane(tid >> 6), lane = tid & 63, r32 = lane & 31, hi = lane >> 5, pr = wid & 3, kh = wid >> 2;
    char* V_lds = lds; char* K_lds = lds + P_OFF_K; char* X_lds = lds + P_OFF_X; float* L_lds = (float*)(lds + P_OFF_L); float* cbw = (float*)(lds + P_OFF_CB);
    const int j_lo = B.jlo, NT = (B.P0 >> 6) + 2 - j_lo;
    const int sr = tid >> 4, sc = (tid & 15) * 8, vst0 = v_st(sr, sc), vst1 = v_st(32 + sr, sc), kws = KSWZ(sr, sc * 2);
    const int vb0 = (int)(uintptr_t)V_lds + kh * (NV == 4 ? SHM_V : 1024) + v_rd_base(lane);
    int ka[4];
#pragma unroll
    for (int dd = 0; dd < 4; ++dd) ka[dd] = (int)(uintptr_t)K_lds + kh * (32 * 256) + KSWZ(r32, (dd * 16 + hi * 8) * 2);
    constexpr float C2 = 1.4426950408889634f * SCALE;
    const float mnL = -B.mref * C2;
    const int qrow = B.P0 + pr * 32 + r32;
    bf16x8 qr[8];
#pragma unroll
    for (int d0 = 0; d0 < 8; ++d0) qr[d0] = load8<bf16>(B.Q + (size_t)(pr * 32 + r32) * LDQ + d0 * 16 + hi * 8);
    const float cq = B.C[qrow];
    f32x16 o[NV] = {}; float l_reg = 0.f;
    PStage stA, stB;
#define TCL(t) ((t) < NT ? (t) : NT - 1)
#define PLOADK(st, t) do { const int k0_ = (j_lo + TCL(t)) * KVBLK; const bf16* kp_ = B.K + (size_t)(k0_ + sr) * LDQ + sc; st.k0 = load8<bf16>(kp_); st.k1 = load8<bf16>(kp_ + (size_t)32 * LDQ); st.c = B.C[k0_ + (tid & 63)]; } while (0)
#define PLOADV(st, t) do { const int k0_ = (j_lo + TCL(t)) * KVBLK; const bf16* vp_ = B.V + (size_t)(k0_ + sr) * LDQ + sc; st.v0 = load8<bf16>(vp_); st.v1 = load8<bf16>(vp_ + (size_t)32 * LDQ); \
        if constexpr (NV == 4) { st.v2 = load8<bf16>(vp_ + 128); st.v3 = load8<bf16>(vp_ + (size_t)32 * LDQ + 128); } } while (0)
#define PWRITEK(st, bf) do { *(bf16x8*)(K_lds + (bf) * SHM_K + kws) = st.k0; *(bf16x8*)(K_lds + (bf) * SHM_K + kws + 32 * 256) = st.k1; if (tid < 64) cbw[(bf) * 64 + tid] = st.c; } while (0)
#define PWRITEV(st, bf) do { *(bf16x8*)(V_lds + (bf) * SHM_V2 + vst0) = st.v0; *(bf16x8*)(V_lds + (bf) * SHM_V2 + vst1) = st.v1; \
        if constexpr (NV == 4) { *(bf16x8*)(V_lds + (bf) * SHM_V2 + SHM_V + vst0) = st.v2; *(bf16x8*)(V_lds + (bf) * SHM_V2 + SHM_V + vst1) = st.v3; } } while (0)
#define KRD_(dst, d0, KB) asm volatile("ds_read_b128 %0, %1 offset:%2" : "=&v"(dst) : "v"(ka[(d0) & 3]), "i"((KB) * SHM_K + ((d0) >> 2) * 128) : "memory")
#define KWT_(n, r) asm volatile("s_waitcnt lgkmcnt(" #n ")" : "+v"(r) :: "memory")
#define ASTAGE(t, KB, XB) do { \
        f32x16 p; { const f32x4* c4 = (const f32x4*)(cbw + (KB) * 64 + 32 * kh + 4 * hi); \
            _Pragma("unroll") for (int g = 0; g < 4; ++g) { const f32x4 a = c4[2 * g]; _Pragma("unroll") for (int i = 0; i < 4; ++i) p[4 * g + i] = cq - a[i]; } } \
        { bf16x8 kf0, kf1, kf2, kf3;     \
          KRD_(kf0, 0, KB); KRD_(kf1, 1, KB); KRD_(kf2, 2, KB); KRD_(kf3, 3, KB); \
          KWT_(3, kf0); p = __builtin_amdgcn_mfma_f32_32x32x16_bf16(kf0, qr[0], p, 0, 0, 0); KRD_(kf0, 4, KB); \
          KWT_(3, kf1); p = __builtin_amdgcn_mfma_f32_32x32x16_bf16(kf1, qr[1], p, 0, 0, 0); KRD_(kf1, 5, KB); \
          KWT_(3, kf2); p = __builtin_amdgcn_mfma_f32_32x32x16_bf16(kf2, qr[2], p, 0, 0, 0); KRD_(kf2, 6, KB); \
          KWT_(3, kf3); p = __builtin_amdgcn_mfma_f32_32x32x16_bf16(kf3, qr[3], p, 0, 0, 0); KRD_(kf3, 7, KB); \
          KWT_(3, kf0); p = __builtin_amdgcn_mfma_f32_32x32x16_bf16(kf0, qr[4], p, 0, 0, 0); \
          KWT_(2, kf1); p = __builtin_amdgcn_mfma_f32_32x32x16_bf16(kf1, qr[5], p, 0, 0, 0); \
          KWT_(1, kf2); p = __builtin_amdgcn_mfma_f32_32x32x16_bf16(kf2, qr[6], p, 0, 0, 0); \
          KWT_(0, kf3); p = __builtin_amdgcn_mfma_f32_32x32x16_bf16(kf3, qr[7], p, 0, 0, 0); } \
        { const int kb = (j_lo + (t)) * KVBLK + 32 * kh; if (kb + 31 > B.P0 + pr * 32) { const int dq = qrow - kb - 4 * hi; const float NEG = -__builtin_inff(); \
            _Pragma("unroll") for (int r = 0; r < 16; ++r) { const int c = (r & 3) + 8 * (r >> 2); if (dq - c < 0) p[r] = NEG; } } } \
        _Pragma("unroll") for (int r = 0; r < 16; ++r) p[r] = __builtin_amdgcn_exp2f(fmaf(p[r], C2, mnL)); \
        { float ps = 0.f; _Pragma("unroll") for (int r = 0; r < 16; ++r) ps += p[r]; \
          auto rr = __builtin_amdgcn_permlane32_swap(__float_as_uint(ps), __float_as_uint(ps), false, false); l_reg += __uint_as_float(rr[0]) + __uint_as_float(rr[1]); } \
        { unsigned a0 = cvtpk(p[0], p[1]), a1 = cvtpk(p[2], p[3]), b0 = cvtpk(p[4], p[5]), b1 = cvtpk(p[6], p[7]); \
          auto r0 = __builtin_amdgcn_permlane32_swap(a0, b0, false, false); auto r1 = __builtin_amdgcn_permlane32_swap(a1, b1, false, false); u32x4 w = {r0[0], r1[0], r0[1], r1[1]}; \
          *(u32x4*)(X_lds + (XB) * (NW * 2048) + wid * 2048 + lane * 16) = w; } \
        { unsigned a0 = cvtpk(p[8], p[9]), a1 = cvtpk(p[10], p[11]), b0 = cvtpk(p[12], p[13]), b1 = cvtpk(p[14], p[15]); \
          auto r0 = __builtin_amdgcn_permlane32_swap(a0, b0, false, false); auto r1 = __builtin_amdgcn_permlane32_swap(a1, b1, false, false); u32x4 w = {r0[0], r1[0], r0[1], r1[1]}; \
          *(u32x4*)(X_lds + (XB) * (NW * 2048) + wid * 2048 + 1024 + lane * 16) = w; } } while (0)
#define BSTAGE(VB, XB) do { const char* xo_ = X_lds + (XB) * (NW * 2048) + wid * 2048 + lane * 16; const char* xp_ = X_lds + (XB) * (NW * 2048) + (wid ^ 4) * 2048 + lane * 16; \
        const bf16x8 own0 = *(const bf16x8*)xo_, own1 = *(const bf16x8*)(xo_ + 1024), oth0 = *(const bf16x8*)xp_, oth1 = *(const bf16x8*)(xp_ + 1024); \
        pair_pv<VB, NV>(o, vb0, kh ? oth0 : own0, kh ? oth1 : own1, kh ? own0 : oth0, kh ? own1 : oth1); } while (0)
    PLOADK(stA, 0); PLOADV(stA, 0); PLOADK(stB, 1); PLOADV(stB, 1);
    __syncthreads();
    PWRITEK(stA, 0); PWRITEV(stA, 0);
    PLOADK(stA, 2);
    __syncthreads();
    PROF_T1(8);
    PROF_T0(9);
    ASTAGE(0, 0, 0);
    PWRITEK(stB, 1);
    PLOADV(stA, 2); PLOADK(stB, 3);
    __syncthreads();
#define PITER(t, P, SV, SK) do {     \
        BSTAGE(P, P); \
        if ((t) + 1 < NT) { ASTAGE((t) + 1, (P) ^ 1, (P) ^ 1); PWRITEV(SV, (P) ^ 1); PWRITEK(SK, P); PLOADV(SV, (t) + 3); PLOADK(SK, (t) + 4); } \
        __syncthreads(); } while (0)
    PROF_T1(9);
    PROF_T1(2);
    { PROF_T0(3);
    int t = 0;
    for (; t + 1 < NT; t += 2) { PITER(t, 0, stB, stA); PITER(t + 1, 1, stA, stB); }
    if (t < NT) PITER(t, 0, stB, stA);
    PROF_T1(3); }
    { PROF_T0(4);
    { PROF_T0(6);
    if (hi == 0) L_lds[wid * 64 + r32] = l_reg;
    __syncthreads();
    PROF_T1(6); }
    PROF_T0(7);
    if (hi == 0) L_lds[wid * 64 + 32 + r32] = l_reg + L_lds[(wid ^ 4) * 64 + r32];
    asm volatile("s_waitcnt lgkmcnt(0)" ::: "memory");
    float rli[16];
#pragma unroll
    for (int r = 0; r < 16; ++r) rli[r] = __builtin_amdgcn_rcpf(L_lds[wid * 64 + 32 + crow(r, hi)]);
    constexpr int OROW = NV * 64 + 16;
    char* ot = lds + wid * (32 * (4 * 64 + 16));
    const bool odd = (r32 & 1) != 0;
#pragma unroll
    for (int r = 0; r < 16; ++r) { const int orow = crow(r, hi);
#pragma unroll
        for (int d0 = 0; d0 < NV; d0 += 2) { const float va = o[d0][r] * rli[r], vb = o[d0 + 1][r] * rli[r];
            const float snd = odd ? va : vb;
            const float rcv = __uint_as_float((unsigned)__builtin_amdgcn_update_dpp(0, (int)__float_as_uint(snd), 0xB1, 0xF, 0xF, true));
            const unsigned pk = cvtpk(odd ? rcv : va, odd ? vb : rcv);
            *(unsigned*)(ot + orow * OROW + ((odd ? d0 + 1 : d0) * 32 + (r32 & ~1)) * 2) = pk; } }
    asm volatile("s_waitcnt lgkmcnt(0)" ::: "memory");
    PROF_T0(10);
    bf16* Ow = B.O + (size_t)(pr * 32) * LDO + kh * (NV * 32);
    constexpr int CPR = NV * 4;
#pragma unroll
    for (int i = 0; i < (32 * CPR) / 64; ++i) { const int idx = i * 64 + lane, row = idx / CPR, ch = idx % CPR;
        const u32x4 w = *(const u32x4*)(ot + row * OROW + ch * 16);
        *(u32x4*)(Ow + (size_t)row * LDO + ch * 8) = w; }
    PROF_T1(10);
    PROF_T1(7);
    PROF_T1(4); }
#undef TCL
#undef PLOADK
#undef PLOADV
#undef PWRITEK
#undef PWRITEV
#undef KRD_
#undef KWT_
#undef ASTAGE
#undef BSTAGE
#undef PITER
}

constexpr float SKIP_T = 20.f;
constexpr int NDIFF = 16 * NQB2, NFOX = 16 * NQB2;
struct Tensors { const bf16* QKV; bf16* A2; bf16* DT; const float* BIAS; const unsigned* NRM; };
__host__ __device__ constexpr int est_diff(int h, int qb2) { const int full = 2 * (qb2 + 1), cap = h == 0 ? 12 : (h == 1 ? 24 : (h == 2 ? 62 : 128)); return full < cap ? full : cap; }
__host__ __device__ constexpr int est_fox(int qb2) { const int full = 2 * (qb2 + 1); return full < 20 ? full : 20; }
struct OrderTab2 { unsigned short v[NDIFF]; };
template <bool FOX> __host__ __device__ constexpr OrderTab2 make_order2() {
    OrderTab2 t{}; int start[130] = {};
    for (int pp = 0; pp < 16; ++pp) for (int qb = 0; qb < NQB2; ++qb) start[128 - (FOX ? est_fox(qb) : est_diff((pp >> 1) & 3, qb)) + 1]++;
    for (int i = 1; i < 130; ++i) start[i] += start[i - 1];
    for (int pp = 0; pp < 16; ++pp) for (int qb = NQB2 - 1; qb >= 0; --qb) { const int b = 128 - (FOX ? est_fox(qb) : est_diff((pp >> 1) & 3, qb)); t.v[start[b]++] = (unsigned short)(pp * 64 + qb); }
    return t;
}
__device__ const OrderTab2 ORDER_D = make_order2<false>();
__device__ const OrderTab2 ORDER_F = make_order2<true>();
constexpr int ORD_OFF = PAIR_LDS, NRMW_OFF = ORD_OFF + NDIFF * 2;
template <bool FOX>
__device__ __forceinline__ PRef make_pref(const Tensors& T, const char* lds, int o, int lane) {
    const int code = __builtin_amdgcn_readfirstlane((int)((const unsigned short*)(lds + ORD_OFF))[o]), pp = code >> 6, qb = code & 63, b = pp >> 3;
    PRef r; int sq, sk;
    const bf16* base = T.QKV + (size_t)b * S * LDQ; r.P0 = qb * QB2;
    if (FOX) { const int h = pp & 7; r.Q = base + (size_t)qb * QB2 * LDQ + C_FQ + h * 128; r.K = base + C_FK + h * 128; r.V = base + C_FV + h * 128; sq = h; sk = 8 + h;
        r.O = T.A2 + ((size_t)b * S + (size_t)qb * QB2) * LDO + h * 128; r.C = T.BIAS + (size_t)(b * 8 + h) * S; }
    else { const int h = (pp >> 1) & 3, mp = pp & 1; r.Q = base + (size_t)qb * QB2 * LDQ + C_DQ + h * 256 + mp * 128; r.K = base + C_DK + h * 256 + mp * 128; r.V = base + C_DV + h * 256; sq = 16 + 2 * h + mp; sk = 24 + 2 * h + mp;
        r.O = T.DT + ((size_t)b * S + (size_t)qb * QB2) * LDO + h * 512 + mp * 256; r.C = T.BIAS + (size_t)(16 + h) * S; }
    const int jd = r.P0 >> 6;
    int ln = lane; asm volatile("" : "+v"(ln));
    const int j0 = ln < jd ? ln : jd, j1 = ln + 64 < jd ? ln + 64 : jd;
    const float cp = r.C[r.P0], c0 = r.C[64 * j0 + 63], c1 = r.C[64 * j1 + 63];
    const float nq = ((const float*)(lds + NRMW_OFF))[b * 32 + sq], nk = ((const float*)(lds + NRMW_OFF))[b * 32 + sk];
    const float qk = 1.015f * sqrtf(nq * nk);
    const float th = (SKIP_T + 2.f * qk * SCALE) * (1.0f / SCALE), lim = cp + th; r.mref = qk;
    const bool k0 = (ln >= jd) | (c0 <= lim), k1 = (ln + 64 >= jd) | (c1 <= lim);
    const unsigned long long b0 = __ballot(k0), b1 = __ballot(k1);
    r.jlo = b0 ? (int)__builtin_ctzll(b0) : 64 + (int)__builtin_ctzll(b1);
    return r;
}
template <bool FOX>
__device__ __forceinline__ void attn_part(char* lds, const Tensors& T, unsigned* head, volatile __attribute__((address_space(3))) int* qw) {
    volatile __attribute__((address_space(3))) unsigned* PROFW = (volatile __attribute__((address_space(3))) unsigned*)(qw + 8);
    PROF_T0(5);
    const int tid = threadIdx.x, lane = tid & 63;
    if (tid == 0) qw[0] = (int)atomicAdd(head, 1u);
    ((unsigned*)(lds + ORD_OFF))[tid] = ((const unsigned*)(FOX ? ORDER_F.v : ORDER_D.v))[tid];
    if (tid < 64) ((unsigned*)(lds + NRMW_OFF))[tid] = T.NRM[tid];
    __syncthreads();
    int k = __builtin_amdgcn_readfirstlane(qw[0]);
    while (k < NDIFF) {
        int kn = 0; if (tid == 0) kn = (int)atomicAdd(head, 1u);
        PROF_T0(1);
        const PRef B = make_pref<FOX>(T, lds, k, lane);
        PROF_T1(1);
        pair_block<FOX ? 2 : 4>(B, lds, PROFW);
        if (tid == 0) qw[1] = kn;
        __syncthreads();
        k = __builtin_amdgcn_readfirstlane(qw[1]);
    }
    __syncthreads();
    PROF_T1(5);
}
#undef KSWZ
#undef SBAR
}

#define GAS __attribute__((address_space(1)))
#define LAS __attribute__((address_space(3)))
typedef unsigned short bf16;
typedef unsigned v4u __attribute__((ext_vector_type(4)));
typedef float f32x4 __attribute__((ext_vector_type(4)));
typedef short bf16x8 __attribute__((ext_vector_type(8)));
typedef GAS unsigned gu32;
typedef GAS unsigned long long gu64;
#define RLX_AGENT __ATOMIC_RELAXED, __HIP_MEMORY_SCOPE_AGENT
#define LDS_WAIT() asm volatile("s_waitcnt lgkmcnt(0)" ::: "memory")
#define VM_WAIT() asm volatile("s_waitcnt vmcnt(0)" ::: "memory")
__device__ __forceinline__ unsigned long long rt() { return __builtin_amdgcn_s_memrealtime(); }
__device__ __forceinline__ unsigned f2bf(float f) { unsigned u = __builtin_bit_cast(unsigned, f); return (u + 0x7fffu + ((u >> 16) & 1u)) >> 16; }
__device__ __forceinline__ unsigned pk2(float lo, float hi) { return f2bf(lo) | (f2bf(hi) << 16); }

#define XB_TMO      128
#define XB_XCNT(j)  (256  + 64 * (j))
#define XB_XSUB(j)  (1280 + 64 * (j))
#define XB_XGEN(j)  (2304 + 64 * (j))
#define XB_TOP      3328
#define XB_TOPGEN   3392
#define XCD_BAR_WORDS 3456
#define XB_SPIN_CAP (1u << 18)

__device__ __forceinline__ unsigned xb_ld(unsigned* p)              { return __hip_atomic_load(p, __ATOMIC_RELAXED, __HIP_MEMORY_SCOPE_AGENT); }
__device__ __forceinline__ unsigned xb_add(unsigned* p, unsigned v) { return __hip_atomic_fetch_add(p, v, __ATOMIC_RELAXED, __HIP_MEMORY_SCOPE_AGENT); }
__device__ __forceinline__ unsigned xb_xcc_id() { return (unsigned)__builtin_amdgcn_s_getreg((3 << 11) | 20) & 0xFu; }
#define XB_SPIN(cond, bar) do { unsigned _sp = 0; while (cond) { __builtin_amdgcn_s_sleep(1); \
    if ((++_sp & 255u) == 0u) { if (xb_ld(&(bar)[XB_TMO])) break; if (_sp > XB_SPIN_CAP) { atomicAdd(&(bar)[XB_TMO], 1u); break; } } } } while (0)

struct XcdBarrier {
    unsigned* bar; unsigned x;
    volatile LAS unsigned* st;
};

__device__ __forceinline__ XcdBarrier xcd_barrier_post(unsigned* bar, volatile LAS unsigned* st) {
    XcdBarrier b; b.bar = bar; b.x = xb_xcc_id(); b.st = st;
    if (threadIdx.x == 0) (void)xb_add(&bar[XB_XCNT(b.x)], 1u);
    return b;
}
__device__ __forceinline__ void xcd_barrier_complete(unsigned* bar, unsigned x, unsigned& nloc, unsigned& nx) {
    const unsigned G = gridDim.x * gridDim.y * gridDim.z;
    unsigned sum, cnt, mine, sp = 0u;
    for (;;) {
        sum = 0u; cnt = 0u; mine = 0u;
#pragma unroll
        for (unsigned j = 0; j < 16; ++j) { const unsigned c = xb_ld(&bar[XB_XCNT(j)]); sum += c; cnt += (c > 0u) ? 1u : 0u; mine = (j == x) ? c : mine; }
        if (sum == G) break;
        __builtin_amdgcn_s_sleep(1);
        if ((++sp & 255u) == 0u) { if (xb_ld(&bar[XB_TMO])) break; if (sp > XB_SPIN_CAP) { atomicAdd(&bar[XB_TMO], 1u); break; } }
    }
    nloc = mine > 0u ? mine : 1u; nx = cnt > 0u ? cnt : 1u;
}

__device__ __forceinline__ void xcd_barrier(const XcdBarrier& b) {
    asm volatile("s_waitcnt vmcnt(0)" ::: "memory");
    __syncthreads();
    if (threadIdx.x == 0) {
        unsigned* bar = b.bar;
        __builtin_amdgcn_s_waitcnt(0);
        unsigned nloc = b.st[0], nx = b.st[1];
        if (nloc == 0u) { xcd_barrier_complete(bar, b.x, nloc, nx); b.st[0] = nloc; b.st[1] = nx; }
        const unsigned old = xb_add(&bar[XB_XSUB(b.x)], 1u);
        const unsigned gen = old / nloc;
        if (old + 1u == (gen + 1u) * nloc) {
            __builtin_amdgcn_fence(__ATOMIC_RELEASE, "agent");
            asm volatile("s_waitcnt vmcnt(0)" ::: "memory");
            const unsigned og = xb_add(&bar[XB_TOP], 1u);
            const unsigned tg = og / nx;
            if (og + 1u == (tg + 1u) * nx) xb_add(&bar[XB_TOPGEN], 1u);
            else XB_SPIN(xb_ld(&bar[XB_TOPGEN]) == tg, bar);
            __builtin_amdgcn_fence(__ATOMIC_ACQUIRE, "agent");
            xb_add(&bar[XB_XGEN(b.x)], 1u);
            asm volatile("s_waitcnt vmcnt(0)" ::: "memory");
        } else {
            XB_SPIN(xb_ld(&bar[XB_XGEN(b.x)]) == gen, bar);
            __builtin_amdgcn_fence(__ATOMIC_ACQUIRE, "agent");
            asm volatile("s_waitcnt vmcnt(0)" ::: "memory");
        }
    }
    __syncthreads();
}

constexpr int NWAVES = 8;
constexpr int RING_OFF = 0, RING_BYTES = 131072;
constexpr int LDSCTL_OFF = RING_BYTES, MISC_OFF = LDSCTL_OFF + 320;
constexpr int SEG_OFF = LDSCTL_OFF + 1024;
constexpr int TILE_E_OFF = LDSCTL_OFF + 2048;
constexpr int TILE_RB_OFF = TILE_E_OFF + 1024;
constexpr int ECAP = M;
constexpr int NRMP_OFF = LDSCTL_OFF + 4096;
constexpr int LDS_BYTES = 147456;
constexpr int ATT_QW_OFF = LDSCTL_OFF + 512;
static_assert(att::PAIR_RING == RING_BYTES && att::PAIR_LDS <= LDS_BYTES && att::P_OFF_L >= ATT_QW_OFF + 64 && att::LDS_BYTES <= RING_BYTES && TILE_E_OFF + NTILE_MAX * 4 <= LDS_BYTES, "LDS map");

struct Args { const float* in[19]; float* out; unsigned char* ws; int ph_lo, ph_hi, li, pad; };

struct Ctx {
    LAS unsigned char* lds; int tid, lane, wave, G, gw, NGW;
    const float *x, *attn_g, *w_in, *fbias, *lq1, *lk1, *lq2, *lk2, *subg, *w_out, *ffn_g, *wg, *bg, *we, *be, *wgate, *wup, *wdown, *fin_g;
    float* out;
    bf16* A1; bf16* WIN; bf16* WOUT; float* BIAS; bf16* QKV; bf16* A2; bf16* DT; bf16* H1;
    int* tok_e; int* tok_pos; float* tok_gate; float* rstd; float* rowgate; int* rowtok; int* etok; float* egate; float* WR; bf16* XG; bf16* HB; bf16* Y; bf16* WGU; bf16* WD; unsigned* cnt; unsigned* nrm;
};
__device__ __forceinline__ float wave_sum(float v) {
#pragma unroll
    for (int o = 1; o < 64; o <<= 1) v += __shfl_xor(v, o);
    return v;
}
typedef unsigned v2u __attribute__((ext_vector_type(2)));

__device__ __forceinline__ void p0_row(const Ctx& C, int t, const LAS float* wf) {
    const int lane = C.lane; const float* xr = C.x + (size_t)t * DM;
    f32x4 v[8]; float ss = 0.f;
#pragma unroll
    for (int j = 0; j < 8; ++j) { v[j] = *(const f32x4*)(xr + j * 256 + lane * 4); ss += (v[j].x * v[j].x + v[j].y * v[j].y) + (v[j].z * v[j].z + v[j].w * v[j].w); }
    const float r = 1.f / sqrtf(wave_sum(ss) * (1.f / DM) + 1e-6f);
    float fl[8] = {0.f, 0.f, 0.f, 0.f, 0.f, 0.f, 0.f, 0.f};
#pragma unroll
    for (int j = 0; j < 8; ++j) {
        const f32x4 gg = *(const f32x4*)(C.attn_g + j * 256 + lane * 4);
        v[j] = v[j] * r * gg;
        v2u o; o.x = pk2(v[j].x, v[j].y); o.y = pk2(v[j].z, v[j].w);
        *(v2u*)(C.A1 + (size_t)t * DM + j * 256 + lane * 4) = o;
#pragma unroll
        for (int h = 0; h < 8; ++h) { const f32x4 w4 = *(const LAS f32x4*)(wf + h * DM + j * 256 + lane * 4); fl[h] += (v[j].x * w4.x + v[j].y * w4.y) + (v[j].z * w4.z + v[j].w * w4.w); }
        asm volatile("" ::: "memory");
    }
#pragma unroll
    for (int h = 0; h < 8; ++h) fl[h] = wave_sum(fl[h]);
    float z = fl[0];
#pragma unroll
    for (int h = 1; h < 8; ++h) z = (lane == h) ? fl[h] : z;
    if (lane < 8) { z += C.fbias[lane]; const float ls = fminf(z, 0.f) - log1pf(expf(-fabsf(z)));
        C.BIAS[(size_t)((t / S) * 8 + lane) * S + (t % S)] = ls; }
}
__device__ __forceinline__ void tr_item(const float* src, int ld, int k0, int c0, bf16* dst, int K, int r0, LAS float* scr, int lane) {
#pragma unroll 8
    for (int i = 0; i < 32; ++i) { const int kk = 2 * i + (lane >> 5); scr[kk * 33 + (lane & 31)] = src[(size_t)(k0 + kk) * ld + c0 + (lane & 31)]; }
    LDS_WAIT(); asm volatile("" ::: "memory");
    const int c = lane & 7;
#pragma unroll
    for (int j = 0; j < 4; ++j) { const int n = (lane >> 3) + 8 * j; const LAS float* s = scr + (8 * c) * 33 + n;
        v4u o; o.x = pk2(s[0 * 33], s[1 * 33]); o.y = pk2(s[2 * 33], s[3 * 33]); o.z = pk2(s[4 * 33], s[5 * 33]); o.w = pk2(s[6 * 33], s[7 * 33]);
        *(GAS v4u*)(dst + (size_t)(r0 + n) * K + k0 + 8 * c) = o; }
    LDS_WAIT(); asm volatile("" ::: "memory");
}
__device__ __forceinline__ void p0_prologue(const Ctx& C) {
    LAS float* scr = (LAS float*)(C.lds + RING_OFF + C.wave * 16384);
    constexpr int I_WIN = 32 * 192, I_WOUT = 32 * 64, I_ALL = I_WIN + I_WOUT;
    for (int it = C.gw; it < I_ALL; it += C.NGW) {
        int r = it;
        if (r < I_WIN) { const int kb = r / 192, nb = r % 192; tr_item(C.w_in, NCOL, 64 * kb, nb < 96 ? 32 * nb : 32 * nb + 8, C.WIN, DM, 32 * nb, scr, C.lane); continue; } r -= I_WIN;
        { const int kb = r / 64, nb = r % 64; tr_item(C.w_out, DM, 64 * kb, 32 * nb, C.WOUT, DM, 32 * nb, scr, C.lane); }
    }
    __syncthreads();
    { LAS float* wf = (LAS float*)(C.lds + RING_OFF);
      for (int k = C.tid; k < DM; k += NWAVES * 64) { const float* wr = C.w_in + (size_t)k * NCOL + FCOL; const f32x4 w0 = *(const f32x4*)wr, w1 = *(const f32x4*)(wr + 4);
          wf[0 * DM + k] = w0.x; wf[1 * DM + k] = w0.y; wf[2 * DM + k] = w0.z; wf[3 * DM + k] = w0.w; wf[4 * DM + k] = w1.x; wf[5 * DM + k] = w1.y; wf[6 * DM + k] = w1.z; wf[7 * DM + k] = w1.w; }
      __syncthreads();
      for (int t = C.gw; t < M; t += C.NGW) p0_row(C, t, wf); }
    const int gt = C.gw * 64 + C.lane, NGT = C.NGW * 64;
    for (int i = gt; i < 4 * S; i += NGT) { const int h = i / S, s = i % S; C.BIAS[(size_t)(16 + h) * S + s] = -exp2f(-2.f * (float)(h + 1)) * (float)s * ATT_ISCALE; }
    for (int i = gt; i < 64 * 5 * 2 * 64; i += NGT) { const int ln = i & 63, hl = (i >> 6) & 1, b = (i >> 7) % 5, kk = (i >> 7) / 5, c = 16 * b + (ln & 15);
        unsigned w[4];
#pragma unroll
        for (int jp = 0; jp < 4; ++jp) { unsigned pk = 0;
#pragma unroll
            for (int q = 0; q < 2; ++q) { const int k = 32 * kk + 8 * (ln >> 4) + 2 * jp + q;
                const float v = (c < 8 ? C.wg[(size_t)k * 8 + c] : (c < 72 ? C.we[(size_t)k * NE + c - 8] : 0.f)) * C.ffn_g[k];
                const unsigned h = f2bf(v); const unsigned l = f2bf(v - __uint_as_float(h << 16));
                pk |= (hl ? l : h) << (16 * q); }
            w[jp] = pk; }
        ((v4u*)C.WR)[i] = (v4u){w[0], w[1], w[2], w[3]}; }
}
__device__ __forceinline__ void p1_cumsum(const Ctx& C) {
    if (blockIdx.x >= 16) return;
    float* p = C.BIAS + (size_t)blockIdx.x * S + C.tid * 16; LAS float* wt = (LAS float*)(C.lds + RING_OFF);
    float loc[16]; float s = 0.f;
    { const f32x4 a = *(const f32x4*)p, b = *(const f32x4*)(p + 4), c = *(const f32x4*)(p + 8), d = *(const f32x4*)(p + 12);
      loc[0] = a.x; loc[1] = a.y; loc[2] = a.z; loc[3] = a.w; loc[4] = b.x; loc[5] = b.y; loc[6] = b.z; loc[7] = b.w; loc[8] = c.x; loc[9] = c.y; loc[10] = c.z; loc[11] = c.w; loc[12] = d.x; loc[13] = d.y; loc[14] = d.z; loc[15] = d.w; }
#pragma unroll
    for (int i = 0; i < 16; ++i) { s += loc[i]; loc[i] = s; }
    float inc = s;
#pragma unroll
    for (int o = 1; o < 64; o <<= 1) { const float q = __shfl_up(inc, o); if (C.lane >= o) inc += q; }
    if (C.lane == 63) wt[C.wave] = inc;
    __syncthreads();
    float base = inc - s;
    for (int w = 0; w < C.wave; ++w) base += wt[w];
#pragma unroll
    for (int i = 0; i < 16; ++i) loc[i] = (base + loc[i]) * ATT_ISCALE;
    *(f32x4*)p = (f32x4){loc[0], loc[1], loc[2], loc[3]}; *(f32x4*)(p + 4) = (f32x4){loc[4], loc[5], loc[6], loc[7]};
    *(f32x4*)(p + 8) = (f32x4){loc[8], loc[9], loc[10], loc[11]}; *(f32x4*)(p + 12) = (f32x4){loc[12], loc[13], loc[14], loc[15]};
    __syncthreads();
}
__device__ __forceinline__ void p_norms(const Ctx& C) {
    const int lane = C.lane, b = C.gw & 1;
    float mx[8] = {0.f, 0.f, 0.f, 0.f, 0.f, 0.f, 0.f, 0.f};
    for (int rr = C.gw >> 1; rr < S; rr += C.NGW >> 1) {
        const bf16* row = C.QKV + (size_t)(b * S + rr) * NQKV + 8 * lane;
#pragma unroll
        for (int i = 0; i < 8; ++i) { const v4u w = *(const v4u*)(row + (i < 4 ? 512 * i : 1024 + 512 * i));
            float ss = 0.f;
#pragma unroll
            for (int c = 0; c < 4; ++c) { const float lo = __uint_as_float(w[c] << 16), hi = __uint_as_float(w[c] & 0xffff0000u); ss += lo * lo + hi * hi; }
            ss += __shfl_xor(ss, 1); ss += __shfl_xor(ss, 2); ss += __shfl_xor(ss, 4); ss += __shfl_xor(ss, 8);
            mx[i] = fmaxf(mx[i], ss); }
    }
    if ((lane & 15) == 0) {
#pragma unroll
        for (int i = 0; i < 8; ++i) atomicMax(C.nrm + b * 32 + 4 * i + (lane >> 4), __float_as_uint(mx[i]));
    }
}
__device__ __forceinline__ void p3_combine(const Ctx& C) {
    const int lane = C.lane;
    const float s1 = wave_sum(C.lq1[lane] * C.lk1[lane] + C.lq1[lane + 64] * C.lk1[lane + 64]);
    const float s2 = wave_sum(C.lq2[lane] * C.lk2[lane] + C.lq2[lane + 64] * C.lk2[lane + 64]);
    const float lam = expf(s1) - expf(s2) + 0.2f;
    const f32x4 gg = *(const f32x4*)(C.subg + lane * 4);
    for (int idx = C.gw; idx < M * 4; idx += C.NGW) {
        const int t = idx >> 2, h = idx & 3;
        const bf16* p = C.DT + (size_t)t * DM + h * 512 + lane * 4;
        const v2u a = *(const v2u*)p, b = *(const v2u*)(p + 256);
        f32x4 d;
        d.x = __uint_as_float(a.x << 16) - lam * __uint_as_float(b.x << 16); d.y = __uint_as_float(a.x & 0xffff0000u) - lam * __uint_as_float(b.x & 0xffff0000u);
        d.z = __uint_as_float(a.y << 16) - lam * __uint_as_float(b.y << 16); d.w = __uint_as_float(a.y & 0xffff0000u) - lam * __uint_as_float(b.y & 0xffff0000u);
        const float ss = wave_sum((d.x * d.x + d.y * d.y) + (d.z * d.z + d.w * d.w));
        const float r = 0.8f / sqrtf(ss * (1.f / 256.f) + 1e-5f);
        v2u o; o.x = pk2(d.x * r * gg.x, d.y * r * gg.y); o.y = pk2(d.z * r * gg.z, d.w * r * gg.w);
        *(v2u*)(C.A2 + (size_t)t * DM + 1024 + h * 256 + lane * 4) = o;
    }
}
__device__ __forceinline__ void p5a_router(const Ctx& C) {
    const int w = C.wave, th = w & 1, ks = w >> 1;
    LAS float* R1 = (LAS float*)(C.lds + RING_OFF);
    LAS float* SS = (LAS float*)(C.lds + RING_OFF + 81920);
    LAS float* RS = SS + 512;
    LAS float* lg = (LAS float*)(C.lds + RING_OFF + 86016);
    for (int tl = (int)blockIdx.x; tl < M / 64; tl += C.G) {
        int lane = C.lane; asm volatile("" : "+v"(lane));
        const int r = lane & 15, g = lane >> 4;
        const int t0 = tl * 64;
        f32x4 acc[2][5];
#pragma unroll
        for (int T = 0; T < 2; ++T)
#pragma unroll
            for (int b = 0; b < 5; ++b) acc[T][b] = (f32x4){0.f, 0.f, 0.f, 0.f};
        float ss[2] = {0.f, 0.f};
        const bf16* hb = C.H1 + (size_t)(t0 + 32 * th) * DM + 512 * ks; const unsigned ho = (unsigned)(r * DM + 8 * g);
        const v4u* wp = (const v4u*)C.WR + (size_t)(16 * ks) * 10 * 64 + lane;
        v4u a[4][2], tb[10];
#define RT_LA(slot, j_) do { _Pragma("unroll") for (int T = 0; T < 2; ++T) a[slot][T] = *(const v4u*)(hb + (ho + (unsigned)(16 * T * DM + 32 * (j_)))); } while (0)
        RT_LA(0, 0);
#pragma unroll
        for (int q = 0; q < 10; ++q) tb[q] = wp[q * 64];
        RT_LA(1, 1); RT_LA(2, 2); RT_LA(3, 3);
#pragma unroll
        for (int j = 0; j < 16; ++j) {
            __builtin_amdgcn_sched_barrier(0);
#pragma unroll
            for (int T = 0; T < 2; ++T)
#pragma unroll
                for (int c = 0; c < 4; ++c) { const unsigned x = a[j & 3][T][c]; const float lo = __uint_as_float(x << 16), hi = __uint_as_float(x & 0xffff0000u); ss[T] += lo * lo + hi * hi; }
#pragma unroll
            for (int b = 0; b < 5; ++b) {
#pragma unroll
                for (int T = 0; T < 2; ++T) acc[T][b] = __builtin_amdgcn_mfma_f32_16x16x32_bf16(__builtin_bit_cast(bf16x8, a[j & 3][T]), __builtin_bit_cast(bf16x8, tb[2 * b]), acc[T][b], 0, 0, 0);
#pragma unroll
                for (int T = 0; T < 2; ++T) acc[T][b] = __builtin_amdgcn_mfma_f32_16x16x32_bf16(__builtin_bit_cast(bf16x8, a[j & 3][T]), __builtin_bit_cast(bf16x8, tb[2 * b + 1]), acc[T][b], 0, 0, 0);
                __builtin_amdgcn_sched_barrier(0);
                if (j + 1 < 16) { tb[2 * b] = wp[((j + 1) * 10 + 2 * b) * 64]; tb[2 * b + 1] = wp[((j + 1) * 10 + 2 * b + 1) * 64]; }
                __builtin_amdgcn_sched_barrier(0);
            }
            if (j + 4 < 16) RT_LA(j & 3, j + 4);
        }
#undef RT_LA
        asm volatile("" ::: "memory");
#pragma unroll
        for (int T = 0; T < 2; ++T) { ss[T] += __int_as_float(__builtin_amdgcn_ds_bpermute((lane ^ 16) << 2, __float_as_int(ss[T]))); ss[T] += __int_as_float(__builtin_amdgcn_ds_bpermute((lane ^ 32) << 2, __float_as_int(ss[T])));
            if (lane < 16) SS[ks * 64 + 16 * (2 * th + T) + lane] = ss[T]; }
        if (ks >= 2) {
#pragma unroll
            for (int T = 0; T < 2; ++T)
#pragma unroll
                for (int b = 0; b < 5; ++b)
#pragma unroll
                    for (int i = 0; i < 4; ++i) R1[((th * 2 + (ks - 2)) * 40 + (T * 5 + b) * 4 + i) * 64 + lane] = acc[T][b][i];
        }
        __syncthreads();
        if (ks < 2) {
#pragma unroll
            for (int T = 0; T < 2; ++T)
#pragma unroll
                for (int b = 0; b < 5; ++b)
#pragma unroll
                    for (int i = 0; i < 4; ++i) { LAS float* q = R1 + ((th * 2 + ks) * 40 + (T * 5 + b) * 4 + i) * 64 + lane; *q = acc[T][b][i] + *q; }
            if (w == 0) { const float s = (SS[lane] + SS[64 + lane]) + (SS[128 + lane] + SS[192 + lane]);
                const float rs = 1.f / sqrtf(s * (1.f / DM) + 1e-6f); RS[lane] = rs; C.rstd[t0 + lane] = rs; }
        }
        __syncthreads();
#pragma unroll
        for (int m = 0; m < 10; ++m) { const int sl = w + 8 * m, T = sl / 20, b = (sl % 20) >> 2, i = sl & 3, tok = 16 * T + 4 * g + i, s2 = sl % 40, hh = sl / 40;
            const float v = R1[((hh * 2 + 0) * 40 + s2) * 64 + lane] + R1[((hh * 2 + 1) * 40 + s2) * 64 + lane];
            lg[tok * 81 + 16 * b + r] = v * RS[tok]; }
        __syncthreads();
        if (w == 0) {
            const int t = t0 + lane; const LAS float* row = lg + lane * 81;
            float gmax = -__builtin_inff(); int gi = 0; float gl[8];
#pragma unroll
            for (int j = 0; j < 8; ++j) { gl[j] = row[j] + C.bg[j]; if (gl[j] > gmax) { gmax = gl[j]; gi = j; } }
            float gs = 0.f;
#pragma unroll
            for (int j = 0; j < 8; ++j) gs += expf(gl[j] - gmax);
            const float gprob = 1.f / gs;
            float l1 = -__builtin_inff(), l2 = -__builtin_inff(); int i1 = 0, i2 = 0;
#pragma unroll
            for (int j = 0; j < 8; ++j) { const float q = row[8 + gi * 8 + j] + C.be[gi * 8 + j];
                if (q > l1) { l2 = l1; i2 = i1; l1 = q; i1 = j; } else if (q > l2) { l2 = q; i2 = j; } }
            const float e2 = expf(l2 - l1), g1 = gprob / (1.f + e2), g2 = gprob * e2 / (1.f + e2);
            const int ea = gi * 8 + i1, eb = gi * 8 + i2;
            LAS unsigned* lc = (LAS unsigned*)(C.lds + RING_OFF + 110592); LAS unsigned* gb = lc + 64;
            lc[lane] = 0u; asm volatile("" ::: "memory");
            const unsigned la = __hip_atomic_fetch_add(lc + ea, 1u, __ATOMIC_RELAXED, __HIP_MEMORY_SCOPE_WORKGROUP); asm volatile("" ::: "memory");
            const unsigned lb = __hip_atomic_fetch_add(lc + eb, 1u, __ATOMIC_RELAXED, __HIP_MEMORY_SCOPE_WORKGROUP); asm volatile("" ::: "memory");
            const unsigned ne = lc[lane]; unsigned gbase = 0u; if (ne) gbase = atomicAdd(C.cnt + lane * CNT_STRIDE, ne);
            gb[lane] = gbase; asm volatile("" ::: "memory");
            const unsigned pa = gb[ea] + la, pb = gb[eb] + lb;
            C.tok_e[t * 2] = ea; C.tok_e[t * 2 + 1] = eb; C.tok_pos[t * 2] = (int)pa; C.tok_pos[t * 2 + 1] = (int)pb; C.etok[ea * ECAP + (int)pa] = t; C.etok[eb * ECAP + (int)pb] = t; C.tok_gate[t * 2] = g1; C.tok_gate[t * 2 + 1] = g2;
        }
        { asm volatile("" ::: "memory"); f32x4 gg[4][2];
#pragma unroll
            for (int j = 0; j < 4; ++j) { gg[j][0] = *(const f32x4*)(C.ffn_g + j * 512 + lane * 8); gg[j][1] = *(const f32x4*)(C.ffn_g + j * 512 + lane * 8 + 4); }
            const int r0 = w ? 9 * (w - 1) : 63, nr = w ? 9 : 1;
#pragma unroll 3
            for (int i = 0; i < nr; ++i) { const int rr = r0 + i; const float rsr = RS[rr]; const bf16* src = C.H1 + (size_t)(t0 + rr) * DM + lane * 8; bf16* dst = C.A1 + (size_t)(t0 + rr) * DM + lane * 8;
#pragma unroll
                for (int j = 0; j < 4; ++j) { const v4u x = *(const v4u*)(src + j * 512); const f32x4 g0 = gg[j][0], g1 = gg[j][1];
                    v4u o; o.x = pk2(__uint_as_float(x.x << 16) * rsr * g0.x, __uint_as_float(x.x & 0xffff0000u) * rsr * g0.y); o.y = pk2(__uint_as_float(x.y << 16) * rsr * g0.z, __uint_as_float(x.y & 0xffff0000u) * rsr * g0.w);
                    o.z = pk2(__uint_as_float(x.z << 16) * rsr * g1.x, __uint_as_float(x.z & 0xffff0000u) * rsr * g1.y); o.w = pk2(__uint_as_float(x.w << 16) * rsr * g1.z, __uint_as_float(x.w & 0xffff0000u) * rsr * g1.w);
                    *(v4u*)(dst + j * 512) = o; } } }
        __syncthreads();
    }
}
__device__ __forceinline__ void build_seg(const Ctx& C) {
    LAS int* seg = (LAS int*)(C.lds + SEG_OFF); LAS int* tile_e = (LAS int*)(C.lds + TILE_E_OFF);
    if (C.wave == 0) { const int p = (int)((C.cnt[C.lane * CNT_STRIDE] + 255u) & ~255u); int inc = p;
#pragma unroll
        for (int o = 1; o < 64; o <<= 1) { const int q = __shfl_up(inc, o); if (C.lane >= o) inc += q; }
        seg[C.lane] = inc - p; if (C.lane == 63) seg[NE] = inc; }
    __syncthreads();
    if (C.tid < NTILE_MAX) { const int row = C.tid * 256; int e = 0; for (int j = 1; j < NE; ++j) if (seg[j] <= row) e = j; tile_e[C.tid] = e; ((LAS int*)(C.lds + TILE_RB_OFF))[C.tid] = e * ECAP - seg[e]; }
    __syncthreads();
}
__device__ __forceinline__ void p5b_dispatch(const Ctx& C) {
    const LAS int* seg = (const LAS int*)(C.lds + SEG_OFF);
    for (int t = C.gw * 64 + C.lane; t < M; t += C.NGW * 64) {
        const int ra = seg[C.tok_e[t * 2]] + C.tok_pos[t * 2], rb = seg[C.tok_e[t * 2 + 1]] + C.tok_pos[t * 2 + 1];
        C.rowgate[ra] = C.tok_gate[t * 2]; C.rowgate[rb] = C.tok_gate[t * 2 + 1]; C.rowtok[ra] = t; C.rowtok[rb] = t;
    }
}
__device__ __forceinline__ void p8_final(const Ctx& C) {
    const LAS int* seg = (const LAS int*)(C.lds + SEG_OFF); const int lane = C.lane;
    for (int t0 = C.gw * 2; t0 < M; t0 += C.NGW * 2) {
        int ra[2], rb[2]; float ga[2], gb[2];
#pragma unroll
        for (int u = 0; u < 2; ++u) { const int t = t0 + u; ra[u] = seg[C.tok_e[t * 2]] + C.tok_pos[t * 2]; rb[u] = seg[C.tok_e[t * 2 + 1]] + C.tok_pos[t * 2 + 1]; ga[u] = C.tok_gate[t * 2]; gb[u] = C.tok_gate[t * 2 + 1]; }
        f32x4 v[2][8]; float ss[2] = {0.f, 0.f};
#pragma unroll
        for (int u = 0; u < 2; ++u) { const bf16* xr = C.H1 + (size_t)(t0 + u) * DM; const bf16* ya = C.Y + (size_t)ra[u] * DM; const bf16* yb = C.Y + (size_t)rb[u] * DM;
#pragma unroll
            for (int j = 0; j < 8; ++j) { const v2u h = *(const v2u*)(xr + j * 256 + lane * 4), a = *(const v2u*)(ya + j * 256 + lane * 4), b = *(const v2u*)(yb + j * 256 + lane * 4);
                v[u][j].x = __uint_as_float(h.x << 16) + (ga[u] * __uint_as_float(a.x << 16) + gb[u] * __uint_as_float(b.x << 16)); v[u][j].y = __uint_as_float(h.x & 0xffff0000u) + (ga[u] * __uint_as_float(a.x & 0xffff0000u) + gb[u] * __uint_as_float(b.x & 0xffff0000u));
                v[u][j].z = __uint_as_float(h.y << 16) + (ga[u] * __uint_as_float(a.y << 16) + gb[u] * __uint_as_float(b.y << 16)); v[u][j].w = __uint_as_float(h.y & 0xffff0000u) + (ga[u] * __uint_as_float(a.y & 0xffff0000u) + gb[u] * __uint_as_float(b.y & 0xffff0000u));
                ss[u] += (v[u][j].x * v[u][j].x + v[u][j].y * v[u][j].y) + (v[u][j].z * v[u][j].z + v[u][j].w * v[u][j].w); } }
#pragma unroll
        for (int u = 0; u < 2; ++u) { const float r = 1.f / sqrtf(wave_sum(ss[u]) * (1.f / DM) + 1e-6f);
#pragma unroll
            for (int j = 0; j < 8; ++j) *(f32x4*)(C.out + (size_t)(t0 + u) * DM + j * 256 + lane * 4) = v[u][j] * r * *(const f32x4*)(C.fin_g + j * 256 + lane * 4); }
    }
}

__global__ void __launch_bounds__(NWAVES * 64, 2) mk_fwd(Args args) {
    extern __shared__ __attribute__((aligned(16))) unsigned char lds[];
    Ctx C;
    C.lds = (LAS unsigned char*)lds; C.tid = threadIdx.x; C.lane = C.tid & 63; C.wave = __builtin_amdgcn_readfirstlane(C.tid >> 6);
    C.G = gridDim.x; C.gw = (int)blockIdx.x * NWAVES + C.wave; C.NGW = C.G * NWAVES;
    C.x = args.in[0]; C.attn_g = args.in[1]; C.w_in = args.in[2]; C.fbias = args.in[3]; C.lq1 = args.in[4]; C.lk1 = args.in[5]; C.lq2 = args.in[6]; C.lk2 = args.in[7];
    C.subg = args.in[8]; C.w_out = args.in[9]; C.ffn_g = args.in[10]; C.wg = args.in[11]; C.bg = args.in[12]; C.we = args.in[13]; C.be = args.in[14];
    C.wgate = args.in[15]; C.wup = args.in[16]; C.wdown = args.in[17]; C.fin_g = args.in[18]; C.out = args.out;
    unsigned char* ws = args.ws;
    C.A1 = (bf16*)(ws + WS_A1); C.WIN = (bf16*)(ws + WS_WIN); C.WOUT = (bf16*)(ws + WS_WOUT); C.BIAS = (float*)(ws + WS_BIAS); C.QKV = (bf16*)(ws + WS_QKV);
    C.A2 = (bf16*)(ws + WS_A2); C.DT = (bf16*)(ws + WS_DT); C.H1 = (bf16*)(ws + WS_H1);
    C.tok_e = (int*)(ws + WS_ROUTE); C.tok_pos = C.tok_e + 2 * M; C.tok_gate = (float*)(C.tok_pos + 2 * M); C.rstd = C.tok_gate + 2 * M; C.rowgate = C.rstd + M; C.rowtok = (int*)(C.rowgate + YROWS);
    C.etok = (int*)(ws + WS_XG); C.egate = (float*)(ws + WS_XG) + (size_t)NE * ECAP;
    C.WR = (float*)(ws + WS_WR); C.XG = (bf16*)(ws + WS_XG); C.HB = (bf16*)(ws + WS_HBUF); C.Y = (bf16*)(ws + WS_Y); C.WGU = (bf16*)(ws + WS_WGU); C.WD = (bf16*)(ws + WS_WD);
    C.cnt = (unsigned*)(ws + WS_CTL) + CW_CNT; C.nrm = (unsigned*)(ws + WS_CTL) + CW_NRM;
    volatile LAS unsigned* MISC = (volatile LAS unsigned*)(C.lds + MISC_OFF);
    for (int u = C.tid; u < (LDS_BYTES - LDSCTL_OFF) / 4; u += NWAVES * 64) ((LAS unsigned*)(C.lds + LDSCTL_OFF))[u] = 0u;
    __syncthreads();
    XcdBarrier bar = xcd_barrier_post((unsigned*)(ws + WS_CTL) + CW_BAR + args.li * XCD_BAR_WORDS, MISC + 8);
    const int lo = args.ph_lo, hi = args.ph_hi;
#define IN(k) (lo <= (k) && (k) < hi)
#define SEAM(k) do { if (IN(k) && IN((k) + 1)) xcd_barrier(bar); } while (0)
#ifndef PROBE_MASK
#define PROBE_MASK 0u
#endif
#ifndef PROBE_REP
#define PROBE_REP 0
#endif
#define TWICE(k) (((PROBE_MASK) >> (k)) & 1u)
#ifdef PROBE_TS
    volatile LAS unsigned long long* TSW = (volatile LAS unsigned long long*)(C.lds + LDSCTL_OFF + 15360);
#define TS(k) do { if (blockIdx.x == 0 && C.tid == 0) TSW[k] = __builtin_amdgcn_s_memrealtime(); } while (0)
#else
#define TS(k) do { } while (0)
#endif
    TS(0);

    if (IN(0)) { p0_prologue(C); if (TWICE(0)) { xcd_barrier(bar); p0_prologue(C); } } SEAM(0); TS(1);
    if (IN(1)) {
        p1_cumsum(C);
        pg8::Gemm g{C.A1, C.WIN, M, NQKV, DM}; pg8::StaticOrder So; So.init(M, NQKV, C.G, (int)blockIdx.x);
        pg8::EpiQKV E{C.QKV, NQKV, (PG8_LAS float*)(C.lds + NRMP_OFF), C.nrm};
        pg8::gemm_phase<pg8::EpiQKV, pg8::StaticOrder, true, true>(C.lds + RING_OFF, g, So, E);
        if (TWICE(1)) { xcd_barrier(bar); pg8::gemm_phase<pg8::EpiQKV, pg8::StaticOrder, true, true>(C.lds + RING_OFF, g, So, E); }
    } SEAM(1); TS(2);
    if (IN(3)) { const att::Tensors T{(const att::bf16*)C.QKV, (att::bf16*)C.A2, (att::bf16*)C.DT, C.BIAS, C.nrm};
        unsigned* qh = (unsigned*)(ws + WS_CTL) + CW_QHEAD; volatile __attribute__((address_space(3))) int* qw = (volatile __attribute__((address_space(3))) int*)(C.lds + RING_OFF + ATT_QW_OFF);
        att::attn_part<false>((char*)lds + RING_OFF, T, qh, qw); TS(3); att::attn_part<true>((char*)lds + RING_OFF, T, qh + 64, qw); if (TWICE(3)) { xcd_barrier(bar); att::attn_part<false>((char*)lds + RING_OFF, T, qh + 128, qw); att::attn_part<true>((char*)lds + RING_OFF, T, qh + 192, qw); } } SEAM(3); TS(4);
    if (IN(4)) { p3_combine(C); if (TWICE(4)) { xcd_barrier(bar); p3_combine(C); } } SEAM(4); TS(5);
    if (IN(5)) {
        pg8::Gemm g{C.A2, C.WOUT, M, DM, DM}; pg8::StaticOrder So; So.init(M, DM, C.G, (int)blockIdx.x);
        pg8::EpiResBf16 E{C.x, C.H1, DM};
        pg8::gemm_phase<pg8::EpiResBf16, pg8::StaticOrder, true, true>(C.lds + RING_OFF, g, So, E);
        if (TWICE(5)) { xcd_barrier(bar); pg8::gemm_phase<pg8::EpiResBf16, pg8::StaticOrder, true, true>(C.lds + RING_OFF, g, So, E); }
    } SEAM(5); TS(6);
    if (IN(6)) { p5a_router(C); } SEAM(6); TS(7);
    if (hi > 7) build_seg(C);
#ifdef PROBE_CLK
    unsigned long long ck0 = 0, cr0 = 0, ckd = 0, crd = 1;
    if (IN(PROBE_CLK)) { ck0 = __builtin_amdgcn_s_memtime(); cr0 = __builtin_amdgcn_s_memrealtime(); }
#endif
    if (IN(8)) {
        const PG8_LAS int* tile_e = (const PG8_LAS int*)(C.lds + TILE_E_OFF); const int ntile = ((const LAS int*)(C.lds + SEG_OFF))[NE] >> 8;
        #if defined(PROBE_HOT) && PROBE_HOT >= 3
        pg8::GemmW g{C.A1, DM, DFF, C.etok, args.li > 0 ? 255 : M - 1, (const PG8_LAS int*)(C.lds + TILE_RB_OFF)};
#else
        pg8::GemmW g{C.A1, DM, DFF, C.etok, M - 1, (const PG8_LAS int*)(C.lds + TILE_RB_OFF)};
#endif
        pg8::GroupedOrderW<0> So{ntile * 8, C.G, (int)blockIdx.x, tile_e, C.wgate, C.wup, args.li > 0};
        pg8::EpiSwiglu E{args.li > 0 ? C.XG : C.HB};
        pg8::gemm_phase_wf32<pg8::EpiSwiglu, pg8::GroupedOrderW<0>, true, true>(C.lds + RING_OFF, g, So, E);
    } SEAM(8); TS(8);
    if (IN(9)) {
        const PG8_LAS int* tile_e = (const PG8_LAS int*)(C.lds + TILE_E_OFF); const int ntile = ((const LAS int*)(C.lds + SEG_OFF))[NE] >> 8;
        pg8::GemmW g{C.HB, DFF, DM, nullptr, 0, nullptr}; pg8::GroupedOrderW<1> So{ntile * 8, C.G, (int)blockIdx.x, tile_e, C.wdown, nullptr};
        pg8::EpiDown E{C.Y};
        pg8::gemm_phase_wf32<pg8::EpiDown, pg8::GroupedOrderW<1>, true, false>(C.lds + RING_OFF, g, So, E);
    } SEAM(9); TS(9);
#ifdef PROBE_CLK
    if (IN(PROBE_CLK)) { ckd = __builtin_amdgcn_s_memtime() - ck0; crd = __builtin_amdgcn_s_memrealtime() - cr0; }
#endif
    if (IN(10)) { p8_final(C); if (TWICE(10)) { xcd_barrier(bar); p8_final(C); } }
#ifdef PROBE_CLK
    if (blockIdx.x == 0) { const unsigned long long want = ckd * 100ull / (crd ? crd : 1);
        const unsigned long long t0 = __builtin_amdgcn_s_memrealtime(); while (__builtin_amdgcn_s_memrealtime() - t0 < want) __builtin_amdgcn_s_sleep(8); }
#endif
#ifdef PROBE_TS
    if (blockIdx.x == 0 && C.tid == 0) { const unsigned long long dA = TSW[(PROBE_TS >> 4) & 15] - TSW[(PROBE_TS >> 8) & 15], dB = TSW[PROBE_TS & 15] - TSW[(PROBE_TS >> 12) & 15];
        const unsigned long long want = ((dA + 1000ull) / 2000ull) * 100000ull + dB;
        const unsigned long long t0 = __builtin_amdgcn_s_memrealtime(); while (__builtin_amdgcn_s_memrealtime() - t0 < want) __builtin_amdgcn_s_sleep(8); }
#endif
#ifdef PROBE_NT
    if (blockIdx.x == 0) { const int ntile_ = ((const LAS int*)(C.lds + SEG_OFF))[NE] >> 8; const unsigned long long want = (unsigned long long)(ntile_ > 150 ? ntile_ - 150 : 0) * 2000ull;
        const unsigned long long t0 = __builtin_amdgcn_s_memrealtime(); while (__builtin_amdgcn_s_memrealtime() - t0 < want) __builtin_amdgcn_s_sleep(8); }
#endif
#ifdef PROF_SECT
    if (blockIdx.x == 0) { __syncthreads(); const unsigned want = ((volatile LAS unsigned*)(C.lds + ATT_QW_OFF + 32))[0]; const unsigned long long t0 = __builtin_amdgcn_s_memtime(); while (__builtin_amdgcn_s_memtime() - t0 < (unsigned long long)want) __builtin_amdgcn_s_sleep(8); }
#endif
#undef IN
#undef SEAM
#undef TWICE
}

#if NAIVE_MASK
namespace nv {
__device__ __forceinline__ float bf2f(bf16_t v) { return __uint_as_float((unsigned)v << 16); }
__device__ __forceinline__ bf16_t f2b(float f) { return (bf16_t)f2bf(f); }
__global__ void __launch_bounds__(256) k_cumsum(float* __restrict__ bias) {
    __shared__ float part[256];
    float* p = bias + (size_t)blockIdx.x * S; const int tid = threadIdx.x;
    float loc[32]; float s = 0.f;
#pragma unroll
    for (int i = 0; i < 32; ++i) { s += p[tid * 32 + i]; loc[i] = s; }
    part[tid] = s; __syncthreads();
    if (tid == 0) { float a = 0.f; for (int i = 0; i < 256; ++i) { const float q = part[i]; part[i] = a; a += q; } }
    __syncthreads();
    const float base = part[tid];
#pragma unroll
    for (int i = 0; i < 32; ++i) p[tid * 32 + i] = (base + loc[i]) * ATT_ISCALE;
}
template <class FA, class FB>
__device__ __forceinline__ void ngemm_tile(int K, FA fa, FB fb, float (&acc)[4][4], float (*As)[65], float (*Bs)[65]) {
    const int tid = threadIdx.x, tx = tid & 15, ty = tid >> 4;
#pragma unroll
    for (int r = 0; r < 4; ++r)
#pragma unroll
        for (int c = 0; c < 4; ++c) acc[r][c] = 0.f;
    for (int k0 = 0; k0 < K; k0 += 16) {
        for (int e = tid; e < 1024; e += 256) { const int i = e >> 4, kk = e & 15; As[kk][i] = fa(i, k0 + kk); Bs[kk][i] = fb(k0 + kk, i); }
        __syncthreads();
#pragma unroll
        for (int kk = 0; kk < 16; ++kk) { float a[4], b[4];
#pragma unroll
            for (int r = 0; r < 4; ++r) a[r] = As[kk][ty * 4 + r];
#pragma unroll
            for (int c = 0; c < 4; ++c) b[c] = Bs[kk][tx * 4 + c];
#pragma unroll
            for (int r = 0; r < 4; ++r)
#pragma unroll
                for (int c = 0; c < 4; ++c) acc[r][c] += a[r] * b[c]; }
        __syncthreads();
    }
}
__global__ void __launch_bounds__(256) k_inproj(const bf16_t* __restrict__ A, const bf16_t* __restrict__ Bt, bf16_t* __restrict__ Cq) {
    __shared__ float As[16][65], Bs[16][65];
    const int m0 = blockIdx.y * 64, n0 = blockIdx.x * 64; float acc[4][4];
    ngemm_tile(DM, [&](int i, int k) { return bf2f(A[(size_t)(m0 + i) * DM + k]); }, [&](int k, int j) { return bf2f(Bt[(size_t)(n0 + j) * DM + k]); }, acc, As, Bs);
    const int tx = threadIdx.x & 15, ty = threadIdx.x >> 4;
#pragma unroll
    for (int r = 0; r < 4; ++r)
#pragma unroll
        for (int c = 0; c < 4; ++c) Cq[(size_t)(m0 + ty * 4 + r) * NQKV + n0 + tx * 4 + c] = f2b(acc[r][c]);
}
__global__ void __launch_bounds__(256) k_outproj(const bf16_t* __restrict__ A, const bf16_t* __restrict__ Bt, const float* __restrict__ x, float* __restrict__ H1) {
    __shared__ float As[16][65], Bs[16][65];
    const int m0 = blockIdx.y * 64, n0 = blockIdx.x * 64; float acc[4][4];
    ngemm_tile(DM, [&](int i, int k) { return bf2f(A[(size_t)(m0 + i) * DM + k]); }, [&](int k, int j) { return bf2f(Bt[(size_t)(n0 + j) * DM + k]); }, acc, As, Bs);
    const int tx = threadIdx.x & 15, ty = threadIdx.x >> 4;
#pragma unroll
    for (int r = 0; r < 4; ++r)
#pragma unroll
        for (int c = 0; c < 4; ++c) { const size_t o = (size_t)(m0 + ty * 4 + r) * DM + n0 + tx * 4 + c; H1[o] = x[o] + acc[r][c]; }
}
__global__ void __launch_bounds__(256) k_attn(const bf16_t* __restrict__ QKV, const float* __restrict__ bias, bf16_t* __restrict__ A2, bf16_t* __restrict__ DT) {
    __shared__ bf16_t Qs[64][130];
    __shared__ float Ks[32][129];
    __shared__ float Vs[32][128];
    __shared__ float Ps[64][33];
    const int tid = threadIdx.x, r = tid >> 2, c4 = tid & 3;
    const int qb = (int)gridDim.x - 1 - (int)blockIdx.x, p = blockIdx.y;
    int b, qcol, kcol, vcol, h, map = 0, vh = 0; const float* cc; const bool fox = p < 16;
    if (fox) { b = p >> 3; h = p & 7; qcol = C_FQ + h * 128; kcol = C_FK + h * 128; vcol = C_FV + h * 128; cc = bias + ((size_t)b * 8 + h) * S; }
    else { const int q = p - 16; b = q >> 4; h = (q >> 2) & 3; map = (q >> 1) & 1; vh = q & 1; qcol = C_DQ + h * 256 + map * 128; kcol = C_DK + h * 256 + map * 128; vcol = C_DV + h * 256 + vh * 128; cc = bias + (size_t)(16 + h) * S; }
    const int q0 = qb * 64; const size_t rowb = (size_t)b * S;
    for (int e = tid; e < 64 * 128; e += 256) { const int i = e >> 7, d = e & 127; Qs[i][d] = QKV[(rowb + q0 + i) * NQKV + qcol + d]; }
    const int t = q0 + r; const float ct = cc[t];
    float m = -1e30f, l = 0.f; float o[32];
#pragma unroll
    for (int j = 0; j < 32; ++j) o[j] = 0.f;
    const int nkt = (q0 + 63) / 32 + 1;
    for (int kt = 0; kt < nkt; ++kt) {
        const int k0 = kt * 32;
        __syncthreads();
        for (int e = tid; e < 32 * 128; e += 256) { const int i = e >> 7, d = e & 127; const size_t ro = (rowb + k0 + i) * NQKV; Ks[i][d] = bf2f(QKV[ro + kcol + d]); Vs[i][d] = bf2f(QKV[ro + vcol + d]); }
        __syncthreads();
        float sc[8];
#pragma unroll
        for (int j = 0; j < 8; ++j) sc[j] = 0.f;
        for (int d = 0; d < 128; ++d) { const float qv = bf2f(Qs[r][d]);
#pragma unroll
            for (int j = 0; j < 8; ++j) sc[j] += qv * Ks[c4 * 8 + j][d]; }
        float tmax = -__builtin_inff();
#pragma unroll
        for (int j = 0; j < 8; ++j) { const int s = k0 + c4 * 8 + j; float v = (sc[j] + (ct - cc[s])) * ATT_SCALE;
            if (s > t) v = -__builtin_inff();
            sc[j] = v; tmax = fmaxf(tmax, v); }
        tmax = fmaxf(tmax, __shfl_xor(tmax, 1)); tmax = fmaxf(tmax, __shfl_xor(tmax, 2));
        const float mn = fmaxf(m, tmax), alpha = __expf(m - mn); m = mn;
        float ps = 0.f;
#pragma unroll
        for (int j = 0; j < 8; ++j) { const float pv = __expf(sc[j] - mn); ps += pv; Ps[r][c4 * 8 + j] = pv; }
        ps += __shfl_xor(ps, 1); ps += __shfl_xor(ps, 2);
        l = l * alpha + ps;
        __syncthreads();
#pragma unroll
        for (int j = 0; j < 32; ++j) o[j] *= alpha;
        for (int kk = 0; kk < 32; ++kk) { const float pv = Ps[r][kk];
#pragma unroll
            for (int j = 0; j < 32; ++j) o[j] += pv * Vs[kk][c4 + 4 * j]; }
    }
    const float il = 1.f / l;
    bf16_t* op = fox ? A2 + (rowb + t) * DM + h * 128 : DT + (rowb + t) * DM + h * 512 + map * 256 + vh * 128;
#pragma unroll
    for (int j = 0; j < 32; ++j) op[c4 + 4 * j] = f2b(o[j] * il);
}
__global__ void __launch_bounds__(256) k_diff_combine(const bf16_t* __restrict__ DT, const float* __restrict__ lq1, const float* __restrict__ lk1, const float* __restrict__ lq2,
                                                      const float* __restrict__ lk2, const float* __restrict__ sg, bf16_t* __restrict__ A2) {
    const int lane = threadIdx.x & 63, wv = threadIdx.x >> 6;
    const int idx = blockIdx.x * 4 + wv, t = idx >> 2, h = idx & 3;
    const float s1 = wave_sum(lq1[lane] * lk1[lane] + lq1[lane + 64] * lk1[lane + 64]);
    const float s2 = wave_sum(lq2[lane] * lk2[lane] + lq2[lane + 64] * lk2[lane + 64]);
    const float lam = expf(s1) - expf(s2) + 0.2f;
    const bf16_t* p = DT + (size_t)t * DM + h * 512;
    float d[4]; float ss = 0.f;
#pragma unroll
    for (int c = 0; c < 4; ++c) { d[c] = bf2f(p[lane * 4 + c]) - lam * bf2f(p[256 + lane * 4 + c]); ss += d[c] * d[c]; }
    ss = wave_sum(ss);
    const float r = rsqrtf(ss * (1.f / 256.f) + 1e-5f) * 0.8f;
    bf16_t* o = A2 + (size_t)t * DM + 1024 + h * 256 + lane * 4;
#pragma unroll
    for (int c = 0; c < 4; ++c) o[c] = f2b(d[c] * r * sg[lane * 4 + c]);
}
__global__ void __launch_bounds__(256) k_route(const float* __restrict__ H1, const float* __restrict__ g, const float* __restrict__ wg, const float* __restrict__ bg,
                                               const float* __restrict__ we, const float* __restrict__ be, int* __restrict__ tok_e, int* __restrict__ tok_pos,
                                               float* __restrict__ tok_gate, float* __restrict__ rstd, unsigned* __restrict__ cnt) {
    __shared__ float xs[4][DM];
    const int lane = threadIdx.x & 63, wv = threadIdx.x >> 6;
    const int t = blockIdx.x * 4 + wv;
    const float* xr = H1 + (size_t)t * DM;
    f32x4 v[8]; float ss = 0.f;
#pragma unroll
    for (int j = 0; j < 8; ++j) { v[j] = *(const f32x4*)(xr + j * 256 + lane * 4); ss += v[j].x * v[j].x + v[j].y * v[j].y + v[j].z * v[j].z + v[j].w * v[j].w; }
    ss = wave_sum(ss);
    const float r = 1.f / sqrtf(ss * (1.f / DM) + 1e-6f);
#pragma unroll
    for (int j = 0; j < 8; ++j) { const f32x4 gg = *(const f32x4*)(g + j * 256 + lane * 4); *(f32x4*)(&xs[wv][j * 256 + lane * 4]) = v[j] * r * gg; }
    __syncthreads();
    float el = 0.f;
    for (int k = 0; k < DM; ++k) el += xs[wv][k] * we[(size_t)k * NE + lane];
    el += be[lane];
    float gl = 0.f;
    for (int k = (lane >> 3); k < DM; k += 8) gl += xs[wv][k] * wg[(size_t)k * 8 + (lane & 7)];
    gl += __shfl_xor(gl, 8); gl += __shfl_xor(gl, 16); gl += __shfl_xor(gl, 32);
    gl += bg[lane & 7];
    float gmax = -__builtin_inff(); int gi = 0;
#pragma unroll
    for (int j = 0; j < 8; ++j) { const float q = __shfl(gl, j); if (q > gmax) { gmax = q; gi = j; } }
    float gs = 0.f;
#pragma unroll
    for (int j = 0; j < 8; ++j) gs += expf(__shfl(gl, j) - gmax);
    const float gprob = 1.f / gs;
    float l1 = -__builtin_inff(), l2 = -__builtin_inff(); int i1 = 0, i2 = 0;
#pragma unroll
    for (int j = 0; j < 8; ++j) { const float q = __shfl(el, gi * 8 + j);
        if (q > l1) { l2 = l1; i2 = i1; l1 = q; i1 = j; } else if (q > l2) { l2 = q; i2 = j; } }
    const float e2 = expf(l2 - l1), g1 = gprob / (1.f + e2), g2 = gprob * e2 / (1.f + e2);
    if (lane == 0) {
        const int ea = gi * 8 + i1, eb = gi * 8 + i2;
        const unsigned pa = atomicAdd(cnt + ea, 1u), pb = atomicAdd(cnt + eb, 1u);
        tok_e[t * 2] = ea; tok_e[t * 2 + 1] = eb; tok_pos[t * 2] = (int)pa; tok_pos[t * 2 + 1] = (int)pb; tok_gate[t * 2] = g1; tok_gate[t * 2 + 1] = g2; rstd[t] = r;
    }
}
__device__ __forceinline__ int seg_off(const unsigned* cnt, int e) { int o = 0; for (int i = 0; i < e; ++i) o += (int)((cnt[i] + 255u) & ~255u); return o; }
__global__ void __launch_bounds__(256) k_dispatch(const float* __restrict__ H1, const float* __restrict__ g, const float* __restrict__ rstd, const int* __restrict__ tok_e,
                                                  const int* __restrict__ tok_pos, const float* __restrict__ tok_gate, const unsigned* __restrict__ cnt, bf16_t* __restrict__ XG, float* __restrict__ rowgate) {
    const int lane = threadIdx.x & 63, wv = threadIdx.x >> 6; const int t = blockIdx.x * 4 + wv;
    const int ra = seg_off(cnt, tok_e[t * 2]) + tok_pos[t * 2], rb = seg_off(cnt, tok_e[t * 2 + 1]) + tok_pos[t * 2 + 1];
    const float rs = rstd[t];
    for (int k = lane; k < DM; k += 64) { const bf16_t v = f2b(H1[(size_t)t * DM + k] * rs * g[k]); XG[(size_t)ra * DM + k] = v; XG[(size_t)rb * DM + k] = v; }
    if (lane == 0) { rowgate[ra] = tok_gate[t * 2]; rowgate[rb] = tok_gate[t * 2 + 1]; }
}
__global__ void __launch_bounds__(256) k_moe_up(const bf16_t* __restrict__ XG, const bf16_t* __restrict__ WGU, const unsigned* __restrict__ cnt, bf16_t* __restrict__ HB) {
    __shared__ float As[16][65], Bs[16][65];
    const int m0 = blockIdx.y * 64, n0 = blockIdx.x * 64;
    int e = 0, tot = 0; { int o = 0; for (int i = 0; i < NE; ++i) { if (o <= m0) e = i; o += (int)((cnt[i] + 255u) & ~255u); } tot = o; }
    if (m0 >= tot) return;
    const bf16_t* W = WGU + (size_t)e * 2048 * DM; const int rg = 256 * (n0 >> 7) + (n0 & 127), ru = rg + 128;
    float ag[4][4], au[4][4];
    ngemm_tile(DM, [&](int i, int k) { return bf2f(XG[(size_t)(m0 + i) * DM + k]); }, [&](int k, int j) { return bf2f(W[(size_t)(rg + j) * DM + k]); }, ag, As, Bs);
    ngemm_tile(DM, [&](int i, int k) { return bf2f(XG[(size_t)(m0 + i) * DM + k]); }, [&](int k, int j) { return bf2f(W[(size_t)(ru + j) * DM + k]); }, au, As, Bs);
    const int tx = threadIdx.x & 15, ty = threadIdx.x >> 4;
#pragma unroll
    for (int r = 0; r < 4; ++r)
#pragma unroll
        for (int c = 0; c < 4; ++c) { const float gv = ag[r][c]; HB[(size_t)(m0 + ty * 4 + r) * DFF + n0 + tx * 4 + c] = f2b(gv / (1.f + expf(-gv)) * au[r][c]); }
}
__global__ void __launch_bounds__(256) k_moe_down(const bf16_t* __restrict__ HB, const bf16_t* __restrict__ WD, const unsigned* __restrict__ cnt, const float* __restrict__ rowgate, bf16_t* __restrict__ Y) {
    __shared__ float As[16][65], Bs[16][65];
    const int m0 = blockIdx.y * 64, n0 = blockIdx.x * 64;
    int e = 0, tot = 0; { int o = 0; for (int i = 0; i < NE; ++i) { if (o <= m0) e = i; o += (int)((cnt[i] + 255u) & ~255u); } tot = o; }
    if (m0 >= tot) return;
    const bf16_t* W = WD + (size_t)e * DM * DFF; float acc[4][4];
    ngemm_tile(DFF, [&](int i, int k) { return bf2f(HB[(size_t)(m0 + i) * DFF + k]); }, [&](int k, int j) { return bf2f(W[(size_t)(n0 + j) * DFF + k]); }, acc, As, Bs);
    const int tx = threadIdx.x & 15, ty = threadIdx.x >> 4;
#pragma unroll
    for (int r = 0; r < 4; ++r) { const int row = m0 + ty * 4 + r; const float gt = rowgate[row];
#pragma unroll
        for (int c = 0; c < 4; ++c) Y[(size_t)row * DM + n0 + tx * 4 + c] = f2b(acc[r][c] * gt); }
}
__global__ void __launch_bounds__(256) k_final(const float* __restrict__ H1, const bf16_t* __restrict__ Y, const unsigned* __restrict__ cnt, const int* __restrict__ tok_e,
                                               const int* __restrict__ tok_pos, const float* __restrict__ g, float* __restrict__ out) {
    const int lane = threadIdx.x & 63, wv = threadIdx.x >> 6; const int t = blockIdx.x * 4 + wv;
    const int ra = seg_off(cnt, tok_e[t * 2]) + tok_pos[t * 2], rb = seg_off(cnt, tok_e[t * 2 + 1]) + tok_pos[t * 2 + 1];
    float v[32]; float ss = 0.f;
#pragma unroll
    for (int i = 0; i < 32; ++i) { const int k = lane + 64 * i; v[i] = H1[(size_t)t * DM + k] + bf2f(Y[(size_t)ra * DM + k]) + bf2f(Y[(size_t)rb * DM + k]); ss += v[i] * v[i]; }
    ss = wave_sum(ss);
    const float r = 1.f / sqrtf(ss * (1.f / DM) + 1e-6f);
#pragma unroll
    for (int i = 0; i < 32; ++i) { const int k = lane + 64 * i; out[(size_t)t * DM + k] = v[i] * r * g[k]; }
}
}
static void naive_phase(int k, const Args& a, hipStream_t stream) {
    unsigned char* ws = a.ws;
    bf16_t* A1 = (bf16_t*)(ws + WS_A1); bf16_t* WIN = (bf16_t*)(ws + WS_WIN); bf16_t* WOUT = (bf16_t*)(ws + WS_WOUT); float* BIAS = (float*)(ws + WS_BIAS); bf16_t* QKV = (bf16_t*)(ws + WS_QKV);
    bf16_t* A2 = (bf16_t*)(ws + WS_A2); bf16_t* DT = (bf16_t*)(ws + WS_DT); float* H1 = (float*)(ws + WS_H1);
    int* tok_e = (int*)(ws + WS_ROUTE); int* tok_pos = tok_e + 2 * M; float* tok_gate = (float*)(tok_pos + 2 * M); float* rstd = tok_gate + 2 * M; float* rowgate = rstd + M;
    bf16_t* XG = (bf16_t*)(ws + WS_XG); bf16_t* HB = (bf16_t*)(ws + WS_HBUF); bf16_t* Y = (bf16_t*)(ws + WS_Y); bf16_t* WGU = (bf16_t*)(ws + WS_WGU); bf16_t* WD = (bf16_t*)(ws + WS_WD);
    unsigned* cnt = (unsigned*)(ws + WS_CTL) + CW_CNT;
    switch (k) {
    case 1: nv::k_cumsum<<<16, 256, 0, stream>>>(BIAS); nv::k_inproj<<<dim3(NQKV / 64, M / 64), 256, 0, stream>>>(A1, WIN, QKV); break;
    case 3: nv::k_attn<<<dim3(S / 64, 48), 256, 0, stream>>>(QKV, BIAS, A2, DT); break;
    case 4: nv::k_diff_combine<<<M, 256, 0, stream>>>(DT, a.in[4], a.in[5], a.in[6], a.in[7], a.in[8], A2); break;
    case 5: nv::k_outproj<<<dim3(DM / 64, M / 64), 256, 0, stream>>>(A2, WOUT, a.in[0], H1); break;
    case 6: nv::k_route<<<M / 4, 256, 0, stream>>>(H1, a.in[10], a.in[11], a.in[12], a.in[13], a.in[14], tok_e, tok_pos, tok_gate, rstd, cnt); break;
    case 7: nv::k_dispatch<<<M / 4, 256, 0, stream>>>(H1, a.in[10], rstd, tok_e, tok_pos, tok_gate, cnt, XG, rowgate); break;
    case 8: nv::k_moe_up<<<dim3(DFF / 64, YROWS / 64), 256, 0, stream>>>(XG, WGU, cnt, HB); break;
    case 9: nv::k_moe_down<<<dim3(DM / 64, YROWS / 64), 256, 0, stream>>>(HB, WD, cnt, rowgate, Y); break;
    case 10: nv::k_final<<<M / 4, 256, 0, stream>>>(H1, Y, cnt, tok_e, tok_pos, a.in[18], a.out); break;
    default: break;
    }
}
#endif


extern "C" void kernel_launch(void* const* d_in, const int* in_sizes, int n_in, void* d_out, int out_size, void* d_ws, size_t ws_size, hipStream_t stream) {
    static int grid = 0;
    if (grid == 0) {
        if (n_in != 19 || in_sizes[0] != M * DM || out_size != M * DM || ws_size < WS_END) {
            fprintf(stderr, "kernel_launch: built for 19 inputs, x and out of %d floats, >= %zu bytes of workspace; got n_in %d, in0 %d, out %d, ws %zu; nothing launched\n", M * DM, (size_t)WS_END, n_in, n_in > 0 ? in_sizes[0] : -1, out_size, ws_size); grid = -1; return; }
        int dev = 0, cus = 0, per_cu = 0;
        if (hipGetDevice(&dev) != hipSuccess || hipDeviceGetAttribute(&cus, hipDeviceAttributeMultiprocessorCount, dev) != hipSuccess) { fprintf(stderr, "kernel_launch: device query failed\n"); grid = -1; return; }
        if (hipFuncSetAttribute((const void*)mk_fwd, hipFuncAttributeMaxDynamicSharedMemorySize, LDS_BYTES) != hipSuccess) { fprintf(stderr, "kernel_launch: hipFuncSetAttribute failed\n"); grid = -1; return; }
        if (hipOccupancyMaxActiveBlocksPerMultiprocessor(&per_cu, (const void*)mk_fwd, NWAVES * 64, LDS_BYTES) != hipSuccess || per_cu < 1)
            fprintf(stderr, "kernel_launch: note: occupancy query reports %d workgroups per CU\n", per_cu);
        (void)hipGetLastError();
        grid = cus;
    }
    if (grid < 0) return;
    if (hipMemsetAsync((char*)d_ws + WS_CTL, 0, CTL_ZERO_BYTES, stream) != hipSuccess) { fprintf(stderr, "kernel_launch: memset failed\n"); return; }
    Args a{};
    for (int i = 0; i < 19; ++i) a.in[i] = (const float*)d_in[i];
    a.out = (float*)d_out; a.ws = (unsigned char*)d_ws;
    int k = 0, li = 0;
    while (k < NPHASE) {
#if NAIVE_MASK
        if (k > 0 && ((NAIVE_MASK >> k) & 1u)) { naive_phase(k, a, stream); ++k; continue; }
#endif
        const int lo = k; ++k;
        while (k < NPHASE && !((NAIVE_MASK >> k) & 1u)) ++k;
        a.ph_lo = lo; a.ph_hi = k; a.li = li++;
        hipLaunchKernelGGL(mk_fwd, dim3(grid), dim3(NWAVES * 64), LDS_BYTES, stream, a);
        const hipError_t le = hipPeekAtLastError();
        if (le != hipSuccess) { fprintf(stderr, "kernel_launch: launch failed: %s\n", hipGetErrorName(le)); break; }
    }
#if PROBE_REP
    a.ph_lo = PROBE_REP; a.ph_hi = PROBE_REP + 1; a.li = li++;
    hipLaunchKernelGGL(mk_fwd, dim3(grid), dim3(NWAVES * 64), LDS_BYTES, stream, a);
#endif
}
```

```cpp
#include <hip/hip_runtime.h>
#include <hip/hip_bf16.h>
#include <cstdio>
#include <cstdint>
#include <cmath>

#ifndef NAIVE_MASK
#define NAIVE_MASK 0u
#endif

typedef unsigned short bf16_t;
constexpr int NB = 2, S = 8192, DM = 2048, M = NB * S;
constexpr int NCOL = 6152, NQKV = 6144;
constexpr int FCOL = 3072;
constexpr int NE = 64, DFF = 1024;
constexpr int YROWS = 49152, NTILE_MAX = YROWS / 256;
constexpr int C_FQ = 0, C_FK = 1024, C_FV = 2048, C_DQ = 3072, C_DK = 4096, C_DV = 5120;
constexpr float ATT_SCALE = 0.08838834764831845f, ATT_ISCALE = 11.313708498984761f;
constexpr int NPHASE = 11;

constexpr size_t MiB = 1u << 20;
constexpr size_t WS_CTL = 0, CTL_ZERO_BYTES = 1 * MiB;
constexpr size_t WS_A1 = 1 * MiB;
constexpr size_t WS_WIN = 65 * MiB;
constexpr size_t WS_WOUT = 89 * MiB;
constexpr size_t WS_BIAS = 97 * MiB;
constexpr size_t WS_QKV = 98 * MiB;
constexpr size_t WS_A2 = 290 * MiB;
constexpr size_t WS_DT = 354 * MiB;
constexpr size_t WS_H1 = 418 * MiB;
constexpr size_t WS_ROUTE = 546 * MiB;
constexpr size_t WS_WR = 547 * MiB;
constexpr size_t WS_XG = 548 * MiB;
constexpr size_t WS_HBUF = 740 * MiB;
constexpr size_t WS_Y = 836 * MiB;
constexpr size_t WS_WGU = 1028 * MiB;
constexpr size_t WS_WD = 1540 * MiB;
constexpr size_t WS_END = 1796 * MiB;
constexpr int CW_CNT = 65536, CNT_STRIDE = 1056;
constexpr int CW_NRM = 2048;
constexpr int CW_QHEAD = 3072;
constexpr int CW_BAR = 4096;

namespace pg8 {
#define PG8_LAS __attribute__((address_space(3)))
typedef unsigned short bf16_t;
typedef short bf16x8 __attribute__((ext_vector_type(8)));
typedef float f32x4 __attribute__((ext_vector_type(4)));
typedef unsigned u32x4 __attribute__((ext_vector_type(4)));
constexpr int BM = 256, BK = 64, HALF = 128, HTB = HALF * BK * 2  , STAGE_BYTES = 8 * HTB, NXCD = 8, WGM = 8;

__host__ __device__ __forceinline__ int lds_byte(int r, int c) { const int st = (r >> 4) * 2 + (c >> 5), rr = r & 15, cc = c & 31, ob = rr * 64 + cc * 2; return st * 1024 + (ob ^ (((ob >> 9) & 1) << 5)); }
__host__ __device__ __forceinline__ void stage_rc(int b, int& R, int& C) { const int st = b / 1024, sb = b % 1024, swz = sb ^ (((sb >> 9) & 1) << 5); R = (st >> 1) * 16 + swz / 64; C = (st & 1) * 32 + (swz % 64) / 2; }
__host__ __device__ __forceinline__ int perm32(int rho) { const int n = rho >> 4, i = rho & 15; return 8 * (i >> 2) + 4 * n + (i & 3); }

struct Unit { int pm, pn; };
struct Gemm { const bf16_t* A; const bf16_t* Bt; int M, N, K; };

struct StaticOrder {
    int nM, nN, nwg, G, c;
    __host__ __device__ void init(int M, int N, int G_, int c_) { nM = M / BM; nN = N / BM; nwg = nM * nN; G = G_; c = c_; }
    __host__ __device__ bool next(int i, Unit& u) const {
        const long L = (long)i * G + c; if (L >= nwg) return false;
        int wgid = (int)L; { const int q = nwg / NXCD, r = nwg % NXCD, xcd = wgid % NXCD, off = wgid / NXCD; wgid = (xcd < r ? xcd * (q + 1) : r * (q + 1) + (xcd - r) * q) + off; }
        const int nig = WGM * nN, gid = wgid / nig, fm = gid * WGM, gsz = (nM - fm) < WGM ? (nM - fm) : WGM;
        u.pm = fm + ((wgid % nig) % gsz); u.pn = (wgid % nig) / gsz; return true;
    }
    __device__ __forceinline__ void a_ready(const Unit&) const {}
    __device__ __forceinline__ void done(const Unit&) const {}
};

__device__ __forceinline__ unsigned cvt_pk_bf16(float lo, float hi) { unsigned r; asm volatile("v_cvt_pk_bf16_f32 %0, %1, %2" : "=v"(r) : "v"(lo), "v"(hi)); return r; }
typedef float f32x2 __attribute__((ext_vector_type(2)));
__device__ __forceinline__ f32x2 gelu_pk(f32x2 v) {
    const f32x2 av = __builtin_elementwise_abs(v), d = av * 0.2316418882f + 1.0f;
    f32x2 t; t.x = __builtin_amdgcn_rcpf(d.x); t.y = __builtin_amdgcn_rcpf(d.y);
    f32x2 q = t * 0.5307027145f + (-0.7265760135f); q = q * t + 0.7107068705f; q = q * t + (-0.142248368f); q = q * t + 0.127414796f; q = q * t;
    const f32x2 s = (v * v) * (-0.72134752044f);
    f32x2 e; e.x = __builtin_amdgcn_exp2f(s.x); e.y = __builtin_amdgcn_exp2f(s.y);
    const f32x2 m = v * (q * e), r = v - m;
    f32x2 o; o.x = v.x < 0.f ? m.x : r.x; o.y = v.y < 0.f ? m.y : r.y; return o;
}

template <int ACT  > struct EpiBf16 {
    static constexpr bool PERM = true, AFTER_DRAIN = false; static_assert(ACT == 0 || ACT == 1, "EpiBf16: ACT is 0 (none) or 1 (gelu_pk)");
    bf16_t* O; int ldc; const float* bias; int split_cols; size_t split_stride; float scale0;
    __device__ __forceinline__ void operator()(const f32x4 (&acc)[2][2][4][2], const Unit& u, int wr, int wc, int fr, int fq) const {
        const int row0 = u.pm * BM + wr * 64 + fr; int colt = u.pn * BM; bf16_t* base = O;
        float sc = 1.f; if (split_cols) { const int t = colt / split_cols; base += (size_t)t * split_stride; colt -= t * split_cols; if (t == 0) sc = scale0; }
        const int col0 = colt + wc * 32 + 8 * fq, bcol0 = u.pn * BM + wc * 32 + 8 * fq;
        f32x4 bv[2][2];
#pragma unroll
        for (int bj = 0; bj < 2; ++bj)
#pragma unroll
            for (int n = 0; n < 2; ++n) bv[bj][n] = bias ? *(const f32x4*)(bias + bcol0 + bj * HALF + 4 * n) : (f32x4){0.f, 0.f, 0.f, 0.f};
#pragma unroll
        for (int ai = 0; ai < 2; ++ai)
#pragma unroll
            for (int m = 0; m < 4; ++m) { bf16_t* rowp = base + (size_t)(row0 + ai * HALF + m * 16) * ldc + col0;
#pragma unroll
                for (int bj = 0; bj < 2; ++bj) { f32x4 v0 = acc[ai][bj][m][0] + bv[bj][0], v1 = acc[ai][bj][m][1] + bv[bj][1];
                    if (ACT == 1) { f32x2 a = gelu_pk((f32x2){v0[0], v0[1]}), b = gelu_pk((f32x2){v0[2], v0[3]}), c = gelu_pk((f32x2){v1[0], v1[1]}), d = gelu_pk((f32x2){v1[2], v1[3]});
                        v0 = (f32x4){a.x, a.y, b.x, b.y}; v1 = (f32x4){c.x, c.y, d.x, d.y}; }
                    v0 = v0 * sc; v1 = v1 * sc; u32x4 w; w.x = cvt_pk_bf16(v0[0], v0[1]); w.y = cvt_pk_bf16(v0[2], v0[3]); w.z = cvt_pk_bf16(v1[0], v1[1]); w.w = cvt_pk_bf16(v1[2], v1[3]);
                    *(u32x4*)(rowp + bj * HALF) = w; } }
    }
};

struct EpiResF32 {
    static constexpr bool PERM = false, AFTER_DRAIN = false;
    const float* base; float* out; int ldc;
    __device__ __forceinline__ void operator()(const f32x4 (&acc)[2][2][4][2], const Unit& u, int wr, int wc, int fr, int fq) const {
        const int col0 = u.pn * BM + wc * 32 + 4 * fq;
#pragma unroll
        for (int ai = 0; ai < 2; ++ai)
#pragma unroll
            for (int m = 0; m < 4; ++m) { const size_t off = (size_t)(u.pm * BM + ai * HALF + wr * 64 + m * 16 + fr) * ldc + col0;
#pragma unroll
                for (int bj = 0; bj < 2; ++bj)
#pragma unroll
                    for (int n = 0; n < 2; ++n) { const f32x4 bs = *(const f32x4*)(base + off + bj * HALF + n * 16); *(f32x4*)(out + off + bj * HALF + n * 16) = bs + acc[ai][bj][m][n]; }
                if (m & 1) asm volatile("" ::: "memory"); }
    }
};
struct EpiResBf16 {
    static constexpr bool PERM = true, AFTER_DRAIN = false;
    const float* base; bf16_t* out; int ldc;
    __device__ __forceinline__ void operator()(const f32x4 (&acc)[2][2][4][2], const Unit& u, int wr, int wc, int fr, int fq) const {
        const int col0 = u.pn * BM + wc * 32 + 8 * fq;
#pragma unroll
        for (int ai = 0; ai < 2; ++ai)
#pragma unroll
            for (int m = 0; m < 4; ++m) { const size_t off = (size_t)(u.pm * BM + ai * HALF + wr * 64 + m * 16 + fr) * ldc + col0;
#pragma unroll
                for (int bj = 0; bj < 2; ++bj) { const f32x4 v0 = *(const f32x4*)(base + off + bj * HALF) + acc[ai][bj][m][0], v1 = *(const f32x4*)(base + off + bj * HALF + 4) + acc[ai][bj][m][1];
                    u32x4 w; w.x = cvt_pk_bf16(v0[0], v0[1]); w.y = cvt_pk_bf16(v0[2], v0[3]); w.z = cvt_pk_bf16(v1[0], v1[1]); w.w = cvt_pk_bf16(v1[2], v1[3]);
                    *(u32x4*)(out + off + bj * HALF) = w; }
                if (m & 1) asm volatile("" ::: "memory"); }
    }
};
struct EpiQKV {
    static constexpr bool PERM = true, AFTER_DRAIN = false;
    bf16_t* O; int ldc; PG8_LAS float* part; unsigned* nrm;
    __device__ __forceinline__ void operator()(const f32x4 (&acc)[2][2][4][2], const Unit& u, int wr, int wc, int fr, int fq) const {
        const int row0 = u.pm * BM + wr * 64 + fr, col0 = u.pn * BM + wc * 32 + 8 * fq;
        const bool track = u.pn < 8 || (u.pn >= 12 && u.pn < 20);
#pragma unroll
        for (int ai = 0; ai < 2; ++ai)
#pragma unroll
            for (int m = 0; m < 4; ++m) { bf16_t* rowp = O + (size_t)(row0 + ai * HALF + m * 16) * ldc + col0;
#pragma unroll
                for (int bj = 0; bj < 2; ++bj) { const f32x4 v0 = acc[ai][bj][m][0], v1 = acc[ai][bj][m][1];
                    u32x4 w; w.x = cvt_pk_bf16(v0[0], v0[1]); w.y = cvt_pk_bf16(v0[2], v0[3]); w.z = cvt_pk_bf16(v1[0], v1[1]); w.w = cvt_pk_bf16(v1[2], v1[3]);
                    *(u32x4*)(rowp + bj * HALF) = w;
                    if (track) { float ss = ((v0[0] * v0[0] + v0[1] * v0[1]) + (v0[2] * v0[2] + v0[3] * v0[3])) + ((v1[0] * v1[0] + v1[1] * v1[1]) + (v1[2] * v1[2] + v1[3] * v1[3]));
                        ss += __shfl_xor(ss, 16); ss += __shfl_xor(ss, 32);
                        if (fq == 0) part[(wc * 2 + bj) * 256 + ai * HALF + wr * 64 + m * 16 + fr] = ss; } } }
        if (track) {
            asm volatile("s_waitcnt lgkmcnt(0)" ::: "memory"); __builtin_amdgcn_s_barrier(); asm volatile("" ::: "memory");
            const int tid = threadIdx.x, row = tid & 255, bj = tid >> 8;
            float v = (part[(0 * 2 + bj) * 256 + row] + part[(1 * 2 + bj) * 256 + row]) + (part[(2 * 2 + bj) * 256 + row] + part[(3 * 2 + bj) * 256 + row]);
#pragma unroll
            for (int o = 1; o < 64; o <<= 1) v = fmaxf(v, __shfl_xor(v, o));
            const int slice = (u.pn < 8 ? 2 * u.pn : 16 + 2 * (u.pn - 12)) + bj;
            if ((tid & 63) == 0) atomicMax(nrm + (u.pm >> 5) * 32 + slice, __float_as_uint(v));
            asm volatile("s_waitcnt lgkmcnt(0)" ::: "memory");
        }
    }
};
struct EpiSwiglu {
    static constexpr bool PERM = true, AFTER_DRAIN = false;
    bf16_t* H;
    __device__ __forceinline__ void operator()(const f32x4 (&acc)[2][2][4][2], const Unit& u, int wr, int wc, int fr, int fq) const {
        const int col0 = (u.pn & 7) * HALF + wc * 32 + 8 * fq;
#pragma unroll
        for (int ai = 0; ai < 2; ++ai)
#pragma unroll
            for (int m = 0; m < 4; ++m) { bf16_t* rowp = H + (size_t)(u.pm * BM + ai * HALF + wr * 64 + m * 16 + fr) * 1024 + col0;
                float hv[8];
#pragma unroll
                for (int n = 0; n < 2; ++n)
#pragma unroll
                    for (int c = 0; c < 4; ++c) { const float g = acc[ai][0][m][n][c], uu = acc[ai][1][m][n][c];
                        hv[n * 4 + c] = g * __builtin_amdgcn_rcpf(1.f + __builtin_amdgcn_exp2f(-1.4426950408889634f * g)) * uu; }
                u32x4 w; w.x = cvt_pk_bf16(hv[0], hv[1]); w.y = cvt_pk_bf16(hv[2], hv[3]); w.z = cvt_pk_bf16(hv[4], hv[5]); w.w = cvt_pk_bf16(hv[6], hv[7]);
                *(u32x4*)rowp = w; }
    }
};
struct EpiDown {
    static constexpr bool PERM = true, AFTER_DRAIN = false;
    bf16_t* Y;
    __device__ __forceinline__ void operator()(const f32x4 (&acc)[2][2][4][2], const Unit& u, int wr, int wc, int fr, int fq) const {
        const int col0 = (u.pn & 7) * BM + wc * 32 + 8 * fq;
#pragma unroll
        for (int ai = 0; ai < 2; ++ai)
#pragma unroll
            for (int m = 0; m < 4; ++m) { const int row = u.pm * BM + ai * HALF + wr * 64 + m * 16 + fr; bf16_t* rowp = Y + (size_t)row * 2048 + col0;
#pragma unroll
                for (int bj = 0; bj < 2; ++bj) { const f32x4 v0 = acc[ai][bj][m][0], v1 = acc[ai][bj][m][1];
                    u32x4 w; w.x = cvt_pk_bf16(v0[0], v0[1]); w.y = cvt_pk_bf16(v0[2], v0[3]); w.z = cvt_pk_bf16(v1[0], v1[1]); w.w = cvt_pk_bf16(v1[2], v1[3]);
                    *(u32x4*)(rowp + bj * HALF) = w; } }
    }
};
struct GroupedOrder {
    int total, G, c; const PG8_LAS int* tile_e;
    __device__ __forceinline__ bool next(int i, Unit& u) const {
        const int L = i * G + c; if (L >= total) return false;
        u.pm = L >> 3; u.pn = __builtin_amdgcn_readfirstlane(tile_e[L >> 3]) * 8 + (L & 7); return true;
    }
    __device__ __forceinline__ void a_ready(const Unit&) const {}
    __device__ __forceinline__ void done(const Unit&) const {}
};

template <class Epi, class Sched, bool ALIGN_EPI = false, bool SP2 = false>
__device__ __forceinline__ void gemm_phase(PG8_LAS unsigned char* lds, const Gemm g, const Sched& S, const Epi& E) {
    const int tid = threadIdx.x, wid = __builtin_amdgcn_readfirstlane(tid >> 6), lane = tid & 63, wr = wid >> 2, wc = wid & 3, fr = lane & 15, fq = lane >> 4;
    const int K = g.K, nt = K / BK;
    unsigned voffA[2], voffB[2];
#pragma unroll
    for (int i = 0; i < 2; ++i) { int R, C; stage_rc(tid * 16 + i * 8192, R, C); const int Rb = Epi::PERM ? ((R & ~31) + perm32(R & 31)) : R;
        voffA[i] = (unsigned)(R * K + C) * 2u; voffB[i] = (unsigned)(Rb * K + C) * 2u; }
    const size_t kstep = (size_t)(BK * 2);
    const size_t hstep = (size_t)HALF * K * 2;
    const size_t tstep = 2 * hstep;
    const unsigned ldsw = (unsigned)wid * 1024u;
    const int aoff = lds_byte(wr * 64 + fr, fq * 8), boff = lds_byte(wc * 32 + fr, fq * 8);
#define PG8_SA(b, h) (((b) * 2 + (h)) * HTB)
#define PG8_SB(b, h) ((4 + (b) * 2 + (h)) * HTB)
#define PG8_STAGE(bufoff, gbase, voff) do { _Pragma("unroll") for (int _i = 0; _i < 2; ++_i) \
        __builtin_amdgcn_global_load_lds((const unsigned*)((const char*)(gbase) + (voff)[_i]), (PG8_LAS unsigned*)(lds + (bufoff) + ldsw + _i * 8192), 16, 0, 0); } while (0)
#define PG8_LDA(dst, b, h) do { _Pragma("unroll") for (int m = 0; m < 4; ++m) _Pragma("unroll") for (int k = 0; k < 2; ++k) dst[m][k] = *(const PG8_LAS bf16x8*)(lds + PG8_SA(b, h) + aoff + m * 2048 + k * 1024); } while (0)
#define PG8_LDB(dst, b, h) do { _Pragma("unroll") for (int n = 0; n < 2; ++n) _Pragma("unroll") for (int k = 0; k < 2; ++k) dst[n][k] = *(const PG8_LAS bf16x8*)(lds + PG8_SB(b, h) + boff + n * 2048 + k * 1024); } while (0)
#define PG8_MMA(ai, bj, At, Bt) do { __builtin_amdgcn_s_setprio(1); _Pragma("unroll") for (int m = 0; m < 4; ++m) _Pragma("unroll") for (int n = 0; n < 2; ++n) _Pragma("unroll") for (int k = 0; k < 2; ++k) \
        acc[ai][bj][m][n] = __builtin_amdgcn_mfma_f32_16x16x32_bf16(Bt[n][k], At[m][k], acc[ai][bj][m][n], 0, 0, 0); __builtin_amdgcn_s_setprio(0); } while (0)
#define PG8_WAIT_V(n) asm volatile("s_waitcnt vmcnt(" #n ")" ::: "memory")
#define PG8_WAIT_L(n) asm volatile("s_waitcnt lgkmcnt(" #n ")" ::: "memory")
#define PG8_BAR __builtin_amdgcn_s_barrier()
#define PG8_SCHED __builtin_amdgcn_sched_barrier(0)
    Unit cur, nxt; int ui = 0;
    if (!S.next(0, cur)) return;
    f32x4 acc[2][2][4][2];
#pragma unroll
    for (int a = 0; a < 2; ++a)
#pragma unroll
        for (int b = 0; b < 2; ++b)
#pragma unroll
            for (int m = 0; m < 4; ++m)
#pragma unroll
                for (int n = 0; n < 2; ++n) acc[a][b][m][n] = (f32x4){0.f, 0.f, 0.f, 0.f};
    bf16x8 At[4][2], B0[2][2], B1[2][2];
    const char* cA = (const char*)g.A + (size_t)cur.pm * tstep; const char* cB = (const char*)g.Bt + (size_t)cur.pn * tstep;
    S.a_ready(cur);
    if constexpr (SP2) {
        PG8_STAGE(PG8_SB(0, 0), cB, voffB); PG8_STAGE(PG8_SB(0, 1), cB + hstep, voffB); PG8_STAGE(PG8_SA(0, 0), cA, voffA); PG8_STAGE(PG8_SA(0, 1), cA + hstep, voffA);
        if (wr == 1) PG8_BAR;
        PG8_WAIT_V(2); PG8_BAR;
        PG8_STAGE(PG8_SB(1, 0), cB + kstep, voffB); PG8_STAGE(PG8_SA(1, 0), cA + kstep, voffA); PG8_STAGE(PG8_SB(1, 1), cB + hstep + kstep, voffB);
        PG8_WAIT_V(6); PG8_BAR;
    } else {
        PG8_STAGE(PG8_SB(0, 0), cB, voffB); PG8_STAGE(PG8_SA(0, 0), cA, voffA); PG8_STAGE(PG8_SB(0, 1), cB + hstep, voffB); PG8_STAGE(PG8_SA(0, 1), cA + hstep, voffA);
        if (wr == 1) PG8_BAR;
        PG8_WAIT_V(4); PG8_BAR;
        PG8_STAGE(PG8_SB(1, 0), cB + kstep, voffB); PG8_STAGE(PG8_SA(1, 0), cA + kstep, voffA); PG8_STAGE(PG8_SB(1, 1), cB + hstep + kstep, voffB);
        PG8_WAIT_V(6); PG8_BAR;
    }
    for (;;) {
        const bool has_next = S.next(ui + 1, nxt);
        const char* nA = has_next ? (const char*)g.A + (size_t)nxt.pm * tstep : cA; const char* nB = has_next ? (const char*)g.Bt + (size_t)nxt.pn * tstep : cB;
        for (int t = 0; t < nt; t += 2) {
            const bool last = (t == nt - 2);
            const char* a1 = cA + (size_t)(t + 1) * kstep;
            const char* a2 = last ? nA : cA + (size_t)(t + 2) * kstep; const char* b2 = last ? nB : cB + (size_t)(t + 2) * kstep;
            const char* a3 = a2 + kstep; const char* b3 = b2 + kstep;
            if (last && has_next) S.a_ready(nxt);
            if constexpr (SP2) {
            PG8_LDB(B0, 0, 0); PG8_LDB(B1, 0, 1); PG8_SCHED; PG8_LDA(At, 0, 0); PG8_STAGE(PG8_SA(1, 1), a1 + hstep, voffA);
            PG8_WAIT_V(8); PG8_WAIT_L(0); PG8_BAR; PG8_MMA(0, 0, At, B0); PG8_MMA(0, 1, At, B1); PG8_BAR; PG8_SCHED;
            PG8_LDA(At, 0, 1); PG8_STAGE(PG8_SB(0, 0), b2, voffB); PG8_STAGE(PG8_SB(0, 1), b2 + hstep, voffB); PG8_STAGE(PG8_SA(0, 0), a2, voffA);
            PG8_WAIT_V(8); PG8_WAIT_L(0); PG8_BAR; PG8_MMA(1, 0, At, B0); PG8_MMA(1, 1, At, B1); PG8_BAR; PG8_SCHED;
            PG8_LDB(B0, 1, 0); PG8_LDB(B1, 1, 1); PG8_SCHED; PG8_LDA(At, 1, 0); PG8_STAGE(PG8_SA(0, 1), a2 + hstep, voffA);
            PG8_WAIT_V(8); PG8_WAIT_L(0); PG8_BAR; PG8_MMA(0, 0, At, B0); PG8_MMA(0, 1, At, B1); PG8_BAR; PG8_SCHED;
            PG8_LDA(At, 1, 1); PG8_STAGE(PG8_SB(1, 0), b3, voffB); PG8_STAGE(PG8_SB(1, 1), b3 + hstep, voffB); PG8_STAGE(PG8_SA(1, 0), a3, voffA);
            PG8_WAIT_V(8); PG8_WAIT_L(0); PG8_BAR; PG8_MMA(1, 0, At, B0); PG8_MMA(1, 1, At, B1); PG8_BAR; PG8_SCHED;
            } else {
            PG8_LDB(B0, 0, 0); PG8_SCHED; PG8_LDA(At, 0, 0); PG8_STAGE(PG8_SA(1, 1), a1 + hstep, voffA);
            PG8_WAIT_L(8); PG8_BAR; PG8_WAIT_L(0); PG8_MMA(0, 0, At, B0); PG8_BAR; PG8_SCHED;
            PG8_LDB(B1, 0, 1); PG8_STAGE(PG8_SB(0, 0), b2, voffB);
            PG8_BAR; PG8_WAIT_L(0); PG8_MMA(0, 1, At, B1); PG8_BAR;
            PG8_LDA(At, 0, 1); PG8_STAGE(PG8_SA(0, 0), a2, voffA);
            PG8_BAR; PG8_WAIT_L(0); PG8_MMA(1, 0, At, B0); PG8_BAR; PG8_SCHED;
            PG8_STAGE(PG8_SB(0, 1), b2 + hstep, voffB);
            PG8_WAIT_V(6); PG8_BAR; PG8_MMA(1, 1, At, B1); PG8_BAR;
            PG8_LDB(B0, 1, 0); PG8_SCHED; PG8_LDA(At, 1, 0); PG8_STAGE(PG8_SA(0, 1), a2 + hstep, voffA);
            PG8_WAIT_L(8); PG8_BAR; PG8_WAIT_L(0); PG8_MMA(0, 0, At, B0); PG8_BAR; PG8_SCHED;
            PG8_LDB(B1, 1, 1); PG8_STAGE(PG8_SB(1, 0), b3, voffB);
            PG8_BAR; PG8_WAIT_L(0); PG8_MMA(0, 1, At, B1); PG8_BAR;
            PG8_LDA(At, 1, 1); PG8_STAGE(PG8_SA(1, 0), a3, voffA);
            PG8_BAR; PG8_WAIT_L(0); PG8_MMA(1, 0, At, B0); PG8_BAR; PG8_SCHED;
            PG8_STAGE(PG8_SB(1, 1), b3 + hstep, voffB);
            PG8_WAIT_V(6); PG8_BAR; PG8_MMA(1, 1, At, B1); PG8_BAR;
            }
        }
        if constexpr (ALIGN_EPI) { if (wr == 0) PG8_BAR; }
        if constexpr (!Epi::AFTER_DRAIN) { E(acc, cur, wr, wc, fr, fq); S.done(cur); }
        if (!has_next) break;
#pragma unroll
        for (int a = 0; a < 2; ++a)
#pragma unroll
            for (int b = 0; b < 2; ++b)
#pragma unroll
                for (int m = 0; m < 4; ++m)
#pragma unroll
                    for (int n = 0; n < 2; ++n) acc[a][b][m][n] = (f32x4){0.f, 0.f, 0.f, 0.f};
        cur = nxt; cA = nA; cB = nB; ++ui;
        if constexpr (ALIGN_EPI) { if (wr == 1) PG8_BAR; }
    }
    PG8_WAIT_V(0);
    if constexpr (!ALIGN_EPI) { if (wr == 0) PG8_BAR; }
    PG8_BAR;
    if constexpr (Epi::AFTER_DRAIN) { E.fused(acc, cur, wr, wc, fr, fq, lds, wid, lane); S.done(cur); }
#undef PG8_SA
#undef PG8_SB
#undef PG8_STAGE
#undef PG8_LDA
#undef PG8_LDB
#undef PG8_MMA
#undef PG8_WAIT_V
#undef PG8_WAIT_L
#undef PG8_BAR
#undef PG8_SCHED
}

struct UnitW { int pm, cn; const float* w0; const float* w1; };
struct GemmW { const bf16_t* A; int K, ldw; const int* rowtok; int tokmask; const PG8_LAS int* rowbase; };
__device__ __forceinline__ void wload1(f32x4& r0, unsigned voff, const char* sbase) { asm volatile("global_load_dwordx4 %0, %1, %2" : "=&v"(r0) : "v"(voff), "s"(sbase) : "memory"); }
template <class Epi, class Sched, bool ALIGN_EPI, bool GATHER>
__device__ __forceinline__ void gemm_phase_wf32(PG8_LAS unsigned char* lds, const GemmW g, const Sched& S, const Epi& E) {
    static_assert(Epi::PERM && !Epi::AFTER_DRAIN, "gemm_phase_wf32: PERM epilogues that run inside the unit loop only");
    const int tid = threadIdx.x, wid = __builtin_amdgcn_readfirstlane(tid >> 6), lane = tid & 63, wr = wid >> 2, wc = wid & 3, fr = lane & 15, fq = lane >> 4;
    const int K = g.K, nt = K / BK;
    const size_t kstep = (size_t)(BK * 2), hstep = (size_t)HALF * K * 2, tstep = 2 * hstep;
    const unsigned ldsw = (unsigned)wid * 1024u;
    const int aoff = lds_byte(wr * 64 + fr, fq * 8), boff = lds_byte(wc * 32 + fr, fq * 8);
    const int cq = lane & 7, sj = lane >> 3;
    #if defined(PROBE_HOT) && (PROBE_HOT == 2 || PROBE_HOT == 4)
    const size_t wrow = (size_t)g.ldw * 4u, wkt = S.hot ? 0 : wrow * BK;
#else
    const size_t wrow = (size_t)g.ldw * 4u, wkt = wrow * BK;
#endif
#if defined(PROBE_HOT) && PROBE_HOT == 5
    const int cqg = S.hot ? (lane & 7) : cq, sjg = S.hot ? (lane >> 3) : sj;
    const size_t wsrc = (size_t)(8 * sjg) * wrow + (size_t)(32 * (wid & 3) + 4 * cqg) * 4u;
#else
    const size_t wsrc = (size_t)(8 * sj) * wrow + (size_t)(32 * (wid & 3) + 4 * cq) * 4u;
#endif
    const int wrho = 16 * (cq & 1) + 4 * (cq >> 1);
    const int wdst = (4 + (wid >> 2)) * HTB + lds_byte(32 * (wid & 3) + wrho, 8 * sj);
#define PG8_SA(b, h) (((b) * 2 + (h)) * HTB)
#define PG8_SB(b, h) ((4 + (b) * 2 + (h)) * HTB)
#define PG8_STAGE(bufoff, gbase, voff) do { _Pragma("unroll") for (int _i = 0; _i < 2; ++_i) \
        __builtin_amdgcn_global_load_lds((const unsigned*)((const char*)(gbase) + (voff)[_i]), (PG8_LAS unsigned*)(lds + (bufoff) + ldsw + _i * 8192), 16, 0, 0); } while (0)
#define PG8_STAGEA(bufoff, h, kb, nx) do { const char* b_ = ((nx) ? nAb : cAb) + (kb); unsigned v_[2]; v_[0] = (nx) ? voN[h][0] : voC[h][0]; v_[1] = (nx) ? voN[h][1] : voC[h][1]; PG8_STAGE(bufoff, b_, v_); } while (0)
#define PG8_LDA(dst, b, h) do { _Pragma("unroll") for (int m = 0; m < 4; ++m) _Pragma("unroll") for (int k = 0; k < 2; ++k) dst[m][k] = *(const PG8_LAS bf16x8*)(lds + PG8_SA(b, h) + aoff + m * 2048 + k * 1024); } while (0)
#define PG8_LDB(dst, b, h) do { _Pragma("unroll") for (int n = 0; n < 2; ++n) _Pragma("unroll") for (int k = 0; k < 2; ++k) dst[n][k] = *(const PG8_LAS bf16x8*)(lds + PG8_SB(b, h) + boff + n * 2048 + k * 1024); } while (0)
#define PG8_MMA(ai, bj, At, Bt) do { __builtin_amdgcn_s_setprio(1); _Pragma("unroll") for (int m = 0; m < 4; ++m) _Pragma("unroll") for (int n = 0; n < 2; ++n) _Pragma("unroll") for (int k = 0; k < 2; ++k) \
        acc[ai][bj][m][n] = __builtin_amdgcn_mfma_f32_16x16x32_bf16(Bt[n][k], At[m][k], acc[ai][bj][m][n], 0, 0, 0); __builtin_amdgcn_s_setprio(0); } while (0)
#define PG8_WAIT_V(n) asm volatile("s_waitcnt vmcnt(" #n ")" ::: "memory")
#define PG8_WAIT_L(n) asm volatile("s_waitcnt lgkmcnt(" #n ")" ::: "memory")
#define PG8_BAR __builtin_amdgcn_s_barrier()
#define PG8_SCHED __builtin_amdgcn_sched_barrier(0)
#define PG8_WLOAD(kk) do { const int kk_ = (kk); const bool in_ = kk_ < nt; const char* q_ = (in_ ? cW : nW) + (size_t)(in_ ? kk_ : kk_ - nt) * wkt; \
        _Pragma("unroll") for (int r_ = 0; r_ < 8; ++r_) wload1(RB[r_], (unsigned)wsrc, q_ + (size_t)r_ * wrow); } while (0)
#define PG8_WWAIT(n) asm volatile("s_waitcnt vmcnt(" #n ")" : "+v"(RB[0]), "+v"(RB[1]), "+v"(RB[2]), "+v"(RB[3]), "+v"(RB[4]), "+v"(RB[5]), "+v"(RB[6]), "+v"(RB[7]) :: "memory")
#define PG8_WWRITE(b) do { _Pragma("unroll") for (int i_ = 0; i_ < 4; ++i_) { u32x4 w_; \
        w_.x = cvt_pk_bf16(RB[0][i_], RB[1][i_]); w_.y = cvt_pk_bf16(RB[2][i_], RB[3][i_]); w_.z = cvt_pk_bf16(RB[4][i_], RB[5][i_]); w_.w = cvt_pk_bf16(RB[6][i_], RB[7][i_]); \
        *(PG8_LAS u32x4*)(lds + (b) * 2 * HTB + wdst + i_ * 64) = w_; } } while (0)
#ifdef PROBE_ABL
    const int abl = S.hot ? PROBE_ABL : 0;
#define PG8_ABL(bit, stmt) do { if (!(abl & (bit))) { stmt; } } while (0)
#else
#define PG8_ABL(bit, stmt) do { stmt; } while (0)
#endif
    UnitW cur, nxt; int ui = 0;
    if (!S.next(0, cur)) return;
    f32x4 acc[2][2][4][2];
#pragma unroll
    for (int a = 0; a < 2; ++a)
#pragma unroll
        for (int b = 0; b < 2; ++b)
#pragma unroll
            for (int m = 0; m < 4; ++m)
#pragma unroll
                for (int n = 0; n < 2; ++n) acc[a][b][m][n] = (f32x4){0.f, 0.f, 0.f, 0.f};
    bf16x8 At[4][2], B0[2][2], B1[2][2]; f32x4 RB[8];
    const bool whalf = wid >= 4;
    const char* cAb; const char* nAb; unsigned voC[2][2], voN[2][2];
#define PG8_UNIT_A(base, vo, pm_) do { int t_ = tid; asm volatile("" : "+v"(t_)); int R_[2], C_[2]; stage_rc(t_ * 16, R_[0], C_[0]); stage_rc(t_ * 16 + 8192, R_[1], C_[1]); \
        if constexpr (GATHER) { base = (const char*)g.A; const int rb_ = __builtin_amdgcn_readfirstlane(g.rowbase[pm_]); _Pragma("unroll") for (int h_ = 0; h_ < 2; ++h_) _Pragma("unroll") for (int i_ = 0; i_ < 2; ++i_) \
            vo[h_][i_] = (unsigned)(g.rowtok[rb_ + (pm_) * BM + h_ * HALF + R_[i_]] & g.tokmask) * (unsigned)(K * 2) + (unsigned)C_[i_] * 2u; } \
        else { base = (const char*)g.A + (size_t)(pm_) * tstep; _Pragma("unroll") for (int h_ = 0; h_ < 2; ++h_) _Pragma("unroll") for (int i_ = 0; i_ < 2; ++i_) vo[h_][i_] = (unsigned)(h_ * HALF + R_[i_]) * (unsigned)(K * 2) + (unsigned)C_[i_] * 2u; } } while (0)
    PG8_UNIT_A(cAb, voC, cur.pm); nAb = cAb;
#pragma unroll
    for (int h_ = 0; h_ < 2; ++h_) { voN[h_][0] = voC[h_][0]; voN[h_][1] = voC[h_][1]; }
    const char* cW = (const char*)(whalf ? cur.w1 : cur.w0);
    const char* nW = cW;
    PG8_WLOAD(0); PG8_STAGEA(PG8_SA(0, 0), 0, 0, false); PG8_STAGEA(PG8_SA(0, 1), 1, 0, false);
    PG8_WWAIT(4); PG8_WWRITE(0);
    PG8_WLOAD(1);
    PG8_WWAIT(0); PG8_WWRITE(1);
    PG8_STAGEA(PG8_SA(1, 0), 0, kstep, false);
    PG8_WLOAD(2);
    PG8_WAIT_L(0);
    if (wr == 1) PG8_BAR;
    PG8_BAR; PG8_BAR;
    for (;;) {
        const bool has_next = S.next(ui + 1, nxt);
        if (has_next) PG8_UNIT_A(nAb, voN, nxt.pm);
        nW = has_next ? (const char*)(whalf ? nxt.w1 : nxt.w0) : cW;
        for (int t = 0; t < nt; t += 2) {
            const bool last = (t == nt - 2);
            const size_t k1 = (size_t)(t + 1) * kstep, k2 = last ? 0 : (size_t)(t + 2) * kstep, k3 = k2 + kstep;
            PG8_LDB(B0, 0, 0); PG8_LDB(B1, 0, 1); PG8_SCHED; PG8_LDA(At, 0, 0); PG8_STAGEA(PG8_SA(1, 1), 1, k1, false);
            PG8_WAIT_V(12); PG8_WAIT_L(0); PG8_BAR; PG8_MMA(0, 0, At, B0); PG8_MMA(0, 1, At, B1); PG8_BAR; PG8_SCHED;
            PG8_WWAIT(2); PG8_ABL(1, PG8_WWRITE(0)); PG8_LDA(At, 0, 1); PG8_STAGEA(PG8_SA(0, 0), 0, k2, last); PG8_ABL(2, PG8_WLOAD(t + 3));
            PG8_WAIT_L(0); PG8_BAR; PG8_MMA(1, 0, At, B0); PG8_MMA(1, 1, At, B1); PG8_BAR; PG8_SCHED;
            PG8_LDB(B0, 1, 0); PG8_LDB(B1, 1, 1); PG8_SCHED; PG8_LDA(At, 1, 0); PG8_STAGEA(PG8_SA(0, 1), 1, k2, last);
            PG8_WAIT_V(12); PG8_WAIT_L(0); PG8_BAR; PG8_MMA(0, 0, At, B0); PG8_MMA(0, 1, At, B1); PG8_BAR; PG8_SCHED;
            PG8_WWAIT(2); PG8_ABL(1, PG8_WWRITE(1)); PG8_LDA(At, 1, 1); PG8_STAGEA(PG8_SA(1, 0), 0, k3, last); PG8_ABL(2, PG8_WLOAD(t + 4));
            PG8_WAIT_L(0); PG8_BAR; PG8_MMA(1, 0, At, B0); PG8_MMA(1, 1, At, B1); PG8_BAR; PG8_SCHED;
        }
        if (!has_next) PG8_WWAIT(0);
        if constexpr (ALIGN_EPI) { if (wr == 0) PG8_BAR; }
        { Unit eu; eu.pm = cur.pm; eu.pn = cur.cn; E(acc, eu, wr, wc, fr, fq); }
        if (!has_next) break;
#pragma unroll
        for (int a = 0; a < 2; ++a)
#pragma unroll
            for (int b = 0; b < 2; ++b)
#pragma unroll
                for (int m = 0; m < 4; ++m)
#pragma unroll
                    for (int n = 0; n < 2; ++n) acc[a][b][m][n] = (f32x4){0.f, 0.f, 0.f, 0.f};
        cur = nxt; cAb = nAb; cW = nW; ++ui;
#pragma unroll
        for (int h_ = 0; h_ < 2; ++h_) { voC[h_][0] = voN[h_][0]; voC[h_][1] = voN[h_][1]; }
        if constexpr (ALIGN_EPI) { if (wr == 1) PG8_BAR; }
    }
    PG8_WAIT_V(0);
    if constexpr (!ALIGN_EPI) { if (wr == 0) PG8_BAR; }
    PG8_BAR;
#undef PG8_SA
#undef PG8_SB
#undef PG8_STAGE
#undef PG8_LDA
#undef PG8_STAGEA
#undef PG8_UNIT_A
#undef PG8_LDB
#undef PG8_MMA
#undef PG8_WAIT_V
#undef PG8_WAIT_L
#undef PG8_BAR
#undef PG8_SCHED
#undef PG8_WLOAD
#undef PG8_ABL
#undef PG8_WWAIT
#undef PG8_WWRITE
}
template <int MODE> struct GroupedOrderW {
    int total, G, c; const PG8_LAS int* tile_e; const float* wa; const float* wb; int hot;
    __device__ __forceinline__ bool next(int i, UnitW& u) const {
        int L = i * G + c;
        if (G == 256) {
            const int x = c & 7, j = c >> 3;
            L = (32 * i + 8 * (x >> 1) + (j & 7)) * 8 + 4 * (x & 1) + (j >> 3);
        }
        if (L >= total) return false;
        int e = __builtin_amdgcn_readfirstlane(tile_e[L >> 3]), nt = L & 7;
        u.pm = L >> 3; u.cn = nt;
#if defined(PROBE_HOT) && PROBE_HOT == 1
        if (hot) { e = 0; nt = 0; }
#endif
        if (MODE == 0) { u.w0 = wa + (size_t)e * 2048 * 1024 + 128 * nt; u.w1 = wb + (size_t)e * 2048 * 1024 + 128 * nt; }
        else { u.w0 = wa + (size_t)e * 1024 * 2048 + 256 * nt; u.w1 = u.w0 + 128; }
        return true;
    }
};
}

namespace att {
using TIN = __hip_bfloat16; using TOUT = __hip_bfloat16;
constexpr int B = 2, H = 1, HKV = 1, SQ = 8192, SKV = 8192, D = 128, QOFF = 0, WINDOW = SKV;
constexpr float THR = 8.f;
constexpr bool WSKIP = false;
constexpr int LDQ = 6144, LDO = 2048;
constexpr int W_INF = 1 << 30;
#ifdef PROF_SECT
#define PROF_T0(sect) unsigned long long pt0_##sect = 0; if (PROF_SECT == (sect) && blockIdx.x == 0) pt0_##sect = __builtin_amdgcn_s_memtime()
#define PROF_T1(sect) do { if (PROF_SECT == (sect) && blockIdx.x == 0) { const unsigned long long d_ = __builtin_amdgcn_s_memtime() - pt0_##sect; if (threadIdx.x == 0) { PROFW[0] += (unsigned)d_; } } } while (0)
#else
#define PROF_T0(sect) do {} while (0)
#define PROF_T1(sect) do {} while (0)
#endif
constexpr float SCALE = 0.08838834764831845f;
constexpr int NW = 8, QBLK = 32, KVBLK = 64, QB = NW * QBLK;
constexpr int SHM_V = KVBLK * D * 2, SHM_K = KVBLK * D * 2;
constexpr int OFF_WS = 2 * SHM_V + 2 * SHM_K, OFF_CB = OFF_WS + NW * 64 * 4, LDS_BYTES = OFF_CB + 2 * 64 * 4;
static_assert(D == 128 && SQ % QB == 0 && SKV % KVBLK == 0 && H % HKV == 0 && QOFF >= 0 && QOFF + SQ <= SKV && WINDOW >= 1, "geometry");

using bf16 = __hip_bfloat16;
typedef short bf16x8 __attribute__((ext_vector_type(8)));
typedef short s16x4 __attribute__((ext_vector_type(4)));
typedef float f32x16 __attribute__((ext_vector_type(16)));
typedef float f32x4 __attribute__((ext_vector_type(4)));
typedef unsigned u32x4 __attribute__((ext_vector_type(4)));
template <class A, class Bt> struct same_t { static constexpr bool v = false; };
template <class A> struct same_t<A, A> { static constexpr bool v = true; };

#define KSWZ(row, colB) ((row) * 256 + ((colB) ^ (((row) & 7) << 4)))
#define SBAR() __builtin_amdgcn_sched_barrier(0)
__device__ __forceinline__ int v_st(int k, int c) { const int kk = (k & ~0xC) | ((k & 4) << 1) | ((k & 8) >> 1); return ((kk >> 3) * 4 + (c >> 5)) * 512 + ((kk & 7) * 32 + (c & 31)) * 2; }
__device__ __forceinline__ int v_rd_base(int lane) { return ((lane & 3) << 3) | (((lane >> 2) & 3) << 6) | (((lane >> 4) & 1) << 5) | (((lane >> 5) & 1) << 8); }
constexpr int v_rd_off(int d0, int ks, int half) { return d0 * 512 + ks * 4096 + half * 2048; }
__device__ __forceinline__ int crow(int r, int hi) { return (r & 3) + 8 * (r >> 2) + 4 * hi; }
__device__ __forceinline__ unsigned cvtpk(float lo, float hi) {
    unsigned r; asm volatile("v_cvt_pk_bf16_f32 %0, %1, %2" : "=v"(r) : "v"(lo), "v"(hi)); return r;
}
__device__ __forceinline__ bf16x8 pack8(f32x4 a, f32x4 b) {
    u32x4 w = {cvtpk(a[0], a[1]), cvtpk(a[2], a[3]), cvtpk(b[0], b[1]), cvtpk(b[2], b[3])};
    return *reinterpret_cast<bf16x8*>(&w);
}
template <class T> __device__ __forceinline__ bf16x8 load8(const T* p) {
    if constexpr (same_t<T, float>::v) { return pack8(*(const f32x4*)p, *(const f32x4*)(p + 4)); }
    else { return *reinterpret_cast<const bf16x8*>(p); }
}
__device__ __forceinline__ void mask_tile(f32x16& p0, f32x16& p1, int dq, unsigned W) {
    const float NEG = -__builtin_inff();
#pragma unroll
    for (int r = 0; r < 16; ++r) {
        const int c = (r & 3) + 8 * (r >> 2);
        if ((unsigned)(dq - c) >= W) p0[r] = NEG;
        if ((unsigned)(dq - c - 32) >= W) p1[r] = NEG;
    }
}
__device__ __forceinline__ void partialSM(f32x16& p0, f32x16& p1, float& m_reg, float& mn, float& alpha) {
    constexpr float C2 = 1.4426950408889634f * SCALE;
    mn = m_reg; alpha = 1.f;
    const float mnL = -m_reg * C2;
    for (int r = 0; r < 16; ++r) p0[r] = fmaf(p0[r], C2, mnL); for (int r = 0; r < 16; ++r) p1[r] = fmaf(p1[r], C2, mnL);
    for (int r = 0; r < 16; ++r) p0[r] = __builtin_amdgcn_exp2f(p0[r]);
}
__device__ __forceinline__ void finishSM(f32x16& p0, f32x16& p1, float alpha, float& l_reg, bf16x8& pa0, bf16x8& pa1, bf16x8& pa2, bf16x8& pa3) {
    for (int r = 0; r < 16; ++r) p1[r] = __builtin_amdgcn_exp2f(p1[r]);
    float ps = 0; for (int r = 0; r < 16; ++r) ps += p0[r]; for (int r = 0; r < 16; ++r) ps += p1[r];
    { auto rr = __builtin_amdgcn_permlane32_swap(__float_as_uint(ps), __float_as_uint(ps), false, false);
      ps = __uint_as_float(rr[0]) + __uint_as_float(rr[1]); }
    l_reg += ps; (void)alpha;
#define PK4(P, B_, OUT) do { unsigned a0 = cvtpk(P[B_+0], P[B_+1]), a1 = cvtpk(P[B_+2], P[B_+3]);                          \
        unsigned b0 = cvtpk(P[B_+4], P[B_+5]), b1 = cvtpk(P[B_+6], P[B_+7]);                                             \
        auto r0 = __builtin_amdgcn_permlane32_swap(a0, b0, false, false); auto r1 = __builtin_amdgcn_permlane32_swap(a1, b1, false, false); \
        u32x4 w = {r0[0], r1[0], r0[1], r1[1]}; OUT = *reinterpret_cast<bf16x8*>(&w); } while (0)
    PK4(p0, 0, pa0); PK4(p0, 8, pa1); PK4(p1, 0, pa2); PK4(p1, 8, pa3);
#undef PK4
}
template <int KB, bool SK>
__device__ __forceinline__ void qkt(f32x16& p0, f32x16& p1, const char* K_lds, int r32, int hi, const bf16x8* qr, bool act, const float* cbt, float cqs) {
    if (SK && !act) { const float NEG = -__builtin_inff();
#pragma unroll
        for (int r = 0; r < 16; ++r) { p0[r] = NEG; p1[r] = NEG; } return; }
    { const f32x4* c4 = (const f32x4*)(cbt + KB * 64);
#pragma unroll
      for (int g = 0; g < 4; ++g) { const f32x4 a = c4[2 * g], b = c4[8 + 2 * g];
#pragma unroll
          for (int i = 0; i < 4; ++i) { p0[4 * g + i] = cqs - a[i]; p1[4 * g + i] = cqs - b[i]; } } }
    const char* kb[4];
#pragma unroll
    for (int dd = 0; dd < 4; ++dd) kb[dd] = K_lds + KB * SHM_K + KSWZ(r32, (dd * 16 + hi * 8) * 2);
#pragma unroll
    for (int d0 = 0; d0 < 8; ++d0) { const char* a = kb[d0 & 3] + (d0 >> 2) * 128;
        bf16x8 b0 = *reinterpret_cast<const bf16x8*>(a);
        bf16x8 b1 = *reinterpret_cast<const bf16x8*>(a + 32 * 256);
        p0 = __builtin_amdgcn_mfma_f32_32x32x16_bf16(b0, qr[d0], p0, 0, 0, 0);
        p1 = __builtin_amdgcn_mfma_f32_32x32x16_bf16(b1, qr[d0], p1, 0, 0, 0); }
}
template <int VB, bool SK>
__device__ __forceinline__ void pv_tile(f32x16* o, int vb0, bf16x8 pa0, bf16x8 pa1, bf16x8 pa2, bf16x8 pa3, bool act) {
    if (SK && !act) return;
#define TRRD(dst, off) asm volatile("ds_read_b64_tr_b16 %0, %1 offset:%2" : "=&v"(dst) : "v"(vb0), "i"(off) : "memory")
#define PV_D0(d0) do { s16x4 l0, l1, l2, l3, h0, h1, h2, h3; constexpr int b_ = VB * SHM_V + v_rd_off(d0, 0, 0);     \
        TRRD(l0, b_); TRRD(h0, b_ + 2048); TRRD(l1, b_ + 4096); TRRD(h1, b_ + 6144); TRRD(l2, b_ + 8192); TRRD(h2, b_ + 10240); TRRD(l3, b_ + 12288); TRRD(h3, b_ + 14336); \
        asm volatile("s_waitcnt lgkmcnt(0)" ::: "memory"); SBAR();                 \
        o[d0] = __builtin_amdgcn_mfma_f32_32x32x16_bf16(pa0, (bf16x8){l0[0], l0[1], l0[2], l0[3], h0[0], h0[1], h0[2], h0[3]}, o[d0], 0, 0, 0);   \
        o[d0] = __builtin_amdgcn_mfma_f32_32x32x16_bf16(pa1, (bf16x8){l1[0], l1[1], l1[2], l1[3], h1[0], h1[1], h1[2], h1[3]}, o[d0], 0, 0, 0);   \
        o[d0] = __builtin_amdgcn_mfma_f32_32x32x16_bf16(pa2, (bf16x8){l2[0], l2[1], l2[2], l2[3], h2[0], h2[1], h2[2], h2[3]}, o[d0], 0, 0, 0);   \
        o[d0] = __builtin_amdgcn_mfma_f32_32x32x16_bf16(pa3, (bf16x8){l3[0], l3[1], l3[2], l3[3], h3[0], h3[1], h3[2], h3[3]}, o[d0], 0, 0, 0); } while (0)
    PV_D0(0); PV_D0(1); PV_D0(2); PV_D0(3);
#undef PV_D0
#undef TRRD
}
template <class TIn, class TOut> struct BlockRef { const TIn* Q; const TIn* K; const TIn* V; TOut* O; const float* C; int P0, jlo; float mref; };
template <class TIn> struct Seam {
    bf16x8 qr[8];
    bf16x8 st_v0, st_v1, st_k0, st_k1; f32x4 sf0, sf1, sf2, sf3;
    float cq, st_c;
    f32x4 tq[16];
};
__device__ __forceinline__ int swa_jlo(int P0, int W) { const int lowk = P0 - W + 1; return lowk > 0 ? lowk / KVBLK : 0; }
#define ROW(p, k0, rr) ((p) + (size_t)((k0) + (rr)) * LDQ + sc)
#define VMW() asm volatile("s_waitcnt vmcnt(0)" ::: "memory")
#define VMWN(n) asm volatile("s_waitcnt vmcnt(%0)" :: "i"(n) : "memory")
#define SLOAD_H(Kp, Vp, Cp, k0) do { S.st_v0 = load8<TIn>(ROW(Vp, k0, sr)); S.st_v1 = load8<TIn>(ROW(Vp, k0, 32 + sr));              \
                         S.st_k0 = load8<TIn>(ROW(Kp, k0, sr)); S.st_k1 = load8<TIn>(ROW(Kp, k0, 32 + sr)); S.st_c = (Cp)[(k0) + (tid & 63)]; } while (0)
#define SWRITE_HK(bf) do { *(bf16x8*)(K_lds + (bf) * SHM_K + kws) = S.st_k0; *(bf16x8*)(K_lds + (bf) * SHM_K + kws + 32 * 256) = S.st_k1; \
                           if (tid < 64) cbw[(bf) * 64 + tid] = S.st_c; } while (0)
#define SWRITE_HV(bf) do { *(bf16x8*)(V_lds + (bf) * SHM_V + vst0) = S.st_v0; *(bf16x8*)(V_lds + (bf) * SHM_V + vst1) = S.st_v1; } while (0)
#define SWRITE_H(bf) do { SWRITE_HV(bf); SWRITE_HK(bf); } while (0)
#define SLOAD_F(p, k0) do { S.sf0 = *(const f32x4*)ROW(p, k0, sr); S.sf1 = *(const f32x4*)(ROW(p, k0, sr) + 4);                \
                            S.sf2 = *(const f32x4*)ROW(p, k0, 32 + sr); S.sf3 = *(const f32x4*)(ROW(p, k0, 32 + sr) + 4); } while (0)
#define SWRITE_KF(bf) do { *(bf16x8*)(K_lds + (bf) * SHM_K + kws) = pack8(S.sf0, S.sf1); *(bf16x8*)(K_lds + (bf) * SHM_K + kws + 32 * 256) = pack8(S.sf2, S.sf3); } while (0)
#define SWRITE_VF(bf) do { *(bf16x8*)(V_lds + (bf) * SHM_V + vst0) = pack8(S.sf0, S.sf1); *(bf16x8*)(V_lds + (bf) * SHM_V + vst1) = pack8(S.sf2, S.sf3); } while (0)
template <class TIn, class TOut>
__device__ __forceinline__ void causal_swa_prime(const BlockRef<TIn, TOut>& cur, int W, char* lds, Seam<TIn>& S) {
    constexpr bool F32 = same_t<TIn, float>::v;
    const int tid = threadIdx.x, wid = __builtin_amdgcn_readfirstlane(tid >> 6), lane = tid & 63, r32 = lane & 31, hi = lane >> 5;
    const int sr = tid >> 4, sc = (tid & 15) * 8, kws = KSWZ(sr, sc * 2); char* K_lds = lds + 2 * SHM_V; float* cbw = (float*)(lds + OFF_CB);
    const int kb0 = cur.jlo * KVBLK;
    for (int d0 = 0; d0 < 8; ++d0) S.qr[d0] = load8<TIn>(cur.Q + (size_t)(wid * QBLK + r32) * LDQ + d0 * 16 + hi * 8);
    S.cq = cur.C[cur.P0 + wid * QBLK + r32];
    if constexpr (F32) { SLOAD_F((const float*)cur.K, kb0); VMW(); SWRITE_KF(0); SBAR(); SLOAD_F((const float*)cur.V, kb0); }
    else { SLOAD_H(cur.K, cur.V, cur.C, kb0); VMW(); SWRITE_HK(0); }
    __syncthreads();
}
template <class TIn, class TOut>
__device__ __forceinline__ void causal_swa_block(const BlockRef<TIn, TOut>& cur, const BlockRef<TIn, TOut>& nxt, int skv, int W, char* lds, Seam<TIn>& S, unsigned* qhead, volatile __attribute__((address_space(3))) int* qw, bool qmore) {
    constexpr bool F32 = same_t<TIn, float>::v;
    const int tid = threadIdx.x, wid = __builtin_amdgcn_readfirstlane(tid >> 6), lane = tid & 63, r32 = lane & 31, hi = lane >> 5;
    int pop_ = 1 << 30; if (threadIdx.x == 0 && qmore) pop_ = (int)atomicAdd(qhead, 1u);
    const int j_lo = cur.jlo;
    int j_hi = (cur.P0 + QB - 1) / KVBLK + 1; if (j_hi > skv / KVBLK) j_hi = skv / KVBLK;
    const int NT = j_hi - j_lo;
    const int kbn = nxt.jlo * KVBLK;
    const int qlo = cur.P0 + wid * QBLK, qm = qlo + r32 - 4 * hi;
    char* V_lds = lds; char* K_lds = lds + 2 * SHM_V; float* cbw = (float*)(lds + OFF_CB); const float* cbt = cbw + 4 * hi; const float* Ch = cur.C;
    float* ws = (float*)(lds + 2 * SHM_V + 2 * SHM_K) + wid * 64; float* li_l = ws, * al_l = ws + 32;
    float m_reg = cur.mref, l_reg = 0; f32x16 o[4] = {};
    const int sr = tid >> 4, sc = (tid & 15) * 8, vst0 = v_st(sr, sc), vst1 = v_st(32 + sr, sc), kws = KSWZ(sr, sc * 2);
    const int vb0 = (int)(uintptr_t)V_lds + v_rd_base(lane);
    const TIn* Kh = cur.K; const TIn* Vh = cur.V;
#define RESC(a) do { (void)(a); (void)al_l; } while (0)
#define KBASE(t) ((j_lo + (t)) * KVBLK)
#define ACT(t) (KBASE(t) <= qlo + QBLK - 1 && KBASE(t) + KVBLK - 1 >= qlo - W + 1)
#define MASKT(P0_, P1_, t) do { const int kb_ = KBASE(t); if ((!SK || ACT(t)) && (kb_ + KVBLK - 1 > qlo || kb_ <= qlo + QBLK - 1 - W)) mask_tile(P0_, P1_, qm - kb_, (unsigned)W); } while (0)
    constexpr int NQL = F32 ? 16 : 9;
    constexpr bool SK = WSKIP && !F32;
#define SEAM_K0() do { VMWN(NQL); if constexpr (F32) { SWRITE_KF(0); SBAR(); SLOAD_F((const float*)nxt.V, kbn); } else { SWRITE_HK(0); } SBAR(); } while (0)
    f32x16 pA0, pA1, pB0, pB1; float mnA, mnB, alA, alB; bf16x8 pa0, pa1, pa2, pa3;
    if constexpr (F32) { VMW(); SWRITE_VF(0); SBAR(); } else { SWRITE_HV(0); SBAR(); }
    if (NT > 1) { if constexpr (F32) SLOAD_F((const float*)Kh, KBASE(1)); else SLOAD_H(Kh, Vh, Ch, KBASE(1)); }
    SBAR(); qkt<0, SK>(pA0, pA1, K_lds, r32, hi, S.qr, ACT(0), cbt, S.cq);
    if constexpr (F32) { if (NT > 1) { VMW(); SWRITE_KF(1); SBAR(); SLOAD_F((const float*)Vh, KBASE(1)); } }
    MASKT(pA0, pA1, 0); partialSM(pA0, pA1, m_reg, mnA, alA);
    if (NT > 1) { VMW(); if constexpr (F32) { SWRITE_VF(1); SBAR(); if (NT > 2) SLOAD_F((const float*)Kh, KBASE(2)); } else SWRITE_H(1); }
    if (tid == 0) qw[0] = pop_;
    __syncthreads();
#define HALF_STEP(PX0, PX1, mnX, alX, PY0, PY1, alY, t, KB, VB, SB) do {                                                      \
        SBAR(); qkt<KB, SK>(PX0, PX1, K_lds, r32, hi, S.qr, ACT(t), cbt, S.cq);                                  \
        finishSM(PY0, PY1, alY, l_reg, pa0, pa1, pa2, pa3); SBAR();                                                           \
        if ((t) + 1 < NT) { if constexpr (F32) { VMW(); SWRITE_KF(SB); SBAR(); SLOAD_F((const float*)Vh, KBASE((t) + 1)); }  \
                            else { SLOAD_H(Kh, Vh, Ch, KBASE((t) + 1)); } SBAR(); }                                           \
        pv_tile<VB, SK>(o, vb0, pa0, pa1, pa2, pa3, ACT((t) - 1)); MASKT(PX0, PX1, (t)); partialSM(PX0, PX1, m_reg, mnX, alX);                                        \
        __syncthreads();                                                                                                      \
        if ((t) + 1 < NT) { VMW(); if constexpr (F32) { SWRITE_VF(SB); SBAR(); if ((t) + 2 < NT) SLOAD_F((const float*)Kh, KBASE((t) + 2)); } \
                            else { SWRITE_H(SB); } }                                                                          \
        RESC(alX); __syncthreads(); } while (0)
    for (int t = 1; t + 1 < NT; t += 2) {
        HALF_STEP(pB0, pB1, mnB, alB, pA0, pA1, alA, t, 1, 0, 0);
        HALF_STEP(pA0, pA1, mnA, alA, pB0, pB1, alB, t + 1, 0, 1, 1);
    }
    int r32s = r32, his = hi; asm volatile("" : "+v"(r32s), "+v"(his));
    const bool even = (NT & 1) == 0;
    if (even) { SBAR(); qkt<1, SK>(pB0, pB1, K_lds, r32, hi, S.qr, ACT(NT - 1), cbt, S.cq); SBAR(); }
#define QROW(e) (nxt.Q + (size_t)(wid * QBLK + r32) * LDQ + ((e) >> 1) * 16 + hi * 8 + ((e) & 1) * 4)
    if constexpr (F32) { SLOAD_F((const float*)nxt.K, kbn); SBAR();
#pragma unroll
        for (int e = 0; e < 8; ++e) S.tq[e] = *(const f32x4*)QROW(e); }
    else { SLOAD_H(nxt.K, nxt.V, nxt.C, kbn); SBAR();
#pragma unroll
        for (int d0 = 0; d0 < 8; ++d0) S.qr[d0] = load8<TIn>(nxt.Q + (size_t)(wid * QBLK + r32s) * LDQ + d0 * 16 + his * 8);
        S.cq = nxt.C[nxt.P0 + wid * QBLK + r32s]; }
    SBAR();
    finishSM(pA0, pA1, alA, l_reg, pa0, pa1, pa2, pa3); SBAR();
    if constexpr (F32) {
#pragma unroll
        for (int e = 8; e < 16; ++e) S.tq[e] = *(const f32x4*)QROW(e); SBAR(); }
#undef QROW
    pv_tile<0, SK>(o, vb0, pa0, pa1, pa2, pa3, ACT(even ? NT - 2 : NT - 1));
    if (even) { MASKT(pB0, pB1, NT - 1); partialSM(pB0, pB1, m_reg, mnB, alB); __syncthreads(); RESC(alB);
        finishSM(pB0, pB1, alB, l_reg, pa0, pa1, pa2, pa3); SBAR(); pv_tile<1, SK>(o, vb0, pa0, pa1, pa2, pa3, ACT(NT - 1)); }
    SBAR(); SEAM_K0();
    if (his == 0) li_l[r32s] = l_reg; asm volatile("s_waitcnt lgkmcnt(0)" ::: "memory");
    float rli[16];
#pragma unroll
    for (int r = 0; r < 16; ++r) rli[r] = __builtin_amdgcn_rcpf(li_l[crow(r, his)]);
    TOut* Ow = cur.O + (size_t)(wid * QBLK) * LDO;
#pragma unroll
    for (int r = 0; r < 16; ++r) { const int orow = crow(r, his);
#pragma unroll
        for (int d0 = 0; d0 < 4; ++d0) { const float v = o[d0][r] * rli[r];
            if constexpr (same_t<TOut, float>::v) { Ow[(size_t)orow * LDO + d0 * 32 + r32] = v; }
            else { const float vn = __shfl_xor(v, 1);
                   if ((r32s & 1) == 0) *(unsigned*)(Ow + (size_t)orow * LDO + d0 * 32 + r32s) = cvtpk(v, vn); } } }
    if constexpr (F32) {
#pragma unroll
        for (int d0 = 0; d0 < 8; ++d0) S.qr[d0] = pack8(S.tq[2 * d0], S.tq[2 * d0 + 1]); }
    __syncthreads();
#undef RESC
#undef KBASE
#undef ACT
#undef MASKT
#undef SEAM_K0
#undef HALF_STEP
}
#undef ROW
#undef VMW
#undef VMWN
#undef SLOAD_H
#undef SWRITE_HK
#undef SWRITE_HV
#undef SWRITE_H
#undef SLOAD_F
#undef SWRITE_KF
#undef SWRITE_VF


constexpr int QB2 = 128, NQB2 = SQ / QB2, SHM_V2 = 2 * SHM_V;
constexpr int P_OFF_K = 2 * SHM_V2, P_OFF_X = P_OFF_K + 2 * SHM_K, PAIR_RING = P_OFF_X + 2 * NW * 2048;
constexpr int P_OFF_L = PAIR_RING + 2048, P_OFF_CB = P_OFF_L + NW * 64 * 4, PAIR_LDS = P_OFF_CB + 2 * 64 * 4;
struct PRef { const bf16* Q; const bf16* K; const bf16* V; bf16* O; const float* C; int P0, jlo; float mref; };
template <int BUF, int NV>
__device__ __forceinline__ void pair_pv(f32x16* o, int vb0, bf16x8 pa0, bf16x8 pa1, bf16x8 pa2, bf16x8 pa3) {
#define TRRD(dst, off) asm volatile("ds_read_b64_tr_b16 %0, %1 offset:%2" : "=&v"(dst) : "v"(vb0), "i"(off) : "memory")
#define PV_D0(d0) do { s16x4 l0, l1, l2, l3, h0, h1, h2, h3; constexpr int b_ = BUF * SHM_V2 + v_rd_off(d0, 0, 0); \
        TRRD(l0, b_); TRRD(h0, b_ + 2048); TRRD(l1, b_ + 4096); TRRD(h1, b_ + 6144); TRRD(l2, b_ + 8192); TRRD(h2, b_ + 10240); TRRD(l3, b_ + 12288); TRRD(h3, b_ + 14336); \
        asm volatile("s_waitcnt lgkmcnt(0)" ::: "memory"); SBAR(); \
        o[d0] = __builtin_amdgcn_mfma_f32_32x32x16_bf16(pa0, (bf16x8){l0[0], l0[1], l0[2], l0[3], h0[0], h0[1], h0[2], h0[3]}, o[d0], 0, 0, 0); \
        o[d0] = __builtin_amdgcn_mfma_f32_32x32x16_bf16(pa1, (bf16x8){l1[0], l1[1], l1[2], l1[3], h1[0], h1[1], h1[2], h1[3]}, o[d0], 0, 0, 0); \
        o[d0] = __builtin_amdgcn_mfma_f32_32x32x16_bf16(pa2, (bf16x8){l2[0], l2[1], l2[2], l2[3], h2[0], h2[1], h2[2], h2[3]}, o[d0], 0, 0, 0); \
        o[d0] = __builtin_amdgcn_mfma_f32_32x32x16_bf16(pa3, (bf16x8){l3[0], l3[1], l3[2], l3[3], h3[0], h3[1], h3[2], h3[3]}, o[d0], 0, 0, 0); } while (0)
    PV_D0(0); PV_D0(1); if constexpr (NV == 4) { PV_D0(2); PV_D0(3); }
#undef PV_D0
#undef TRRD
}
struct PStage { bf16x8 k0, k1, v0, v1, v2, v3; float c; };
template <int NV>
__device__ __forceinline__ void pair_block(const PRef& B, char* lds, volatile __attribute__((address_space(3))) unsigned* PROFW) {
    PROF_T0(2);
    PROF_T0(8);
    const int tid = threadIdx.x, wid = __builtin_amdgcn_readfirstlane(tid >> 6), lane = tid & 63, r32 = lane & 31, hi = lane >> 5, pr = wid & 3, kh = wid >> 2;
    char* V_lds = lds; char* K_lds = lds + P_OFF_K; char* X_lds = lds + P_OFF_X; float* L_lds = (float*)(lds + P_OFF_L); float* cbw = (float*)(lds + P_OFF_CB);
    const int j_lo = B.jlo, NT = (B.P0 >> 6) + 2 - j_lo;
    const int sr = tid >> 4, sc = (tid & 15) * 8, vst0 = v_st(sr, sc), vst1 = v_st(32 + sr, sc), kws = KSWZ(sr, sc * 2);
    const int vb0 = (int)(uintptr_t)V_lds + kh * (NV == 4 ? SHM_V : 1024) + v_rd_base(lane);
    int ka[4];
#pragma unroll
    for (int dd = 0; dd < 4; ++dd) ka[dd] = (int)(uintptr_t)K_lds + kh * (32 * 256) + KSWZ(r32, (dd * 16 + hi * 8) * 2);
    constexpr float C2 = 1.4426950408889634f * SCALE;
    const float mnL = -B.mref * C2;
    const int qrow = B.P0 + pr * 32 + r32;
    bf16x8 qr[8];
#pragma unroll
    for (int d0 = 0; d0 < 8; ++d0) qr[d0] = load8<bf16>(B.Q + (size_t)(pr * 32 + r32) * LDQ + d0 * 16 + hi * 8);
    const float cq = B.C[qrow];
    f32x16 o[NV] = {}; float l_reg = 0.f;
    PStage stA, stB;
#define TCL(t) ((t) < NT ? (t) : NT - 1)
#define PLOADK(st, t) do { const int k0_ = (j_lo + TCL(t)) * KVBLK; const bf16* kp_ = B.K + (size_t)(k0_ + sr) * LDQ + sc; st.k0 = load8<bf16>(kp_); st.k1 = load8<bf16>(kp_ + (size_t)32 * LDQ); st.c = B.C[k0_ + (tid & 63)]; } while (0)
#define PLOADV(st, t) do { const int k0_ = (j_lo + TCL(t)) * KVBLK; const bf16* vp_ = B.V + (size_t)(k0_ + sr) * LDQ + sc; st.v0 = load8<bf16>(vp_); st.v1 = load8<bf16>(vp_ + (size_t)32 * LDQ); \
        if constexpr (NV == 4) { st.v2 = load8<bf16>(vp_ + 128); st.v3 = load8<bf16>(vp_ + (size_t)32 * LDQ + 128); } } while (0)
#define PWRITEK(st, bf) do { *(bf16x8*)(K_lds + (bf) * SHM_K + kws) = st.k0; *(bf16x8*)(K_lds + (bf) * SHM_K + kws + 32 * 256) = st.k1; if (tid < 64) cbw[(bf) * 64 + tid] = st.c; } while (0)
#define PWRITEV(st, bf) do { *(bf16x8*)(V_lds + (bf) * SHM_V2 + vst0) = st.v0; *(bf16x8*)(V_lds + (bf) * SHM_V2 + vst1) = st.v1; \
        if constexpr (NV == 4) { *(bf16x8*)(V_lds + (bf) * SHM_V2 + SHM_V + vst0) = st.v2; *(bf16x8*)(V_lds + (bf) * SHM_V2 + SHM_V + vst1) = st.v3; } } while (0)
#define KRD_(dst, d0, KB) asm volatile("ds_read_b128 %0, %1 offset:%2" : "=&v"(dst) : "v"(ka[(d0) & 3]), "i"((KB) * SHM_K + ((d0) >> 2) * 128) : "memory")
#define KWT_(n, r) asm volatile("s_waitcnt lgkmcnt(" #n ")" : "+v"(r) :: "memory")
#define ASTAGE(t, KB, XB) do { \
        f32x16 p; { const f32x4* c4 = (const f32x4*)(cbw + (KB) * 64 + 32 * kh + 4 * hi); \
            _Pragma("unroll") for (int g = 0; g < 4; ++g) { const f32x4 a = c4[2 * g]; _Pragma("unroll") for (int i = 0; i < 4; ++i) p[4 * g + i] = cq - a[i]; } } \
        { bf16x8 kf0, kf1, kf2, kf3;     \
          KRD_(kf0, 0, KB); KRD_(kf1, 1, KB); KRD_(kf2, 2, KB); KRD_(kf3, 3, KB); \
          KWT_(3, kf0); p = __builtin_amdgcn_mfma_f32_32x32x16_bf16(kf0, qr[0], p, 0, 0, 0); KRD_(kf0, 4, KB); \
          KWT_(3, kf1); p = __builtin_amdgcn_mfma_f32_32x32x16_bf16(kf1, qr[1], p, 0, 0, 0); KRD_(kf1, 5, KB); \
          KWT_(3, kf2); p = __builtin_amdgcn_mfma_f32_32x32x16_bf16(kf2, qr[2], p, 0, 0, 0); KRD_(kf2, 6, KB); \
          KWT_(3, kf3); p = __builtin_amdgcn_mfma_f32_32x32x16_bf16(kf3, qr[3], p, 0, 0, 0); KRD_(kf3, 7, KB); \
          KWT_(3, kf0); p = __builtin_amdgcn_mfma_f32_32x32x16_bf16(kf0, qr[4], p, 0, 0, 0); \
          KWT_(2, kf1); p = __builtin_amdgcn_mfma_f32_32x32x16_bf16(kf1, qr[5], p, 0, 0, 0); \
          KWT_(1, kf2); p = __builtin_amdgcn_mfma_f32_32x32x16_bf16(kf2, qr[6], p, 0, 0, 0); \
          KWT_(0, kf3); p = __builtin_amdgcn_mfma_f32_32x32x16_bf16(kf3, qr[7], p, 0, 0, 0); } \
        { const int kb = (j_lo + (t)) * KVBLK + 32 * kh; if (kb + 31 > B.P0 + pr * 32) { const int dq = qrow - kb - 4 * hi; const float NEG = -__builtin_inff(); \
            _Pragma("unroll") for (int r = 0; r < 16; ++r) { const int c = (r & 3) + 8 * (r >> 2); if (dq - c < 0) p[r] = NEG; } } } \
        _Pragma("unroll") for (int r = 0; r < 16; ++r) p[r] = __builtin_amdgcn_exp2f(fmaf(p[r], C2, mnL)); \
        { float ps = 0.f; _Pragma("unroll") for (int r = 0; r < 16; ++r) ps += p[r]; \
          auto rr = __builtin_amdgcn_permlane32_swap(__float_as_uint(ps), __float_as_uint(ps), false, false); l_reg += __uint_as_float(rr[0]) + __uint_as_float(rr[1]); } \
        { unsigned a0 = cvtpk(p[0], p[1]), a1 = cvtpk(p[2], p[3]), b0 = cvtpk(p[4], p[5]), b1 = cvtpk(p[6], p[7]); \
          auto r0 = __builtin_amdgcn_permlane32_swap(a0, b0, false, false); auto r1 = __builtin_amdgcn_permlane32_swap(a1, b1, false, false); u32x4 w = {r0[0], r1[0], r0[1], r1[1]}; \
          *(u32x4*)(X_lds + (XB) * (NW * 2048) + wid * 2048 + lane * 16) = w; } \
        { unsigned a0 = cvtpk(p[8], p[9]), a1 = cvtpk(p[10], p[11]), b0 = cvtpk(p[12], p[13]), b1 = cvtpk(p[14], p[15]); \
          auto r0 = __builtin_amdgcn_permlane32_swap(a0, b0, false, false); auto r1 = __builtin_amdgcn_permlane32_swap(a1, b1, false, false); u32x4 w = {r0[0], r1[0], r0[1], r1[1]}; \
          *(u32x4*)(X_lds + (XB) * (NW * 2048) + wid * 2048 + 1024 + lane * 16) = w; } } while (0)
#define BSTAGE(VB, XB) do { const char* xo_ = X_lds + (XB) * (NW * 2048) + wid * 2048 + lane * 16; const char* xp_ = X_lds + (XB) * (NW * 2048) + (wid ^ 4) * 2048 + lane * 16; \
        const bf16x8 own0 = *(const bf16x8*)xo_, own1 = *(const bf16x8*)(xo_ + 1024), oth0 = *(const bf16x8*)xp_, oth1 = *(const bf16x8*)(xp_ + 1024); \
        pair_pv<VB, NV>(o, vb0, kh ? oth0 : own0, kh ? oth1 : own1, kh ? own0 : oth0, kh ? own1 : oth1); } while (0)
    PLOADK(stA, 0); PLOADV(stA, 0); PLOADK(stB, 1); PLOADV(stB, 1);
    __syncthreads();
    PWRITEK(stA, 0); PWRITEV(stA, 0);
    PLOADK(stA, 2);
    __syncthreads();
    PROF_T1(8);
    PROF_T0(9);
    ASTAGE(0, 0, 0);
    PWRITEK(stB, 1);
    PLOADV(stA, 2); PLOADK(stB, 3);
    __syncthreads();
#define PITER(t, P, SV, SK) do {     \
        BSTAGE(P, P); \
        if ((t) + 1 < NT) { ASTAGE((t) + 1, (P) ^ 1, (P) ^ 1); PWRITEV(SV, (P) ^ 1); PWRITEK(SK, P); PLOADV(SV, (t) + 3); PLOADK(SK, (t) + 4); } \
        __syncthreads(); } while (0)
    PROF_T1(9);
    PROF_T1(2);
    { PROF_T0(3);
    int t = 0;
    for (; t + 1 < NT; t += 2) { PITER(t, 0, stB, stA); PITER(t + 1, 1, stA, stB); }
    if (t < NT) PITER(t, 0, stB, stA);
    PROF_T1(3); }
    { PROF_T0(4);
    { PROF_T0(6);
    if (hi == 0) L_lds[wid * 64 + r32] = l_reg;
    __syncthreads();
    PROF_T1(6); }
    PROF_T0(7);
    if (hi == 0) L_lds[wid * 64 + 32 + r32] = l_reg + L_lds[(wid ^ 4) * 64 + r32];
    asm volatile("s_waitcnt lgkmcnt(0)" ::: "memory");
    float rli[16];
#pragma unroll
    for (int r = 0; r < 16; ++r) rli[r] = __builtin_amdgcn_rcpf(L_lds[wid * 64 + 32 + crow(r, hi)]);
    constexpr int OROW = NV * 64 + 16;
    char* ot = lds + wid * (32 * (4 * 64 + 16));
    const bool odd = (r32 & 1) != 0;
#pragma unroll
    for (int r = 0; r < 16; ++r) { const int orow = crow(r, hi);
#pragma unroll
        for (int d0 = 0; d0 < NV; d0 += 2) { const float va = o[d0][r] * rli[r], vb = o[d0 + 1][r] * rli[r];
            const float snd = odd ? va : vb;
            const float rcv = __uint_as_float((unsigned)__builtin_amdgcn_update_dpp(0, (int)__float_as_uint(snd), 0xB1, 0xF, 0xF, true));
            const unsigned pk = cvtpk(odd ? rcv : va, odd ? vb : rcv);
            *(unsigned*)(ot + orow * OROW + ((odd ? d0 + 1 : d0) * 32 + (r32 & ~1)) * 2) = pk; } }
    asm volatile("s_waitcnt lgkmcnt(0)" ::: "memory");
    PROF_T0(10);
    bf16* Ow = B.O + (size_t)(pr * 32) * LDO + kh * (NV * 32);
    constexpr int CPR = NV * 4;
#pragma unroll
    for (int i = 0; i < (32 * CPR) / 64; ++i) { const int idx = i * 64 + lane, row = idx / CPR, ch = idx % CPR;
        const u32x4 w = *(const u32x4*)(ot + row * OROW + ch * 16);
        *(u32x4*)(Ow + (size_t)row * LDO + ch * 8) = w; }
    PROF_T1(10);
    PROF_T1(7);
    PROF_T1(4); }
#undef TCL
#undef PLOADK
#undef PLOADV
#undef PWRITEK
#undef PWRITEV
#undef KRD_
#undef KWT_
#undef ASTAGE
#undef BSTAGE
#undef PITER
}

constexpr float SKIP_T = 20.f;
constexpr int NDIFF = 16 * NQB2, NFOX = 16 * NQB2;
struct Tensors { const bf16* QKV; bf16* A2; bf16* DT; const float* BIAS; const unsigned* NRM; };
__host__ __device__ constexpr int est_diff(int h, int qb2) { const int full = 2 * (qb2 + 1), cap = h == 0 ? 12 : (h == 1 ? 24 : (h == 2 ? 62 : 128)); return full < cap ? full : cap; }
__host__ __device__ constexpr int est_fox(int qb2) { const int full = 2 * (qb2 + 1); return full < 20 ? full : 20; }
struct OrderTab2 { unsigned short v[NDIFF]; };
template <bool FOX> __host__ __device__ constexpr OrderTab2 make_order2() {
    OrderTab2 t{}; int start[130] = {};
    for (int pp = 0; pp < 16; ++pp) for (int qb = 0; qb < NQB2; ++qb) start[128 - (FOX ? est_fox(qb) : est_diff((pp >> 1) & 3, qb)) + 1]++;
    for (int i = 1; i < 130; ++i) start[i] += start[i - 1];
    for (int pp = 0; pp < 16; ++pp) for (int qb = NQB2 - 1; qb >= 0; --qb) { const int b = 128 - (FOX ? est_fox(qb) : est_diff((pp >> 1) & 3, qb)); t.v[start[b]++] = (unsigned short)(pp * 64 + qb); }
    return t;
}
__device__ const OrderTab2 ORDER_D = make_order2<false>();
__device__ const OrderTab2 ORDER_F = make_order2<true>();
constexpr int ORD_OFF = PAIR_LDS, NRMW_OFF = ORD_OFF + NDIFF * 2;
template <bool FOX>
__device__ __forceinline__ PRef make_pref(const Tensors& T, const char* lds, int o, int lane) {
    const int code = __builtin_amdgcn_readfirstlane((int)((const unsigned short*)(lds + ORD_OFF))[o]), pp = code >> 6, qb = code & 63, b = pp >> 3;
    PRef r; int sq, sk;
    const bf16* base = T.QKV + (size_t)b * S * LDQ; r.P0 = qb * QB2;
    if (FOX) { const int h = pp & 7; r.Q = base + (size_t)qb * QB2 * LDQ + C_FQ + h * 128; r.K = base + C_FK + h * 128; r.V = base + C_FV + h * 128; sq = h; sk = 8 + h;
        r.O = T.A2 + ((size_t)b * S + (size_t)qb * QB2) * LDO + h * 128; r.C = T.BIAS + (size_t)(b * 8 + h) * S; }
    else { const int h = (pp >> 1) & 3, mp = pp & 1; r.Q = base + (size_t)qb * QB2 * LDQ + C_DQ + h * 256 + mp * 128; r.K = base + C_DK + h * 256 + mp * 128; r.V = base + C_DV + h * 256; sq = 16 + 2 * h + mp; sk = 24 + 2 * h + mp;
        r.O = T.DT + ((size_t)b * S + (size_t)qb * QB2) * LDO + h * 512 + mp * 256; r.C = T.BIAS + (size_t)(16 + h) * S; }
    const int jd = r.P0 >> 6;
    int ln = lane; asm volatile("" : "+v"(ln));
    const int j0 = ln < jd ? ln : jd, j1 = ln + 64 < jd ? ln + 64 : jd;
    const float cp = r.C[r.P0], c0 = r.C[64 * j0 + 63], c1 = r.C[64 * j1 + 63];
    const float nq = ((const float*)(lds + NRMW_OFF))[b * 32 + sq], nk = ((const float*)(lds + NRMW_OFF))[b * 32 + sk];
    const float qk = 1.015f * sqrtf(nq * nk);
    const float th = (SKIP_T + 2.f * qk * SCALE) * (1.0f / SCALE), lim = cp + th; r.mref = qk;
    const bool k0 = (ln >= jd) | (c0 <= lim), k1 = (ln + 64 >= jd) | (c1 <= lim);
    const unsigned long long b0 = __ballot(k0), b1 = __ballot(k1);
    r.jlo = b0 ? (int)__builtin_ctzll(b0) : 64 + (int)__builtin_ctzll(b1);
    return r;
}
template <bool FOX>
__device__ __forceinline__ void attn_part(char* lds, const Tensors& T, unsigned* head, volatile __attribute__((address_space(3))) int* qw) {
    volatile __attribute__((address_space(3))) unsigned* PROFW = (volatile __attribute__((address_space(3))) unsigned*)(qw + 8);
    PROF_T0(5);
    const int tid = threadIdx.x, lane = tid & 63;
    if (tid == 0) qw[0] = (int)atomicAdd(head, 1u);
    ((unsigned*)(lds + ORD_OFF))[tid] = ((const unsigned*)(FOX ? ORDER_F.v : ORDER_D.v))[tid];
    if (tid < 64) ((unsigned*)(lds + NRMW_OFF))[tid] = T.NRM[tid];
    __syncthreads();
    int k = __builtin_amdgcn_readfirstlane(qw[0]);
    while (k < NDIFF) {
        int kn = 0; if (tid == 0) kn = (int)atomicAdd(head, 1u);
        PROF_T0(1);
        const PRef B = make_pref<FOX>(T, lds, k, lane);
        PROF_T1(1);
        pair_block<FOX ? 2 : 4>(B, lds, PROFW);
        if (tid == 0) qw[1] = kn;
        __syncthreads();
        k = __builtin_amdgcn_readfirstlane(qw[1]);
    }
    __syncthreads();
    PROF_T1(5);
}
#undef KSWZ
#undef SBAR
}

#define GAS __attribute__((address_space(1)))
#define LAS __attribute__((address_space(3)))
typedef unsigned short bf16;
typedef unsigned v4u __attribute__((ext_vector_type(4)));
typedef float f32x4 __attribute__((ext_vector_type(4)));
typedef short bf16x8 __attribute__((ext_vector_type(8)));
typedef GAS unsigned gu32;
typedef GAS unsigned long long gu64;
#define RLX_AGENT __ATOMIC_RELAXED, __HIP_MEMORY_SCOPE_AGENT
#define LDS_WAIT() asm volatile("s_waitcnt lgkmcnt(0)" ::: "memory")
#define VM_WAIT() asm volatile("s_waitcnt vmcnt(0)" ::: "memory")
__device__ __forceinline__ unsigned long long rt() { return __builtin_amdgcn_s_memrealtime(); }
__device__ __forceinline__ unsigned f2bf(float f) { unsigned u = __builtin_bit_cast(unsigned, f); return (u + 0x7fffu + ((u >> 16) & 1u)) >> 16; }
__device__ __forceinline__ unsigned pk2(float lo, float hi) { return f2bf(lo) | (f2bf(hi) << 16); }

#define XB_TMO      128
#define XB_XCNT(j)  (256  + 64 * (j))
#define XB_XSUB(j)  (1280 + 64 * (j))
#define XB_XGEN(j)  (2304 + 64 * (j))
#define XB_TOP      3328
#define XB_TOPGEN   3392
#define XCD_BAR_WORDS 3456
#define XB_SPIN_CAP (1u << 18)

__device__ __forceinline__ unsigned xb_ld(unsigned* p)              { return __hip_atomic_load(p, __ATOMIC_RELAXED, __HIP_MEMORY_SCOPE_AGENT); }
__device__ __forceinline__ unsigned xb_add(unsigned* p, unsigned v) { return __hip_atomic_fetch_add(p, v, __ATOMIC_RELAXED, __HIP_MEMORY_SCOPE_AGENT); }
__device__ __forceinline__ unsigned xb_xcc_id() { return (unsigned)__builtin_amdgcn_s_getreg((3 << 11) | 20) & 0xFu; }
#define XB_SPIN(cond, bar) do { unsigned _sp = 0; while (cond) { __builtin_amdgcn_s_sleep(1); \
    if ((++_sp & 255u) == 0u) { if (xb_ld(&(bar)[XB_TMO])) break; if (_sp > XB_SPIN_CAP) { atomicAdd(&(bar)[XB_TMO], 1u); break; } } } } while (0)

struct XcdBarrier {
    unsigned* bar; unsigned x;
    volatile LAS unsigned* st;
};

__device__ __forceinline__ XcdBarrier xcd_barrier_post(unsigned* bar, volatile LAS unsigned* st) {
    XcdBarrier b; b.bar = bar; b.x = xb_xcc_id(); b.st = st;
    if (threadIdx.x == 0) (void)xb_add(&bar[XB_XCNT(b.x)], 1u);
    return b;
}
__device__ __forceinline__ void xcd_barrier_complete(unsigned* bar, unsigned x, unsigned& nloc, unsigned& nx) {
    const unsigned G = gridDim.x * gridDim.y * gridDim.z;
    unsigned sum, cnt, mine, sp = 0u;
    for (;;) {
        sum = 0u; cnt = 0u; mine = 0u;
#pragma unroll
        for (unsigned j = 0; j < 16; ++j) { const unsigned c = xb_ld(&bar[XB_XCNT(j)]); sum += c; cnt += (c > 0u) ? 1u : 0u; mine = (j == x) ? c : mine; }
        if (sum == G) break;
        __builtin_amdgcn_s_sleep(1);
        if ((++sp & 255u) == 0u) { if (xb_ld(&bar[XB_TMO])) break; if (sp > XB_SPIN_CAP) { atomicAdd(&bar[XB_TMO], 1u); break; } }
    }
    nloc = mine > 0u ? mine : 1u; nx = cnt > 0u ? cnt : 1u;
}

__device__ __forceinline__ void xcd_barrier(const XcdBarrier& b) {
    asm volatile("s_waitcnt vmcnt(0)" ::: "memory");
    __syncthreads();
    if (threadIdx.x == 0) {
        unsigned* bar = b.bar;
        __builtin_amdgcn_s_waitcnt(0);
        unsigned nloc = b.st[0], nx = b.st[1];
        if (nloc == 0u) { xcd_barrier_complete(bar, b.x, nloc, nx); b.st[0] = nloc; b.st[1] = nx; }
        const unsigned old = xb_add(&bar[XB_XSUB(b.x)], 1u);
        const unsigned gen = old / nloc;
        if (old + 1u == (gen + 1u) * nloc) {
            __builtin_amdgcn_fence(__ATOMIC_RELEASE, "agent");
            asm volatile("s_waitcnt vmcnt(0)" ::: "memory");
            const unsigned og = xb_add(&bar[XB_TOP], 1u);
            const unsigned tg = og / nx;
            if (og + 1u == (tg + 1u) * nx) xb_add(&bar[XB_TOPGEN], 1u);
            else XB_SPIN(xb_ld(&bar[XB_TOPGEN]) == tg, bar);
            __builtin_amdgcn_fence(__ATOMIC_ACQUIRE, "agent");
            xb_add(&bar[XB_XGEN(b.x)], 1u);
            asm volatile("s_waitcnt vmcnt(0)" ::: "memory");
        } else {
            XB_SPIN(xb_ld(&bar[XB_XGEN(b.x)]) == gen, bar);
            __builtin_amdgcn_fence(__ATOMIC_ACQUIRE, "agent");
            asm volatile("s_waitcnt vmcnt(0)" ::: "memory");
        }
    }
    __syncthreads();
}

constexpr int NWAVES = 8;
constexpr int RING_OFF = 0, RING_BYTES = 131072;
constexpr int LDSCTL_OFF = RING_BYTES, MISC_OFF = LDSCTL_OFF + 320;
constexpr int SEG_OFF = LDSCTL_OFF + 1024;
constexpr int TILE_E_OFF = LDSCTL_OFF + 2048;
constexpr int TILE_RB_OFF = TILE_E_OFF + 1024;
constexpr int ECAP = M;
constexpr int NRMP_OFF = LDSCTL_OFF + 4096;
constexpr int LDS_BYTES = 147456;
constexpr int ATT_QW_OFF = LDSCTL_OFF + 512;
static_assert(att::PAIR_RING == RING_BYTES && att::PAIR_LDS <= LDS_BYTES && att::P_OFF_L >= ATT_QW_OFF + 64 && att::LDS_BYTES <= RING_BYTES && TILE_E_OFF + NTILE_MAX * 4 <= LDS_BYTES, "LDS map");

struct Args { const float* in[19]; float* out; unsigned char* ws; int ph_lo, ph_hi, li, pad; };

struct Ctx {
    LAS unsigned char* lds; int tid, lane, wave, G, gw, NGW;
    const float *x, *attn_g, *w_in, *fbias, *lq1, *lk1, *lq2, *lk2, *subg, *w_out, *ffn_g, *wg, *bg, *we, *be, *wgate, *wup, *wdown, *fin_g;
    float* out;
    bf16* A1; bf16* WIN; bf16* WOUT; float* BIAS; bf16* QKV; bf16* A2; bf16* DT; bf16* H1;
    int* tok_e; int* tok_pos; float* tok_gate; float* rstd; float* rowgate; int* rowtok; int* etok; float* egate; float* WR; bf16* XG; bf16* HB; bf16* Y; bf16* WGU; bf16* WD; unsigned* cnt; unsigned* nrm;
};
__device__ __forceinline__ float wave_sum(float v) {
#pragma unroll
    for (int o = 1; o < 64; o <<= 1) v += __shfl_xor(v, o);
    return v;
}
typedef unsigned v2u __attribute__((ext_vector_type(2)));

__device__ __forceinline__ void p0_row(const Ctx& C, int t, const LAS float* wf) {
    const int lane = C.lane; const float* xr = C.x + (size_t)t * DM;
    f32x4 v[8]; float ss = 0.f;
#pragma unroll
    for (int j = 0; j < 8; ++j) { v[j] = *(const f32x4*)(xr + j * 256 + lane * 4); ss += (v[j].x * v[j].x + v[j].y * v[j].y) + (v[j].z * v[j].z + v[j].w * v[j].w); }
    const float r = 1.f / sqrtf(wave_sum(ss) * (1.f / DM) + 1e-6f);
    float fl[8] = {0.f, 0.f, 0.f, 0.f, 0.f, 0.f, 0.f, 0.f};
#pragma unroll
    for (int j = 0; j < 8; ++j) {
        const f32x4 gg = *(const f32x4*)(C.attn_g + j * 256 + lane * 4);
        v[j] = v[j] * r * gg;
        v2u o; o.x = pk2(v[j].x, v[j].y); o.y = pk2(v[j].z, v[j].w);
        *(v2u*)(C.A1 + (size_t)t * DM + j * 256 + lane * 4) = o;
#pragma unroll
        for (int h = 0; h < 8; ++h) { const f32x4 w4 = *(const LAS f32x4*)(wf + h * DM + j * 256 + lane * 4); fl[h] += (v[j].x * w4.x + v[j].y * w4.y) + (v[j].z * w4.z + v[j].w * w4.w); }
        asm volatile("" ::: "memory");
    }
#pragma unroll
    for (int h = 0; h < 8; ++h) fl[h] = wave_sum(fl[h]);
    float z = fl[0];
#pragma unroll
    for (int h = 1; h < 8; ++h) z = (lane == h) ? fl[h] : z;
    if (lane < 8) { z += C.fbias[lane]; const float ls = fminf(z, 0.f) - log1pf(expf(-fabsf(z)));
        C.BIAS[(size_t)((t / S) * 8 + lane) * S + (t % S)] = ls; }
}
__device__ __forceinline__ void tr_item(const float* src, int ld, int k0, int c0, bf16* dst, int K, int r0, LAS float* scr, int lane) {
#pragma unroll 8
    for (int i = 0; i < 32; ++i) { const int kk = 2 * i + (lane >> 5); scr[kk * 33 + (lane & 31)] = src[(size_t)(k0 + kk) * ld + c0 + (lane & 31)]; }
    LDS_WAIT(); asm volatile("" ::: "memory");
    const int c = lane & 7;
#pragma unroll
    for (int j = 0; j < 4; ++j) { const int n = (lane >> 3) + 8 * j; const LAS float* s = scr + (8 * c) * 33 + n;
        v4u o; o.x = pk2(s[0 * 33], s[1 * 33]); o.y = pk2(s[2 * 33], s[3 * 33]); o.z = pk2(s[4 * 33], s[5 * 33]); o.w = pk2(s[6 * 33], s[7 * 33]);
        *(GAS v4u*)(dst + (size_t)(r0 + n) * K + k0 + 8 * c) = o; }
    LDS_WAIT(); asm volatile("" ::: "memory");
}
__device__ __forceinline__ void p0_prologue(const Ctx& C) {
    LAS float* scr = (LAS float*)(C.lds + RING_OFF + C.wave * 16384);
    constexpr int I_WIN = 32 * 192, I_WOUT = 32 * 64, I_ALL = I_WIN + I_WOUT;
    for (int it = C.gw; it < I_ALL; it += C.NGW) {
        int r = it;
        if (r < I_WIN) { const int kb = r / 192, nb = r % 192; tr_item(C.w_in, NCOL, 64 * kb, nb < 96 ? 32 * nb : 32 * nb + 8, C.WIN, DM, 32 * nb, scr, C.lane); continue; } r -= I_WIN;
        { const int kb = r / 64, nb = r % 64; tr_item(C.w_out, DM, 64 * kb, 32 * nb, C.WOUT, DM, 32 * nb, scr, C.lane); }
    }
    __syncthreads();
    { LAS float* wf = (LAS float*)(C.lds + RING_OFF);
      for (int k = C.tid; k < DM; k += NWAVES * 64) { const float* wr = C.w_in + (size_t)k * NCOL + FCOL; const f32x4 w0 = *(const f32x4*)wr, w1 = *(const f32x4*)(wr + 4);
          wf[0 * DM + k] = w0.x; wf[1 * DM + k] = w0.y; wf[2 * DM + k] = w0.z; wf[3 * DM + k] = w0.w; wf[4 * DM + k] = w1.x; wf[5 * DM + k] = w1.y; wf[6 * DM + k] = w1.z; wf[7 * DM + k] = w1.w; }
      __syncthreads();
      for (int t = C.gw; t < M; t += C.NGW) p0_row(C, t, wf); }
    const int gt = C.gw * 64 + C.lane, NGT = C.NGW * 64;
    for (int i = gt; i < 4 * S; i += NGT) { const int h = i / S, s = i % S; C.BIAS[(size_t)(16 + h) * S + s] = -exp2f(-2.f * (float)(h + 1)) * (float)s * ATT_ISCALE; }
    for (int i = gt; i < 64 * 5 * 2 * 64; i += NGT) { const int ln = i & 63, hl = (i >> 6) & 1, b = (i >> 7) % 5, kk = (i >> 7) / 5, c = 16 * b + (ln & 15);
        unsigned w[4];
#pragma unroll
        for (int jp = 0; jp < 4; ++jp) { unsigned pk = 0;
#pragma unroll
            for (int q = 0; q < 2; ++q) { const int k = 32 * kk + 8 * (ln >> 4) + 2 * jp + q;
                const float v = (c < 8 ? C.wg[(size_t)k * 8 + c] : (c < 72 ? C.we[(size_t)k * NE + c - 8] : 0.f)) * C.ffn_g[k];
                const unsigned h = f2bf(v); const unsigned l = f2bf(v - __uint_as_float(h << 16));
                pk |= (hl ? l : h) << (16 * q); }
            w[jp] = pk; }
        ((v4u*)C.WR)[i] = (v4u){w[0], w[1], w[2], w[3]}; }
}
__device__ __forceinline__ void p1_cumsum(const Ctx& C) {
    if (blockIdx.x >= 16) return;
    float* p = C.BIAS + (size_t)blockIdx.x * S + C.tid * 16; LAS float* wt = (LAS float*)(C.lds + RING_OFF);
    float loc[16]; float s = 0.f;
    { const f32x4 a = *(const f32x4*)p, b = *(const f32x4*)(p + 4), c = *(const f32x4*)(p + 8), d = *(const f32x4*)(p + 12);
      loc[0] = a.x; loc[1] = a.y; loc[2] = a.z; loc[3] = a.w; loc[4] = b.x; loc[5] = b.y; loc[6] = b.z; loc[7] = b.w; loc[8] = c.x; loc[9] = c.y; loc[10] = c.z; loc[11] = c.w; loc[12] = d.x; loc[13] = d.y; loc[14] = d.z; loc[15] = d.w; }
#pragma unroll
    for (int i = 0; i < 16; ++i) { s += loc[i]; loc[i] = s; }
    float inc = s;
#pragma unroll
    for (int o = 1; o < 64; o <<= 1) { const float q = __shfl_up(inc, o); if (C.lane >= o) inc += q; }
    if (C.lane == 63) wt[C.wave] = inc;
    __syncthreads();
    float base = inc - s;
    for (int w = 0; w < C.wave; ++w) base += wt[w];
#pragma unroll
    for (int i = 0; i < 16; ++i) loc[i] = (base + loc[i]) * ATT_ISCALE;
    *(f32x4*)p = (f32x4){loc[0], loc[1], loc[2], loc[3]}; *(f32x4*)(p + 4) = (f32x4){loc[4], loc[5], loc[6], loc[7]};
    *(f32x4*)(p + 8) = (f32x4){loc[8], loc[9], loc[10], loc[11]}; *(f32x4*)(p + 12) = (f32x4){loc[12], loc[13], loc[14], loc[15]};
    __syncthreads();
}
__device__ __forceinline__ void p_norms(const Ctx& C) {
    const int lane = C.lane, b = C.gw & 1;
    float mx[8] = {0.f, 0.f, 0.f, 0.f, 0.f, 0.f, 0.f, 0.f};
    for (int rr = C.gw >> 1; rr < S; rr += C.NGW >> 1) {
        const bf16* row = C.QKV + (size_t)(b * S + rr) * NQKV + 8 * lane;
#pragma unroll
        for (int i = 0; i < 8; ++i) { const v4u w = *(const v4u*)(row + (i < 4 ? 512 * i : 1024 + 512 * i));
            float ss = 0.f;
#pragma unroll
            for (int c = 0; c < 4; ++c) { const float lo = __uint_as_float(w[c] << 16), hi = __uint_as_float(w[c] & 0xffff0000u); ss += lo * lo + hi * hi; }
            ss += __shfl_xor(ss, 1); ss += __shfl_xor(ss, 2); ss += __shfl_xor(ss, 4); ss += __shfl_xor(ss, 8);
            mx[i] = fmaxf(mx[i], ss); }
    }
    if ((lane & 15) == 0) {
#pragma unroll
        for (int i = 0; i < 8; ++i) atomicMax(C.nrm + b * 32 + 4 * i + (lane >> 4), __float_as_uint(mx[i]));
    }
}
__device__ __forceinline__ void p3_combine(const Ctx& C) {
    const int lane = C.lane;
    const float s1 = wave_sum(C.lq1[lane] * C.lk1[lane] + C.lq1[lane + 64] * C.lk1[lane + 64]);
    const float s2 = wave_sum(C.lq2[lane] * C.lk2[lane] + C.lq2[lane + 64] * C.lk2[lane + 64]);
    const float lam = expf(s1) - expf(s2) + 0.2f;
    const f32x4 gg = *(const f32x4*)(C.subg + lane * 4);
    for (int idx = C.gw; idx < M * 4; idx += C.NGW) {
        const int t = idx >> 2, h = idx & 3;
        const bf16* p = C.DT + (size_t)t * DM + h * 512 + lane * 4;
        const v2u a = *(const v2u*)p, b = *(const v2u*)(p + 256);
        f32x4 d;
        d.x = __uint_as_float(a.x << 16) - lam * __uint_as_float(b.x << 16); d.y = __uint_as_float(a.x & 0xffff0000u) - lam * __uint_as_float(b.x & 0xffff0000u);
        d.z = __uint_as_float(a.y << 16) - lam * __uint_as_float(b.y << 16); d.w = __uint_as_float(a.y & 0xffff0000u) - lam * __uint_as_float(b.y & 0xffff0000u);
        const float ss = wave_sum((d.x * d.x + d.y * d.y) + (d.z * d.z + d.w * d.w));
        const float r = 0.8f / sqrtf(ss * (1.f / 256.f) + 1e-5f);
        v2u o; o.x = pk2(d.x * r * gg.x, d.y * r * gg.y); o.y = pk2(d.z * r * gg.z, d.w * r * gg.w);
        *(v2u*)(C.A2 + (size_t)t * DM + 1024 + h * 256 + lane * 4) = o;
    }
}
__device__ __forceinline__ void p5a_router(const Ctx& C) {
    const int w = C.wave, th = w & 1, ks = w >> 1;
    LAS float* R1 = (LAS float*)(C.lds + RING_OFF);
    LAS float* SS = (LAS float*)(C.lds + RING_OFF + 81920);
    LAS float* RS = SS + 512;
    LAS float* lg = (LAS float*)(C.lds + RING_OFF + 86016);
    for (int tl = (int)blockIdx.x; tl < M / 64; tl += C.G) {
        int lane = C.lane; asm volatile("" : "+v"(lane));
        const int r = lane & 15, g = lane >> 4;
        const int t0 = tl * 64;
        f32x4 acc[2][5];
#pragma unroll
        for (int T = 0; T < 2; ++T)
#pragma unroll
            for (int b = 0; b < 5; ++b) acc[T][b] = (f32x4){0.f, 0.f, 0.f, 0.f};
        float ss[2] = {0.f, 0.f};
        const bf16* hb = C.H1 + (size_t)(t0 + 32 * th) * DM + 512 * ks; const unsigned ho = (unsigned)(r * DM + 8 * g);
        const v4u* wp = (const v4u*)C.WR + (size_t)(16 * ks) * 10 * 64 + lane;
        v4u a[4][2], tb[10];
#define RT_LA(slot, j_) do { _Pragma("unroll") for (int T = 0; T < 2; ++T) a[slot][T] = *(const v4u*)(hb + (ho + (unsigned)(16 * T * DM + 32 * (j_)))); } while (0)
        RT_LA(0, 0);
#pragma unroll
        for (int q = 0; q < 10; ++q) tb[q] = wp[q * 64];
        RT_LA(1, 1); RT_LA(2, 2); RT_LA(3, 3);
#pragma unroll
        for (int j = 0; j < 16; ++j) {
            __builtin_amdgcn_sched_barrier(0);
#pragma unroll
            for (int T = 0; T < 2; ++T)
#pragma unroll
                for (int c = 0; c < 4; ++c) { const unsigned x = a[j & 3][T][c]; const float lo = __uint_as_float(x << 16), hi = __uint_as_float(x & 0xffff0000u); ss[T] += lo * lo + hi * hi; }
#pragma unroll
            for (int b = 0; b < 5; ++b) {
#pragma unroll
                for (int T = 0; T < 2; ++T) acc[T][b] = __builtin_amdgcn_mfma_f32_16x16x32_bf16(__builtin_bit_cast(bf16x8, a[j & 3][T]), __builtin_bit_cast(bf16x8, tb[2 * b]), acc[T][b], 0, 0, 0);
#pragma unroll
                for (int T = 0; T < 2; ++T) acc[T][b] = __builtin_amdgcn_mfma_f32_16x16x32_bf16(__builtin_bit_cast(bf16x8, a[j & 3][T]), __builtin_bit_cast(bf16x8, tb[2 * b + 1]), acc[T][b], 0, 0, 0);
                __builtin_amdgcn_sched_barrier(0);
                if (j + 1 < 16) { tb[2 * b] = wp[((j + 1) * 10 + 2 * b) * 64]; tb[2 * b + 1] = wp[((j + 1) * 10 + 2 * b + 1) * 64]; }
                __builtin_amdgcn_sched_barrier(0);
            }
            if (j + 4 < 16) RT_LA(j & 3, j + 4);
        }
#undef RT_LA
        asm volatile("" ::: "memory");
#pragma unroll
        for (int T = 0; T < 2; ++T) { ss[T] += __int_as_float(__builtin_amdgcn_ds_bpermute((lane ^ 16) << 2, __float_as_int(ss[T]))); ss[T] += __int_as_float(__builtin_amdgcn_ds_bpermute((lane ^ 32) << 2, __float_as_int(ss[T])));
            if (lane < 16) SS[ks * 64 + 16 * (2 * th + T) + lane] = ss[T]; }
        if (ks >= 2) {
#pragma unroll
            for (int T = 0; T < 2; ++T)
#pragma unroll
                for (int b = 0; b < 5; ++b)
#pragma unroll
                    for (int i = 0; i < 4; ++i) R1[((th * 2 + (ks - 2)) * 40 + (T * 5 + b) * 4 + i) * 64 + lane] = acc[T][b][i];
        }
        __syncthreads();
        if (ks < 2) {
#pragma unroll
            for (int T = 0; T < 2; ++T)
#pragma unroll
                for (int b = 0; b < 5; ++b)
#pragma unroll
                    for (int i = 0; i < 4; ++i) { LAS float* q = R1 + ((th * 2 + ks) * 40 + (T * 5 + b) * 4 + i) * 64 + lane; *q = acc[T][b][i] + *q; }
            if (w == 0) { const float s = (SS[lane] + SS[64 + lane]) + (SS[128 + lane] + SS[192 + lane]);
                const float rs = 1.f / sqrtf(s * (1.f / DM) + 1e-6f); RS[lane] = rs; C.rstd[t0 + lane] = rs; }
        }
        __syncthreads();
#pragma unroll
        for (int m = 0; m < 10; ++m) { const int sl = w + 8 * m, T = sl / 20, b = (sl % 20) >> 2, i = sl & 3, tok = 16 * T + 4 * g + i, s2 = sl % 40, hh = sl / 40;
            const float v = R1[((hh * 2 + 0) * 40 + s2) * 64 + lane] + R1[((hh * 2 + 1) * 40 + s2) * 64 + lane];
            lg[tok * 81 + 16 * b + r] = v * RS[tok]; }
        __syncthreads();
        if (w == 0) {
            const int t = t0 + lane; const LAS float* row = lg + lane * 81;
            float gmax = -__builtin_inff(); int gi = 0; float gl[8];
#pragma unroll
            for (int j = 0; j < 8; ++j) { gl[j] = row[j] + C.bg[j]; if (gl[j] > gmax) { gmax = gl[j]; gi = j; } }
            float gs = 0.f;
#pragma unroll
            for (int j = 0; j < 8; ++j) gs += expf(gl[j] - gmax);
            const float gprob = 1.f / gs;
            float l1 = -__builtin_inff(), l2 = -__builtin_inff(); int i1 = 0, i2 = 0;
#pragma unroll
            for (int j = 0; j < 8; ++j) { const float q = row[8 + gi * 8 + j] + C.be[gi * 8 + j];
                if (q > l1) { l2 = l1; i2 = i1; l1 = q; i1 = j; } else if (q > l2) { l2 = q; i2 = j; } }
            const float e2 = expf(l2 - l1), g1 = gprob / (1.f + e2), g2 = gprob * e2 / (1.f + e2);
            const int ea = gi * 8 + i1, eb = gi * 8 + i2;
            LAS unsigned* lc = (LAS unsigned*)(C.lds + RING_OFF + 110592); LAS unsigned* gb = lc + 64;
            lc[lane] = 0u; asm volatile("" ::: "memory");
            const unsigned la = __hip_atomic_fetch_add(lc + ea, 1u, __ATOMIC_RELAXED, __HIP_MEMORY_SCOPE_WORKGROUP); asm volatile("" ::: "memory");
            const unsigned lb = __hip_atomic_fetch_add(lc + eb, 1u, __ATOMIC_RELAXED, __HIP_MEMORY_SCOPE_WORKGROUP); asm volatile("" ::: "memory");
            const unsigned ne = lc[lane]; unsigned gbase = 0u; if (ne) gbase = atomicAdd(C.cnt + lane * CNT_STRIDE, ne);
            gb[lane] = gbase; asm volatile("" ::: "memory");
            const unsigned pa = gb[ea] + la, pb = gb[eb] + lb;
            C.tok_e[t * 2] = ea; C.tok_e[t * 2 + 1] = eb; C.tok_pos[t * 2] = (int)pa; C.tok_pos[t * 2 + 1] = (int)pb; C.etok[ea * ECAP + (int)pa] = t; C.etok[eb * ECAP + (int)pb] = t; C.tok_gate[t * 2] = g1; C.tok_gate[t * 2 + 1] = g2;
        }
        { asm volatile("" ::: "memory"); f32x4 gg[4][2];
#pragma unroll
            for (int j = 0; j < 4; ++j) { gg[j][0] = *(const f32x4*)(C.ffn_g + j * 512 + lane * 8); gg[j][1] = *(const f32x4*)(C.ffn_g + j * 512 + lane * 8 + 4); }
            const int r0 = w ? 9 * (w - 1) : 63, nr = w ? 9 : 1;
#pragma unroll 3
            for (int i = 0; i < nr; ++i) { const int rr = r0 + i; const float rsr = RS[rr]; const bf16* src = C.H1 + (size_t)(t0 + rr) * DM + lane * 8; bf16* dst = C.A1 + (size_t)(t0 + rr) * DM + lane * 8;
#pragma unroll
                for (int j = 0; j < 4; ++j) { const v4u x = *(const v4u*)(src + j * 512); const f32x4 g0 = gg[j][0], g1 = gg[j][1];
                    v4u o; o.x = pk2(__uint_as_float(x.x << 16) * rsr * g0.x, __uint_as_float(x.x & 0xffff0000u) * rsr * g0.y); o.y = pk2(__uint_as_float(x.y << 16) * rsr * g0.z, __uint_as_float(x.y & 0xffff0000u) * rsr * g0.w);
                    o.z = pk2(__uint_as_float(x.z << 16) * rsr * g1.x, __uint_as_float(x.z & 0xffff0000u) * rsr * g1.y); o.w = pk2(__uint_as_float(x.w << 16) * rsr * g1.z, __uint_as_float(x.w & 0xffff0000u) * rsr * g1.w);
                    *(v4u*)(dst + j * 512) = o; } } }
        __syncthreads();
    }
}
__device__ __forceinline__ void build_seg(const Ctx& C) {
    LAS int* seg = (LAS int*)(C.lds + SEG_OFF); LAS int* tile_e = (LAS int*)(C.lds + TILE_E_OFF);
    if (C.wave == 0) { const int p = (int)((C.cnt[C.lane * CNT_STRIDE] + 255u) & ~255u); int inc = p;
#pragma unroll
        for (int o = 1; o < 64; o <<= 1) { const int q = __shfl_up(inc, o); if (C.lane >= o) inc += q; }
        seg[C.lane] = inc - p; if (C.lane == 63) seg[NE] = inc; }
    __syncthreads();
    if (C.tid < NTILE_MAX) { const int row = C.tid * 256; int e = 0; for (int j = 1; j < NE; ++j) if (seg[j] <= row) e = j; tile_e[C.tid] = e; ((LAS int*)(C.lds + TILE_RB_OFF))[C.tid] = e * ECAP - seg[e]; }
    __syncthreads();
}
__device__ __forceinline__ void p5b_dispatch(const Ctx& C) {
    const LAS int* seg = (const LAS int*)(C.lds + SEG_OFF);
    for (int t = C.gw * 64 + C.lane; t < M; t += C.NGW * 64) {
        const int ra = seg[C.tok_e[t * 2]] + C.tok_pos[t * 2], rb = seg[C.tok_e[t * 2 + 1]] + C.tok_pos[t * 2 + 1];
        C.rowgate[ra] = C.tok_gate[t * 2]; C.rowgate[rb] = C.tok_gate[t * 2 + 1]; C.rowtok[ra] = t; C.rowtok[rb] = t;
    }
}
__device__ __forceinline__ void p8_final(const Ctx& C) {
    const LAS int* seg = (const LAS int*)(C.lds + SEG_OFF); const int lane = C.lane;
    for (int t0 = C.gw * 2; t0 < M; t0 += C.NGW * 2) {
        int ra[2], rb[2]; float ga[2], gb[2];
#pragma unroll
        for (int u = 0; u < 2; ++u) { const int t = t0 + u; ra[u] = seg[C.tok_e[t * 2]] + C.tok_pos[t * 2]; rb[u] = seg[C.tok_e[t * 2 + 1]] + C.tok_pos[t * 2 + 1]; ga[u] = C.tok_gate[t * 2]; gb[u] = C.tok_gate[t * 2 + 1]; }
        f32x4 v[2][8]; float ss[2] = {0.f, 0.f};
#pragma unroll
        for (int u = 0; u < 2; ++u) { const bf16* xr = C.H1 + (size_t)(t0 + u) * DM; const bf16* ya = C.Y + (size_t)ra[u] * DM; const bf16* yb = C.Y + (size_t)rb[u] * DM;
#pragma unroll
            for (int j = 0; j < 8; ++j) { const v2u h = *(const v2u*)(xr + j * 256 + lane * 4), a = *(const v2u*)(ya + j * 256 + lane * 4), b = *(const v2u*)(yb + j * 256 + lane * 4);
                v[u][j].x = __uint_as_float(h.x << 16) + (ga[u] * __uint_as_float(a.x << 16) + gb[u] * __uint_as_float(b.x << 16)); v[u][j].y = __uint_as_float(h.x & 0xffff0000u) + (ga[u] * __uint_as_float(a.x & 0xffff0000u) + gb[u] * __uint_as_float(b.x & 0xffff0000u));
                v[u][j].z = __uint_as_float(h.y << 16) + (ga[u] * __uint_as_float(a.y << 16) + gb[u] * __uint_as_float(b.y << 16)); v[u][j].w = __uint_as_float(h.y & 0xffff0000u) + (ga[u] * __uint_as_float(a.y & 0xffff0000u) + gb[u] * __uint_as_float(b.y & 0xffff0000u));
                ss[u] += (v[u][j].x * v[u][j].x + v[u][j].y * v[u][j].y) + (v[u][j].z * v[u][j].z + v[u][j].w * v[u][j].w); } }
#pragma unroll
        for (int u = 0; u < 2; ++u) { const float r = 1.f / sqrtf(wave_sum(ss[u]) * (1.f / DM) + 1e-6f);
#pragma unroll
            for (int j = 0; j < 8; ++j) *(f32x4*)(C.out + (size_t)(t0 + u) * DM + j * 256 + lane * 4) = v[u][j] * r * *(const f32x4*)(C.fin_g + j * 256 + lane * 4); }
    }
}

__global__ void __launch_bounds__(NWAVES * 64, 2) mk_fwd(Args args) {
    extern __shared__ __attribute__((aligned(16))) unsigned char lds[];
    Ctx C;
    C.lds = (LAS unsigned char*)lds; C.tid = threadIdx.x; C.lane = C.tid & 63; C.wave = __builtin_amdgcn_readfirstlane(C.tid >> 6);
    C.G = gridDim.x; C.gw = (int)blockIdx.x * NWAVES + C.wave; C.NGW = C.G * NWAVES;
    C.x = args.in[0]; C.attn_g = args.in[1]; C.w_in = args.in[2]; C.fbias = args.in[3]; C.lq1 = args.in[4]; C.lk1 = args.in[5]; C.lq2 = args.in[6]; C.lk2 = args.in[7];
    C.subg = args.in[8]; C.w_out = args.in[9]; C.ffn_g = args.in[10]; C.wg = args.in[11]; C.bg = args.in[12]; C.we = args.in[13]; C.be = args.in[14];
    C.wgate = args.in[15]; C.wup = args.in[16]; C.wdown = args.in[17]; C.fin_g = args.in[18]; C.out = args.out;
    unsigned char* ws = args.ws;
    C.A1 = (bf16*)(ws + WS_A1); C.WIN = (bf16*)(ws + WS_WIN); C.WOUT = (bf16*)(ws + WS_WOUT); C.BIAS = (float*)(ws + WS_BIAS); C.QKV = (bf16*)(ws + WS_QKV);
    C.A2 = (bf16*)(ws + WS_A2); C.DT = (bf16*)(ws + WS_DT); C.H1 = (bf16*)(ws + WS_H1);
    C.tok_e = (int*)(ws + WS_ROUTE); C.tok_pos = C.tok_e + 2 * M; C.tok_gate = (float*)(C.tok_pos + 2 * M); C.rstd = C.tok_gate + 2 * M; C.rowgate = C.rstd + M; C.rowtok = (int*)(C.rowgate + YROWS);
    C.etok = (int*)(ws + WS_XG); C.egate = (float*)(ws + WS_XG) + (size_t)NE * ECAP;
    C.WR = (float*)(ws + WS_WR); C.XG = (bf16*)(ws + WS_XG); C.HB = (bf16*)(ws + WS_HBUF); C.Y = (bf16*)(ws + WS_Y); C.WGU = (bf16*)(ws + WS_WGU); C.WD = (bf16*)(ws + WS_WD);
    C.cnt = (unsigned*)(ws + WS_CTL) + CW_CNT; C.nrm = (unsigned*)(ws + WS_CTL) + CW_NRM;
    volatile LAS unsigned* MISC = (volatile LAS unsigned*)(C.lds + MISC_OFF);
    for (int u = C.tid; u < (LDS_BYTES - LDSCTL_OFF) / 4; u += NWAVES * 64) ((LAS unsigned*)(C.lds + LDSCTL_OFF))[u] = 0u;
    __syncthreads();
    XcdBarrier bar = xcd_barrier_post((unsigned*)(ws + WS_CTL) + CW_BAR + args.li * XCD_BAR_WORDS, MISC + 8);
    const int lo = args.ph_lo, hi = args.ph_hi;
#define IN(k) (lo <= (k) && (k) < hi)
#define SEAM(k) do { if (IN(k) && IN((k) + 1)) xcd_barrier(bar); } while (0)
#ifndef PROBE_MASK
#define PROBE_MASK 0u
#endif
#ifndef PROBE_REP
#define PROBE_REP 0
#endif
#define TWICE(k) (((PROBE_MASK) >> (k)) & 1u)
#ifdef PROBE_TS
    volatile LAS unsigned long long* TSW = (volatile LAS unsigned long long*)(C.lds + LDSCTL_OFF + 15360);
#define TS(k) do { if (blockIdx.x == 0 && C.tid == 0) TSW[k] = __builtin_amdgcn_s_memrealtime(); } while (0)
#else
#define TS(k) do { } while (0)
#endif
    TS(0);

    if (IN(0)) { p0_prologue(C); if (TWICE(0)) { xcd_barrier(bar); p0_prologue(C); } } SEAM(0); TS(1);
    if (IN(1)) {
        p1_cumsum(C);
        pg8::Gemm g{C.A1, C.WIN, M, NQKV, DM}; pg8::StaticOrder So; So.init(M, NQKV, C.G, (int)blockIdx.x);
        pg8::EpiQKV E{C.QKV, NQKV, (PG8_LAS float*)(C.lds + NRMP_OFF), C.nrm};
        pg8::gemm_phase<pg8::EpiQKV, pg8::StaticOrder, true, true>(C.lds + RING_OFF, g, So, E);
        if (TWICE(1)) { xcd_barrier(bar); pg8::gemm_phase<pg8::EpiQKV, pg8::StaticOrder, true, true>(C.lds + RING_OFF, g, So, E); }
    } SEAM(1); TS(2);
    if (IN(3)) { const att::Tensors T{(const att::bf16*)C.QKV, (att::bf16*)C.A2, (att::bf16*)C.DT, C.BIAS, C.nrm};
        unsigned* qh = (unsigned*)(ws + WS_CTL) + CW_QHEAD; volatile __attribute__((address_space(3))) int* qw = (volatile __attribute__((address_space(3))) int*)(C.lds + RING_OFF + ATT_QW_OFF);
        att::attn_part<false>((char*)lds + RING_OFF, T, qh, qw); TS(3); att::attn_part<true>((char*)lds + RING_OFF, T, qh + 64, qw); if (TWICE(3)) { xcd_barrier(bar); att::attn_part<false>((char*)lds + RING_OFF, T, qh + 128, qw); att::attn_part<true>((char*)lds + RING_OFF, T, qh + 192, qw); } } SEAM(3); TS(4);
    if (IN(4)) { p3_combine(C); if (TWICE(4)) { xcd_barrier(bar); p3_combine(C); } } SEAM(4); TS(5);
    if (IN(5)) {
        pg8::Gemm g{C.A2, C.WOUT, M, DM, DM}; pg8::StaticOrder So; So.init(M, DM, C.G, (int)blockIdx.x);
        pg8::EpiResBf16 E{C.x, C.H1, DM};
        pg8::gemm_phase<pg8::EpiResBf16, pg8::StaticOrder, true, true>(C.lds + RING_OFF, g, So, E);
        if (TWICE(5)) { xcd_barrier(bar); pg8::gemm_phase<pg8::EpiResBf16, pg8::StaticOrder, true, true>(C.lds + RING_OFF, g, So, E); }
    } SEAM(5); TS(6);
    if (IN(6)) { p5a_router(C); } SEAM(6); TS(7);
#ifdef PROBE_IDLE
    { const unsigned long long t0 = __builtin_amdgcn_s_memrealtime(); while (__builtin_amdgcn_s_memrealtime() - t0 < (unsigned long long)(PROBE_IDLE) * 100ull) __builtin_amdgcn_s_sleep(32); }
#endif
    if (hi > 7) build_seg(C);
#ifdef PROBE_CLK
    unsigned long long ck0 = 0, cr0 = 0, ckd = 0, crd = 1;
    if (IN(PROBE_CLK)) { ck0 = __builtin_amdgcn_s_memtime(); cr0 = __builtin_amdgcn_s_memrealtime(); }
#endif
    if (IN(8)) {
        const PG8_LAS int* tile_e = (const PG8_LAS int*)(C.lds + TILE_E_OFF); const int ntile = ((const LAS int*)(C.lds + SEG_OFF))[NE] >> 8;
        #if defined(PROBE_HOT) && PROBE_HOT >= 3
        pg8::GemmW g{C.A1, DM, DFF, C.etok, args.li > 0 ? 255 : M - 1, (const PG8_LAS int*)(C.lds + TILE_RB_OFF)};
#else
        pg8::GemmW g{C.A1, DM, DFF, C.etok, M - 1, (const PG8_LAS int*)(C.lds + TILE_RB_OFF)};
#endif
        pg8::GroupedOrderW<0> So{ntile * 8, C.G, (int)blockIdx.x, tile_e, C.wgate, C.wup, args.li > 0};
        pg8::EpiSwiglu E{args.li > 0 ? C.XG : C.HB};
        pg8::gemm_phase_wf32<pg8::EpiSwiglu, pg8::GroupedOrderW<0>, true, true>(C.lds + RING_OFF, g, So, E);
    } SEAM(8); TS(8);
    if (IN(9)) {
        const PG8_LAS int* tile_e = (const PG8_LAS int*)(C.lds + TILE_E_OFF); const int ntile = ((const LAS int*)(C.lds + SEG_OFF))[NE] >> 8;
        pg8::GemmW g{C.HB, DFF, DM, nullptr, 0, nullptr}; pg8::GroupedOrderW<1> So{ntile * 8, C.G, (int)blockIdx.x, tile_e, C.wdown, nullptr};
        pg8::EpiDown E{C.Y};
        pg8::gemm_phase_wf32<pg8::EpiDown, pg8::GroupedOrderW<1>, true, false>(C.lds + RING_OFF, g, So, E);
    } SEAM(9); TS(9);
#ifdef PROBE_CLK
    if (IN(PROBE_CLK)) { ckd = __builtin_amdgcn_s_memtime() - ck0; crd = __builtin_amdgcn_s_memrealtime() - cr0; }
#endif
    if (IN(10)) { p8_final(C); if (TWICE(10)) { xcd_barrier(bar); p8_final(C); } }
#ifdef PROBE_CLK
    if (blockIdx.x == 0) { const unsigned long long want = ckd * 100ull / (crd ? crd : 1);
        const unsigned long long t0 = __builtin_amdgcn_s_memrealtime(); while (__builtin_amdgcn_s_memrealtime() - t0 < want) __builtin_amdgcn_s_sleep(8); }
#endif
#ifdef PROBE_TS
    if (blockIdx.x == 0 && C.tid == 0) { const unsigned long long dA = TSW[(PROBE_TS >> 4) & 15] - TSW[(PROBE_TS >> 8) & 15], dB = TSW[PROBE_TS & 15] - TSW[(PROBE_TS >> 12) & 15];
        const unsigned long long want = ((dA + 1000ull) / 2000ull) * 100000ull + dB;
        const unsigned long long t0 = __builtin_amdgcn_s_memrealtime(); while (__builtin_amdgcn_s_memrealtime() - t0 < want) __builtin_amdgcn_s_sleep(8); }
#endif
#ifdef PROBE_NT
    if (blockIdx.x == 0) { const int ntile_ = ((const LAS int*)(C.lds + SEG_OFF))[NE] >> 8; const unsigned long long want = (unsigned long long)(ntile_ > 150 ? ntile_ - 150 : 0) * 2000ull;
        const unsigned long long t0 = __builtin_amdgcn_s_memrealtime(); while (__builtin_amdgcn_s_memrealtime() - t0 < want) __builtin_amdgcn_s_sleep(8); }
#endif
#ifdef PROF_SECT
    if (blockIdx.x == 0) { __syncthreads(); const unsigned want = ((volatile LAS unsigned*)(C.lds + ATT_QW_OFF + 32))[0]; const unsigned long long t0 = __builtin_amdgcn_s_memtime(); while (__builtin_amdgcn_s_memtime() - t0 < (unsigned long long)want) __builtin_amdgcn_s_sleep(8); }
#endif
#undef IN
#undef SEAM
#undef TWICE
}

#if NAIVE_MASK
namespace nv {
__device__ __forceinline__ float bf2f(bf16_t v) { return __uint_as_float((unsigned)v << 16); }
__device__ __forceinline__ bf16_t f2b(float f) { return (bf16_t)f2bf(f); }
__global__ void __launch_bounds__(256) k_cumsum(float* __restrict__ bias) {
    __shared__ float part[256];
    float* p = bias + (size_t)blockIdx.x * S; const int tid = threadIdx.x;
    float loc[32]; float s = 0.f;
#pragma unroll
    for (int i = 0; i < 32; ++i) { s += p[tid * 32 + i]; loc[i] = s; }
    part[tid] = s; __syncthreads();
    if (tid == 0) { float a = 0.f; for (int i = 0; i < 256; ++i) { const float q = part[i]; part[i] = a; a += q; } }
    __syncthreads();
    const float base = part[tid];
#pragma unroll
    for (int i = 0; i < 32; ++i) p[tid * 32 + i] = (base + loc[i]) * ATT_ISCALE;
}
template <class FA, class FB>
__device__ __forceinline__ void ngemm_tile(int K, FA fa, FB fb, float (&acc)[4][4], float (*As)[65], float (*Bs)[65]) {
    const int tid = threadIdx.x, tx = tid & 15, ty = tid >> 4;
#pragma unroll
    for (int r = 0; r < 4; ++r)
#pragma unroll
        for (int c = 0; c < 4; ++c) acc[r][c] = 0.f;
    for (int k0 = 0; k0 < K; k0 += 16) {
        for (int e = tid; e < 1024; e += 256) { const int i = e >> 4, kk = e & 15; As[kk][i] = fa(i, k0 + kk); Bs[kk][i] = fb(k0 + kk, i); }
        __syncthreads();
#pragma unroll
        for (int kk = 0; kk < 16; ++kk) { float a[4], b[4];
#pragma unroll
            for (int r = 0; r < 4; ++r) a[r] = As[kk][ty * 4 + r];
#pragma unroll
            for (int c = 0; c < 4; ++c) b[c] = Bs[kk][tx * 4 + c];
#pragma unroll
            for (int r = 0; r < 4; ++r)
#pragma unroll
                for (int c = 0; c < 4; ++c) acc[r][c] += a[r] * b[c]; }
        __syncthreads();
    }
}
__global__ void __launch_bounds__(256) k_inproj(const bf16_t* __restrict__ A, const bf16_t* __restrict__ Bt, bf16_t* __restrict__ Cq) {
    __shared__ float As[16][65], Bs[16][65];
    const int m0 = blockIdx.y * 64, n0 = blockIdx.x * 64; float acc[4][4];
    ngemm_tile(DM, [&](int i, int k) { return bf2f(A[(size_t)(m0 + i) * DM + k]); }, [&](int k, int j) { return bf2f(Bt[(size_t)(n0 + j) * DM + k]); }, acc, As, Bs);
    const int tx = threadIdx.x & 15, ty = threadIdx.x >> 4;
#pragma unroll
    for (int r = 0; r < 4; ++r)
#pragma unroll
        for (int c = 0; c < 4; ++c) Cq[(size_t)(m0 + ty * 4 + r) * NQKV + n0 + tx * 4 + c] = f2b(acc[r][c]);
}
__global__ void __launch_bounds__(256) k_outproj(const bf16_t* __restrict__ A, const bf16_t* __restrict__ Bt, const float* __restrict__ x, float* __restrict__ H1) {
    __shared__ float As[16][65], Bs[16][65];
    const int m0 = blockIdx.y * 64, n0 = blockIdx.x * 64; float acc[4][4];
    ngemm_tile(DM, [&](int i, int k) { return bf2f(A[(size_t)(m0 + i) * DM + k]); }, [&](int k, int j) { return bf2f(Bt[(size_t)(n0 + j) * DM + k]); }, acc, As, Bs);
    const int tx = threadIdx.x & 15, ty = threadIdx.x >> 4;
#pragma unroll
    for (int r = 0; r < 4; ++r)
#pragma unroll
        for (int c = 0; c < 4; ++c) { const size_t o = (size_t)(m0 + ty * 4 + r) * DM + n0 + tx * 4 + c; H1[o] = x[o] + acc[r][c]; }
}
__global__ void __launch_bounds__(256) k_attn(const bf16_t* __restrict__ QKV, const float* __restrict__ bias, bf16_t* __restrict__ A2, bf16_t* __restrict__ DT) {
    __shared__ bf16_t Qs[64][130];
    __shared__ float Ks[32][129];
    __shared__ float Vs[32][128];
    __shared__ float Ps[64][33];
    const int tid = threadIdx.x, r = tid >> 2, c4 = tid & 3;
    const int qb = (int)gridDim.x - 1 - (int)blockIdx.x, p = blockIdx.y;
    int b, qcol, kcol, vcol, h, map = 0, vh = 0; const float* cc; const bool fox = p < 16;
    if (fox) { b = p >> 3; h = p & 7; qcol = C_FQ + h * 128; kcol = C_FK + h * 128; vcol = C_FV + h * 128; cc = bias + ((size_t)b * 8 + h) * S; }
    else { const int q = p - 16; b = q >> 4; h = (q >> 2) & 3; map = (q >> 1) & 1; vh = q & 1; qcol = C_DQ + h * 256 + map * 128; kcol = C_DK + h * 256 + map * 128; vcol = C_DV + h * 256 + vh * 128; cc = bias + (size_t)(16 + h) * S; }
    const int q0 = qb * 64; const size_t rowb = (size_t)b * S;
    for (int e = tid; e < 64 * 128; e += 256) { const int i = e >> 7, d = e & 127; Qs[i][d] = QKV[(rowb + q0 + i) * NQKV + qcol + d]; }
    const int t = q0 + r; const float ct = cc[t];
    float m = -1e30f, l = 0.f; float o[32];
#pragma unroll
    for (int j = 0; j < 32; ++j) o[j] = 0.f;
    const int nkt = (q0 + 63) / 32 + 1;
    for (int kt = 0; kt < nkt; ++kt) {
        const int k0 = kt * 32;
        __syncthreads();
        for (int e = tid; e < 32 * 128; e += 256) { const int i = e >> 7, d = e & 127; const size_t ro = (rowb + k0 + i) * NQKV; Ks[i][d] = bf2f(QKV[ro + kcol + d]); Vs[i][d] = bf2f(QKV[ro + vcol + d]); }
        __syncthreads();
        float sc[8];
#pragma unroll
        for (int j = 0; j < 8; ++j) sc[j] = 0.f;
        for (int d = 0; d < 128; ++d) { const float qv = bf2f(Qs[r][d]);
#pragma unroll
            for (int j = 0; j < 8; ++j) sc[j] += qv * Ks[c4 * 8 + j][d]; }
        float tmax = -__builtin_inff();
#pragma unroll
        for (int j = 0; j < 8; ++j) { const int s = k0 + c4 * 8 + j; float v = (sc[j] + (ct - cc[s])) * ATT_SCALE;
            if (s > t) v = -__builtin_inff();
            sc[j] = v; tmax = fmaxf(tmax, v); }
        tmax = fmaxf(tmax, __shfl_xor(tmax, 1)); tmax = fmaxf(tmax, __shfl_xor(tmax, 2));
        const float mn = fmaxf(m, tmax), alpha = __expf(m - mn); m = mn;
        float ps = 0.f;
#pragma unroll
        for (int j = 0; j < 8; ++j) { const float pv = __expf(sc[j] - mn); ps += pv; Ps[r][c4 * 8 + j] = pv; }
        ps += __shfl_xor(ps, 1); ps += __shfl_xor(ps, 2);
        l = l * alpha + ps;
        __syncthreads();
#pragma unroll
        for (int j = 0; j < 32; ++j) o[j] *= alpha;
        for (int kk = 0; kk < 32; ++kk) { const float pv = Ps[r][kk];
#pragma unroll
            for (int j = 0; j < 32; ++j) o[j] += pv * Vs[kk][c4 + 4 * j]; }
    }
    const float il = 1.f / l;
    bf16_t* op = fox ? A2 + (rowb + t) * DM + h * 128 : DT + (rowb + t) * DM + h * 512 + map * 256 + vh * 128;
#pragma unroll
    for (int j = 0; j < 32; ++j) op[c4 + 4 * j] = f2b(o[j] * il);
}
__global__ void __launch_bounds__(256) k_diff_combine(const bf16_t* __restrict__ DT, const float* __restrict__ lq1, const float* __restrict__ lk1, const float* __restrict__ lq2,
                                                      const float* __restrict__ lk2, const float* __restrict__ sg, bf16_t* __restrict__ A2) {
    const int lane = threadIdx.x & 63, wv = threadIdx.x >> 6;
    const int idx = blockIdx.x * 4 + wv, t = idx >> 2, h = idx & 3;
    const float s1 = wave_sum(lq1[lane] * lk1[lane] + lq1[lane + 64] * lk1[lane + 64]);
    const float s2 = wave_sum(lq2[lane] * lk2[lane] + lq2[lane + 64] * lk2[lane + 64]);
    const float lam = expf(s1) - expf(s2) + 0.2f;
    const bf16_t* p = DT + (size_t)t * DM + h * 512;
    float d[4]; float ss = 0.f;
#pragma unroll
    for (int c = 0; c < 4; ++c) { d[c] = bf2f(p[lane * 4 + c]) - lam * bf2f(p[256 + lane * 4 + c]); ss += d[c] * d[c]; }
    ss = wave_sum(ss);
    const float r = rsqrtf(ss * (1.f / 256.f) + 1e-5f) * 0.8f;
    bf16_t* o = A2 + (size_t)t * DM + 1024 + h * 256 + lane * 4;
#pragma unroll
    for (int c = 0; c < 4; ++c) o[c] = f2b(d[c] * r * sg[lane * 4 + c]);
}
__global__ void __launch_bounds__(256) k_route(const float* __restrict__ H1, const float* __restrict__ g, const float* __restrict__ wg, const float* __restrict__ bg,
                                               const float* __restrict__ we, const float* __restrict__ be, int* __restrict__ tok_e, int* __restrict__ tok_pos,
                                               float* __restrict__ tok_gate, float* __restrict__ rstd, unsigned* __restrict__ cnt) {
    __shared__ float xs[4][DM];
    const int lane = threadIdx.x & 63, wv = threadIdx.x >> 6;
    const int t = blockIdx.x * 4 + wv;
    const float* xr = H1 + (size_t)t * DM;
    f32x4 v[8]; float ss = 0.f;
#pragma unroll
    for (int j = 0; j < 8; ++j) { v[j] = *(const f32x4*)(xr + j * 256 + lane * 4); ss += v[j].x * v[j].x + v[j].y * v[j].y + v[j].z * v[j].z + v[j].w * v[j].w; }
    ss = wave_sum(ss);
    const float r = 1.f / sqrtf(ss * (1.f / DM) + 1e-6f);
#pragma unroll
    for (int j = 0; j < 8; ++j) { const f32x4 gg = *(const f32x4*)(g + j * 256 + lane * 4); *(f32x4*)(&xs[wv][j * 256 + lane * 4]) = v[j] * r * gg; }
    __syncthreads();
    float el = 0.f;
    for (int k = 0; k < DM; ++k) el += xs[wv][k] * we[(size_t)k * NE + lane];
    el += be[lane];
    float gl = 0.f;
    for (int k = (lane >> 3); k < DM; k += 8) gl += xs[wv][k] * wg[(size_t)k * 8 + (lane & 7)];
    gl += __shfl_xor(gl, 8); gl += __shfl_xor(gl, 16); gl += __shfl_xor(gl, 32);
    gl += bg[lane & 7];
    float gmax = -__builtin_inff(); int gi = 0;
#pragma unroll
    for (int j = 0; j < 8; ++j) { const float q = __shfl(gl, j); if (q > gmax) { gmax = q; gi = j; } }
    float gs = 0.f;
#pragma unroll
    for (int j = 0; j < 8; ++j) gs += expf(__shfl(gl, j) - gmax);
    const float gprob = 1.f / gs;
    float l1 = -__builtin_inff(), l2 = -__builtin_inff(); int i1 = 0, i2 = 0;
#pragma unroll
    for (int j = 0; j < 8; ++j) { const float q = __shfl(el, gi * 8 + j);
        if (q > l1) { l2 = l1; i2 = i1; l1 = q; i1 = j; } else if (q > l2) { l2 = q; i2 = j; } }
    const float e2 = expf(l2 - l1), g1 = gprob / (1.f + e2), g2 = gprob * e2 / (1.f + e2);
    if (lane == 0) {
        const int ea = gi * 8 + i1, eb = gi * 8 + i2;
        const unsigned pa = atomicAdd(cnt + ea, 1u), pb = atomicAdd(cnt + eb, 1u);
        tok_e[t * 2] = ea; tok_e[t * 2 + 1] = eb; tok_pos[t * 2] = (int)pa; tok_pos[t * 2 + 1] = (int)pb; tok_gate[t * 2] = g1; tok_gate[t * 2 + 1] = g2; rstd[t] = r;
    }
}
__device__ __forceinline__ int seg_off(const unsigned* cnt, int e) { int o = 0; for (int i = 0; i < e; ++i) o += (int)((cnt[i] + 255u) & ~255u); return o; }
__global__ void __launch_bounds__(256) k_dispatch(const float* __restrict__ H1, const float* __restrict__ g, const float* __restrict__ rstd, const int* __restrict__ tok_e,
                                                  const int* __restrict__ tok_pos, const float* __restrict__ tok_gate, const unsigned* __restrict__ cnt, bf16_t* __restrict__ XG, float* __restrict__ rowgate) {
    const int lane = threadIdx.x & 63, wv = threadIdx.x >> 6; const int t = blockIdx.x * 4 + wv;
    const int ra = seg_off(cnt, tok_e[t * 2]) + tok_pos[t * 2], rb = seg_off(cnt, tok_e[t * 2 + 1]) + tok_pos[t * 2 + 1];
    const float rs = rstd[t];
    for (int k = lane; k < DM; k += 64) { const bf16_t v = f2b(H1[(size_t)t * DM + k] * rs * g[k]); XG[(size_t)ra * DM + k] = v; XG[(size_t)rb * DM + k] = v; }
    if (lane == 0) { rowgate[ra] = tok_gate[t * 2]; rowgate[rb] = tok_gate[t * 2 + 1]; }
}
__global__ void __launch_bounds__(256) k_moe_up(const bf16_t* __restrict__ XG, const bf16_t* __restrict__ WGU, const unsigned* __restrict__ cnt, bf16_t* __restrict__ HB) {
    __shared__ float As[16][65], Bs[16][65];
    const int m0 = blockIdx.y * 64, n0 = blockIdx.x * 64;
    int e = 0, tot = 0; { int o = 0; for (int i = 0; i < NE; ++i) { if (o <= m0) e = i; o += (int)((cnt[i] + 255u) & ~255u); } tot = o; }
    if (m0 >= tot) return;
    const bf16_t* W = WGU + (size_t)e * 2048 * DM; const int rg = 256 * (n0 >> 7) + (n0 & 127), ru = rg + 128;
    float ag[4][4], au[4][4];
    ngemm_tile(DM, [&](int i, int k) { return bf2f(XG[(size_t)(m0 + i) * DM + k]); }, [&](int k, int j) { return bf2f(W[(size_t)(rg + j) * DM + k]); }, ag, As, Bs);
    ngemm_tile(DM, [&](int i, int k) { return bf2f(XG[(size_t)(m0 + i) * DM + k]); }, [&](int k, int j) { return bf2f(W[(size_t)(ru + j) * DM + k]); }, au, As, Bs);
    const int tx = threadIdx.x & 15, ty = threadIdx.x >> 4;
#pragma unroll
    for (int r = 0; r < 4; ++r)
#pragma unroll
        for (int c = 0; c < 4; ++c) { const float gv = ag[r][c]; HB[(size_t)(m0 + ty * 4 + r) * DFF + n0 + tx * 4 + c] = f2b(gv / (1.f + expf(-gv)) * au[r][c]); }
}
__global__ void __launch_bounds__(256) k_moe_down(const bf16_t* __restrict__ HB, const bf16_t* __restrict__ WD, const unsigned* __restrict__ cnt, const float* __restrict__ rowgate, bf16_t* __restrict__ Y) {
    __shared__ float As[16][65], Bs[16][65];
    const int m0 = blockIdx.y * 64, n0 = blockIdx.x * 64;
    int e = 0, tot = 0; { int o = 0; for (int i = 0; i < NE; ++i) { if (o <= m0) e = i; o += (int)((cnt[i] + 255u) & ~255u); } tot = o; }
    if (m0 >= tot) return;
    const bf16_t* W = WD + (size_t)e * DM * DFF; float acc[4][4];
    ngemm_tile(DFF, [&](int i, int k) { return bf2f(HB[(size_t)(m0 + i) * DFF + k]); }, [&](int k, int j) { return bf2f(W[(size_t)(n0 + j) * DFF + k]); }, acc, As, Bs);
    const int tx = threadIdx.x & 15, ty = threadIdx.x >> 4;
#pragma unroll
    for (int r = 0; r < 4; ++r) { const int row = m0 + ty * 4 + r; const float gt = rowgate[row];
#pragma unroll
        for (int c = 0; c < 4; ++c) Y[(size_t)row * DM + n0 + tx * 4 + c] = f2b(acc[r][c] * gt); }
}
__global__ void __launch_bounds__(256) k_final(const float* __restrict__ H1, const bf16_t* __restrict__ Y, const unsigned* __restrict__ cnt, const int* __restrict__ tok_e,
                                               const int* __restrict__ tok_pos, const float* __restrict__ g, float* __restrict__ out) {
    const int lane = threadIdx.x & 63, wv = threadIdx.x >> 6; const int t = blockIdx.x * 4 + wv;
    const int ra = seg_off(cnt, tok_e[t * 2]) + tok_pos[t * 2], rb = seg_off(cnt, tok_e[t * 2 + 1]) + tok_pos[t * 2 + 1];
    float v[32]; float ss = 0.f;
#pragma unroll
    for (int i = 0; i < 32; ++i) { const int k = lane + 64 * i; v[i] = H1[(size_t)t * DM + k] + bf2f(Y[(size_t)ra * DM + k]) + bf2f(Y[(size_t)rb * DM + k]); ss += v[i] * v[i]; }
    ss = wave_sum(ss);
    const float r = 1.f / sqrtf(ss * (1.f / DM) + 1e-6f);
#pragma unroll
    for (int i = 0; i < 32; ++i) { const int k = lane + 64 * i; out[(size_t)t * DM + k] = v[i] * r * g[k]; }
}
}
static void naive_phase(int k, const Args& a, hipStream_t stream) {
    unsigned char* ws = a.ws;
    bf16_t* A1 = (bf16_t*)(ws + WS_A1); bf16_t* WIN = (bf16_t*)(ws + WS_WIN); bf16_t* WOUT = (bf16_t*)(ws + WS_WOUT); float* BIAS = (float*)(ws + WS_BIAS); bf16_t* QKV = (bf16_t*)(ws + WS_QKV);
    bf16_t* A2 = (bf16_t*)(ws + WS_A2); bf16_t* DT = (bf16_t*)(ws + WS_DT); float* H1 = (float*)(ws + WS_H1);
    int* tok_e = (int*)(ws + WS_ROUTE); int* tok_pos = tok_e + 2 * M; float* tok_gate = (float*)(tok_pos + 2 * M); float* rstd = tok_gate + 2 * M; float* rowgate = rstd + M;
    bf16_t* XG = (bf16_t*)(ws + WS_XG); bf16_t* HB = (bf16_t*)(ws + WS_HBUF); bf16_t* Y = (bf16_t*)(ws + WS_Y); bf16_t* WGU = (bf16_t*)(ws + WS_WGU); bf16_t* WD = (bf16_t*)(ws + WS_WD);
    unsigned* cnt = (unsigned*)(ws + WS_CTL) + CW_CNT;
    switch (k) {
    case 1: nv::k_cumsum<<<16, 256, 0, stream>>>(BIAS); nv::k_inproj<<<dim3(NQKV / 64, M / 64), 256, 0, stream>>>(A1, WIN, QKV); break;
    case 3: nv::k_attn<<<dim3(S / 64, 48), 256, 0, stream>>>(QKV, BIAS, A2, DT); break;
    case 4: nv::k_diff_combine<<<M, 256, 0, stream>>>(DT, a.in[4], a.in[5], a.in[6], a.in[7], a.in[8], A2); break;
    case 5: nv::k_outproj<<<dim3(DM / 64, M / 64), 256, 0, stream>>>(A2, WOUT, a.in[0], H1); break;
    case 6: nv::k_route<<<M / 4, 256, 0, stream>>>(H1, a.in[10], a.in[11], a.in[12], a.in[13], a.in[14], tok_e, tok_pos, tok_gate, rstd, cnt); break;
    case 7: nv::k_dispatch<<<M / 4, 256, 0, stream>>>(H1, a.in[10], rstd, tok_e, tok_pos, tok_gate, cnt, XG, rowgate); break;
    case 8: nv::k_moe_up<<<dim3(DFF / 64, YROWS / 64), 256, 0, stream>>>(XG, WGU, cnt, HB); break;
    case 9: nv::k_moe_down<<<dim3(DM / 64, YROWS / 64), 256, 0, stream>>>(HB, WD, cnt, rowgate, Y); break;
    case 10: nv::k_final<<<M / 4, 256, 0, stream>>>(H1, Y, cnt, tok_e, tok_pos, a.in[18], a.out); break;
    default: break;
    }
}
#endif


extern "C" void kernel_launch(void* const* d_in, const int* in_sizes, int n_in, void* d_out, int out_size, void* d_ws, size_t ws_size, hipStream_t stream) {
    static int grid = 0;
    if (grid == 0) {
        if (n_in != 19 || in_sizes[0] != M * DM || out_size != M * DM || ws_size < WS_END) {
            fprintf(stderr, "kernel_launch: built for 19 inputs, x and out of %d floats, >= %zu bytes of workspace; got n_in %d, in0 %d, out %d, ws %zu; nothing launched\n", M * DM, (size_t)WS_END, n_in, n_in > 0 ? in_sizes[0] : -1, out_size, ws_size); grid = -1; return; }
        int dev = 0, cus = 0, per_cu = 0;
        if (hipGetDevice(&dev) != hipSuccess || hipDeviceGetAttribute(&cus, hipDeviceAttributeMultiprocessorCount, dev) != hipSuccess) { fprintf(stderr, "kernel_launch: device query failed\n"); grid = -1; return; }
        if (hipFuncSetAttribute((const void*)mk_fwd, hipFuncAttributeMaxDynamicSharedMemorySize, LDS_BYTES) != hipSuccess) { fprintf(stderr, "kernel_launch: hipFuncSetAttribute failed\n"); grid = -1; return; }
        if (hipOccupancyMaxActiveBlocksPerMultiprocessor(&per_cu, (const void*)mk_fwd, NWAVES * 64, LDS_BYTES) != hipSuccess || per_cu < 1)
            fprintf(stderr, "kernel_launch: note: occupancy query reports %d workgroups per CU\n", per_cu);
        (void)hipGetLastError();
        grid = cus;
    }
    if (grid < 0) return;
    if (hipMemsetAsync((char*)d_ws + WS_CTL, 0, CTL_ZERO_BYTES, stream) != hipSuccess) { fprintf(stderr, "kernel_launch: memset failed\n"); return; }
    Args a{};
    for (int i = 0; i < 19; ++i) a.in[i] = (const float*)d_in[i];
    a.out = (float*)d_out; a.ws = (unsigned char*)d_ws;
    int k = 0, li = 0;
    while (k < NPHASE) {
#if NAIVE_MASK
        if (k > 0 && ((NAIVE_MASK >> k) & 1u)) { naive_phase(k, a, stream); ++k; continue; }
#endif
        const int lo = k; ++k;
        while (k < NPHASE && !((NAIVE_MASK >> k) & 1u)) ++k;
        a.ph_lo = lo; a.ph_hi = k; a.li = li++;
        hipLaunchKernelGGL(mk_fwd, dim3(grid), dim3(NWAVES * 64), LDS_BYTES, stream, a);
        const hipError_t le = hipPeekAtLastError();
        if (le != hipSuccess) { fprintf(stderr, "kernel_launch: launch failed: %s\n", hipGetErrorName(le)); break; }
    }
#if PROBE_REP
    a.ph_lo = PROBE_REP; a.ph_hi = PROBE_REP + 1; a.li = li++;
    hipLaunchKernelGGL(mk_fwd, dim3(grid), dim3(NWAVES * 64), LDS_BYTES, stream, a);
#endif
}
```

```cpp
#include <hip/hip_runtime.h>
#include <hip/hip_bf16.h>
#include <cstdio>
#include <cstdint>
#include <cmath>

#ifndef NAIVE_MASK
#define NAIVE_MASK 0u
#endif

typedef unsigned short bf16_t;
constexpr int NB = 2, S = 8192, DM = 2048, M = NB * S;
constexpr int NCOL = 6152, NQKV = 6144;
constexpr int FCOL = 3072;
constexpr int NE = 64, DFF = 1024;
constexpr int YROWS = 49152, NTILE_MAX = YROWS / 256;
constexpr int C_FQ = 0, C_FK = 1024, C_FV = 2048, C_DQ = 3072, C_DK = 4096, C_DV = 5120;
constexpr float ATT_SCALE = 0.08838834764831845f, ATT_ISCALE = 11.313708498984761f;
constexpr int NPHASE = 11;

constexpr size_t MiB = 1u << 20;
constexpr size_t WS_CTL = 0, CTL_ZERO_BYTES = 1 * MiB;
constexpr size_t WS_A1 = 1 * MiB;
constexpr size_t WS_WIN = 65 * MiB;
constexpr size_t WS_WOUT = 89 * MiB;
constexpr size_t WS_BIAS = 97 * MiB;
constexpr size_t WS_QKV = 98 * MiB;
constexpr size_t WS_A2 = 290 * MiB;
constexpr size_t WS_DT = 354 * MiB;
constexpr size_t WS_H1 = 418 * MiB;
constexpr size_t WS_ROUTE = 546 * MiB;
constexpr size_t WS_WR = 547 * MiB;
constexpr size_t WS_XG = 548 * MiB;
constexpr size_t WS_HBUF = 740 * MiB;
constexpr size_t WS_Y = 836 * MiB;
constexpr size_t WS_WGU = 1028 * MiB;
constexpr size_t WS_WD = 1540 * MiB;
constexpr size_t WS_END = 1796 * MiB;
constexpr int CW_CNT = 65536, CNT_STRIDE = 1056;
constexpr int CW_NRM = 2048;
constexpr int CW_QHEAD = 3072;
constexpr int CW_BAR = 4096;

namespace pg8 {
#define PG8_LAS __attribute__((address_space(3)))
typedef unsigned short bf16_t;
typedef short bf16x8 __attribute__((ext_vector_type(8)));
typedef float f32x4 __attribute__((ext_vector_type(4)));
typedef unsigned u32x4 __attribute__((ext_vector_type(4)));
constexpr int BM = 256, BK = 64, HALF = 128, HTB = HALF * BK * 2  , STAGE_BYTES = 8 * HTB, NXCD = 8, WGM = 8;

__host__ __device__ __forceinline__ int lds_byte(int r, int c) { const int st = (r >> 4) * 2 + (c >> 5), rr = r & 15, cc = c & 31, ob = rr * 64 + cc * 2; return st * 1024 + (ob ^ (((ob >> 9) & 1) << 5)); }
__host__ __device__ __forceinline__ void stage_rc(int b, int& R, int& C) { const int st = b / 1024, sb = b % 1024, swz = sb ^ (((sb >> 9) & 1) << 5); R = (st >> 1) * 16 + swz / 64; C = (st & 1) * 32 + (swz % 64) / 2; }
__host__ __device__ __forceinline__ int perm32(int rho) { const int n = rho >> 4, i = rho & 15; return 8 * (i >> 2) + 4 * n + (i & 3); }

struct Unit { int pm, pn; };
struct Gemm { const bf16_t* A; const bf16_t* Bt; int M, N, K; };

struct StaticOrder {
    int nM, nN, nwg, G, c;
    __host__ __device__ void init(int M, int N, int G_, int c_) { nM = M / BM; nN = N / BM; nwg = nM * nN; G = G_; c = c_; }
    __host__ __device__ bool next(int i, Unit& u) const {
        const long L = (long)i * G + c; if (L >= nwg) return false;
        int wgid = (int)L; { const int q = nwg / NXCD, r = nwg % NXCD, xcd = wgid % NXCD, off = wgid / NXCD; wgid = (xcd < r ? xcd * (q + 1) : r * (q + 1) + (xcd - r) * q) + off; }
        const int nig = WGM * nN, gid = wgid / nig, fm = gid * WGM, gsz = (nM - fm) < WGM ? (nM - fm) : WGM;
        u.pm = fm + ((wgid % nig) % gsz); u.pn = (wgid % nig) / gsz; return true;
    }
    __device__ __forceinline__ void a_ready(const Unit&) const {}
    __device__ __forceinline__ void done(const Unit&) const {}
};

__device__ __forceinline__ unsigned cvt_pk_bf16(float lo, float hi) { unsigned r; asm volatile("v_cvt_pk_bf16_f32 %0, %1, %2" : "=v"(r) : "v"(lo), "v"(hi)); return r; }
typedef float f32x2 __attribute__((ext_vector_type(2)));
__device__ __forceinline__ f32x2 gelu_pk(f32x2 v) {
    const f32x2 av = __builtin_elementwise_abs(v), d = av * 0.2316418882f + 1.0f;
    f32x2 t; t.x = __builtin_amdgcn_rcpf(d.x); t.y = __builtin_amdgcn_rcpf(d.y);
    f32x2 q = t * 0.5307027145f + (-0.7265760135f); q = q * t + 0.7107068705f; q = q * t + (-0.142248368f); q = q * t + 0.127414796f; q = q * t;
    const f32x2 s = (v * v) * (-0.72134752044f);
    f32x2 e; e.x = __builtin_amdgcn_exp2f(s.x); e.y = __builtin_amdgcn_exp2f(s.y);
    const f32x2 m = v * (q * e), r = v - m;
    f32x2 o; o.x = v.x < 0.f ? m.x : r.x; o.y = v.y < 0.f ? m.y : r.y; return o;
}

template <int ACT  > struct EpiBf16 {
    static constexpr bool PERM = true, AFTER_DRAIN = false; static_assert(ACT == 0 || ACT == 1, "EpiBf16: ACT is 0 (none) or 1 (gelu_pk)");
    bf16_t* O; int ldc; const float* bias; int split_cols; size_t split_stride; float scale0;
    __device__ __forceinline__ void operator()(const f32x4 (&acc)[2][2][4][2], const Unit& u, int wr, int wc, int fr, int fq) const {
        const int row0 = u.pm * BM + wr * 64 + fr; int colt = u.pn * BM; bf16_t* base = O;
        float sc = 1.f; if (split_cols) { const int t = colt / split_cols; base += (size_t)t * split_stride; colt -= t * split_cols; if (t == 0) sc = scale0; }
        const int col0 = colt + wc * 32 + 8 * fq, bcol0 = u.pn * BM + wc * 32 + 8 * fq;
        f32x4 bv[2][2];
#pragma unroll
        for (int bj = 0; bj < 2; ++bj)
#pragma unroll
            for (int n = 0; n < 2; ++n) bv[bj][n] = bias ? *(const f32x4*)(bias + bcol0 + bj * HALF + 4 * n) : (f32x4){0.f, 0.f, 0.f, 0.f};
#pragma unroll
        for (int ai = 0; ai < 2; ++ai)
#pragma unroll
            for (int m = 0; m < 4; ++m) { bf16_t* rowp = base + (size_t)(row0 + ai * HALF + m * 16) * ldc + col0;
#pragma unroll
                for (int bj = 0; bj < 2; ++bj) { f32x4 v0 = acc[ai][bj][m][0] + bv[bj][0], v1 = acc[ai][bj][m][1] + bv[bj][1];
                    if (ACT == 1) { f32x2 a = gelu_pk((f32x2){v0[0], v0[1]}), b = gelu_pk((f32x2){v0[2], v0[3]}), c = gelu_pk((f32x2){v1[0], v1[1]}), d = gelu_pk((f32x2){v1[2], v1[3]});
                        v0 = (f32x4){a.x, a.y, b.x, b.y}; v1 = (f32x4){c.x, c.y, d.x, d.y}; }
                    v0 = v0 * sc; v1 = v1 * sc; u32x4 w; w.x = cvt_pk_bf16(v0[0], v0[1]); w.y = cvt_pk_bf16(v0[2], v0[3]); w.z = cvt_pk_bf16(v1[0], v1[1]); w.w = cvt_pk_bf16(v1[2], v1[3]);
                    *(u32x4*)(rowp + bj * HALF) = w; } }
    }
};

struct EpiResF32 {
    static constexpr bool PERM = false, AFTER_DRAIN = false;
    const float* base; float* out; int ldc;
    __device__ __forceinline__ void operator()(const f32x4 (&acc)[2][2][4][2], const Unit& u, int wr, int wc, int fr, int fq) const {
        const int col0 = u.pn * BM + wc * 32 + 4 * fq;
#pragma unroll
        for (int ai = 0; ai < 2; ++ai)
#pragma unroll
            for (int m = 0; m < 4; ++m) { const size_t off = (size_t)(u.pm * BM + ai * HALF + wr * 64 + m * 16 + fr) * ldc + col0;
#pragma unroll
                for (int bj = 0; bj < 2; ++bj)
#pragma unroll
                    for (int n = 0; n < 2; ++n) { const f32x4 bs = *(const f32x4*)(base + off + bj * HALF + n * 16); *(f32x4*)(out + off + bj * HALF + n * 16) = bs + acc[ai][bj][m][n]; }
                if (m & 1) asm volatile("" ::: "memory"); }
    }
};
struct EpiResBf16 {
    static constexpr bool PERM = true, AFTER_DRAIN = false;
    const float* base; bf16_t* out; int ldc;
    __device__ __forceinline__ void operator()(const f32x4 (&acc)[2][2][4][2], const Unit& u, int wr, int wc, int fr, int fq) const {
        const int col0 = u.pn * BM + wc * 32 + 8 * fq;
#pragma unroll
        for (int ai = 0; ai < 2; ++ai)
#pragma unroll
            for (int m = 0; m < 4; ++m) { const size_t off = (size_t)(u.pm * BM + ai * HALF + wr * 64 + m * 16 + fr) * ldc + col0;
#pragma unroll
                for (int bj = 0; bj < 2; ++bj) { const f32x4 v0 = *(const f32x4*)(base + off + bj * HALF) + acc[ai][bj][m][0], v1 = *(const f32x4*)(base + off + bj * HALF + 4) + acc[ai][bj][m][1];
                    u32x4 w; w.x = cvt_pk_bf16(v0[0], v0[1]); w.y = cvt_pk_bf16(v0[2], v0[3]); w.z = cvt_pk_bf16(v1[0], v1[1]); w.w = cvt_pk_bf16(v1[2], v1[3]);
                    *(u32x4*)(out + off + bj * HALF) = w; }
                if (m & 1) asm volatile("" ::: "memory"); }
    }
};
struct EpiQKV {
    static constexpr bool PERM = true, AFTER_DRAIN = false;
    bf16_t* O; int ldc; PG8_LAS float* part; unsigned* nrm;
    __device__ __forceinline__ void operator()(const f32x4 (&acc)[2][2][4][2], const Unit& u, int wr, int wc, int fr, int fq) const {
        const int row0 = u.pm * BM + wr * 64 + fr, col0 = u.pn * BM + wc * 32 + 8 * fq;
        const bool track = u.pn < 8 || (u.pn >= 12 && u.pn < 20);
#pragma unroll
        for (int ai = 0; ai < 2; ++ai)
#pragma unroll
            for (int m = 0; m < 4; ++m) { bf16_t* rowp = O + (size_t)(row0 + ai * HALF + m * 16) * ldc + col0;
#pragma unroll
                for (int bj = 0; bj < 2; ++bj) { const f32x4 v0 = acc[ai][bj][m][0], v1 = acc[ai][bj][m][1];
                    u32x4 w; w.x = cvt_pk_bf16(v0[0], v0[1]); w.y = cvt_pk_bf16(v0[2], v0[3]); w.z = cvt_pk_bf16(v1[0], v1[1]); w.w = cvt_pk_bf16(v1[2], v1[3]);
                    *(u32x4*)(rowp + bj * HALF) = w;
                    if (track) { float ss = ((v0[0] * v0[0] + v0[1] * v0[1]) + (v0[2] * v0[2] + v0[3] * v0[3])) + ((v1[0] * v1[0] + v1[1] * v1[1]) + (v1[2] * v1[2] + v1[3] * v1[3]));
                        ss += __shfl_xor(ss, 16); ss += __shfl_xor(ss, 32);
                        if (fq == 0) part[(wc * 2 + bj) * 256 + ai * HALF + wr * 64 + m * 16 + fr] = ss; } } }
        if (track) {
            asm volatile("s_waitcnt lgkmcnt(0)" ::: "memory"); __builtin_amdgcn_s_barrier(); asm volatile("" ::: "memory");
            const int tid = threadIdx.x, row = tid & 255, bj = tid >> 8;
            float v = (part[(0 * 2 + bj) * 256 + row] + part[(1 * 2 + bj) * 256 + row]) + (part[(2 * 2 + bj) * 256 + row] + part[(3 * 2 + bj) * 256 + row]);
#pragma unroll
            for (int o = 1; o < 64; o <<= 1) v = fmaxf(v, __shfl_xor(v, o));
            const int slice = (u.pn < 8 ? 2 * u.pn : 16 + 2 * (u.pn - 12)) + bj;
            if ((tid & 63) == 0) atomicMax(nrm + (u.pm >> 5) * 32 + slice, __float_as_uint(v));
            asm volatile("s_waitcnt lgkmcnt(0)" ::: "memory");
        }
    }
};
struct EpiSwiglu {
    static constexpr bool PERM = true, AFTER_DRAIN = false;
    bf16_t* H;
    __device__ __forceinline__ void operator()(const f32x4 (&acc)[2][2][4][2], const Unit& u, int wr, int wc, int fr, int fq) const {
        const int col0 = (u.pn & 7) * HALF + wc * 32 + 8 * fq;
#pragma unroll
        for (int ai = 0; ai < 2; ++ai)
#pragma unroll
            for (int m = 0; m < 4; ++m) { bf16_t* rowp = H + (size_t)(u.pm * BM + ai * HALF + wr * 64 + m * 16 + fr) * 1024 + col0;
                float hv[8];
#pragma unroll
                for (int n = 0; n < 2; ++n)
#pragma unroll
                    for (int c = 0; c < 4; ++c) { const float g = acc[ai][0][m][n][c], uu = acc[ai][1][m][n][c];
                        hv[n * 4 + c] = g * __builtin_amdgcn_rcpf(1.f + __builtin_amdgcn_exp2f(-1.4426950408889634f * g)) * uu; }
                u32x4 w; w.x = cvt_pk_bf16(hv[0], hv[1]); w.y = cvt_pk_bf16(hv[2], hv[3]); w.z = cvt_pk_bf16(hv[4], hv[5]); w.w = cvt_pk_bf16(hv[6], hv[7]);
                *(u32x4*)rowp = w; }
    }
};
struct EpiDown {
    static constexpr bool PERM = true, AFTER_DRAIN = false;
    bf16_t* Y;
    __device__ __forceinline__ void operator()(const f32x4 (&acc)[2][2][4][2], const Unit& u, int wr, int wc, int fr, int fq) const {
        const int col0 = (u.pn & 7) * BM + wc * 32 + 8 * fq;
#pragma unroll
        for (int ai = 0; ai < 2; ++ai)
#pragma unroll
            for (int m = 0; m < 4; ++m) { const int row = u.pm * BM + ai * HALF + wr * 64 + m * 16 + fr; bf16_t* rowp = Y + (size_t)row * 2048 + col0;
#pragma unroll
                for (int bj = 0; bj < 2; ++bj) { const f32x4 v0 = acc[ai][bj][m][0], v1 = acc[ai][bj][m][1];
                    u32x4 w; w.x = cvt_pk_bf16(v0[0], v0[1]); w.y = cvt_pk_bf16(v0[2], v0[3]); w.z = cvt_pk_bf16(v1[0], v1[1]); w.w = cvt_pk_bf16(v1[2], v1[3]);
                    *(u32x4*)(rowp + bj * HALF) = w; } }
    }
};
struct GroupedOrder {
    int total, G, c; const PG8_LAS int* tile_e;
    __device__ __forceinline__ bool next(int i, Unit& u) const {
        const int L = i * G + c; if (L >= total) return false;
        u.pm = L >> 3; u.pn = __builtin_amdgcn_readfirstlane(tile_e[L >> 3]) * 8 + (L & 7); return true;
    }
    __device__ __forceinline__ void a_ready(const Unit&) const {}
    __device__ __forceinline__ void done(const Unit&) const {}
};

template <class Epi, class Sched, bool ALIGN_EPI = false, bool SP2 = false>
__device__ __forceinline__ void gemm_phase(PG8_LAS unsigned char* lds, const Gemm g, const Sched& S, const Epi& E) {
    const int tid = threadIdx.x, wid = __builtin_amdgcn_readfirstlane(tid >> 6), lane = tid & 63, wr = wid >> 2, wc = wid & 3, fr = lane & 15, fq = lane >> 4;
    const int K = g.K, nt = K / BK;
    unsigned voffA[2], voffB[2];
#pragma unroll
    for (int i = 0; i < 2; ++i) { int R, C; stage_rc(tid * 16 + i * 8192, R, C); const int Rb = Epi::PERM ? ((R & ~31) + perm32(R & 31)) : R;
        voffA[i] = (unsigned)(R * K + C) * 2u; voffB[i] = (unsigned)(Rb * K + C) * 2u; }
    const size_t kstep = (size_t)(BK * 2);
    const size_t hstep = (size_t)HALF * K * 2;
    const size_t tstep = 2 * hstep;
    const unsigned ldsw = (unsigned)wid * 1024u;
    const int aoff = lds_byte(wr * 64 + fr, fq * 8), boff = lds_byte(wc * 32 + fr, fq * 8);
#define PG8_SA(b, h) (((b) * 2 + (h)) * HTB)
#define PG8_SB(b, h) ((4 + (b) * 2 + (h)) * HTB)
#define PG8_STAGE(bufoff, gbase, voff) do { _Pragma("unroll") for (int _i = 0; _i < 2; ++_i) \
        __builtin_amdgcn_global_load_lds((const unsigned*)((const char*)(gbase) + (voff)[_i]), (PG8_LAS unsigned*)(lds + (bufoff) + ldsw + _i * 8192), 16, 0, 0); } while (0)
#define PG8_LDA(dst, b, h) do { _Pragma("unroll") for (int m = 0; m < 4; ++m) _Pragma("unroll") for (int k = 0; k < 2; ++k) dst[m][k] = *(const PG8_LAS bf16x8*)(lds + PG8_SA(b, h) + aoff + m * 2048 + k * 1024); } while (0)
#define PG8_LDB(dst, b, h) do { _Pragma("unroll") for (int n = 0; n < 2; ++n) _Pragma("unroll") for (int k = 0; k < 2; ++k) dst[n][k] = *(const PG8_LAS bf16x8*)(lds + PG8_SB(b, h) + boff + n * 2048 + k * 1024); } while (0)
#define PG8_MMA(ai, bj, At, Bt) do { __builtin_amdgcn_s_setprio(1); _Pragma("unroll") for (int m = 0; m < 4; ++m) _Pragma("unroll") for (int n = 0; n < 2; ++n) _Pragma("unroll") for (int k = 0; k < 2; ++k) \
        acc[ai][bj][m][n] = __builtin_amdgcn_mfma_f32_16x16x32_bf16(Bt[n][k], At[m][k], acc[ai][bj][m][n], 0, 0, 0); __builtin_amdgcn_s_setprio(0); } while (0)
#define PG8_WAIT_V(n) asm volatile("s_waitcnt vmcnt(" #n ")" ::: "memory")
#define PG8_WAIT_L(n) asm volatile("s_waitcnt lgkmcnt(" #n ")" ::: "memory")
#define PG8_BAR __builtin_amdgcn_s_barrier()
#define PG8_SCHED __builtin_amdgcn_sched_barrier(0)
    Unit cur, nxt; int ui = 0;
    if (!S.next(0, cur)) return;
    f32x4 acc[2][2][4][2];
#pragma unroll
    for (int a = 0; a < 2; ++a)
#pragma unroll
        for (int b = 0; b < 2; ++b)
#pragma unroll
            for (int m = 0; m < 4; ++m)
#pragma unroll
                for (int n = 0; n < 2; ++n) acc[a][b][m][n] = (f32x4){0.f, 0.f, 0.f, 0.f};
    bf16x8 At[4][2], B0[2][2], B1[2][2];
    const char* cA = (const char*)g.A + (size_t)cur.pm * tstep; const char* cB = (const char*)g.Bt + (size_t)cur.pn * tstep;
    S.a_ready(cur);
    if constexpr (SP2) {
        PG8_STAGE(PG8_SB(0, 0), cB, voffB); PG8_STAGE(PG8_SB(0, 1), cB + hstep, voffB); PG8_STAGE(PG8_SA(0, 0), cA, voffA); PG8_STAGE(PG8_SA(0, 1), cA + hstep, voffA);
        if (wr == 1) PG8_BAR;
        PG8_WAIT_V(2); PG8_BAR;
        PG8_STAGE(PG8_SB(1, 0), cB + kstep, voffB); PG8_STAGE(PG8_SA(1, 0), cA + kstep, voffA); PG8_STAGE(PG8_SB(1, 1), cB + hstep + kstep, voffB);
        PG8_WAIT_V(6); PG8_BAR;
    } else {
        PG8_STAGE(PG8_SB(0, 0), cB, voffB); PG8_STAGE(PG8_SA(0, 0), cA, voffA); PG8_STAGE(PG8_SB(0, 1), cB + hstep, voffB); PG8_STAGE(PG8_SA(0, 1), cA + hstep, voffA);
        if (wr == 1) PG8_BAR;
        PG8_WAIT_V(4); PG8_BAR;
        PG8_STAGE(PG8_SB(1, 0), cB + kstep, voffB); PG8_STAGE(PG8_SA(1, 0), cA + kstep, voffA); PG8_STAGE(PG8_SB(1, 1), cB + hstep + kstep, voffB);
        PG8_WAIT_V(6); PG8_BAR;
    }
    for (;;) {
        const bool has_next = S.next(ui + 1, nxt);
        const char* nA = has_next ? (const char*)g.A + (size_t)nxt.pm * tstep : cA; const char* nB = has_next ? (const char*)g.Bt + (size_t)nxt.pn * tstep : cB;
        for (int t = 0; t < nt; t += 2) {
            const bool last = (t == nt - 2);
            const char* a1 = cA + (size_t)(t + 1) * kstep;
            const char* a2 = last ? nA : cA + (size_t)(t + 2) * kstep; const char* b2 = last ? nB : cB + (size_t)(t + 2) * kstep;
            const char* a3 = a2 + kstep; const char* b3 = b2 + kstep;
            if (last && has_next) S.a_ready(nxt);
            if constexpr (SP2) {
            PG8_LDB(B0, 0, 0); PG8_LDB(B1, 0, 1); PG8_SCHED; PG8_LDA(At, 0, 0); PG8_STAGE(PG8_SA(1, 1), a1 + hstep, voffA);
            PG8_WAIT_V(8); PG8_WAIT_L(0); PG8_BAR; PG8_MMA(0, 0, At, B0); PG8_MMA(0, 1, At, B1); PG8_BAR; PG8_SCHED;
            PG8_LDA(At, 0, 1); PG8_STAGE(PG8_SB(0, 0), b2, voffB); PG8_STAGE(PG8_SB(0, 1), b2 + hstep, voffB); PG8_STAGE(PG8_SA(0, 0), a2, voffA);
            PG8_WAIT_V(8); PG8_WAIT_L(0); PG8_BAR; PG8_MMA(1, 0, At, B0); PG8_MMA(1, 1, At, B1); PG8_BAR; PG8_SCHED;
            PG8_LDB(B0, 1, 0); PG8_LDB(B1, 1, 1); PG8_SCHED; PG8_LDA(At, 1, 0); PG8_STAGE(PG8_SA(0, 1), a2 + hstep, voffA);
            PG8_WAIT_V(8); PG8_WAIT_L(0); PG8_BAR; PG8_MMA(0, 0, At, B0); PG8_MMA(0, 1, At, B1); PG8_BAR; PG8_SCHED;
            PG8_LDA(At, 1, 1); PG8_STAGE(PG8_SB(1, 0), b3, voffB); PG8_STAGE(PG8_SB(1, 1), b3 + hstep, voffB); PG8_STAGE(PG8_SA(1, 0), a3, voffA);
            PG8_WAIT_V(8); PG8_WAIT_L(0); PG8_BAR; PG8_MMA(1, 0, At, B0); PG8_MMA(1, 1, At, B1); PG8_BAR; PG8_SCHED;
            } else {
            PG8_LDB(B0, 0, 0); PG8_SCHED; PG8_LDA(At, 0, 0); PG8_STAGE(PG8_SA(1, 1), a1 + hstep, voffA);
            PG8_WAIT_L(8); PG8_BAR; PG8_WAIT_L(0); PG8_MMA(0, 0, At, B0); PG8_BAR; PG8_SCHED;
            PG8_LDB(B1, 0, 1); PG8_STAGE(PG8_SB(0, 0), b2, voffB);
            PG8_BAR; PG8_WAIT_L(0); PG8_MMA(0, 1, At, B1); PG8_BAR;
            PG8_LDA(At, 0, 1); PG8_STAGE(PG8_SA(0, 0), a2, voffA);
            PG8_BAR; PG8_WAIT_L(0); PG8_MMA(1, 0, At, B0); PG8_BAR; PG8_SCHED;
            PG8_STAGE(PG8_SB(0, 1), b2 + hstep, voffB);
            PG8_WAIT_V(6); PG8_BAR; PG8_MMA(1, 1, At, B1); PG8_BAR;
            PG8_LDB(B0, 1, 0); PG8_SCHED; PG8_LDA(At, 1, 0); PG8_STAGE(PG8_SA(0, 1), a2 + hstep, voffA);
            PG8_WAIT_L(8); PG8_BAR; PG8_WAIT_L(0); PG8_MMA(0, 0, At, B0); PG8_BAR; PG8_SCHED;
            PG8_LDB(B1, 1, 1); PG8_STAGE(PG8_SB(1, 0), b3, voffB);
            PG8_BAR; PG8_WAIT_L(0); PG8_MMA(0, 1, At, B1); PG8_BAR;
            PG8_LDA(At, 1, 1); PG8_STAGE(PG8_SA(1, 0), a3, voffA);
            PG8_BAR; PG8_WAIT_L(0); PG8_MMA(1, 0, At, B0); PG8_BAR; PG8_SCHED;
            PG8_STAGE(PG8_SB(1, 1), b3 + hstep, voffB);
            PG8_WAIT_V(6); PG8_BAR; PG8_MMA(1, 1, At, B1); PG8_BAR;
            }
        }
        if constexpr (ALIGN_EPI) { if (wr == 0) PG8_BAR; }
        if constexpr (!Epi::AFTER_DRAIN) { E(acc, cur, wr, wc, fr, fq); S.done(cur); }
        if (!has_next) break;
#pragma unroll
        for (int a = 0; a < 2; ++a)
#pragma unroll
            for (int b = 0; b < 2; ++b)
#pragma unroll
                for (int m = 0; m < 4; ++m)
#pragma unroll
                    for (int n = 0; n < 2; ++n) acc[a][b][m][n] = (f32x4){0.f, 0.f, 0.f, 0.f};
        cur = nxt; cA = nA; cB = nB; ++ui;
        if constexpr (ALIGN_EPI) { if (wr == 1) PG8_BAR; }
    }
    PG8_WAIT_V(0);
    if constexpr (!ALIGN_EPI) { if (wr == 0) PG8_BAR; }
    PG8_BAR;
    if constexpr (Epi::AFTER_DRAIN) { E.fused(acc, cur, wr, wc, fr, fq, lds, wid, lane); S.done(cur); }
#undef PG8_SA
#undef PG8_SB
#undef PG8_STAGE
#undef PG8_LDA
#undef PG8_LDB
#undef PG8_MMA
#undef PG8_WAIT_V
#undef PG8_WAIT_L
#undef PG8_BAR
#undef PG8_SCHED
}

struct UnitW { int pm, cn; const float* w0; const float* w1; };
struct GemmW { const bf16_t* A; int K, ldw; const int* rowtok; int tokmask; const PG8_LAS int* rowbase; };
__device__ __forceinline__ void wload1(f32x4& r0, unsigned voff, const char* sbase) { asm volatile("global_load_dwordx4 %0, %1, %2" : "=&v"(r0) : "v"(voff), "s"(sbase) : "memory"); }
template <class Epi, class Sched, bool ALIGN_EPI, bool GATHER>
__device__ __forceinline__ void gemm_phase_wf32(PG8_LAS unsigned char* lds, const GemmW g, const Sched& S, const Epi& E) {
    static_assert(Epi::PERM && !Epi::AFTER_DRAIN, "gemm_phase_wf32: PERM epilogues that run inside the unit loop only");
    const int tid = threadIdx.x, wid = __builtin_amdgcn_readfirstlane(tid >> 6), lane = tid & 63, wr = wid >> 2, wc = wid & 3, fr = lane & 15, fq = lane >> 4;
    const int K = g.K, nt = K / BK;
    const size_t kstep = (size_t)(BK * 2), hstep = (size_t)HALF * K * 2, tstep = 2 * hstep;
    const unsigned ldsw = (unsigned)wid * 1024u;
    const int aoff = lds_byte(wr * 64 + fr, fq * 8), boff = lds_byte(wc * 32 + fr, fq * 8);
    const int cq = lane & 7, sj = lane >> 3;
    #if defined(PROBE_HOT) && (PROBE_HOT == 2 || PROBE_HOT == 4)
    const size_t wrow = (size_t)g.ldw * 4u, wkt = S.hot ? 0 : wrow * BK;
#else
    const size_t wrow = (size_t)g.ldw * 4u, wkt = wrow * BK;
#endif
#if defined(PROBE_HOT) && PROBE_HOT == 5
    const int cqg = S.hot ? (lane & 7) : cq, sjg = S.hot ? (lane >> 3) : sj;
    const size_t wsrc = (size_t)(8 * sjg) * wrow + (size_t)(32 * (wid & 3) + 4 * cqg) * 4u;
#else
    const size_t wsrc = (size_t)(8 * sj) * wrow + (size_t)(32 * (wid & 3) + 4 * cq) * 4u;
#endif
    const int wrho = 16 * (cq & 1) + 4 * (cq >> 1);
    const int wdst = (4 + (wid >> 2)) * HTB + lds_byte(32 * (wid & 3) + wrho, 8 * sj);
#define PG8_SA(b, h) (((b) * 2 + (h)) * HTB)
#define PG8_SB(b, h) ((4 + (b) * 2 + (h)) * HTB)
#define PG8_STAGE(bufoff, gbase, voff) do { _Pragma("unroll") for (int _i = 0; _i < 2; ++_i) \
        __builtin_amdgcn_global_load_lds((const unsigned*)((const char*)(gbase) + (voff)[_i]), (PG8_LAS unsigned*)(lds + (bufoff) + ldsw + _i * 8192), 16, 0, 0); } while (0)
#define PG8_STAGEA(bufoff, h, kb, nx) do { const char* b_ = ((nx) ? nAb : cAb) + (kb); unsigned v_[2]; v_[0] = (nx) ? voN[h][0] : voC[h][0]; v_[1] = (nx) ? voN[h][1] : voC[h][1]; PG8_STAGE(bufoff, b_, v_); } while (0)
#define PG8_LDA(dst, b, h) do { _Pragma("unroll") for (int m = 0; m < 4; ++m) _Pragma("unroll") for (int k = 0; k < 2; ++k) dst[m][k] = *(const PG8_LAS bf16x8*)(lds + PG8_SA(b, h) + aoff + m * 2048 + k * 1024); } while (0)
#define PG8_LDB(dst, b, h) do { _Pragma("unroll") for (int n = 0; n < 2; ++n) _Pragma("unroll") for (int k = 0; k < 2; ++k) dst[n][k] = *(const PG8_LAS bf16x8*)(lds + PG8_SB(b, h) + boff + n * 2048 + k * 1024); } while (0)
#define PG8_MMA(ai, bj, At, Bt) do { __builtin_amdgcn_s_setprio(1); _Pragma("unroll") for (int m = 0; m < 4; ++m) _Pragma("unroll") for (int n = 0; n < 2; ++n) _Pragma("unroll") for (int k = 0; k < 2; ++k) \
        acc[ai][bj][m][n] = __builtin_amdgcn_mfma_f32_16x16x32_bf16(Bt[n][k], At[m][k], acc[ai][bj][m][n], 0, 0, 0); __builtin_amdgcn_s_setprio(0); } while (0)
#define PG8_WAIT_V(n) asm volatile("s_waitcnt vmcnt(" #n ")" ::: "memory")
#define PG8_WAIT_L(n) asm volatile("s_waitcnt lgkmcnt(" #n ")" ::: "memory")
#define PG8_BAR __builtin_amdgcn_s_barrier()
#define PG8_SCHED __builtin_amdgcn_sched_barrier(0)
#define PG8_WLOAD(kk) do { const int kk_ = (kk); const bool in_ = kk_ < nt; const char* q_ = (in_ ? cW : nW) + (size_t)(in_ ? kk_ : kk_ - nt) * wkt; \
        _Pragma("unroll") for (int r_ = 0; r_ < 8; ++r_) wload1(RB[r_], (unsigned)wsrc, q_ + (size_t)r_ * wrow); } while (0)
#define PG8_WWAIT(n) asm volatile("s_waitcnt vmcnt(" #n ")" : "+v"(RB[0]), "+v"(RB[1]), "+v"(RB[2]), "+v"(RB[3]), "+v"(RB[4]), "+v"(RB[5]), "+v"(RB[6]), "+v"(RB[7]) :: "memory")
#define PG8_WWRITE(b) do { _Pragma("unroll") for (int i_ = 0; i_ < 4; ++i_) { u32x4 w_; \
        w_.x = cvt_pk_bf16(RB[0][i_], RB[1][i_]); w_.y = cvt_pk_bf16(RB[2][i_], RB[3][i_]); w_.z = cvt_pk_bf16(RB[4][i_], RB[5][i_]); w_.w = cvt_pk_bf16(RB[6][i_], RB[7][i_]); \
        *(PG8_LAS u32x4*)(lds + (b) * 2 * HTB + wdst + i_ * 64) = w_; } } while (0)
#ifdef PROBE_ABL
    const int abl = S.hot ? PROBE_ABL : 0;
#define PG8_ABL(bit, stmt) do { if (!(abl & (bit))) { stmt; } } while (0)
#else
#define PG8_ABL(bit, stmt) do { stmt; } while (0)
#endif
    UnitW cur, nxt; int ui = 0;
    if (!S.next(0, cur)) return;
    f32x4 acc[2][2][4][2];
#pragma unroll
    for (int a = 0; a < 2; ++a)
#pragma unroll
        for (int b = 0; b < 2; ++b)
#pragma unroll
            for (int m = 0; m < 4; ++m)
#pragma unroll
                for (int n = 0; n < 2; ++n) acc[a][b][m][n] = (f32x4){0.f, 0.f, 0.f, 0.f};
    bf16x8 At[4][2], B0[2][2], B1[2][2]; f32x4 RB[8];
    const bool whalf = wid >= 4;
    const char* cAb; const char* nAb; unsigned voC[2][2], voN[2][2];
#define PG8_UNIT_A(base, vo, pm_) do { int t_ = tid; asm volatile("" : "+v"(t_)); int R_[2], C_[2]; stage_rc(t_ * 16, R_[0], C_[0]); stage_rc(t_ * 16 + 8192, R_[1], C_[1]); \
        if constexpr (GATHER) { base = (const char*)g.A; const int rb_ = __builtin_amdgcn_readfirstlane(g.rowbase[pm_]); _Pragma("unroll") for (int h_ = 0; h_ < 2; ++h_) _Pragma("unroll") for (int i_ = 0; i_ < 2; ++i_) \
            vo[h_][i_] = (unsigned)(g.rowtok[rb_ + (pm_) * BM + h_ * HALF + R_[i_]] & g.tokmask) * (unsigned)(K * 2) + (unsigned)C_[i_] * 2u; } \
        else { base = (const char*)g.A + (size_t)(pm_) * tstep; _Pragma("unroll") for (int h_ = 0; h_ < 2; ++h_) _Pragma("unroll") for (int i_ = 0; i_ < 2; ++i_) vo[h_][i_] = (unsigned)(h_ * HALF + R_[i_]) * (unsigned)(K * 2) + (unsigned)C_[i_] * 2u; } } while (0)
    PG8_UNIT_A(cAb, voC, cur.pm); nAb = cAb;
#pragma unroll
    for (int h_ = 0; h_ < 2; ++h_) { voN[h_][0] = voC[h_][0]; voN[h_][1] = voC[h_][1]; }
    const char* cW = (const char*)(whalf ? cur.w1 : cur.w0);
    const char* nW = cW;
    PG8_WLOAD(0); PG8_STAGEA(PG8_SA(0, 0), 0, 0, false); PG8_STAGEA(PG8_SA(0, 1), 1, 0, false);
    PG8_WWAIT(4); PG8_WWRITE(0);
    PG8_WLOAD(1);
    PG8_WWAIT(0); PG8_WWRITE(1);
    PG8_STAGEA(PG8_SA(1, 0), 0, kstep, false);
    PG8_WLOAD(2);
    PG8_WAIT_L(0);
    if (wr == 1) PG8_BAR;
    PG8_BAR; PG8_BAR;
    for (;;) {
        const bool has_next = S.next(ui + 1, nxt);
        if (has_next) PG8_UNIT_A(nAb, voN, nxt.pm);
        nW = has_next ? (const char*)(whalf ? nxt.w1 : nxt.w0) : cW;
        for (int t = 0; t < nt; t += 2) {
            const bool last = (t == nt - 2);
            const size_t k1 = (size_t)(t + 1) * kstep, k2 = last ? 0 : (size_t)(t + 2) * kstep, k3 = k2 + kstep;
            PG8_LDB(B0, 0, 0); PG8_LDB(B1, 0, 1); PG8_SCHED; PG8_LDA(At, 0, 0); PG8_STAGEA(PG8_SA(1, 1), 1, k1, false);
            PG8_WAIT_V(12); PG8_WAIT_L(0); PG8_BAR; PG8_MMA(0, 0, At, B0); PG8_MMA(0, 1, At, B1); PG8_BAR; PG8_SCHED;
            PG8_WWAIT(2); PG8_ABL(1, PG8_WWRITE(0)); PG8_LDA(At, 0, 1); PG8_STAGEA(PG8_SA(0, 0), 0, k2, last); PG8_ABL(2, PG8_WLOAD(t + 3));
            PG8_WAIT_L(0); PG8_BAR; PG8_MMA(1, 0, At, B0); PG8_MMA(1, 1, At, B1); PG8_BAR; PG8_SCHED;
            PG8_LDB(B0, 1, 0); PG8_LDB(B1, 1, 1); PG8_SCHED; PG8_LDA(At, 1, 0); PG8_STAGEA(PG8_SA(0, 1), 1, k2, last);
            PG8_WAIT_V(12); PG8_WAIT_L(0); PG8_BAR; PG8_MMA(0, 0, At, B0); PG8_MMA(0, 1, At, B1); PG8_BAR; PG8_SCHED;
            PG8_WWAIT(2); PG8_ABL(1, PG8_WWRITE(1)); PG8_LDA(At, 1, 1); PG8_STAGEA(PG8_SA(1, 0), 0, k3, last); PG8_ABL(2, PG8_WLOAD(t + 4));
            PG8_WAIT_L(0); PG8_BAR; PG8_MMA(1, 0, At, B0); PG8_MMA(1, 1, At, B1); PG8_BAR; PG8_SCHED;
        }
        if (!has_next) PG8_WWAIT(0);
        if constexpr (ALIGN_EPI) { if (wr == 0) PG8_BAR; }
        { Unit eu; eu.pm = cur.pm; eu.pn = cur.cn; E(acc, eu, wr, wc, fr, fq); }
        if (!has_next) break;
#pragma unroll
        for (int a = 0; a < 2; ++a)
#pragma unroll
            for (int b = 0; b < 2; ++b)
#pragma unroll
                for (int m = 0; m < 4; ++m)
#pragma unroll
                    for (int n = 0; n < 2; ++n) acc[a][b][m][n] = (f32x4){0.f, 0.f, 0.f, 0.f};
        cur = nxt; cAb = nAb; cW = nW; ++ui;
#pragma unroll
        for (int h_ = 0; h_ < 2; ++h_) { voC[h_][0] = voN[h_][0]; voC[h_][1] = voN[h_][1]; }
        if constexpr (ALIGN_EPI) { if (wr == 1) PG8_BAR; }
    }
    PG8_WAIT_V(0);
    if constexpr (!ALIGN_EPI) { if (wr == 0) PG8_BAR; }
    PG8_BAR;
#undef PG8_SA
#undef PG8_SB
#undef PG8_STAGE
#undef PG8_LDA
#undef PG8_STAGEA
#undef PG8_UNIT_A
#undef PG8_LDB
#undef PG8_MMA
#undef PG8_WAIT_V
#undef PG8_WAIT_L
#undef PG8_BAR
#undef PG8_SCHED
#undef PG8_WLOAD
#undef PG8_ABL
#undef PG8_WWAIT
#undef PG8_WWRITE
}
template <int MODE> struct GroupedOrderW {
    int total, G, c; const PG8_LAS int* tile_e; const float* wa; const float* wb; int hot;
    __device__ __forceinline__ bool next(int i, UnitW& u) const {
        int L = i * G + c;
        if (G == 256) {
            const int x = c & 7, j = c >> 3;
            L = (32 * i + 8 * (x >> 1) + (j & 7)) * 8 + 4 * (x & 1) + (j >> 3);
        }
        if (L >= total) return false;
        int e = __builtin_amdgcn_readfirstlane(tile_e[L >> 3]), nt = L & 7;
        u.pm = L >> 3; u.cn = nt;
#if defined(PROBE_HOT) && PROBE_HOT == 1
        if (hot) { e = 0; nt = 0; }
#endif
        if (MODE == 0) { u.w0 = wa + (size_t)e * 2048 * 1024 + 128 * nt; u.w1 = wb + (size_t)e * 2048 * 1024 + 128 * nt; }
        else { u.w0 = wa + (size_t)e * 1024 * 2048 + 256 * nt; u.w1 = u.w0 + 128; }
        return true;
    }
};
}

namespace att {
using TIN = __hip_bfloat16; using TOUT = __hip_bfloat16;
constexpr int B = 2, H = 1, HKV = 1, SQ = 8192, SKV = 8192, D = 128, QOFF = 0, WINDOW = SKV;
constexpr float THR = 8.f;
constexpr bool WSKIP = false;
constexpr int LDQ = 6144, LDO = 2048;
constexpr int W_INF = 1 << 30;
#ifdef PROF_SECT
#define PROF_T0(sect) unsigned long long pt0_##sect = 0; if (PROF_SECT == (sect) && blockIdx.x == 0) pt0_##sect = __builtin_amdgcn_s_memtime()
#define PROF_T1(sect) do { if (PROF_SECT == (sect) && blockIdx.x == 0) { const unsigned long long d_ = __builtin_amdgcn_s_memtime() - pt0_##sect; if (threadIdx.x == 0) { PROFW[0] += (unsigned)d_; } } } while (0)
#else
#define PROF_T0(sect) do {} while (0)
#define PROF_T1(sect) do {} while (0)
#endif
constexpr float SCALE = 0.08838834764831845f;
constexpr int NW = 8, QBLK = 32, KVBLK = 64, QB = NW * QBLK;
constexpr int SHM_V = KVBLK * D * 2, SHM_K = KVBLK * D * 2;
constexpr int OFF_WS = 2 * SHM_V + 2 * SHM_K, OFF_CB = OFF_WS + NW * 64 * 4, LDS_BYTES = OFF_CB + 2 * 64 * 4;
static_assert(D == 128 && SQ % QB == 0 && SKV % KVBLK == 0 && H % HKV == 0 && QOFF >= 0 && QOFF + SQ <= SKV && WINDOW >= 1, "geometry");

using bf16 = __hip_bfloat16;
typedef short bf16x8 __attribute__((ext_vector_type(8)));
typedef short s16x4 __attribute__((ext_vector_type(4)));
typedef float f32x16 __attribute__((ext_vector_type(16)));
typedef float f32x4 __attribute__((ext_vector_type(4)));
typedef unsigned u32x4 __attribute__((ext_vector_type(4)));
template <class A, class Bt> struct same_t { static constexpr bool v = false; };
template <class A> struct same_t<A, A> { static constexpr bool v = true; };

#define KSWZ(row, colB) ((row) * 256 + ((colB) ^ (((row) & 7) << 4)))
#define SBAR() __builtin_amdgcn_sched_barrier(0)
__device__ __forceinline__ int v_st(int k, int c) { const int kk = (k & ~0xC) | ((k & 4) << 1) | ((k & 8) >> 1); return ((kk >> 3) * 4 + (c >> 5)) * 512 + ((kk & 7) * 32 + (c & 31)) * 2; }
__device__ __forceinline__ int v_rd_base(int lane) { return ((lane & 3) << 3) | (((lane >> 2) & 3) << 6) | (((lane >> 4) & 1) << 5) | (((lane >> 5) & 1) << 8); }
constexpr int v_rd_off(int d0, int ks, int half) { return d0 * 512 + ks * 4096 + half * 2048; }
__device__ __forceinline__ int crow(int r, int hi) { return (r & 3) + 8 * (r >> 2) + 4 * hi; }
__device__ __forceinline__ unsigned cvtpk(float lo, float hi) {
    unsigned r; asm volatile("v_cvt_pk_bf16_f32 %0, %1, %2" : "=v"(r) : "v"(lo), "v"(hi)); return r;
}
__device__ __forceinline__ bf16x8 pack8(f32x4 a, f32x4 b) {
    u32x4 w = {cvtpk(a[0], a[1]), cvtpk(a[2], a[3]), cvtpk(b[0], b[1]), cvtpk(b[2], b[3])};
    return *reinterpret_cast<bf16x8*>(&w);
}
template <class T> __device__ __forceinline__ bf16x8 load8(const T* p) {
    if constexpr (same_t<T, float>::v) { return pack8(*(const f32x4*)p, *(const f32x4*)(p + 4)); }
    else { return *reinterpret_cast<const bf16x8*>(p); }
}
__device__ __forceinline__ void mask_tile(f32x16& p0, f32x16& p1, int dq, unsigned W) {
    const float NEG = -__builtin_inff();
#pragma unroll
    for (int r = 0; r < 16; ++r) {
        const int c = (r & 3) + 8 * (r >> 2);
        if ((unsigned)(dq - c) >= W) p0[r] = NEG;
        if ((unsigned)(dq - c - 32) >= W) p1[r] = NEG;
    }
}
__device__ __forceinline__ void partialSM(f32x16& p0, f32x16& p1, float& m_reg, float& mn, float& alpha) {
    constexpr float C2 = 1.4426950408889634f * SCALE;
    mn = m_reg; alpha = 1.f;
    const float mnL = -m_reg * C2;
    for (int r = 0; r < 16; ++r) p0[r] = fmaf(p0[r], C2, mnL); for (int r = 0; r < 16; ++r) p1[r] = fmaf(p1[r], C2, mnL);
    for (int r = 0; r < 16; ++r) p0[r] = __builtin_amdgcn_exp2f(p0[r]);
}
__device__ __forceinline__ void finishSM(f32x16& p0, f32x16& p1, float alpha, float& l_reg, bf16x8& pa0, bf16x8& pa1, bf16x8& pa2, bf16x8& pa3) {
    for (int r = 0; r < 16; ++r) p1[r] = __builtin_amdgcn_exp2f(p1[r]);
    float ps = 0; for (int r = 0; r < 16; ++r) ps += p0[r]; for (int r = 0; r < 16; ++r) ps += p1[r];
    { auto rr = __builtin_amdgcn_permlane32_swap(__float_as_uint(ps), __float_as_uint(ps), false, false);
      ps = __uint_as_float(rr[0]) + __uint_as_float(rr[1]); }
    l_reg += ps; (void)alpha;
#define PK4(P, B_, OUT) do { unsigned a0 = cvtpk(P[B_+0], P[B_+1]), a1 = cvtpk(P[B_+2], P[B_+3]);                          \
        unsigned b0 = cvtpk(P[B_+4], P[B_+5]), b1 = cvtpk(P[B_+6], P[B_+7]);                                             \
        auto r0 = __builtin_amdgcn_permlane32_swap(a0, b0, false, false); auto r1 = __builtin_amdgcn_permlane32_swap(a1, b1, false, false); \
        u32x4 w = {r0[0], r1[0], r0[1], r1[1]}; OUT = *reinterpret_cast<bf16x8*>(&w); } while (0)
    PK4(p0, 0, pa0); PK4(p0, 8, pa1); PK4(p1, 0, pa2); PK4(p1, 8, pa3);
#undef PK4
}
template <int KB, bool SK>
__device__ __forceinline__ void qkt(f32x16& p0, f32x16& p1, const char* K_lds, int r32, int hi, const bf16x8* qr, bool act, const float* cbt, float cqs) {
    if (SK && !act) { const float NEG = -__builtin_inff();
#pragma unroll
        for (int r = 0; r < 16; ++r) { p0[r] = NEG; p1[r] = NEG; } return; }
    { const f32x4* c4 = (const f32x4*)(cbt + KB * 64);
#pragma unroll
      for (int g = 0; g < 4; ++g) { const f32x4 a = c4[2 * g], b = c4[8 + 2 * g];
#pragma unroll
          for (int i = 0; i < 4; ++i) { p0[4 * g + i] = cqs - a[i]; p1[4 * g + i] = cqs - b[i]; } } }
    const char* kb[4];
#pragma unroll
    for (int dd = 0; dd < 4; ++dd) kb[dd] = K_lds + KB * SHM_K + KSWZ(r32, (dd * 16 + hi * 8) * 2);
#pragma unroll
    for (int d0 = 0; d0 < 8; ++d0) { const char* a = kb[d0 & 3] + (d0 >> 2) * 128;
        bf16x8 b0 = *reinterpret_cast<const bf16x8*>(a);
        bf16x8 b1 = *reinterpret_cast<const bf16x8*>(a + 32 * 256);
        p0 = __builtin_amdgcn_mfma_f32_32x32x16_bf16(b0, qr[d0], p0, 0, 0, 0);
        p1 = __builtin_amdgcn_mfma_f32_32x32x16_bf16(b1, qr[d0], p1, 0, 0, 0); }
}
template <int VB, bool SK>
__device__ __forceinline__ void pv_tile(f32x16* o, int vb0, bf16x8 pa0, bf16x8 pa1, bf16x8 pa2, bf16x8 pa3, bool act) {
    if (SK && !act) return;
#define TRRD(dst, off) asm volatile("ds_read_b64_tr_b16 %0, %1 offset:%2" : "=&v"(dst) : "v"(vb0), "i"(off) : "memory")
#define PV_D0(d0) do { s16x4 l0, l1, l2, l3, h0, h1, h2, h3; constexpr int b_ = VB * SHM_V + v_rd_off(d0, 0, 0);     \
        TRRD(l0, b_); TRRD(h0, b_ + 2048); TRRD(l1, b_ + 4096); TRRD(h1, b_ + 6144); TRRD(l2, b_ + 8192); TRRD(h2, b_ + 10240); TRRD(l3, b_ + 12288); TRRD(h3, b_ + 14336); \
        asm volatile("s_waitcnt lgkmcnt(0)" ::: "memory"); SBAR();                 \
        o[d0] = __builtin_amdgcn_mfma_f32_32x32x16_bf16(pa0, (bf16x8){l0[0], l0[1], l0[2], l0[3], h0[0], h0[1], h0[2], h0[3]}, o[d0], 0, 0, 0);   \
        o[d0] = __builtin_amdgcn_mfma_f32_32x32x16_bf16(pa1, (bf16x8){l1[0], l1[1], l1[2], l1[3], h1[0], h1[1], h1[2], h1[3]}, o[d0], 0, 0, 0);   \
        o[d0] = __builtin_amdgcn_mfma_f32_32x32x16_bf16(pa2, (bf16x8){l2[0], l2[1], l2[2], l2[3], h2[0], h2[1], h2[2], h2[3]}, o[d0], 0, 0, 0);   \
        o[d0] = __builtin_amdgcn_mfma_f32_32x32x16_bf16(pa3, (bf16x8){l3[0], l3[1], l3[2], l3[3], h3[0], h3[1], h3[2], h3[3]}, o[d0], 0, 0, 0); } while (0)
    PV_D0(0); PV_D0(1); PV_D0(2); PV_D0(3);
#undef PV_D0
#undef TRRD
}
template <class TIn, class TOut> struct BlockRef { const TIn* Q; const TIn* K; const TIn* V; TOut* O; const float* C; int P0, jlo; float mref; };
template <class TIn> struct Seam {
    bf16x8 qr[8];
    bf16x8 st_v0, st_v1, st_k0, st_k1; f32x4 sf0, sf1, sf2, sf3;
    float cq, st_c;
    f32x4 tq[16];
};
__device__ __forceinline__ int swa_jlo(int P0, int W) { const int lowk = P0 - W + 1; return lowk > 0 ? lowk / KVBLK : 0; }
#define ROW(p, k0, rr) ((p) + (size_t)((k0) + (rr)) * LDQ + sc)
#define VMW() asm volatile("s_waitcnt vmcnt(0)" ::: "memory")
#define VMWN(n) asm volatile("s_waitcnt vmcnt(%0)" :: "i"(n) : "memory")
#define SLOAD_H(Kp, Vp, Cp, k0) do { S.st_v0 = load8<TIn>(ROW(Vp, k0, sr)); S.st_v1 = load8<TIn>(ROW(Vp, k0, 32 + sr));              \
                         S.st_k0 = load8<TIn>(ROW(Kp, k0, sr)); S.st_k1 = load8<TIn>(ROW(Kp, k0, 32 + sr)); S.st_c = (Cp)[(k0) + (tid & 63)]; } while (0)
#define SWRITE_HK(bf) do { *(bf16x8*)(K_lds + (bf) * SHM_K + kws) = S.st_k0; *(bf16x8*)(K_lds + (bf) * SHM_K + kws + 32 * 256) = S.st_k1; \
                           if (tid < 64) cbw[(bf) * 64 + tid] = S.st_c; } while (0)
#define SWRITE_HV(bf) do { *(bf16x8*)(V_lds + (bf) * SHM_V + vst0) = S.st_v0; *(bf16x8*)(V_lds + (bf) * SHM_V + vst1) = S.st_v1; } while (0)
#define SWRITE_H(bf) do { SWRITE_HV(bf); SWRITE_HK(bf); } while (0)
#define SLOAD_F(p, k0) do { S.sf0 = *(const f32x4*)ROW(p, k0, sr); S.sf1 = *(const f32x4*)(ROW(p, k0, sr) + 4);                \
                            S.sf2 = *(const f32x4*)ROW(p, k0, 32 + sr); S.sf3 = *(const f32x4*)(ROW(p, k0, 32 + sr) + 4); } while (0)
#define SWRITE_KF(bf) do { *(bf16x8*)(K_lds + (bf) * SHM_K + kws) = pack8(S.sf0, S.sf1); *(bf16x8*)(K_lds + (bf) * SHM_K + kws + 32 * 256) = pack8(S.sf2, S.sf3); } while (0)
#define SWRITE_VF(bf) do { *(bf16x8*)(V_lds + (bf) * SHM_V + vst0) = pack8(S.sf0, S.sf1); *(bf16x8*)(V_lds + (bf) * SHM_V + vst1) = pack8(S.sf2, S.sf3); } while (0)
template <class TIn, class TOut>
__device__ __forceinline__ void causal_swa_prime(const BlockRef<TIn, TOut>& cur, int W, char* lds, Seam<TIn>& S) {
    constexpr bool F32 = same_t<TIn, float>::v;
    const int tid = threadIdx.x, wid = __builtin_amdgcn_readfirstlane(tid >> 6), lane = tid & 63, r32 = lane & 31, hi = lane >> 5;
    const int sr = tid >> 4, sc = (tid & 15) * 8, kws = KSWZ(sr, sc * 2); char* K_lds = lds + 2 * SHM_V; float* cbw = (float*)(lds + OFF_CB);
    const int kb0 = cur.jlo * KVBLK;
    for (int d0 = 0; d0 < 8; ++d0) S.qr[d0] = load8<TIn>(cur.Q + (size_t)(wid * QBLK + r32) * LDQ + d0 * 16 + hi * 8);
    S.cq = cur.C[cur.P0 + wid * QBLK + r32];
    if constexpr (F32) { SLOAD_F((const float*)cur.K, kb0); VMW(); SWRITE_KF(0); SBAR(); SLOAD_F((const float*)cur.V, kb0); }
    else { SLOAD_H(cur.K, cur.V, cur.C, kb0); VMW(); SWRITE_HK(0); }
    __syncthreads();
}
template <class TIn, class TOut>
__device__ __forceinline__ void causal_swa_block(const BlockRef<TIn, TOut>& cur, const BlockRef<TIn, TOut>& nxt, int skv, int W, char* lds, Seam<TIn>& S, unsigned* qhead, volatile __attribute__((address_space(3))) int* qw, bool qmore) {
    constexpr bool F32 = same_t<TIn, float>::v;
    const int tid = threadIdx.x, wid = __builtin_amdgcn_readfirstlane(tid >> 6), lane = tid & 63, r32 = lane & 31, hi = lane >> 5;
    int pop_ = 1 << 30; if (threadIdx.x == 0 && qmore) pop_ = (int)atomicAdd(qhead, 1u);
    const int j_lo = cur.jlo;
    int j_hi = (cur.P0 + QB - 1) / KVBLK + 1; if (j_hi > skv / KVBLK) j_hi = skv / KVBLK;
    const int NT = j_hi - j_lo;
    const int kbn = nxt.jlo * KVBLK;
    const int qlo = cur.P0 + wid * QBLK, qm = qlo + r32 - 4 * hi;
    char* V_lds = lds; char* K_lds = lds + 2 * SHM_V; float* cbw = (float*)(lds + OFF_CB); const float* cbt = cbw + 4 * hi; const float* Ch = cur.C;
    float* ws = (float*)(lds + 2 * SHM_V + 2 * SHM_K) + wid * 64; float* li_l = ws, * al_l = ws + 32;
    float m_reg = cur.mref, l_reg = 0; f32x16 o[4] = {};
    const int sr = tid >> 4, sc = (tid & 15) * 8, vst0 = v_st(sr, sc), vst1 = v_st(32 + sr, sc), kws = KSWZ(sr, sc * 2);
    const int vb0 = (int)(uintptr_t)V_lds + v_rd_base(lane);
    const TIn* Kh = cur.K; const TIn* Vh = cur.V;
#define RESC(a) do { (void)(a); (void)al_l; } while (0)
#define KBASE(t) ((j_lo + (t)) * KVBLK)
#define ACT(t) (KBASE(t) <= qlo + QBLK - 1 && KBASE(t) + KVBLK - 1 >= qlo - W + 1)
#define MASKT(P0_, P1_, t) do { const int kb_ = KBASE(t); if ((!SK || ACT(t)) && (kb_ + KVBLK - 1 > qlo || kb_ <= qlo + QBLK - 1 - W)) mask_tile(P0_, P1_, qm - kb_, (unsigned)W); } while (0)
    constexpr int NQL = F32 ? 16 : 9;
    constexpr bool SK = WSKIP && !F32;
#define SEAM_K0() do { VMWN(NQL); if constexpr (F32) { SWRITE_KF(0); SBAR(); SLOAD_F((const float*)nxt.V, kbn); } else { SWRITE_HK(0); } SBAR(); } while (0)
    f32x16 pA0, pA1, pB0, pB1; float mnA, mnB, alA, alB; bf16x8 pa0, pa1, pa2, pa3;
    if constexpr (F32) { VMW(); SWRITE_VF(0); SBAR(); } else { SWRITE_HV(0); SBAR(); }
    if (NT > 1) { if constexpr (F32) SLOAD_F((const float*)Kh, KBASE(1)); else SLOAD_H(Kh, Vh, Ch, KBASE(1)); }
    SBAR(); qkt<0, SK>(pA0, pA1, K_lds, r32, hi, S.qr, ACT(0), cbt, S.cq);
    if constexpr (F32) { if (NT > 1) { VMW(); SWRITE_KF(1); SBAR(); SLOAD_F((const float*)Vh, KBASE(1)); } }
    MASKT(pA0, pA1, 0); partialSM(pA0, pA1, m_reg, mnA, alA);
    if (NT > 1) { VMW(); if constexpr (F32) { SWRITE_VF(1); SBAR(); if (NT > 2) SLOAD_F((const float*)Kh, KBASE(2)); } else SWRITE_H(1); }
    if (tid == 0) qw[0] = pop_;
    __syncthreads();
#define HALF_STEP(PX0, PX1, mnX, alX, PY0, PY1, alY, t, KB, VB, SB) do {                                                      \
        SBAR(); qkt<KB, SK>(PX0, PX1, K_lds, r32, hi, S.qr, ACT(t), cbt, S.cq);                                  \
        finishSM(PY0, PY1, alY, l_reg, pa0, pa1, pa2, pa3); SBAR();                                                           \
        if ((t) + 1 < NT) { if constexpr (F32) { VMW(); SWRITE_KF(SB); SBAR(); SLOAD_F((const float*)Vh, KBASE((t) + 1)); }  \
                            else { SLOAD_H(Kh, Vh, Ch, KBASE((t) + 1)); } SBAR(); }                                           \
        pv_tile<VB, SK>(o, vb0, pa0, pa1, pa2, pa3, ACT((t) - 1)); MASKT(PX0, PX1, (t)); partialSM(PX0, PX1, m_reg, mnX, alX);                                        \
        __syncthreads();                                                                                                      \
        if ((t) + 1 < NT) { VMW(); if constexpr (F32) { SWRITE_VF(SB); SBAR(); if ((t) + 2 < NT) SLOAD_F((const float*)Kh, KBASE((t) + 2)); } \
                            else { SWRITE_H(SB); } }                                                                          \
        RESC(alX); __syncthreads(); } while (0)
    for (int t = 1; t + 1 < NT; t += 2) {
        HALF_STEP(pB0, pB1, mnB, alB, pA0, pA1, alA, t, 1, 0, 0);
        HALF_STEP(pA0, pA1, mnA, alA, pB0, pB1, alB, t + 1, 0, 1, 1);
    }
    int r32s = r32, his = hi; asm volatile("" : "+v"(r32s), "+v"(his));
    const bool even = (NT & 1) == 0;
    if (even) { SBAR(); qkt<1, SK>(pB0, pB1, K_lds, r32, hi, S.qr, ACT(NT - 1), cbt, S.cq); SBAR(); }
#define QROW(e) (nxt.Q + (size_t)(wid * QBLK + r32) * LDQ + ((e) >> 1) * 16 + hi * 8 + ((e) & 1) * 4)
    if constexpr (F32) { SLOAD_F((const float*)nxt.K, kbn); SBAR();
#pragma unroll
        for (int e = 0; e < 8; ++e) S.tq[e] = *(const f32x4*)QROW(e); }
    else { SLOAD_H(nxt.K, nxt.V, nxt.C, kbn); SBAR();
#pragma unroll
        for (int d0 = 0; d0 < 8; ++d0) S.qr[d0] = load8<TIn>(nxt.Q + (size_t)(wid * QBLK + r32s) * LDQ + d0 * 16 + his * 8);
        S.cq = nxt.C[nxt.P0 + wid * QBLK + r32s]; }
    SBAR();
    finishSM(pA0, pA1, alA, l_reg, pa0, pa1, pa2, pa3); SBAR();
    if constexpr (F32) {
#pragma unroll
        for (int e = 8; e < 16; ++e) S.tq[e] = *(const f32x4*)QROW(e); SBAR(); }
#undef QROW
    pv_tile<0, SK>(o, vb0, pa0, pa1, pa2, pa3, ACT(even ? NT - 2 : NT - 1));
    if (even) { MASKT(pB0, pB1, NT - 1); partialSM(pB0, pB1, m_reg, mnB, alB); __syncthreads(); RESC(alB);
        finishSM(pB0, pB1, alB, l_reg, pa0, pa1, pa2, pa3); SBAR(); pv_tile<1, SK>(o, vb0, pa0, pa1, pa2, pa3, ACT(NT - 1)); }
    SBAR(); SEAM_K0();
    if (his == 0) li_l[r32s] = l_reg; asm volatile("s_waitcnt lgkmcnt(0)" ::: "memory");
    float rli[16];
#pragma unroll
    for (int r = 0; r < 16; ++r) rli[r] = __builtin_amdgcn_rcpf(li_l[crow(r, his)]);
    TOut* Ow = cur.O + (size_t)(wid * QBLK) * LDO;
#pragma unroll
    for (int r = 0; r < 16; ++r) { const int orow = crow(r, his);
#pragma unroll
        for (int d0 = 0; d0 < 4; ++d0) { const float v = o[d0][r] * rli[r];
            if constexpr (same_t<TOut, float>::v) { Ow[(size_t)orow * LDO + d0 * 32 + r32] = v; }
            else { const float vn = __shfl_xor(v, 1);
                   if ((r32s & 1) == 0) *(unsigned*)(Ow + (size_t)orow * LDO + d0 * 32 + r32s) = cvtpk(v, vn); } } }
    if constexpr (F32) {
#pragma unroll
        for (int d0 = 0; d0 < 8; ++d0) S.qr[d0] = pack8(S.tq[2 * d0], S.tq[2 * d0 + 1]); }
    __syncthreads();
#undef RESC
#undef KBASE
#undef ACT
#undef MASKT
#undef SEAM_K0
#undef HALF_STEP
}
#undef ROW
#undef VMW
#undef VMWN
#undef SLOAD_H
#undef SWRITE_HK
#undef SWRITE_HV
#undef SWRITE_H
#undef SLOAD_F
#undef SWRITE_KF
#undef SWRITE_VF


constexpr int QB2 = 128, NQB2 = SQ / QB2, SHM_V2 = 2 * SHM_V;
constexpr int P_OFF_K = 2 * SHM_V2, P_OFF_X = P_OFF_K + 2 * SHM_K, PAIR_RING = P_OFF_X + 2 * NW * 2048;
constexpr int P_OFF_L = PAIR_RING + 2048, P_OFF_CB = P_OFF_L + NW * 64 * 4, PAIR_LDS = P_OFF_CB + 2 * 64 * 4;
struct PRef { const bf16* Q; const bf16* K; const bf16* V; bf16* O; const float* C; int P0, jlo; float mref; };
template <int BUF, int NV>
__device__ __forceinline__ void pair_pv(f32x16* o, int vb0, bf16x8 pa0, bf16x8 pa1, bf16x8 pa2, bf16x8 pa3) {
#define TRRD(dst, off) asm volatile("ds_read_b64_tr_b16 %0, %1 offset:%2" : "=&v"(dst) : "v"(vb0), "i"(off) : "memory")
#define PV_D0(d0) do { s16x4 l0, l1, l2, l3, h0, h1, h2, h3; constexpr int b_ = BUF * SHM_V2 + v_rd_off(d0, 0, 0); \
        TRRD(l0, b_); TRRD(h0, b_ + 2048); TRRD(l1, b_ + 4096); TRRD(h1, b_ + 6144); TRRD(l2, b_ + 8192); TRRD(h2, b_ + 10240); TRRD(l3, b_ + 12288); TRRD(h3, b_ + 14336); \
        asm volatile("s_waitcnt lgkmcnt(0)" ::: "memory"); SBAR(); \
        o[d0] = __builtin_amdgcn_mfma_f32_32x32x16_bf16(pa0, (bf16x8){l0[0], l0[1], l0[2], l0[3], h0[0], h0[1], h0[2], h0[3]}, o[d0], 0, 0, 0); \
        o[d0] = __builtin_amdgcn_mfma_f32_32x32x16_bf16(pa1, (bf16x8){l1[0], l1[1], l1[2], l1[3], h1[0], h1[1], h1[2], h1[3]}, o[d0], 0, 0, 0); \
        o[d0] = __builtin_amdgcn_mfma_f32_32x32x16_bf16(pa2, (bf16x8){l2[0], l2[1], l2[2], l2[3], h2[0], h2[1], h2[2], h2[3]}, o[d0], 0, 0, 0); \
        o[d0] = __builtin_amdgcn_mfma_f32_32x32x16_bf16(pa3, (bf16x8){l3[0], l3[1], l3[2], l3[3], h3[0], h3[1], h3[2], h3[3]}, o[d0], 0, 0, 0); } while (0)
    PV_D0(0); PV_D0(1); if constexpr (NV == 4) { PV_D0(2); PV_D0(3); }
#undef PV_D0
#undef TRRD
}
struct PStage { bf16x8 k0, k1, v0, v1, v2, v3; float c; };
template <int NV>
__device__ __forceinline__ void pair_block(const PRef& B, char* lds, volatile __attribute__((address_space(3))) unsigned* PROFW) {
    PROF_T0(2);
    PROF_T0(8);
    const int tid = threadIdx.x, wid = __builtin_amdgcn_readfirstlane(tid >> 6), lane = tid & 63, r32 = lane & 31, hi = lane >> 5, pr = wid & 3, kh = wid >> 2;
    char* V_lds = lds; char* K_lds = lds + P_OFF_K; char* X_lds = lds + P_OFF_X; float* L_lds = (float*)(lds + P_OFF_L); float* cbw = (float*)(lds + P_OFF_CB);
    const int j_lo = B.jlo, NT = (B.P0 >> 6) + 2 - j_lo;
    const int sr = tid >> 4, sc = (tid & 15) * 8, vst0 = v_st(sr, sc), vst1 = v_st(32 + sr, sc), kws = KSWZ(sr, sc * 2);
    const int vb0 = (int)(uintptr_t)V_lds + kh * (NV == 4 ? SHM_V : 1024) + v_rd_base(lane);
    int ka[4];
#pragma unroll
    for (int dd = 0; dd < 4; ++dd) ka[dd] = (int)(uintptr_t)K_lds + kh * (32 * 256) + KSWZ(r32, (dd * 16 + hi * 8) * 2);
    constexpr float C2 = 1.4426950408889634f * SCALE;
    const float mnL = -B.mref * C2;
    const int qrow = B.P0 + pr * 32 + r32;
    bf16x8 qr[8];
#pragma unroll
    for (int d0 = 0; d0 < 8; ++d0) qr[d0] = load8<bf16>(B.Q + (size_t)(pr * 32 + r32) * LDQ + d0 * 16 + hi * 8);
    const float cq = B.C[qrow];
    f32x16 o[NV] = {}; float l_reg = 0.f;
    PStage stA, stB;
#define TCL(t) ((t) < NT ? (t) : NT - 1)
#define PLOADK(st, t) do { const int k0_ = (j_lo + TCL(t)) * KVBLK; const bf16* kp_ = B.K + (size_t)(k0_ + sr) * LDQ + sc; st.k0 = load8<bf16>(kp_); st.k1 = load8<bf16>(kp_ + (size_t)32 * LDQ); st.c = B.C[k0_ + (tid & 63)]; } while (0)
#define PLOADV(st, t) do { const int k0_ = (j_lo + TCL(t)) * KVBLK; const bf16* vp_ = B.V + (size_t)(k0_ + sr) * LDQ + sc; st.v0 = load8<bf16>(vp_); st.v1 = load8<bf16>(vp_ + (size_t)32 * LDQ); \
        if constexpr (NV == 4) { st.v2 = load8<bf16>(vp_ + 128); st.v3 = load8<bf16>(vp_ + (size_t)32 * LDQ + 128); } } while (0)
#define PWRITEK(st, bf) do { *(bf16x8*)(K_lds + (bf) * SHM_K + kws) = st.k0; *(bf16x8*)(K_lds + (bf) * SHM_K + kws + 32 * 256) = st.k1; if (tid < 64) cbw[(bf) * 64 + tid] = st.c; } while (0)
#define PWRITEV(st, bf) do { *(bf16x8*)(V_lds + (bf) * SHM_V2 + vst0) = st.v0; *(bf16x8*)(V_lds + (bf) * SHM_V2 + vst1) = st.v1; \
        if constexpr (NV == 4) { *(bf16x8*)(V_lds + (bf) * SHM_V2 + SHM_V + vst0) = st.v2; *(bf16x8*)(V_lds + (bf) * SHM_V2 + SHM_V + vst1) = st.v3; } } while (0)
#define KRD_(dst, d0, KB) asm volatile("ds_read_b128 %0, %1 offset:%2" : "=&v"(dst) : "v"(ka[(d0) & 3]), "i"((KB) * SHM_K + ((d0) >> 2) * 128) : "memory")
#define KWT_(n, r) asm volatile("s_waitcnt lgkmcnt(" #n ")" : "+v"(r) :: "memory")
#define ASTAGE(t, KB, XB) do { \
        f32x16 p; { const f32x4* c4 = (const f32x4*)(cbw + (KB) * 64 + 32 * kh + 4 * hi); \
            _Pragma("unroll") for (int g = 0; g < 4; ++g) { const f32x4 a = c4[2 * g]; _Pragma("unroll") for (int i = 0; i < 4; ++i) p[4 * g + i] = cq - a[i]; } } \
        { bf16x8 kf0, kf1, kf2, kf3;     \
          KRD_(kf0, 0, KB); KRD_(kf1, 1, KB); KRD_(kf2, 2, KB); KRD_(kf3, 3, KB); \
          KWT_(3, kf0); p = __builtin_amdgcn_mfma_f32_32x32x16_bf16(kf0, qr[0], p, 0, 0, 0); KRD_(kf0, 4, KB); \
          KWT_(3, kf1); p = __builtin_amdgcn_mfma_f32_32x32x16_bf16(kf1, qr[1], p, 0, 0, 0); KRD_(kf1, 5, KB); \
          KWT_(3, kf2); p = __builtin_amdgcn_mfma_f32_32x32x16_bf16(kf2, qr[2], p, 0, 0, 0); KRD_(kf2, 6, KB); \
          KWT_(3, kf3); p = __builtin_amdgcn_mfma_f32_32x32x16_bf16(kf3, qr[3], p, 0, 0, 0); KRD_(kf3, 7, KB); \
          KWT_(3, kf0); p = __builtin_amdgcn_mfma_f32_32x32x16_bf16(kf0, qr[4], p, 0, 0, 0); \
          KWT_(2, kf1); p = __builtin_amdgcn_mfma_f32_32x32x16_bf16(kf1, qr[5], p, 0, 0, 0); \
          KWT_(1, kf2); p = __builtin_amdgcn_mfma_f32_32x32x16_bf16(kf2, qr[6], p, 0, 0, 0); \
          KWT_(0, kf3); p = __builtin_amdgcn_mfma_f32_32x32x16_bf16(kf3, qr[7], p, 0, 0, 0); } \
        { const int kb = (j_lo + (t)) * KVBLK + 32 * kh; if (kb + 31 > B.P0 + pr * 32) { const int dq = qrow - kb - 4 * hi; const float NEG = -__builtin_inff(); \
            _Pragma("unroll") for (int r = 0; r < 16; ++r) { const int c = (r & 3) + 8 * (r >> 2); if (dq - c < 0) p[r] = NEG; } } } \
        _Pragma("unroll") for (int r = 0; r < 16; ++r) p[r] = __builtin_amdgcn_exp2f(fmaf(p[r], C2, mnL)); \
        { float ps = 0.f; _Pragma("unroll") for (int r = 0; r < 16; ++r) ps += p[r]; \
          auto rr = __builtin_amdgcn_permlane32_swap(__float_as_uint(ps), __float_as_uint(ps), false, false); l_reg += __uint_as_float(rr[0]) + __uint_as_float(rr[1]); } \
        { unsigned a0 = cvtpk(p[0], p[1]), a1 = cvtpk(p[2], p[3]), b0 = cvtpk(p[4], p[5]), b1 = cvtpk(p[6], p[7]); \
          auto r0 = __builtin_amdgcn_permlane32_swap(a0, b0, false, false); auto r1 = __builtin_amdgcn_permlane32_swap(a1, b1, false, false); u32x4 w = {r0[0], r1[0], r0[1], r1[1]}; \
          *(u32x4*)(X_lds + (XB) * (NW * 2048) + wid * 2048 + lane * 16) = w; } \
        { unsigned a0 = cvtpk(p[8], p[9]), a1 = cvtpk(p[10], p[11]), b0 = cvtpk(p[12], p[13]), b1 = cvtpk(p[14], p[15]); \
          auto r0 = __builtin_amdgcn_permlane32_swap(a0, b0, false, false); auto r1 = __builtin_amdgcn_permlane32_swap(a1, b1, false, false); u32x4 w = {r0[0], r1[0], r0[1], r1[1]}; \
          *(u32x4*)(X_lds + (XB) * (NW * 2048) + wid * 2048 + 1024 + lane * 16) = w; } } while (0)
#define BSTAGE(VB, XB) do { const char* xo_ = X_lds + (XB) * (NW * 2048) + wid * 2048 + lane * 16; const char* xp_ = X_lds + (XB) * (NW * 2048) + (wid ^ 4) * 2048 + lane * 16; \
        const bf16x8 own0 = *(const bf16x8*)xo_, own1 = *(const bf16x8*)(xo_ + 1024), oth0 = *(const bf16x8*)xp_, oth1 = *(const bf16x8*)(xp_ + 1024); \
        pair_pv<VB, NV>(o, vb0, kh ? oth0 : own0, kh ? oth1 : own1, kh ? own0 : oth0, kh ? own1 : oth1); } while (0)
    PLOADK(stA, 0); PLOADV(stA, 0); PLOADK(stB, 1); PLOADV(stB, 1);
    __syncthreads();
    PWRITEK(stA, 0); PWRITEV(stA, 0);
    PLOADK(stA, 2);
    __syncthreads();
    PROF_T1(8);
    PROF_T0(9);
    ASTAGE(0, 0, 0);
    PWRITEK(stB, 1);
    PLOADV(stA, 2); PLOADK(stB, 3);
    __syncthreads();
#define PITER(t, P, SV, SK) do {     \
        BSTAGE(P, P); \
        if ((t) + 1 < NT) { ASTAGE((t) + 1, (P) ^ 1, (P) ^ 1); PWRITEV(SV, (P) ^ 1); PWRITEK(SK, P); PLOADV(SV, (t) + 3); PLOADK(SK, (t) + 4); } \
        __syncthreads(); } while (0)
    PROF_T1(9);
    PROF_T1(2);
    { PROF_T0(3);
    int t = 0;
    for (; t + 1 < NT; t += 2) { PITER(t, 0, stB, stA); PITER(t + 1, 1, stA, stB); }
    if (t < NT) PITER(t, 0, stB, stA);
    PROF_T1(3); }
    { PROF_T0(4);
    { PROF_T0(6);
    if (hi == 0) L_lds[wid * 64 + r32] = l_reg;
    __syncthreads();
    PROF_T1(6); }
    PROF_T0(7);
    if (hi == 0) L_lds[wid * 64 + 32 + r32] = l_reg + L_lds[(wid ^ 4) * 64 + r32];
    asm volatile("s_waitcnt lgkmcnt(0)" ::: "memory");
    float rli[16];
#pragma unroll
    for (int r = 0; r < 16; ++r) rli[r] = __builtin_amdgcn_rcpf(L_lds[wid * 64 + 32 + crow(r, hi)]);
    constexpr int OROW = NV * 64 + 16;
    char* ot = lds + wid * (32 * (4 * 64 + 16));
    const bool odd = (r32 & 1) != 0;
#pragma unroll
    for (int r = 0; r < 16; ++r) { const int orow = crow(r, hi);
#pragma unroll
        for (int d0 = 0; d0 < NV; d0 += 2) { const float va = o[d0][r] * rli[r], vb = o[d0 + 1][r] * rli[r];
            const float snd = odd ? va : vb;
            const float rcv = __uint_as_float((unsigned)__builtin_amdgcn_update_dpp(0, (int)__float_as_uint(snd), 0xB1, 0xF, 0xF, true));
            const unsigned pk = cvtpk(odd ? rcv : va, odd ? vb : rcv);
            *(unsigned*)(ot + orow * OROW + ((odd ? d0 + 1 : d0) * 32 + (r32 & ~1)) * 2) = pk; } }
    asm volatile("s_waitcnt lgkmcnt(0)" ::: "memory");
    PROF_T0(10);
    bf16* Ow = B.O + (size_t)(pr * 32) * LDO + kh * (NV * 32);
    constexpr int CPR = NV * 4;
#pragma unroll
    for (int i = 0; i < (32 * CPR) / 64; ++i) { const int idx = i * 64 + lane, row = idx / CPR, ch = idx % CPR;
        const u32x4 w = *(const u32x4*)(ot + row * OROW + ch * 16);
        *(u32x4*)(Ow + (size_t)row * LDO + ch * 8) = w; }
    PROF_T1(10);
    PROF_T1(7);
    PROF_T1(4); }
#undef TCL
#undef PLOADK
#undef PLOADV
#undef PWRITEK
#undef PWRITEV
#undef KRD_
#undef KWT_
#undef ASTAGE
#undef BSTAGE
#undef PITER
}

constexpr float SKIP_T = 20.f;
constexpr int NDIFF = 16 * NQB2, NFOX = 16 * NQB2;
struct Tensors { const bf16* QKV; bf16* A2; bf16* DT; const float* BIAS; const unsigned* NRM; };
__host__ __device__ constexpr int est_diff(int h, int qb2) { const int full = 2 * (qb2 + 1), cap = h == 0 ? 12 : (h == 1 ? 24 : (h == 2 ? 62 : 128)); return full < cap ? full : cap; }
__host__ __device__ constexpr int est_fox(int qb2) { const int full = 2 * (qb2 + 1); return full < 20 ? full : 20; }
struct OrderTab2 { unsigned short v[NDIFF]; };
template <bool FOX> __host__ __device__ constexpr OrderTab2 make_order2() {
    OrderTab2 t{}; int start[130] = {};
    for (int pp = 0; pp < 16; ++pp) for (int qb = 0; qb < NQB2; ++qb) start[128 - (FOX ? est_fox(qb) : est_diff((pp >> 1) & 3, qb)) + 1]++;
    for (int i = 1; i < 130; ++i) start[i] += start[i - 1];
    for (int pp = 0; pp < 16; ++pp) for (int qb = NQB2 - 1; qb >= 0; --qb) { const int b = 128 - (FOX ? est_fox(qb) : est_diff((pp >> 1) & 3, qb)); t.v[start[b]++] = (unsigned short)(pp * 64 + qb); }
    return t;
}
__device__ const OrderTab2 ORDER_D = make_order2<false>();
__device__ const OrderTab2 ORDER_F = make_order2<true>();
constexpr int ORD_OFF = PAIR_LDS, NRMW_OFF = ORD_OFF + NDIFF * 2;
template <bool FOX>
__device__ __forceinline__ PRef make_pref(const Tensors& T, const char* lds, int o, int lane) {
    const int code = __builtin_amdgcn_readfirstlane((int)((const unsigned short*)(lds + ORD_OFF))[o]), pp = code >> 6, qb = code & 63, b = pp >> 3;
    PRef r; int sq, sk;
    const bf16* base = T.QKV + (size_t)b * S * LDQ; r.P0 = qb * QB2;
    if (FOX) { const int h = pp & 7; r.Q = base + (size_t)qb * QB2 * LDQ + C_FQ + h * 128; r.K = base + C_FK + h * 128; r.V = base + C_FV + h * 128; sq = h; sk = 8 + h;
        r.O = T.A2 + ((size_t)b * S + (size_t)qb * QB2) * LDO + h * 128; r.C = T.BIAS + (size_t)(b * 8 + h) * S; }
    else { const int h = (pp >> 1) & 3, mp = pp & 1; r.Q = base + (size_t)qb * QB2 * LDQ + C_DQ + h * 256 + mp * 128; r.K = base + C_DK + h * 256 + mp * 128; r.V = base + C_DV + h * 256; sq = 16 + 2 * h + mp; sk = 24 + 2 * h + mp;
        r.O = T.DT + ((size_t)b * S + (size_t)qb * QB2) * LDO + h * 512 + mp * 256; r.C = T.BIAS + (size_t)(16 + h) * S; }
    const int jd = r.P0 >> 6;
    int ln = lane; asm volatile("" : "+v"(ln));
    const int j0 = ln < jd ? ln : jd, j1 = ln + 64 < jd ? ln + 64 : jd;
    const float cp = r.C[r.P0], c0 = r.C[64 * j0 + 63], c1 = r.C[64 * j1 + 63];
    const float nq = ((const float*)(lds + NRMW_OFF))[b * 32 + sq], nk = ((const float*)(lds + NRMW_OFF))[b * 32 + sk];
    const float qk = 1.015f * sqrtf(nq * nk);
    const float th = (SKIP_T + 2.f * qk * SCALE) * (1.0f / SCALE), lim = cp + th; r.mref = qk;
    const bool k0 = (ln >= jd) | (c0 <= lim), k1 = (ln + 64 >= jd) | (c1 <= lim);
    const unsigned long long b0 = __ballot(k0), b1 = __ballot(k1);
    r.jlo = b0 ? (int)__builtin_ctzll(b0) : 64 + (int)__builtin_ctzll(b1);
    return r;
}
template <bool FOX>
__device__ __forceinline__ void attn_part(char* lds, const Tensors& T, unsigned* head, volatile __attribute__((address_space(3))) int* qw) {
    volatile __attribute__((address_space(3))) unsigned* PROFW = (volatile __attribute__((address_space(3))) unsigned*)(qw + 8);
    PROF_T0(5);
    const int tid = threadIdx.x, lane = tid & 63;
    if (tid == 0) qw[0] = (int)atomicAdd(head, 1u);
    ((unsigned*)(lds + ORD_OFF))[tid] = ((const unsigned*)(FOX ? ORDER_F.v : ORDER_D.v))[tid];
    if (tid < 64) ((unsigned*)(lds + NRMW_OFF))[tid] = T.NRM[tid];
    __syncthreads();
    int k = __builtin_amdgcn_readfirstlane(qw[0]);
    while (k < NDIFF) {
        int kn = 0; if (tid == 0) kn = (int)atomicAdd(head, 1u);
        PROF_T0(1);
        const PRef B = make_pref<FOX>(T, lds, k, lane);
        PROF_T1(1);
        pair_block<FOX ? 2 : 4>(B, lds, PROFW);
        if (tid == 0) qw[1] = kn;
        __syncthreads();
        k = __builtin_amdgcn_readfirstlane(qw[1]);
    }
    __syncthreads();
    PROF_T1(5);
}
#undef KSWZ
#undef SBAR
}

#define GAS __attribute__((address_space(1)))
#define LAS __attribute__((address_space(3)))
typedef unsigned short bf16;
typedef unsigned v4u __attribute__((ext_vector_type(4)));
typedef float f32x4 __attribute__((ext_vector_type(4)));
typedef short bf16x8 __attribute__((ext_vector_type(8)));
typedef GAS unsigned gu32;
typedef GAS unsigned long long gu64;
#define RLX_AGENT __ATOMIC_RELAXED, __HIP_MEMORY_SCOPE_AGENT
#define LDS_WAIT() asm volatile("s_waitcnt lgkmcnt(0)" ::: "memory")
#define VM_WAIT() asm volatile("s_waitcnt vmcnt(0)" ::: "memory")
__device__ __forceinline__ unsigned long long rt() { return __builtin_amdgcn_s_memrealtime(); }
__device__ __forceinline__ unsigned f2bf(float f) { unsigned u = __builtin_bit_cast(unsigned, f); return (u + 0x7fffu + ((u >> 16) & 1u)) >> 16; }
__device__ __forceinline__ unsigned pk2(float lo, float hi) { return f2bf(lo) | (f2bf(hi) << 16); }

#define XB_TMO      128
#define XB_XCNT(j)  (256  + 64 * (j))
#define XB_XSUB(j)  (1280 + 64 * (j))
#define XB_XGEN(j)  (2304 + 64 * (j))
#define XB_TOP      3328
#define XB_TOPGEN   3392
#define XCD_BAR_WORDS 3456
#define XB_SPIN_CAP (1u << 18)

__device__ __forceinline__ unsigned xb_ld(unsigned* p)              { return __hip_atomic_load(p, __ATOMIC_RELAXED, __HIP_MEMORY_SCOPE_AGENT); }
__device__ __forceinline__ unsigned xb_add(unsigned* p, unsigned v) { return __hip_atomic_fetch_add(p, v, __ATOMIC_RELAXED, __HIP_MEMORY_SCOPE_AGENT); }
__device__ __forceinline__ unsigned xb_xcc_id() { return (unsigned)__builtin_amdgcn_s_getreg((3 << 11) | 20) & 0xFu; }
#define XB_SPIN(cond, bar) do { unsigned _sp = 0; while (cond) { __builtin_amdgcn_s_sleep(1); \
    if ((++_sp & 255u) == 0u) { if (xb_ld(&(bar)[XB_TMO])) break; if (_sp > XB_SPIN_CAP) { atomicAdd(&(bar)[XB_TMO], 1u); break; } } } } while (0)

struct XcdBarrier {
    unsigned* bar; unsigned x;
    volatile LAS unsigned* st;
};

__device__ __forceinline__ XcdBarrier xcd_barrier_post(unsigned* bar, volatile LAS unsigned* st) {
    XcdBarrier b; b.bar = bar; b.x = xb_xcc_id(); b.st = st;
    if (threadIdx.x == 0) (void)xb_add(&bar[XB_XCNT(b.x)], 1u);
    return b;
}
__device__ __forceinline__ void xcd_barrier_complete(unsigned* bar, unsigned x, unsigned& nloc, unsigned& nx) {
    const unsigned G = gridDim.x * gridDim.y * gridDim.z;
    unsigned sum, cnt, mine, sp = 0u;
    for (;;) {
        sum = 0u; cnt = 0u; mine = 0u;
#pragma unroll
        for (unsigned j = 0; j < 16; ++j) { const unsigned c = xb_ld(&bar[XB_XCNT(j)]); sum += c; cnt += (c > 0u) ? 1u : 0u; mine = (j == x) ? c : mine; }
        if (sum == G) break;
        __builtin_amdgcn_s_sleep(1);
        if ((++sp & 255u) == 0u) { if (xb_ld(&bar[XB_TMO])) break; if (sp > XB_SPIN_CAP) { atomicAdd(&bar[XB_TMO], 1u); break; } }
    }
    nloc = mine > 0u ? mine : 1u; nx = cnt > 0u ? cnt : 1u;
}

__device__ __forceinline__ void xcd_barrier(const XcdBarrier& b) {
    asm volatile("s_waitcnt vmcnt(0)" ::: "memory");
    __syncthreads();
    if (threadIdx.x == 0) {
        unsigned* bar = b.bar;
        __builtin_amdgcn_s_waitcnt(0);
        unsigned nloc = b.st[0], nx = b.st[1];
        if (nloc == 0u) { xcd_barrier_complete(bar, b.x, nloc, nx); b.st[0] = nloc; b.st[1] = nx; }
        const unsigned old = xb_add(&bar[XB_XSUB(b.x)], 1u);
        const unsigned gen = old / nloc;
        if (old + 1u == (gen + 1u) * nloc) {
            __builtin_amdgcn_fence(__ATOMIC_RELEASE, "agent");
            asm volatile("s_waitcnt vmcnt(0)" ::: "memory");
            const unsigned og = xb_add(&bar[XB_TOP], 1u);
            const unsigned tg = og / nx;
            if (og + 1u == (tg + 1u) * nx) xb_add(&bar[XB_TOPGEN], 1u);
            else XB_SPIN(xb_ld(&bar[XB_TOPGEN]) == tg, bar);
            __builtin_amdgcn_fence(__ATOMIC_ACQUIRE, "agent");
            xb_add(&bar[XB_XGEN(b.x)], 1u);
            asm volatile("s_waitcnt vmcnt(0)" ::: "memory");
        } else {
            XB_SPIN(xb_ld(&bar[XB_XGEN(b.x)]) == gen, bar);
            __builtin_amdgcn_fence(__ATOMIC_ACQUIRE, "agent");
            asm volatile("s_waitcnt vmcnt(0)" ::: "memory");
        }
    }
    __syncthreads();
}

constexpr int NWAVES = 8;
constexpr int RING_OFF = 0, RING_BYTES = 131072;
constexpr int LDSCTL_OFF = RING_BYTES, MISC_OFF = LDSCTL_OFF + 320;
constexpr int SEG_OFF = LDSCTL_OFF + 1024;
constexpr int TILE_E_OFF = LDSCTL_OFF + 2048;
constexpr int TILE_RB_OFF = TILE_E_OFF + 1024;
constexpr int ECAP = M;
constexpr int NRMP_OFF = LDSCTL_OFF + 4096;
constexpr int LDS_BYTES = 147456;
constexpr int ATT_QW_OFF = LDSCTL_OFF + 512;
static_assert(att::PAIR_RING == RING_BYTES && att::PAIR_LDS <= LDS_BYTES && att::P_OFF_L >= ATT_QW_OFF + 64 && att::LDS_BYTES <= RING_BYTES && TILE_E_OFF + NTILE_MAX * 4 <= LDS_BYTES, "LDS map");

struct Args { const float* in[19]; float* out; unsigned char* ws; int ph_lo, ph_hi, li, pad; };

struct Ctx {
    LAS unsigned char* lds; int tid, lane, wave, G, gw, NGW;
    const float *x, *attn_g, *w_in, *fbias, *lq1, *lk1, *lq2, *lk2, *subg, *w_out, *ffn_g, *wg, *bg, *we, *be, *wgate, *wup, *wdown, *fin_g;
    float* out;
    bf16* A1; bf16* WIN; bf16* WOUT; float* BIAS; bf16* QKV; bf16* A2; bf16* DT; bf16* H1;
    int* tok_e; int* tok_pos; float* tok_gate; float* rstd; float* rowgate; int* rowtok; int* etok; float* egate; float* WR; bf16* XG; bf16* HB; bf16* Y; bf16* WGU; bf16* WD; unsigned* cnt; unsigned* nrm;
};
__device__ __forceinline__ float wave_sum(float v) {
#pragma unroll
    for (int o = 1; o < 64; o <<= 1) v += __shfl_xor(v, o);
    return v;
}
typedef unsigned v2u __attribute__((ext_vector_type(2)));

__device__ __forceinline__ void p0_row2(const Ctx& C, int t0, int t1, const LAS float* wf) {
    const int lane = C.lane; const float* xr0 = C.x + (size_t)t0 * DM; const float* xr1 = C.x + (size_t)t1 * DM;
    f32x4 v0[8], v1[8]; float ss0 = 0.f, ss1 = 0.f;
#pragma unroll
    for (int j = 0; j < 8; ++j) { v0[j] = *(const f32x4*)(xr0 + j * 256 + lane * 4); v1[j] = *(const f32x4*)(xr1 + j * 256 + lane * 4); }
#pragma unroll
    for (int j = 0; j < 8; ++j) { ss0 += (v0[j].x * v0[j].x + v0[j].y * v0[j].y) + (v0[j].z * v0[j].z + v0[j].w * v0[j].w); ss1 += (v1[j].x * v1[j].x + v1[j].y * v1[j].y) + (v1[j].z * v1[j].z + v1[j].w * v1[j].w); }
    const float r0 = 1.f / sqrtf(wave_sum(ss0) * (1.f / DM) + 1e-6f), r1 = 1.f / sqrtf(wave_sum(ss1) * (1.f / DM) + 1e-6f);
    float fl0[8] = {0.f, 0.f, 0.f, 0.f, 0.f, 0.f, 0.f, 0.f}, fl1[8] = {0.f, 0.f, 0.f, 0.f, 0.f, 0.f, 0.f, 0.f};
#pragma unroll
    for (int j = 0; j < 8; ++j) {
        const f32x4 gg = *(const f32x4*)(C.attn_g + j * 256 + lane * 4);
        v0[j] = v0[j] * r0 * gg; v1[j] = v1[j] * r1 * gg;
        v2u o; o.x = pk2(v0[j].x, v0[j].y); o.y = pk2(v0[j].z, v0[j].w);
        *(v2u*)(C.A1 + (size_t)t0 * DM + j * 256 + lane * 4) = o;
        o.x = pk2(v1[j].x, v1[j].y); o.y = pk2(v1[j].z, v1[j].w);
        *(v2u*)(C.A1 + (size_t)t1 * DM + j * 256 + lane * 4) = o;
#pragma unroll
        for (int h = 0; h < 8; ++h) { const f32x4 w4 = *(const LAS f32x4*)(wf + h * DM + j * 256 + lane * 4);
            fl0[h] += (v0[j].x * w4.x + v0[j].y * w4.y) + (v0[j].z * w4.z + v0[j].w * w4.w); fl1[h] += (v1[j].x * w4.x + v1[j].y * w4.y) + (v1[j].z * w4.z + v1[j].w * w4.w); }
        asm volatile("" ::: "memory");
    }
#pragma unroll
    for (int h = 0; h < 8; ++h) { fl0[h] = wave_sum(fl0[h]); fl1[h] = wave_sum(fl1[h]); }
    float z0 = fl0[0], z1 = fl1[0];
#pragma unroll
    for (int h = 1; h < 8; ++h) { z0 = (lane == h) ? fl0[h] : z0; z1 = (lane == h) ? fl1[h] : z1; }
    if (lane < 8) { z0 += C.fbias[lane]; z1 += C.fbias[lane];
        C.BIAS[(size_t)((t0 / S) * 8 + lane) * S + (t0 % S)] = fminf(z0, 0.f) - log1pf(expf(-fabsf(z0)));
        C.BIAS[(size_t)((t1 / S) * 8 + lane) * S + (t1 % S)] = fminf(z1, 0.f) - log1pf(expf(-fabsf(z1))); }
}
__device__ __forceinline__ void tr_item(const float* src, int ld, int k0, int c0, bf16* dst, int K, int r0, LAS float* scr, int lane) {
    { f32x4 v[8];
#pragma unroll
      for (int i = 0; i < 8; ++i) v[i] = *(const f32x4*)(src + (size_t)(k0 + 8 * i + (lane >> 3)) * ld + c0 + 4 * (lane & 7));
#pragma unroll
      for (int i = 0; i < 8; ++i) { LAS float* d = scr + (8 * i + (lane >> 3)) * 33 + 4 * (lane & 7); d[0] = v[i].x; d[1] = v[i].y; d[2] = v[i].z; d[3] = v[i].w; } }
    LDS_WAIT(); asm volatile("" ::: "memory");
    const int c = lane & 7;
#pragma unroll
    for (int j = 0; j < 4; ++j) { const int n = (lane >> 3) + 8 * j; const LAS float* s = scr + (8 * c) * 33 + n;
        v4u o; o.x = pk2(s[0 * 33], s[1 * 33]); o.y = pk2(s[2 * 33], s[3 * 33]); o.z = pk2(s[4 * 33], s[5 * 33]); o.w = pk2(s[6 * 33], s[7 * 33]);
        *(GAS v4u*)(dst + (size_t)(r0 + n) * K + k0 + 8 * c) = o; }
    LDS_WAIT(); asm volatile("" ::: "memory");
}
__device__ __forceinline__ void p0_prologue(const Ctx& C) {
    LAS float* scr = (LAS float*)(C.lds + RING_OFF + C.wave * 16384);
    constexpr int I_WIN = 32 * 192, I_WOUT = 32 * 64, I_ALL = I_WIN + I_WOUT;
    for (int it = C.gw; it < I_ALL; it += C.NGW) {
        int r = it;
        if (r < I_WIN) { const int kb = r / 192, nb = r % 192; tr_item(C.w_in, NCOL, 64 * kb, nb < 96 ? 32 * nb : 32 * nb + 8, C.WIN, DM, 32 * nb, scr, C.lane); continue; } r -= I_WIN;
        { const int kb = r / 64, nb = r % 64; tr_item(C.w_out, DM, 64 * kb, 32 * nb, C.WOUT, DM, 32 * nb, scr, C.lane); }
    }
    __syncthreads();
    { LAS float* wf = (LAS float*)(C.lds + RING_OFF);
      for (int k = C.tid; k < DM; k += NWAVES * 64) { const float* wr = C.w_in + (size_t)k * NCOL + FCOL; const f32x4 w0 = *(const f32x4*)wr, w1 = *(const f32x4*)(wr + 4);
          wf[0 * DM + k] = w0.x; wf[1 * DM + k] = w0.y; wf[2 * DM + k] = w0.z; wf[3 * DM + k] = w0.w; wf[4 * DM + k] = w1.x; wf[5 * DM + k] = w1.y; wf[6 * DM + k] = w1.z; wf[7 * DM + k] = w1.w; }
      __syncthreads();
      for (int t = C.gw; t < M; t += 2 * C.NGW) { const int t1 = t + C.NGW; p0_row2(C, t, t1 < M ? t1 : t, wf); } }
    const int gt = C.gw * 64 + C.lane, NGT = C.NGW * 64;
    for (int i = gt; i < 4 * S; i += NGT) { const int h = i / S, s = i % S; C.BIAS[(size_t)(16 + h) * S + s] = -exp2f(-2.f * (float)(h + 1)) * (float)s * ATT_ISCALE; }
    for (int i = gt; i < 64 * 5 * 2 * 64; i += NGT) { const int ln = i & 63, hl = (i >> 6) & 1, b = (i >> 7) % 5, kk = (i >> 7) / 5, c = 16 * b + (ln & 15);
        unsigned w[4];
#pragma unroll
        for (int jp = 0; jp < 4; ++jp) { unsigned pk = 0;
#pragma unroll
            for (int q = 0; q < 2; ++q) { const int k = 32 * kk + 8 * (ln >> 4) + 2 * jp + q;
                const float v = (c < 8 ? C.wg[(size_t)k * 8 + c] : (c < 72 ? C.we[(size_t)k * NE + c - 8] : 0.f)) * C.ffn_g[k];
                const unsigned h = f2bf(v); const unsigned l = f2bf(v - __uint_as_float(h << 16));
                pk |= (hl ? l : h) << (16 * q); }
            w[jp] = pk; }
        ((v4u*)C.WR)[i] = (v4u){w[0], w[1], w[2], w[3]}; }
}
__device__ __forceinline__ void p1_cumsum(const Ctx& C) {
    if (blockIdx.x >= 16) return;
    float* p = C.BIAS + (size_t)blockIdx.x * S + C.tid * 16; LAS float* wt = (LAS float*)(C.lds + RING_OFF);
    float loc[16]; float s = 0.f;
    { const f32x4 a = *(const f32x4*)p, b = *(const f32x4*)(p + 4), c = *(const f32x4*)(p + 8), d = *(const f32x4*)(p + 12);
      loc[0] = a.x; loc[1] = a.y; loc[2] = a.z; loc[3] = a.w; loc[4] = b.x; loc[5] = b.y; loc[6] = b.z; loc[7] = b.w; loc[8] = c.x; loc[9] = c.y; loc[10] = c.z; loc[11] = c.w; loc[12] = d.x; loc[13] = d.y; loc[14] = d.z; loc[15] = d.w; }
#pragma unroll
    for (int i = 0; i < 16; ++i) { s += loc[i]; loc[i] = s; }
    float inc = s;
#pragma unroll
    for (int o = 1; o < 64; o <<= 1) { const float q = __shfl_up(inc, o); if (C.lane >= o) inc += q; }
    if (C.lane == 63) wt[C.wave] = inc;
    __syncthreads();
    float base = inc - s;
    for (int w = 0; w < C.wave; ++w) base += wt[w];
#pragma unroll
    for (int i = 0; i < 16; ++i) loc[i] = (base + loc[i]) * ATT_ISCALE;
    *(f32x4*)p = (f32x4){loc[0], loc[1], loc[2], loc[3]}; *(f32x4*)(p + 4) = (f32x4){loc[4], loc[5], loc[6], loc[7]};
    *(f32x4*)(p + 8) = (f32x4){loc[8], loc[9], loc[10], loc[11]}; *(f32x4*)(p + 12) = (f32x4){loc[12], loc[13], loc[14], loc[15]};
    __syncthreads();
}
__device__ __forceinline__ void p_norms(const Ctx& C) {
    const int lane = C.lane, b = C.gw & 1;
    float mx[8] = {0.f, 0.f, 0.f, 0.f, 0.f, 0.f, 0.f, 0.f};
    for (int rr = C.gw >> 1; rr < S; rr += C.NGW >> 1) {
        const bf16* row = C.QKV + (size_t)(b * S + rr) * NQKV + 8 * lane;
#pragma unroll
        for (int i = 0; i < 8; ++i) { const v4u w = *(const v4u*)(row + (i < 4 ? 512 * i : 1024 + 512 * i));
            float ss = 0.f;
#pragma unroll
            for (int c = 0; c < 4; ++c) { const float lo = __uint_as_float(w[c] << 16), hi = __uint_as_float(w[c] & 0xffff0000u); ss += lo * lo + hi * hi; }
            ss += __shfl_xor(ss, 1); ss += __shfl_xor(ss, 2); ss += __shfl_xor(ss, 4); ss += __shfl_xor(ss, 8);
            mx[i] = fmaxf(mx[i], ss); }
    }
    if ((lane & 15) == 0) {
#pragma unroll
        for (int i = 0; i < 8; ++i) atomicMax(C.nrm + b * 32 + 4 * i + (lane >> 4), __float_as_uint(mx[i]));
    }
}
__device__ __forceinline__ void p3_combine(const Ctx& C) {
    const int lane = C.lane;
    const float s1 = wave_sum(C.lq1[lane] * C.lk1[lane] + C.lq1[lane + 64] * C.lk1[lane + 64]);
    const float s2 = wave_sum(C.lq2[lane] * C.lk2[lane] + C.lq2[lane + 64] * C.lk2[lane + 64]);
    const float lam = expf(s1) - expf(s2) + 0.2f;
    const f32x4 gg = *(const f32x4*)(C.subg + lane * 4);
    for (int idx = C.gw; idx < M * 4; idx += C.NGW) {
        const int t = idx >> 2, h = idx & 3;
        const bf16* p = C.DT + (size_t)t * DM + h * 512 + lane * 4;
        const v2u a = *(const v2u*)p, b = *(const v2u*)(p + 256);
        f32x4 d;
        d.x = __uint_as_float(a.x << 16) - lam * __uint_as_float(b.x << 16); d.y = __uint_as_float(a.x & 0xffff0000u) - lam * __uint_as_float(b.x & 0xffff0000u);
        d.z = __uint_as_float(a.y << 16) - lam * __uint_as_float(b.y << 16); d.w = __uint_as_float(a.y & 0xffff0000u) - lam * __uint_as_float(b.y & 0xffff0000u);
        const float ss = wave_sum((d.x * d.x + d.y * d.y) + (d.z * d.z + d.w * d.w));
        const float r = 0.8f / sqrtf(ss * (1.f / 256.f) + 1e-5f);
        v2u o; o.x = pk2(d.x * r * gg.x, d.y * r * gg.y); o.y = pk2(d.z * r * gg.z, d.w * r * gg.w);
        *(v2u*)(C.A2 + (size_t)t * DM + 1024 + h * 256 + lane * 4) = o;
    }
}
__device__ __forceinline__ void p5a_router(const Ctx& C) {
    const int w = C.wave, th = w & 1, ks = w >> 1;
    LAS float* R1 = (LAS float*)(C.lds + RING_OFF);
    LAS float* SS = (LAS float*)(C.lds + RING_OFF + 81920);
    LAS float* RS = SS + 512;
    LAS float* lg = (LAS float*)(C.lds + RING_OFF + 86016);
    for (int tl = (int)blockIdx.x; tl < M / 64; tl += C.G) {
        int lane = C.lane; asm volatile("" : "+v"(lane));
        const int r = lane & 15, g = lane >> 4;
        const int t0 = tl * 64;
        f32x4 acc[2][5];
#pragma unroll
        for (int T = 0; T < 2; ++T)
#pragma unroll
            for (int b = 0; b < 5; ++b) acc[T][b] = (f32x4){0.f, 0.f, 0.f, 0.f};
        float ss[2] = {0.f, 0.f};
        const bf16* hb = C.H1 + (size_t)(t0 + 32 * th) * DM + 512 * ks; const unsigned ho = (unsigned)(r * DM + 8 * g);
        const v4u* wp = (const v4u*)C.WR + (size_t)(16 * ks) * 10 * 64 + lane;
        v4u a[4][2], tb[10];
#define RT_LA(slot, j_) do { _Pragma("unroll") for (int T = 0; T < 2; ++T) a[slot][T] = *(const v4u*)(hb + (ho + (unsigned)(16 * T * DM + 32 * (j_)))); } while (0)
        RT_LA(0, 0);
#pragma unroll
        for (int q = 0; q < 10; ++q) tb[q] = wp[q * 64];
        RT_LA(1, 1); RT_LA(2, 2); RT_LA(3, 3);
#pragma unroll
        for (int j = 0; j < 16; ++j) {
            __builtin_amdgcn_sched_barrier(0);
#pragma unroll
            for (int T = 0; T < 2; ++T)
#pragma unroll
                for (int c = 0; c < 4; ++c) { const unsigned x = a[j & 3][T][c]; const float lo = __uint_as_float(x << 16), hi = __uint_as_float(x & 0xffff0000u); ss[T] += lo * lo + hi * hi; }
#pragma unroll
            for (int b = 0; b < 5; ++b) {
#pragma unroll
                for (int T = 0; T < 2; ++T) acc[T][b] = __builtin_amdgcn_mfma_f32_16x16x32_bf16(__builtin_bit_cast(bf16x8, a[j & 3][T]), __builtin_bit_cast(bf16x8, tb[2 * b]), acc[T][b], 0, 0, 0);
#pragma unroll
                for (int T = 0; T < 2; ++T) acc[T][b] = __builtin_amdgcn_mfma_f32_16x16x32_bf16(__builtin_bit_cast(bf16x8, a[j & 3][T]), __builtin_bit_cast(bf16x8, tb[2 * b + 1]), acc[T][b], 0, 0, 0);
                __builtin_amdgcn_sched_barrier(0);
                if (j + 1 < 16) { tb[2 * b] = wp[((j + 1) * 10 + 2 * b) * 64]; tb[2 * b + 1] = wp[((j + 1) * 10 + 2 * b + 1) * 64]; }
                __builtin_amdgcn_sched_barrier(0);
            }
            if (j + 4 < 16) RT_LA(j & 3, j + 4);
        }
#undef RT_LA
        asm volatile("" ::: "memory");
#pragma unroll
        for (int T = 0; T < 2; ++T) { ss[T] += __int_as_float(__builtin_amdgcn_ds_bpermute((lane ^ 16) << 2, __float_as_int(ss[T]))); ss[T] += __int_as_float(__builtin_amdgcn_ds_bpermute((lane ^ 32) << 2, __float_as_int(ss[T])));
            if (lane < 16) SS[ks * 64 + 16 * (2 * th + T) + lane] = ss[T]; }
        if (ks >= 2) {
#pragma unroll
            for (int T = 0; T < 2; ++T)
#pragma unroll
                for (int b = 0; b < 5; ++b)
#pragma unroll
                    for (int i = 0; i < 4; ++i) R1[((th * 2 + (ks - 2)) * 40 + (T * 5 + b) * 4 + i) * 64 + lane] = acc[T][b][i];
        }
        __syncthreads();
        if (ks < 2) {
#pragma unroll
            for (int T = 0; T < 2; ++T)
#pragma unroll
                for (int b = 0; b < 5; ++b)
#pragma unroll
                    for (int i = 0; i < 4; ++i) { LAS float* q = R1 + ((th * 2 + ks) * 40 + (T * 5 + b) * 4 + i) * 64 + lane; *q = acc[T][b][i] + *q; }
            if (w == 0) { const float s = (SS[lane] + SS[64 + lane]) + (SS[128 + lane] + SS[192 + lane]);
                const float rs = 1.f / sqrtf(s * (1.f / DM) + 1e-6f); RS[lane] = rs; C.rstd[t0 + lane] = rs; }
        }
        __syncthreads();
#pragma unroll
        for (int m = 0; m < 10; ++m) { const int sl = w + 8 * m, T = sl / 20, b = (sl % 20) >> 2, i = sl & 3, tok = 16 * T + 4 * g + i, s2 = sl % 40, hh = sl / 40;
            const float v = R1[((hh * 2 + 0) * 40 + s2) * 64 + lane] + R1[((hh * 2 + 1) * 40 + s2) * 64 + lane];
            lg[tok * 81 + 16 * b + r] = v * RS[tok]; }
        __syncthreads();
        if (w == 0) {
            const int t = t0 + lane; const LAS float* row = lg + lane * 81;
            float gmax = -__builtin_inff(); int gi = 0; float gl[8];
#pragma unroll
            for (int j = 0; j < 8; ++j) { gl[j] = row[j] + C.bg[j]; if (gl[j] > gmax) { gmax = gl[j]; gi = j; } }
            float gs = 0.f;
#pragma unroll
            for (int j = 0; j < 8; ++j) gs += expf(gl[j] - gmax);
            const float gprob = 1.f / gs;
            float l1 = -__builtin_inff(), l2 = -__builtin_inff(); int i1 = 0, i2 = 0;
#pragma unroll
            for (int j = 0; j < 8; ++j) { const float q = row[8 + gi * 8 + j] + C.be[gi * 8 + j];
                if (q > l1) { l2 = l1; i2 = i1; l1 = q; i1 = j; } else if (q > l2) { l2 = q; i2 = j; } }
            const float e2 = expf(l2 - l1), g1 = gprob / (1.f + e2), g2 = gprob * e2 / (1.f + e2);
            const int ea = gi * 8 + i1, eb = gi * 8 + i2;
            LAS unsigned* lc = (LAS unsigned*)(C.lds + RING_OFF + 110592); LAS unsigned* gb = lc + 64;
            lc[lane] = 0u; asm volatile("" ::: "memory");
            const unsigned la = __hip_atomic_fetch_add(lc + ea, 1u, __ATOMIC_RELAXED, __HIP_MEMORY_SCOPE_WORKGROUP); asm volatile("" ::: "memory");
            const unsigned lb = __hip_atomic_fetch_add(lc + eb, 1u, __ATOMIC_RELAXED, __HIP_MEMORY_SCOPE_WORKGROUP); asm volatile("" ::: "memory");
            const unsigned ne = lc[lane]; unsigned gbase = 0u; if (ne) gbase = atomicAdd(C.cnt + lane * CNT_STRIDE, ne);
            gb[lane] = gbase; asm volatile("" ::: "memory");
            const unsigned pa = gb[ea] + la, pb = gb[eb] + lb;
            C.tok_e[t * 2] = ea; C.tok_e[t * 2 + 1] = eb; C.tok_pos[t * 2] = (int)pa; C.tok_pos[t * 2 + 1] = (int)pb; C.etok[ea * ECAP + (int)pa] = t; C.etok[eb * ECAP + (int)pb] = t; C.tok_gate[t * 2] = g1; C.tok_gate[t * 2 + 1] = g2;
        }
        { asm volatile("" ::: "memory"); f32x4 gg[4][2];
#pragma unroll
            for (int j = 0; j < 4; ++j) { gg[j][0] = *(const f32x4*)(C.ffn_g + j * 512 + lane * 8); gg[j][1] = *(const f32x4*)(C.ffn_g + j * 512 + lane * 8 + 4); }
            const int r0 = w ? 9 * (w - 1) : 63, nr = w ? 9 : 1;
#pragma unroll 3
            for (int i = 0; i < nr; ++i) { const int rr = r0 + i; const float rsr = RS[rr]; const bf16* src = C.H1 + (size_t)(t0 + rr) * DM + lane * 8; bf16* dst = C.A1 + (size_t)(t0 + rr) * DM + lane * 8;
#pragma unroll
                for (int j = 0; j < 4; ++j) { const v4u x = *(const v4u*)(src + j * 512); const f32x4 g0 = gg[j][0], g1 = gg[j][1];
                    v4u o; o.x = pk2(__uint_as_float(x.x << 16) * rsr * g0.x, __uint_as_float(x.x & 0xffff0000u) * rsr * g0.y); o.y = pk2(__uint_as_float(x.y << 16) * rsr * g0.z, __uint_as_float(x.y & 0xffff0000u) * rsr * g0.w);
                    o.z = pk2(__uint_as_float(x.z << 16) * rsr * g1.x, __uint_as_float(x.z & 0xffff0000u) * rsr * g1.y); o.w = pk2(__uint_as_float(x.w << 16) * rsr * g1.z, __uint_as_float(x.w & 0xffff0000u) * rsr * g1.w);
                    *(v4u*)(dst + j * 512) = o; } } }
        __syncthreads();
    }
}
__device__ __forceinline__ void build_seg(const Ctx& C) {
    LAS int* seg = (LAS int*)(C.lds + SEG_OFF); LAS int* tile_e = (LAS int*)(C.lds + TILE_E_OFF);
    if (C.wave == 0) { const int p = (int)((C.cnt[C.lane * CNT_STRIDE] + 255u) & ~255u); int inc = p;
#pragma unroll
        for (int o = 1; o < 64; o <<= 1) { const int q = __shfl_up(inc, o); if (C.lane >= o) inc += q; }
        seg[C.lane] = inc - p; if (C.lane == 63) seg[NE] = inc; }
    __syncthreads();
    if (C.tid < NTILE_MAX) { const int row = C.tid * 256; int e = 0; for (int j = 1; j < NE; ++j) if (seg[j] <= row) e = j; tile_e[C.tid] = e; ((LAS int*)(C.lds + TILE_RB_OFF))[C.tid] = e * ECAP - seg[e]; }
    __syncthreads();
}
__device__ __forceinline__ void p5b_dispatch(const Ctx& C) {
    const LAS int* seg = (const LAS int*)(C.lds + SEG_OFF);
    for (int t = C.gw * 64 + C.lane; t < M; t += C.NGW * 64) {
        const int ra = seg[C.tok_e[t * 2]] + C.tok_pos[t * 2], rb = seg[C.tok_e[t * 2 + 1]] + C.tok_pos[t * 2 + 1];
        C.rowgate[ra] = C.tok_gate[t * 2]; C.rowgate[rb] = C.tok_gate[t * 2 + 1]; C.rowtok[ra] = t; C.rowtok[rb] = t;
    }
}
__device__ __forceinline__ void p8_final(const Ctx& C) {
    const LAS int* seg = (const LAS int*)(C.lds + SEG_OFF); const int lane = C.lane;
    for (int t0 = C.gw * 2; t0 < M; t0 += C.NGW * 2) {
        int ra[2], rb[2]; float ga[2], gb[2];
#pragma unroll
        for (int u = 0; u < 2; ++u) { const int t = t0 + u; ra[u] = seg[C.tok_e[t * 2]] + C.tok_pos[t * 2]; rb[u] = seg[C.tok_e[t * 2 + 1]] + C.tok_pos[t * 2 + 1]; ga[u] = C.tok_gate[t * 2]; gb[u] = C.tok_gate[t * 2 + 1]; }
        f32x4 v[2][8]; float ss[2] = {0.f, 0.f};
#pragma unroll
        for (int u = 0; u < 2; ++u) { const bf16* xr = C.H1 + (size_t)(t0 + u) * DM; const bf16* ya = C.Y + (size_t)ra[u] * DM; const bf16* yb = C.Y + (size_t)rb[u] * DM;
#pragma unroll
            for (int j = 0; j < 8; ++j) { const v2u h = *(const v2u*)(xr + j * 256 + lane * 4), a = *(const v2u*)(ya + j * 256 + lane * 4), b = *(const v2u*)(yb + j * 256 + lane * 4);
                v[u][j].x = __uint_as_float(h.x << 16) + (ga[u] * __uint_as_float(a.x << 16) + gb[u] * __uint_as_float(b.x << 16)); v[u][j].y = __uint_as_float(h.x & 0xffff0000u) + (ga[u] * __uint_as_float(a.x & 0xffff0000u) + gb[u] * __uint_as_float(b.x & 0xffff0000u));
                v[u][j].z = __uint_as_float(h.y << 16) + (ga[u] * __uint_as_float(a.y << 16) + gb[u] * __uint_as_float(b.y << 16)); v[u][j].w = __uint_as_float(h.y & 0xffff0000u) + (ga[u] * __uint_as_float(a.y & 0xffff0000u) + gb[u] * __uint_as_float(b.y & 0xffff0000u));
                ss[u] += (v[u][j].x * v[u][j].x + v[u][j].y * v[u][j].y) + (v[u][j].z * v[u][j].z + v[u][j].w * v[u][j].w); } }
#pragma unroll
        for (int u = 0; u < 2; ++u) { const float r = 1.f / sqrtf(wave_sum(ss[u]) * (1.f / DM) + 1e-6f);
#pragma unroll
            for (int j = 0; j < 8; ++j) *(f32x4*)(C.out + (size_t)(t0 + u) * DM + j * 256 + lane * 4) = v[u][j] * r * *(const f32x4*)(C.fin_g + j * 256 + lane * 4); }
    }
}

__global__ void __launch_bounds__(NWAVES * 64, 2) mk_fwd(Args args) {
    extern __shared__ __attribute__((aligned(16))) unsigned char lds[];
    Ctx C;
    C.lds = (LAS unsigned char*)lds; C.tid = threadIdx.x; C.lane = C.tid & 63; C.wave = __builtin_amdgcn_readfirstlane(C.tid >> 6);
    C.G = gridDim.x; C.gw = (int)blockIdx.x * NWAVES + C.wave; C.NGW = C.G * NWAVES;
    C.x = args.in[0]; C.attn_g = args.in[1]; C.w_in = args.in[2]; C.fbias = args.in[3]; C.lq1 = args.in[4]; C.lk1 = args.in[5]; C.lq2 = args.in[6]; C.lk2 = args.in[7];
    C.subg = args.in[8]; C.w_out = args.in[9]; C.ffn_g = args.in[10]; C.wg = args.in[11]; C.bg = args.in[12]; C.we = args.in[13]; C.be = args.in[14];
    C.wgate = args.in[15]; C.wup = args.in[16]; C.wdown = args.in[17]; C.fin_g = args.in[18]; C.out = args.out;
    unsigned char* ws = args.ws;
    C.A1 = (bf16*)(ws + WS_A1); C.WIN = (bf16*)(ws + WS_WIN); C.WOUT = (bf16*)(ws + WS_WOUT); C.BIAS = (float*)(ws + WS_BIAS); C.QKV = (bf16*)(ws + WS_QKV);
    C.A2 = (bf16*)(ws + WS_A2); C.DT = (bf16*)(ws + WS_DT); C.H1 = (bf16*)(ws + WS_H1);
    C.tok_e = (int*)(ws + WS_ROUTE); C.tok_pos = C.tok_e + 2 * M; C.tok_gate = (float*)(C.tok_pos + 2 * M); C.rstd = C.tok_gate + 2 * M; C.rowgate = C.rstd + M; C.rowtok = (int*)(C.rowgate + YROWS);
    C.etok = (int*)(ws + WS_XG); C.egate = (float*)(ws + WS_XG) + (size_t)NE * ECAP;
    C.WR = (float*)(ws + WS_WR); C.XG = (bf16*)(ws + WS_XG); C.HB = (bf16*)(ws + WS_HBUF); C.Y = (bf16*)(ws + WS_Y); C.WGU = (bf16*)(ws + WS_WGU); C.WD = (bf16*)(ws + WS_WD);
    C.cnt = (unsigned*)(ws + WS_CTL) + CW_CNT; C.nrm = (unsigned*)(ws + WS_CTL) + CW_NRM;
    volatile LAS unsigned* MISC = (volatile LAS unsigned*)(C.lds + MISC_OFF);
    for (int u = C.tid; u < (LDS_BYTES - LDSCTL_OFF) / 4; u += NWAVES * 64) ((LAS unsigned*)(C.lds + LDSCTL_OFF))[u] = 0u;
    __syncthreads();
    XcdBarrier bar = xcd_barrier_post((unsigned*)(ws + WS_CTL) + CW_BAR + args.li * XCD_BAR_WORDS, MISC + 8);
    const int lo = args.ph_lo, hi = args.ph_hi;
#define IN(k) (lo <= (k) && (k) < hi)
#define SEAM(k) do { if (IN(k) && IN((k) + 1)) xcd_barrier(bar); } while (0)
#ifndef PROBE_MASK
#define PROBE_MASK 0u
#endif
#ifndef PROBE_REP
#define PROBE_REP 0
#endif
#define TWICE(k) (((PROBE_MASK) >> (k)) & 1u)
#ifdef PROBE_TS
    volatile LAS unsigned long long* TSW = (volatile LAS unsigned long long*)(C.lds + LDSCTL_OFF + 15360);
#define TS(k) do { if (blockIdx.x == 0 && C.tid == 0) TSW[k] = __builtin_amdgcn_s_memrealtime(); } while (0)
#else
#define TS(k) do { } while (0)
#endif
    TS(0);

    if (IN(0)) { p0_prologue(C); if (TWICE(0)) { xcd_barrier(bar); p0_prologue(C); } } SEAM(0); TS(1);
    if (IN(1)) {
        p1_cumsum(C);
        pg8::Gemm g{C.A1, C.WIN, M, NQKV, DM}; pg8::StaticOrder So; So.init(M, NQKV, C.G, (int)blockIdx.x);
        pg8::EpiQKV E{C.QKV, NQKV, (PG8_LAS float*)(C.lds + NRMP_OFF), C.nrm};
        pg8::gemm_phase<pg8::EpiQKV, pg8::StaticOrder, true, true>(C.lds + RING_OFF, g, So, E);
        if (TWICE(1)) { xcd_barrier(bar); pg8::gemm_phase<pg8::EpiQKV, pg8::StaticOrder, true, true>(C.lds + RING_OFF, g, So, E); }
    } SEAM(1); TS(2);
    if (IN(3)) { const att::Tensors T{(const att::bf16*)C.QKV, (att::bf16*)C.A2, (att::bf16*)C.DT, C.BIAS, C.nrm};
        unsigned* qh = (unsigned*)(ws + WS_CTL) + CW_QHEAD; volatile __attribute__((address_space(3))) int* qw = (volatile __attribute__((address_space(3))) int*)(C.lds + RING_OFF + ATT_QW_OFF);
        att::attn_part<false>((char*)lds + RING_OFF, T, qh, qw); TS(3); att::attn_part<true>((char*)lds + RING_OFF, T, qh + 64, qw); if (TWICE(3)) { xcd_barrier(bar); att::attn_part<false>((char*)lds + RING_OFF, T, qh + 128, qw); att::attn_part<true>((char*)lds + RING_OFF, T, qh + 192, qw); } } SEAM(3); TS(4);
    if (IN(4)) { p3_combine(C); if (TWICE(4)) { xcd_barrier(bar); p3_combine(C); } } SEAM(4); TS(5);
    if (IN(5)) {
        pg8::Gemm g{C.A2, C.WOUT, M, DM, DM}; pg8::StaticOrder So; So.init(M, DM, C.G, (int)blockIdx.x);
        pg8::EpiResBf16 E{C.x, C.H1, DM};
        pg8::gemm_phase<pg8::EpiResBf16, pg8::StaticOrder, true, true>(C.lds + RING_OFF, g, So, E);
        if (TWICE(5)) { xcd_barrier(bar); pg8::gemm_phase<pg8::EpiResBf16, pg8::StaticOrder, true, true>(C.lds + RING_OFF, g, So, E); }
    } SEAM(5); TS(6);
    if (IN(6)) { p5a_router(C); } SEAM(6); TS(7);
#ifdef PROBE_IDLE
    { const unsigned long long t0 = __builtin_amdgcn_s_memrealtime(); while (__builtin_amdgcn_s_memrealtime() - t0 < (unsigned long long)(PROBE_IDLE) * 100ull) __builtin_amdgcn_s_sleep(32); }
#endif
    if (hi > 7) build_seg(C);
#ifdef PROBE_CLK
    unsigned long long ck0 = 0, cr0 = 0, ckd = 0, crd = 1;
    if (IN(PROBE_CLK)) { ck0 = __builtin_amdgcn_s_memtime(); cr0 = __builtin_amdgcn_s_memrealtime(); }
#endif
    if (IN(8)) {
        const PG8_LAS int* tile_e = (const PG8_LAS int*)(C.lds + TILE_E_OFF); const int ntile = ((const LAS int*)(C.lds + SEG_OFF))[NE] >> 8;
        #if defined(PROBE_HOT) && PROBE_HOT >= 3
        pg8::GemmW g{C.A1, DM, DFF, C.etok, args.li > 0 ? 255 : M - 1, (const PG8_LAS int*)(C.lds + TILE_RB_OFF)};
#else
        pg8::GemmW g{C.A1, DM, DFF, C.etok, M - 1, (const PG8_LAS int*)(C.lds + TILE_RB_OFF)};
#endif
        pg8::GroupedOrderW<0> So{ntile * 8, C.G, (int)blockIdx.x, tile_e, C.wgate, C.wup, args.li > 0};
        pg8::EpiSwiglu E{args.li > 0 ? C.XG : C.HB};
        pg8::gemm_phase_wf32<pg8::EpiSwiglu, pg8::GroupedOrderW<0>, true, true>(C.lds + RING_OFF, g, So, E);
    } SEAM(8); TS(8);
    if (IN(9)) {
        const PG8_LAS int* tile_e = (const PG8_LAS int*)(C.lds + TILE_E_OFF); const int ntile = ((const LAS int*)(C.lds + SEG_OFF))[NE] >> 8;
        pg8::GemmW g{C.HB, DFF, DM, nullptr, 0, nullptr}; pg8::GroupedOrderW<1> So{ntile * 8, C.G, (int)blockIdx.x, tile_e, C.wdown, nullptr};
        pg8::EpiDown E{C.Y};
        pg8::gemm_phase_wf32<pg8::EpiDown, pg8::GroupedOrderW<1>, true, false>(C.lds + RING_OFF, g, So, E);
    } SEAM(9); TS(9);
#ifdef PROBE_CLK
    if (IN(PROBE_CLK)) { ckd = __builtin_amdgcn_s_memtime() - ck0; crd = __builtin_amdgcn_s_memrealtime() - cr0; }
#endif
    if (IN(10)) { p8_final(C); if (TWICE(10)) { xcd_barrier(bar); p8_final(C); } }
#ifdef PROBE_CLK
    if (blockIdx.x == 0) { const unsigned long long want = ckd * 100ull / (crd ? crd : 1);
        const unsigned long long t0 = __builtin_amdgcn_s_memrealtime(); while (__builtin_amdgcn_s_memrealtime() - t0 < want) __builtin_amdgcn_s_sleep(8); }
#endif
#ifdef PROBE_TS
    if (blockIdx.x == 0 && C.tid == 0) { const unsigned long long dA = TSW[(PROBE_TS >> 4) & 15] - TSW[(PROBE_TS >> 8) & 15], dB = TSW[PROBE_TS & 15] - TSW[(PROBE_TS >> 12) & 15];
        const unsigned long long want = ((dA + 1000ull) / 2000ull) * 100000ull + dB;
        const unsigned long long t0 = __builtin_amdgcn_s_memrealtime(); while (__builtin_amdgcn_s_memrealtime() - t0 < want) __builtin_amdgcn_s_sleep(8); }
#endif
#ifdef PROBE_NT
    if (blockIdx.x == 0) { const int ntile_ = ((const LAS int*)(C.lds + SEG_OFF))[NE] >> 8; const unsigned long long want = (unsigned long long)(ntile_ > 150 ? ntile_ - 150 : 0) * 2000ull;
        const unsigned long long t0 = __builtin_amdgcn_s_memrealtime(); while (__builtin_amdgcn_s_memrealtime() - t0 < want) __builtin_amdgcn_s_sleep(8); }
#endif
#ifdef PROF_SECT
    if (blockIdx.x == 0) { __syncthreads(); const unsigned want = ((volatile LAS unsigned*)(C.lds + ATT_QW_OFF + 32))[0]; const unsigned long long t0 = __builtin_amdgcn_s_memtime(); while (__builtin_amdgcn_s_memtime() - t0 < (unsigned long long)want) __builtin_amdgcn_s_sleep(8); }
#endif
#undef IN
#undef SEAM
#undef TWICE
}

#if NAIVE_MASK
namespace nv {
__device__ __forceinline__ float bf2f(bf16_t v) { return __uint_as_float((unsigned)v << 16); }
__device__ __forceinline__ bf16_t f2b(float f) { return (bf16_t)f2bf(f); }
__global__ void __launch_bounds__(256) k_cumsum(float* __restrict__ bias) {
    __shared__ float part[256];
    float* p = bias + (size_t)blockIdx.x * S; const int tid = threadIdx.x;
    float loc[32]; float s = 0.f;
#pragma unroll
    for (int i = 0; i < 32; ++i) { s += p[tid * 32 + i]; loc[i] = s; }
    part[tid] = s; __syncthreads();
    if (tid == 0) { float a = 0.f; for (int i = 0; i < 256; ++i) { const float q = part[i]; part[i] = a; a += q; } }
    __syncthreads();
    const float base = part[tid];
#pragma unroll
    for (int i = 0; i < 32; ++i) p[tid * 32 + i] = (base + loc[i]) * ATT_ISCALE;
}
template <class FA, class FB>
__device__ __forceinline__ void ngemm_tile(int K, FA fa, FB fb, float (&acc)[4][4], float (*As)[65], float (*Bs)[65]) {
    const int tid = threadIdx.x, tx = tid & 15, ty = tid >> 4;
#pragma unroll
    for (int r = 0; r < 4; ++r)
#pragma unroll
        for (int c = 0; c < 4; ++c) acc[r][c] = 0.f;
    for (int k0 = 0; k0 < K; k0 += 16) {
        for (int e = tid; e < 1024; e += 256) { const int i = e >> 4, kk = e & 15; As[kk][i] = fa(i, k0 + kk); Bs[kk][i] = fb(k0 + kk, i); }
        __syncthreads();
#pragma unroll
        for (int kk = 0; kk < 16; ++kk) { float a[4], b[4];
#pragma unroll
            for (int r = 0; r < 4; ++r) a[r] = As[kk][ty * 4 + r];
#pragma unroll
            for (int c = 0; c < 4; ++c) b[c] = Bs[kk][tx * 4 + c];
#pragma unroll
            for (int r = 0; r < 4; ++r)
#pragma unroll
                for (int c = 0; c < 4; ++c) acc[r][c] += a[r] * b[c]; }
        __syncthreads();
    }
}
__global__ void __launch_bounds__(256) k_inproj(const bf16_t* __restrict__ A, const bf16_t* __restrict__ Bt, bf16_t* __restrict__ Cq) {
    __shared__ float As[16][65], Bs[16][65];
    const int m0 = blockIdx.y * 64, n0 = blockIdx.x * 64; float acc[4][4];
    ngemm_tile(DM, [&](int i, int k) { return bf2f(A[(size_t)(m0 + i) * DM + k]); }, [&](int k, int j) { return bf2f(Bt[(size_t)(n0 + j) * DM + k]); }, acc, As, Bs);
    const int tx = threadIdx.x & 15, ty = threadIdx.x >> 4;
#pragma unroll
    for (int r = 0; r < 4; ++r)
#pragma unroll
        for (int c = 0; c < 4; ++c) Cq[(size_t)(m0 + ty * 4 + r) * NQKV + n0 + tx * 4 + c] = f2b(acc[r][c]);
}
__global__ void __launch_bounds__(256) k_outproj(const bf16_t* __restrict__ A, const bf16_t* __restrict__ Bt, const float* __restrict__ x, float* __restrict__ H1) {
    __shared__ float As[16][65], Bs[16][65];
    const int m0 = blockIdx.y * 64, n0 = blockIdx.x * 64; float acc[4][4];
    ngemm_tile(DM, [&](int i, int k) { return bf2f(A[(size_t)(m0 + i) * DM + k]); }, [&](int k, int j) { return bf2f(Bt[(size_t)(n0 + j) * DM + k]); }, acc, As, Bs);
    const int tx = threadIdx.x & 15, ty = threadIdx.x >> 4;
#pragma unroll
    for (int r = 0; r < 4; ++r)
#pragma unroll
        for (int c = 0; c < 4; ++c) { const size_t o = (size_t)(m0 + ty * 4 + r) * DM + n0 + tx * 4 + c; H1[o] = x[o] + acc[r][c]; }
}
__global__ void __launch_bounds__(256) k_attn(const bf16_t* __restrict__ QKV, const float* __restrict__ bias, bf16_t* __restrict__ A2, bf16_t* __restrict__ DT) {
    __shared__ bf16_t Qs[64][130];
    __shared__ float Ks[32][129];
    __shared__ float Vs[32][128];
    __shared__ float Ps[64][33];
    const int tid = threadIdx.x, r = tid >> 2, c4 = tid & 3;
    const int qb = (int)gridDim.x - 1 - (int)blockIdx.x, p = blockIdx.y;
    int b, qcol, kcol, vcol, h, map = 0, vh = 0; const float* cc; const bool fox = p < 16;
    if (fox) { b = p >> 3; h = p & 7; qcol = C_FQ + h * 128; kcol = C_FK + h * 128; vcol = C_FV + h * 128; cc = bias + ((size_t)b * 8 + h) * S; }
    else { const int q = p - 16; b = q >> 4; h = (q >> 2) & 3; map = (q >> 1) & 1; vh = q & 1; qcol = C_DQ + h * 256 + map * 128; kcol = C_DK + h * 256 + map * 128; vcol = C_DV + h * 256 + vh * 128; cc = bias + (size_t)(16 + h) * S; }
    const int q0 = qb * 64; const size_t rowb = (size_t)b * S;
    for (int e = tid; e < 64 * 128; e += 256) { const int i = e >> 7, d = e & 127; Qs[i][d] = QKV[(rowb + q0 + i) * NQKV + qcol + d]; }
    const int t = q0 + r; const float ct = cc[t];
    float m = -1e30f, l = 0.f; float o[32];
#pragma unroll
    for (int j = 0; j < 32; ++j) o[j] = 0.f;
    const int nkt = (q0 + 63) / 32 + 1;
    for (int kt = 0; kt < nkt; ++kt) {
        const int k0 = kt * 32;
        __syncthreads();
        for (int e = tid; e < 32 * 128; e += 256) { const int i = e >> 7, d = e & 127; const size_t ro = (rowb + k0 + i) * NQKV; Ks[i][d] = bf2f(QKV[ro + kcol + d]); Vs[i][d] = bf2f(QKV[ro + vcol + d]); }
        __syncthreads();
        float sc[8];
#pragma unroll
        for (int j = 0; j < 8; ++j) sc[j] = 0.f;
        for (int d = 0; d < 128; ++d) { const float qv = bf2f(Qs[r][d]);
#pragma unroll
            for (int j = 0; j < 8; ++j) sc[j] += qv * Ks[c4 * 8 + j][d]; }
        float tmax = -__builtin_inff();
#pragma unroll
        for (int j = 0; j < 8; ++j) { const int s = k0 + c4 * 8 + j; float v = (sc[j] + (ct - cc[s])) * ATT_SCALE;
            if (s > t) v = -__builtin_inff();
            sc[j] = v; tmax = fmaxf(tmax, v); }
        tmax = fmaxf(tmax, __shfl_xor(tmax, 1)); tmax = fmaxf(tmax, __shfl_xor(tmax, 2));
        const float mn = fmaxf(m, tmax), alpha = __expf(m - mn); m = mn;
        float ps = 0.f;
#pragma unroll
        for (int j = 0; j < 8; ++j) { const float pv = __expf(sc[j] - mn); ps += pv; Ps[r][c4 * 8 + j] = pv; }
        ps += __shfl_xor(ps, 1); ps += __shfl_xor(ps, 2);
        l = l * alpha + ps;
        __syncthreads();
#pragma unroll
        for (int j = 0; j < 32; ++j) o[j] *= alpha;
        for (int kk = 0; kk < 32; ++kk) { const float pv = Ps[r][kk];
#pragma unroll
            for (int j = 0; j < 32; ++j) o[j] += pv * Vs[kk][c4 + 4 * j]; }
    }
    const float il = 1.f / l;
    bf16_t* op = fox ? A2 + (rowb + t) * DM + h * 128 : DT + (rowb + t) * DM + h * 512 + map * 256 + vh * 128;
#pragma unroll
    for (int j = 0; j < 32; ++j) op[c4 + 4 * j] = f2b(o[j] * il);
}
__global__ void __launch_bounds__(256) k_diff_combine(const bf16_t* __restrict__ DT, const float* __restrict__ lq1, const float* __restrict__ lk1, const float* __restrict__ lq2,
                                                      const float* __restrict__ lk2, const float* __restrict__ sg, bf16_t* __restrict__ A2) {
    const int lane = threadIdx.x & 63, wv = threadIdx.x >> 6;
    const int idx = blockIdx.x * 4 + wv, t = idx >> 2, h = idx & 3;
    const float s1 = wave_sum(lq1[lane] * lk1[lane] + lq1[lane + 64] * lk1[lane + 64]);
    const float s2 = wave_sum(lq2[lane] * lk2[lane] + lq2[lane + 64] * lk2[lane + 64]);
    const float lam = expf(s1) - expf(s2) + 0.2f;
    const bf16_t* p = DT + (size_t)t * DM + h * 512;
    float d[4]; float ss = 0.f;
#pragma unroll
    for (int c = 0; c < 4; ++c) { d[c] = bf2f(p[lane * 4 + c]) - lam * bf2f(p[256 + lane * 4 + c]); ss += d[c] * d[c]; }
    ss = wave_sum(ss);
    const float r = rsqrtf(ss * (1.f / 256.f) + 1e-5f) * 0.8f;
    bf16_t* o = A2 + (size_t)t * DM + 1024 + h * 256 + lane * 4;
#pragma unroll
    for (int c = 0; c < 4; ++c) o[c] = f2b(d[c] * r * sg[lane * 4 + c]);
}
__global__ void __launch_bounds__(256) k_route(const float* __restrict__ H1, const float* __restrict__ g, const float* __restrict__ wg, const float* __restrict__ bg,
                                               const float* __restrict__ we, const float* __restrict__ be, int* __restrict__ tok_e, int* __restrict__ tok_pos,
                                               float* __restrict__ tok_gate, float* __restrict__ rstd, unsigned* __restrict__ cnt) {
    __shared__ float xs[4][DM];
    const int lane = threadIdx.x & 63, wv = threadIdx.x >> 6;
    const int t = blockIdx.x * 4 + wv;
    const float* xr = H1 + (size_t)t * DM;
    f32x4 v[8]; float ss = 0.f;
#pragma unroll
    for (int j = 0; j < 8; ++j) { v[j] = *(const f32x4*)(xr + j * 256 + lane * 4); ss += v[j].x * v[j].x + v[j].y * v[j].y + v[j].z * v[j].z + v[j].w * v[j].w; }
    ss = wave_sum(ss);
    const float r = 1.f / sqrtf(ss * (1.f / DM) + 1e-6f);
#pragma unroll
    for (int j = 0; j < 8; ++j) { const f32x4 gg = *(const f32x4*)(g + j * 256 + lane * 4); *(f32x4*)(&xs[wv][j * 256 + lane * 4]) = v[j] * r * gg; }
    __syncthreads();
    float el = 0.f;
    for (int k = 0; k < DM; ++k) el += xs[wv][k] * we[(size_t)k * NE + lane];
    el += be[lane];
    float gl = 0.f;
    for (int k = (lane >> 3); k < DM; k += 8) gl += xs[wv][k] * wg[(size_t)k * 8 + (lane & 7)];
    gl += __shfl_xor(gl, 8); gl += __shfl_xor(gl, 16); gl += __shfl_xor(gl, 32);
    gl += bg[lane & 7];
    float gmax = -__builtin_inff(); int gi = 0;
#pragma unroll
    for (int j = 0; j < 8; ++j) { const float q = __shfl(gl, j); if (q > gmax) { gmax = q; gi = j; } }
    float gs = 0.f;
#pragma unroll
    for (int j = 0; j < 8; ++j) gs += expf(__shfl(gl, j) - gmax);
    const float gprob = 1.f / gs;
    float l1 = -__builtin_inff(), l2 = -__builtin_inff(); int i1 = 0, i2 = 0;
#pragma unroll
    for (int j = 0; j < 8; ++j) { const float q = __shfl(el, gi * 8 + j);
        if (q > l1) { l2 = l1; i2 = i1; l1 = q; i1 = j; } else if (q > l2) { l2 = q; i2 = j; } }
    const float e2 = expf(l2 - l1), g1 = gprob / (1.f + e2), g2 = gprob * e2 / (1.f + e2);
    if (lane == 0) {
        const int ea = gi * 8 + i1, eb = gi * 8 + i2;
        const unsigned pa = atomicAdd(cnt + ea, 1u), pb = atomicAdd(cnt + eb, 1u);
        tok_e[t * 2] = ea; tok_e[t * 2 + 1] = eb; tok_pos[t * 2] = (int)pa; tok_pos[t * 2 + 1] = (int)pb; tok_gate[t * 2] = g1; tok_gate[t * 2 + 1] = g2; rstd[t] = r;
    }
}
__device__ __forceinline__ int seg_off(const unsigned* cnt, int e) { int o = 0; for (int i = 0; i < e; ++i) o += (int)((cnt[i] + 255u) & ~255u); return o; }
__global__ void __launch_bounds__(256) k_dispatch(const float* __restrict__ H1, const float* __restrict__ g, const float* __restrict__ rstd, const int* __restrict__ tok_e,
                                                  const int* __restrict__ tok_pos, const float* __restrict__ tok_gate, const unsigned* __restrict__ cnt, bf16_t* __restrict__ XG, float* __restrict__ rowgate) {
    const int lane = threadIdx.x & 63, wv = threadIdx.x >> 6; const int t = blockIdx.x * 4 + wv;
    const int ra = seg_off(cnt, tok_e[t * 2]) + tok_pos[t * 2], rb = seg_off(cnt, tok_e[t * 2 + 1]) + tok_pos[t * 2 + 1];
    const float rs = rstd[t];
    for (int k = lane; k < DM; k += 64) { const bf16_t v = f2b(H1[(size_t)t * DM + k] * rs * g[k]); XG[(size_t)ra * DM + k] = v; XG[(size_t)rb * DM + k] = v; }
    if (lane == 0) { rowgate[ra] = tok_gate[t * 2]; rowgate[rb] = tok_gate[t * 2 + 1]; }
}
__global__ void __launch_bounds__(256) k_moe_up(const bf16_t* __restrict__ XG, const bf16_t* __restrict__ WGU, const unsigned* __restrict__ cnt, bf16_t* __restrict__ HB) {
    __shared__ float As[16][65], Bs[16][65];
    const int m0 = blockIdx.y * 64, n0 = blockIdx.x * 64;
    int e = 0, tot = 0; { int o = 0; for (int i = 0; i < NE; ++i) { if (o <= m0) e = i; o += (int)((cnt[i] + 255u) & ~255u); } tot = o; }
    if (m0 >= tot) return;
    const bf16_t* W = WGU + (size_t)e * 2048 * DM; const int rg = 256 * (n0 >> 7) + (n0 & 127), ru = rg + 128;
    float ag[4][4], au[4][4];
    ngemm_tile(DM, [&](int i, int k) { return bf2f(XG[(size_t)(m0 + i) * DM + k]); }, [&](int k, int j) { return bf2f(W[(size_t)(rg + j) * DM + k]); }, ag, As, Bs);
    ngemm_tile(DM, [&](int i, int k) { return bf2f(XG[(size_t)(m0 + i) * DM + k]); }, [&](int k, int j) { return bf2f(W[(size_t)(ru + j) * DM + k]); }, au, As, Bs);
    const int tx = threadIdx.x & 15, ty = threadIdx.x >> 4;
#pragma unroll
    for (int r = 0; r < 4; ++r)
#pragma unroll
        for (int c = 0; c < 4; ++c) { const float gv = ag[r][c]; HB[(size_t)(m0 + ty * 4 + r) * DFF + n0 + tx * 4 + c] = f2b(gv / (1.f + expf(-gv)) * au[r][c]); }
}
__global__ void __launch_bounds__(256) k_moe_down(const bf16_t* __restrict__ HB, const bf16_t* __restrict__ WD, const unsigned* __restrict__ cnt, const float* __restrict__ rowgate, bf16_t* __restrict__ Y) {
    __shared__ float As[16][65], Bs[16][65];
    const int m0 = blockIdx.y * 64, n0 = blockIdx.x * 64;
    int e = 0, tot = 0; { int o = 0; for (int i = 0; i < NE; ++i) { if (o <= m0) e = i; o += (int)((cnt[i] + 255u) & ~255u); } tot = o; }
    if (m0 >= tot) return;
    const bf16_t* W = WD + (size_t)e * DM * DFF; float acc[4][4];
    ngemm_tile(DFF, [&](int i, int k) { return bf2f(HB[(size_t)(m0 + i) * DFF + k]); }, [&](int k, int j) { return bf2f(W[(size_t)(n0 + j) * DFF + k]); }, acc, As, Bs);
    const int tx = threadIdx.x & 15, ty = threadIdx.x >> 4;
#pragma unroll
    for (int r = 0; r < 4; ++r) { const int row = m0 + ty * 4 + r; const float gt = rowgate[row];
#pragma unroll
        for (int c = 0; c < 4; ++c) Y[(size_t)row * DM + n0 + tx * 4 + c] = f2b(acc[r][c] * gt); }
}
__global__ void __launch_bounds__(256) k_final(const float* __restrict__ H1, const bf16_t* __restrict__ Y, const unsigned* __restrict__ cnt, const int* __restrict__ tok_e,
                                               const int* __restrict__ tok_pos, const float* __restrict__ g, float* __restrict__ out) {
    const int lane = threadIdx.x & 63, wv = threadIdx.x >> 6; const int t = blockIdx.x * 4 + wv;
    const int ra = seg_off(cnt, tok_e[t * 2]) + tok_pos[t * 2], rb = seg_off(cnt, tok_e[t * 2 + 1]) + tok_pos[t * 2 + 1];
    float v[32]; float ss = 0.f;
#pragma unroll
    for (int i = 0; i < 32; ++i) { const int k = lane + 64 * i; v[i] = H1[(size_t)t * DM + k] + bf2f(Y[(size_t)ra * DM + k]) + bf2f(Y[(size_t)rb * DM + k]); ss += v[i] * v[i]; }
    ss = wave_sum(ss);
    const float r = 1.f / sqrtf(ss * (1.f / DM) + 1e-6f);
#pragma unroll
    for (int i = 0; i < 32; ++i) { const int k = lane + 64 * i; out[(size_t)t * DM + k] = v[i] * r * g[k]; }
}
}
static void naive_phase(int k, const Args& a, hipStream_t stream) {
    unsigned char* ws = a.ws;
    bf16_t* A1 = (bf16_t*)(ws + WS_A1); bf16_t* WIN = (bf16_t*)(ws + WS_WIN); bf16_t* WOUT = (bf16_t*)(ws + WS_WOUT); float* BIAS = (float*)(ws + WS_BIAS); bf16_t* QKV = (bf16_t*)(ws + WS_QKV);
    bf16_t* A2 = (bf16_t*)(ws + WS_A2); bf16_t* DT = (bf16_t*)(ws + WS_DT); float* H1 = (float*)(ws + WS_H1);
    int* tok_e = (int*)(ws + WS_ROUTE); int* tok_pos = tok_e + 2 * M; float* tok_gate = (float*)(tok_pos + 2 * M); float* rstd = tok_gate + 2 * M; float* rowgate = rstd + M;
    bf16_t* XG = (bf16_t*)(ws + WS_XG); bf16_t* HB = (bf16_t*)(ws + WS_HBUF); bf16_t* Y = (bf16_t*)(ws + WS_Y); bf16_t* WGU = (bf16_t*)(ws + WS_WGU); bf16_t* WD = (bf16_t*)(ws + WS_WD);
    unsigned* cnt = (unsigned*)(ws + WS_CTL) + CW_CNT;
    switch (k) {
    case 1: nv::k_cumsum<<<16, 256, 0, stream>>>(BIAS); nv::k_inproj<<<dim3(NQKV / 64, M / 64), 256, 0, stream>>>(A1, WIN, QKV); break;
    case 3: nv::k_attn<<<dim3(S / 64, 48), 256, 0, stream>>>(QKV, BIAS, A2, DT); break;
    case 4: nv::k_diff_combine<<<M, 256, 0, stream>>>(DT, a.in[4], a.in[5], a.in[6], a.in[7], a.in[8], A2); break;
    case 5: nv::k_outproj<<<dim3(DM / 64, M / 64), 256, 0, stream>>>(A2, WOUT, a.in[0], H1); break;
    case 6: nv::k_route<<<M / 4, 256, 0, stream>>>(H1, a.in[10], a.in[11], a.in[12], a.in[13], a.in[14], tok_e, tok_pos, tok_gate, rstd, cnt); break;
    case 7: nv::k_dispatch<<<M / 4, 256, 0, stream>>>(H1, a.in[10], rstd, tok_e, tok_pos, tok_gate, cnt, XG, rowgate); break;
    case 8: nv::k_moe_up<<<dim3(DFF / 64, YROWS / 64), 256, 0, stream>>>(XG, WGU, cnt, HB); break;
    case 9: nv::k_moe_down<<<dim3(DM / 64, YROWS / 64), 256, 0, stream>>>(HB, WD, cnt, rowgate, Y); break;
    case 10: nv::k_final<<<M / 4, 256, 0, stream>>>(H1, Y, cnt, tok_e, tok_pos, a.in[18], a.out); break;
    default: break;
    }
}
#endif


extern "C" void kernel_launch(void* const* d_in, const int* in_sizes, int n_in, void* d_out, int out_size, void* d_ws, size_t ws_size, hipStream_t stream) {
    static int grid = 0;
    if (grid == 0) {
        if (n_in != 19 || in_sizes[0] != M * DM || out_size != M * DM || ws_size < WS_END) {
            fprintf(stderr, "kernel_launch: built for 19 inputs, x and out of %d floats, >= %zu bytes of workspace; got n_in %d, in0 %d, out %d, ws %zu; nothing launched\n", M * DM, (size_t)WS_END, n_in, n_in > 0 ? in_sizes[0] : -1, out_size, ws_size); grid = -1; return; }
        int dev = 0, cus = 0, per_cu = 0;
        if (hipGetDevice(&dev) != hipSuccess || hipDeviceGetAttribute(&cus, hipDeviceAttributeMultiprocessorCount, dev) != hipSuccess) { fprintf(stderr, "kernel_launch: device query failed\n"); grid = -1; return; }
        if (hipFuncSetAttribute((const void*)mk_fwd, hipFuncAttributeMaxDynamicSharedMemorySize, LDS_BYTES) != hipSuccess) { fprintf(stderr, "kernel_launch: hipFuncSetAttribute failed\n"); grid = -1; return; }
        if (hipOccupancyMaxActiveBlocksPerMultiprocessor(&per_cu, (const void*)mk_fwd, NWAVES * 64, LDS_BYTES) != hipSuccess || per_cu < 1)
            fprintf(stderr, "kernel_launch: note: occupancy query reports %d workgroups per CU\n", per_cu);
        (void)hipGetLastError();
        grid = cus;
    }
    if (grid < 0) return;
    if (hipMemsetAsync((char*)d_ws + WS_CTL, 0, CTL_ZERO_BYTES, stream) != hipSuccess) { fprintf(stderr, "kernel_launch: memset failed\n"); return; }
    Args a{};
    for (int i = 0; i < 19; ++i) a.in[i] = (const float*)d_in[i];
    a.out = (float*)d_out; a.ws = (unsigned char*)d_ws;
    int k = 0, li = 0;
    while (k < NPHASE) {
#if NAIVE_MASK
        if (k > 0 && ((NAIVE_MASK >> k) & 1u)) { naive_phase(k, a, stream); ++k; continue; }
#endif
        const int lo = k; ++k;
        while (k < NPHASE && !((NAIVE_MASK >> k) & 1u)) ++k;
        a.ph_lo = lo; a.ph_hi = k; a.li = li++;
        hipLaunchKernelGGL(mk_fwd, dim3(grid), dim3(NWAVES * 64), LDS_BYTES, stream, a);
        const hipError_t le = hipPeekAtLastError();
        if (le != hipSuccess) { fprintf(stderr, "kernel_launch: launch failed: %s\n", hipGetErrorName(le)); break; }
    }
#if PROBE_REP
    a.ph_lo = PROBE_REP; a.ph_hi = PROBE_REP + 1; a.li = li++;
    hipLaunchKernelGGL(mk_fwd, dim3(grid), dim3(NWAVES * 64), LDS_BYTES, stream, a);
#endif
}
```

```cpp
#include <hip/hip_runtime.h>
#include <hip/hip_bf16.h>
#include <cstdio>
#include <cstdint>
#include <cmath>

#ifndef NAIVE_MASK
#define NAIVE_MASK 0u
#endif

typedef unsigned short bf16_t;
constexpr int NB = 2, S = 8192, DM = 2048, M = NB * S;
constexpr int NCOL = 6152, NQKV = 6144;
constexpr int FCOL = 3072;
constexpr int NE = 64, DFF = 1024;
constexpr int YROWS = 49152, NTILE_MAX = YROWS / 256;
constexpr int C_FQ = 0, C_FK = 1024, C_FV = 2048, C_DQ = 3072, C_DK = 4096, C_DV = 5120;
constexpr float ATT_SCALE = 0.08838834764831845f, ATT_ISCALE = 11.313708498984761f;
constexpr int NPHASE = 11;

constexpr size_t MiB = 1u << 20;
constexpr size_t WS_CTL = 0, CTL_ZERO_BYTES = 1 * MiB;
constexpr size_t WS_A1 = 1 * MiB;
constexpr size_t WS_WIN = 65 * MiB;
constexpr size_t WS_WOUT = 89 * MiB;
constexpr size_t WS_BIAS = 97 * MiB;
constexpr size_t WS_QKV = 98 * MiB;
constexpr size_t WS_A2 = 290 * MiB;
constexpr size_t WS_DT = 354 * MiB;
constexpr size_t WS_H1 = 418 * MiB;
constexpr size_t WS_ROUTE = 546 * MiB;
constexpr size_t WS_WR = 547 * MiB;
constexpr size_t WS_XG = 548 * MiB;
constexpr size_t WS_HBUF = 740 * MiB;
constexpr size_t WS_Y = 836 * MiB;
constexpr size_t WS_WGU = 1028 * MiB;
constexpr size_t WS_WD = 1540 * MiB;
constexpr size_t WS_END = 1796 * MiB;
constexpr int CW_CNT = 65536, CNT_STRIDE = 1056;
constexpr int CW_NRM = 2048;
constexpr int CW_QHEAD = 3072;
constexpr int CW_BAR = 4096;

namespace pg8 {
#define PG8_LAS __attribute__((address_space(3)))
typedef unsigned short bf16_t;
typedef short bf16x8 __attribute__((ext_vector_type(8)));
typedef float f32x4 __attribute__((ext_vector_type(4)));
typedef unsigned u32x4 __attribute__((ext_vector_type(4)));
constexpr int BM = 256, BK = 64, HALF = 128, HTB = HALF * BK * 2  , STAGE_BYTES = 8 * HTB, NXCD = 8, WGM = 8;

__host__ __device__ __forceinline__ int lds_byte(int r, int c) { const int st = (r >> 4) * 2 + (c >> 5), rr = r & 15, cc = c & 31, ob = rr * 64 + cc * 2; return st * 1024 + (ob ^ (((ob >> 9) & 1) << 5)); }
__host__ __device__ __forceinline__ void stage_rc(int b, int& R, int& C) { const int st = b / 1024, sb = b % 1024, swz = sb ^ (((sb >> 9) & 1) << 5); R = (st >> 1) * 16 + swz / 64; C = (st & 1) * 32 + (swz % 64) / 2; }
__host__ __device__ __forceinline__ int perm32(int rho) { const int n = rho >> 4, i = rho & 15; return 8 * (i >> 2) + 4 * n + (i & 3); }

struct Unit { int pm, pn; };
struct Gemm { const bf16_t* A; const bf16_t* Bt; int M, N, K; };

struct StaticOrder {
    int nM, nN, nwg, G, c;
    __host__ __device__ void init(int M, int N, int G_, int c_) { nM = M / BM; nN = N / BM; nwg = nM * nN; G = G_; c = c_; }
    __host__ __device__ bool next(int i, Unit& u) const {
        const long L = (long)i * G + c; if (L >= nwg) return false;
        int wgid = (int)L; { const int q = nwg / NXCD, r = nwg % NXCD, xcd = wgid % NXCD, off = wgid / NXCD; wgid = (xcd < r ? xcd * (q + 1) : r * (q + 1) + (xcd - r) * q) + off; }
        const int nig = WGM * nN, gid = wgid / nig, fm = gid * WGM, gsz = (nM - fm) < WGM ? (nM - fm) : WGM;
        u.pm = fm + ((wgid % nig) % gsz); u.pn = (wgid % nig) / gsz; return true;
    }
    __device__ __forceinline__ void a_ready(const Unit&) const {}
    __device__ __forceinline__ void done(const Unit&) const {}
};

__device__ __forceinline__ unsigned cvt_pk_bf16(float lo, float hi) { unsigned r; asm volatile("v_cvt_pk_bf16_f32 %0, %1, %2" : "=v"(r) : "v"(lo), "v"(hi)); return r; }
typedef float f32x2 __attribute__((ext_vector_type(2)));
__device__ __forceinline__ f32x2 gelu_pk(f32x2 v) {
    const f32x2 av = __builtin_elementwise_abs(v), d = av * 0.2316418882f + 1.0f;
    f32x2 t; t.x = __builtin_amdgcn_rcpf(d.x); t.y = __builtin_amdgcn_rcpf(d.y);
    f32x2 q = t * 0.5307027145f + (-0.7265760135f); q = q * t + 0.7107068705f; q = q * t + (-0.142248368f); q = q * t + 0.127414796f; q = q * t;
    const f32x2 s = (v * v) * (-0.72134752044f);
    f32x2 e; e.x = __builtin_amdgcn_exp2f(s.x); e.y = __builtin_amdgcn_exp2f(s.y);
    const f32x2 m = v * (q * e), r = v - m;
    f32x2 o; o.x = v.x < 0.f ? m.x : r.x; o.y = v.y < 0.f ? m.y : r.y; return o;
}

template <int ACT  > struct EpiBf16 {
    static constexpr bool PERM = true, AFTER_DRAIN = false; static_assert(ACT == 0 || ACT == 1, "EpiBf16: ACT is 0 (none) or 1 (gelu_pk)");
    bf16_t* O; int ldc; const float* bias; int split_cols; size_t split_stride; float scale0;
    __device__ __forceinline__ void operator()(const f32x4 (&acc)[2][2][4][2], const Unit& u, int wr, int wc, int fr, int fq) const {
        const int row0 = u.pm * BM + wr * 64 + fr; int colt = u.pn * BM; bf16_t* base = O;
        float sc = 1.f; if (split_cols) { const int t = colt / split_cols; base += (size_t)t * split_stride; colt -= t * split_cols; if (t == 0) sc = scale0; }
        const int col0 = colt + wc * 32 + 8 * fq, bcol0 = u.pn * BM + wc * 32 + 8 * fq;
        f32x4 bv[2][2];
#pragma unroll
        for (int bj = 0; bj < 2; ++bj)
#pragma unroll
            for (int n = 0; n < 2; ++n) bv[bj][n] = bias ? *(const f32x4*)(bias + bcol0 + bj * HALF + 4 * n) : (f32x4){0.f, 0.f, 0.f, 0.f};
#pragma unroll
        for (int ai = 0; ai < 2; ++ai)
#pragma unroll
            for (int m = 0; m < 4; ++m) { bf16_t* rowp = base + (size_t)(row0 + ai * HALF + m * 16) * ldc + col0;
#pragma unroll
                for (int bj = 0; bj < 2; ++bj) { f32x4 v0 = acc[ai][bj][m][0] + bv[bj][0], v1 = acc[ai][bj][m][1] + bv[bj][1];
                    if (ACT == 1) { f32x2 a = gelu_pk((f32x2){v0[0], v0[1]}), b = gelu_pk((f32x2){v0[2], v0[3]}), c = gelu_pk((f32x2){v1[0], v1[1]}), d = gelu_pk((f32x2){v1[2], v1[3]});
                        v0 = (f32x4){a.x, a.y, b.x, b.y}; v1 = (f32x4){c.x, c.y, d.x, d.y}; }
                    v0 = v0 * sc; v1 = v1 * sc; u32x4 w; w.x = cvt_pk_bf16(v0[0], v0[1]); w.y = cvt_pk_bf16(v0[2], v0[3]); w.z = cvt_pk_bf16(v1[0], v1[1]); w.w = cvt_pk_bf16(v1[2], v1[3]);
                    *(u32x4*)(rowp + bj * HALF) = w; } }
    }
};

struct EpiResF32 {
    static constexpr bool PERM = false, AFTER_DRAIN = false;
    const float* base; float* out; int ldc;
    __device__ __forceinline__ void operator()(const f32x4 (&acc)[2][2][4][2], const Unit& u, int wr, int wc, int fr, int fq) const {
        const int col0 = u.pn * BM + wc * 32 + 4 * fq;
#pragma unroll
        for (int ai = 0; ai < 2; ++ai)
#pragma unroll
            for (int m = 0; m < 4; ++m) { const size_t off = (size_t)(u.pm * BM + ai * HALF + wr * 64 + m * 16 + fr) * ldc + col0;
#pragma unroll
                for (int bj = 0; bj < 2; ++bj)
#pragma unroll
                    for (int n = 0; n < 2; ++n) { const f32x4 bs = *(const f32x4*)(base + off + bj * HALF + n * 16); *(f32x4*)(out + off + bj * HALF + n * 16) = bs + acc[ai][bj][m][n]; }
                if (m & 1) asm volatile("" ::: "memory"); }
    }
};
struct EpiResBf16 {
    static constexpr bool PERM = true, AFTER_DRAIN = false;
    const float* base; bf16_t* out; int ldc;
    __device__ __forceinline__ void operator()(const f32x4 (&acc)[2][2][4][2], const Unit& u, int wr, int wc, int fr, int fq) const {
        const int col0 = u.pn * BM + wc * 32 + 8 * fq;
#pragma unroll
        for (int ai = 0; ai < 2; ++ai)
#pragma unroll
            for (int m = 0; m < 4; ++m) { const size_t off = (size_t)(u.pm * BM + ai * HALF + wr * 64 + m * 16 + fr) * ldc + col0;
#pragma unroll
                for (int bj = 0; bj < 2; ++bj) { const f32x4 v0 = *(const f32x4*)(base + off + bj * HALF) + acc[ai][bj][m][0], v1 = *(const f32x4*)(base + off + bj * HALF + 4) + acc[ai][bj][m][1];
                    u32x4 w; w.x = cvt_pk_bf16(v0[0], v0[1]); w.y = cvt_pk_bf16(v0[2], v0[3]); w.z = cvt_pk_bf16(v1[0], v1[1]); w.w = cvt_pk_bf16(v1[2], v1[3]);
                    *(u32x4*)(out + off + bj * HALF) = w; }
                if (m & 1) asm volatile("" ::: "memory"); }
    }
};
struct EpiQKV {
    static constexpr bool PERM = true, AFTER_DRAIN = false;
    bf16_t* O; int ldc; PG8_LAS float* part; unsigned* nrm;
    __device__ __forceinline__ void operator()(const f32x4 (&acc)[2][2][4][2], const Unit& u, int wr, int wc, int fr, int fq) const {
        const int row0 = u.pm * BM + wr * 64 + fr, col0 = u.pn * BM + wc * 32 + 8 * fq;
        const bool track = u.pn < 8 || (u.pn >= 12 && u.pn < 20);
#pragma unroll
        for (int ai = 0; ai < 2; ++ai)
#pragma unroll
            for (int m = 0; m < 4; ++m) { bf16_t* rowp = O + (size_t)(row0 + ai * HALF + m * 16) * ldc + col0;
#pragma unroll
                for (int bj = 0; bj < 2; ++bj) { const f32x4 v0 = acc[ai][bj][m][0], v1 = acc[ai][bj][m][1];
                    u32x4 w; w.x = cvt_pk_bf16(v0[0], v0[1]); w.y = cvt_pk_bf16(v0[2], v0[3]); w.z = cvt_pk_bf16(v1[0], v1[1]); w.w = cvt_pk_bf16(v1[2], v1[3]);
                    *(u32x4*)(rowp + bj * HALF) = w;
                    if (track) { float ss = ((v0[0] * v0[0] + v0[1] * v0[1]) + (v0[2] * v0[2] + v0[3] * v0[3])) + ((v1[0] * v1[0] + v1[1] * v1[1]) + (v1[2] * v1[2] + v1[3] * v1[3]));
                        ss += __shfl_xor(ss, 16); ss += __shfl_xor(ss, 32);
                        if (fq == 0) part[(wc * 2 + bj) * 256 + ai * HALF + wr * 64 + m * 16 + fr] = ss; } } }
        if (track) {
            asm volatile("s_waitcnt lgkmcnt(0)" ::: "memory"); __builtin_amdgcn_s_barrier(); asm volatile("" ::: "memory");
            const int tid = threadIdx.x, row = tid & 255, bj = tid >> 8;
            float v = (part[(0 * 2 + bj) * 256 + row] + part[(1 * 2 + bj) * 256 + row]) + (part[(2 * 2 + bj) * 256 + row] + part[(3 * 2 + bj) * 256 + row]);
#pragma unroll
            for (int o = 1; o < 64; o <<= 1) v = fmaxf(v, __shfl_xor(v, o));
            const int slice = (u.pn < 8 ? 2 * u.pn : 16 + 2 * (u.pn - 12)) + bj;
            if ((tid & 63) == 0) atomicMax(nrm + (u.pm >> 5) * 32 + slice, __float_as_uint(v));
            asm volatile("s_waitcnt lgkmcnt(0)" ::: "memory");
        }
    }
};
struct EpiSwiglu {
    static constexpr bool PERM = true, AFTER_DRAIN = false;
    bf16_t* H;
    __device__ __forceinline__ void operator()(const f32x4 (&acc)[2][2][4][2], const Unit& u, int wr, int wc, int fr, int fq) const {
        const int col0 = (u.pn & 7) * HALF + wc * 32 + 8 * fq;
#pragma unroll
        for (int ai = 0; ai < 2; ++ai)
#pragma unroll
            for (int m = 0; m < 4; ++m) { bf16_t* rowp = H + (size_t)(u.pm * BM + ai * HALF + wr * 64 + m * 16 + fr) * 1024 + col0;
                float hv[8];
#pragma unroll
                for (int n = 0; n < 2; ++n)
#pragma unroll
                    for (int c = 0; c < 4; ++c) { const float g = acc[ai][0][m][n][c], uu = acc[ai][1][m][n][c];
                        hv[n * 4 + c] = g * __builtin_amdgcn_rcpf(1.f + __builtin_amdgcn_exp2f(-1.4426950408889634f * g)) * uu; }
                u32x4 w; w.x = cvt_pk_bf16(hv[0], hv[1]); w.y = cvt_pk_bf16(hv[2], hv[3]); w.z = cvt_pk_bf16(hv[4], hv[5]); w.w = cvt_pk_bf16(hv[6], hv[7]);
                *(u32x4*)rowp = w; }
    }
};
struct EpiDown {
    static constexpr bool PERM = true, AFTER_DRAIN = false;
    bf16_t* Y;
    __device__ __forceinline__ void operator()(const f32x4 (&acc)[2][2][4][2], const Unit& u, int wr, int wc, int fr, int fq) const {
        const int col0 = (u.pn & 7) * BM + wc * 32 + 8 * fq;
#pragma unroll
        for (int ai = 0; ai < 2; ++ai)
#pragma unroll
            for (int m = 0; m < 4; ++m) { const int row = u.pm * BM + ai * HALF + wr * 64 + m * 16 + fr; bf16_t* rowp = Y + (size_t)row * 2048 + col0;
#pragma unroll
                for (int bj = 0; bj < 2; ++bj) { const f32x4 v0 = acc[ai][bj][m][0], v1 = acc[ai][bj][m][1];
                    u32x4 w; w.x = cvt_pk_bf16(v0[0], v0[1]); w.y = cvt_pk_bf16(v0[2], v0[3]); w.z = cvt_pk_bf16(v1[0], v1[1]); w.w = cvt_pk_bf16(v1[2], v1[3]);
                    *(u32x4*)(rowp + bj * HALF) = w; } }
    }
};
struct GroupedOrder {
    int total, G, c; const PG8_LAS int* tile_e;
    __device__ __forceinline__ bool next(int i, Unit& u) const {
        const int L = i * G + c; if (L >= total) return false;
        u.pm = L >> 3; u.pn = __builtin_amdgcn_readfirstlane(tile_e[L >> 3]) * 8 + (L & 7); return true;
    }
    __device__ __forceinline__ void a_ready(const Unit&) const {}
    __device__ __forceinline__ void done(const Unit&) const {}
};

template <class Epi, class Sched, bool ALIGN_EPI = false, bool SP2 = false>
__device__ __forceinline__ void gemm_phase(PG8_LAS unsigned char* lds, const Gemm g, const Sched& S, const Epi& E) {
    const int tid = threadIdx.x, wid = __builtin_amdgcn_readfirstlane(tid >> 6), lane = tid & 63, wr = wid >> 2, wc = wid & 3, fr = lane & 15, fq = lane >> 4;
    const int K = g.K, nt = K / BK;
    unsigned voffA[2], voffB[2];
#pragma unroll
    for (int i = 0; i < 2; ++i) { int R, C; stage_rc(tid * 16 + i * 8192, R, C); const int Rb = Epi::PERM ? ((R & ~31) + perm32(R & 31)) : R;
        voffA[i] = (unsigned)(R * K + C) * 2u; voffB[i] = (unsigned)(Rb * K + C) * 2u; }
    const size_t kstep = (size_t)(BK * 2);
    const size_t hstep = (size_t)HALF * K * 2;
    const size_t tstep = 2 * hstep;
    const unsigned ldsw = (unsigned)wid * 1024u;
    const int aoff = lds_byte(wr * 64 + fr, fq * 8), boff = lds_byte(wc * 32 + fr, fq * 8);
#define PG8_SA(b, h) (((b) * 2 + (h)) * HTB)
#define PG8_SB(b, h) ((4 + (b) * 2 + (h)) * HTB)
#define PG8_STAGE(bufoff, gbase, voff) do { _Pragma("unroll") for (int _i = 0; _i < 2; ++_i) \
        __builtin_amdgcn_global_load_lds((const unsigned*)((const char*)(gbase) + (voff)[_i]), (PG8_LAS unsigned*)(lds + (bufoff) + ldsw + _i * 8192), 16, 0, 0); } while (0)
#define PG8_LDA(dst, b, h) do { _Pragma("unroll") for (int m = 0; m < 4; ++m) _Pragma("unroll") for (int k = 0; k < 2; ++k) dst[m][k] = *(const PG8_LAS bf16x8*)(lds + PG8_SA(b, h) + aoff + m * 2048 + k * 1024); } while (0)
#define PG8_LDB(dst, b, h) do { _Pragma("unroll") for (int n = 0; n < 2; ++n) _Pragma("unroll") for (int k = 0; k < 2; ++k) dst[n][k] = *(const PG8_LAS bf16x8*)(lds + PG8_SB(b, h) + boff + n * 2048 + k * 1024); } while (0)
#define PG8_MMA(ai, bj, At, Bt) do { __builtin_amdgcn_s_setprio(1); _Pragma("unroll") for (int m = 0; m < 4; ++m) _Pragma("unroll") for (int n = 0; n < 2; ++n) _Pragma("unroll") for (int k = 0; k < 2; ++k) \
        acc[ai][bj][m][n] = __builtin_amdgcn_mfma_f32_16x16x32_bf16(Bt[n][k], At[m][k], acc[ai][bj][m][n], 0, 0, 0); __builtin_amdgcn_s_setprio(0); } while (0)
#define PG8_WAIT_V(n) asm volatile("s_waitcnt vmcnt(" #n ")" ::: "memory")
#define PG8_WAIT_L(n) asm volatile("s_waitcnt lgkmcnt(" #n ")" ::: "memory")
#define PG8_BAR __builtin_amdgcn_s_barrier()
#define PG8_SCHED __builtin_amdgcn_sched_barrier(0)
    Unit cur, nxt; int ui = 0;
    if (!S.next(0, cur)) return;
    f32x4 acc[2][2][4][2];
#pragma unroll
    for (int a = 0; a < 2; ++a)
#pragma unroll
        for (int b = 0; b < 2; ++b)
#pragma unroll
            for (int m = 0; m < 4; ++m)
#pragma unroll
                for (int n = 0; n < 2; ++n) acc[a][b][m][n] = (f32x4){0.f, 0.f, 0.f, 0.f};
    bf16x8 At[4][2], B0[2][2], B1[2][2];
    const char* cA = (const char*)g.A + (size_t)cur.pm * tstep; const char* cB = (const char*)g.Bt + (size_t)cur.pn * tstep;
    S.a_ready(cur);
    if constexpr (SP2) {
        PG8_STAGE(PG8_SB(0, 0), cB, voffB); PG8_STAGE(PG8_SB(0, 1), cB + hstep, voffB); PG8_STAGE(PG8_SA(0, 0), cA, voffA); PG8_STAGE(PG8_SA(0, 1), cA + hstep, voffA);
        if (wr == 1) PG8_BAR;
        PG8_WAIT_V(2); PG8_BAR;
        PG8_STAGE(PG8_SB(1, 0), cB + kstep, voffB); PG8_STAGE(PG8_SA(1, 0), cA + kstep, voffA); PG8_STAGE(PG8_SB(1, 1), cB + hstep + kstep, voffB);
        PG8_WAIT_V(6); PG8_BAR;
    } else {
        PG8_STAGE(PG8_SB(0, 0), cB, voffB); PG8_STAGE(PG8_SA(0, 0), cA, voffA); PG8_STAGE(PG8_SB(0, 1), cB + hstep, voffB); PG8_STAGE(PG8_SA(0, 1), cA + hstep, voffA);
        if (wr == 1) PG8_BAR;
        PG8_WAIT_V(4); PG8_BAR;
        PG8_STAGE(PG8_SB(1, 0), cB + kstep, voffB); PG8_STAGE(PG8_SA(1, 0), cA + kstep, voffA); PG8_STAGE(PG8_SB(1, 1), cB + hstep + kstep, voffB);
        PG8_WAIT_V(6); PG8_BAR;
    }
    for (;;) {
        const bool has_next = S.next(ui + 1, nxt);
        const char* nA = has_next ? (const char*)g.A + (size_t)nxt.pm * tstep : cA; const char* nB = has_next ? (const char*)g.Bt + (size_t)nxt.pn * tstep : cB;
        for (int t = 0; t < nt; t += 2) {
            const bool last = (t == nt - 2);
            const char* a1 = cA + (size_t)(t + 1) * kstep;
            const char* a2 = last ? nA : cA + (size_t)(t + 2) * kstep; const char* b2 = last ? nB : cB + (size_t)(t + 2) * kstep;
            const char* a3 = a2 + kstep; const char* b3 = b2 + kstep;
            if (last && has_next) S.a_ready(nxt);
            if constexpr (SP2) {
            PG8_LDB(B0, 0, 0); PG8_LDB(B1, 0, 1); PG8_SCHED; PG8_LDA(At, 0, 0); PG8_STAGE(PG8_SA(1, 1), a1 + hstep, voffA);
            PG8_WAIT_V(8); PG8_WAIT_L(0); PG8_BAR; PG8_MMA(0, 0, At, B0); PG8_MMA(0, 1, At, B1); PG8_BAR; PG8_SCHED;
            PG8_LDA(At, 0, 1); PG8_STAGE(PG8_SB(0, 0), b2, voffB); PG8_STAGE(PG8_SB(0, 1), b2 + hstep, voffB); PG8_STAGE(PG8_SA(0, 0), a2, voffA);
            PG8_WAIT_V(8); PG8_WAIT_L(0); PG8_BAR; PG8_MMA(1, 0, At, B0); PG8_MMA(1, 1, At, B1); PG8_BAR; PG8_SCHED;
            PG8_LDB(B0, 1, 0); PG8_LDB(B1, 1, 1); PG8_SCHED; PG8_LDA(At, 1, 0); PG8_STAGE(PG8_SA(0, 1), a2 + hstep, voffA);
            PG8_WAIT_V(8); PG8_WAIT_L(0); PG8_BAR; PG8_MMA(0, 0, At, B0); PG8_MMA(0, 1, At, B1); PG8_BAR; PG8_SCHED;
            PG8_LDA(At, 1, 1); PG8_STAGE(PG8_SB(1, 0), b3, voffB); PG8_STAGE(PG8_SB(1, 1), b3 + hstep, voffB); PG8_STAGE(PG8_SA(1, 0), a3, voffA);
            PG8_WAIT_V(8); PG8_WAIT_L(0); PG8_BAR; PG8_MMA(1, 0, At, B0); PG8_MMA(1, 1, At, B1); PG8_BAR; PG8_SCHED;
            } else {
            PG8_LDB(B0, 0, 0); PG8_SCHED; PG8_LDA(At, 0, 0); PG8_STAGE(PG8_SA(1, 1), a1 + hstep, voffA);
            PG8_WAIT_L(8); PG8_BAR; PG8_WAIT_L(0); PG8_MMA(0, 0, At, B0); PG8_BAR; PG8_SCHED;
            PG8_LDB(B1, 0, 1); PG8_STAGE(PG8_SB(0, 0), b2, voffB);
            PG8_BAR; PG8_WAIT_L(0); PG8_MMA(0, 1, At, B1); PG8_BAR;
            PG8_LDA(At, 0, 1); PG8_STAGE(PG8_SA(0, 0), a2, voffA);
            PG8_BAR; PG8_WAIT_L(0); PG8_MMA(1, 0, At, B0); PG8_BAR; PG8_SCHED;
            PG8_STAGE(PG8_SB(0, 1), b2 + hstep, voffB);
            PG8_WAIT_V(6); PG8_BAR; PG8_MMA(1, 1, At, B1); PG8_BAR;
            PG8_LDB(B0, 1, 0); PG8_SCHED; PG8_LDA(At, 1, 0); PG8_STAGE(PG8_SA(0, 1), a2 + hstep, voffA);
            PG8_WAIT_L(8); PG8_BAR; PG8_WAIT_L(0); PG8_MMA(0, 0, At, B0); PG8_BAR; PG8_SCHED;
            PG8_LDB(B1, 1, 1); PG8_STAGE(PG8_SB(1, 0), b3, voffB);
            PG8_BAR; PG8_WAIT_L(0); PG8_MMA(0, 1, At, B1); PG8_BAR;
            PG8_LDA(At, 1, 1); PG8_STAGE(PG8_SA(1, 0), a3, voffA);
            PG8_BAR; PG8_WAIT_L(0); PG8_MMA(1, 0, At, B0); PG8_BAR; PG8_SCHED;
            PG8_STAGE(PG8_SB(1, 1), b3 + hstep, voffB);
            PG8_WAIT_V(6); PG8_BAR; PG8_MMA(1, 1, At, B1); PG8_BAR;
            }
        }
        if constexpr (ALIGN_EPI) { if (wr == 0) PG8_BAR; }
        if constexpr (!Epi::AFTER_DRAIN) { E(acc, cur, wr, wc, fr, fq); S.done(cur); }
        if (!has_next) break;
#pragma unroll
        for (int a = 0; a < 2; ++a)
#pragma unroll
            for (int b = 0; b < 2; ++b)
#pragma unroll
                for (int m = 0; m < 4; ++m)
#pragma unroll
                    for (int n = 0; n < 2; ++n) acc[a][b][m][n] = (f32x4){0.f, 0.f, 0.f, 0.f};
        cur = nxt; cA = nA; cB = nB; ++ui;
        if constexpr (ALIGN_EPI) { if (wr == 1) PG8_BAR; }
    }
    PG8_WAIT_V(0);
    if constexpr (!ALIGN_EPI) { if (wr == 0) PG8_BAR; }
    PG8_BAR;
    if constexpr (Epi::AFTER_DRAIN) { E.fused(acc, cur, wr, wc, fr, fq, lds, wid, lane); S.done(cur); }
#undef PG8_SA
#undef PG8_SB
#undef PG8_STAGE
#undef PG8_LDA
#undef PG8_LDB
#undef PG8_MMA
#undef PG8_WAIT_V
#undef PG8_WAIT_L
#undef PG8_BAR
#undef PG8_SCHED
}

struct UnitW { int pm, cn; const float* w0; const float* w1; };
struct GemmW { const bf16_t* A; int K, ldw; const int* rowtok; int tokmask; const PG8_LAS int* rowbase; };
__device__ __forceinline__ void wload1(f32x4& r0, unsigned voff, const char* sbase) { asm volatile("global_load_dwordx4 %0, %1, %2" : "=&v"(r0) : "v"(voff), "s"(sbase) : "memory"); }
template <class Epi, class Sched, bool ALIGN_EPI, bool GATHER>
__device__ __forceinline__ void gemm_phase_wf32(PG8_LAS unsigned char* lds, const GemmW g, const Sched& S, const Epi& E) {
    static_assert(Epi::PERM && !Epi::AFTER_DRAIN, "gemm_phase_wf32: PERM epilogues that run inside the unit loop only");
    const int tid = threadIdx.x, wid = __builtin_amdgcn_readfirstlane(tid >> 6), lane = tid & 63, wr = wid >> 2, wc = wid & 3, fr = lane & 15, fq = lane >> 4;
    const int K = g.K, nt = K / BK;
    const size_t kstep = (size_t)(BK * 2), hstep = (size_t)HALF * K * 2, tstep = 2 * hstep;
    const unsigned ldsw = (unsigned)wid * 1024u;
    const int aoff = lds_byte(wr * 64 + fr, fq * 8), boff = lds_byte(wc * 32 + fr, fq * 8);
    const int cq = lane & 7, sj = lane >> 3;
    #if defined(PROBE_HOT) && (PROBE_HOT == 2 || PROBE_HOT == 4)
    const size_t wrow = (size_t)g.ldw * 4u, wkt = S.hot ? 0 : wrow * BK;
#else
    const size_t wrow = (size_t)g.ldw * 4u, wkt = wrow * BK;
#endif
#if defined(PROBE_HOT) && PROBE_HOT == 5
    const int cqg = S.hot ? (lane & 7) : cq, sjg = S.hot ? (lane >> 3) : sj;
    const size_t wsrc = (size_t)(8 * sjg) * wrow + (size_t)(32 * (wid & 3) + 4 * cqg) * 4u;
#else
    const size_t wsrc = (size_t)(8 * sj) * wrow + (size_t)(32 * (wid & 3) + 4 * cq) * 4u;
#endif
    const int wrho = 16 * (cq & 1) + 4 * (cq >> 1);
    const int wdst = (4 + (wid >> 2)) * HTB + lds_byte(32 * (wid & 3) + wrho, 8 * sj);
#define PG8_SA(b, h) (((b) * 2 + (h)) * HTB)
#define PG8_SB(b, h) ((4 + (b) * 2 + (h)) * HTB)
#define PG8_STAGE(bufoff, gbase, voff) do { _Pragma("unroll") for (int _i = 0; _i < 2; ++_i) \
        __builtin_amdgcn_global_load_lds((const unsigned*)((const char*)(gbase) + (voff)[_i]), (PG8_LAS unsigned*)(lds + (bufoff) + ldsw + _i * 8192), 16, 0, 0); } while (0)
#define PG8_STAGEA(bufoff, h, kb, nx) do { const char* b_ = ((nx) ? nAb : cAb) + (kb); unsigned v_[2]; v_[0] = (nx) ? voN[h][0] : voC[h][0]; v_[1] = (nx) ? voN[h][1] : voC[h][1]; PG8_STAGE(bufoff, b_, v_); } while (0)
#define PG8_LDA(dst, b, h) do { _Pragma("unroll") for (int m = 0; m < 4; ++m) _Pragma("unroll") for (int k = 0; k < 2; ++k) dst[m][k] = *(const PG8_LAS bf16x8*)(lds + PG8_SA(b, h) + aoff + m * 2048 + k * 1024); } while (0)
#define PG8_LDB(dst, b, h) do { _Pragma("unroll") for (int n = 0; n < 2; ++n) _Pragma("unroll") for (int k = 0; k < 2; ++k) dst[n][k] = *(const PG8_LAS bf16x8*)(lds + PG8_SB(b, h) + boff + n * 2048 + k * 1024); } while (0)
#define PG8_MMA(ai, bj, At, Bt) do { __builtin_amdgcn_s_setprio(1); _Pragma("unroll") for (int m = 0; m < 4; ++m) _Pragma("unroll") for (int n = 0; n < 2; ++n) _Pragma("unroll") for (int k = 0; k < 2; ++k) \
        acc[ai][bj][m][n] = __builtin_amdgcn_mfma_f32_16x16x32_bf16(Bt[n][k], At[m][k], acc[ai][bj][m][n], 0, 0, 0); __builtin_amdgcn_s_setprio(0); } while (0)
#define PG8_WAIT_V(n) asm volatile("s_waitcnt vmcnt(" #n ")" ::: "memory")
#define PG8_WAIT_L(n) asm volatile("s_waitcnt lgkmcnt(" #n ")" ::: "memory")
#define PG8_BAR __builtin_amdgcn_s_barrier()
#define PG8_SCHED __builtin_amdgcn_sched_barrier(0)
#define PG8_WLOAD(kk) do { const int kk_ = (kk); const bool in_ = kk_ < nt; const char* q_ = (in_ ? cW : nW) + (size_t)(in_ ? kk_ : kk_ - nt) * wkt; \
        _Pragma("unroll") for (int r_ = 0; r_ < 8; ++r_) wload1(RB[r_], (unsigned)wsrc, q_ + (size_t)r_ * wrow); } while (0)
#define PG8_WWAIT(n) asm volatile("s_waitcnt vmcnt(" #n ")" : "+v"(RB[0]), "+v"(RB[1]), "+v"(RB[2]), "+v"(RB[3]), "+v"(RB[4]), "+v"(RB[5]), "+v"(RB[6]), "+v"(RB[7]) :: "memory")
#define PG8_WWRITE(b) do { _Pragma("unroll") for (int i_ = 0; i_ < 4; ++i_) { u32x4 w_; \
        w_.x = cvt_pk_bf16(RB[0][i_], RB[1][i_]); w_.y = cvt_pk_bf16(RB[2][i_], RB[3][i_]); w_.z = cvt_pk_bf16(RB[4][i_], RB[5][i_]); w_.w = cvt_pk_bf16(RB[6][i_], RB[7][i_]); \
        *(PG8_LAS u32x4*)(lds + (b) * 2 * HTB + wdst + i_ * 64) = w_; } } while (0)
#ifdef PROBE_ABL
    const int abl = S.hot ? PROBE_ABL : 0;
#define PG8_ABL(bit, stmt) do { if (!(abl & (bit))) { stmt; } } while (0)
#else
#define PG8_ABL(bit, stmt) do { stmt; } while (0)
#endif
    UnitW cur, nxt; int ui = 0;
    if (!S.next(0, cur)) return;
    f32x4 acc[2][2][4][2];
#pragma unroll
    for (int a = 0; a < 2; ++a)
#pragma unroll
        for (int b = 0; b < 2; ++b)
#pragma unroll
            for (int m = 0; m < 4; ++m)
#pragma unroll
                for (int n = 0; n < 2; ++n) acc[a][b][m][n] = (f32x4){0.f, 0.f, 0.f, 0.f};
    bf16x8 At[4][2], B0[2][2], B1[2][2]; f32x4 RB[8];
    const bool whalf = wid >= 4;
    const char* cAb; const char* nAb; unsigned voC[2][2], voN[2][2];
#define PG8_UNIT_A(base, vo, pm_) do { int t_ = tid; asm volatile("" : "+v"(t_)); int R_[2], C_[2]; stage_rc(t_ * 16, R_[0], C_[0]); stage_rc(t_ * 16 + 8192, R_[1], C_[1]); \
        if constexpr (GATHER) { base = (const char*)g.A; const int rb_ = __builtin_amdgcn_readfirstlane(g.rowbase[pm_]); _Pragma("unroll") for (int h_ = 0; h_ < 2; ++h_) _Pragma("unroll") for (int i_ = 0; i_ < 2; ++i_) \
            vo[h_][i_] = (unsigned)(g.rowtok[rb_ + (pm_) * BM + h_ * HALF + R_[i_]] & g.tokmask) * (unsigned)(K * 2) + (unsigned)C_[i_] * 2u; } \
        else { base = (const char*)g.A + (size_t)(pm_) * tstep; _Pragma("unroll") for (int h_ = 0; h_ < 2; ++h_) _Pragma("unroll") for (int i_ = 0; i_ < 2; ++i_) vo[h_][i_] = (unsigned)(h_ * HALF + R_[i_]) * (unsigned)(K * 2) + (unsigned)C_[i_] * 2u; } } while (0)
    PG8_UNIT_A(cAb, voC, cur.pm); nAb = cAb;
#pragma unroll
    for (int h_ = 0; h_ < 2; ++h_) { voN[h_][0] = voC[h_][0]; voN[h_][1] = voC[h_][1]; }
    const char* cW = (const char*)(whalf ? cur.w1 : cur.w0);
    const char* nW = cW;
    PG8_WLOAD(0); PG8_STAGEA(PG8_SA(0, 0), 0, 0, false); PG8_STAGEA(PG8_SA(0, 1), 1, 0, false);
    PG8_WWAIT(4); PG8_WWRITE(0);
    PG8_WLOAD(1);
    PG8_WWAIT(0); PG8_WWRITE(1);
    PG8_STAGEA(PG8_SA(1, 0), 0, kstep, false);
    PG8_WLOAD(2);
    PG8_WAIT_L(0);
    if (wr == 1) PG8_BAR;
    PG8_BAR; PG8_BAR;
    for (;;) {
        const bool has_next = S.next(ui + 1, nxt);
        if (has_next) PG8_UNIT_A(nAb, voN, nxt.pm);
        nW = has_next ? (const char*)(whalf ? nxt.w1 : nxt.w0) : cW;
        for (int t = 0; t < nt; t += 2) {
            const bool last = (t == nt - 2);
            const size_t k1 = (size_t)(t + 1) * kstep, k2 = last ? 0 : (size_t)(t + 2) * kstep, k3 = k2 + kstep;
            PG8_LDB(B0, 0, 0); PG8_LDB(B1, 0, 1); PG8_SCHED; PG8_LDA(At, 0, 0); PG8_STAGEA(PG8_SA(1, 1), 1, k1, false);
            PG8_WAIT_V(12); PG8_WAIT_L(0); PG8_BAR; PG8_MMA(0, 0, At, B0); PG8_MMA(0, 1, At, B1); PG8_BAR; PG8_SCHED;
            PG8_WWAIT(2); PG8_ABL(1, PG8_WWRITE(0)); PG8_LDA(At, 0, 1); PG8_STAGEA(PG8_SA(0, 0), 0, k2, last); PG8_ABL(2, PG8_WLOAD(t + 3));
            PG8_WAIT_L(0); PG8_BAR; PG8_MMA(1, 0, At, B0); PG8_MMA(1, 1, At, B1); PG8_BAR; PG8_SCHED;
            PG8_LDB(B0, 1, 0); PG8_LDB(B1, 1, 1); PG8_SCHED; PG8_LDA(At, 1, 0); PG8_STAGEA(PG8_SA(0, 1), 1, k2, last);
            PG8_WAIT_V(12); PG8_WAIT_L(0); PG8_BAR; PG8_MMA(0, 0, At, B0); PG8_MMA(0, 1, At, B1); PG8_BAR; PG8_SCHED;
            PG8_WWAIT(2); PG8_ABL(1, PG8_WWRITE(1)); PG8_LDA(At, 1, 1); PG8_STAGEA(PG8_SA(1, 0), 0, k3, last); PG8_ABL(2, PG8_WLOAD(t + 4));
            PG8_WAIT_L(0); PG8_BAR; PG8_MMA(1, 0, At, B0); PG8_MMA(1, 1, At, B1); PG8_BAR; PG8_SCHED;
        }
        if (!has_next) PG8_WWAIT(0);
        if constexpr (ALIGN_EPI) { if (wr == 0) PG8_BAR; }
        { Unit eu; eu.pm = cur.pm; eu.pn = cur.cn; E(acc, eu, wr, wc, fr, fq); }
        if (!has_next) break;
#pragma unroll
        for (int a = 0; a < 2; ++a)
#pragma unroll
            for (int b = 0; b < 2; ++b)
#pragma unroll
                for (int m = 0; m < 4; ++m)
#pragma unroll
                    for (int n = 0; n < 2; ++n) acc[a][b][m][n] = (f32x4){0.f, 0.f, 0.f, 0.f};
        cur = nxt; cAb = nAb; cW = nW; ++ui;
#pragma unroll
        for (int h_ = 0; h_ < 2; ++h_) { voC[h_][0] = voN[h_][0]; voC[h_][1] = voN[h_][1]; }
        if constexpr (ALIGN_EPI) { if (wr == 1) PG8_BAR; }
    }
    PG8_WAIT_V(0);
    if constexpr (!ALIGN_EPI) { if (wr == 0) PG8_BAR; }
    PG8_BAR;
#undef PG8_SA
#undef PG8_SB
#undef PG8_STAGE
#undef PG8_LDA
#undef PG8_STAGEA
#undef PG8_UNIT_A
#undef PG8_LDB
#undef PG8_MMA
#undef PG8_WAIT_V
#undef PG8_WAIT_L
#undef PG8_BAR
#undef PG8_SCHED
#undef PG8_WLOAD
#undef PG8_ABL
#undef PG8_WWAIT
#undef PG8_WWRITE
}
template <int MODE> struct GroupedOrderW {
    int total, G, c; const PG8_LAS int* tile_e; const float* wa; const float* wb; int hot;
    __device__ __forceinline__ bool next(int i, UnitW& u) const {
        int L = i * G + c;
        if (G == 256) {
            const int x = c & 7, j = c >> 3;
            L = (32 * i + 8 * (x >> 1) + (j & 7)) * 8 + 4 * (x & 1) + (j >> 3);
        }
        if (L >= total) return false;
        int e = __builtin_amdgcn_readfirstlane(tile_e[L >> 3]), nt = L & 7;
        u.pm = L >> 3; u.cn = nt;
#if defined(PROBE_HOT) && PROBE_HOT == 1
        if (hot) { e = 0; nt = 0; }
#endif
        if (MODE == 0) { u.w0 = wa + (size_t)e * 2048 * 1024 + 128 * nt; u.w1 = wb + (size_t)e * 2048 * 1024 + 128 * nt; }
        else { u.w0 = wa + (size_t)e * 1024 * 2048 + 256 * nt; u.w1 = u.w0 + 128; }
        return true;
    }
};
}

namespace att {
using TIN = __hip_bfloat16; using TOUT = __hip_bfloat16;
constexpr int B = 2, H = 1, HKV = 1, SQ = 8192, SKV = 8192, D = 128, QOFF = 0, WINDOW = SKV;
constexpr float THR = 8.f;
constexpr bool WSKIP = false;
constexpr int LDQ = 6144, LDO = 2048;
constexpr int W_INF = 1 << 30;
#ifdef PROF_SECT
#define PROF_T0(sect) unsigned long long pt0_##sect = 0; if (PROF_SECT == (sect) && blockIdx.x == 0) pt0_##sect = __builtin_amdgcn_s_memtime()
#define PROF_T1(sect) do { if (PROF_SECT == (sect) && blockIdx.x == 0) { const unsigned long long d_ = __builtin_amdgcn_s_memtime() - pt0_##sect; if (threadIdx.x == 0) { PROFW[0] += (unsigned)d_; } } } while (0)
#else
#define PROF_T0(sect) do {} while (0)
#define PROF_T1(sect) do {} while (0)
#endif
constexpr float SCALE = 0.08838834764831845f;
constexpr int NW = 8, QBLK = 32, KVBLK = 64, QB = NW * QBLK;
constexpr int SHM_V = KVBLK * D * 2, SHM_K = KVBLK * D * 2;
constexpr int OFF_WS = 2 * SHM_V + 2 * SHM_K, OFF_CB = OFF_WS + NW * 64 * 4, LDS_BYTES = OFF_CB + 2 * 64 * 4;
static_assert(D == 128 && SQ % QB == 0 && SKV % KVBLK == 0 && H % HKV == 0 && QOFF >= 0 && QOFF + SQ <= SKV && WINDOW >= 1, "geometry");

using bf16 = __hip_bfloat16;
typedef short bf16x8 __attribute__((ext_vector_type(8)));
typedef short s16x4 __attribute__((ext_vector_type(4)));
typedef float f32x16 __attribute__((ext_vector_type(16)));
typedef float f32x4 __attribute__((ext_vector_type(4)));
typedef unsigned u32x4 __attribute__((ext_vector_type(4)));
template <class A, class Bt> struct same_t { static constexpr bool v = false; };
template <class A> struct same_t<A, A> { static constexpr bool v = true; };

#define KSWZ(row, colB) ((row) * 256 + ((colB) ^ (((row) & 7) << 4)))
#define SBAR() __builtin_amdgcn_sched_barrier(0)
__device__ __forceinline__ int v_st(int k, int c) { const int kk = (k & ~0xC) | ((k & 4) << 1) | ((k & 8) >> 1); return ((kk >> 3) * 4 + (c >> 5)) * 512 + ((kk & 7) * 32 + (c & 31)) * 2; }
__device__ __forceinline__ int v_rd_base(int lane) { return ((lane & 3) << 3) | (((lane >> 2) & 3) << 6) | (((lane >> 4) & 1) << 5) | (((lane >> 5) & 1) << 8); }
constexpr int v_rd_off(int d0, int ks, int half) { return d0 * 512 + ks * 4096 + half * 2048; }
__device__ __forceinline__ int crow(int r, int hi) { return (r & 3) + 8 * (r >> 2) + 4 * hi; }
__device__ __forceinline__ unsigned cvtpk(float lo, float hi) {
    unsigned r; asm volatile("v_cvt_pk_bf16_f32 %0, %1, %2" : "=v"(r) : "v"(lo), "v"(hi)); return r;
}
__device__ __forceinline__ bf16x8 pack8(f32x4 a, f32x4 b) {
    u32x4 w = {cvtpk(a[0], a[1]), cvtpk(a[2], a[3]), cvtpk(b[0], b[1]), cvtpk(b[2], b[3])};
    return *reinterpret_cast<bf16x8*>(&w);
}
template <class T> __device__ __forceinline__ bf16x8 load8(const T* p) {
    if constexpr (same_t<T, float>::v) { return pack8(*(const f32x4*)p, *(const f32x4*)(p + 4)); }
    else { return *reinterpret_cast<const bf16x8*>(p); }
}
__device__ __forceinline__ void mask_tile(f32x16& p0, f32x16& p1, int dq, unsigned W) {
    const float NEG = -__builtin_inff();
#pragma unroll
    for (int r = 0; r < 16; ++r) {
        const int c = (r & 3) + 8 * (r >> 2);
        if ((unsigned)(dq - c) >= W) p0[r] = NEG;
        if ((unsigned)(dq - c - 32) >= W) p1[r] = NEG;
    }
}
__device__ __forceinline__ void partialSM(f32x16& p0, f32x16& p1, float& m_reg, float& mn, float& alpha) {
    constexpr float C2 = 1.4426950408889634f * SCALE;
    mn = m_reg; alpha = 1.f;
    const float mnL = -m_reg * C2;
    for (int r = 0; r < 16; ++r) p0[r] = fmaf(p0[r], C2, mnL); for (int r = 0; r < 16; ++r) p1[r] = fmaf(p1[r], C2, mnL);
    for (int r = 0; r < 16; ++r) p0[r] = __builtin_amdgcn_exp2f(p0[r]);
}
__device__ __forceinline__ void finishSM(f32x16& p0, f32x16& p1, float alpha, float& l_reg, bf16x8& pa0, bf16x8& pa1, bf16x8& pa2, bf16x8& pa3) {
    for (int r = 0; r < 16; ++r) p1[r] = __builtin_amdgcn_exp2f(p1[r]);
    float ps = 0; for (int r = 0; r < 16; ++r) ps += p0[r]; for (int r = 0; r < 16; ++r) ps += p1[r];
    { auto rr = __builtin_amdgcn_permlane32_swap(__float_as_uint(ps), __float_as_uint(ps), false, false);
      ps = __uint_as_float(rr[0]) + __uint_as_float(rr[1]); }
    l_reg += ps; (void)alpha;
#define PK4(P, B_, OUT) do { unsigned a0 = cvtpk(P[B_+0], P[B_+1]), a1 = cvtpk(P[B_+2], P[B_+3]);                          \
        unsigned b0 = cvtpk(P[B_+4], P[B_+5]), b1 = cvtpk(P[B_+6], P[B_+7]);                                             \
        auto r0 = __builtin_amdgcn_permlane32_swap(a0, b0, false, false); auto r1 = __builtin_amdgcn_permlane32_swap(a1, b1, false, false); \
        u32x4 w = {r0[0], r1[0], r0[1], r1[1]}; OUT = *reinterpret_cast<bf16x8*>(&w); } while (0)
    PK4(p0, 0, pa0); PK4(p0, 8, pa1); PK4(p1, 0, pa2); PK4(p1, 8, pa3);
#undef PK4
}
template <int KB, bool SK>
__device__ __forceinline__ void qkt(f32x16& p0, f32x16& p1, const char* K_lds, int r32, int hi, const bf16x8* qr, bool act, const float* cbt, float cqs) {
    if (SK && !act) { const float NEG = -__builtin_inff();
#pragma unroll
        for (int r = 0; r < 16; ++r) { p0[r] = NEG; p1[r] = NEG; } return; }
    { const f32x4* c4 = (const f32x4*)(cbt + KB * 64);
#pragma unroll
      for (int g = 0; g < 4; ++g) { const f32x4 a = c4[2 * g], b = c4[8 + 2 * g];
#pragma unroll
          for (int i = 0; i < 4; ++i) { p0[4 * g + i] = cqs - a[i]; p1[4 * g + i] = cqs - b[i]; } } }
    const char* kb[4];
#pragma unroll
    for (int dd = 0; dd < 4; ++dd) kb[dd] = K_lds + KB * SHM_K + KSWZ(r32, (dd * 16 + hi * 8) * 2);
#pragma unroll
    for (int d0 = 0; d0 < 8; ++d0) { const char* a = kb[d0 & 3] + (d0 >> 2) * 128;
        bf16x8 b0 = *reinterpret_cast<const bf16x8*>(a);
        bf16x8 b1 = *reinterpret_cast<const bf16x8*>(a + 32 * 256);
        p0 = __builtin_amdgcn_mfma_f32_32x32x16_bf16(b0, qr[d0], p0, 0, 0, 0);
        p1 = __builtin_amdgcn_mfma_f32_32x32x16_bf16(b1, qr[d0], p1, 0, 0, 0); }
}
template <int VB, bool SK>
__device__ __forceinline__ void pv_tile(f32x16* o, int vb0, bf16x8 pa0, bf16x8 pa1, bf16x8 pa2, bf16x8 pa3, bool act) {
    if (SK && !act) return;
#define TRRD(dst, off) asm volatile("ds_read_b64_tr_b16 %0, %1 offset:%2" : "=&v"(dst) : "v"(vb0), "i"(off) : "memory")
#define PV_D0(d0) do { s16x4 l0, l1, l2, l3, h0, h1, h2, h3; constexpr int b_ = VB * SHM_V + v_rd_off(d0, 0, 0);     \
        TRRD(l0, b_); TRRD(h0, b_ + 2048); TRRD(l1, b_ + 4096); TRRD(h1, b_ + 6144); TRRD(l2, b_ + 8192); TRRD(h2, b_ + 10240); TRRD(l3, b_ + 12288); TRRD(h3, b_ + 14336); \
        asm volatile("s_waitcnt lgkmcnt(0)" ::: "memory"); SBAR();                 \
        o[d0] = __builtin_amdgcn_mfma_f32_32x32x16_bf16(pa0, (bf16x8){l0[0], l0[1], l0[2], l0[3], h0[0], h0[1], h0[2], h0[3]}, o[d0], 0, 0, 0);   \
        o[d0] = __builtin_amdgcn_mfma_f32_32x32x16_bf16(pa1, (bf16x8){l1[0], l1[1], l1[2], l1[3], h1[0], h1[1], h1[2], h1[3]}, o[d0], 0, 0, 0);   \
        o[d0] = __builtin_amdgcn_mfma_f32_32x32x16_bf16(pa2, (bf16x8){l2[0], l2[1], l2[2], l2[3], h2[0], h2[1], h2[2], h2[3]}, o[d0], 0, 0, 0);   \
        o[d0] = __builtin_amdgcn_mfma_f32_32x32x16_bf16(pa3, (bf16x8){l3[0], l3[1], l3[2], l3[3], h3[0], h3[1], h3[2], h3[3]}, o[d0], 0, 0, 0); } while (0)
    PV_D0(0); PV_D0(1); PV_D0(2); PV_D0(3);
#undef PV_D0
#undef TRRD
}
template <class TIn, class TOut> struct BlockRef { const TIn* Q; const TIn* K; const TIn* V; TOut* O; const float* C; int P0, jlo; float mref; };
template <class TIn> struct Seam {
    bf16x8 qr[8];
    bf16x8 st_v0, st_v1, st_k0, st_k1; f32x4 sf0, sf1, sf2, sf3;
    float cq, st_c;
    f32x4 tq[16];
};
__device__ __forceinline__ int swa_jlo(int P0, int W) { const int lowk = P0 - W + 1; return lowk > 0 ? lowk / KVBLK : 0; }
#define ROW(p, k0, rr) ((p) + (size_t)((k0) + (rr)) * LDQ + sc)
#define VMW() asm volatile("s_waitcnt vmcnt(0)" ::: "memory")
#define VMWN(n) asm volatile("s_waitcnt vmcnt(%0)" :: "i"(n) : "memory")
#define SLOAD_H(Kp, Vp, Cp, k0) do { S.st_v0 = load8<TIn>(ROW(Vp, k0, sr)); S.st_v1 = load8<TIn>(ROW(Vp, k0, 32 + sr));              \
                         S.st_k0 = load8<TIn>(ROW(Kp, k0, sr)); S.st_k1 = load8<TIn>(ROW(Kp, k0, 32 + sr)); S.st_c = (Cp)[(k0) + (tid & 63)]; } while (0)
#define SWRITE_HK(bf) do { *(bf16x8*)(K_lds + (bf) * SHM_K + kws) = S.st_k0; *(bf16x8*)(K_lds + (bf) * SHM_K + kws + 32 * 256) = S.st_k1; \
                           if (tid < 64) cbw[(bf) * 64 + tid] = S.st_c; } while (0)
#define SWRITE_HV(bf) do { *(bf16x8*)(V_lds + (bf) * SHM_V + vst0) = S.st_v0; *(bf16x8*)(V_lds + (bf) * SHM_V + vst1) = S.st_v1; } while (0)
#define SWRITE_H(bf) do { SWRITE_HV(bf); SWRITE_HK(bf); } while (0)
#define SLOAD_F(p, k0) do { S.sf0 = *(const f32x4*)ROW(p, k0, sr); S.sf1 = *(const f32x4*)(ROW(p, k0, sr) + 4);                \
                            S.sf2 = *(const f32x4*)ROW(p, k0, 32 + sr); S.sf3 = *(const f32x4*)(ROW(p, k0, 32 + sr) + 4); } while (0)
#define SWRITE_KF(bf) do { *(bf16x8*)(K_lds + (bf) * SHM_K + kws) = pack8(S.sf0, S.sf1); *(bf16x8*)(K_lds + (bf) * SHM_K + kws + 32 * 256) = pack8(S.sf2, S.sf3); } while (0)
#define SWRITE_VF(bf) do { *(bf16x8*)(V_lds + (bf) * SHM_V + vst0) = pack8(S.sf0, S.sf1); *(bf16x8*)(V_lds + (bf) * SHM_V + vst1) = pack8(S.sf2, S.sf3); } while (0)
template <class TIn, class TOut>
__device__ __forceinline__ void causal_swa_prime(const BlockRef<TIn, TOut>& cur, int W, char* lds, Seam<TIn>& S) {
    constexpr bool F32 = same_t<TIn, float>::v;
    const int tid = threadIdx.x, wid = __builtin_amdgcn_readfirstlane(tid >> 6), lane = tid & 63, r32 = lane & 31, hi = lane >> 5;
    const int sr = tid >> 4, sc = (tid & 15) * 8, kws = KSWZ(sr, sc * 2); char* K_lds = lds + 2 * SHM_V; float* cbw = (float*)(lds + OFF_CB);
    const int kb0 = cur.jlo * KVBLK;
    for (int d0 = 0; d0 < 8; ++d0) S.qr[d0] = load8<TIn>(cur.Q + (size_t)(wid * QBLK + r32) * LDQ + d0 * 16 + hi * 8);
    S.cq = cur.C[cur.P0 + wid * QBLK + r32];
    if constexpr (F32) { SLOAD_F((const float*)cur.K, kb0); VMW(); SWRITE_KF(0); SBAR(); SLOAD_F((const float*)cur.V, kb0); }
    else { SLOAD_H(cur.K, cur.V, cur.C, kb0); VMW(); SWRITE_HK(0); }
    __syncthreads();
}
template <class TIn, class TOut>
__device__ __forceinline__ void causal_swa_block(const BlockRef<TIn, TOut>& cur, const BlockRef<TIn, TOut>& nxt, int skv, int W, char* lds, Seam<TIn>& S, unsigned* qhead, volatile __attribute__((address_space(3))) int* qw, bool qmore) {
    constexpr bool F32 = same_t<TIn, float>::v;
    const int tid = threadIdx.x, wid = __builtin_amdgcn_readfirstlane(tid >> 6), lane = tid & 63, r32 = lane & 31, hi = lane >> 5;
    int pop_ = 1 << 30; if (threadIdx.x == 0 && qmore) pop_ = (int)atomicAdd(qhead, 1u);
    const int j_lo = cur.jlo;
    int j_hi = (cur.P0 + QB - 1) / KVBLK + 1; if (j_hi > skv / KVBLK) j_hi = skv / KVBLK;
    const int NT = j_hi - j_lo;
    const int kbn = nxt.jlo * KVBLK;
    const int qlo = cur.P0 + wid * QBLK, qm = qlo + r32 - 4 * hi;
    char* V_lds = lds; char* K_lds = lds + 2 * SHM_V; float* cbw = (float*)(lds + OFF_CB); const float* cbt = cbw + 4 * hi; const float* Ch = cur.C;
    float* ws = (float*)(lds + 2 * SHM_V + 2 * SHM_K) + wid * 64; float* li_l = ws, * al_l = ws + 32;
    float m_reg = cur.mref, l_reg = 0; f32x16 o[4] = {};
    const int sr = tid >> 4, sc = (tid & 15) * 8, vst0 = v_st(sr, sc), vst1 = v_st(32 + sr, sc), kws = KSWZ(sr, sc * 2);
    const int vb0 = (int)(uintptr_t)V_lds + v_rd_base(lane);
    const TIn* Kh = cur.K; const TIn* Vh = cur.V;
#define RESC(a) do { (void)(a); (void)al_l; } while (0)
#define KBASE(t) ((j_lo + (t)) * KVBLK)
#define ACT(t) (KBASE(t) <= qlo + QBLK - 1 && KBASE(t) + KVBLK - 1 >= qlo - W + 1)
#define MASKT(P0_, P1_, t) do { const int kb_ = KBASE(t); if ((!SK || ACT(t)) && (kb_ + KVBLK - 1 > qlo || kb_ <= qlo + QBLK - 1 - W)) mask_tile(P0_, P1_, qm - kb_, (unsigned)W); } while (0)
    constexpr int NQL = F32 ? 16 : 9;
    constexpr bool SK = WSKIP && !F32;
#define SEAM_K0() do { VMWN(NQL); if constexpr (F32) { SWRITE_KF(0); SBAR(); SLOAD_F((const float*)nxt.V, kbn); } else { SWRITE_HK(0); } SBAR(); } while (0)
    f32x16 pA0, pA1, pB0, pB1; float mnA, mnB, alA, alB; bf16x8 pa0, pa1, pa2, pa3;
    if constexpr (F32) { VMW(); SWRITE_VF(0); SBAR(); } else { SWRITE_HV(0); SBAR(); }
    if (NT > 1) { if constexpr (F32) SLOAD_F((const float*)Kh, KBASE(1)); else SLOAD_H(Kh, Vh, Ch, KBASE(1)); }
    SBAR(); qkt<0, SK>(pA0, pA1, K_lds, r32, hi, S.qr, ACT(0), cbt, S.cq);
    if constexpr (F32) { if (NT > 1) { VMW(); SWRITE_KF(1); SBAR(); SLOAD_F((const float*)Vh, KBASE(1)); } }
    MASKT(pA0, pA1, 0); partialSM(pA0, pA1, m_reg, mnA, alA);
    if (NT > 1) { VMW(); if constexpr (F32) { SWRITE_VF(1); SBAR(); if (NT > 2) SLOAD_F((const float*)Kh, KBASE(2)); } else SWRITE_H(1); }
    if (tid == 0) qw[0] = pop_;
    __syncthreads();
#define HALF_STEP(PX0, PX1, mnX, alX, PY0, PY1, alY, t, KB, VB, SB) do {                                                      \
        SBAR(); qkt<KB, SK>(PX0, PX1, K_lds, r32, hi, S.qr, ACT(t), cbt, S.cq);                                  \
        finishSM(PY0, PY1, alY, l_reg, pa0, pa1, pa2, pa3); SBAR();                                                           \
        if ((t) + 1 < NT) { if constexpr (F32) { VMW(); SWRITE_KF(SB); SBAR(); SLOAD_F((const float*)Vh, KBASE((t) + 1)); }  \
                            else { SLOAD_H(Kh, Vh, Ch, KBASE((t) + 1)); } SBAR(); }                                           \
        pv_tile<VB, SK>(o, vb0, pa0, pa1, pa2, pa3, ACT((t) - 1)); MASKT(PX0, PX1, (t)); partialSM(PX0, PX1, m_reg, mnX, alX);                                        \
        __syncthreads();                                                                                                      \
        if ((t) + 1 < NT) { VMW(); if constexpr (F32) { SWRITE_VF(SB); SBAR(); if ((t) + 2 < NT) SLOAD_F((const float*)Kh, KBASE((t) + 2)); } \
                            else { SWRITE_H(SB); } }                                                                          \
        RESC(alX); __syncthreads(); } while (0)
    for (int t = 1; t + 1 < NT; t += 2) {
        HALF_STEP(pB0, pB1, mnB, alB, pA0, pA1, alA, t, 1, 0, 0);
        HALF_STEP(pA0, pA1, mnA, alA, pB0, pB1, alB, t + 1, 0, 1, 1);
    }
    int r32s = r32, his = hi; asm volatile("" : "+v"(r32s), "+v"(his));
    const bool even = (NT & 1) == 0;
    if (even) { SBAR(); qkt<1, SK>(pB0, pB1, K_lds, r32, hi, S.qr, ACT(NT - 1), cbt, S.cq); SBAR(); }
#define QROW(e) (nxt.Q + (size_t)(wid * QBLK + r32) * LDQ + ((e) >> 1) * 16 + hi * 8 + ((e) & 1) * 4)
    if constexpr (F32) { SLOAD_F((const float*)nxt.K, kbn); SBAR();
#pragma unroll
        for (int e = 0; e < 8; ++e) S.tq[e] = *(const f32x4*)QROW(e); }
    else { SLOAD_H(nxt.K, nxt.V, nxt.C, kbn); SBAR();
#pragma unroll
        for (int d0 = 0; d0 < 8; ++d0) S.qr[d0] = load8<TIn>(nxt.Q + (size_t)(wid * QBLK + r32s) * LDQ + d0 * 16 + his * 8);
        S.cq = nxt.C[nxt.P0 + wid * QBLK + r32s]; }
    SBAR();
    finishSM(pA0, pA1, alA, l_reg, pa0, pa1, pa2, pa3); SBAR();
    if constexpr (F32) {
#pragma unroll
        for (int e = 8; e < 16; ++e) S.tq[e] = *(const f32x4*)QROW(e); SBAR(); }
#undef QROW
    pv_tile<0, SK>(o, vb0, pa0, pa1, pa2, pa3, ACT(even ? NT - 2 : NT - 1));
    if (even) { MASKT(pB0, pB1, NT - 1); partialSM(pB0, pB1, m_reg, mnB, alB); __syncthreads(); RESC(alB);
        finishSM(pB0, pB1, alB, l_reg, pa0, pa1, pa2, pa3); SBAR(); pv_tile<1, SK>(o, vb0, pa0, pa1, pa2, pa3, ACT(NT - 1)); }
    SBAR(); SEAM_K0();
    if (his == 0) li_l[r32s] = l_reg; asm volatile("s_waitcnt lgkmcnt(0)" ::: "memory");
    float rli[16];
#pragma unroll
    for (int r = 0; r < 16; ++r) rli[r] = __builtin_amdgcn_rcpf(li_l[crow(r, his)]);
    TOut* Ow = cur.O + (size_t)(wid * QBLK) * LDO;
#pragma unroll
    for (int r = 0; r < 16; ++r) { const int orow = crow(r, his);
#pragma unroll
        for (int d0 = 0; d0 < 4; ++d0) { const float v = o[d0][r] * rli[r];
            if constexpr (same_t<TOut, float>::v) { Ow[(size_t)orow * LDO + d0 * 32 + r32] = v; }
            else { const float vn = __shfl_xor(v, 1);
                   if ((r32s & 1) == 0) *(unsigned*)(Ow + (size_t)orow * LDO + d0 * 32 + r32s) = cvtpk(v, vn); } } }
    if constexpr (F32) {
#pragma unroll
        for (int d0 = 0; d0 < 8; ++d0) S.qr[d0] = pack8(S.tq[2 * d0], S.tq[2 * d0 + 1]); }
    __syncthreads();
#undef RESC
#undef KBASE
#undef ACT
#undef MASKT
#undef SEAM_K0
#undef HALF_STEP
}
#undef ROW
#undef VMW
#undef VMWN
#undef SLOAD_H
#undef SWRITE_HK
#undef SWRITE_HV
#undef SWRITE_H
#undef SLOAD_F
#undef SWRITE_KF
#undef SWRITE_VF


constexpr int QB2 = 128, NQB2 = SQ / QB2, SHM_V2 = 2 * SHM_V;
constexpr int P_OFF_K = 2 * SHM_V2, P_OFF_X = P_OFF_K + 2 * SHM_K, PAIR_RING = P_OFF_X + 2 * NW * 2048;
constexpr int P_OFF_L = PAIR_RING + 2048, P_OFF_CB = P_OFF_L + NW * 64 * 4, PAIR_LDS = P_OFF_CB + 2 * 64 * 4;
struct PRef { const bf16* Q; const bf16* K; const bf16* V; bf16* O; const float* C; int P0, jlo; float mref; };
template <int BUF, int NV>
__device__ __forceinline__ void pair_pv(f32x16* o, int vb0, bf16x8 pa0, bf16x8 pa1, bf16x8 pa2, bf16x8 pa3) {
#define TRRD(dst, off) asm volatile("ds_read_b64_tr_b16 %0, %1 offset:%2" : "=&v"(dst) : "v"(vb0), "i"(off) : "memory")
#define PV_D0(d0) do { s16x4 l0, l1, l2, l3, h0, h1, h2, h3; constexpr int b_ = BUF * SHM_V2 + v_rd_off(d0, 0, 0); \
        TRRD(l0, b_); TRRD(h0, b_ + 2048); TRRD(l1, b_ + 4096); TRRD(h1, b_ + 6144); TRRD(l2, b_ + 8192); TRRD(h2, b_ + 10240); TRRD(l3, b_ + 12288); TRRD(h3, b_ + 14336); \
        asm volatile("s_waitcnt lgkmcnt(0)" ::: "memory"); SBAR(); \
        o[d0] = __builtin_amdgcn_mfma_f32_32x32x16_bf16(pa0, (bf16x8){l0[0], l0[1], l0[2], l0[3], h0[0], h0[1], h0[2], h0[3]}, o[d0], 0, 0, 0); \
        o[d0] = __builtin_amdgcn_mfma_f32_32x32x16_bf16(pa1, (bf16x8){l1[0], l1[1], l1[2], l1[3], h1[0], h1[1], h1[2], h1[3]}, o[d0], 0, 0, 0); \
        o[d0] = __builtin_amdgcn_mfma_f32_32x32x16_bf16(pa2, (bf16x8){l2[0], l2[1], l2[2], l2[3], h2[0], h2[1], h2[2], h2[3]}, o[d0], 0, 0, 0); \
        o[d0] = __builtin_amdgcn_mfma_f32_32x32x16_bf16(pa3, (bf16x8){l3[0], l3[1], l3[2], l3[3], h3[0], h3[1], h3[2], h3[3]}, o[d0], 0, 0, 0); } while (0)
    PV_D0(0); PV_D0(1); if constexpr (NV == 4) { PV_D0(2); PV_D0(3); }
#undef PV_D0
#undef TRRD
}
struct PStage { bf16x8 k0, k1, v0, v1, v2, v3; float c; };
template <int NV>
__device__ __forceinline__ void pair_block(const PRef& B, char* lds, volatile __attribute__((address_space(3))) unsigned* PROFW) {
    PROF_T0(2);
    PROF_T0(8);
    const int tid = threadIdx.x, wid = __builtin_amdgcn_readfirstlane(tid >> 6), lane = tid & 63, r32 = lane & 31, hi = lane >> 5, pr = wid & 3, kh = wid >> 2;
    char* V_lds = lds; char* K_lds = lds + P_OFF_K; char* X_lds = lds + P_OFF_X; float* L_lds = (float*)(lds + P_OFF_L); float* cbw = (float*)(lds + P_OFF_CB);
    const int j_lo = B.jlo, NT = (B.P0 >> 6) + 2 - j_lo;
    const int sr = tid >> 4, sc = (tid & 15) * 8, vst0 = v_st(sr, sc), vst1 = v_st(32 + sr, sc), kws = KSWZ(sr, sc * 2);
    const int vb0 = (int)(uintptr_t)V_lds + kh * (NV == 4 ? SHM_V : 1024) + v_rd_base(lane);
    int ka[4];
#pragma unroll
    for (int dd = 0; dd < 4; ++dd) ka[dd] = (int)(uintptr_t)K_lds + kh * (32 * 256) + KSWZ(r32, (dd * 16 + hi * 8) * 2);
    constexpr float C2 = 1.4426950408889634f * SCALE;
    const float mnL = -B.mref * C2;
    const int qrow = B.P0 + pr * 32 + r32;
    bf16x8 qr[8];
#pragma unroll
    for (int d0 = 0; d0 < 8; ++d0) qr[d0] = load8<bf16>(B.Q + (size_t)(pr * 32 + r32) * LDQ + d0 * 16 + hi * 8);
    const float cq = B.C[qrow];
    f32x16 o[NV] = {}; float l_reg = 0.f;
    PStage stA, stB;
#define TCL(t) ((t) < NT ? (t) : NT - 1)
#define PLOADK(st, t) do { const int k0_ = (j_lo + TCL(t)) * KVBLK; const bf16* kp_ = B.K + (size_t)(k0_ + sr) * LDQ + sc; st.k0 = load8<bf16>(kp_); st.k1 = load8<bf16>(kp_ + (size_t)32 * LDQ); st.c = B.C[k0_ + (tid & 63)]; } while (0)
#define PLOADV(st, t) do { const int k0_ = (j_lo + TCL(t)) * KVBLK; const bf16* vp_ = B.V + (size_t)(k0_ + sr) * LDQ + sc; st.v0 = load8<bf16>(vp_); st.v1 = load8<bf16>(vp_ + (size_t)32 * LDQ); \
        if constexpr (NV == 4) { st.v2 = load8<bf16>(vp_ + 128); st.v3 = load8<bf16>(vp_ + (size_t)32 * LDQ + 128); } } while (0)
#define PWRITEK(st, bf) do { *(bf16x8*)(K_lds + (bf) * SHM_K + kws) = st.k0; *(bf16x8*)(K_lds + (bf) * SHM_K + kws + 32 * 256) = st.k1; if (tid < 64) cbw[(bf) * 64 + tid] = st.c; } while (0)
#define PWRITEV(st, bf) do { *(bf16x8*)(V_lds + (bf) * SHM_V2 + vst0) = st.v0; *(bf16x8*)(V_lds + (bf) * SHM_V2 + vst1) = st.v1; \
        if constexpr (NV == 4) { *(bf16x8*)(V_lds + (bf) * SHM_V2 + SHM_V + vst0) = st.v2; *(bf16x8*)(V_lds + (bf) * SHM_V2 + SHM_V + vst1) = st.v3; } } while (0)
#define KRD_(dst, d0, KB) asm volatile("ds_read_b128 %0, %1 offset:%2" : "=&v"(dst) : "v"(ka[(d0) & 3]), "i"((KB) * SHM_K + ((d0) >> 2) * 128) : "memory")
#define KWT_(n, r) asm volatile("s_waitcnt lgkmcnt(" #n ")" : "+v"(r) :: "memory")
#define ASTAGE(t, KB, XB) do { \
        f32x16 p; { const f32x4* c4 = (const f32x4*)(cbw + (KB) * 64 + 32 * kh + 4 * hi); \
            _Pragma("unroll") for (int g = 0; g < 4; ++g) { const f32x4 a = c4[2 * g]; _Pragma("unroll") for (int i = 0; i < 4; ++i) p[4 * g + i] = cq - a[i]; } } \
        { bf16x8 kf0, kf1, kf2, kf3;     \
          KRD_(kf0, 0, KB); KRD_(kf1, 1, KB); KRD_(kf2, 2, KB); KRD_(kf3, 3, KB); \
          KWT_(3, kf0); p = __builtin_amdgcn_mfma_f32_32x32x16_bf16(kf0, qr[0], p, 0, 0, 0); KRD_(kf0, 4, KB); \
          KWT_(3, kf1); p = __builtin_amdgcn_mfma_f32_32x32x16_bf16(kf1, qr[1], p, 0, 0, 0); KRD_(kf1, 5, KB); \
          KWT_(3, kf2); p = __builtin_amdgcn_mfma_f32_32x32x16_bf16(kf2, qr[2], p, 0, 0, 0); KRD_(kf2, 6, KB); \
          KWT_(3, kf3); p = __builtin_amdgcn_mfma_f32_32x32x16_bf16(kf3, qr[3], p, 0, 0, 0); KRD_(kf3, 7, KB); \
          KWT_(3, kf0); p = __builtin_amdgcn_mfma_f32_32x32x16_bf16(kf0, qr[4], p, 0, 0, 0); \
          KWT_(2, kf1); p = __builtin_amdgcn_mfma_f32_32x32x16_bf16(kf1, qr[5], p, 0, 0, 0); \
          KWT_(1, kf2); p = __builtin_amdgcn_mfma_f32_32x32x16_bf16(kf2, qr[6], p, 0, 0, 0); \
          KWT_(0, kf3); p = __builtin_amdgcn_mfma_f32_32x32x16_bf16(kf3, qr[7], p, 0, 0, 0); } \
        { const int kb = (j_lo + (t)) * KVBLK + 32 * kh; if (kb + 31 > B.P0 + pr * 32) { const int dq = qrow - kb - 4 * hi; const float NEG = -__builtin_inff(); \
            _Pragma("unroll") for (int r = 0; r < 16; ++r) { const int c = (r & 3) + 8 * (r >> 2); if (dq - c < 0) p[r] = NEG; } } } \
        _Pragma("unroll") for (int r = 0; r < 16; ++r) p[r] = __builtin_amdgcn_exp2f(fmaf(p[r], C2, mnL)); \
        { float ps = 0.f; _Pragma("unroll") for (int r = 0; r < 16; ++r) ps += p[r]; \
          auto rr = __builtin_amdgcn_permlane32_swap(__float_as_uint(ps), __float_as_uint(ps), false, false); l_reg += __uint_as_float(rr[0]) + __uint_as_float(rr[1]); } \
        { unsigned a0 = cvtpk(p[0], p[1]), a1 = cvtpk(p[2], p[3]), b0 = cvtpk(p[4], p[5]), b1 = cvtpk(p[6], p[7]); \
          auto r0 = __builtin_amdgcn_permlane32_swap(a0, b0, false, false); auto r1 = __builtin_amdgcn_permlane32_swap(a1, b1, false, false); u32x4 w = {r0[0], r1[0], r0[1], r1[1]}; \
          *(u32x4*)(X_lds + (XB) * (NW * 2048) + wid * 2048 + lane * 16) = w; } \
        { unsigned a0 = cvtpk(p[8], p[9]), a1 = cvtpk(p[10], p[11]), b0 = cvtpk(p[12], p[13]), b1 = cvtpk(p[14], p[15]); \
          auto r0 = __builtin_amdgcn_permlane32_swap(a0, b0, false, false); auto r1 = __builtin_amdgcn_permlane32_swap(a1, b1, false, false); u32x4 w = {r0[0], r1[0], r0[1], r1[1]}; \
          *(u32x4*)(X_lds + (XB) * (NW * 2048) + wid * 2048 + 1024 + lane * 16) = w; } } while (0)
#define BSTAGE(VB, XB) do { const char* xo_ = X_lds + (XB) * (NW * 2048) + wid * 2048 + lane * 16; const char* xp_ = X_lds + (XB) * (NW * 2048) + (wid ^ 4) * 2048 + lane * 16; \
        const bf16x8 own0 = *(const bf16x8*)xo_, own1 = *(const bf16x8*)(xo_ + 1024), oth0 = *(const bf16x8*)xp_, oth1 = *(const bf16x8*)(xp_ + 1024); \
        pair_pv<VB, NV>(o, vb0, kh ? oth0 : own0, kh ? oth1 : own1, kh ? own0 : oth0, kh ? own1 : oth1); } while (0)
    PLOADK(stA, 0); PLOADV(stA, 0); PLOADK(stB, 1); PLOADV(stB, 1);
    __syncthreads();
    PWRITEK(stA, 0); PWRITEV(stA, 0);
    PLOADK(stA, 2);
    __syncthreads();
    PROF_T1(8);
    PROF_T0(9);
    ASTAGE(0, 0, 0);
    PWRITEK(stB, 1);
    PLOADV(stA, 2); PLOADK(stB, 3);
    __syncthreads();
#define PITER(t, P, SV, SK) do {     \
        BSTAGE(P, P); \
        if ((t) + 1 < NT) { ASTAGE((t) + 1, (P) ^ 1, (P) ^ 1); PWRITEV(SV, (P) ^ 1); PWRITEK(SK, P); PLOADV(SV, (t) + 3); PLOADK(SK, (t) + 4); } \
        __syncthreads(); } while (0)
    PROF_T1(9);
    PROF_T1(2);
    { PROF_T0(3);
    int t = 0;
    for (; t + 1 < NT; t += 2) { PITER(t, 0, stB, stA); PITER(t + 1, 1, stA, stB); }
    if (t < NT) PITER(t, 0, stB, stA);
    PROF_T1(3); }
    { PROF_T0(4);
    { PROF_T0(6);
    if (hi == 0) L_lds[wid * 64 + r32] = l_reg;
    __syncthreads();
    PROF_T1(6); }
    PROF_T0(7);
    if (hi == 0) L_lds[wid * 64 + 32 + r32] = l_reg + L_lds[(wid ^ 4) * 64 + r32];
    asm volatile("s_waitcnt lgkmcnt(0)" ::: "memory");
    float rli[16];
#pragma unroll
    for (int r = 0; r < 16; ++r) rli[r] = __builtin_amdgcn_rcpf(L_lds[wid * 64 + 32 + crow(r, hi)]);
    constexpr int OROW = NV * 64 + 16;
    char* ot = lds + wid * (32 * (4 * 64 + 16));
    const bool odd = (r32 & 1) != 0;
#pragma unroll
    for (int r = 0; r < 16; ++r) { const int orow = crow(r, hi);
#pragma unroll
        for (int d0 = 0; d0 < NV; d0 += 2) { const float va = o[d0][r] * rli[r], vb = o[d0 + 1][r] * rli[r];
            const float snd = odd ? va : vb;
            const float rcv = __uint_as_float((unsigned)__builtin_amdgcn_update_dpp(0, (int)__float_as_uint(snd), 0xB1, 0xF, 0xF, true));
            const unsigned pk = cvtpk(odd ? rcv : va, odd ? vb : rcv);
            *(unsigned*)(ot + orow * OROW + ((odd ? d0 + 1 : d0) * 32 + (r32 & ~1)) * 2) = pk; } }
    asm volatile("s_waitcnt lgkmcnt(0)" ::: "memory");
    PROF_T0(10);
    bf16* Ow = B.O + (size_t)(pr * 32) * LDO + kh * (NV * 32);
    constexpr int CPR = NV * 4;
#pragma unroll
    for (int i = 0; i < (32 * CPR) / 64; ++i) { const int idx = i * 64 + lane, row = idx / CPR, ch = idx % CPR;
        const u32x4 w = *(const u32x4*)(ot + row * OROW + ch * 16);
        *(u32x4*)(Ow + (size_t)row * LDO + ch * 8) = w; }
    PROF_T1(10);
    PROF_T1(7);
    PROF_T1(4); }
#undef TCL
#undef PLOADK
#undef PLOADV
#undef PWRITEK
#undef PWRITEV
#undef KRD_
#undef KWT_
#undef ASTAGE
#undef BSTAGE
#undef PITER
}

constexpr float SKIP_T = 16.f;
constexpr int NDIFF = 16 * NQB2, NFOX = 16 * NQB2;
struct Tensors { const bf16* QKV; bf16* A2; bf16* DT; const float* BIAS; const unsigned* NRM; };
__host__ __device__ constexpr int est_diff(int h, int qb2) { const int full = 2 * (qb2 + 1), cap = h == 0 ? 12 : (h == 1 ? 24 : (h == 2 ? 62 : 128)); return full < cap ? full : cap; }
__host__ __device__ constexpr int est_fox(int qb2) { const int full = 2 * (qb2 + 1); return full < 20 ? full : 20; }
struct OrderTab2 { unsigned short v[NDIFF]; };
template <bool FOX> __host__ __device__ constexpr OrderTab2 make_order2() {
    OrderTab2 t{}; int start[130] = {};
    for (int pp = 0; pp < 16; ++pp) for (int qb = 0; qb < NQB2; ++qb) start[128 - (FOX ? est_fox(qb) : est_diff((pp >> 1) & 3, qb)) + 1]++;
    for (int i = 1; i < 130; ++i) start[i] += start[i - 1];
    for (int pp = 0; pp < 16; ++pp) for (int qb = NQB2 - 1; qb >= 0; --qb) { const int b = 128 - (FOX ? est_fox(qb) : est_diff((pp >> 1) & 3, qb)); t.v[start[b]++] = (unsigned short)(pp * 64 + qb); }
    return t;
}
__device__ const OrderTab2 ORDER_D = make_order2<false>();
__device__ const OrderTab2 ORDER_F = make_order2<true>();
constexpr int ORD_OFF = PAIR_LDS, NRMW_OFF = ORD_OFF + NDIFF * 2;
template <bool FOX>
__device__ __forceinline__ PRef make_pref(const Tensors& T, const char* lds, int o, int lane) {
    const int code = __builtin_amdgcn_readfirstlane((int)((const unsigned short*)(lds + ORD_OFF))[o]), pp = code >> 6, qb = code & 63, b = pp >> 3;
    PRef r; int sq, sk;
    const bf16* base = T.QKV + (size_t)b * S * LDQ; r.P0 = qb * QB2;
    if (FOX) { const int h = pp & 7; r.Q = base + (size_t)qb * QB2 * LDQ + C_FQ + h * 128; r.K = base + C_FK + h * 128; r.V = base + C_FV + h * 128; sq = h; sk = 8 + h;
        r.O = T.A2 + ((size_t)b * S + (size_t)qb * QB2) * LDO + h * 128; r.C = T.BIAS + (size_t)(b * 8 + h) * S; }
    else { const int h = (pp >> 1) & 3, mp = pp & 1; r.Q = base + (size_t)qb * QB2 * LDQ + C_DQ + h * 256 + mp * 128; r.K = base + C_DK + h * 256 + mp * 128; r.V = base + C_DV + h * 256; sq = 16 + 2 * h + mp; sk = 24 + 2 * h + mp;
        r.O = T.DT + ((size_t)b * S + (size_t)qb * QB2) * LDO + h * 512 + mp * 256; r.C = T.BIAS + (size_t)(16 + h) * S; }
    const int jd = r.P0 >> 6;
    int ln = lane; asm volatile("" : "+v"(ln));
    const int j0 = ln < jd ? ln : jd, j1 = ln + 64 < jd ? ln + 64 : jd;
    const float cp = r.C[r.P0], c0 = r.C[64 * j0 + 63], c1 = r.C[64 * j1 + 63];
    const float nq = ((const float*)(lds + NRMW_OFF))[b * 32 + sq], nk = ((const float*)(lds + NRMW_OFF))[b * 32 + sk];
    const float qk = 1.015f * sqrtf(nq * nk);
    const float th = (SKIP_T + 2.f * qk * SCALE) * (1.0f / SCALE), lim = cp + th; r.mref = qk;
    const bool k0 = (ln >= jd) | (c0 <= lim), k1 = (ln + 64 >= jd) | (c1 <= lim);
    const unsigned long long b0 = __ballot(k0), b1 = __ballot(k1);
    r.jlo = b0 ? (int)__builtin_ctzll(b0) : 64 + (int)__builtin_ctzll(b1);
    return r;
}
template <bool FOX>
__device__ __forceinline__ void attn_part(char* lds, const Tensors& T, unsigned* head, volatile __attribute__((address_space(3))) int* qw) {
    volatile __attribute__((address_space(3))) unsigned* PROFW = (volatile __attribute__((address_space(3))) unsigned*)(qw + 8);
    PROF_T0(5);
    const int tid = threadIdx.x, lane = tid & 63;
    if (tid == 0) qw[0] = (int)atomicAdd(head, 1u);
    ((unsigned*)(lds + ORD_OFF))[tid] = ((const unsigned*)(FOX ? ORDER_F.v : ORDER_D.v))[tid];
    if (tid < 64) ((unsigned*)(lds + NRMW_OFF))[tid] = T.NRM[tid];
    __syncthreads();
    int k = __builtin_amdgcn_readfirstlane(qw[0]);
    while (k < NDIFF) {
        int kn = 0; if (tid == 0) kn = (int)atomicAdd(head, 1u);
        PROF_T0(1);
        const PRef B = make_pref<FOX>(T, lds, k, lane);
        PROF_T1(1);
        pair_block<FOX ? 2 : 4>(B, lds, PROFW);
        if (tid == 0) qw[1] = kn;
        __syncthreads();
        k = __builtin_amdgcn_readfirstlane(qw[1]);
    }
    __syncthreads();
    PROF_T1(5);
}
#undef KSWZ
#undef SBAR
}

#define GAS __attribute__((address_space(1)))
#define LAS __attribute__((address_space(3)))
typedef unsigned short bf16;
typedef unsigned v4u __attribute__((ext_vector_type(4)));
typedef float f32x4 __attribute__((ext_vector_type(4)));
typedef short bf16x8 __attribute__((ext_vector_type(8)));
typedef GAS unsigned gu32;
typedef GAS unsigned long long gu64;
#define RLX_AGENT __ATOMIC_RELAXED, __HIP_MEMORY_SCOPE_AGENT
#define LDS_WAIT() asm volatile("s_waitcnt lgkmcnt(0)" ::: "memory")
#define VM_WAIT() asm volatile("s_waitcnt vmcnt(0)" ::: "memory")
__device__ __forceinline__ unsigned long long rt() { return __builtin_amdgcn_s_memrealtime(); }
__device__ __forceinline__ unsigned f2bf(float f) { unsigned u = __builtin_bit_cast(unsigned, f); return (u + 0x7fffu + ((u >> 16) & 1u)) >> 16; }
__device__ __forceinline__ unsigned pk2(float lo, float hi) { return f2bf(lo) | (f2bf(hi) << 16); }

#define XB_TMO      128
#define XB_XCNT(j)  (256  + 64 * (j))
#define XB_XSUB(j)  (1280 + 64 * (j))
#define XB_XGEN(j)  (2304 + 64 * (j))
#define XB_TOP      3328
#define XB_TOPGEN   3392
#define XCD_BAR_WORDS 3456
#define XB_SPIN_CAP (1u << 18)

__device__ __forceinline__ unsigned xb_ld(unsigned* p)              { return __hip_atomic_load(p, __ATOMIC_RELAXED, __HIP_MEMORY_SCOPE_AGENT); }
__device__ __forceinline__ unsigned xb_add(unsigned* p, unsigned v) { return __hip_atomic_fetch_add(p, v, __ATOMIC_RELAXED, __HIP_MEMORY_SCOPE_AGENT); }
__device__ __forceinline__ unsigned xb_xcc_id() { return (unsigned)__builtin_amdgcn_s_getreg((3 << 11) | 20) & 0xFu; }
#define XB_SPIN(cond, bar) do { unsigned _sp = 0; while (cond) { __builtin_amdgcn_s_sleep(1); \
    if ((++_sp & 255u) == 0u) { if (xb_ld(&(bar)[XB_TMO])) break; if (_sp > XB_SPIN_CAP) { atomicAdd(&(bar)[XB_TMO], 1u); break; } } } } while (0)

struct XcdBarrier {
    unsigned* bar; unsigned x;
    volatile LAS unsigned* st;
};

__device__ __forceinline__ XcdBarrier xcd_barrier_post(unsigned* bar, volatile LAS unsigned* st) {
    XcdBarrier b; b.bar = bar; b.x = xb_xcc_id(); b.st = st;
    if (threadIdx.x == 0) (void)xb_add(&bar[XB_XCNT(b.x)], 1u);
    return b;
}
__device__ __forceinline__ void xcd_barrier_complete(unsigned* bar, unsigned x, unsigned& nloc, unsigned& nx) {
    const unsigned G = gridDim.x * gridDim.y * gridDim.z;
    unsigned sum, cnt, mine, sp = 0u;
    for (;;) {
        sum = 0u; cnt = 0u; mine = 0u;
#pragma unroll
        for (unsigned j = 0; j < 16; ++j) { const unsigned c = xb_ld(&bar[XB_XCNT(j)]); sum += c; cnt += (c > 0u) ? 1u : 0u; mine = (j == x) ? c : mine; }
        if (sum == G) break;
        __builtin_amdgcn_s_sleep(1);
        if ((++sp & 255u) == 0u) { if (xb_ld(&bar[XB_TMO])) break; if (sp > XB_SPIN_CAP) { atomicAdd(&bar[XB_TMO], 1u); break; } }
    }
    nloc = mine > 0u ? mine : 1u; nx = cnt > 0u ? cnt : 1u;
}

__device__ __forceinline__ void xcd_barrier(const XcdBarrier& b) {
    asm volatile("s_waitcnt vmcnt(0)" ::: "memory");
    __syncthreads();
    if (threadIdx.x == 0) {
        unsigned* bar = b.bar;
        __builtin_amdgcn_s_waitcnt(0);
        unsigned nloc = b.st[0], nx = b.st[1];
        if (nloc == 0u) { xcd_barrier_complete(bar, b.x, nloc, nx); b.st[0] = nloc; b.st[1] = nx; }
        const unsigned old = xb_add(&bar[XB_XSUB(b.x)], 1u);
        const unsigned gen = old / nloc;
        if (old + 1u == (gen + 1u) * nloc) {
            __builtin_amdgcn_fence(__ATOMIC_RELEASE, "agent");
            asm volatile("s_waitcnt vmcnt(0)" ::: "memory");
            const unsigned og = xb_add(&bar[XB_TOP], 1u);
            const unsigned tg = og / nx;
            if (og + 1u == (tg + 1u) * nx) xb_add(&bar[XB_TOPGEN], 1u);
            else XB_SPIN(xb_ld(&bar[XB_TOPGEN]) == tg, bar);
            __builtin_amdgcn_fence(__ATOMIC_ACQUIRE, "agent");
            xb_add(&bar[XB_XGEN(b.x)], 1u);
            asm volatile("s_waitcnt vmcnt(0)" ::: "memory");
        } else {
            XB_SPIN(xb_ld(&bar[XB_XGEN(b.x)]) == gen, bar);
            __builtin_amdgcn_fence(__ATOMIC_ACQUIRE, "agent");
            asm volatile("s_waitcnt vmcnt(0)" ::: "memory");
        }
    }
    __syncthreads();
}

constexpr int NWAVES = 8;
constexpr int RING_OFF = 0, RING_BYTES = 131072;
constexpr int LDSCTL_OFF = RING_BYTES, MISC_OFF = LDSCTL_OFF + 320;
constexpr int SEG_OFF = LDSCTL_OFF + 1024;
constexpr int TILE_E_OFF = LDSCTL_OFF + 2048;
constexpr int TILE_RB_OFF = TILE_E_OFF + 1024;
constexpr int ECAP = M;
constexpr int NRMP_OFF = LDSCTL_OFF + 4096;
constexpr int LDS_BYTES = 147456;
constexpr int ATT_QW_OFF = LDSCTL_OFF + 512;
static_assert(att::PAIR_RING == RING_BYTES && att::PAIR_LDS <= LDS_BYTES && att::P_OFF_L >= ATT_QW_OFF + 64 && att::LDS_BYTES <= RING_BYTES && TILE_E_OFF + NTILE_MAX * 4 <= LDS_BYTES, "LDS map");

struct Args { const float* in[19]; float* out; unsigned char* ws; int ph_lo, ph_hi, li, pad; };

struct Ctx {
    LAS unsigned char* lds; int tid, lane, wave, G, gw, NGW;
    const float *x, *attn_g, *w_in, *fbias, *lq1, *lk1, *lq2, *lk2, *subg, *w_out, *ffn_g, *wg, *bg, *we, *be, *wgate, *wup, *wdown, *fin_g;
    float* out;
    bf16* A1; bf16* WIN; bf16* WOUT; float* BIAS; bf16* QKV; bf16* A2; bf16* DT; bf16* H1;
    int* tok_e; int* tok_pos; float* tok_gate; float* rstd; float* rowgate; int* rowtok; int* etok; float* egate; float* WR; bf16* XG; bf16* HB; bf16* Y; bf16* WGU; bf16* WD; unsigned* cnt; unsigned* nrm;
};
__device__ __forceinline__ float wave_sum(float v) {
#pragma unroll
    for (int o = 1; o < 64; o <<= 1) v += __shfl_xor(v, o);
    return v;
}
typedef unsigned v2u __attribute__((ext_vector_type(2)));

__device__ __forceinline__ void p0_row2(const Ctx& C, int t0, int t1, const LAS float* wf) {
    const int lane = C.lane; const float* xr0 = C.x + (size_t)t0 * DM; const float* xr1 = C.x + (size_t)t1 * DM;
    f32x4 v0[8], v1[8]; float ss0 = 0.f, ss1 = 0.f;
#pragma unroll
    for (int j = 0; j < 8; ++j) { v0[j] = *(const f32x4*)(xr0 + j * 256 + lane * 4); v1[j] = *(const f32x4*)(xr1 + j * 256 + lane * 4); }
#pragma unroll
    for (int j = 0; j < 8; ++j) { ss0 += (v0[j].x * v0[j].x + v0[j].y * v0[j].y) + (v0[j].z * v0[j].z + v0[j].w * v0[j].w); ss1 += (v1[j].x * v1[j].x + v1[j].y * v1[j].y) + (v1[j].z * v1[j].z + v1[j].w * v1[j].w); }
    const float r0 = 1.f / sqrtf(wave_sum(ss0) * (1.f / DM) + 1e-6f), r1 = 1.f / sqrtf(wave_sum(ss1) * (1.f / DM) + 1e-6f);
    float fl0[8] = {0.f, 0.f, 0.f, 0.f, 0.f, 0.f, 0.f, 0.f}, fl1[8] = {0.f, 0.f, 0.f, 0.f, 0.f, 0.f, 0.f, 0.f};
#pragma unroll
    for (int j = 0; j < 8; ++j) {
        const f32x4 gg = *(const f32x4*)(C.attn_g + j * 256 + lane * 4);
        v0[j] = v0[j] * r0 * gg; v1[j] = v1[j] * r1 * gg;
        v2u o; o.x = pk2(v0[j].x, v0[j].y); o.y = pk2(v0[j].z, v0[j].w);
        *(v2u*)(C.A1 + (size_t)t0 * DM + j * 256 + lane * 4) = o;
        o.x = pk2(v1[j].x, v1[j].y); o.y = pk2(v1[j].z, v1[j].w);
        *(v2u*)(C.A1 + (size_t)t1 * DM + j * 256 + lane * 4) = o;
#pragma unroll
        for (int h = 0; h < 8; ++h) { const f32x4 w4 = *(const LAS f32x4*)(wf + h * DM + j * 256 + lane * 4);
            fl0[h] += (v0[j].x * w4.x + v0[j].y * w4.y) + (v0[j].z * w4.z + v0[j].w * w4.w); fl1[h] += (v1[j].x * w4.x + v1[j].y * w4.y) + (v1[j].z * w4.z + v1[j].w * w4.w); }
        asm volatile("" ::: "memory");
    }
#pragma unroll
    for (int h = 0; h < 8; ++h) { fl0[h] = wave_sum(fl0[h]); fl1[h] = wave_sum(fl1[h]); }
    float z0 = fl0[0], z1 = fl1[0];
#pragma unroll
    for (int h = 1; h < 8; ++h) { z0 = (lane == h) ? fl0[h] : z0; z1 = (lane == h) ? fl1[h] : z1; }
    if (lane < 8) { z0 += C.fbias[lane]; z1 += C.fbias[lane];
        C.BIAS[(size_t)((t0 / S) * 8 + lane) * S + (t0 % S)] = fminf(z0, 0.f) - log1pf(expf(-fabsf(z0)));
        C.BIAS[(size_t)((t1 / S) * 8 + lane) * S + (t1 % S)] = fminf(z1, 0.f) - log1pf(expf(-fabsf(z1))); }
}
__device__ __forceinline__ void tr_item(const float* src, int ld, int k0, int c0, bf16* dst, int K, int r0, LAS float* scr, int lane) {
    { f32x4 v[8];
#pragma unroll
      for (int i = 0; i < 8; ++i) v[i] = *(const f32x4*)(src + (size_t)(k0 + 8 * i + (lane >> 3)) * ld + c0 + 4 * (lane & 7));
#pragma unroll
      for (int i = 0; i < 8; ++i) { LAS float* d = scr + (8 * i + (lane >> 3)) * 33 + 4 * (lane & 7); d[0] = v[i].x; d[1] = v[i].y; d[2] = v[i].z; d[3] = v[i].w; } }
    LDS_WAIT(); asm volatile("" ::: "memory");
    const int c = lane & 7;
#pragma unroll
    for (int j = 0; j < 4; ++j) { const int n = (lane >> 3) + 8 * j; const LAS float* s = scr + (8 * c) * 33 + n;
        v4u o; o.x = pk2(s[0 * 33], s[1 * 33]); o.y = pk2(s[2 * 33], s[3 * 33]); o.z = pk2(s[4 * 33], s[5 * 33]); o.w = pk2(s[6 * 33], s[7 * 33]);
        *(GAS v4u*)(dst + (size_t)(r0 + n) * K + k0 + 8 * c) = o; }
    LDS_WAIT(); asm volatile("" ::: "memory");
}
__device__ __forceinline__ void p0_prologue(const Ctx& C) {
    LAS float* scr = (LAS float*)(C.lds + RING_OFF + C.wave * 16384);
    constexpr int I_WIN = 32 * 192, I_WOUT = 32 * 64, I_ALL = I_WIN + I_WOUT;
    for (int it = C.gw; it < I_ALL; it += C.NGW) {
        int r = it;
        if (r < I_WIN) { const int kb = r / 192, nb = r % 192; tr_item(C.w_in, NCOL, 64 * kb, nb < 96 ? 32 * nb : 32 * nb + 8, C.WIN, DM, 32 * nb, scr, C.lane); continue; } r -= I_WIN;
        { const int kb = r / 64, nb = r % 64; tr_item(C.w_out, DM, 64 * kb, 32 * nb, C.WOUT, DM, 32 * nb, scr, C.lane); }
    }
    __syncthreads();
    { LAS float* wf = (LAS float*)(C.lds + RING_OFF);
      for (int k = C.tid; k < DM; k += NWAVES * 64) { const float* wr = C.w_in + (size_t)k * NCOL + FCOL; const f32x4 w0 = *(const f32x4*)wr, w1 = *(const f32x4*)(wr + 4);
          wf[0 * DM + k] = w0.x; wf[1 * DM + k] = w0.y; wf[2 * DM + k] = w0.z; wf[3 * DM + k] = w0.w; wf[4 * DM + k] = w1.x; wf[5 * DM + k] = w1.y; wf[6 * DM + k] = w1.z; wf[7 * DM + k] = w1.w; }
      __syncthreads();
      for (int t = C.gw; t < M; t += 2 * C.NGW) { const int t1 = t + C.NGW; p0_row2(C, t, t1 < M ? t1 : t, wf); } }
    const int gt = C.gw * 64 + C.lane, NGT = C.NGW * 64;
    for (int i = gt; i < 4 * S; i += NGT) { const int h = i / S, s = i % S; C.BIAS[(size_t)(16 + h) * S + s] = -exp2f(-2.f * (float)(h + 1)) * (float)s * ATT_ISCALE; }
    for (int i = gt; i < 64 * 5 * 2 * 64; i += NGT) { const int ln = i & 63, hl = (i >> 6) & 1, b = (i >> 7) % 5, kk = (i >> 7) / 5, c = 16 * b + (ln & 15);
        unsigned w[4];
#pragma unroll
        for (int jp = 0; jp < 4; ++jp) { unsigned pk = 0;
#pragma unroll
            for (int q = 0; q < 2; ++q) { const int k = 32 * kk + 8 * (ln >> 4) + 2 * jp + q;
                const float v = (c < 8 ? C.wg[(size_t)k * 8 + c] : (c < 72 ? C.we[(size_t)k * NE + c - 8] : 0.f)) * C.ffn_g[k];
                const unsigned h = f2bf(v); const unsigned l = f2bf(v - __uint_as_float(h << 16));
                pk |= (hl ? l : h) << (16 * q); }
            w[jp] = pk; }
        ((v4u*)C.WR)[i] = (v4u){w[0], w[1], w[2], w[3]}; }
}
__device__ __forceinline__ void p1_cumsum(const Ctx& C) {
    if (blockIdx.x >= 16) return;
    float* p = C.BIAS + (size_t)blockIdx.x * S + C.tid * 16; LAS float* wt = (LAS float*)(C.lds + RING_OFF);
    float loc[16]; float s = 0.f;
    { const f32x4 a = *(const f32x4*)p, b = *(const f32x4*)(p + 4), c = *(const f32x4*)(p + 8), d = *(const f32x4*)(p + 12);
      loc[0] = a.x; loc[1] = a.y; loc[2] = a.z; loc[3] = a.w; loc[4] = b.x; loc[5] = b.y; loc[6] = b.z; loc[7] = b.w; loc[8] = c.x; loc[9] = c.y; loc[10] = c.z; loc[11] = c.w; loc[12] = d.x; loc[13] = d.y; loc[14] = d.z; loc[15] = d.w; }
#pragma unroll
    for (int i = 0; i < 16; ++i) { s += loc[i]; loc[i] = s; }
    float inc = s;
#pragma unroll
    for (int o = 1; o < 64; o <<= 1) { const float q = __shfl_up(inc, o); if (C.lane >= o) inc += q; }
    if (C.lane == 63) wt[C.wave] = inc;
    __syncthreads();
    float base = inc - s;
    for (int w = 0; w < C.wave; ++w) base += wt[w];
#pragma unroll
    for (int i = 0; i < 16; ++i) loc[i] = (base + loc[i]) * ATT_ISCALE;
    *(f32x4*)p = (f32x4){loc[0], loc[1], loc[2], loc[3]}; *(f32x4*)(p + 4) = (f32x4){loc[4], loc[5], loc[6], loc[7]};
    *(f32x4*)(p + 8) = (f32x4){loc[8], loc[9], loc[10], loc[11]}; *(f32x4*)(p + 12) = (f32x4){loc[12], loc[13], loc[14], loc[15]};
    __syncthreads();
}
__device__ __forceinline__ void p_norms(const Ctx& C) {
    const int lane = C.lane, b = C.gw & 1;
    float mx[8] = {0.f, 0.f, 0.f, 0.f, 0.f, 0.f, 0.f, 0.f};
    for (int rr = C.gw >> 1; rr < S; rr += C.NGW >> 1) {
        const bf16* row = C.QKV + (size_t)(b * S + rr) * NQKV + 8 * lane;
#pragma unroll
        for (int i = 0; i < 8; ++i) { const v4u w = *(const v4u*)(row + (i < 4 ? 512 * i : 1024 + 512 * i));
            float ss = 0.f;
#pragma unroll
            for (int c = 0; c < 4; ++c) { const float lo = __uint_as_float(w[c] << 16), hi = __uint_as_float(w[c] & 0xffff0000u); ss += lo * lo + hi * hi; }
            ss += __shfl_xor(ss, 1); ss += __shfl_xor(ss, 2); ss += __shfl_xor(ss, 4); ss += __shfl_xor(ss, 8);
            mx[i] = fmaxf(mx[i], ss); }
    }
    if ((lane & 15) == 0) {
#pragma unroll
        for (int i = 0; i < 8; ++i) atomicMax(C.nrm + b * 32 + 4 * i + (lane >> 4), __float_as_uint(mx[i]));
    }
}
__device__ __forceinline__ void p3_combine(const Ctx& C) {
    const int lane = C.lane;
    const float s1 = wave_sum(C.lq1[lane] * C.lk1[lane] + C.lq1[lane + 64] * C.lk1[lane + 64]);
    const float s2 = wave_sum(C.lq2[lane] * C.lk2[lane] + C.lq2[lane + 64] * C.lk2[lane + 64]);
    const float lam = expf(s1) - expf(s2) + 0.2f;
    const f32x4 gg = *(const f32x4*)(C.subg + lane * 4);
    for (int idx = C.gw; idx < M * 4; idx += C.NGW) {
        const int t = idx >> 2, h = idx & 3;
        const bf16* p = C.DT + (size_t)t * DM + h * 512 + lane * 4;
        const v2u a = *(const v2u*)p, b = *(const v2u*)(p + 256);
        f32x4 d;
        d.x = __uint_as_float(a.x << 16) - lam * __uint_as_float(b.x << 16); d.y = __uint_as_float(a.x & 0xffff0000u) - lam * __uint_as_float(b.x & 0xffff0000u);
        d.z = __uint_as_float(a.y << 16) - lam * __uint_as_float(b.y << 16); d.w = __uint_as_float(a.y & 0xffff0000u) - lam * __uint_as_float(b.y & 0xffff0000u);
        const float ss = wave_sum((d.x * d.x + d.y * d.y) + (d.z * d.z + d.w * d.w));
        const float r = 0.8f / sqrtf(ss * (1.f / 256.f) + 1e-5f);
        v2u o; o.x = pk2(d.x * r * gg.x, d.y * r * gg.y); o.y = pk2(d.z * r * gg.z, d.w * r * gg.w);
        *(v2u*)(C.A2 + (size_t)t * DM + 1024 + h * 256 + lane * 4) = o;
    }
}
__device__ __forceinline__ void p5a_router(const Ctx& C) {
    const int w = C.wave, th = w & 1, ks = w >> 1;
    LAS float* R1 = (LAS float*)(C.lds + RING_OFF);
    LAS float* SS = (LAS float*)(C.lds + RING_OFF + 81920);
    LAS float* RS = SS + 512;
    LAS float* lg = (LAS float*)(C.lds + RING_OFF + 86016);
    for (int tl = (int)blockIdx.x; tl < M / 64; tl += C.G) {
        int lane = C.lane; asm volatile("" : "+v"(lane));
        const int r = lane & 15, g = lane >> 4;
        const int t0 = tl * 64;
        f32x4 acc[2][5];
#pragma unroll
        for (int T = 0; T < 2; ++T)
#pragma unroll
            for (int b = 0; b < 5; ++b) acc[T][b] = (f32x4){0.f, 0.f, 0.f, 0.f};
        float ss[2] = {0.f, 0.f};
        const bf16* hb = C.H1 + (size_t)(t0 + 32 * th) * DM + 512 * ks; const unsigned ho = (unsigned)(r * DM + 8 * g);
        const v4u* wp = (const v4u*)C.WR + (size_t)(16 * ks) * 10 * 64 + lane;
        v4u a[4][2], tb[10];
#define RT_LA(slot, j_) do { _Pragma("unroll") for (int T = 0; T < 2; ++T) a[slot][T] = *(const v4u*)(hb + (ho + (unsigned)(16 * T * DM + 32 * (j_)))); } while (0)
        RT_LA(0, 0);
#pragma unroll
        for (int q = 0; q < 10; ++q) tb[q] = wp[q * 64];
        RT_LA(1, 1); RT_LA(2, 2); RT_LA(3, 3);
#pragma unroll
        for (int j = 0; j < 16; ++j) {
            __builtin_amdgcn_sched_barrier(0);
#pragma unroll
            for (int T = 0; T < 2; ++T)
#pragma unroll
                for (int c = 0; c < 4; ++c) { const unsigned x = a[j & 3][T][c]; const float lo = __uint_as_float(x << 16), hi = __uint_as_float(x & 0xffff0000u); ss[T] += lo * lo + hi * hi; }
#pragma unroll
            for (int b = 0; b < 5; ++b) {
#pragma unroll
                for (int T = 0; T < 2; ++T) acc[T][b] = __builtin_amdgcn_mfma_f32_16x16x32_bf16(__builtin_bit_cast(bf16x8, a[j & 3][T]), __builtin_bit_cast(bf16x8, tb[2 * b]), acc[T][b], 0, 0, 0);
#pragma unroll
                for (int T = 0; T < 2; ++T) acc[T][b] = __builtin_amdgcn_mfma_f32_16x16x32_bf16(__builtin_bit_cast(bf16x8, a[j & 3][T]), __builtin_bit_cast(bf16x8, tb[2 * b + 1]), acc[T][b], 0, 0, 0);
                __builtin_amdgcn_sched_barrier(0);
                if (j + 1 < 16) { tb[2 * b] = wp[((j + 1) * 10 + 2 * b) * 64]; tb[2 * b + 1] = wp[((j + 1) * 10 + 2 * b + 1) * 64]; }
                __builtin_amdgcn_sched_barrier(0);
            }
            if (j + 4 < 16) RT_LA(j & 3, j + 4);
        }
#undef RT_LA
        asm volatile("" ::: "memory");
#pragma unroll
        for (int T = 0; T < 2; ++T) { ss[T] += __int_as_float(__builtin_amdgcn_ds_bpermute((lane ^ 16) << 2, __float_as_int(ss[T]))); ss[T] += __int_as_float(__builtin_amdgcn_ds_bpermute((lane ^ 32) << 2, __float_as_int(ss[T])));
            if (lane < 16) SS[ks * 64 + 16 * (2 * th + T) + lane] = ss[T]; }
        if (ks >= 2) {
#pragma unroll
            for (int T = 0; T < 2; ++T)
#pragma unroll
                for (int b = 0; b < 5; ++b)
#pragma unroll
                    for (int i = 0; i < 4; ++i) R1[((th * 2 + (ks - 2)) * 40 + (T * 5 + b) * 4 + i) * 64 + lane] = acc[T][b][i];
        }
        __syncthreads();
        if (ks < 2) {
#pragma unroll
            for (int T = 0; T < 2; ++T)
#pragma unroll
                for (int b = 0; b < 5; ++b)
#pragma unroll
                    for (int i = 0; i < 4; ++i) { LAS float* q = R1 + ((th * 2 + ks) * 40 + (T * 5 + b) * 4 + i) * 64 + lane; *q = acc[T][b][i] + *q; }
            if (w == 0) { const float s = (SS[lane] + SS[64 + lane]) + (SS[128 + lane] + SS[192 + lane]);
                const float rs = 1.f / sqrtf(s * (1.f / DM) + 1e-6f); RS[lane] = rs; C.rstd[t0 + lane] = rs; }
        }
        __syncthreads();
#pragma unroll
        for (int m = 0; m < 10; ++m) { const int sl = w + 8 * m, T = sl / 20, b = (sl % 20) >> 2, i = sl & 3, tok = 16 * T + 4 * g + i, s2 = sl % 40, hh = sl / 40;
            const float v = R1[((hh * 2 + 0) * 40 + s2) * 64 + lane] + R1[((hh * 2 + 1) * 40 + s2) * 64 + lane];
            lg[tok * 81 + 16 * b + r] = v * RS[tok]; }
        __syncthreads();
        if (w == 0) {
            const int t = t0 + lane; const LAS float* row = lg + lane * 81;
            float gmax = -__builtin_inff(); int gi = 0; float gl[8];
#pragma unroll
            for (int j = 0; j < 8; ++j) { gl[j] = row[j] + C.bg[j]; if (gl[j] > gmax) { gmax = gl[j]; gi = j; } }
            float gs = 0.f;
#pragma unroll
            for (int j = 0; j < 8; ++j) gs += expf(gl[j] - gmax);
            const float gprob = 1.f / gs;
            float l1 = -__builtin_inff(), l2 = -__builtin_inff(); int i1 = 0, i2 = 0;
#pragma unroll
            for (int j = 0; j < 8; ++j) { const float q = row[8 + gi * 8 + j] + C.be[gi * 8 + j];
                if (q > l1) { l2 = l1; i2 = i1; l1 = q; i1 = j; } else if (q > l2) { l2 = q; i2 = j; } }
            const float e2 = expf(l2 - l1), g1 = gprob / (1.f + e2), g2 = gprob * e2 / (1.f + e2);
            const int ea = gi * 8 + i1, eb = gi * 8 + i2;
            LAS unsigned* lc = (LAS unsigned*)(C.lds + RING_OFF + 110592); LAS unsigned* gb = lc + 64;
            lc[lane] = 0u; asm volatile("" ::: "memory");
            const unsigned la = __hip_atomic_fetch_add(lc + ea, 1u, __ATOMIC_RELAXED, __HIP_MEMORY_SCOPE_WORKGROUP); asm volatile("" ::: "memory");
            const unsigned lb = __hip_atomic_fetch_add(lc + eb, 1u, __ATOMIC_RELAXED, __HIP_MEMORY_SCOPE_WORKGROUP); asm volatile("" ::: "memory");
            const unsigned ne = lc[lane]; unsigned gbase = 0u; if (ne) gbase = atomicAdd(C.cnt + lane * CNT_STRIDE, ne);
            gb[lane] = gbase; asm volatile("" ::: "memory");
            const unsigned pa = gb[ea] + la, pb = gb[eb] + lb;
            C.tok_e[t * 2] = ea; C.tok_e[t * 2 + 1] = eb; C.tok_pos[t * 2] = (int)pa; C.tok_pos[t * 2 + 1] = (int)pb; C.etok[ea * ECAP + (int)pa] = t; C.etok[eb * ECAP + (int)pb] = t; C.tok_gate[t * 2] = g1; C.tok_gate[t * 2 + 1] = g2;
        }
        { asm volatile("" ::: "memory"); f32x4 gg[4][2];
#pragma unroll
            for (int j = 0; j < 4; ++j) { gg[j][0] = *(const f32x4*)(C.ffn_g + j * 512 + lane * 8); gg[j][1] = *(const f32x4*)(C.ffn_g + j * 512 + lane * 8 + 4); }
            const int r0 = w ? 9 * (w - 1) : 63, nr = w ? 9 : 1;
#pragma unroll 3
            for (int i = 0; i < nr; ++i) { const int rr = r0 + i; const float rsr = RS[rr]; const bf16* src = C.H1 + (size_t)(t0 + rr) * DM + lane * 8; bf16* dst = C.A1 + (size_t)(t0 + rr) * DM + lane * 8;
#pragma unroll
                for (int j = 0; j < 4; ++j) { const v4u x = *(const v4u*)(src + j * 512); const f32x4 g0 = gg[j][0], g1 = gg[j][1];
                    v4u o; o.x = pk2(__uint_as_float(x.x << 16) * rsr * g0.x, __uint_as_float(x.x & 0xffff0000u) * rsr * g0.y); o.y = pk2(__uint_as_float(x.y << 16) * rsr * g0.z, __uint_as_float(x.y & 0xffff0000u) * rsr * g0.w);
                    o.z = pk2(__uint_as_float(x.z << 16) * rsr * g1.x, __uint_as_float(x.z & 0xffff0000u) * rsr * g1.y); o.w = pk2(__uint_as_float(x.w << 16) * rsr * g1.z, __uint_as_float(x.w & 0xffff0000u) * rsr * g1.w);
                    *(v4u*)(dst + j * 512) = o; } } }
        __syncthreads();
    }
}
__device__ __forceinline__ void build_seg(const Ctx& C) {
    LAS int* seg = (LAS int*)(C.lds + SEG_OFF); LAS int* tile_e = (LAS int*)(C.lds + TILE_E_OFF);
    if (C.wave == 0) { const int p = (int)((C.cnt[C.lane * CNT_STRIDE] + 255u) & ~255u); int inc = p;
#pragma unroll
        for (int o = 1; o < 64; o <<= 1) { const int q = __shfl_up(inc, o); if (C.lane >= o) inc += q; }
        seg[C.lane] = inc - p; if (C.lane == 63) seg[NE] = inc; }
    __syncthreads();
    if (C.tid < NTILE_MAX) { const int row = C.tid * 256; int e = 0; for (int j = 1; j < NE; ++j) if (seg[j] <= row) e = j; tile_e[C.tid] = e; ((LAS int*)(C.lds + TILE_RB_OFF))[C.tid] = e * ECAP - seg[e]; }
    __syncthreads();
}
__device__ __forceinline__ void p5b_dispatch(const Ctx& C) {
    const LAS int* seg = (const LAS int*)(C.lds + SEG_OFF);
    for (int t = C.gw * 64 + C.lane; t < M; t += C.NGW * 64) {
        const int ra = seg[C.tok_e[t * 2]] + C.tok_pos[t * 2], rb = seg[C.tok_e[t * 2 + 1]] + C.tok_pos[t * 2 + 1];
        C.rowgate[ra] = C.tok_gate[t * 2]; C.rowgate[rb] = C.tok_gate[t * 2 + 1]; C.rowtok[ra] = t; C.rowtok[rb] = t;
    }
}
__device__ __forceinline__ void p8_final(const Ctx& C) {
    const LAS int* seg = (const LAS int*)(C.lds + SEG_OFF); const int lane = C.lane;
    for (int t0 = C.gw * 2; t0 < M; t0 += C.NGW * 2) {
        int ra[2], rb[2]; float ga[2], gb[2];
#pragma unroll
        for (int u = 0; u < 2; ++u) { const int t = t0 + u; ra[u] = seg[C.tok_e[t * 2]] + C.tok_pos[t * 2]; rb[u] = seg[C.tok_e[t * 2 + 1]] + C.tok_pos[t * 2 + 1]; ga[u] = C.tok_gate[t * 2]; gb[u] = C.tok_gate[t * 2 + 1]; }
        f32x4 v[2][8]; float ss[2] = {0.f, 0.f};
#pragma unroll
        for (int u = 0; u < 2; ++u) { const bf16* xr = C.H1 + (size_t)(t0 + u) * DM; const bf16* ya = C.Y + (size_t)ra[u] * DM; const bf16* yb = C.Y + (size_t)rb[u] * DM;
#pragma unroll
            for (int j = 0; j < 8; ++j) { const v2u h = *(const v2u*)(xr + j * 256 + lane * 4), a = *(const v2u*)(ya + j * 256 + lane * 4), b = *(const v2u*)(yb + j * 256 + lane * 4);
                v[u][j].x = __uint_as_float(h.x << 16) + (ga[u] * __uint_as_float(a.x << 16) + gb[u] * __uint_as_float(b.x << 16)); v[u][j].y = __uint_as_float(h.x & 0xffff0000u) + (ga[u] * __uint_as_float(a.x & 0xffff0000u) + gb[u] * __uint_as_float(b.x & 0xffff0000u));
                v[u][j].z = __uint_as_float(h.y << 16) + (ga[u] * __uint_as_float(a.y << 16) + gb[u] * __uint_as_float(b.y << 16)); v[u][j].w = __uint_as_float(h.y & 0xffff0000u) + (ga[u] * __uint_as_float(a.y & 0xffff0000u) + gb[u] * __uint_as_float(b.y & 0xffff0000u));
                ss[u] += (v[u][j].x * v[u][j].x + v[u][j].y * v[u][j].y) + (v[u][j].z * v[u][j].z + v[u][j].w * v[u][j].w); } }
#pragma unroll
        for (int u = 0; u < 2; ++u) { const float r = 1.f / sqrtf(wave_sum(ss[u]) * (1.f / DM) + 1e-6f);
#pragma unroll
            for (int j = 0; j < 8; ++j) *(f32x4*)(C.out + (size_t)(t0 + u) * DM + j * 256 + lane * 4) = v[u][j] * r * *(const f32x4*)(C.fin_g + j * 256 + lane * 4); }
    }
}

__global__ void __launch_bounds__(NWAVES * 64, 2) mk_fwd(Args args) {
    extern __shared__ __attribute__((aligned(16))) unsigned char lds[];
    Ctx C;
    C.lds = (LAS unsigned char*)lds; C.tid = threadIdx.x; C.lane = C.tid & 63; C.wave = __builtin_amdgcn_readfirstlane(C.tid >> 6);
    C.G = gridDim.x; C.gw = (int)blockIdx.x * NWAVES + C.wave; C.NGW = C.G * NWAVES;
    C.x = args.in[0]; C.attn_g = args.in[1]; C.w_in = args.in[2]; C.fbias = args.in[3]; C.lq1 = args.in[4]; C.lk1 = args.in[5]; C.lq2 = args.in[6]; C.lk2 = args.in[7];
    C.subg = args.in[8]; C.w_out = args.in[9]; C.ffn_g = args.in[10]; C.wg = args.in[11]; C.bg = args.in[12]; C.we = args.in[13]; C.be = args.in[14];
    C.wgate = args.in[15]; C.wup = args.in[16]; C.wdown = args.in[17]; C.fin_g = args.in[18]; C.out = args.out;
    unsigned char* ws = args.ws;
    C.A1 = (bf16*)(ws + WS_A1); C.WIN = (bf16*)(ws + WS_WIN); C.WOUT = (bf16*)(ws + WS_WOUT); C.BIAS = (float*)(ws + WS_BIAS); C.QKV = (bf16*)(ws + WS_QKV);
    C.A2 = (bf16*)(ws + WS_A2); C.DT = (bf16*)(ws + WS_DT); C.H1 = (bf16*)(ws + WS_H1);
    C.tok_e = (int*)(ws + WS_ROUTE); C.tok_pos = C.tok_e + 2 * M; C.tok_gate = (float*)(C.tok_pos + 2 * M); C.rstd = C.tok_gate + 2 * M; C.rowgate = C.rstd + M; C.rowtok = (int*)(C.rowgate + YROWS);
    C.etok = (int*)(ws + WS_XG); C.egate = (float*)(ws + WS_XG) + (size_t)NE * ECAP;
    C.WR = (float*)(ws + WS_WR); C.XG = (bf16*)(ws + WS_XG); C.HB = (bf16*)(ws + WS_HBUF); C.Y = (bf16*)(ws + WS_Y); C.WGU = (bf16*)(ws + WS_WGU); C.WD = (bf16*)(ws + WS_WD);
    C.cnt = (unsigned*)(ws + WS_CTL) + CW_CNT; C.nrm = (unsigned*)(ws + WS_CTL) + CW_NRM;
    volatile LAS unsigned* MISC = (volatile LAS unsigned*)(C.lds + MISC_OFF);
    for (int u = C.tid; u < (LDS_BYTES - LDSCTL_OFF) / 4; u += NWAVES * 64) ((LAS unsigned*)(C.lds + LDSCTL_OFF))[u] = 0u;
    __syncthreads();
    XcdBarrier bar = xcd_barrier_post((unsigned*)(ws + WS_CTL) + CW_BAR + args.li * XCD_BAR_WORDS, MISC + 8);
    const int lo = args.ph_lo, hi = args.ph_hi;
#define IN(k) (lo <= (k) && (k) < hi)
#define SEAM(k) do { if (IN(k) && IN((k) + 1)) xcd_barrier(bar); } while (0)
#ifndef PROBE_MASK
#define PROBE_MASK 0u
#endif
#ifndef PROBE_REP
#define PROBE_REP 0
#endif
#define TWICE(k) (((PROBE_MASK) >> (k)) & 1u)
#ifdef PROBE_TS
    volatile LAS unsigned long long* TSW = (volatile LAS unsigned long long*)(C.lds + LDSCTL_OFF + 15360);
#define TS(k) do { if (blockIdx.x == 0 && C.tid == 0) TSW[k] = __builtin_amdgcn_s_memrealtime(); } while (0)
#else
#define TS(k) do { } while (0)
#endif
    TS(0);

    if (IN(0)) { p0_prologue(C); if (TWICE(0)) { xcd_barrier(bar); p0_prologue(C); } } SEAM(0); TS(1);
    if (IN(1)) {
        p1_cumsum(C);
        pg8::Gemm g{C.A1, C.WIN, M, NQKV, DM}; pg8::StaticOrder So; So.init(M, NQKV, C.G, (int)blockIdx.x);
        pg8::EpiQKV E{C.QKV, NQKV, (PG8_LAS float*)(C.lds + NRMP_OFF), C.nrm};
        pg8::gemm_phase<pg8::EpiQKV, pg8::StaticOrder, true, true>(C.lds + RING_OFF, g, So, E);
        if (TWICE(1)) { xcd_barrier(bar); pg8::gemm_phase<pg8::EpiQKV, pg8::StaticOrder, true, true>(C.lds + RING_OFF, g, So, E); }
    } SEAM(1); TS(2);
    if (IN(3)) { const att::Tensors T{(const att::bf16*)C.QKV, (att::bf16*)C.A2, (att::bf16*)C.DT, C.BIAS, C.nrm};
        unsigned* qh = (unsigned*)(ws + WS_CTL) + CW_QHEAD; volatile __attribute__((address_space(3))) int* qw = (volatile __attribute__((address_space(3))) int*)(C.lds + RING_OFF + ATT_QW_OFF);
        att::attn_part<false>((char*)lds + RING_OFF, T, qh, qw); TS(3); att::attn_part<true>((char*)lds + RING_OFF, T, qh + 64, qw); if (TWICE(3)) { xcd_barrier(bar); att::attn_part<false>((char*)lds + RING_OFF, T, qh + 128, qw); att::attn_part<true>((char*)lds + RING_OFF, T, qh + 192, qw); } } SEAM(3); TS(4);
    if (IN(4)) { p3_combine(C); if (TWICE(4)) { xcd_barrier(bar); p3_combine(C); } } SEAM(4); TS(5);
    if (IN(5)) {
        pg8::Gemm g{C.A2, C.WOUT, M, DM, DM}; pg8::StaticOrder So; So.init(M, DM, C.G, (int)blockIdx.x);
        pg8::EpiResBf16 E{C.x, C.H1, DM};
        pg8::gemm_phase<pg8::EpiResBf16, pg8::StaticOrder, true, true>(C.lds + RING_OFF, g, So, E);
        if (TWICE(5)) { xcd_barrier(bar); pg8::gemm_phase<pg8::EpiResBf16, pg8::StaticOrder, true, true>(C.lds + RING_OFF, g, So, E); }
    } SEAM(5); TS(6);
    if (IN(6)) { p5a_router(C); } SEAM(6); TS(7);
#ifdef PROBE_IDLE
    { const unsigned long long t0 = __builtin_amdgcn_s_memrealtime(); while (__builtin_amdgcn_s_memrealtime() - t0 < (unsigned long long)(PROBE_IDLE) * 100ull) __builtin_amdgcn_s_sleep(32); }
#endif
    if (hi > 7) build_seg(C);
#ifdef PROBE_CLK
    unsigned long long ck0 = 0, cr0 = 0, ckd = 0, crd = 1;
    if (IN(PROBE_CLK)) { ck0 = __builtin_amdgcn_s_memtime(); cr0 = __builtin_amdgcn_s_memrealtime(); }
#endif
    if (IN(8)) {
        const PG8_LAS int* tile_e = (const PG8_LAS int*)(C.lds + TILE_E_OFF); const int ntile = ((const LAS int*)(C.lds + SEG_OFF))[NE] >> 8;
        #if defined(PROBE_HOT) && PROBE_HOT >= 3
        pg8::GemmW g{C.A1, DM, DFF, C.etok, args.li > 0 ? 255 : M - 1, (const PG8_LAS int*)(C.lds + TILE_RB_OFF)};
#else
        pg8::GemmW g{C.A1, DM, DFF, C.etok, M - 1, (const PG8_LAS int*)(C.lds + TILE_RB_OFF)};
#endif
        pg8::GroupedOrderW<0> So{ntile * 8, C.G, (int)blockIdx.x, tile_e, C.wgate, C.wup, args.li > 0};
        pg8::EpiSwiglu E{args.li > 0 ? C.XG : C.HB};
        pg8::gemm_phase_wf32<pg8::EpiSwiglu, pg8::GroupedOrderW<0>, true, true>(C.lds + RING_OFF, g, So, E);
    } SEAM(8); TS(8);
    if (IN(9)) {
        const PG8_LAS int* tile_e = (const PG8_LAS int*)(C.lds + TILE_E_OFF); const int ntile = ((const LAS int*)(C.lds + SEG_OFF))[NE] >> 8;
        pg8::GemmW g{C.HB, DFF, DM, nullptr, 0, nullptr}; pg8::GroupedOrderW<1> So{ntile * 8, C.G, (int)blockIdx.x, tile_e, C.wdown, nullptr};
        pg8::EpiDown E{C.Y};
        pg8::gemm_phase_wf32<pg8::EpiDown, pg8::GroupedOrderW<1>, true, false>(C.lds + RING_OFF, g, So, E);
    } SEAM(9); TS(9);
#ifdef PROBE_CLK
    if (IN(PROBE_CLK)) { ckd = __builtin_amdgcn_s_memtime() - ck0; crd = __builtin_amdgcn_s_memrealtime() - cr0; }
#endif
    if (IN(10)) { p8_final(C); if (TWICE(10)) { xcd_barrier(bar); p8_final(C); } }
#ifdef PROBE_CLK
    if (blockIdx.x == 0) { const unsigned long long want = ckd * 100ull / (crd ? crd : 1);
        const unsigned long long t0 = __builtin_amdgcn_s_memrealtime(); while (__builtin_amdgcn_s_memrealtime() - t0 < want) __builtin_amdgcn_s_sleep(8); }
#endif
#ifdef PROBE_TS
    if (blockIdx.x == 0 && C.tid == 0) { const unsigned long long dA = TSW[(PROBE_TS >> 4) & 15] - TSW[(PROBE_TS >> 8) & 15], dB = TSW[PROBE_TS & 15] - TSW[(PROBE_TS >> 12) & 15];
        const unsigned long long want = ((dA + 1000ull) / 2000ull) * 100000ull + dB;
        const unsigned long long t0 = __builtin_amdgcn_s_memrealtime(); while (__builtin_amdgcn_s_memrealtime() - t0 < want) __builtin_amdgcn_s_sleep(8); }
#endif
#ifdef PROBE_NT
    if (blockIdx.x == 0) { const int ntile_ = ((const LAS int*)(C.lds + SEG_OFF))[NE] >> 8; const unsigned long long want = (unsigned long long)(ntile_ > 150 ? ntile_ - 150 : 0) * 2000ull;
        const unsigned long long t0 = __builtin_amdgcn_s_memrealtime(); while (__builtin_amdgcn_s_memrealtime() - t0 < want) __builtin_amdgcn_s_sleep(8); }
#endif
#ifdef PROF_SECT
    if (blockIdx.x == 0) { __syncthreads(); const unsigned want = ((volatile LAS unsigned*)(C.lds + ATT_QW_OFF + 32))[0]; const unsigned long long t0 = __builtin_amdgcn_s_memtime(); while (__builtin_amdgcn_s_memtime() - t0 < (unsigned long long)want) __builtin_amdgcn_s_sleep(8); }
#endif
#undef IN
#undef SEAM
#undef TWICE
}

#if NAIVE_MASK
namespace nv {
__device__ __forceinline__ float bf2f(bf16_t v) { return __uint_as_float((unsigned)v << 16); }
__device__ __forceinline__ bf16_t f2b(float f) { return (bf16_t)f2bf(f); }
__global__ void __launch_bounds__(256) k_cumsum(float* __restrict__ bias) {
    __shared__ float part[256];
    float* p = bias + (size_t)blockIdx.x * S; const int tid = threadIdx.x;
    float loc[32]; float s = 0.f;
#pragma unroll
    for (int i = 0; i < 32; ++i) { s += p[tid * 32 + i]; loc[i] = s; }
    part[tid] = s; __syncthreads();
    if (tid == 0) { float a = 0.f; for (int i = 0; i < 256; ++i) { const float q = part[i]; part[i] = a; a += q; } }
    __syncthreads();
    const float base = part[tid];
#pragma unroll
    for (int i = 0; i < 32; ++i) p[tid * 32 + i] = (base + loc[i]) * ATT_ISCALE;
}
template <class FA, class FB>
__device__ __forceinline__ void ngemm_tile(int K, FA fa, FB fb, float (&acc)[4][4], float (*As)[65], float (*Bs)[65]) {
    const int tid = threadIdx.x, tx = tid & 15, ty = tid >> 4;
#pragma unroll
    for (int r = 0; r < 4; ++r)
#pragma unroll
        for (int c = 0; c < 4; ++c) acc[r][c] = 0.f;
    for (int k0 = 0; k0 < K; k0 += 16) {
        for (int e = tid; e < 1024; e += 256) { const int i = e >> 4, kk = e & 15; As[kk][i] = fa(i, k0 + kk); Bs[kk][i] = fb(k0 + kk, i); }
        __syncthreads();
#pragma unroll
        for (int kk = 0; kk < 16; ++kk) { float a[4], b[4];
#pragma unroll
            for (int r = 0; r < 4; ++r) a[r] = As[kk][ty * 4 + r];
#pragma unroll
            for (int c = 0; c < 4; ++c) b[c] = Bs[kk][tx * 4 + c];
#pragma unroll
            for (int r = 0; r < 4; ++r)
#pragma unroll
                for (int c = 0; c < 4; ++c) acc[r][c] += a[r] * b[c]; }
        __syncthreads();
    }
}
__global__ void __launch_bounds__(256) k_inproj(const bf16_t* __restrict__ A, const bf16_t* __restrict__ Bt, bf16_t* __restrict__ Cq) {
    __shared__ float As[16][65], Bs[16][65];
    const int m0 = blockIdx.y * 64, n0 = blockIdx.x * 64; float acc[4][4];
    ngemm_tile(DM, [&](int i, int k) { return bf2f(A[(size_t)(m0 + i) * DM + k]); }, [&](int k, int j) { return bf2f(Bt[(size_t)(n0 + j) * DM + k]); }, acc, As, Bs);
    const int tx = threadIdx.x & 15, ty = threadIdx.x >> 4;
#pragma unroll
    for (int r = 0; r < 4; ++r)
#pragma unroll
        for (int c = 0; c < 4; ++c) Cq[(size_t)(m0 + ty * 4 + r) * NQKV + n0 + tx * 4 + c] = f2b(acc[r][c]);
}
__global__ void __launch_bounds__(256) k_outproj(const bf16_t* __restrict__ A, const bf16_t* __restrict__ Bt, const float* __restrict__ x, float* __restrict__ H1) {
    __shared__ float As[16][65], Bs[16][65];
    const int m0 = blockIdx.y * 64, n0 = blockIdx.x * 64; float acc[4][4];
    ngemm_tile(DM, [&](int i, int k) { return bf2f(A[(size_t)(m0 + i) * DM + k]); }, [&](int k, int j) { return bf2f(Bt[(size_t)(n0 + j) * DM + k]); }, acc, As, Bs);
    const int tx = threadIdx.x & 15, ty = threadIdx.x >> 4;
#pragma unroll
    for (int r = 0; r < 4; ++r)
#pragma unroll
        for (int c = 0; c < 4; ++c) { const size_t o = (size_t)(m0 + ty * 4 + r) * DM + n0 + tx * 4 + c; H1[o] = x[o] + acc[r][c]; }
}
__global__ void __launch_bounds__(256) k_attn(const bf16_t* __restrict__ QKV, const float* __restrict__ bias, bf16_t* __restrict__ A2, bf16_t* __restrict__ DT) {
    __shared__ bf16_t Qs[64][130];
    __shared__ float Ks[32][129];
    __shared__ float Vs[32][128];
    __shared__ float Ps[64][33];
    const int tid = threadIdx.x, r = tid >> 2, c4 = tid & 3;
    const int qb = (int)gridDim.x - 1 - (int)blockIdx.x, p = blockIdx.y;
    int b, qcol, kcol, vcol, h, map = 0, vh = 0; const float* cc; const bool fox = p < 16;
    if (fox) { b = p >> 3; h = p & 7; qcol = C_FQ + h * 128; kcol = C_FK + h * 128; vcol = C_FV + h * 128; cc = bias + ((size_t)b * 8 + h) * S; }
    else { const int q = p - 16; b = q >> 4; h = (q >> 2) & 3; map = (q >> 1) & 1; vh = q & 1; qcol = C_DQ + h * 256 + map * 128; kcol = C_DK + h * 256 + map * 128; vcol = C_DV + h * 256 + vh * 128; cc = bias + (size_t)(16 + h) * S; }
    const int q0 = qb * 64; const size_t rowb = (size_t)b * S;
    for (int e = tid; e < 64 * 128; e += 256) { const int i = e >> 7, d = e & 127; Qs[i][d] = QKV[(rowb + q0 + i) * NQKV + qcol + d]; }
    const int t = q0 + r; const float ct = cc[t];
    float m = -1e30f, l = 0.f; float o[32];
#pragma unroll
    for (int j = 0; j < 32; ++j) o[j] = 0.f;
    const int nkt = (q0 + 63) / 32 + 1;
    for (int kt = 0; kt < nkt; ++kt) {
        const int k0 = kt * 32;
        __syncthreads();
        for (int e = tid; e < 32 * 128; e += 256) { const int i = e >> 7, d = e & 127; const size_t ro = (rowb + k0 + i) * NQKV; Ks[i][d] = bf2f(QKV[ro + kcol + d]); Vs[i][d] = bf2f(QKV[ro + vcol + d]); }
        __syncthreads();
        float sc[8];
#pragma unroll
        for (int j = 0; j < 8; ++j) sc[j] = 0.f;
        for (int d = 0; d < 128; ++d) { const float qv = bf2f(Qs[r][d]);
#pragma unroll
            for (int j = 0; j < 8; ++j) sc[j] += qv * Ks[c4 * 8 + j][d]; }
        float tmax = -__builtin_inff();
#pragma unroll
        for (int j = 0; j < 8; ++j) { const int s = k0 + c4 * 8 + j; float v = (sc[j] + (ct - cc[s])) * ATT_SCALE;
            if (s > t) v = -__builtin_inff();
            sc[j] = v; tmax = fmaxf(tmax, v); }
        tmax = fmaxf(tmax, __shfl_xor(tmax, 1)); tmax = fmaxf(tmax, __shfl_xor(tmax, 2));
        const float mn = fmaxf(m, tmax), alpha = __expf(m - mn); m = mn;
        float ps = 0.f;
#pragma unroll
        for (int j = 0; j < 8; ++j) { const float pv = __expf(sc[j] - mn); ps += pv; Ps[r][c4 * 8 + j] = pv; }
        ps += __shfl_xor(ps, 1); ps += __shfl_xor(ps, 2);
        l = l * alpha + ps;
        __syncthreads();
#pragma unroll
        for (int j = 0; j < 32; ++j) o[j] *= alpha;
        for (int kk = 0; kk < 32; ++kk) { const float pv = Ps[r][kk];
#pragma unroll
            for (int j = 0; j < 32; ++j) o[j] += pv * Vs[kk][c4 + 4 * j]; }
    }
    const float il = 1.f / l;
    bf16_t* op = fox ? A2 + (rowb + t) * DM + h * 128 : DT + (rowb + t) * DM + h * 512 + map * 256 + vh * 128;
#pragma unroll
    for (int j = 0; j < 32; ++j) op[c4 + 4 * j] = f2b(o[j] * il);
}
__global__ void __launch_bounds__(256) k_diff_combine(const bf16_t* __restrict__ DT, const float* __restrict__ lq1, const float* __restrict__ lk1, const float* __restrict__ lq2,
                                                      const float* __restrict__ lk2, const float* __restrict__ sg, bf16_t* __restrict__ A2) {
    const int lane = threadIdx.x & 63, wv = threadIdx.x >> 6;
    const int idx = blockIdx.x * 4 + wv, t = idx >> 2, h = idx & 3;
    const float s1 = wave_sum(lq1[lane] * lk1[lane] + lq1[lane + 64] * lk1[lane + 64]);
    const float s2 = wave_sum(lq2[lane] * lk2[lane] + lq2[lane + 64] * lk2[lane + 64]);
    const float lam = expf(s1) - expf(s2) + 0.2f;
    const bf16_t* p = DT + (size_t)t * DM + h * 512;
    float d[4]; float ss = 0.f;
#pragma unroll
    for (int c = 0; c < 4; ++c) { d[c] = bf2f(p[lane * 4 + c]) - lam * bf2f(p[256 + lane * 4 + c]); ss += d[c] * d[c]; }
    ss = wave_sum(ss);
    const float r = rsqrtf(ss * (1.f / 256.f) + 1e-5f) * 0.8f;
    bf16_t* o = A2 + (size_t)t * DM + 1024 + h * 256 + lane * 4;
#pragma unroll
    for (int c = 0; c < 4; ++c) o[c] = f2b(d[c] * r * sg[lane * 4 + c]);
}
__global__ void __launch_bounds__(256) k_route(const float* __restrict__ H1, const float* __restrict__ g, const float* __restrict__ wg, const float* __restrict__ bg,
                                               const float* __restrict__ we, const float* __restrict__ be, int* __restrict__ tok_e, int* __restrict__ tok_pos,
                                               float* __restrict__ tok_gate, float* __restrict__ rstd, unsigned* __restrict__ cnt) {
    __shared__ float xs[4][DM];
    const int lane = threadIdx.x & 63, wv = threadIdx.x >> 6;
    const int t = blockIdx.x * 4 + wv;
    const float* xr = H1 + (size_t)t * DM;
    f32x4 v[8]; float ss = 0.f;
#pragma unroll
    for (int j = 0; j < 8; ++j) { v[j] = *(const f32x4*)(xr + j * 256 + lane * 4); ss += v[j].x * v[j].x + v[j].y * v[j].y + v[j].z * v[j].z + v[j].w * v[j].w; }
    ss = wave_sum(ss);
    const float r = 1.f / sqrtf(ss * (1.f / DM) + 1e-6f);
#pragma unroll
    for (int j = 0; j < 8; ++j) { const f32x4 gg = *(const f32x4*)(g + j * 256 + lane * 4); *(f32x4*)(&xs[wv][j * 256 + lane * 4]) = v[j] * r * gg; }
    __syncthreads();
    float el = 0.f;
    for (int k = 0; k < DM; ++k) el += xs[wv][k] * we[(size_t)k * NE + lane];
    el += be[lane];
    float gl = 0.f;
    for (int k = (lane >> 3); k < DM; k += 8) gl += xs[wv][k] * wg[(size_t)k * 8 + (lane & 7)];
    gl += __shfl_xor(gl, 8); gl += __shfl_xor(gl, 16); gl += __shfl_xor(gl, 32);
    gl += bg[lane & 7];
    float gmax = -__builtin_inff(); int gi = 0;
#pragma unroll
    for (int j = 0; j < 8; ++j) { const float q = __shfl(gl, j); if (q > gmax) { gmax = q; gi = j; } }
    float gs = 0.f;
#pragma unroll
    for (int j = 0; j < 8; ++j) gs += expf(__shfl(gl, j) - gmax);
    const float gprob = 1.f / gs;
    float l1 = -__builtin_inff(), l2 = -__builtin_inff(); int i1 = 0, i2 = 0;
#pragma unroll
    for (int j = 0; j < 8; ++j) { const float q = __shfl(el, gi * 8 + j);
        if (q > l1) { l2 = l1; i2 = i1; l1 = q; i1 = j; } else if (q > l2) { l2 = q; i2 = j; } }
    const float e2 = expf(l2 - l1), g1 = gprob / (1.f + e2), g2 = gprob * e2 / (1.f + e2);
    if (lane == 0) {
        const int ea = gi * 8 + i1, eb = gi * 8 + i2;
        const unsigned pa = atomicAdd(cnt + ea, 1u), pb = atomicAdd(cnt + eb, 1u);
        tok_e[t * 2] = ea; tok_e[t * 2 + 1] = eb; tok_pos[t * 2] = (int)pa; tok_pos[t * 2 + 1] = (int)pb; tok_gate[t * 2] = g1; tok_gate[t * 2 + 1] = g2; rstd[t] = r;
    }
}
__device__ __forceinline__ int seg_off(const unsigned* cnt, int e) { int o = 0; for (int i = 0; i < e; ++i) o += (int)((cnt[i] + 255u) & ~255u); return o; }
__global__ void __launch_bounds__(256) k_dispatch(const float* __restrict__ H1, const float* __restrict__ g, const float* __restrict__ rstd, const int* __restrict__ tok_e,
                                                  const int* __restrict__ tok_pos, const float* __restrict__ tok_gate, const unsigned* __restrict__ cnt, bf16_t* __restrict__ XG, float* __restrict__ rowgate) {
    const int lane = threadIdx.x & 63, wv = threadIdx.x >> 6; const int t = blockIdx.x * 4 + wv;
    const int ra = seg_off(cnt, tok_e[t * 2]) + tok_pos[t * 2], rb = seg_off(cnt, tok_e[t * 2 + 1]) + tok_pos[t * 2 + 1];
    const float rs = rstd[t];
    for (int k = lane; k < DM; k += 64) { const bf16_t v = f2b(H1[(size_t)t * DM + k] * rs * g[k]); XG[(size_t)ra * DM + k] = v; XG[(size_t)rb * DM + k] = v; }
    if (lane == 0) { rowgate[ra] = tok_gate[t * 2]; rowgate[rb] = tok_gate[t * 2 + 1]; }
}
__global__ void __launch_bounds__(256) k_moe_up(const bf16_t* __restrict__ XG, const bf16_t* __restrict__ WGU, const unsigned* __restrict__ cnt, bf16_t* __restrict__ HB) {
    __shared__ float As[16][65], Bs[16][65];
    const int m0 = blockIdx.y * 64, n0 = blockIdx.x * 64;
    int e = 0, tot = 0; { int o = 0; for (int i = 0; i < NE; ++i) { if (o <= m0) e = i; o += (int)((cnt[i] + 255u) & ~255u); } tot = o; }
    if (m0 >= tot) return;
    const bf16_t* W = WGU + (size_t)e * 2048 * DM; const int rg = 256 * (n0 >> 7) + (n0 & 127), ru = rg + 128;
    float ag[4][4], au[4][4];
    ngemm_tile(DM, [&](int i, int k) { return bf2f(XG[(size_t)(m0 + i) * DM + k]); }, [&](int k, int j) { return bf2f(W[(size_t)(rg + j) * DM + k]); }, ag, As, Bs);
    ngemm_tile(DM, [&](int i, int k) { return bf2f(XG[(size_t)(m0 + i) * DM + k]); }, [&](int k, int j) { return bf2f(W[(size_t)(ru + j) * DM + k]); }, au, As, Bs);
    const int tx = threadIdx.x & 15, ty = threadIdx.x >> 4;
#pragma unroll
    for (int r = 0; r < 4; ++r)
#pragma unroll
        for (int c = 0; c < 4; ++c) { const float gv = ag[r][c]; HB[(size_t)(m0 + ty * 4 + r) * DFF + n0 + tx * 4 + c] = f2b(gv / (1.f + expf(-gv)) * au[r][c]); }
}
__global__ void __launch_bounds__(256) k_moe_down(const bf16_t* __restrict__ HB, const bf16_t* __restrict__ WD, const unsigned* __restrict__ cnt, const float* __restrict__ rowgate, bf16_t* __restrict__ Y) {
    __shared__ float As[16][65], Bs[16][65];
    const int m0 = blockIdx.y * 64, n0 = blockIdx.x * 64;
    int e = 0, tot = 0; { int o = 0; for (int i = 0; i < NE; ++i) { if (o <= m0) e = i; o += (int)((cnt[i] + 255u) & ~255u); } tot = o; }
    if (m0 >= tot) return;
    const bf16_t* W = WD + (size_t)e * DM * DFF; float acc[4][4];
    ngemm_tile(DFF, [&](int i, int k) { return bf2f(HB[(size_t)(m0 + i) * DFF + k]); }, [&](int k, int j) { return bf2f(W[(size_t)(n0 + j) * DFF + k]); }, acc, As, Bs);
    const int tx = threadIdx.x & 15, ty = threadIdx.x >> 4;
#pragma unroll
    for (int r = 0; r < 4; ++r) { const int row = m0 + ty * 4 + r; const float gt = rowgate[row];
#pragma unroll
        for (int c = 0; c < 4; ++c) Y[(size_t)row * DM + n0 + tx * 4 + c] = f2b(acc[r][c] * gt); }
}
__global__ void __launch_bounds__(256) k_final(const float* __restrict__ H1, const bf16_t* __restrict__ Y, const unsigned* __restrict__ cnt, const int* __restrict__ tok_e,
                                               const int* __restrict__ tok_pos, const float* __restrict__ g, float* __restrict__ out) {
    const int lane = threadIdx.x & 63, wv = threadIdx.x >> 6; const int t = blockIdx.x * 4 + wv;
    const int ra = seg_off(cnt, tok_e[t * 2]) + tok_pos[t * 2], rb = seg_off(cnt, tok_e[t * 2 + 1]) + tok_pos[t * 2 + 1];
    float v[32]; float ss = 0.f;
#pragma unroll
    for (int i = 0; i < 32; ++i) { const int k = lane + 64 * i; v[i] = H1[(size_t)t * DM + k] + bf2f(Y[(size_t)ra * DM + k]) + bf2f(Y[(size_t)rb * DM + k]); ss += v[i] * v[i]; }
    ss = wave_sum(ss);
    const float r = 1.f / sqrtf(ss * (1.f / DM) + 1e-6f);
#pragma unroll
    for (int i = 0; i < 32; ++i) { const int k = lane + 64 * i; out[(size_t)t * DM + k] = v[i] * r * g[k]; }
}
}
static void naive_phase(int k, const Args& a, hipStream_t stream) {
    unsigned char* ws = a.ws;
    bf16_t* A1 = (bf16_t*)(ws + WS_A1); bf16_t* WIN = (bf16_t*)(ws + WS_WIN); bf16_t* WOUT = (bf16_t*)(ws + WS_WOUT); float* BIAS = (float*)(ws + WS_BIAS); bf16_t* QKV = (bf16_t*)(ws + WS_QKV);
    bf16_t* A2 = (bf16_t*)(ws + WS_A2); bf16_t* DT = (bf16_t*)(ws + WS_DT); float* H1 = (float*)(ws + WS_H1);
    int* tok_e = (int*)(ws + WS_ROUTE); int* tok_pos = tok_e + 2 * M; float* tok_gate = (float*)(tok_pos + 2 * M); float* rstd = tok_gate + 2 * M; float* rowgate = rstd + M;
    bf16_t* XG = (bf16_t*)(ws + WS_XG); bf16_t* HB = (bf16_t*)(ws + WS_HBUF); bf16_t* Y = (bf16_t*)(ws + WS_Y); bf16_t* WGU = (bf16_t*)(ws + WS_WGU); bf16_t* WD = (bf16_t*)(ws + WS_WD);
    unsigned* cnt = (unsigned*)(ws + WS_CTL) + CW_CNT;
    switch (k) {
    case 1: nv::k_cumsum<<<16, 256, 0, stream>>>(BIAS); nv::k_inproj<<<dim3(NQKV / 64, M / 64), 256, 0, stream>>>(A1, WIN, QKV); break;
    case 3: nv::k_attn<<<dim3(S / 64, 48), 256, 0, stream>>>(QKV, BIAS, A2, DT); break;
    case 4: nv::k_diff_combine<<<M, 256, 0, stream>>>(DT, a.in[4], a.in[5], a.in[6], a.in[7], a.in[8], A2); break;
    case 5: nv::k_outproj<<<dim3(DM / 64, M / 64), 256, 0, stream>>>(A2, WOUT, a.in[0], H1); break;
    case 6: nv::k_route<<<M / 4, 256, 0, stream>>>(H1, a.in[10], a.in[11], a.in[12], a.in[13], a.in[14], tok_e, tok_pos, tok_gate, rstd, cnt); break;
    case 7: nv::k_dispatch<<<M / 4, 256, 0, stream>>>(H1, a.in[10], rstd, tok_e, tok_pos, tok_gate, cnt, XG, rowgate); break;
    case 8: nv::k_moe_up<<<dim3(DFF / 64, YROWS / 64), 256, 0, stream>>>(XG, WGU, cnt, HB); break;
    case 9: nv::k_moe_down<<<dim3(DM / 64, YROWS / 64), 256, 0, stream>>>(HB, WD, cnt, rowgate, Y); break;
    case 10: nv::k_final<<<M / 4, 256, 0, stream>>>(H1, Y, cnt, tok_e, tok_pos, a.in[18], a.out); break;
    default: break;
    }
}
#endif


extern "C" void kernel_launch(void* const* d_in, const int* in_sizes, int n_in, void* d_out, int out_size, void* d_ws, size_t ws_size, hipStream_t stream) {
    static int grid = 0;
    if (grid == 0) {
        if (n_in != 19 || in_sizes[0] != M * DM || out_size != M * DM || ws_size < WS_END) {
            fprintf(stderr, "kernel_launch: built for 19 inputs, x and out of %d floats, >= %zu bytes of workspace; got n_in %d, in0 %d, out %d, ws %zu; nothing launched\n", M * DM, (size_t)WS_END, n_in, n_in > 0 ? in_sizes[0] : -1, out_size, ws_size); grid = -1; return; }
        int dev = 0, cus = 0, per_cu = 0;
        if (hipGetDevice(&dev) != hipSuccess || hipDeviceGetAttribute(&cus, hipDeviceAttributeMultiprocessorCount, dev) != hipSuccess) { fprintf(stderr, "kernel_launch: device query failed\n"); grid = -1; return; }
        if (hipFuncSetAttribute((const void*)mk_fwd, hipFuncAttributeMaxDynamicSharedMemorySize, LDS_BYTES) != hipSuccess) { fprintf(stderr, "kernel_launch: hipFuncSetAttribute failed\n"); grid = -1; return; }
        if (hipOccupancyMaxActiveBlocksPerMultiprocessor(&per_cu, (const void*)mk_fwd, NWAVES * 64, LDS_BYTES) != hipSuccess || per_cu < 1)
            fprintf(stderr, "kernel_launch: note: occupancy query reports %d workgroups per CU\n", per_cu);
        (void)hipGetLastError();
        grid = cus;
    }
    if (grid < 0) return;
    if (hipMemsetAsync((char*)d_ws + WS_CTL, 0, CTL_ZERO_BYTES, stream) != hipSuccess) { fprintf(stderr, "kernel_launch: memset failed\n"); return; }
    Args a{};
    for (int i = 0; i < 19; ++i) a.in[i] = (const float*)d_in[i];
    a.out = (float*)d_out; a.ws = (unsigned char*)d_ws;
    int k = 0, li = 0;
    while (k < NPHASE) {
#if NAIVE_MASK
        if (k > 0 && ((NAIVE_MASK >> k) & 1u)) { naive_phase(k, a, stream); ++k; continue; }
#endif
        const int lo = k; ++k;
        while (k < NPHASE && !((NAIVE_MASK >> k) & 1u)) ++k;
        a.ph_lo = lo; a.ph_hi = k; a.li = li++;
        hipLaunchKernelGGL(mk_fwd, dim3(grid), dim3(NWAVES * 64), LDS_BYTES, stream, a);
        const hipError_t le = hipPeekAtLastError();
        if (le != hipSuccess) { fprintf(stderr, "kernel_launch: launch failed: %s\n", hipGetErrorName(le)); break; }
    }
#if PROBE_REP
    a.ph_lo = PROBE_REP; a.ph_hi = PROBE_REP + 1; a.li = li++;
    hipLaunchKernelGGL(mk_fwd, dim3(grid), dim3(NWAVES * 64), LDS_BYTES, stream, a);
#endif
}
```

```cpp
#include <hip/hip_runtime.h>
#include <hip/hip_bf16.h>
#include <cstdio>
#include <cstdint>
#include <cmath>

#ifndef NAIVE_MASK
#define NAIVE_MASK 0u
#endif

typedef unsigned short bf16_t;
constexpr int NB = 2, S = 8192, DM = 2048, M = NB * S;
constexpr int NCOL = 6152, NQKV = 6144;
constexpr int FCOL = 3072;
constexpr int NE = 64, DFF = 1024;
constexpr int YROWS = 49152, NTILE_MAX = YROWS / 256;
constexpr int C_FQ = 0, C_FK = 1024, C_FV = 2048, C_DQ = 3072, C_DK = 4096, C_DV = 5120;
constexpr float ATT_SCALE = 0.08838834764831845f, ATT_ISCALE = 11.313708498984761f;
constexpr int NPHASE = 11;

constexpr size_t MiB = 1u << 20;
constexpr size_t WS_CTL = 0, CTL_ZERO_BYTES = 1 * MiB;
constexpr size_t WS_A1 = 1 * MiB;
constexpr size_t WS_WIN = 65 * MiB;
constexpr size_t WS_WOUT = 89 * MiB;
constexpr size_t WS_BIAS = 97 * MiB;
constexpr size_t WS_QKV = 98 * MiB;
constexpr size_t WS_A2 = 290 * MiB;
constexpr size_t WS_DT = 354 * MiB;
constexpr size_t WS_H1 = 418 * MiB;
constexpr size_t WS_ROUTE = 546 * MiB;
constexpr size_t WS_WR = 547 * MiB;
constexpr size_t WS_XG = 548 * MiB;
constexpr size_t WS_HBUF = 740 * MiB;
constexpr size_t WS_Y = 836 * MiB;
constexpr size_t WS_WGU = 1028 * MiB;
constexpr size_t WS_WD = 1540 * MiB;
constexpr size_t WS_END = 1796 * MiB;
constexpr int CW_CNT = 65536, CNT_STRIDE = 1056;
constexpr int CW_NRM = 2048;
constexpr int CW_QHEAD = 3072;
constexpr int CW_BAR = 4096;

namespace pg8 {
#define PG8_LAS __attribute__((address_space(3)))
typedef unsigned short bf16_t;
typedef short bf16x8 __attribute__((ext_vector_type(8)));
typedef float f32x4 __attribute__((ext_vector_type(4)));
typedef unsigned u32x4 __attribute__((ext_vector_type(4)));
constexpr int BM = 256, BK = 64, HALF = 128, HTB = HALF * BK * 2  , STAGE_BYTES = 8 * HTB, NXCD = 8, WGM = 8;

__host__ __device__ __forceinline__ int lds_byte(int r, int c) { const int st = (r >> 4) * 2 + (c >> 5), rr = r & 15, cc = c & 31, ob = rr * 64 + cc * 2; return st * 1024 + (ob ^ (((ob >> 9) & 1) << 5)); }
__host__ __device__ __forceinline__ void stage_rc(int b, int& R, int& C) { const int st = b / 1024, sb = b % 1024, swz = sb ^ (((sb >> 9) & 1) << 5); R = (st >> 1) * 16 + swz / 64; C = (st & 1) * 32 + (swz % 64) / 2; }
__host__ __device__ __forceinline__ int perm32(int rho) { const int n = rho >> 4, i = rho & 15; return 8 * (i >> 2) + 4 * n + (i & 3); }

struct Unit { int pm, pn; };
struct Gemm { const bf16_t* A; const bf16_t* Bt; int M, N, K; };

struct StaticOrder {
    int nM, nN, nwg, G, c;
    __host__ __device__ void init(int M, int N, int G_, int c_) { nM = M / BM; nN = N / BM; nwg = nM * nN; G = G_; c = c_; }
    __host__ __device__ bool next(int i, Unit& u) const {
        const long L = (long)i * G + c; if (L >= nwg) return false;
        int wgid = (int)L; { const int q = nwg / NXCD, r = nwg % NXCD, xcd = wgid % NXCD, off = wgid / NXCD; wgid = (xcd < r ? xcd * (q + 1) : r * (q + 1) + (xcd - r) * q) + off; }
        const int nig = WGM * nN, gid = wgid / nig, fm = gid * WGM, gsz = (nM - fm) < WGM ? (nM - fm) : WGM;
        u.pm = fm + ((wgid % nig) % gsz); u.pn = (wgid % nig) / gsz; return true;
    }
    __device__ __forceinline__ void a_ready(const Unit&) const {}
    __device__ __forceinline__ void done(const Unit&) const {}
};

__device__ __forceinline__ unsigned cvt_pk_bf16(float lo, float hi) { unsigned r; asm volatile("v_cvt_pk_bf16_f32 %0, %1, %2" : "=v"(r) : "v"(lo), "v"(hi)); return r; }
typedef float f32x2 __attribute__((ext_vector_type(2)));
__device__ __forceinline__ f32x2 gelu_pk(f32x2 v) {
    const f32x2 av = __builtin_elementwise_abs(v), d = av * 0.2316418882f + 1.0f;
    f32x2 t; t.x = __builtin_amdgcn_rcpf(d.x); t.y = __builtin_amdgcn_rcpf(d.y);
    f32x2 q = t * 0.5307027145f + (-0.7265760135f); q = q * t + 0.7107068705f; q = q * t + (-0.142248368f); q = q * t + 0.127414796f; q = q * t;
    const f32x2 s = (v * v) * (-0.72134752044f);
    f32x2 e; e.x = __builtin_amdgcn_exp2f(s.x); e.y = __builtin_amdgcn_exp2f(s.y);
    const f32x2 m = v * (q * e), r = v - m;
    f32x2 o; o.x = v.x < 0.f ? m.x : r.x; o.y = v.y < 0.f ? m.y : r.y; return o;
}

template <int ACT  > struct EpiBf16 {
    static constexpr bool PERM = true, AFTER_DRAIN = false; static_assert(ACT == 0 || ACT == 1, "EpiBf16: ACT is 0 (none) or 1 (gelu_pk)");
    bf16_t* O; int ldc; const float* bias; int split_cols; size_t split_stride; float scale0;
    __device__ __forceinline__ void operator()(const f32x4 (&acc)[2][2][4][2], const Unit& u, int wr, int wc, int fr, int fq) const {
        const int row0 = u.pm * BM + wr * 64 + fr; int colt = u.pn * BM; bf16_t* base = O;
        float sc = 1.f; if (split_cols) { const int t = colt / split_cols; base += (size_t)t * split_stride; colt -= t * split_cols; if (t == 0) sc = scale0; }
        const int col0 = colt + wc * 32 + 8 * fq, bcol0 = u.pn * BM + wc * 32 + 8 * fq;
        f32x4 bv[2][2];
#pragma unroll
        for (int bj = 0; bj < 2; ++bj)
#pragma unroll
            for (int n = 0; n < 2; ++n) bv[bj][n] = bias ? *(const f32x4*)(bias + bcol0 + bj * HALF + 4 * n) : (f32x4){0.f, 0.f, 0.f, 0.f};
#pragma unroll
        for (int ai = 0; ai < 2; ++ai)
#pragma unroll
            for (int m = 0; m < 4; ++m) { bf16_t* rowp = base + (size_t)(row0 + ai * HALF + m * 16) * ldc + col0;
#pragma unroll
                for (int bj = 0; bj < 2; ++bj) { f32x4 v0 = acc[ai][bj][m][0] + bv[bj][0], v1 = acc[ai][bj][m][1] + bv[bj][1];
                    if (ACT == 1) { f32x2 a = gelu_pk((f32x2){v0[0], v0[1]}), b = gelu_pk((f32x2){v0[2], v0[3]}), c = gelu_pk((f32x2){v1[0], v1[1]}), d = gelu_pk((f32x2){v1[2], v1[3]});
                        v0 = (f32x4){a.x, a.y, b.x, b.y}; v1 = (f32x4){c.x, c.y, d.x, d.y}; }
                    v0 = v0 * sc; v1 = v1 * sc; u32x4 w; w.x = cvt_pk_bf16(v0[0], v0[1]); w.y = cvt_pk_bf16(v0[2], v0[3]); w.z = cvt_pk_bf16(v1[0], v1[1]); w.w = cvt_pk_bf16(v1[2], v1[3]);
                    *(u32x4*)(rowp + bj * HALF) = w; } }
    }
};

struct EpiResF32 {
    static constexpr bool PERM = false, AFTER_DRAIN = false;
    const float* base; float* out; int ldc;
    __device__ __forceinline__ void operator()(const f32x4 (&acc)[2][2][4][2], const Unit& u, int wr, int wc, int fr, int fq) const {
        const int col0 = u.pn * BM + wc * 32 + 4 * fq;
#pragma unroll
        for (int ai = 0; ai < 2; ++ai)
#pragma unroll
            for (int m = 0; m < 4; ++m) { const size_t off = (size_t)(u.pm * BM + ai * HALF + wr * 64 + m * 16 + fr) * ldc + col0;
#pragma unroll
                for (int bj = 0; bj < 2; ++bj)
#pragma unroll
                    for (int n = 0; n < 2; ++n) { const f32x4 bs = *(const f32x4*)(base + off + bj * HALF + n * 16); *(f32x4*)(out + off + bj * HALF + n * 16) = bs + acc[ai][bj][m][n]; }
                if (m & 1) asm volatile("" ::: "memory"); }
    }
};
struct EpiResBf16 {
    static constexpr bool PERM = true, AFTER_DRAIN = false;
    const float* base; bf16_t* out; int ldc;
    __device__ __forceinline__ void operator()(const f32x4 (&acc)[2][2][4][2], const Unit& u, int wr, int wc, int fr, int fq) const {
        const int col0 = u.pn * BM + wc * 32 + 8 * fq;
#pragma unroll
        for (int ai = 0; ai < 2; ++ai)
#pragma unroll
            for (int m = 0; m < 4; ++m) { const size_t off = (size_t)(u.pm * BM + ai * HALF + wr * 64 + m * 16 + fr) * ldc + col0;
#pragma unroll
                for (int bj = 0; bj < 2; ++bj) { const f32x4 v0 = *(const f32x4*)(base + off + bj * HALF) + acc[ai][bj][m][0], v1 = *(const f32x4*)(base + off + bj * HALF + 4) + acc[ai][bj][m][1];
                    u32x4 w; w.x = cvt_pk_bf16(v0[0], v0[1]); w.y = cvt_pk_bf16(v0[2], v0[3]); w.z = cvt_pk_bf16(v1[0], v1[1]); w.w = cvt_pk_bf16(v1[2], v1[3]);
                    *(u32x4*)(out + off + bj * HALF) = w; }
                if (m & 1) asm volatile("" ::: "memory"); }
    }
};
struct EpiQKV {
    static constexpr bool PERM = true, AFTER_DRAIN = false;
    bf16_t* O; int ldc; PG8_LAS float* part; unsigned* nrm;
    __device__ __forceinline__ void operator()(const f32x4 (&acc)[2][2][4][2], const Unit& u, int wr, int wc, int fr, int fq) const {
        const int row0 = u.pm * BM + wr * 64 + fr, col0 = u.pn * BM + wc * 32 + 8 * fq;
        const bool track = u.pn < 8 || (u.pn >= 12 && u.pn < 20);
#pragma unroll
        for (int ai = 0; ai < 2; ++ai)
#pragma unroll
            for (int m = 0; m < 4; ++m) { bf16_t* rowp = O + (size_t)(row0 + ai * HALF + m * 16) * ldc + col0;
#pragma unroll
                for (int bj = 0; bj < 2; ++bj) { const f32x4 v0 = acc[ai][bj][m][0], v1 = acc[ai][bj][m][1];
                    u32x4 w; w.x = cvt_pk_bf16(v0[0], v0[1]); w.y = cvt_pk_bf16(v0[2], v0[3]); w.z = cvt_pk_bf16(v1[0], v1[1]); w.w = cvt_pk_bf16(v1[2], v1[3]);
                    *(u32x4*)(rowp + bj * HALF) = w;
                    if (track) { float ss = ((v0[0] * v0[0] + v0[1] * v0[1]) + (v0[2] * v0[2] + v0[3] * v0[3])) + ((v1[0] * v1[0] + v1[1] * v1[1]) + (v1[2] * v1[2] + v1[3] * v1[3]));
                        ss += __shfl_xor(ss, 16); ss += __shfl_xor(ss, 32);
                        if (fq == 0) part[(wc * 2 + bj) * 256 + ai * HALF + wr * 64 + m * 16 + fr] = ss; } } }
        if (track) {
            asm volatile("s_waitcnt lgkmcnt(0)" ::: "memory"); __builtin_amdgcn_s_barrier(); asm volatile("" ::: "memory");
            const int tid = threadIdx.x, row = tid & 255, bj = tid >> 8;
            float v = (part[(0 * 2 + bj) * 256 + row] + part[(1 * 2 + bj) * 256 + row]) + (part[(2 * 2 + bj) * 256 + row] + part[(3 * 2 + bj) * 256 + row]);
#pragma unroll
            for (int o = 1; o < 64; o <<= 1) v = fmaxf(v, __shfl_xor(v, o));
            const int slice = (u.pn < 8 ? 2 * u.pn : 16 + 2 * (u.pn - 12)) + bj;
            if ((tid & 63) == 0) atomicMax(nrm + (u.pm >> 5) * 32 + slice, __float_as_uint(v));
            asm volatile("s_waitcnt lgkmcnt(0)" ::: "memory");
        }
    }
};
struct EpiSwiglu {
    static constexpr bool PERM = true, AFTER_DRAIN = false;
    bf16_t* H;
    __device__ __forceinline__ void operator()(const f32x4 (&acc)[2][2][4][2], const Unit& u, int wr, int wc, int fr, int fq) const {
        const int col0 = (u.pn & 7) * HALF + wc * 32 + 8 * fq;
#pragma unroll
        for (int ai = 0; ai < 2; ++ai)
#pragma unroll
            for (int m = 0; m < 4; ++m) { bf16_t* rowp = H + (size_t)(u.pm * BM + ai * HALF + wr * 64 + m * 16 + fr) * 1024 + col0;
                float hv[8];
#pragma unroll
                for (int n = 0; n < 2; ++n)
#pragma unroll
                    for (int c = 0; c < 4; ++c) { const float g = acc[ai][0][m][n][c], uu = acc[ai][1][m][n][c];
                        hv[n * 4 + c] = g * __builtin_amdgcn_rcpf(1.f + __builtin_amdgcn_exp2f(-1.4426950408889634f * g)) * uu; }
                u32x4 w; w.x = cvt_pk_bf16(hv[0], hv[1]); w.y = cvt_pk_bf16(hv[2], hv[3]); w.z = cvt_pk_bf16(hv[4], hv[5]); w.w = cvt_pk_bf16(hv[6], hv[7]);
                *(u32x4*)rowp = w; }
    }
};
struct EpiDown {
    static constexpr bool PERM = true, AFTER_DRAIN = false;
    bf16_t* Y;
    __device__ __forceinline__ void operator()(const f32x4 (&acc)[2][2][4][2], const Unit& u, int wr, int wc, int fr, int fq) const {
        const int col0 = (u.pn & 7) * BM + wc * 32 + 8 * fq;
#pragma unroll
        for (int ai = 0; ai < 2; ++ai)
#pragma unroll
            for (int m = 0; m < 4; ++m) { const int row = u.pm * BM + ai * HALF + wr * 64 + m * 16 + fr; bf16_t* rowp = Y + (size_t)row * 2048 + col0;
#pragma unroll
                for (int bj = 0; bj < 2; ++bj) { const f32x4 v0 = acc[ai][bj][m][0], v1 = acc[ai][bj][m][1];
                    u32x4 w; w.x = cvt_pk_bf16(v0[0], v0[1]); w.y = cvt_pk_bf16(v0[2], v0[3]); w.z = cvt_pk_bf16(v1[0], v1[1]); w.w = cvt_pk_bf16(v1[2], v1[3]);
                    *(u32x4*)(rowp + bj * HALF) = w; } }
    }
};
struct GroupedOrder {
    int total, G, c; const PG8_LAS int* tile_e;
    __device__ __forceinline__ bool next(int i, Unit& u) const {
        const int L = i * G + c; if (L >= total) return false;
        u.pm = L >> 3; u.pn = __builtin_amdgcn_readfirstlane(tile_e[L >> 3]) * 8 + (L & 7); return true;
    }
    __device__ __forceinline__ void a_ready(const Unit&) const {}
    __device__ __forceinline__ void done(const Unit&) const {}
};

template <class Epi, class Sched, bool ALIGN_EPI = false, bool SP2 = false>
__device__ __forceinline__ void gemm_phase(PG8_LAS unsigned char* lds, const Gemm g, const Sched& S, const Epi& E) {
    const int tid = threadIdx.x, wid = __builtin_amdgcn_readfirstlane(tid >> 6), lane = tid & 63, wr = wid >> 2, wc = wid & 3, fr = lane & 15, fq = lane >> 4;
    const int K = g.K, nt = K / BK;
    unsigned voffA[2], voffB[2];
#pragma unroll
    for (int i = 0; i < 2; ++i) { int R, C; stage_rc(tid * 16 + i * 8192, R, C); const int Rb = Epi::PERM ? ((R & ~31) + perm32(R & 31)) : R;
        voffA[i] = (unsigned)(R * K + C) * 2u; voffB[i] = (unsigned)(Rb * K + C) * 2u; }
    const size_t kstep = (size_t)(BK * 2);
    const size_t hstep = (size_t)HALF * K * 2;
    const size_t tstep = 2 * hstep;
    const unsigned ldsw = (unsigned)wid * 1024u;
    const int aoff = lds_byte(wr * 64 + fr, fq * 8), boff = lds_byte(wc * 32 + fr, fq * 8);
#define PG8_SA(b, h) (((b) * 2 + (h)) * HTB)
#define PG8_SB(b, h) ((4 + (b) * 2 + (h)) * HTB)
#define PG8_STAGE(bufoff, gbase, voff) do { _Pragma("unroll") for (int _i = 0; _i < 2; ++_i) \
        __builtin_amdgcn_global_load_lds((const unsigned*)((const char*)(gbase) + (voff)[_i]), (PG8_LAS unsigned*)(lds + (bufoff) + ldsw + _i * 8192), 16, 0, 0); } while (0)
#define PG8_LDA(dst, b, h) do { _Pragma("unroll") for (int m = 0; m < 4; ++m) _Pragma("unroll") for (int k = 0; k < 2; ++k) dst[m][k] = *(const PG8_LAS bf16x8*)(lds + PG8_SA(b, h) + aoff + m * 2048 + k * 1024); } while (0)
#define PG8_LDB(dst, b, h) do { _Pragma("unroll") for (int n = 0; n < 2; ++n) _Pragma("unroll") for (int k = 0; k < 2; ++k) dst[n][k] = *(const PG8_LAS bf16x8*)(lds + PG8_SB(b, h) + boff + n * 2048 + k * 1024); } while (0)
#define PG8_MMA(ai, bj, At, Bt) do { __builtin_amdgcn_s_setprio(1); _Pragma("unroll") for (int m = 0; m < 4; ++m) _Pragma("unroll") for (int n = 0; n < 2; ++n) _Pragma("unroll") for (int k = 0; k < 2; ++k) \
        acc[ai][bj][m][n] = __builtin_amdgcn_mfma_f32_16x16x32_bf16(Bt[n][k], At[m][k], acc[ai][bj][m][n], 0, 0, 0); __builtin_amdgcn_s_setprio(0); } while (0)
#define PG8_WAIT_V(n) asm volatile("s_waitcnt vmcnt(" #n ")" ::: "memory")
#define PG8_WAIT_L(n) asm volatile("s_waitcnt lgkmcnt(" #n ")" ::: "memory")
#define PG8_BAR __builtin_amdgcn_s_barrier()
#define PG8_SCHED __builtin_amdgcn_sched_barrier(0)
    Unit cur, nxt; int ui = 0;
    if (!S.next(0, cur)) return;
    f32x4 acc[2][2][4][2];
#pragma unroll
    for (int a = 0; a < 2; ++a)
#pragma unroll
        for (int b = 0; b < 2; ++b)
#pragma unroll
            for (int m = 0; m < 4; ++m)
#pragma unroll
                for (int n = 0; n < 2; ++n) acc[a][b][m][n] = (f32x4){0.f, 0.f, 0.f, 0.f};
    bf16x8 At[4][2], B0[2][2], B1[2][2];
    const char* cA = (const char*)g.A + (size_t)cur.pm * tstep; const char* cB = (const char*)g.Bt + (size_t)cur.pn * tstep;
    S.a_ready(cur);
    if constexpr (SP2) {
        PG8_STAGE(PG8_SB(0, 0), cB, voffB); PG8_STAGE(PG8_SB(0, 1), cB + hstep, voffB); PG8_STAGE(PG8_SA(0, 0), cA, voffA); PG8_STAGE(PG8_SA(0, 1), cA + hstep, voffA);
        if (wr == 1) PG8_BAR;
        PG8_WAIT_V(2); PG8_BAR;
        PG8_STAGE(PG8_SB(1, 0), cB + kstep, voffB); PG8_STAGE(PG8_SA(1, 0), cA + kstep, voffA); PG8_STAGE(PG8_SB(1, 1), cB + hstep + kstep, voffB);
        PG8_WAIT_V(6); PG8_BAR;
    } else {
        PG8_STAGE(PG8_SB(0, 0), cB, voffB); PG8_STAGE(PG8_SA(0, 0), cA, voffA); PG8_STAGE(PG8_SB(0, 1), cB + hstep, voffB); PG8_STAGE(PG8_SA(0, 1), cA + hstep, voffA);
        if (wr == 1) PG8_BAR;
        PG8_WAIT_V(4); PG8_BAR;
        PG8_STAGE(PG8_SB(1, 0), cB + kstep, voffB); PG8_STAGE(PG8_SA(1, 0), cA + kstep, voffA); PG8_STAGE(PG8_SB(1, 1), cB + hstep + kstep, voffB);
        PG8_WAIT_V(6); PG8_BAR;
    }
    for (;;) {
        const bool has_next = S.next(ui + 1, nxt);
        const char* nA = has_next ? (const char*)g.A + (size_t)nxt.pm * tstep : cA; const char* nB = has_next ? (const char*)g.Bt + (size_t)nxt.pn * tstep : cB;
        for (int t = 0; t < nt; t += 2) {
            const bool last = (t == nt - 2);
            const char* a1 = cA + (size_t)(t + 1) * kstep;
            const char* a2 = last ? nA : cA + (size_t)(t + 2) * kstep; const char* b2 = last ? nB : cB + (size_t)(t + 2) * kstep;
            const char* a3 = a2 + kstep; const char* b3 = b2 + kstep;
            if (last && has_next) S.a_ready(nxt);
            if constexpr (SP2) {
            PG8_LDB(B0, 0, 0); PG8_LDB(B1, 0, 1); PG8_SCHED; PG8_LDA(At, 0, 0); PG8_STAGE(PG8_SA(1, 1), a1 + hstep, voffA);
            PG8_WAIT_V(8); PG8_WAIT_L(0); PG8_BAR; PG8_MMA(0, 0, At, B0); PG8_MMA(0, 1, At, B1); PG8_BAR; PG8_SCHED;
            PG8_LDA(At, 0, 1); PG8_STAGE(PG8_SB(0, 0), b2, voffB); PG8_STAGE(PG8_SB(0, 1), b2 + hstep, voffB); PG8_STAGE(PG8_SA(0, 0), a2, voffA);
            PG8_WAIT_V(8); PG8_WAIT_L(0); PG8_BAR; PG8_MMA(1, 0, At, B0); PG8_MMA(1, 1, At, B1); PG8_BAR; PG8_SCHED;
            PG8_LDB(B0, 1, 0); PG8_LDB(B1, 1, 1); PG8_SCHED; PG8_LDA(At, 1, 0); PG8_STAGE(PG8_SA(0, 1), a2 + hstep, voffA);
            PG8_WAIT_V(8); PG8_WAIT_L(0); PG8_BAR; PG8_MMA(0, 0, At, B0); PG8_MMA(0, 1, At, B1); PG8_BAR; PG8_SCHED;
            PG8_LDA(At, 1, 1); PG8_STAGE(PG8_SB(1, 0), b3, voffB); PG8_STAGE(PG8_SB(1, 1), b3 + hstep, voffB); PG8_STAGE(PG8_SA(1, 0), a3, voffA);
            PG8_WAIT_V(8); PG8_WAIT_L(0); PG8_BAR; PG8_MMA(1, 0, At, B0); PG8_MMA(1, 1, At, B1); PG8_BAR; PG8_SCHED;
            } else {
            PG8_LDB(B0, 0, 0); PG8_SCHED; PG8_LDA(At, 0, 0); PG8_STAGE(PG8_SA(1, 1), a1 + hstep, voffA);
            PG8_WAIT_L(8); PG8_BAR; PG8_WAIT_L(0); PG8_MMA(0, 0, At, B0); PG8_BAR; PG8_SCHED;
            PG8_LDB(B1, 0, 1); PG8_STAGE(PG8_SB(0, 0), b2, voffB);
            PG8_BAR; PG8_WAIT_L(0); PG8_MMA(0, 1, At, B1); PG8_BAR;
            PG8_LDA(At, 0, 1); PG8_STAGE(PG8_SA(0, 0), a2, voffA);
            PG8_BAR; PG8_WAIT_L(0); PG8_MMA(1, 0, At, B0); PG8_BAR; PG8_SCHED;
            PG8_STAGE(PG8_SB(0, 1), b2 + hstep, voffB);
            PG8_WAIT_V(6); PG8_BAR; PG8_MMA(1, 1, At, B1); PG8_BAR;
            PG8_LDB(B0, 1, 0); PG8_SCHED; PG8_LDA(At, 1, 0); PG8_STAGE(PG8_SA(0, 1), a2 + hstep, voffA);
            PG8_WAIT_L(8); PG8_BAR; PG8_WAIT_L(0); PG8_MMA(0, 0, At, B0); PG8_BAR; PG8_SCHED;
            PG8_LDB(B1, 1, 1); PG8_STAGE(PG8_SB(1, 0), b3, voffB);
            PG8_BAR; PG8_WAIT_L(0); PG8_MMA(0, 1, At, B1); PG8_BAR;
            PG8_LDA(At, 1, 1); PG8_STAGE(PG8_SA(1, 0), a3, voffA);
            PG8_BAR; PG8_WAIT_L(0); PG8_MMA(1, 0, At, B0); PG8_BAR; PG8_SCHED;
            PG8_STAGE(PG8_SB(1, 1), b3 + hstep, voffB);
            PG8_WAIT_V(6); PG8_BAR; PG8_MMA(1, 1, At, B1); PG8_BAR;
            }
        }
        if constexpr (ALIGN_EPI) { if (wr == 0) PG8_BAR; }
        if constexpr (!Epi::AFTER_DRAIN) { E(acc, cur, wr, wc, fr, fq); S.done(cur); }
        if (!has_next) break;
#pragma unroll
        for (int a = 0; a < 2; ++a)
#pragma unroll
            for (int b = 0; b < 2; ++b)
#pragma unroll
                for (int m = 0; m < 4; ++m)
#pragma unroll
                    for (int n = 0; n < 2; ++n) acc[a][b][m][n] = (f32x4){0.f, 0.f, 0.f, 0.f};
        cur = nxt; cA = nA; cB = nB; ++ui;
        if constexpr (ALIGN_EPI) { if (wr == 1) PG8_BAR; }
    }
    PG8_WAIT_V(0);
    if constexpr (!ALIGN_EPI) { if (wr == 0) PG8_BAR; }
    PG8_BAR;
    if constexpr (Epi::AFTER_DRAIN) { E.fused(acc, cur, wr, wc, fr, fq, lds, wid, lane); S.done(cur); }
#undef PG8_SA
#undef PG8_SB
#undef PG8_STAGE
#undef PG8_LDA
#undef PG8_LDB
#undef PG8_MMA
#undef PG8_WAIT_V
#undef PG8_WAIT_L
#undef PG8_BAR
#undef PG8_SCHED
}

struct UnitW { int pm, cn; const float* w0; const float* w1; };
struct GemmW { const bf16_t* A; int K, ldw; const int* rowtok; int tokmask; const PG8_LAS int* rowbase; };
__device__ __forceinline__ void wload1(f32x4& r0, unsigned voff, const char* sbase) { asm volatile("global_load_dwordx4 %0, %1, %2" : "=&v"(r0) : "v"(voff), "s"(sbase) : "memory"); }
template <class Epi, class Sched, bool ALIGN_EPI, bool GATHER>
__device__ __forceinline__ void gemm_phase_wf32(PG8_LAS unsigned char* lds, const GemmW g, const Sched& S, const Epi& E) {
    static_assert(Epi::PERM && !Epi::AFTER_DRAIN, "gemm_phase_wf32: PERM epilogues that run inside the unit loop only");
    const int tid = threadIdx.x, wid = __builtin_amdgcn_readfirstlane(tid >> 6), lane = tid & 63, wr = wid >> 2, wc = wid & 3, fr = lane & 15, fq = lane >> 4;
    const int K = g.K, nt = K / BK;
    const size_t kstep = (size_t)(BK * 2), hstep = (size_t)HALF * K * 2, tstep = 2 * hstep;
    const unsigned ldsw = (unsigned)wid * 1024u;
    const int aoff = lds_byte(wr * 64 + fr, fq * 8), boff = lds_byte(wc * 32 + fr, fq * 8);
    const int cq = lane & 7, sj = lane >> 3;
    #if defined(PROBE_HOT) && (PROBE_HOT == 2 || PROBE_HOT == 4)
    const size_t wrow = (size_t)g.ldw * 4u, wkt = S.hot ? 0 : wrow * BK;
#else
    const size_t wrow = (size_t)g.ldw * 4u, wkt = wrow * BK;
#endif
#if defined(PROBE_HOT) && PROBE_HOT == 5
    const int cqg = S.hot ? (lane & 7) : cq, sjg = S.hot ? (lane >> 3) : sj;
    const size_t wsrc = (size_t)(8 * sjg) * wrow + (size_t)(32 * (wid & 3) + 4 * cqg) * 4u;
#else
    const size_t wsrc = (size_t)(8 * sj) * wrow + (size_t)(32 * (wid & 3) + 4 * cq) * 4u;
#endif
    const int wrho = 16 * (cq & 1) + 4 * (cq >> 1);
    const int wdst = (4 + (wid >> 2)) * HTB + lds_byte(32 * (wid & 3) + wrho, 8 * sj);
#define PG8_SA(b, h) (((b) * 2 + (h)) * HTB)
#define PG8_SB(b, h) ((4 + (b) * 2 + (h)) * HTB)
#define PG8_STAGE(bufoff, gbase, voff) do { _Pragma("unroll") for (int _i = 0; _i < 2; ++_i) \
        __builtin_amdgcn_global_load_lds((const unsigned*)((const char*)(gbase) + (voff)[_i]), (PG8_LAS unsigned*)(lds + (bufoff) + ldsw + _i * 8192), 16, 0, 0); } while (0)
#define PG8_STAGEA(bufoff, h, kb, nx) do { const char* b_ = ((nx) ? nAb : cAb) + (kb); unsigned v_[2]; v_[0] = (nx) ? voN[h][0] : voC[h][0]; v_[1] = (nx) ? voN[h][1] : voC[h][1]; PG8_STAGE(bufoff, b_, v_); } while (0)
#define PG8_LDA(dst, b, h) do { _Pragma("unroll") for (int m = 0; m < 4; ++m) _Pragma("unroll") for (int k = 0; k < 2; ++k) dst[m][k] = *(const PG8_LAS bf16x8*)(lds + PG8_SA(b, h) + aoff + m * 2048 + k * 1024); } while (0)
#define PG8_LDB(dst, b, h) do { _Pragma("unroll") for (int n = 0; n < 2; ++n) _Pragma("unroll") for (int k = 0; k < 2; ++k) dst[n][k] = *(const PG8_LAS bf16x8*)(lds + PG8_SB(b, h) + boff + n * 2048 + k * 1024); } while (0)
#define PG8_MMA(ai, bj, At, Bt) do { __builtin_amdgcn_s_setprio(1); _Pragma("unroll") for (int m = 0; m < 4; ++m) _Pragma("unroll") for (int n = 0; n < 2; ++n) _Pragma("unroll") for (int k = 0; k < 2; ++k) \
        acc[ai][bj][m][n] = __builtin_amdgcn_mfma_f32_16x16x32_bf16(Bt[n][k], At[m][k], acc[ai][bj][m][n], 0, 0, 0); __builtin_amdgcn_s_setprio(0); } while (0)
#define PG8_WAIT_V(n) asm volatile("s_waitcnt vmcnt(" #n ")" ::: "memory")
#define PG8_WAIT_L(n) asm volatile("s_waitcnt lgkmcnt(" #n ")" ::: "memory")
#define PG8_BAR __builtin_amdgcn_s_barrier()
#define PG8_SCHED __builtin_amdgcn_sched_barrier(0)
#define PG8_WLOAD(kk) do { const int kk_ = (kk); const bool in_ = kk_ < nt; const char* q_ = (in_ ? cW : nW) + (size_t)(in_ ? kk_ : kk_ - nt) * wkt; \
        _Pragma("unroll") for (int r_ = 0; r_ < 8; ++r_) wload1(RB[r_], (unsigned)wsrc, q_ + (size_t)r_ * wrow); } while (0)
#define PG8_WWAIT(n) asm volatile("s_waitcnt vmcnt(" #n ")" : "+v"(RB[0]), "+v"(RB[1]), "+v"(RB[2]), "+v"(RB[3]), "+v"(RB[4]), "+v"(RB[5]), "+v"(RB[6]), "+v"(RB[7]) :: "memory")
#define PG8_WWRITE(b) do { _Pragma("unroll") for (int i_ = 0; i_ < 4; ++i_) { u32x4 w_; \
        w_.x = cvt_pk_bf16(RB[0][i_], RB[1][i_]); w_.y = cvt_pk_bf16(RB[2][i_], RB[3][i_]); w_.z = cvt_pk_bf16(RB[4][i_], RB[5][i_]); w_.w = cvt_pk_bf16(RB[6][i_], RB[7][i_]); \
        *(PG8_LAS u32x4*)(lds + (b) * 2 * HTB + wdst + i_ * 64) = w_; } } while (0)
#ifdef PROBE_ABL
    const int abl = S.hot ? PROBE_ABL : 0;
#define PG8_ABL(bit, stmt) do { if (!(abl & (bit))) { stmt; } } while (0)
#else
#define PG8_ABL(bit, stmt) do { stmt; } while (0)
#endif
    UnitW cur, nxt; int ui = 0;
    if (!S.next(0, cur)) return;
    f32x4 acc[2][2][4][2];
#pragma unroll
    for (int a = 0; a < 2; ++a)
#pragma unroll
        for (int b = 0; b < 2; ++b)
#pragma unroll
            for (int m = 0; m < 4; ++m)
#pragma unroll
                for (int n = 0; n < 2; ++n) acc[a][b][m][n] = (f32x4){0.f, 0.f, 0.f, 0.f};
    bf16x8 At[4][2], B0[2][2], B1[2][2]; f32x4 RB[8];
    const bool whalf = wid >= 4;
    const char* cAb; const char* nAb; unsigned voC[2][2], voN[2][2];
#define PG8_UNIT_A(base, vo, pm_) do { int t_ = tid; asm volatile("" : "+v"(t_)); int R_[2], C_[2]; stage_rc(t_ * 16, R_[0], C_[0]); stage_rc(t_ * 16 + 8192, R_[1], C_[1]); \
        if constexpr (GATHER) { base = (const char*)g.A; const int rb_ = __builtin_amdgcn_readfirstlane(g.rowbase[pm_]); _Pragma("unroll") for (int h_ = 0; h_ < 2; ++h_) _Pragma("unroll") for (int i_ = 0; i_ < 2; ++i_) \
            vo[h_][i_] = (unsigned)(g.rowtok[rb_ + (pm_) * BM + h_ * HALF + R_[i_]] & g.tokmask) * (unsigned)(K * 2) + (unsigned)C_[i_] * 2u; } \
        else { base = (const char*)g.A + (size_t)(pm_) * tstep; _Pragma("unroll") for (int h_ = 0; h_ < 2; ++h_) _Pragma("unroll") for (int i_ = 0; i_ < 2; ++i_) vo[h_][i_] = (unsigned)(h_ * HALF + R_[i_]) * (unsigned)(K * 2) + (unsigned)C_[i_] * 2u; } } while (0)
    PG8_UNIT_A(cAb, voC, cur.pm); nAb = cAb;
#pragma unroll
    for (int h_ = 0; h_ < 2; ++h_) { voN[h_][0] = voC[h_][0]; voN[h_][1] = voC[h_][1]; }
    const char* cW = (const char*)(whalf ? cur.w1 : cur.w0);
    const char* nW = cW;
    PG8_WLOAD(0); PG8_STAGEA(PG8_SA(0, 0), 0, 0, false); PG8_STAGEA(PG8_SA(0, 1), 1, 0, false);
    PG8_WWAIT(4); PG8_WWRITE(0);
    PG8_WLOAD(1);
    PG8_WWAIT(0); PG8_WWRITE(1);
    PG8_STAGEA(PG8_SA(1, 0), 0, kstep, false);
    PG8_WLOAD(2);
    PG8_WAIT_L(0);
    if (wr == 1) PG8_BAR;
    PG8_BAR; PG8_BAR;
    for (;;) {
        const bool has_next = S.next(ui + 1, nxt);
        if (has_next) PG8_UNIT_A(nAb, voN, nxt.pm);
        nW = has_next ? (const char*)(whalf ? nxt.w1 : nxt.w0) : cW;
        for (int t = 0; t < nt; t += 2) {
            const bool last = (t == nt - 2);
            const size_t k1 = (size_t)(t + 1) * kstep, k2 = last ? 0 : (size_t)(t + 2) * kstep, k3 = k2 + kstep;
            PG8_LDB(B0, 0, 0); PG8_LDB(B1, 0, 1); PG8_SCHED; PG8_LDA(At, 0, 0); PG8_STAGEA(PG8_SA(1, 1), 1, k1, false);
            PG8_WAIT_V(12); PG8_WAIT_L(0); PG8_BAR; PG8_MMA(0, 0, At, B0); PG8_MMA(0, 1, At, B1); PG8_BAR; PG8_SCHED;
            PG8_WWAIT(2); PG8_ABL(1, PG8_WWRITE(0)); PG8_LDA(At, 0, 1); PG8_STAGEA(PG8_SA(0, 0), 0, k2, last); PG8_ABL(2, PG8_WLOAD(t + 3));
            PG8_WAIT_L(0); PG8_BAR; PG8_MMA(1, 0, At, B0); PG8_MMA(1, 1, At, B1); PG8_BAR; PG8_SCHED;
            PG8_LDB(B0, 1, 0); PG8_LDB(B1, 1, 1); PG8_SCHED; PG8_LDA(At, 1, 0); PG8_STAGEA(PG8_SA(0, 1), 1, k2, last);
            PG8_WAIT_V(12); PG8_WAIT_L(0); PG8_BAR; PG8_MMA(0, 0, At, B0); PG8_MMA(0, 1, At, B1); PG8_BAR; PG8_SCHED;
            PG8_WWAIT(2); PG8_ABL(1, PG8_WWRITE(1)); PG8_LDA(At, 1, 1); PG8_STAGEA(PG8_SA(1, 0), 0, k3, last); PG8_ABL(2, PG8_WLOAD(t + 4));
            PG8_WAIT_L(0); PG8_BAR; PG8_MMA(1, 0, At, B0); PG8_MMA(1, 1, At, B1); PG8_BAR; PG8_SCHED;
        }
        if (!has_next) PG8_WWAIT(0);
        if constexpr (ALIGN_EPI) { if (wr == 0) PG8_BAR; }
        { Unit eu; eu.pm = cur.pm; eu.pn = cur.cn; E(acc, eu, wr, wc, fr, fq); }
        if (!has_next) break;
#pragma unroll
        for (int a = 0; a < 2; ++a)
#pragma unroll
            for (int b = 0; b < 2; ++b)
#pragma unroll
                for (int m = 0; m < 4; ++m)
#pragma unroll
                    for (int n = 0; n < 2; ++n) acc[a][b][m][n] = (f32x4){0.f, 0.f, 0.f, 0.f};
        cur = nxt; cAb = nAb; cW = nW; ++ui;
#pragma unroll
        for (int h_ = 0; h_ < 2; ++h_) { voC[h_][0] = voN[h_][0]; voC[h_][1] = voN[h_][1]; }
        if constexpr (ALIGN_EPI) { if (wr == 1) PG8_BAR; }
    }
    PG8_WAIT_V(0);
    if constexpr (!ALIGN_EPI) { if (wr == 0) PG8_BAR; }
    PG8_BAR;
#undef PG8_SA
#undef PG8_SB
#undef PG8_STAGE
#undef PG8_LDA
#undef PG8_STAGEA
#undef PG8_UNIT_A
#undef PG8_LDB
#undef PG8_MMA
#undef PG8_WAIT_V
#undef PG8_WAIT_L
#undef PG8_BAR
#undef PG8_SCHED
#undef PG8_WLOAD
#undef PG8_ABL
#undef PG8_WWAIT
#undef PG8_WWRITE
}
template <int MODE> struct GroupedOrderW {
    int total, G, c; const PG8_LAS int* tile_e; const float* wa; const float* wb; int hot;
    __device__ __forceinline__ bool next(int i, UnitW& u) const {
        int L = i * G + c;
        if (G == 256) {
            const int x = c & 7, j = c >> 3;
            L = (32 * i + 8 * (x >> 1) + (j & 7)) * 8 + 4 * (x & 1) + (j >> 3);
        }
        if (L >= total) return false;
        int e = __builtin_amdgcn_readfirstlane(tile_e[L >> 3]), nt = L & 7;
        u.pm = L >> 3; u.cn = nt;
#if defined(PROBE_HOT) && PROBE_HOT == 1
        if (hot) { e = 0; nt = 0; }
#endif
        if (MODE == 0) { u.w0 = wa + (size_t)e * 2048 * 1024 + 128 * nt; u.w1 = wb + (size_t)e * 2048 * 1024 + 128 * nt; }
        else { u.w0 = wa + (size_t)e * 1024 * 2048 + 256 * nt; u.w1 = u.w0 + 128; }
        return true;
    }
};
}

namespace att {
using TIN = __hip_bfloat16; using TOUT = __hip_bfloat16;
constexpr int B = 2, H = 1, HKV = 1, SQ = 8192, SKV = 8192, D = 128, QOFF = 0, WINDOW = SKV;
constexpr float THR = 8.f;
constexpr bool WSKIP = false;
constexpr int LDQ = 6144, LDO = 2048;
constexpr int W_INF = 1 << 30;
#ifdef PROF_SECT
#define PROF_T0(sect) unsigned long long pt0_##sect = 0; if (PROF_SECT == (sect) && blockIdx.x == 0) pt0_##sect = __builtin_amdgcn_s_memtime()
#define PROF_T1(sect) do { if (PROF_SECT == (sect) && blockIdx.x == 0) { const unsigned long long d_ = __builtin_amdgcn_s_memtime() - pt0_##sect; if (threadIdx.x == 0) { PROFW[0] += (unsigned)d_; } } } while (0)
#else
#define PROF_T0(sect) do {} while (0)
#define PROF_T1(sect) do {} while (0)
#endif
constexpr float SCALE = 0.08838834764831845f;
constexpr int NW = 8, QBLK = 32, KVBLK = 64, QB = NW * QBLK;
constexpr int SHM_V = KVBLK * D * 2, SHM_K = KVBLK * D * 2;
constexpr int OFF_WS = 2 * SHM_V + 2 * SHM_K, OFF_CB = OFF_WS + NW * 64 * 4, LDS_BYTES = OFF_CB + 2 * 64 * 4;
static_assert(D == 128 && SQ % QB == 0 && SKV % KVBLK == 0 && H % HKV == 0 && QOFF >= 0 && QOFF + SQ <= SKV && WINDOW >= 1, "geometry");

using bf16 = __hip_bfloat16;
typedef short bf16x8 __attribute__((ext_vector_type(8)));
typedef short s16x4 __attribute__((ext_vector_type(4)));
typedef float f32x16 __attribute__((ext_vector_type(16)));
typedef float f32x4 __attribute__((ext_vector_type(4)));
typedef unsigned u32x4 __attribute__((ext_vector_type(4)));
template <class A, class Bt> struct same_t { static constexpr bool v = false; };
template <class A> struct same_t<A, A> { static constexpr bool v = true; };

#define KSWZ(row, colB) ((row) * 256 + ((colB) ^ (((row) & 7) << 4)))
#define SBAR() __builtin_amdgcn_sched_barrier(0)
__device__ __forceinline__ int v_st(int k, int c) { const int kk = (k & ~0xC) | ((k & 4) << 1) | ((k & 8) >> 1); return ((kk >> 3) * 4 + (c >> 5)) * 512 + ((kk & 7) * 32 + (c & 31)) * 2; }
__device__ __forceinline__ int v_rd_base(int lane) { return ((lane & 3) << 3) | (((lane >> 2) & 3) << 6) | (((lane >> 4) & 1) << 5) | (((lane >> 5) & 1) << 8); }
constexpr int v_rd_off(int d0, int ks, int half) { return d0 * 512 + ks * 4096 + half * 2048; }
__device__ __forceinline__ int crow(int r, int hi) { return (r & 3) + 8 * (r >> 2) + 4 * hi; }
__device__ __forceinline__ unsigned cvtpk(float lo, float hi) {
    unsigned r; asm volatile("v_cvt_pk_bf16_f32 %0, %1, %2" : "=v"(r) : "v"(lo), "v"(hi)); return r;
}
__device__ __forceinline__ bf16x8 pack8(f32x4 a, f32x4 b) {
    u32x4 w = {cvtpk(a[0], a[1]), cvtpk(a[2], a[3]), cvtpk(b[0], b[1]), cvtpk(b[2], b[3])};
    return *reinterpret_cast<bf16x8*>(&w);
}
template <class T> __device__ __forceinline__ bf16x8 load8(const T* p) {
    if constexpr (same_t<T, float>::v) { return pack8(*(const f32x4*)p, *(const f32x4*)(p + 4)); }
    else { return *reinterpret_cast<const bf16x8*>(p); }
}
__device__ __forceinline__ void mask_tile(f32x16& p0, f32x16& p1, int dq, unsigned W) {
    const float NEG = -__builtin_inff();
#pragma unroll
    for (int r = 0; r < 16; ++r) {
        const int c = (r & 3) + 8 * (r >> 2);
        if ((unsigned)(dq - c) >= W) p0[r] = NEG;
        if ((unsigned)(dq - c - 32) >= W) p1[r] = NEG;
    }
}
__device__ __forceinline__ void partialSM(f32x16& p0, f32x16& p1, float& m_reg, float& mn, float& alpha) {
    constexpr float C2 = 1.4426950408889634f * SCALE;
    mn = m_reg; alpha = 1.f;
    const float mnL = -m_reg * C2;
    for (int r = 0; r < 16; ++r) p0[r] = fmaf(p0[r], C2, mnL); for (int r = 0; r < 16; ++r) p1[r] = fmaf(p1[r], C2, mnL);
    for (int r = 0; r < 16; ++r) p0[r] = __builtin_amdgcn_exp2f(p0[r]);
}
__device__ __forceinline__ void finishSM(f32x16& p0, f32x16& p1, float alpha, float& l_reg, bf16x8& pa0, bf16x8& pa1, bf16x8& pa2, bf16x8& pa3) {
    for (int r = 0; r < 16; ++r) p1[r] = __builtin_amdgcn_exp2f(p1[r]);
    float ps = 0; for (int r = 0; r < 16; ++r) ps += p0[r]; for (int r = 0; r < 16; ++r) ps += p1[r];
    { auto rr = __builtin_amdgcn_permlane32_swap(__float_as_uint(ps), __float_as_uint(ps), false, false);
      ps = __uint_as_float(rr[0]) + __uint_as_float(rr[1]); }
    l_reg += ps; (void)alpha;
#define PK4(P, B_, OUT) do { unsigned a0 = cvtpk(P[B_+0], P[B_+1]), a1 = cvtpk(P[B_+2], P[B_+3]);                          \
        unsigned b0 = cvtpk(P[B_+4], P[B_+5]), b1 = cvtpk(P[B_+6], P[B_+7]);                                             \
        auto r0 = __builtin_amdgcn_permlane32_swap(a0, b0, false, false); auto r1 = __builtin_amdgcn_permlane32_swap(a1, b1, false, false); \
        u32x4 w = {r0[0], r1[0], r0[1], r1[1]}; OUT = *reinterpret_cast<bf16x8*>(&w); } while (0)
    PK4(p0, 0, pa0); PK4(p0, 8, pa1); PK4(p1, 0, pa2); PK4(p1, 8, pa3);
#undef PK4
}
template <int KB, bool SK>
__device__ __forceinline__ void qkt(f32x16& p0, f32x16& p1, const char* K_lds, int r32, int hi, const bf16x8* qr, bool act, const float* cbt, float cqs) {
    if (SK && !act) { const float NEG = -__builtin_inff();
#pragma unroll
        for (int r = 0; r < 16; ++r) { p0[r] = NEG; p1[r] = NEG; } return; }
    { const f32x4* c4 = (const f32x4*)(cbt + KB * 64);
#pragma unroll
      for (int g = 0; g < 4; ++g) { const f32x4 a = c4[2 * g], b = c4[8 + 2 * g];
#pragma unroll
          for (int i = 0; i < 4; ++i) { p0[4 * g + i] = cqs - a[i]; p1[4 * g + i] = cqs - b[i]; } } }
    const char* kb[4];
#pragma unroll
    for (int dd = 0; dd < 4; ++dd) kb[dd] = K_lds + KB * SHM_K + KSWZ(r32, (dd * 16 + hi * 8) * 2);
#pragma unroll
    for (int d0 = 0; d0 < 8; ++d0) { const char* a = kb[d0 & 3] + (d0 >> 2) * 128;
        bf16x8 b0 = *reinterpret_cast<const bf16x8*>(a);
        bf16x8 b1 = *reinterpret_cast<const bf16x8*>(a + 32 * 256);
        p0 = __builtin_amdgcn_mfma_f32_32x32x16_bf16(b0, qr[d0], p0, 0, 0, 0);
        p1 = __builtin_amdgcn_mfma_f32_32x32x16_bf16(b1, qr[d0], p1, 0, 0, 0); }
}
template <int VB, bool SK>
__device__ __forceinline__ void pv_tile(f32x16* o, int vb0, bf16x8 pa0, bf16x8 pa1, bf16x8 pa2, bf16x8 pa3, bool act) {
    if (SK && !act) return;
#define TRRD(dst, off) asm volatile("ds_read_b64_tr_b16 %0, %1 offset:%2" : "=&v"(dst) : "v"(vb0), "i"(off) : "memory")
#define PV_D0(d0) do { s16x4 l0, l1, l2, l3, h0, h1, h2, h3; constexpr int b_ = VB * SHM_V + v_rd_off(d0, 0, 0);     \
        TRRD(l0, b_); TRRD(h0, b_ + 2048); TRRD(l1, b_ + 4096); TRRD(h1, b_ + 6144); TRRD(l2, b_ + 8192); TRRD(h2, b_ + 10240); TRRD(l3, b_ + 12288); TRRD(h3, b_ + 14336); \
        asm volatile("s_waitcnt lgkmcnt(0)" ::: "memory"); SBAR();                 \
        o[d0] = __builtin_amdgcn_mfma_f32_32x32x16_bf16(pa0, (bf16x8){l0[0], l0[1], l0[2], l0[3], h0[0], h0[1], h0[2], h0[3]}, o[d0], 0, 0, 0);   \
        o[d0] = __builtin_amdgcn_mfma_f32_32x32x16_bf16(pa1, (bf16x8){l1[0], l1[1], l1[2], l1[3], h1[0], h1[1], h1[2], h1[3]}, o[d0], 0, 0, 0);   \
        o[d0] = __builtin_amdgcn_mfma_f32_32x32x16_bf16(pa2, (bf16x8){l2[0], l2[1], l2[2], l2[3], h2[0], h2[1], h2[2], h2[3]}, o[d0], 0, 0, 0);   \
        o[d0] = __builtin_amdgcn_mfma_f32_32x32x16_bf16(pa3, (bf16x8){l3[0], l3[1], l3[2], l3[3], h3[0], h3[1], h3[2], h3[3]}, o[d0], 0, 0, 0); } while (0)
    PV_D0(0); PV_D0(1); PV_D0(2); PV_D0(3);
#undef PV_D0
#undef TRRD
}
template <class TIn, class TOut> struct BlockRef { const TIn* Q; const TIn* K; const TIn* V; TOut* O; const float* C; int P0, jlo; float mref; };
template <class TIn> struct Seam {
    bf16x8 qr[8];
    bf16x8 st_v0, st_v1, st_k0, st_k1; f32x4 sf0, sf1, sf2, sf3;
    float cq, st_c;
    f32x4 tq[16];
};
__device__ __forceinline__ int swa_jlo(int P0, int W) { const int lowk = P0 - W + 1; return lowk > 0 ? lowk / KVBLK : 0; }
#define ROW(p, k0, rr) ((p) + (size_t)((k0) + (rr)) * LDQ + sc)
#define VMW() asm volatile("s_waitcnt vmcnt(0)" ::: "memory")
#define VMWN(n) asm volatile("s_waitcnt vmcnt(%0)" :: "i"(n) : "memory")
#define SLOAD_H(Kp, Vp, Cp, k0) do { S.st_v0 = load8<TIn>(ROW(Vp, k0, sr)); S.st_v1 = load8<TIn>(ROW(Vp, k0, 32 + sr));              \
                         S.st_k0 = load8<TIn>(ROW(Kp, k0, sr)); S.st_k1 = load8<TIn>(ROW(Kp, k0, 32 + sr)); S.st_c = (Cp)[(k0) + (tid & 63)]; } while (0)
#define SWRITE_HK(bf) do { *(bf16x8*)(K_lds + (bf) * SHM_K + kws) = S.st_k0; *(bf16x8*)(K_lds + (bf) * SHM_K + kws + 32 * 256) = S.st_k1; \
                           if (tid < 64) cbw[(bf) * 64 + tid] = S.st_c; } while (0)
#define SWRITE_HV(bf) do { *(bf16x8*)(V_lds + (bf) * SHM_V + vst0) = S.st_v0; *(bf16x8*)(V_lds + (bf) * SHM_V + vst1) = S.st_v1; } while (0)
#define SWRITE_H(bf) do { SWRITE_HV(bf); SWRITE_HK(bf); } while (0)
#define SLOAD_F(p, k0) do { S.sf0 = *(const f32x4*)ROW(p, k0, sr); S.sf1 = *(const f32x4*)(ROW(p, k0, sr) + 4);                \
                            S.sf2 = *(const f32x4*)ROW(p, k0, 32 + sr); S.sf3 = *(const f32x4*)(ROW(p, k0, 32 + sr) + 4); } while (0)
#define SWRITE_KF(bf) do { *(bf16x8*)(K_lds + (bf) * SHM_K + kws) = pack8(S.sf0, S.sf1); *(bf16x8*)(K_lds + (bf) * SHM_K + kws + 32 * 256) = pack8(S.sf2, S.sf3); } while (0)
#define SWRITE_VF(bf) do { *(bf16x8*)(V_lds + (bf) * SHM_V + vst0) = pack8(S.sf0, S.sf1); *(bf16x8*)(V_lds + (bf) * SHM_V + vst1) = pack8(S.sf2, S.sf3); } while (0)
template <class TIn, class TOut>
__device__ __forceinline__ void causal_swa_prime(const BlockRef<TIn, TOut>& cur, int W, char* lds, Seam<TIn>& S) {
    constexpr bool F32 = same_t<TIn, float>::v;
    const int tid = threadIdx.x, wid = __builtin_amdgcn_readfirstlane(tid >> 6), lane = tid & 63, r32 = lane & 31, hi = lane >> 5;
    const int sr = tid >> 4, sc = (tid & 15) * 8, kws = KSWZ(sr, sc * 2); char* K_lds = lds + 2 * SHM_V; float* cbw = (float*)(lds + OFF_CB);
    const int kb0 = cur.jlo * KVBLK;
    for (int d0 = 0; d0 < 8; ++d0) S.qr[d0] = load8<TIn>(cur.Q + (size_t)(wid * QBLK + r32) * LDQ + d0 * 16 + hi * 8);
    S.cq = cur.C[cur.P0 + wid * QBLK + r32];
    if constexpr (F32) { SLOAD_F((const float*)cur.K, kb0); VMW(); SWRITE_KF(0); SBAR(); SLOAD_F((const float*)cur.V, kb0); }
    else { SLOAD_H(cur.K, cur.V, cur.C, kb0); VMW(); SWRITE_HK(0); }
    __syncthreads();
}
template <class TIn, class TOut>
__device__ __forceinline__ void causal_swa_block(const BlockRef<TIn, TOut>& cur, const BlockRef<TIn, TOut>& nxt, int skv, int W, char* lds, Seam<TIn>& S, unsigned* qhead, volatile __attribute__((address_space(3))) int* qw, bool qmore) {
    constexpr bool F32 = same_t<TIn, float>::v;
    const int tid = threadIdx.x, wid = __builtin_amdgcn_readfirstlane(tid >> 6), lane = tid & 63, r32 = lane & 31, hi = lane >> 5;
    int pop_ = 1 << 30; if (threadIdx.x == 0 && qmore) pop_ = (int)atomicAdd(qhead, 1u);
    const int j_lo = cur.jlo;
    int j_hi = (cur.P0 + QB - 1) / KVBLK + 1; if (j_hi > skv / KVBLK) j_hi = skv / KVBLK;
    const int NT = j_hi - j_lo;
    const int kbn = nxt.jlo * KVBLK;
    const int qlo = cur.P0 + wid * QBLK, qm = qlo + r32 - 4 * hi;
    char* V_lds = lds; char* K_lds = lds + 2 * SHM_V; float* cbw = (float*)(lds + OFF_CB); const float* cbt = cbw + 4 * hi; const float* Ch = cur.C;
    float* ws = (float*)(lds + 2 * SHM_V + 2 * SHM_K) + wid * 64; float* li_l = ws, * al_l = ws + 32;
    float m_reg = cur.mref, l_reg = 0; f32x16 o[4] = {};
    const int sr = tid >> 4, sc = (tid & 15) * 8, vst0 = v_st(sr, sc), vst1 = v_st(32 + sr, sc), kws = KSWZ(sr, sc * 2);
    const int vb0 = (int)(uintptr_t)V_lds + v_rd_base(lane);
    const TIn* Kh = cur.K; const TIn* Vh = cur.V;
#define RESC(a) do { (void)(a); (void)al_l; } while (0)
#define KBASE(t) ((j_lo + (t)) * KVBLK)
#define ACT(t) (KBASE(t) <= qlo + QBLK - 1 && KBASE(t) + KVBLK - 1 >= qlo - W + 1)
#define MASKT(P0_, P1_, t) do { const int kb_ = KBASE(t); if ((!SK || ACT(t)) && (kb_ + KVBLK - 1 > qlo || kb_ <= qlo + QBLK - 1 - W)) mask_tile(P0_, P1_, qm - kb_, (unsigned)W); } while (0)
    constexpr int NQL = F32 ? 16 : 9;
    constexpr bool SK = WSKIP && !F32;
#define SEAM_K0() do { VMWN(NQL); if constexpr (F32) { SWRITE_KF(0); SBAR(); SLOAD_F((const float*)nxt.V, kbn); } else { SWRITE_HK(0); } SBAR(); } while (0)
    f32x16 pA0, pA1, pB0, pB1; float mnA, mnB, alA, alB; bf16x8 pa0, pa1, pa2, pa3;
    if constexpr (F32) { VMW(); SWRITE_VF(0); SBAR(); } else { SWRITE_HV(0); SBAR(); }
    if (NT > 1) { if constexpr (F32) SLOAD_F((const float*)Kh, KBASE(1)); else SLOAD_H(Kh, Vh, Ch, KBASE(1)); }
    SBAR(); qkt<0, SK>(pA0, pA1, K_lds, r32, hi, S.qr, ACT(0), cbt, S.cq);
    if constexpr (F32) { if (NT > 1) { VMW(); SWRITE_KF(1); SBAR(); SLOAD_F((const float*)Vh, KBASE(1)); } }
    MASKT(pA0, pA1, 0); partialSM(pA0, pA1, m_reg, mnA, alA);
    if (NT > 1) { VMW(); if constexpr (F32) { SWRITE_VF(1); SBAR(); if (NT > 2) SLOAD_F((const float*)Kh, KBASE(2)); } else SWRITE_H(1); }
    if (tid == 0) qw[0] = pop_;
    __syncthreads();
#define HALF_STEP(PX0, PX1, mnX, alX, PY0, PY1, alY, t, KB, VB, SB) do {                                                      \
        SBAR(); qkt<KB, SK>(PX0, PX1, K_lds, r32, hi, S.qr, ACT(t), cbt, S.cq);                                  \
        finishSM(PY0, PY1, alY, l_reg, pa0, pa1, pa2, pa3); SBAR();                                                           \
        if ((t) + 1 < NT) { if constexpr (F32) { VMW(); SWRITE_KF(SB); SBAR(); SLOAD_F((const float*)Vh, KBASE((t) + 1)); }  \
                            else { SLOAD_H(Kh, Vh, Ch, KBASE((t) + 1)); } SBAR(); }                                           \
        pv_tile<VB, SK>(o, vb0, pa0, pa1, pa2, pa3, ACT((t) - 1)); MASKT(PX0, PX1, (t)); partialSM(PX0, PX1, m_reg, mnX, alX);                                        \
        __syncthreads();                                                                                                      \
        if ((t) + 1 < NT) { VMW(); if constexpr (F32) { SWRITE_VF(SB); SBAR(); if ((t) + 2 < NT) SLOAD_F((const float*)Kh, KBASE((t) + 2)); } \
                            else { SWRITE_H(SB); } }                                                                          \
        RESC(alX); __syncthreads(); } while (0)
    for (int t = 1; t + 1 < NT; t += 2) {
        HALF_STEP(pB0, pB1, mnB, alB, pA0, pA1, alA, t, 1, 0, 0);
        HALF_STEP(pA0, pA1, mnA, alA, pB0, pB1, alB, t + 1, 0, 1, 1);
    }
    int r32s = r32, his = hi; asm volatile("" : "+v"(r32s), "+v"(his));
    const bool even = (NT & 1) == 0;
    if (even) { SBAR(); qkt<1, SK>(pB0, pB1, K_lds, r32, hi, S.qr, ACT(NT - 1), cbt, S.cq); SBAR(); }
#define QROW(e) (nxt.Q + (size_t)(wid * QBLK + r32) * LDQ + ((e) >> 1) * 16 + hi * 8 + ((e) & 1) * 4)
    if constexpr (F32) { SLOAD_F((const float*)nxt.K, kbn); SBAR();
#pragma unroll
        for (int e = 0; e < 8; ++e) S.tq[e] = *(const f32x4*)QROW(e); }
    else { SLOAD_H(nxt.K, nxt.V, nxt.C, kbn); SBAR();
#pragma unroll
        for (int d0 = 0; d0 < 8; ++d0) S.qr[d0] = load8<TIn>(nxt.Q + (size_t)(wid * QBLK + r32s) * LDQ + d0 * 16 + his * 8);
        S.cq = nxt.C[nxt.P0 + wid * QBLK + r32s]; }
    SBAR();
    finishSM(pA0, pA1, alA, l_reg, pa0, pa1, pa2, pa3); SBAR();
    if constexpr (F32) {
#pragma unroll
        for (int e = 8; e < 16; ++e) S.tq[e] = *(const f32x4*)QROW(e); SBAR(); }
#undef QROW
    pv_tile<0, SK>(o, vb0, pa0, pa1, pa2, pa3, ACT(even ? NT - 2 : NT - 1));
    if (even) { MASKT(pB0, pB1, NT - 1); partialSM(pB0, pB1, m_reg, mnB, alB); __syncthreads(); RESC(alB);
        finishSM(pB0, pB1, alB, l_reg, pa0, pa1, pa2, pa3); SBAR(); pv_tile<1, SK>(o, vb0, pa0, pa1, pa2, pa3, ACT(NT - 1)); }
    SBAR(); SEAM_K0();
    if (his == 0) li_l[r32s] = l_reg; asm volatile("s_waitcnt lgkmcnt(0)" ::: "memory");
    float rli[16];
#pragma unroll
    for (int r = 0; r < 16; ++r) rli[r] = __builtin_amdgcn_rcpf(li_l[crow(r, his)]);
    TOut* Ow = cur.O + (size_t)(wid * QBLK) * LDO;
#pragma unroll
    for (int r = 0; r < 16; ++r) { const int orow = crow(r, his);
#pragma unroll
        for (int d0 = 0; d0 < 4; ++d0) { const float v = o[d0][r] * rli[r];
            if constexpr (same_t<TOut, float>::v) { Ow[(size_t)orow * LDO + d0 * 32 + r32] = v; }
            else { const float vn = __shfl_xor(v, 1);
                   if ((r32s & 1) == 0) *(unsigned*)(Ow + (size_t)orow * LDO + d0 * 32 + r32s) = cvtpk(v, vn); } } }
    if constexpr (F32) {
#pragma unroll
        for (int d0 = 0; d0 < 8; ++d0) S.qr[d0] = pack8(S.tq[2 * d0], S.tq[2 * d0 + 1]); }
    __syncthreads();
#undef RESC
#undef KBASE
#undef ACT
#undef MASKT
#undef SEAM_K0
#undef HALF_STEP
}
#undef ROW
#undef VMW
#undef VMWN
#undef SLOAD_H
#undef SWRITE_HK
#undef SWRITE_HV
#undef SWRITE_H
#undef SLOAD_F
#undef SWRITE_KF
#undef SWRITE_VF


constexpr int QB2 = 128, NQB2 = SQ / QB2, SHM_V2 = 2 * SHM_V;
constexpr int P_OFF_K = 2 * SHM_V2, P_OFF_X = P_OFF_K + 2 * SHM_K, PAIR_RING = P_OFF_X + 2 * NW * 2048;
constexpr int P_OFF_L = PAIR_RING + 2048, P_OFF_CB = P_OFF_L + NW * 64 * 4, PAIR_LDS = P_OFF_CB + 2 * 64 * 4;
struct PRef { const bf16* Q; const bf16* K; const bf16* V; bf16* O; const float* C; int P0, jlo; float mref; };
template <int BUF, int NV>
__device__ __forceinline__ void pair_pv(f32x16* o, int vb0, bf16x8 pa0, bf16x8 pa1, bf16x8 pa2, bf16x8 pa3) {
#define TRRD(dst, off) asm volatile("ds_read_b64_tr_b16 %0, %1 offset:%2" : "=&v"(dst) : "v"(vb0), "i"(off) : "memory")
#define PV_D0(d0) do { s16x4 l0, l1, l2, l3, h0, h1, h2, h3; constexpr int b_ = BUF * SHM_V2 + v_rd_off(d0, 0, 0); \
        TRRD(l0, b_); TRRD(h0, b_ + 2048); TRRD(l1, b_ + 4096); TRRD(h1, b_ + 6144); TRRD(l2, b_ + 8192); TRRD(h2, b_ + 10240); TRRD(l3, b_ + 12288); TRRD(h3, b_ + 14336); \
        asm volatile("s_waitcnt lgkmcnt(0)" ::: "memory"); SBAR(); \
        o[d0] = __builtin_amdgcn_mfma_f32_32x32x16_bf16(pa0, (bf16x8){l0[0], l0[1], l0[2], l0[3], h0[0], h0[1], h0[2], h0[3]}, o[d0], 0, 0, 0); \
        o[d0] = __builtin_amdgcn_mfma_f32_32x32x16_bf16(pa1, (bf16x8){l1[0], l1[1], l1[2], l1[3], h1[0], h1[1], h1[2], h1[3]}, o[d0], 0, 0, 0); \
        o[d0] = __builtin_amdgcn_mfma_f32_32x32x16_bf16(pa2, (bf16x8){l2[0], l2[1], l2[2], l2[3], h2[0], h2[1], h2[2], h2[3]}, o[d0], 0, 0, 0); \
        o[d0] = __builtin_amdgcn_mfma_f32_32x32x16_bf16(pa3, (bf16x8){l3[0], l3[1], l3[2], l3[3], h3[0], h3[1], h3[2], h3[3]}, o[d0], 0, 0, 0); } while (0)
    PV_D0(0); PV_D0(1); if constexpr (NV == 4) { PV_D0(2); PV_D0(3); }
#undef PV_D0
#undef TRRD
}
struct PStage { bf16x8 k0, k1, v0, v1, v2, v3; float c; };
template <int NV>
__device__ __forceinline__ void pair_block(const PRef& B, char* lds, volatile __attribute__((address_space(3))) unsigned* PROFW) {
    PROF_T0(2);
    PROF_T0(8);
    const int tid = threadIdx.x, wid = __builtin_amdgcn_readfirstlane(tid >> 6), lane = tid & 63, r32 = lane & 31, hi = lane >> 5, pr = wid & 3, kh = wid >> 2;
    char* V_lds = lds; char* K_lds = lds + P_OFF_K; char* X_lds = lds + P_OFF_X; float* L_lds = (float*)(lds + P_OFF_L); float* cbw = (float*)(lds + P_OFF_CB);
    const int j_lo = B.jlo, NT = (B.P0 >> 6) + 2 - j_lo;
    const int sr = tid >> 4, sc = (tid & 15) * 8, vst0 = v_st(sr, sc), vst1 = v_st(32 + sr, sc), kws = KSWZ(sr, sc * 2);
    const int vb0 = (int)(uintptr_t)V_lds + kh * (NV == 4 ? SHM_V : 1024) + v_rd_base(lane);
    int ka[4];
#pragma unroll
    for (int dd = 0; dd < 4; ++dd) ka[dd] = (int)(uintptr_t)K_lds + kh * (32 * 256) + KSWZ(r32, (dd * 16 + hi * 8) * 2);
    constexpr float C2 = 1.4426950408889634f * SCALE;
    const float mnL = -B.mref * C2;
    const int qrow = B.P0 + pr * 32 + r32;
    bf16x8 qr[8];
#pragma unroll
    for (int d0 = 0; d0 < 8; ++d0) qr[d0] = load8<bf16>(B.Q + (size_t)(pr * 32 + r32) * LDQ + d0 * 16 + hi * 8);
    const float cq = B.C[qrow];
    f32x16 o[NV] = {}; float l_reg = 0.f;
    PStage stA, stB;
#define TCL(t) ((t) < NT ? (t) : NT - 1)
#define PLOADK(st, t) do { const int k0_ = (j_lo + TCL(t)) * KVBLK; const bf16* kp_ = B.K + (size_t)(k0_ + sr) * LDQ + sc; st.k0 = load8<bf16>(kp_); st.k1 = load8<bf16>(kp_ + (size_t)32 * LDQ); st.c = B.C[k0_ + (tid & 63)]; } while (0)
#define PLOADV(st, t) do { const int k0_ = (j_lo + TCL(t)) * KVBLK; const bf16* vp_ = B.V + (size_t)(k0_ + sr) * LDQ + sc; st.v0 = load8<bf16>(vp_); st.v1 = load8<bf16>(vp_ + (size_t)32 * LDQ); \
        if constexpr (NV == 4) { st.v2 = load8<bf16>(vp_ + 128); st.v3 = load8<bf16>(vp_ + (size_t)32 * LDQ + 128); } } while (0)
#define PWRITEK(st, bf) do { *(bf16x8*)(K_lds + (bf) * SHM_K + kws) = st.k0; *(bf16x8*)(K_lds + (bf) * SHM_K + kws + 32 * 256) = st.k1; if (tid < 64) cbw[(bf) * 64 + tid] = st.c; } while (0)
#define PWRITEV(st, bf) do { *(bf16x8*)(V_lds + (bf) * SHM_V2 + vst0) = st.v0; *(bf16x8*)(V_lds + (bf) * SHM_V2 + vst1) = st.v1; \
        if constexpr (NV == 4) { *(bf16x8*)(V_lds + (bf) * SHM_V2 + SHM_V + vst0) = st.v2; *(bf16x8*)(V_lds + (bf) * SHM_V2 + SHM_V + vst1) = st.v3; } } while (0)
#define KRD_(dst, d0, KB) asm volatile("ds_read_b128 %0, %1 offset:%2" : "=&v"(dst) : "v"(ka[(d0) & 3]), "i"((KB) * SHM_K + ((d0) >> 2) * 128) : "memory")
#define KWT_(n, r) asm volatile("s_waitcnt lgkmcnt(" #n ")" : "+v"(r) :: "memory")
#define ASTAGE(t, KB, XB) do { \
        f32x16 p; { const f32x4* c4 = (const f32x4*)(cbw + (KB) * 64 + 32 * kh + 4 * hi); \
            _Pragma("unroll") for (int g = 0; g < 4; ++g) { const f32x4 a = c4[2 * g]; _Pragma("unroll") for (int i = 0; i < 4; ++i) p[4 * g + i] = cq - a[i]; } } \
        { bf16x8 kf0, kf1, kf2, kf3;     \
          KRD_(kf0, 0, KB); KRD_(kf1, 1, KB); KRD_(kf2, 2, KB); KRD_(kf3, 3, KB); \
          KWT_(3, kf0); p = __builtin_amdgcn_mfma_f32_32x32x16_bf16(kf0, qr[0], p, 0, 0, 0); KRD_(kf0, 4, KB); \
          KWT_(3, kf1); p = __builtin_amdgcn_mfma_f32_32x32x16_bf16(kf1, qr[1], p, 0, 0, 0); KRD_(kf1, 5, KB); \
          KWT_(3, kf2); p = __builtin_amdgcn_mfma_f32_32x32x16_bf16(kf2, qr[2], p, 0, 0, 0); KRD_(kf2, 6, KB); \
          KWT_(3, kf3); p = __builtin_amdgcn_mfma_f32_32x32x16_bf16(kf3, qr[3], p, 0, 0, 0); KRD_(kf3, 7, KB); \
          KWT_(3, kf0); p = __builtin_amdgcn_mfma_f32_32x32x16_bf16(kf0, qr[4], p, 0, 0, 0); \
          KWT_(2, kf1); p = __builtin_amdgcn_mfma_f32_32x32x16_bf16(kf1, qr[5], p, 0, 0, 0); \
          KWT_(1, kf2); p = __builtin_amdgcn_mfma_f32_32x32x16_bf16(kf2, qr[6], p, 0, 0, 0); \
          KWT_(0, kf3); p = __builtin_amdgcn_mfma_f32_32x32x16_bf16(kf3, qr[7], p, 0, 0, 0); } \
        { const int kb = (j_lo + (t)) * KVBLK + 32 * kh; if (kb + 31 > B.P0 + pr * 32) { const int dq = qrow - kb - 4 * hi; const float NEG = -__builtin_inff(); \
            _Pragma("unroll") for (int r = 0; r < 16; ++r) { const int c = (r & 3) + 8 * (r >> 2); if (dq - c < 0) p[r] = NEG; } } } \
        _Pragma("unroll") for (int r = 0; r < 16; ++r) p[r] = __builtin_amdgcn_exp2f(fmaf(p[r], C2, mnL)); \
        { float ps = 0.f; _Pragma("unroll") for (int r = 0; r < 16; ++r) ps += p[r]; \
          auto rr = __builtin_amdgcn_permlane32_swap(__float_as_uint(ps), __float_as_uint(ps), false, false); l_reg += __uint_as_float(rr[0]) + __uint_as_float(rr[1]); } \
        { unsigned a0 = cvtpk(p[0], p[1]), a1 = cvtpk(p[2], p[3]), b0 = cvtpk(p[4], p[5]), b1 = cvtpk(p[6], p[7]); \
          auto r0 = __builtin_amdgcn_permlane32_swap(a0, b0, false, false); auto r1 = __builtin_amdgcn_permlane32_swap(a1, b1, false, false); u32x4 w = {r0[0], r1[0], r0[1], r1[1]}; \
          *(u32x4*)(X_lds + (XB) * (NW * 2048) + wid * 2048 + lane * 16) = w; } \
        { unsigned a0 = cvtpk(p[8], p[9]), a1 = cvtpk(p[10], p[11]), b0 = cvtpk(p[12], p[13]), b1 = cvtpk(p[14], p[15]); \
          auto r0 = __builtin_amdgcn_permlane32_swap(a0, b0, false, false); auto r1 = __builtin_amdgcn_permlane32_swap(a1, b1, false, false); u32x4 w = {r0[0], r1[0], r0[1], r1[1]}; \
          *(u32x4*)(X_lds + (XB) * (NW * 2048) + wid * 2048 + 1024 + lane * 16) = w; } } while (0)
#define BSTAGE(VB, XB) do { const char* xo_ = X_lds + (XB) * (NW * 2048) + wid * 2048 + lane * 16; const char* xp_ = X_lds + (XB) * (NW * 2048) + (wid ^ 4) * 2048 + lane * 16; \
        const bf16x8 own0 = *(const bf16x8*)xo_, own1 = *(const bf16x8*)(xo_ + 1024), oth0 = *(const bf16x8*)xp_, oth1 = *(const bf16x8*)(xp_ + 1024); \
        pair_pv<VB, NV>(o, vb0, kh ? oth0 : own0, kh ? oth1 : own1, kh ? own0 : oth0, kh ? own1 : oth1); } while (0)
    PLOADK(stA, 0); PLOADV(stA, 0); PLOADK(stB, 1); PLOADV(stB, 1);
    __syncthreads();
    PWRITEK(stA, 0); PWRITEV(stA, 0);
    PLOADK(stA, 2);
    __syncthreads();
    PROF_T1(8);
    PROF_T0(9);
    ASTAGE(0, 0, 0);
    PWRITEK(stB, 1);
    PLOADV(stA, 2); PLOADK(stB, 3);
    __syncthreads();
#define PITER(t, P, SV, SK) do {     \
        BSTAGE(P, P); \
        if ((t) + 1 < NT) { ASTAGE((t) + 1, (P) ^ 1, (P) ^ 1); PWRITEV(SV, (P) ^ 1); PWRITEK(SK, P); PLOADV(SV, (t) + 3); PLOADK(SK, (t) + 4); } \
        __syncthreads(); } while (0)
    PROF_T1(9);
    PROF_T1(2);
    { PROF_T0(3);
    int t = 0;
    for (; t + 1 < NT; t += 2) { PITER(t, 0, stB, stA); PITER(t + 1, 1, stA, stB); }
    if (t < NT) PITER(t, 0, stB, stA);
    PROF_T1(3); }
    { PROF_T0(4);
    { PROF_T0(6);
    if (hi == 0) L_lds[wid * 64 + r32] = l_reg;
    __syncthreads();
    PROF_T1(6); }
    PROF_T0(7);
    if (hi == 0) L_lds[wid * 64 + 32 + r32] = l_reg + L_lds[(wid ^ 4) * 64 + r32];
    asm volatile("s_waitcnt lgkmcnt(0)" ::: "memory");
    float rli[16];
#pragma unroll
    for (int r = 0; r < 16; ++r) rli[r] = __builtin_amdgcn_rcpf(L_lds[wid * 64 + 32 + crow(r, hi)]);
    constexpr int OROW = NV * 64 + 16;
    char* ot = lds + wid * (32 * (4 * 64 + 16));
    const bool odd = (r32 & 1) != 0;
#pragma unroll
    for (int r = 0; r < 16; ++r) { const int orow = crow(r, hi);
#pragma unroll
        for (int d0 = 0; d0 < NV; d0 += 2) { const float va = o[d0][r] * rli[r], vb = o[d0 + 1][r] * rli[r];
            const float snd = odd ? va : vb;
            const float rcv = __uint_as_float((unsigned)__builtin_amdgcn_update_dpp(0, (int)__float_as_uint(snd), 0xB1, 0xF, 0xF, true));
            const unsigned pk = cvtpk(odd ? rcv : va, odd ? vb : rcv);
            *(unsigned*)(ot + orow * OROW + ((odd ? d0 + 1 : d0) * 32 + (r32 & ~1)) * 2) = pk; } }
    asm volatile("s_waitcnt lgkmcnt(0)" ::: "memory");
    PROF_T0(10);
    bf16* Ow = B.O + (size_t)(pr * 32) * LDO + kh * (NV * 32);
    constexpr int CPR = NV * 4;
#pragma unroll
    for (int i = 0; i < (32 * CPR) / 64; ++i) { const int idx = i * 64 + lane, row = idx / CPR, ch = idx % CPR;
        const u32x4 w = *(const u32x4*)(ot + row * OROW + ch * 16);
        *(u32x4*)(Ow + (size_t)row * LDO + ch * 8) = w; }
    PROF_T1(10);
    PROF_T1(7);
    PROF_T1(4); }
#undef TCL
#undef PLOADK
#undef PLOADV
#undef PWRITEK
#undef PWRITEV
#undef KRD_
#undef KWT_
#undef ASTAGE
#undef BSTAGE
#undef PITER
}

constexpr float SKIP_T = 16.f;
constexpr int NDIFF = 16 * NQB2, NFOX = 16 * NQB2;
struct Tensors { const bf16* QKV; bf16* A2; bf16* DT; const float* BIAS; const unsigned* NRM; };
__host__ __device__ constexpr int est_diff(int h, int qb2) { const int full = 2 * (qb2 + 1), cap = h == 0 ? 5 : (h == 1 ? 12 : (h == 2 ? 38 : 128)); return full < cap ? full : cap; }
__host__ __device__ constexpr int est_fox(int qb2) { const int full = 2 * (qb2 + 1); return full < 14 ? full : 14; }
struct OrderTab2 { unsigned short v[NDIFF]; };
template <bool FOX> __host__ __device__ constexpr OrderTab2 make_order2() {
    OrderTab2 t{}; int start[130] = {};
    for (int pp = 0; pp < 16; ++pp) for (int qb = 0; qb < NQB2; ++qb) start[128 - (FOX ? est_fox(qb) : est_diff((pp >> 1) & 3, qb)) + 1]++;
    for (int i = 1; i < 130; ++i) start[i] += start[i - 1];
    for (int pp = 0; pp < 16; ++pp) for (int qb = NQB2 - 1; qb >= 0; --qb) { const int b = 128 - (FOX ? est_fox(qb) : est_diff((pp >> 1) & 3, qb)); t.v[start[b]++] = (unsigned short)(pp * 64 + qb); }
    return t;
}
__device__ const OrderTab2 ORDER_D = make_order2<false>();
__device__ const OrderTab2 ORDER_F = make_order2<true>();
constexpr int ORD_OFF = PAIR_LDS, NRMW_OFF = ORD_OFF + NDIFF * 2, DG_OFF = NRMW_OFF + 256;
template <bool FOX>
__device__ __forceinline__ PRef make_pref(const Tensors& T, const char* lds, int o, int lane) {
    const int code = __builtin_amdgcn_readfirstlane((int)((const unsigned short*)(lds + ORD_OFF))[o]), pp = code >> 6, qb = code & 63, b = pp >> 3;
    PRef r; int sq, sk;
    const bf16* base = T.QKV + (size_t)b * S * LDQ; r.P0 = qb * QB2;
    if (FOX) { const int h = pp & 7; r.Q = base + (size_t)qb * QB2 * LDQ + C_FQ + h * 128; r.K = base + C_FK + h * 128; r.V = base + C_FV + h * 128; sq = h; sk = 8 + h;
        r.O = T.A2 + ((size_t)b * S + (size_t)qb * QB2) * LDO + h * 128; r.C = T.BIAS + (size_t)(b * 8 + h) * S; }
    else { const int h = (pp >> 1) & 3, mp = pp & 1; r.Q = base + (size_t)qb * QB2 * LDQ + C_DQ + h * 256 + mp * 128; r.K = base + C_DK + h * 256 + mp * 128; r.V = base + C_DV + h * 256; sq = 16 + 2 * h + mp; sk = 24 + 2 * h + mp;
        r.O = T.DT + ((size_t)b * S + (size_t)qb * QB2) * LDO + h * 512 + mp * 256; r.C = T.BIAS + (size_t)(16 + h) * S; }
    const int jd = r.P0 >> 6;
    int ln = lane; asm volatile("" : "+v"(ln));
    const int j0 = ln < jd ? ln : jd, j1 = ln + 64 < jd ? ln + 64 : jd;
    const float cp = r.C[r.P0], c0 = r.C[64 * j0 + 63], c1 = r.C[64 * j1 + 63];
    const float nq = ((const float*)(lds + NRMW_OFF))[b * 32 + sq], nk = ((const float*)(lds + NRMW_OFF))[b * 32 + sk];
    const float qk = 1.015f * sqrtf(nq * nk);
    float bw;
    { const int tid = (int)threadIdx.x; int tt = tid; asm volatile("" : "+v"(tt));
      const int row = tt >> 2, part = tt & 3;
      const bf16* qp = r.Q + (size_t)row * LDQ + part * 32; const bf16* kp = r.K + (size_t)(r.P0 + row) * LDQ + part * 32;
      bf16x8 qa[4], ka[4];
#pragma unroll
      for (int i = 0; i < 4; ++i) { qa[i] = load8<bf16>(qp + 8 * i); ka[i] = load8<bf16>(kp + 8 * i); }
      float d = 0.f, qq = 0.f;
#pragma unroll
      for (int i = 0; i < 4; ++i)
#pragma unroll
          for (int e = 0; e < 8; ++e) { const float fa = __uint_as_float((unsigned)(unsigned short)qa[i][e] << 16), fb = __uint_as_float((unsigned)(unsigned short)ka[i][e] << 16); d = fmaf(fa, fb, d); qq = fmaf(fa, fa, qq); }
      d += __shfl_xor(d, 1); qq += __shfl_xor(qq, 1); d += __shfl_xor(d, 2); qq += __shfl_xor(qq, 2);
      bw = 1.015f * sqrtf(qq * nk) - d;
#pragma unroll
      for (int o_ = 4; o_ < 64; o_ <<= 1) bw = fmaxf(bw, __shfl_xor(bw, o_));
      float* dg = (float*)(lds + DG_OFF) + (o & 1) * 8;
      if ((tt & 63) == 0) dg[tt >> 6] = bw;
      __syncthreads();
      bw = fmaxf(fmaxf(fmaxf(dg[0], dg[1]), fmaxf(dg[2], dg[3])), fmaxf(fmaxf(dg[4], dg[5]), fmaxf(dg[6], dg[7])));
      bw = fminf(bw, 2.f * qk); }
    const float th = SKIP_T * (1.0f / SCALE) + bw, lim = cp + th; r.mref = qk;
    const bool k0 = (ln >= jd) | (c0 <= lim), k1 = (ln + 64 >= jd) | (c1 <= lim);
    const unsigned long long b0 = __ballot(k0), b1 = __ballot(k1);
    r.jlo = b0 ? (int)__builtin_ctzll(b0) : 64 + (int)__builtin_ctzll(b1);
    return r;
}
template <bool FOX>
__device__ __forceinline__ void attn_part(char* lds, const Tensors& T, unsigned* head, volatile __attribute__((address_space(3))) int* qw) {
    volatile __attribute__((address_space(3))) unsigned* PROFW = (volatile __attribute__((address_space(3))) unsigned*)(qw + 8);
    PROF_T0(5);
    const int tid = threadIdx.x, lane = tid & 63;
    if (tid == 0) qw[0] = (int)atomicAdd(head, 1u);
    ((unsigned*)(lds + ORD_OFF))[tid] = ((const unsigned*)(FOX ? ORDER_F.v : ORDER_D.v))[tid];
    if (tid < 64) ((unsigned*)(lds + NRMW_OFF))[tid] = T.NRM[tid];
    __syncthreads();
    int k = __builtin_amdgcn_readfirstlane(qw[0]);
    while (k < NDIFF) {
        int kn = 0; if (tid == 0) kn = (int)atomicAdd(head, 1u);
        PROF_T0(1);
        const PRef B = make_pref<FOX>(T, lds, k, lane);
        PROF_T1(1);
        pair_block<FOX ? 2 : 4>(B, lds, PROFW);
        if (tid == 0) qw[1] = kn;
        __syncthreads();
        k = __builtin_amdgcn_readfirstlane(qw[1]);
    }
    __syncthreads();
    PROF_T1(5);
}
#undef KSWZ
#undef SBAR
}

#define GAS __attribute__((address_space(1)))
#define LAS __attribute__((address_space(3)))
typedef unsigned short bf16;
typedef unsigned v4u __attribute__((ext_vector_type(4)));
typedef float f32x4 __attribute__((ext_vector_type(4)));
typedef short bf16x8 __attribute__((ext_vector_type(8)));
typedef GAS unsigned gu32;
typedef GAS unsigned long long gu64;
#define RLX_AGENT __ATOMIC_RELAXED, __HIP_MEMORY_SCOPE_AGENT
#define LDS_WAIT() asm volatile("s_waitcnt lgkmcnt(0)" ::: "memory")
#define VM_WAIT() asm volatile("s_waitcnt vmcnt(0)" ::: "memory")
__device__ __forceinline__ unsigned long long rt() { return __builtin_amdgcn_s_memrealtime(); }
__device__ __forceinline__ unsigned f2bf(float f) { unsigned u = __builtin_bit_cast(unsigned, f); return (u + 0x7fffu + ((u >> 16) & 1u)) >> 16; }
__device__ __forceinline__ unsigned pk2(float lo, float hi) { return f2bf(lo) | (f2bf(hi) << 16); }

#define XB_TMO      128
#define XB_XCNT(j)  (256  + 64 * (j))
#define XB_XSUB(j)  (1280 + 64 * (j))
#define XB_XGEN(j)  (2304 + 64 * (j))
#define XB_TOP      3328
#define XB_TOPGEN   3392
#define XCD_BAR_WORDS 3456
#define XB_SPIN_CAP (1u << 18)

__device__ __forceinline__ unsigned xb_ld(unsigned* p)              { return __hip_atomic_load(p, __ATOMIC_RELAXED, __HIP_MEMORY_SCOPE_AGENT); }
__device__ __forceinline__ unsigned xb_add(unsigned* p, unsigned v) { return __hip_atomic_fetch_add(p, v, __ATOMIC_RELAXED, __HIP_MEMORY_SCOPE_AGENT); }
__device__ __forceinline__ unsigned xb_xcc_id() { return (unsigned)__builtin_amdgcn_s_getreg((3 << 11) | 20) & 0xFu; }
#define XB_SPIN(cond, bar) do { unsigned _sp = 0; while (cond) { __builtin_amdgcn_s_sleep(1); \
    if ((++_sp & 255u) == 0u) { if (xb_ld(&(bar)[XB_TMO])) break; if (_sp > XB_SPIN_CAP) { atomicAdd(&(bar)[XB_TMO], 1u); break; } } } } while (0)

struct XcdBarrier {
    unsigned* bar; unsigned x;
    volatile LAS unsigned* st;
};

__device__ __forceinline__ XcdBarrier xcd_barrier_post(unsigned* bar, volatile LAS unsigned* st) {
    XcdBarrier b; b.bar = bar; b.x = xb_xcc_id(); b.st = st;
    if (threadIdx.x == 0) (void)xb_add(&bar[XB_XCNT(b.x)], 1u);
    return b;
}
__device__ __forceinline__ void xcd_barrier_complete(unsigned* bar, unsigned x, unsigned& nloc, unsigned& nx) {
    const unsigned G = gridDim.x * gridDim.y * gridDim.z;
    unsigned sum, cnt, mine, sp = 0u;
    for (;;) {
        sum = 0u; cnt = 0u; mine = 0u;
#pragma unroll
        for (unsigned j = 0; j < 16; ++j) { const unsigned c = xb_ld(&bar[XB_XCNT(j)]); sum += c; cnt += (c > 0u) ? 1u : 0u; mine = (j == x) ? c : mine; }
        if (sum == G) break;
        __builtin_amdgcn_s_sleep(1);
        if ((++sp & 255u) == 0u) { if (xb_ld(&bar[XB_TMO])) break; if (sp > XB_SPIN_CAP) { atomicAdd(&bar[XB_TMO], 1u); break; } }
    }
    nloc = mine > 0u ? mine : 1u; nx = cnt > 0u ? cnt : 1u;
}

__device__ __forceinline__ void xcd_barrier(const XcdBarrier& b) {
    asm volatile("s_waitcnt vmcnt(0)" ::: "memory");
    __syncthreads();
    if (threadIdx.x == 0) {
        unsigned* bar = b.bar;
        __builtin_amdgcn_s_waitcnt(0);
        unsigned nloc = b.st[0], nx = b.st[1];
        if (nloc == 0u) { xcd_barrier_complete(bar, b.x, nloc, nx); b.st[0] = nloc; b.st[1] = nx; }
        const unsigned old = xb_add(&bar[XB_XSUB(b.x)], 1u);
        const unsigned gen = old / nloc;
        if (old + 1u == (gen + 1u) * nloc) {
            __builtin_amdgcn_fence(__ATOMIC_RELEASE, "agent");
            asm volatile("s_waitcnt vmcnt(0)" ::: "memory");
            const unsigned og = xb_add(&bar[XB_TOP], 1u);
            const unsigned tg = og / nx;
            if (og + 1u == (tg + 1u) * nx) xb_add(&bar[XB_TOPGEN], 1u);
            else XB_SPIN(xb_ld(&bar[XB_TOPGEN]) == tg, bar);
            __builtin_amdgcn_fence(__ATOMIC_ACQUIRE, "agent");
            xb_add(&bar[XB_XGEN(b.x)], 1u);
            asm volatile("s_waitcnt vmcnt(0)" ::: "memory");
        } else {
            XB_SPIN(xb_ld(&bar[XB_XGEN(b.x)]) == gen, bar);
            __builtin_amdgcn_fence(__ATOMIC_ACQUIRE, "agent");
            asm volatile("s_waitcnt vmcnt(0)" ::: "memory");
        }
    }
    __syncthreads();
}

constexpr int NWAVES = 8;
constexpr int RING_OFF = 0, RING_BYTES = 131072;
constexpr int LDSCTL_OFF = RING_BYTES, MISC_OFF = LDSCTL_OFF + 320;
constexpr int SEG_OFF = LDSCTL_OFF + 1024;
constexpr int TILE_E_OFF = LDSCTL_OFF + 2048;
constexpr int TILE_RB_OFF = TILE_E_OFF + 1024;
constexpr int ECAP = M;
constexpr int NRMP_OFF = LDSCTL_OFF + 4096;
constexpr int LDS_BYTES = 147456;
constexpr int ATT_QW_OFF = LDSCTL_OFF + 512;
static_assert(att::PAIR_RING == RING_BYTES && att::PAIR_LDS <= LDS_BYTES && att::P_OFF_L >= ATT_QW_OFF + 64 && att::LDS_BYTES <= RING_BYTES && TILE_E_OFF + NTILE_MAX * 4 <= LDS_BYTES, "LDS map");

struct Args { const float* in[19]; float* out; unsigned char* ws; int ph_lo, ph_hi, li, pad; };

struct Ctx {
    LAS unsigned char* lds; int tid, lane, wave, G, gw, NGW;
    const float *x, *attn_g, *w_in, *fbias, *lq1, *lk1, *lq2, *lk2, *subg, *w_out, *ffn_g, *wg, *bg, *we, *be, *wgate, *wup, *wdown, *fin_g;
    float* out;
    bf16* A1; bf16* WIN; bf16* WOUT; float* BIAS; bf16* QKV; bf16* A2; bf16* DT; bf16* H1;
    int* tok_e; int* tok_pos; float* tok_gate; float* rstd; float* rowgate; int* rowtok; int* etok; float* egate; float* WR; bf16* XG; bf16* HB; bf16* Y; bf16* WGU; bf16* WD; unsigned* cnt; unsigned* nrm;
};
__device__ __forceinline__ float wave_sum(float v) {
#pragma unroll
    for (int o = 1; o < 64; o <<= 1) v += __shfl_xor(v, o);
    return v;
}
typedef unsigned v2u __attribute__((ext_vector_type(2)));

__device__ __forceinline__ void p0_row2(const Ctx& C, int t0, int t1, const LAS float* wf) {
    const int lane = C.lane; const float* xr0 = C.x + (size_t)t0 * DM; const float* xr1 = C.x + (size_t)t1 * DM;
    f32x4 v0[8], v1[8]; float ss0 = 0.f, ss1 = 0.f;
#pragma unroll
    for (int j = 0; j < 8; ++j) { v0[j] = *(const f32x4*)(xr0 + j * 256 + lane * 4); v1[j] = *(const f32x4*)(xr1 + j * 256 + lane * 4); }
#pragma unroll
    for (int j = 0; j < 8; ++j) { ss0 += (v0[j].x * v0[j].x + v0[j].y * v0[j].y) + (v0[j].z * v0[j].z + v0[j].w * v0[j].w); ss1 += (v1[j].x * v1[j].x + v1[j].y * v1[j].y) + (v1[j].z * v1[j].z + v1[j].w * v1[j].w); }
    const float r0 = 1.f / sqrtf(wave_sum(ss0) * (1.f / DM) + 1e-6f), r1 = 1.f / sqrtf(wave_sum(ss1) * (1.f / DM) + 1e-6f);
    float fl0[8] = {0.f, 0.f, 0.f, 0.f, 0.f, 0.f, 0.f, 0.f}, fl1[8] = {0.f, 0.f, 0.f, 0.f, 0.f, 0.f, 0.f, 0.f};
#pragma unroll
    for (int j = 0; j < 8; ++j) {
        const f32x4 gg = *(const f32x4*)(C.attn_g + j * 256 + lane * 4);
        v0[j] = v0[j] * r0 * gg; v1[j] = v1[j] * r1 * gg;
        v2u o; o.x = pk2(v0[j].x, v0[j].y); o.y = pk2(v0[j].z, v0[j].w);
        *(v2u*)(C.A1 + (size_t)t0 * DM + j * 256 + lane * 4) = o;
        o.x = pk2(v1[j].x, v1[j].y); o.y = pk2(v1[j].z, v1[j].w);
        *(v2u*)(C.A1 + (size_t)t1 * DM + j * 256 + lane * 4) = o;
#pragma unroll
        for (int h = 0; h < 8; ++h) { const f32x4 w4 = *(const LAS f32x4*)(wf + h * DM + j * 256 + lane * 4);
            fl0[h] += (v0[j].x * w4.x + v0[j].y * w4.y) + (v0[j].z * w4.z + v0[j].w * w4.w); fl1[h] += (v1[j].x * w4.x + v1[j].y * w4.y) + (v1[j].z * w4.z + v1[j].w * w4.w); }
        asm volatile("" ::: "memory");
    }
#pragma unroll
    for (int h = 0; h < 8; ++h) { fl0[h] = wave_sum(fl0[h]); fl1[h] = wave_sum(fl1[h]); }
    float z0 = fl0[0], z1 = fl1[0];
#pragma unroll
    for (int h = 1; h < 8; ++h) { z0 = (lane == h) ? fl0[h] : z0; z1 = (lane == h) ? fl1[h] : z1; }
    if (lane < 8) { z0 += C.fbias[lane]; z1 += C.fbias[lane];
        C.BIAS[(size_t)((t0 / S) * 8 + lane) * S + (t0 % S)] = fminf(z0, 0.f) - log1pf(expf(-fabsf(z0)));
        C.BIAS[(size_t)((t1 / S) * 8 + lane) * S + (t1 % S)] = fminf(z1, 0.f) - log1pf(expf(-fabsf(z1))); }
}
__device__ __forceinline__ void tr_item(const float* src, int ld, int k0, int c0, bf16* dst, int K, int r0, LAS float* scr, int lane) {
    { f32x4 v[8];
#pragma unroll
      for (int i = 0; i < 8; ++i) v[i] = *(const f32x4*)(src + (size_t)(k0 + 8 * i + (lane >> 3)) * ld + c0 + 4 * (lane & 7));
#pragma unroll
      for (int i = 0; i < 8; ++i) { LAS float* d = scr + (8 * i + (lane >> 3)) * 33 + 4 * (lane & 7); d[0] = v[i].x; d[1] = v[i].y; d[2] = v[i].z; d[3] = v[i].w; } }
    LDS_WAIT(); asm volatile("" ::: "memory");
    const int c = lane & 7;
#pragma unroll
    for (int j = 0; j < 4; ++j) { const int n = (lane >> 3) + 8 * j; const LAS float* s = scr + (8 * c) * 33 + n;
        v4u o; o.x = pk2(s[0 * 33], s[1 * 33]); o.y = pk2(s[2 * 33], s[3 * 33]); o.z = pk2(s[4 * 33], s[5 * 33]); o.w = pk2(s[6 * 33], s[7 * 33]);
        *(GAS v4u*)(dst + (size_t)(r0 + n) * K + k0 + 8 * c) = o; }
    LDS_WAIT(); asm volatile("" ::: "memory");
}
__device__ __forceinline__ void p0_prologue(const Ctx& C) {
    LAS float* scr = (LAS float*)(C.lds + RING_OFF + C.wave * 16384);
    constexpr int I_WIN = 32 * 192, I_WOUT = 32 * 64, I_ALL = I_WIN + I_WOUT;
    for (int it = C.gw; it < I_ALL; it += C.NGW) {
        int r = it;
        if (r < I_WIN) { const int kb = r / 192, nb = r % 192; tr_item(C.w_in, NCOL, 64 * kb, nb < 96 ? 32 * nb : 32 * nb + 8, C.WIN, DM, 32 * nb, scr, C.lane); continue; } r -= I_WIN;
        { const int kb = r / 64, nb = r % 64; tr_item(C.w_out, DM, 64 * kb, 32 * nb, C.WOUT, DM, 32 * nb, scr, C.lane); }
    }
    __syncthreads();
    { LAS float* wf = (LAS float*)(C.lds + RING_OFF);
      for (int k = C.tid; k < DM; k += NWAVES * 64) { const float* wr = C.w_in + (size_t)k * NCOL + FCOL; const f32x4 w0 = *(const f32x4*)wr, w1 = *(const f32x4*)(wr + 4);
          wf[0 * DM + k] = w0.x; wf[1 * DM + k] = w0.y; wf[2 * DM + k] = w0.z; wf[3 * DM + k] = w0.w; wf[4 * DM + k] = w1.x; wf[5 * DM + k] = w1.y; wf[6 * DM + k] = w1.z; wf[7 * DM + k] = w1.w; }
      __syncthreads();
      for (int t = C.gw; t < M; t += 2 * C.NGW) { const int t1 = t + C.NGW; p0_row2(C, t, t1 < M ? t1 : t, wf); } }
    const int gt = C.gw * 64 + C.lane, NGT = C.NGW * 64;
    for (int i = gt; i < 4 * S; i += NGT) { const int h = i / S, s = i % S; C.BIAS[(size_t)(16 + h) * S + s] = -exp2f(-2.f * (float)(h + 1)) * (float)s * ATT_ISCALE; }
    for (int i = gt; i < 64 * 5 * 2 * 64; i += NGT) { const int ln = i & 63, hl = (i >> 6) & 1, b = (i >> 7) % 5, kk = (i >> 7) / 5, c = 16 * b + (ln & 15);
        unsigned w[4];
#pragma unroll
        for (int jp = 0; jp < 4; ++jp) { unsigned pk = 0;
#pragma unroll
            for (int q = 0; q < 2; ++q) { const int k = 32 * kk + 8 * (ln >> 4) + 2 * jp + q;
                const float v = (c < 8 ? C.wg[(size_t)k * 8 + c] : (c < 72 ? C.we[(size_t)k * NE + c - 8] : 0.f)) * C.ffn_g[k];
                const unsigned h = f2bf(v); const unsigned l = f2bf(v - __uint_as_float(h << 16));
                pk |= (hl ? l : h) << (16 * q); }
            w[jp] = pk; }
        ((v4u*)C.WR)[i] = (v4u){w[0], w[1], w[2], w[3]}; }
}
__device__ __forceinline__ void p1_cumsum(const Ctx& C) {
    if (blockIdx.x >= 16) return;
    float* p = C.BIAS + (size_t)blockIdx.x * S + C.tid * 16; LAS float* wt = (LAS float*)(C.lds + RING_OFF);
    float loc[16]; float s = 0.f;
    { const f32x4 a = *(const f32x4*)p, b = *(const f32x4*)(p + 4), c = *(const f32x4*)(p + 8), d = *(const f32x4*)(p + 12);
      loc[0] = a.x; loc[1] = a.y; loc[2] = a.z; loc[3] = a.w; loc[4] = b.x; loc[5] = b.y; loc[6] = b.z; loc[7] = b.w; loc[8] = c.x; loc[9] = c.y; loc[10] = c.z; loc[11] = c.w; loc[12] = d.x; loc[13] = d.y; loc[14] = d.z; loc[15] = d.w; }
#pragma unroll
    for (int i = 0; i < 16; ++i) { s += loc[i]; loc[i] = s; }
    float inc = s;
#pragma unroll
    for (int o = 1; o < 64; o <<= 1) { const float q = __shfl_up(inc, o); if (C.lane >= o) inc += q; }
    if (C.lane == 63) wt[C.wave] = inc;
    __syncthreads();
    float base = inc - s;
    for (int w = 0; w < C.wave; ++w) base += wt[w];
#pragma unroll
    for (int i = 0; i < 16; ++i) loc[i] = (base + loc[i]) * ATT_ISCALE;
    *(f32x4*)p = (f32x4){loc[0], loc[1], loc[2], loc[3]}; *(f32x4*)(p + 4) = (f32x4){loc[4], loc[5], loc[6], loc[7]};
    *(f32x4*)(p + 8) = (f32x4){loc[8], loc[9], loc[10], loc[11]}; *(f32x4*)(p + 12) = (f32x4){loc[12], loc[13], loc[14], loc[15]};
    __syncthreads();
}
__device__ __forceinline__ void p_norms(const Ctx& C) {
    const int lane = C.lane, b = C.gw & 1;
    float mx[8] = {0.f, 0.f, 0.f, 0.f, 0.f, 0.f, 0.f, 0.f};
    for (int rr = C.gw >> 1; rr < S; rr += C.NGW >> 1) {
        const bf16* row = C.QKV + (size_t)(b * S + rr) * NQKV + 8 * lane;
#pragma unroll
        for (int i = 0; i < 8; ++i) { const v4u w = *(const v4u*)(row + (i < 4 ? 512 * i : 1024 + 512 * i));
            float ss = 0.f;
#pragma unroll
            for (int c = 0; c < 4; ++c) { const float lo = __uint_as_float(w[c] << 16), hi = __uint_as_float(w[c] & 0xffff0000u); ss += lo * lo + hi * hi; }
            ss += __shfl_xor(ss, 1); ss += __shfl_xor(ss, 2); ss += __shfl_xor(ss, 4); ss += __shfl_xor(ss, 8);
            mx[i] = fmaxf(mx[i], ss); }
    }
    if ((lane & 15) == 0) {
#pragma unroll
        for (int i = 0; i < 8; ++i) atomicMax(C.nrm + b * 32 + 4 * i + (lane >> 4), __float_as_uint(mx[i]));
    }
}
__device__ __forceinline__ void p3_combine(const Ctx& C) {
    const int lane = C.lane;
    const float s1 = wave_sum(C.lq1[lane] * C.lk1[lane] + C.lq1[lane + 64] * C.lk1[lane + 64]);
    const float s2 = wave_sum(C.lq2[lane] * C.lk2[lane] + C.lq2[lane + 64] * C.lk2[lane + 64]);
    const float lam = expf(s1) - expf(s2) + 0.2f;
    const f32x4 gg = *(const f32x4*)(C.subg + lane * 4);
    for (int idx = C.gw; idx < M * 4; idx += C.NGW) {
        const int t = idx >> 2, h = idx & 3;
        const bf16* p = C.DT + (size_t)t * DM + h * 512 + lane * 4;
        const v2u a = *(const v2u*)p, b = *(const v2u*)(p + 256);
        f32x4 d;
        d.x = __uint_as_float(a.x << 16) - lam * __uint_as_float(b.x << 16); d.y = __uint_as_float(a.x & 0xffff0000u) - lam * __uint_as_float(b.x & 0xffff0000u);
        d.z = __uint_as_float(a.y << 16) - lam * __uint_as_float(b.y << 16); d.w = __uint_as_float(a.y & 0xffff0000u) - lam * __uint_as_float(b.y & 0xffff0000u);
        const float ss = wave_sum((d.x * d.x + d.y * d.y) + (d.z * d.z + d.w * d.w));
        const float r = 0.8f / sqrtf(ss * (1.f / 256.f) + 1e-5f);
        v2u o; o.x = pk2(d.x * r * gg.x, d.y * r * gg.y); o.y = pk2(d.z * r * gg.z, d.w * r * gg.w);
        *(v2u*)(C.A2 + (size_t)t * DM + 1024 + h * 256 + lane * 4) = o;
    }
}
__device__ __forceinline__ void p5a_router(const Ctx& C) {
    const int w = C.wave, th = w & 1, ks = w >> 1;
    LAS float* R1 = (LAS float*)(C.lds + RING_OFF);
    LAS float* SS = (LAS float*)(C.lds + RING_OFF + 81920);
    LAS float* RS = SS + 512;
    LAS float* lg = (LAS float*)(C.lds + RING_OFF + 86016);
    for (int tl = (int)blockIdx.x; tl < M / 64; tl += C.G) {
        int lane = C.lane; asm volatile("" : "+v"(lane));
        const int r = lane & 15, g = lane >> 4;
        const int t0 = tl * 64;
        f32x4 acc[2][5];
#pragma unroll
        for (int T = 0; T < 2; ++T)
#pragma unroll
            for (int b = 0; b < 5; ++b) acc[T][b] = (f32x4){0.f, 0.f, 0.f, 0.f};
        float ss[2] = {0.f, 0.f};
        const bf16* hb = C.H1 + (size_t)(t0 + 32 * th) * DM + 512 * ks; const unsigned ho = (unsigned)(r * DM + 8 * g);
        const v4u* wp = (const v4u*)C.WR + (size_t)(16 * ks) * 10 * 64 + lane;
        v4u a[4][2], tb[10];
#define RT_LA(slot, j_) do { _Pragma("unroll") for (int T = 0; T < 2; ++T) a[slot][T] = *(const v4u*)(hb + (ho + (unsigned)(16 * T * DM + 32 * (j_)))); } while (0)
        RT_LA(0, 0);
#pragma unroll
        for (int q = 0; q < 10; ++q) tb[q] = wp[q * 64];
        RT_LA(1, 1); RT_LA(2, 2); RT_LA(3, 3);
#pragma unroll
        for (int j = 0; j < 16; ++j) {
            __builtin_amdgcn_sched_barrier(0);
#pragma unroll
            for (int T = 0; T < 2; ++T)
#pragma unroll
                for (int c = 0; c < 4; ++c) { const unsigned x = a[j & 3][T][c]; const float lo = __uint_as_float(x << 16), hi = __uint_as_float(x & 0xffff0000u); ss[T] += lo * lo + hi * hi; }
#pragma unroll
            for (int b = 0; b < 5; ++b) {
#pragma unroll
                for (int T = 0; T < 2; ++T) acc[T][b] = __builtin_amdgcn_mfma_f32_16x16x32_bf16(__builtin_bit_cast(bf16x8, a[j & 3][T]), __builtin_bit_cast(bf16x8, tb[2 * b]), acc[T][b], 0, 0, 0);
#pragma unroll
                for (int T = 0; T < 2; ++T) acc[T][b] = __builtin_amdgcn_mfma_f32_16x16x32_bf16(__builtin_bit_cast(bf16x8, a[j & 3][T]), __builtin_bit_cast(bf16x8, tb[2 * b + 1]), acc[T][b], 0, 0, 0);
                __builtin_amdgcn_sched_barrier(0);
                if (j + 1 < 16) { tb[2 * b] = wp[((j + 1) * 10 + 2 * b) * 64]; tb[2 * b + 1] = wp[((j + 1) * 10 + 2 * b + 1) * 64]; }
                __builtin_amdgcn_sched_barrier(0);
            }
            if (j + 4 < 16) RT_LA(j & 3, j + 4);
        }
#undef RT_LA
        asm volatile("" ::: "memory");
#pragma unroll
        for (int T = 0; T < 2; ++T) { ss[T] += __int_as_float(__builtin_amdgcn_ds_bpermute((lane ^ 16) << 2, __float_as_int(ss[T]))); ss[T] += __int_as_float(__builtin_amdgcn_ds_bpermute((lane ^ 32) << 2, __float_as_int(ss[T])));
            if (lane < 16) SS[ks * 64 + 16 * (2 * th + T) + lane] = ss[T]; }
        if (ks >= 2) {
#pragma unroll
            for (int T = 0; T < 2; ++T)
#pragma unroll
                for (int b = 0; b < 5; ++b)
#pragma unroll
                    for (int i = 0; i < 4; ++i) R1[((th * 2 + (ks - 2)) * 40 + (T * 5 + b) * 4 + i) * 64 + lane] = acc[T][b][i];
        }
        __syncthreads();
        if (ks < 2) {
#pragma unroll
            for (int T = 0; T < 2; ++T)
#pragma unroll
                for (int b = 0; b < 5; ++b)
#pragma unroll
                    for (int i = 0; i < 4; ++i) { LAS float* q = R1 + ((th * 2 + ks) * 40 + (T * 5 + b) * 4 + i) * 64 + lane; *q = acc[T][b][i] + *q; }
            if (w == 0) { const float s = (SS[lane] + SS[64 + lane]) + (SS[128 + lane] + SS[192 + lane]);
                const float rs = 1.f / sqrtf(s * (1.f / DM) + 1e-6f); RS[lane] = rs; C.rstd[t0 + lane] = rs; }
        }
        __syncthreads();
#pragma unroll
        for (int m = 0; m < 10; ++m) { const int sl = w + 8 * m, T = sl / 20, b = (sl % 20) >> 2, i = sl & 3, tok = 16 * T + 4 * g + i, s2 = sl % 40, hh = sl / 40;
            const float v = R1[((hh * 2 + 0) * 40 + s2) * 64 + lane] + R1[((hh * 2 + 1) * 40 + s2) * 64 + lane];
            lg[tok * 81 + 16 * b + r] = v * RS[tok]; }
        __syncthreads();
        if (w == 0) {
            const int t = t0 + lane; const LAS float* row = lg + lane * 81;
            float gmax = -__builtin_inff(); int gi = 0; float gl[8];
#pragma unroll
            for (int j = 0; j < 8; ++j) { gl[j] = row[j] + C.bg[j]; if (gl[j] > gmax) { gmax = gl[j]; gi = j; } }
            float gs = 0.f;
#pragma unroll
            for (int j = 0; j < 8; ++j) gs += expf(gl[j] - gmax);
            const float gprob = 1.f / gs;
            float l1 = -__builtin_inff(), l2 = -__builtin_inff(); int i1 = 0, i2 = 0;
#pragma unroll
            for (int j = 0; j < 8; ++j) { const float q = row[8 + gi * 8 + j] + C.be[gi * 8 + j];
                if (q > l1) { l2 = l1; i2 = i1; l1 = q; i1 = j; } else if (q > l2) { l2 = q; i2 = j; } }
            const float e2 = expf(l2 - l1), g1 = gprob / (1.f + e2), g2 = gprob * e2 / (1.f + e2);
            const int ea = gi * 8 + i1, eb = gi * 8 + i2;
            LAS unsigned* lc = (LAS unsigned*)(C.lds + RING_OFF + 110592); LAS unsigned* gb = lc + 64;
            lc[lane] = 0u; asm volatile("" ::: "memory");
            const unsigned la = __hip_atomic_fetch_add(lc + ea, 1u, __ATOMIC_RELAXED, __HIP_MEMORY_SCOPE_WORKGROUP); asm volatile("" ::: "memory");
            const unsigned lb = __hip_atomic_fetch_add(lc + eb, 1u, __ATOMIC_RELAXED, __HIP_MEMORY_SCOPE_WORKGROUP); asm volatile("" ::: "memory");
            const unsigned ne = lc[lane]; unsigned gbase = 0u; if (ne) gbase = atomicAdd(C.cnt + lane * CNT_STRIDE, ne);
            gb[lane] = gbase; asm volatile("" ::: "memory");
            const unsigned pa = gb[ea] + la, pb = gb[eb] + lb;
            C.tok_e[t * 2] = ea; C.tok_e[t * 2 + 1] = eb; C.tok_pos[t * 2] = (int)pa; C.tok_pos[t * 2 + 1] = (int)pb; C.etok[ea * ECAP + (int)pa] = t; C.etok[eb * ECAP + (int)pb] = t; C.tok_gate[t * 2] = g1; C.tok_gate[t * 2 + 1] = g2;
        }
        { asm volatile("" ::: "memory"); f32x4 gg[4][2];
#pragma unroll
            for (int j = 0; j < 4; ++j) { gg[j][0] = *(const f32x4*)(C.ffn_g + j * 512 + lane * 8); gg[j][1] = *(const f32x4*)(C.ffn_g + j * 512 + lane * 8 + 4); }
            const int r0 = w ? 9 * (w - 1) : 63, nr = w ? 9 : 1;
#pragma unroll 3
            for (int i = 0; i < nr; ++i) { const int rr = r0 + i; const float rsr = RS[rr]; const bf16* src = C.H1 + (size_t)(t0 + rr) * DM + lane * 8; bf16* dst = C.A1 + (size_t)(t0 + rr) * DM + lane * 8;
#pragma unroll
                for (int j = 0; j < 4; ++j) { const v4u x = *(const v4u*)(src + j * 512); const f32x4 g0 = gg[j][0], g1 = gg[j][1];
                    v4u o; o.x = pk2(__uint_as_float(x.x << 16) * rsr * g0.x, __uint_as_float(x.x & 0xffff0000u) * rsr * g0.y); o.y = pk2(__uint_as_float(x.y << 16) * rsr * g0.z, __uint_as_float(x.y & 0xffff0000u) * rsr * g0.w);
                    o.z = pk2(__uint_as_float(x.z << 16) * rsr * g1.x, __uint_as_float(x.z & 0xffff0000u) * rsr * g1.y); o.w = pk2(__uint_as_float(x.w << 16) * rsr * g1.z, __uint_as_float(x.w & 0xffff0000u) * rsr * g1.w);
                    *(v4u*)(dst + j * 512) = o; } } }
        __syncthreads();
    }
}
__device__ __forceinline__ void build_seg(const Ctx& C) {
    LAS int* seg = (LAS int*)(C.lds + SEG_OFF); LAS int* tile_e = (LAS int*)(C.lds + TILE_E_OFF);
    if (C.wave == 0) { const int p = (int)((C.cnt[C.lane * CNT_STRIDE] + 255u) & ~255u); int inc = p;
#pragma unroll
        for (int o = 1; o < 64; o <<= 1) { const int q = __shfl_up(inc, o); if (C.lane >= o) inc += q; }
        seg[C.lane] = inc - p; if (C.lane == 63) seg[NE] = inc; }
    __syncthreads();
    if (C.tid < NTILE_MAX) { const int row = C.tid * 256; int e = 0; for (int j = 1; j < NE; ++j) if (seg[j] <= row) e = j; tile_e[C.tid] = e; ((LAS int*)(C.lds + TILE_RB_OFF))[C.tid] = e * ECAP - seg[e]; }
    __syncthreads();
}
__device__ __forceinline__ void p5b_dispatch(const Ctx& C) {
    const LAS int* seg = (const LAS int*)(C.lds + SEG_OFF);
    for (int t = C.gw * 64 + C.lane; t < M; t += C.NGW * 64) {
        const int ra = seg[C.tok_e[t * 2]] + C.tok_pos[t * 2], rb = seg[C.tok_e[t * 2 + 1]] + C.tok_pos[t * 2 + 1];
        C.rowgate[ra] = C.tok_gate[t * 2]; C.rowgate[rb] = C.tok_gate[t * 2 + 1]; C.rowtok[ra] = t; C.rowtok[rb] = t;
    }
}
__device__ __forceinline__ void p8_final(const Ctx& C) {
    const LAS int* seg = (const LAS int*)(C.lds + SEG_OFF); const int lane = C.lane;
    for (int t0 = C.gw * 2; t0 < M; t0 += C.NGW * 2) {
        int ra[2], rb[2]; float ga[2], gb[2];
#pragma unroll
        for (int u = 0; u < 2; ++u) { const int t = t0 + u; ra[u] = seg[C.tok_e[t * 2]] + C.tok_pos[t * 2]; rb[u] = seg[C.tok_e[t * 2 + 1]] + C.tok_pos[t * 2 + 1]; ga[u] = C.tok_gate[t * 2]; gb[u] = C.tok_gate[t * 2 + 1]; }
        f32x4 v[2][8]; float ss[2] = {0.f, 0.f};
#pragma unroll
        for (int u = 0; u < 2; ++u) { const bf16* xr = C.H1 + (size_t)(t0 + u) * DM; const bf16* ya = C.Y + (size_t)ra[u] * DM; const bf16* yb = C.Y + (size_t)rb[u] * DM;
#pragma unroll
            for (int j = 0; j < 8; ++j) { const v2u h = *(const v2u*)(xr + j * 256 + lane * 4), a = *(const v2u*)(ya + j * 256 + lane * 4), b = *(const v2u*)(yb + j * 256 + lane * 4);
                v[u][j].x = __uint_as_float(h.x << 16) + (ga[u] * __uint_as_float(a.x << 16) + gb[u] * __uint_as_float(b.x << 16)); v[u][j].y = __uint_as_float(h.x & 0xffff0000u) + (ga[u] * __uint_as_float(a.x & 0xffff0000u) + gb[u] * __uint_as_float(b.x & 0xffff0000u));
                v[u][j].z = __uint_as_float(h.y << 16) + (ga[u] * __uint_as_float(a.y << 16) + gb[u] * __uint_as_float(b.y << 16)); v[u][j].w = __uint_as_float(h.y & 0xffff0000u) + (ga[u] * __uint_as_float(a.y & 0xffff0000u) + gb[u] * __uint_as_float(b.y & 0xffff0000u));
                ss[u] += (v[u][j].x * v[u][j].x + v[u][j].y * v[u][j].y) + (v[u][j].z * v[u][j].z + v[u][j].w * v[u][j].w); } }
#pragma unroll
        for (int u = 0; u < 2; ++u) { const float r = 1.f / sqrtf(wave_sum(ss[u]) * (1.f / DM) + 1e-6f);
#pragma unroll
            for (int j = 0; j < 8; ++j) *(f32x4*)(C.out + (size_t)(t0 + u) * DM + j * 256 + lane * 4) = v[u][j] * r * *(const f32x4*)(C.fin_g + j * 256 + lane * 4); }
    }
}

__global__ void __launch_bounds__(NWAVES * 64, 2) mk_fwd(Args args) {
    extern __shared__ __attribute__((aligned(16))) unsigned char lds[];
    Ctx C;
    C.lds = (LAS unsigned char*)lds; C.tid = threadIdx.x; C.lane = C.tid & 63; C.wave = __builtin_amdgcn_readfirstlane(C.tid >> 6);
    C.G = gridDim.x; C.gw = (int)blockIdx.x * NWAVES + C.wave; C.NGW = C.G * NWAVES;
    C.x = args.in[0]; C.attn_g = args.in[1]; C.w_in = args.in[2]; C.fbias = args.in[3]; C.lq1 = args.in[4]; C.lk1 = args.in[5]; C.lq2 = args.in[6]; C.lk2 = args.in[7];
    C.subg = args.in[8]; C.w_out = args.in[9]; C.ffn_g = args.in[10]; C.wg = args.in[11]; C.bg = args.in[12]; C.we = args.in[13]; C.be = args.in[14];
    C.wgate = args.in[15]; C.wup = args.in[16]; C.wdown = args.in[17]; C.fin_g = args.in[18]; C.out = args.out;
    unsigned char* ws = args.ws;
    C.A1 = (bf16*)(ws + WS_A1); C.WIN = (bf16*)(ws + WS_WIN); C.WOUT = (bf16*)(ws + WS_WOUT); C.BIAS = (float*)(ws + WS_BIAS); C.QKV = (bf16*)(ws + WS_QKV);
    C.A2 = (bf16*)(ws + WS_A2); C.DT = (bf16*)(ws + WS_DT); C.H1 = (bf16*)(ws + WS_H1);
    C.tok_e = (int*)(ws + WS_ROUTE); C.tok_pos = C.tok_e + 2 * M; C.tok_gate = (float*)(C.tok_pos + 2 * M); C.rstd = C.tok_gate + 2 * M; C.rowgate = C.rstd + M; C.rowtok = (int*)(C.rowgate + YROWS);
    C.etok = (int*)(ws + WS_XG); C.egate = (float*)(ws + WS_XG) + (size_t)NE * ECAP;
    C.WR = (float*)(ws + WS_WR); C.XG = (bf16*)(ws + WS_XG); C.HB = (bf16*)(ws + WS_HBUF); C.Y = (bf16*)(ws + WS_Y); C.WGU = (bf16*)(ws + WS_WGU); C.WD = (bf16*)(ws + WS_WD);
    C.cnt = (unsigned*)(ws + WS_CTL) + CW_CNT; C.nrm = (unsigned*)(ws + WS_CTL) + CW_NRM;
    volatile LAS unsigned* MISC = (volatile LAS unsigned*)(C.lds + MISC_OFF);
    for (int u = C.tid; u < (LDS_BYTES - LDSCTL_OFF) / 4; u += NWAVES * 64) ((LAS unsigned*)(C.lds + LDSCTL_OFF))[u] = 0u;
    __syncthreads();
    XcdBarrier bar = xcd_barrier_post((unsigned*)(ws + WS_CTL) + CW_BAR + args.li * XCD_BAR_WORDS, MISC + 8);
    const int lo = args.ph_lo, hi = args.ph_hi;
#define IN(k) (lo <= (k) && (k) < hi)
#define SEAM(k) do { if (IN(k) && IN((k) + 1)) xcd_barrier(bar); } while (0)
#ifndef PROBE_MASK
#define PROBE_MASK 0u
#endif
#ifndef PROBE_REP
#define PROBE_REP 0
#endif
#define TWICE(k) (((PROBE_MASK) >> (k)) & 1u)
#ifdef PROBE_TS
    volatile LAS unsigned long long* TSW = (volatile LAS unsigned long long*)(C.lds + LDSCTL_OFF + 15360);
#define TS(k) do { if (blockIdx.x == 0 && C.tid == 0) TSW[k] = __builtin_amdgcn_s_memrealtime(); } while (0)
#else
#define TS(k) do { } while (0)
#endif
    TS(0);

    if (IN(0)) { p0_prologue(C); if (TWICE(0)) { xcd_barrier(bar); p0_prologue(C); } } SEAM(0); TS(1);
    if (IN(1)) {
        p1_cumsum(C);
        pg8::Gemm g{C.A1, C.WIN, M, NQKV, DM}; pg8::StaticOrder So; So.init(M, NQKV, C.G, (int)blockIdx.x);
        pg8::EpiQKV E{C.QKV, NQKV, (PG8_LAS float*)(C.lds + NRMP_OFF), C.nrm};
        pg8::gemm_phase<pg8::EpiQKV, pg8::StaticOrder, true, true>(C.lds + RING_OFF, g, So, E);
        if (TWICE(1)) { xcd_barrier(bar); pg8::gemm_phase<pg8::EpiQKV, pg8::StaticOrder, true, true>(C.lds + RING_OFF, g, So, E); }
    } SEAM(1); TS(2);
    if (IN(3)) { const att::Tensors T{(const att::bf16*)C.QKV, (att::bf16*)C.A2, (att::bf16*)C.DT, C.BIAS, C.nrm};
        unsigned* qh = (unsigned*)(ws + WS_CTL) + CW_QHEAD; volatile __attribute__((address_space(3))) int* qw = (volatile __attribute__((address_space(3))) int*)(C.lds + RING_OFF + ATT_QW_OFF);
        att::attn_part<false>((char*)lds + RING_OFF, T, qh, qw); TS(3); att::attn_part<true>((char*)lds + RING_OFF, T, qh + 64, qw); if (TWICE(3)) { xcd_barrier(bar); att::attn_part<false>((char*)lds + RING_OFF, T, qh + 128, qw); att::attn_part<true>((char*)lds + RING_OFF, T, qh + 192, qw); } } SEAM(3); TS(4);
    if (IN(4)) { p3_combine(C); if (TWICE(4)) { xcd_barrier(bar); p3_combine(C); } } SEAM(4); TS(5);
    if (IN(5)) {
        pg8::Gemm g{C.A2, C.WOUT, M, DM, DM}; pg8::StaticOrder So; So.init(M, DM, C.G, (int)blockIdx.x);
        pg8::EpiResBf16 E{C.x, C.H1, DM};
        pg8::gemm_phase<pg8::EpiResBf16, pg8::StaticOrder, true, true>(C.lds + RING_OFF, g, So, E);
        if (TWICE(5)) { xcd_barrier(bar); pg8::gemm_phase<pg8::EpiResBf16, pg8::StaticOrder, true, true>(C.lds + RING_OFF, g, So, E); }
    } SEAM(5); TS(6);
    if (IN(6)) { p5a_router(C); } SEAM(6); TS(7);
#ifdef PROBE_IDLE
    { const unsigned long long t0 = __builtin_amdgcn_s_memrealtime(); while (__builtin_amdgcn_s_memrealtime() - t0 < (unsigned long long)(PROBE_IDLE) * 100ull) __builtin_amdgcn_s_sleep(32); }
#endif
    if (hi > 7) build_seg(C);
#ifdef PROBE_CLK
    unsigned long long ck0 = 0, cr0 = 0, ckd = 0, crd = 1;
    if (IN(PROBE_CLK)) { ck0 = __builtin_amdgcn_s_memtime(); cr0 = __builtin_amdgcn_s_memrealtime(); }
#endif
    if (IN(8)) {
        const PG8_LAS int* tile_e = (const PG8_LAS int*)(C.lds + TILE_E_OFF); const int ntile = ((const LAS int*)(C.lds + SEG_OFF))[NE] >> 8;
        #if defined(PROBE_HOT) && PROBE_HOT >= 3
        pg8::GemmW g{C.A1, DM, DFF, C.etok, args.li > 0 ? 255 : M - 1, (const PG8_LAS int*)(C.lds + TILE_RB_OFF)};
#else
        pg8::GemmW g{C.A1, DM, DFF, C.etok, M - 1, (const PG8_LAS int*)(C.lds + TILE_RB_OFF)};
#endif
        pg8::GroupedOrderW<0> So{ntile * 8, C.G, (int)blockIdx.x, tile_e, C.wgate, C.wup, args.li > 0};
        pg8::EpiSwiglu E{args.li > 0 ? C.XG : C.HB};
        pg8::gemm_phase_wf32<pg8::EpiSwiglu, pg8::GroupedOrderW<0>, true, true>(C.lds + RING_OFF, g, So, E);
    } SEAM(8); TS(8);
    if (IN(9)) {
        const PG8_LAS int* tile_e = (const PG8_LAS int*)(C.lds + TILE_E_OFF); const int ntile = ((const LAS int*)(C.lds + SEG_OFF))[NE] >> 8;
        pg8::GemmW g{C.HB, DFF, DM, nullptr, 0, nullptr}; pg8::GroupedOrderW<1> So{ntile * 8, C.G, (int)blockIdx.x, tile_e, C.wdown, nullptr};
        pg8::EpiDown E{C.Y};
        pg8::gemm_phase_wf32<pg8::EpiDown, pg8::GroupedOrderW<1>, true, false>(C.lds + RING_OFF, g, So, E);
    } SEAM(9); TS(9);
#ifdef PROBE_CLK
    if (IN(PROBE_CLK)) { ckd = __builtin_amdgcn_s_memtime() - ck0; crd = __builtin_amdgcn_s_memrealtime() - cr0; }
#endif
    if (IN(10)) { p8_final(C); if (TWICE(10)) { xcd_barrier(bar); p8_final(C); } }
#ifdef PROBE_CLK
    if (blockIdx.x == 0) { const unsigned long long want = ckd * 100ull / (crd ? crd : 1);
        const unsigned long long t0 = __builtin_amdgcn_s_memrealtime(); while (__builtin_amdgcn_s_memrealtime() - t0 < want) __builtin_amdgcn_s_sleep(8); }
#endif
#ifdef PROBE_TS
    if (blockIdx.x == 0 && C.tid == 0) { const unsigned long long dA = TSW[(PROBE_TS >> 4) & 15] - TSW[(PROBE_TS >> 8) & 15], dB = TSW[PROBE_TS & 15] - TSW[(PROBE_TS >> 12) & 15];
        const unsigned long long want = ((dA + 1000ull) / 2000ull) * 100000ull + dB;
        const unsigned long long t0 = __builtin_amdgcn_s_memrealtime(); while (__builtin_amdgcn_s_memrealtime() - t0 < want) __builtin_amdgcn_s_sleep(8); }
#endif
#ifdef PROBE_NT
    if (blockIdx.x == 0) { const int ntile_ = ((const LAS int*)(C.lds + SEG_OFF))[NE] >> 8; const unsigned long long want = (unsigned long long)(ntile_ > 150 ? ntile_ - 150 : 0) * 2000ull;
        const unsigned long long t0 = __builtin_amdgcn_s_memrealtime(); while (__builtin_amdgcn_s_memrealtime() - t0 < want) __builtin_amdgcn_s_sleep(8); }
#endif
#ifdef PROF_SECT
    if (blockIdx.x == 0) { __syncthreads(); const unsigned want = ((volatile LAS unsigned*)(C.lds + ATT_QW_OFF + 32))[0]; const unsigned long long t0 = __builtin_amdgcn_s_memtime(); while (__builtin_amdgcn_s_memtime() - t0 < (unsigned long long)want) __builtin_amdgcn_s_sleep(8); }
#endif
#undef IN
#undef SEAM
#undef TWICE
}

#if NAIVE_MASK
namespace nv {
__device__ __forceinline__ float bf2f(bf16_t v) { return __uint_as_float((unsigned)v << 16); }
__device__ __forceinline__ bf16_t f2b(float f) { return (bf16_t)f2bf(f); }
__global__ void __launch_bounds__(256) k_cumsum(float* __restrict__ bias) {
    __shared__ float part[256];
    float* p = bias + (size_t)blockIdx.x * S; const int tid = threadIdx.x;
    float loc[32]; float s = 0.f;
#pragma unroll
    for (int i = 0; i < 32; ++i) { s += p[tid * 32 + i]; loc[i] = s; }
    part[tid] = s; __syncthreads();
    if (tid == 0) { float a = 0.f; for (int i = 0; i < 256; ++i) { const float q = part[i]; part[i] = a; a += q; } }
    __syncthreads();
    const float base = part[tid];
#pragma unroll
    for (int i = 0; i < 32; ++i) p[tid * 32 + i] = (base + loc[i]) * ATT_ISCALE;
}
template <class FA, class FB>
__device__ __forceinline__ void ngemm_tile(int K, FA fa, FB fb, float (&acc)[4][4], float (*As)[65], float (*Bs)[65]) {
    const int tid = threadIdx.x, tx = tid & 15, ty = tid >> 4;
#pragma unroll
    for (int r = 0; r < 4; ++r)
#pragma unroll
        for (int c = 0; c < 4; ++c) acc[r][c] = 0.f;
    for (int k0 = 0; k0 < K; k0 += 16) {
        for (int e = tid; e < 1024; e += 256) { const int i = e >> 4, kk = e & 15; As[kk][i] = fa(i, k0 + kk); Bs[kk][i] = fb(k0 + kk, i); }
        __syncthreads();
#pragma unroll
        for (int kk = 0; kk < 16; ++kk) { float a[4], b[4];
#pragma unroll
            for (int r = 0; r < 4; ++r) a[r] = As[kk][ty * 4 + r];
#pragma unroll
            for (int c = 0; c < 4; ++c) b[c] = Bs[kk][tx * 4 + c];
#pragma unroll
            for (int r = 0; r < 4; ++r)
#pragma unroll
                for (int c = 0; c < 4; ++c) acc[r][c] += a[r] * b[c]; }
        __syncthreads();
    }
}
__global__ void __launch_bounds__(256) k_inproj(const bf16_t* __restrict__ A, const bf16_t* __restrict__ Bt, bf16_t* __restrict__ Cq) {
    __shared__ float As[16][65], Bs[16][65];
    const int m0 = blockIdx.y * 64, n0 = blockIdx.x * 64; float acc[4][4];
    ngemm_tile(DM, [&](int i, int k) { return bf2f(A[(size_t)(m0 + i) * DM + k]); }, [&](int k, int j) { return bf2f(Bt[(size_t)(n0 + j) * DM + k]); }, acc, As, Bs);
    const int tx = threadIdx.x & 15, ty = threadIdx.x >> 4;
#pragma unroll
    for (int r = 0; r < 4; ++r)
#pragma unroll
        for (int c = 0; c < 4; ++c) Cq[(size_t)(m0 + ty * 4 + r) * NQKV + n0 + tx * 4 + c] = f2b(acc[r][c]);
}
__global__ void __launch_bounds__(256) k_outproj(const bf16_t* __restrict__ A, const bf16_t* __restrict__ Bt, const float* __restrict__ x, float* __restrict__ H1) {
    __shared__ float As[16][65], Bs[16][65];
    const int m0 = blockIdx.y * 64, n0 = blockIdx.x * 64; float acc[4][4];
    ngemm_tile(DM, [&](int i, int k) { return bf2f(A[(size_t)(m0 + i) * DM + k]); }, [&](int k, int j) { return bf2f(Bt[(size_t)(n0 + j) * DM + k]); }, acc, As, Bs);
    const int tx = threadIdx.x & 15, ty = threadIdx.x >> 4;
#pragma unroll
    for (int r = 0; r < 4; ++r)
#pragma unroll
        for (int c = 0; c < 4; ++c) { const size_t o = (size_t)(m0 + ty * 4 + r) * DM + n0 + tx * 4 + c; H1[o] = x[o] + acc[r][c]; }
}
__global__ void __launch_bounds__(256) k_attn(const bf16_t* __restrict__ QKV, const float* __restrict__ bias, bf16_t* __restrict__ A2, bf16_t* __restrict__ DT) {
    __shared__ bf16_t Qs[64][130];
    __shared__ float Ks[32][129];
    __shared__ float Vs[32][128];
    __shared__ float Ps[64][33];
    const int tid = threadIdx.x, r = tid >> 2, c4 = tid & 3;
    const int qb = (int)gridDim.x - 1 - (int)blockIdx.x, p = blockIdx.y;
    int b, qcol, kcol, vcol, h, map = 0, vh = 0; const float* cc; const bool fox = p < 16;
    if (fox) { b = p >> 3; h = p & 7; qcol = C_FQ + h * 128; kcol = C_FK + h * 128; vcol = C_FV + h * 128; cc = bias + ((size_t)b * 8 + h) * S; }
    else { const int q = p - 16; b = q >> 4; h = (q >> 2) & 3; map = (q >> 1) & 1; vh = q & 1; qcol = C_DQ + h * 256 + map * 128; kcol = C_DK + h * 256 + map * 128; vcol = C_DV + h * 256 + vh * 128; cc = bias + (size_t)(16 + h) * S; }
    const int q0 = qb * 64; const size_t rowb = (size_t)b * S;
    for (int e = tid; e < 64 * 128; e += 256) { const int i = e >> 7, d = e & 127; Qs[i][d] = QKV[(rowb + q0 + i) * NQKV + qcol + d]; }
    const int t = q0 + r; const float ct = cc[t];
    float m = -1e30f, l = 0.f; float o[32];
#pragma unroll
    for (int j = 0; j < 32; ++j) o[j] = 0.f;
    const int nkt = (q0 + 63) / 32 + 1;
    for (int kt = 0; kt < nkt; ++kt) {
        const int k0 = kt * 32;
        __syncthreads();
        for (int e = tid; e < 32 * 128; e += 256) { const int i = e >> 7, d = e & 127; const size_t ro = (rowb + k0 + i) * NQKV; Ks[i][d] = bf2f(QKV[ro + kcol + d]); Vs[i][d] = bf2f(QKV[ro + vcol + d]); }
        __syncthreads();
        float sc[8];
#pragma unroll
        for (int j = 0; j < 8; ++j) sc[j] = 0.f;
        for (int d = 0; d < 128; ++d) { const float qv = bf2f(Qs[r][d]);
#pragma unroll
            for (int j = 0; j < 8; ++j) sc[j] += qv * Ks[c4 * 8 + j][d]; }
        float tmax = -__builtin_inff();
#pragma unroll
        for (int j = 0; j < 8; ++j) { const int s = k0 + c4 * 8 + j; float v = (sc[j] + (ct - cc[s])) * ATT_SCALE;
            if (s > t) v = -__builtin_inff();
            sc[j] = v; tmax = fmaxf(tmax, v); }
        tmax = fmaxf(tmax, __shfl_xor(tmax, 1)); tmax = fmaxf(tmax, __shfl_xor(tmax, 2));
        const float mn = fmaxf(m, tmax), alpha = __expf(m - mn); m = mn;
        float ps = 0.f;
#pragma unroll
        for (int j = 0; j < 8; ++j) { const float pv = __expf(sc[j] - mn); ps += pv; Ps[r][c4 * 8 + j] = pv; }
        ps += __shfl_xor(ps, 1); ps += __shfl_xor(ps, 2);
        l = l * alpha + ps;
        __syncthreads();
#pragma unroll
        for (int j = 0; j < 32; ++j) o[j] *= alpha;
        for (int kk = 0; kk < 32; ++kk) { const float pv = Ps[r][kk];
#pragma unroll
            for (int j = 0; j < 32; ++j) o[j] += pv * Vs[kk][c4 + 4 * j]; }
    }
    const float il = 1.f / l;
    bf16_t* op = fox ? A2 + (rowb + t) * DM + h * 128 : DT + (rowb + t) * DM + h * 512 + map * 256 + vh * 128;
#pragma unroll
    for (int j = 0; j < 32; ++j) op[c4 + 4 * j] = f2b(o[j] * il);
}
__global__ void __launch_bounds__(256) k_diff_combine(const bf16_t* __restrict__ DT, const float* __restrict__ lq1, const float* __restrict__ lk1, const float* __restrict__ lq2,
                                                      const float* __restrict__ lk2, const float* __restrict__ sg, bf16_t* __restrict__ A2) {
    const int lane = threadIdx.x & 63, wv = threadIdx.x >> 6;
    const int idx = blockIdx.x * 4 + wv, t = idx >> 2, h = idx & 3;
    const float s1 = wave_sum(lq1[lane] * lk1[lane] + lq1[lane + 64] * lk1[lane + 64]);
    const float s2 = wave_sum(lq2[lane] * lk2[lane] + lq2[lane + 64] * lk2[lane + 64]);
    const float lam = expf(s1) - expf(s2) + 0.2f;
    const bf16_t* p = DT + (size_t)t * DM + h * 512;
    float d[4]; float ss = 0.f;
#pragma unroll
    for (int c = 0; c < 4; ++c) { d[c] = bf2f(p[lane * 4 + c]) - lam * bf2f(p[256 + lane * 4 + c]); ss += d[c] * d[c]; }
    ss = wave_sum(ss);
    const float r = rsqrtf(ss * (1.f / 256.f) + 1e-5f) * 0.8f;
    bf16_t* o = A2 + (size_t)t * DM + 1024 + h * 256 + lane * 4;
#pragma unroll
    for (int c = 0; c < 4; ++c) o[c] = f2b(d[c] * r * sg[lane * 4 + c]);
}
__global__ void __launch_bounds__(256) k_route(const float* __restrict__ H1, const float* __restrict__ g, const float* __restrict__ wg, const float* __restrict__ bg,
                                               const float* __restrict__ we, const float* __restrict__ be, int* __restrict__ tok_e, int* __restrict__ tok_pos,
                                               float* __restrict__ tok_gate, float* __restrict__ rstd, unsigned* __restrict__ cnt) {
    __shared__ float xs[4][DM];
    const int lane = threadIdx.x & 63, wv = threadIdx.x >> 6;
    const int t = blockIdx.x * 4 + wv;
    const float* xr = H1 + (size_t)t * DM;
    f32x4 v[8]; float ss = 0.f;
#pragma unroll
    for (int j = 0; j < 8; ++j) { v[j] = *(const f32x4*)(xr + j * 256 + lane * 4); ss += v[j].x * v[j].x + v[j].y * v[j].y + v[j].z * v[j].z + v[j].w * v[j].w; }
    ss = wave_sum(ss);
    const float r = 1.f / sqrtf(ss * (1.f / DM) + 1e-6f);
#pragma unroll
    for (int j = 0; j < 8; ++j) { const f32x4 gg = *(const f32x4*)(g + j * 256 + lane * 4); *(f32x4*)(&xs[wv][j * 256 + lane * 4]) = v[j] * r * gg; }
    __syncthreads();
    float el = 0.f;
    for (int k = 0; k < DM; ++k) el += xs[wv][k] * we[(size_t)k * NE + lane];
    el += be[lane];
    float gl = 0.f;
    for (int k = (lane >> 3); k < DM; k += 8) gl += xs[wv][k] * wg[(size_t)k * 8 + (lane & 7)];
    gl += __shfl_xor(gl, 8); gl += __shfl_xor(gl, 16); gl += __shfl_xor(gl, 32);
    gl += bg[lane & 7];
    float gmax = -__builtin_inff(); int gi = 0;
#pragma unroll
    for (int j = 0; j < 8; ++j) { const float q = __shfl(gl, j); if (q > gmax) { gmax = q; gi = j; } }
    float gs = 0.f;
#pragma unroll
    for (int j = 0; j < 8; ++j) gs += expf(__shfl(gl, j) - gmax);
    const float gprob = 1.f / gs;
    float l1 = -__builtin_inff(), l2 = -__builtin_inff(); int i1 = 0, i2 = 0;
#pragma unroll
    for (int j = 0; j < 8; ++j) { const float q = __shfl(el, gi * 8 + j);
        if (q > l1) { l2 = l1; i2 = i1; l1 = q; i1 = j; } else if (q > l2) { l2 = q; i2 = j; } }
    const float e2 = expf(l2 - l1), g1 = gprob / (1.f + e2), g2 = gprob * e2 / (1.f + e2);
    if (lane == 0) {
        const int ea = gi * 8 + i1, eb = gi * 8 + i2;
        const unsigned pa = atomicAdd(cnt + ea, 1u), pb = atomicAdd(cnt + eb, 1u);
        tok_e[t * 2] = ea; tok_e[t * 2 + 1] = eb; tok_pos[t * 2] = (int)pa; tok_pos[t * 2 + 1] = (int)pb; tok_gate[t * 2] = g1; tok_gate[t * 2 + 1] = g2; rstd[t] = r;
    }
}
__device__ __forceinline__ int seg_off(const unsigned* cnt, int e) { int o = 0; for (int i = 0; i < e; ++i) o += (int)((cnt[i] + 255u) & ~255u); return o; }
__global__ void __launch_bounds__(256) k_dispatch(const float* __restrict__ H1, const float* __restrict__ g, const float* __restrict__ rstd, const int* __restrict__ tok_e,
                                                  const int* __restrict__ tok_pos, const float* __restrict__ tok_gate, const unsigned* __restrict__ cnt, bf16_t* __restrict__ XG, float* __restrict__ rowgate) {
    const int lane = threadIdx.x & 63, wv = threadIdx.x >> 6; const int t = blockIdx.x * 4 + wv;
    const int ra = seg_off(cnt, tok_e[t * 2]) + tok_pos[t * 2], rb = seg_off(cnt, tok_e[t * 2 + 1]) + tok_pos[t * 2 + 1];
    const float rs = rstd[t];
    for (int k = lane; k < DM; k += 64) { const bf16_t v = f2b(H1[(size_t)t * DM + k] * rs * g[k]); XG[(size_t)ra * DM + k] = v; XG[(size_t)rb * DM + k] = v; }
    if (lane == 0) { rowgate[ra] = tok_gate[t * 2]; rowgate[rb] = tok_gate[t * 2 + 1]; }
}
__global__ void __launch_bounds__(256) k_moe_up(const bf16_t* __restrict__ XG, const bf16_t* __restrict__ WGU, const unsigned* __restrict__ cnt, bf16_t* __restrict__ HB) {
    __shared__ float As[16][65], Bs[16][65];
    const int m0 = blockIdx.y * 64, n0 = blockIdx.x * 64;
    int e = 0, tot = 0; { int o = 0; for (int i = 0; i < NE; ++i) { if (o <= m0) e = i; o += (int)((cnt[i] + 255u) & ~255u); } tot = o; }
    if (m0 >= tot) return;
    const bf16_t* W = WGU + (size_t)e * 2048 * DM; const int rg = 256 * (n0 >> 7) + (n0 & 127), ru = rg + 128;
    float ag[4][4], au[4][4];
    ngemm_tile(DM, [&](int i, int k) { return bf2f(XG[(size_t)(m0 + i) * DM + k]); }, [&](int k, int j) { return bf2f(W[(size_t)(rg + j) * DM + k]); }, ag, As, Bs);
    ngemm_tile(DM, [&](int i, int k) { return bf2f(XG[(size_t)(m0 + i) * DM + k]); }, [&](int k, int j) { return bf2f(W[(size_t)(ru + j) * DM + k]); }, au, As, Bs);
    const int tx = threadIdx.x & 15, ty = threadIdx.x >> 4;
#pragma unroll
    for (int r = 0; r < 4; ++r)
#pragma unroll
        for (int c = 0; c < 4; ++c) { const float gv = ag[r][c]; HB[(size_t)(m0 + ty * 4 + r) * DFF + n0 + tx * 4 + c] = f2b(gv / (1.f + expf(-gv)) * au[r][c]); }
}
__global__ void __launch_bounds__(256) k_moe_down(const bf16_t* __restrict__ HB, const bf16_t* __restrict__ WD, const unsigned* __restrict__ cnt, const float* __restrict__ rowgate, bf16_t* __restrict__ Y) {
    __shared__ float As[16][65], Bs[16][65];
    const int m0 = blockIdx.y * 64, n0 = blockIdx.x * 64;
    int e = 0, tot = 0; { int o = 0; for (int i = 0; i < NE; ++i) { if (o <= m0) e = i; o += (int)((cnt[i] + 255u) & ~255u); } tot = o; }
    if (m0 >= tot) return;
    const bf16_t* W = WD + (size_t)e * DM * DFF; float acc[4][4];
    ngemm_tile(DFF, [&](int i, int k) { return bf2f(HB[(size_t)(m0 + i) * DFF + k]); }, [&](int k, int j) { return bf2f(W[(size_t)(n0 + j) * DFF + k]); }, acc, As, Bs);
    const int tx = threadIdx.x & 15, ty = threadIdx.x >> 4;
#pragma unroll
    for (int r = 0; r < 4; ++r) { const int row = m0 + ty * 4 + r; const float gt = rowgate[row];
#pragma unroll
        for (int c = 0; c < 4; ++c) Y[(size_t)row * DM + n0 + tx * 4 + c] = f2b(acc[r][c] * gt); }
}
__global__ void __launch_bounds__(256) k_final(const float* __restrict__ H1, const bf16_t* __restrict__ Y, const unsigned* __restrict__ cnt, const int* __restrict__ tok_e,
                                               const int* __restrict__ tok_pos, const float* __restrict__ g, float* __restrict__ out) {
    const int lane = threadIdx.x & 63, wv = threadIdx.x >> 6; const int t = blockIdx.x * 4 + wv;
    const int ra = seg_off(cnt, tok_e[t * 2]) + tok_pos[t * 2], rb = seg_off(cnt, tok_e[t * 2 + 1]) + tok_pos[t * 2 + 1];
    float v[32]; float ss = 0.f;
#pragma unroll
    for (int i = 0; i < 32; ++i) { const int k = lane + 64 * i; v[i] = H1[(size_t)t * DM + k] + bf2f(Y[(size_t)ra * DM + k]) + bf2f(Y[(size_t)rb * DM + k]); ss += v[i] * v[i]; }
    ss = wave_sum(ss);
    const float r = 1.f / sqrtf(ss * (1.f / DM) + 1e-6f);
#pragma unroll
    for (int i = 0; i < 32; ++i) { const int k = lane + 64 * i; out[(size_t)t * DM + k] = v[i] * r * g[k]; }
}
}
static void naive_phase(int k, const Args& a, hipStream_t stream) {
    unsigned char* ws = a.ws;
    bf16_t* A1 = (bf16_t*)(ws + WS_A1); bf16_t* WIN = (bf16_t*)(ws + WS_WIN); bf16_t* WOUT = (bf16_t*)(ws + WS_WOUT); float* BIAS = (float*)(ws + WS_BIAS); bf16_t* QKV = (bf16_t*)(ws + WS_QKV);
    bf16_t* A2 = (bf16_t*)(ws + WS_A2); bf16_t* DT = (bf16_t*)(ws + WS_DT); float* H1 = (float*)(ws + WS_H1);
    int* tok_e = (int*)(ws + WS_ROUTE); int* tok_pos = tok_e + 2 * M; float* tok_gate = (float*)(tok_pos + 2 * M); float* rstd = tok_gate + 2 * M; float* rowgate = rstd + M;
    bf16_t* XG = (bf16_t*)(ws + WS_XG); bf16_t* HB = (bf16_t*)(ws + WS_HBUF); bf16_t* Y = (bf16_t*)(ws + WS_Y); bf16_t* WGU = (bf16_t*)(ws + WS_WGU); bf16_t* WD = (bf16_t*)(ws + WS_WD);
    unsigned* cnt = (unsigned*)(ws + WS_CTL) + CW_CNT;
    switch (k) {
    case 1: nv::k_cumsum<<<16, 256, 0, stream>>>(BIAS); nv::k_inproj<<<dim3(NQKV / 64, M / 64), 256, 0, stream>>>(A1, WIN, QKV); break;
    case 3: nv::k_attn<<<dim3(S / 64, 48), 256, 0, stream>>>(QKV, BIAS, A2, DT); break;
    case 4: nv::k_diff_combine<<<M, 256, 0, stream>>>(DT, a.in[4], a.in[5], a.in[6], a.in[7], a.in[8], A2); break;
    case 5: nv::k_outproj<<<dim3(DM / 64, M / 64), 256, 0, stream>>>(A2, WOUT, a.in[0], H1); break;
    case 6: nv::k_route<<<M / 4, 256, 0, stream>>>(H1, a.in[10], a.in[11], a.in[12], a.in[13], a.in[14], tok_e, tok_pos, tok_gate, rstd, cnt); break;
    case 7: nv::k_dispatch<<<M / 4, 256, 0, stream>>>(H1, a.in[10], rstd, tok_e, tok_pos, tok_gate, cnt, XG, rowgate); break;
    case 8: nv::k_moe_up<<<dim3(DFF / 64, YROWS / 64), 256, 0, stream>>>(XG, WGU, cnt, HB); break;
    case 9: nv::k_moe_down<<<dim3(DM / 64, YROWS / 64), 256, 0, stream>>>(HB, WD, cnt, rowgate, Y); break;
    case 10: nv::k_final<<<M / 4, 256, 0, stream>>>(H1, Y, cnt, tok_e, tok_pos, a.in[18], a.out); break;
    default: break;
    }
}
#endif


extern "C" void kernel_launch(void* const* d_in, const int* in_sizes, int n_in, void* d_out, int out_size, void* d_ws, size_t ws_size, hipStream_t stream) {
    static int grid = 0;
    if (grid == 0) {
        if (n_in != 19 || in_sizes[0] != M * DM || out_size != M * DM || ws_size < WS_END) {
            fprintf(stderr, "kernel_launch: built for 19 inputs, x and out of %d floats, >= %zu bytes of workspace; got n_in %d, in0 %d, out %d, ws %zu; nothing launched\n", M * DM, (size_t)WS_END, n_in, n_in > 0 ? in_sizes[0] : -1, out_size, ws_size); grid = -1; return; }
        int dev = 0, cus = 0, per_cu = 0;
        if (hipGetDevice(&dev) != hipSuccess || hipDeviceGetAttribute(&cus, hipDeviceAttributeMultiprocessorCount, dev) != hipSuccess) { fprintf(stderr, "kernel_launch: device query failed\n"); grid = -1; return; }
        if (hipFuncSetAttribute((const void*)mk_fwd, hipFuncAttributeMaxDynamicSharedMemorySize, LDS_BYTES) != hipSuccess) { fprintf(stderr, "kernel_launch: hipFuncSetAttribute failed\n"); grid = -1; return; }
        if (hipOccupancyMaxActiveBlocksPerMultiprocessor(&per_cu, (const void*)mk_fwd, NWAVES * 64, LDS_BYTES) != hipSuccess || per_cu < 1)
            fprintf(stderr, "kernel_launch: note: occupancy query reports %d workgroups per CU\n", per_cu);
        (void)hipGetLastError();
        grid = cus;
    }
    if (grid < 0) return;
    if (hipMemsetAsync((char*)d_ws + WS_CTL, 0, CTL_ZERO_BYTES, stream) != hipSuccess) { fprintf(stderr, "kernel_launch: memset failed\n"); return; }
    Args a{};
    for (int i = 0; i < 19; ++i) a.in[i] = (const float*)d_in[i];
    a.out = (float*)d_out; a.ws = (unsigned char*)d_ws;
    int k = 0, li = 0;
    while (k < NPHASE) {
#if NAIVE_MASK
        if (k > 0 && ((NAIVE_MASK >> k) & 1u)) { naive_phase(k, a, stream); ++k; continue; }
#endif
        const int lo = k; ++k;
        while (k < NPHASE && !((NAIVE_MASK >> k) & 1u)) ++k;
        a.ph_lo = lo; a.ph_hi = k; a.li = li++;
        hipLaunchKernelGGL(mk_fwd, dim3(grid), dim3(NWAVES * 64), LDS_BYTES, stream, a);
        const hipError_t le = hipPeekAtLastError();
        if (le != hipSuccess) { fprintf(stderr, "kernel_launch: launch failed: %s\n", hipGetErrorName(le)); break; }
    }
#if PROBE_REP
    a.ph_lo = PROBE_REP; a.ph_hi = PROBE_REP + 1; a.li = li++;
    hipLaunchKernelGGL(mk_fwd, dim3(grid), dim3(NWAVES * 64), LDS_BYTES, stream, a);
#endif
}
```

```cpp
#include <hip/hip_runtime.h>
#include <hip/hip_bf16.h>
#include <cstdio>
#include <cstdint>
#include <cmath>

#ifndef NAIVE_MASK
#define NAIVE_MASK 0u
#endif

typedef unsigned short bf16_t;
constexpr int NB = 2, S = 8192, DM = 2048, M = NB * S;
constexpr int NCOL = 6152, NQKV = 6144;
constexpr int FCOL = 3072;
constexpr int NE = 64, DFF = 1024;
constexpr int YROWS = 49152, NTILE_MAX = YROWS / 256;
constexpr int C_FQ = 0, C_FK = 1024, C_FV = 2048, C_DQ = 3072, C_DK = 4096, C_DV = 5120;
constexpr float ATT_SCALE = 0.08838834764831845f, ATT_ISCALE = 11.313708498984761f;
constexpr int NPHASE = 11;

constexpr size_t MiB = 1u << 20;
constexpr size_t WS_CTL = 0, CTL_ZERO_BYTES = 1 * MiB;
constexpr size_t WS_A1 = 1 * MiB;
constexpr size_t WS_WIN = 65 * MiB;
constexpr size_t WS_WOUT = 89 * MiB;
constexpr size_t WS_BIAS = 97 * MiB;
constexpr size_t WS_QKV = 98 * MiB;
constexpr size_t WS_A2 = 290 * MiB;
constexpr size_t WS_DT = 354 * MiB;
constexpr size_t WS_H1 = 418 * MiB;
constexpr size_t WS_ROUTE = 546 * MiB;
constexpr size_t WS_WR = 547 * MiB;
constexpr size_t WS_XG = 548 * MiB;
constexpr size_t WS_HBUF = 740 * MiB;
constexpr size_t WS_Y = 836 * MiB;
constexpr size_t WS_WGU = 1028 * MiB;
constexpr size_t WS_WD = 1540 * MiB;
constexpr size_t WS_END = 1796 * MiB;
constexpr int CW_CNT = 65536, CNT_STRIDE = 1056;
constexpr int CW_NRM = 2048;
constexpr int CW_QHEAD = 3072;
constexpr int CW_BAR = 4096;

namespace pg8 {
#define PG8_LAS __attribute__((address_space(3)))
typedef unsigned short bf16_t;
typedef short bf16x8 __attribute__((ext_vector_type(8)));
typedef float f32x4 __attribute__((ext_vector_type(4)));
typedef unsigned u32x4 __attribute__((ext_vector_type(4)));
constexpr int BM = 256, BK = 64, HALF = 128, HTB = HALF * BK * 2  , STAGE_BYTES = 8 * HTB, NXCD = 8, WGM = 8;

__host__ __device__ __forceinline__ int lds_byte(int r, int c) { const int st = (r >> 4) * 2 + (c >> 5), rr = r & 15, cc = c & 31, ob = rr * 64 + cc * 2; return st * 1024 + (ob ^ (((ob >> 9) & 1) << 5)); }
__host__ __device__ __forceinline__ void stage_rc(int b, int& R, int& C) { const int st = b / 1024, sb = b % 1024, swz = sb ^ (((sb >> 9) & 1) << 5); R = (st >> 1) * 16 + swz / 64; C = (st & 1) * 32 + (swz % 64) / 2; }
__host__ __device__ __forceinline__ int perm32(int rho) { const int n = rho >> 4, i = rho & 15; return 8 * (i >> 2) + 4 * n + (i & 3); }

struct Unit { int pm, pn; };
struct Gemm { const bf16_t* A; const bf16_t* Bt; int M, N, K; };

struct StaticOrder {
    int nM, nN, nwg, G, c;
    __host__ __device__ void init(int M, int N, int G_, int c_) { nM = M / BM; nN = N / BM; nwg = nM * nN; G = G_; c = c_; }
    __host__ __device__ bool next(int i, Unit& u) const {
        const long L = (long)i * G + c; if (L >= nwg) return false;
        int wgid = (int)L; { const int q = nwg / NXCD, r = nwg % NXCD, xcd = wgid % NXCD, off = wgid / NXCD; wgid = (xcd < r ? xcd * (q + 1) : r * (q + 1) + (xcd - r) * q) + off; }
        const int nig = WGM * nN, gid = wgid / nig, fm = gid * WGM, gsz = (nM - fm) < WGM ? (nM - fm) : WGM;
        u.pm = fm + ((wgid % nig) % gsz); u.pn = (wgid % nig) / gsz; return true;
    }
    __device__ __forceinline__ void a_ready(const Unit&) const {}
    __device__ __forceinline__ void done(const Unit&) const {}
};

__device__ __forceinline__ unsigned cvt_pk_bf16(float lo, float hi) { unsigned r; asm volatile("v_cvt_pk_bf16_f32 %0, %1, %2" : "=v"(r) : "v"(lo), "v"(hi)); return r; }
typedef float f32x2 __attribute__((ext_vector_type(2)));
__device__ __forceinline__ f32x2 gelu_pk(f32x2 v) {
    const f32x2 av = __builtin_elementwise_abs(v), d = av * 0.2316418882f + 1.0f;
    f32x2 t; t.x = __builtin_amdgcn_rcpf(d.x); t.y = __builtin_amdgcn_rcpf(d.y);
    f32x2 q = t * 0.5307027145f + (-0.7265760135f); q = q * t + 0.7107068705f; q = q * t + (-0.142248368f); q = q * t + 0.127414796f; q = q * t;
    const f32x2 s = (v * v) * (-0.72134752044f);
    f32x2 e; e.x = __builtin_amdgcn_exp2f(s.x); e.y = __builtin_amdgcn_exp2f(s.y);
    const f32x2 m = v * (q * e), r = v - m;
    f32x2 o; o.x = v.x < 0.f ? m.x : r.x; o.y = v.y < 0.f ? m.y : r.y; return o;
}

template <int ACT  > struct EpiBf16 {
    static constexpr bool PERM = true, AFTER_DRAIN = false; static_assert(ACT == 0 || ACT == 1, "EpiBf16: ACT is 0 (none) or 1 (gelu_pk)");
    bf16_t* O; int ldc; const float* bias; int split_cols; size_t split_stride; float scale0;
    __device__ __forceinline__ void operator()(const f32x4 (&acc)[2][2][4][2], const Unit& u, int wr, int wc, int fr, int fq) const {
        const int row0 = u.pm * BM + wr * 64 + fr; int colt = u.pn * BM; bf16_t* base = O;
        float sc = 1.f; if (split_cols) { const int t = colt / split_cols; base += (size_t)t * split_stride; colt -= t * split_cols; if (t == 0) sc = scale0; }
        const int col0 = colt + wc * 32 + 8 * fq, bcol0 = u.pn * BM + wc * 32 + 8 * fq;
        f32x4 bv[2][2];
#pragma unroll
        for (int bj = 0; bj < 2; ++bj)
#pragma unroll
            for (int n = 0; n < 2; ++n) bv[bj][n] = bias ? *(const f32x4*)(bias + bcol0 + bj * HALF + 4 * n) : (f32x4){0.f, 0.f, 0.f, 0.f};
#pragma unroll
        for (int ai = 0; ai < 2; ++ai)
#pragma unroll
            for (int m = 0; m < 4; ++m) { bf16_t* rowp = base + (size_t)(row0 + ai * HALF + m * 16) * ldc + col0;
#pragma unroll
                for (int bj = 0; bj < 2; ++bj) { f32x4 v0 = acc[ai][bj][m][0] + bv[bj][0], v1 = acc[ai][bj][m][1] + bv[bj][1];
                    if (ACT == 1) { f32x2 a = gelu_pk((f32x2){v0[0], v0[1]}), b = gelu_pk((f32x2){v0[2], v0[3]}), c = gelu_pk((f32x2){v1[0], v1[1]}), d = gelu_pk((f32x2){v1[2], v1[3]});
                        v0 = (f32x4){a.x, a.y, b.x, b.y}; v1 = (f32x4){c.x, c.y, d.x, d.y}; }
                    v0 = v0 * sc; v1 = v1 * sc; u32x4 w; w.x = cvt_pk_bf16(v0[0], v0[1]); w.y = cvt_pk_bf16(v0[2], v0[3]); w.z = cvt_pk_bf16(v1[0], v1[1]); w.w = cvt_pk_bf16(v1[2], v1[3]);
                    *(u32x4*)(rowp + bj * HALF) = w; } }
    }
};

struct EpiResF32 {
    static constexpr bool PERM = false, AFTER_DRAIN = false;
    const float* base; float* out; int ldc;
    __device__ __forceinline__ void operator()(const f32x4 (&acc)[2][2][4][2], const Unit& u, int wr, int wc, int fr, int fq) const {
        const int col0 = u.pn * BM + wc * 32 + 4 * fq;
#pragma unroll
        for (int ai = 0; ai < 2; ++ai)
#pragma unroll
            for (int m = 0; m < 4; ++m) { const size_t off = (size_t)(u.pm * BM + ai * HALF + wr * 64 + m * 16 + fr) * ldc + col0;
#pragma unroll
                for (int bj = 0; bj < 2; ++bj)
#pragma unroll
                    for (int n = 0; n < 2; ++n) { const f32x4 bs = *(const f32x4*)(base + off + bj * HALF + n * 16); *(f32x4*)(out + off + bj * HALF + n * 16) = bs + acc[ai][bj][m][n]; }
                if (m & 1) asm volatile("" ::: "memory"); }
    }
};
struct EpiResBf16 {
    static constexpr bool PERM = true, AFTER_DRAIN = false;
    const float* base; bf16_t* out; int ldc;
    __device__ __forceinline__ void operator()(const f32x4 (&acc)[2][2][4][2], const Unit& u, int wr, int wc, int fr, int fq) const {
        const int col0 = u.pn * BM + wc * 32 + 8 * fq;
#pragma unroll
        for (int ai = 0; ai < 2; ++ai)
#pragma unroll
            for (int m = 0; m < 4; ++m) { const size_t off = (size_t)(u.pm * BM + ai * HALF + wr * 64 + m * 16 + fr) * ldc + col0;
#pragma unroll
                for (int bj = 0; bj < 2; ++bj) { const f32x4 v0 = *(const f32x4*)(base + off + bj * HALF) + acc[ai][bj][m][0], v1 = *(const f32x4*)(base + off + bj * HALF + 4) + acc[ai][bj][m][1];
                    u32x4 w; w.x = cvt_pk_bf16(v0[0], v0[1]); w.y = cvt_pk_bf16(v0[2], v0[3]); w.z = cvt_pk_bf16(v1[0], v1[1]); w.w = cvt_pk_bf16(v1[2], v1[3]);
                    *(u32x4*)(out + off + bj * HALF) = w; }
                if (m & 1) asm volatile("" ::: "memory"); }
    }
};
struct EpiQKV {
    static constexpr bool PERM = true, AFTER_DRAIN = false;
    bf16_t* O; int ldc; PG8_LAS float* part; unsigned* nrm;
    __device__ __forceinline__ void operator()(const f32x4 (&acc)[2][2][4][2], const Unit& u, int wr, int wc, int fr, int fq) const {
        const int row0 = u.pm * BM + wr * 64 + fr, col0 = u.pn * BM + wc * 32 + 8 * fq;
        const bool track = u.pn < 8 || (u.pn >= 12 && u.pn < 20);
#pragma unroll
        for (int ai = 0; ai < 2; ++ai)
#pragma unroll
            for (int m = 0; m < 4; ++m) { bf16_t* rowp = O + (size_t)(row0 + ai * HALF + m * 16) * ldc + col0;
#pragma unroll
                for (int bj = 0; bj < 2; ++bj) { const f32x4 v0 = acc[ai][bj][m][0], v1 = acc[ai][bj][m][1];
                    u32x4 w; w.x = cvt_pk_bf16(v0[0], v0[1]); w.y = cvt_pk_bf16(v0[2], v0[3]); w.z = cvt_pk_bf16(v1[0], v1[1]); w.w = cvt_pk_bf16(v1[2], v1[3]);
                    *(u32x4*)(rowp + bj * HALF) = w;
                    if (track) { float ss = ((v0[0] * v0[0] + v0[1] * v0[1]) + (v0[2] * v0[2] + v0[3] * v0[3])) + ((v1[0] * v1[0] + v1[1] * v1[1]) + (v1[2] * v1[2] + v1[3] * v1[3]));
                        ss += __shfl_xor(ss, 16); ss += __shfl_xor(ss, 32);
                        if (fq == 0) part[(wc * 2 + bj) * 256 + ai * HALF + wr * 64 + m * 16 + fr] = ss; } } }
        if (track) {
            asm volatile("s_waitcnt lgkmcnt(0)" ::: "memory"); __builtin_amdgcn_s_barrier(); asm volatile("" ::: "memory");
            const int tid = threadIdx.x, row = tid & 255, bj = tid >> 8;
            float v = (part[(0 * 2 + bj) * 256 + row] + part[(1 * 2 + bj) * 256 + row]) + (part[(2 * 2 + bj) * 256 + row] + part[(3 * 2 + bj) * 256 + row]);
#pragma unroll
            for (int o = 1; o < 64; o <<= 1) v = fmaxf(v, __shfl_xor(v, o));
            const int slice = (u.pn < 8 ? 2 * u.pn : 16 + 2 * (u.pn - 12)) + bj;
            if ((tid & 63) == 0) atomicMax(nrm + (u.pm >> 5) * 32 + slice, __float_as_uint(v));
            asm volatile("s_waitcnt lgkmcnt(0)" ::: "memory");
        }
    }
};
struct EpiSwiglu {
    static constexpr bool PERM = true, AFTER_DRAIN = false;
    bf16_t* H;
    __device__ __forceinline__ void operator()(const f32x4 (&acc)[2][2][4][2], const Unit& u, int wr, int wc, int fr, int fq) const {
        const int col0 = (u.pn & 7) * HALF + wc * 32 + 8 * fq;
#pragma unroll
        for (int ai = 0; ai < 2; ++ai)
#pragma unroll
            for (int m = 0; m < 4; ++m) { bf16_t* rowp = H + (size_t)(u.pm * BM + ai * HALF + wr * 64 + m * 16 + fr) * 1024 + col0;
                float hv[8];
#pragma unroll
                for (int n = 0; n < 2; ++n)
#pragma unroll
                    for (int c = 0; c < 4; ++c) { const float g = acc[ai][0][m][n][c], uu = acc[ai][1][m][n][c];
                        hv[n * 4 + c] = g * __builtin_amdgcn_rcpf(1.f + __builtin_amdgcn_exp2f(-1.4426950408889634f * g)) * uu; }
                u32x4 w; w.x = cvt_pk_bf16(hv[0], hv[1]); w.y = cvt_pk_bf16(hv[2], hv[3]); w.z = cvt_pk_bf16(hv[4], hv[5]); w.w = cvt_pk_bf16(hv[6], hv[7]);
                *(u32x4*)rowp = w; }
    }
};
struct EpiDown {
    static constexpr bool PERM = true, AFTER_DRAIN = false;
    bf16_t* Y;
    __device__ __forceinline__ void operator()(const f32x4 (&acc)[2][2][4][2], const Unit& u, int wr, int wc, int fr, int fq) const {
        const int col0 = (u.pn & 7) * BM + wc * 32 + 8 * fq;
#pragma unroll
        for (int ai = 0; ai < 2; ++ai)
#pragma unroll
            for (int m = 0; m < 4; ++m) { const int row = u.pm * BM + ai * HALF + wr * 64 + m * 16 + fr; bf16_t* rowp = Y + (size_t)row * 2048 + col0;
#pragma unroll
                for (int bj = 0; bj < 2; ++bj) { const f32x4 v0 = acc[ai][bj][m][0], v1 = acc[ai][bj][m][1];
                    u32x4 w; w.x = cvt_pk_bf16(v0[0], v0[1]); w.y = cvt_pk_bf16(v0[2], v0[3]); w.z = cvt_pk_bf16(v1[0], v1[1]); w.w = cvt_pk_bf16(v1[2], v1[3]);
                    *(u32x4*)(rowp + bj * HALF) = w; } }
    }
};
struct GroupedOrder {
    int total, G, c; const PG8_LAS int* tile_e;
    __device__ __forceinline__ bool next(int i, Unit& u) const {
        const int L = i * G + c; if (L >= total) return false;
        u.pm = L >> 3; u.pn = __builtin_amdgcn_readfirstlane(tile_e[L >> 3]) * 8 + (L & 7); return true;
    }
    __device__ __forceinline__ void a_ready(const Unit&) const {}
    __device__ __forceinline__ void done(const Unit&) const {}
};

template <class Epi, class Sched, bool ALIGN_EPI = false, bool SP2 = false>
__device__ __forceinline__ void gemm_phase(PG8_LAS unsigned char* lds, const Gemm g, const Sched& S, const Epi& E) {
    const int tid = threadIdx.x, wid = __builtin_amdgcn_readfirstlane(tid >> 6), lane = tid & 63, wr = wid >> 2, wc = wid & 3, fr = lane & 15, fq = lane >> 4;
    const int K = g.K, nt = K / BK;
    unsigned voffA[2], voffB[2];
#pragma unroll
    for (int i = 0; i < 2; ++i) { int R, C; stage_rc(tid * 16 + i * 8192, R, C); const int Rb = Epi::PERM ? ((R & ~31) + perm32(R & 31)) : R;
        voffA[i] = (unsigned)(R * K + C) * 2u; voffB[i] = (unsigned)(Rb * K + C) * 2u; }
    const size_t kstep = (size_t)(BK * 2);
    const size_t hstep = (size_t)HALF * K * 2;
    const size_t tstep = 2 * hstep;
    const unsigned ldsw = (unsigned)wid * 1024u;
    const int aoff = lds_byte(wr * 64 + fr, fq * 8), boff = lds_byte(wc * 32 + fr, fq * 8);
#define PG8_SA(b, h) (((b) * 2 + (h)) * HTB)
#define PG8_SB(b, h) ((4 + (b) * 2 + (h)) * HTB)
#define PG8_STAGE(bufoff, gbase, voff) do { _Pragma("unroll") for (int _i = 0; _i < 2; ++_i) \
        __builtin_amdgcn_global_load_lds((const unsigned*)((const char*)(gbase) + (voff)[_i]), (PG8_LAS unsigned*)(lds + (bufoff) + ldsw + _i * 8192), 16, 0, 0); } while (0)
#define PG8_LDA(dst, b, h) do { _Pragma("unroll") for (int m = 0; m < 4; ++m) _Pragma("unroll") for (int k = 0; k < 2; ++k) dst[m][k] = *(const PG8_LAS bf16x8*)(lds + PG8_SA(b, h) + aoff + m * 2048 + k * 1024); } while (0)
#define PG8_LDB(dst, b, h) do { _Pragma("unroll") for (int n = 0; n < 2; ++n) _Pragma("unroll") for (int k = 0; k < 2; ++k) dst[n][k] = *(const PG8_LAS bf16x8*)(lds + PG8_SB(b, h) + boff + n * 2048 + k * 1024); } while (0)
#define PG8_MMA(ai, bj, At, Bt) do { __builtin_amdgcn_s_setprio(1); _Pragma("unroll") for (int m = 0; m < 4; ++m) _Pragma("unroll") for (int n = 0; n < 2; ++n) _Pragma("unroll") for (int k = 0; k < 2; ++k) \
        acc[ai][bj][m][n] = __builtin_amdgcn_mfma_f32_16x16x32_bf16(Bt[n][k], At[m][k], acc[ai][bj][m][n], 0, 0, 0); __builtin_amdgcn_s_setprio(0); } while (0)
#define PG8_WAIT_V(n) asm volatile("s_waitcnt vmcnt(" #n ")" ::: "memory")
#define PG8_WAIT_L(n) asm volatile("s_waitcnt lgkmcnt(" #n ")" ::: "memory")
#define PG8_BAR __builtin_amdgcn_s_barrier()
#define PG8_SCHED __builtin_amdgcn_sched_barrier(0)
    Unit cur, nxt; int ui = 0;
    if (!S.next(0, cur)) return;
    f32x4 acc[2][2][4][2];
#pragma unroll
    for (int a = 0; a < 2; ++a)
#pragma unroll
        for (int b = 0; b < 2; ++b)
#pragma unroll
            for (int m = 0; m < 4; ++m)
#pragma unroll
                for (int n = 0; n < 2; ++n) acc[a][b][m][n] = (f32x4){0.f, 0.f, 0.f, 0.f};
    bf16x8 At[4][2], B0[2][2], B1[2][2];
    const char* cA = (const char*)g.A + (size_t)cur.pm * tstep; const char* cB = (const char*)g.Bt + (size_t)cur.pn * tstep;
    S.a_ready(cur);
    if constexpr (SP2) {
        PG8_STAGE(PG8_SB(0, 0), cB, voffB); PG8_STAGE(PG8_SB(0, 1), cB + hstep, voffB); PG8_STAGE(PG8_SA(0, 0), cA, voffA); PG8_STAGE(PG8_SA(0, 1), cA + hstep, voffA);
        if (wr == 1) PG8_BAR;
        PG8_WAIT_V(2); PG8_BAR;
        PG8_STAGE(PG8_SB(1, 0), cB + kstep, voffB); PG8_STAGE(PG8_SA(1, 0), cA + kstep, voffA); PG8_STAGE(PG8_SB(1, 1), cB + hstep + kstep, voffB);
        PG8_WAIT_V(6); PG8_BAR;
    } else {
        PG8_STAGE(PG8_SB(0, 0), cB, voffB); PG8_STAGE(PG8_SA(0, 0), cA, voffA); PG8_STAGE(PG8_SB(0, 1), cB + hstep, voffB); PG8_STAGE(PG8_SA(0, 1), cA + hstep, voffA);
        if (wr == 1) PG8_BAR;
        PG8_WAIT_V(4); PG8_BAR;
        PG8_STAGE(PG8_SB(1, 0), cB + kstep, voffB); PG8_STAGE(PG8_SA(1, 0), cA + kstep, voffA); PG8_STAGE(PG8_SB(1, 1), cB + hstep + kstep, voffB);
        PG8_WAIT_V(6); PG8_BAR;
    }
    for (;;) {
        const bool has_next = S.next(ui + 1, nxt);
        const char* nA = has_next ? (const char*)g.A + (size_t)nxt.pm * tstep : cA; const char* nB = has_next ? (const char*)g.Bt + (size_t)nxt.pn * tstep : cB;
        for (int t = 0; t < nt; t += 2) {
            const bool last = (t == nt - 2);
            const char* a1 = cA + (size_t)(t + 1) * kstep;
            const char* a2 = last ? nA : cA + (size_t)(t + 2) * kstep; const char* b2 = last ? nB : cB + (size_t)(t + 2) * kstep;
            const char* a3 = a2 + kstep; const char* b3 = b2 + kstep;
            if (last && has_next) S.a_ready(nxt);
            if constexpr (SP2) {
            PG8_LDB(B0, 0, 0); PG8_LDB(B1, 0, 1); PG8_SCHED; PG8_LDA(At, 0, 0); PG8_STAGE(PG8_SA(1, 1), a1 + hstep, voffA);
            PG8_WAIT_V(8); PG8_WAIT_L(0); PG8_BAR; PG8_MMA(0, 0, At, B0); PG8_MMA(0, 1, At, B1); PG8_BAR; PG8_SCHED;
            PG8_LDA(At, 0, 1); PG8_STAGE(PG8_SB(0, 0), b2, voffB); PG8_STAGE(PG8_SB(0, 1), b2 + hstep, voffB); PG8_STAGE(PG8_SA(0, 0), a2, voffA);
            PG8_WAIT_V(8); PG8_WAIT_L(0); PG8_BAR; PG8_MMA(1, 0, At, B0); PG8_MMA(1, 1, At, B1); PG8_BAR; PG8_SCHED;
            PG8_LDB(B0, 1, 0); PG8_LDB(B1, 1, 1); PG8_SCHED; PG8_LDA(At, 1, 0); PG8_STAGE(PG8_SA(0, 1), a2 + hstep, voffA);
            PG8_WAIT_V(8); PG8_WAIT_L(0); PG8_BAR; PG8_MMA(0, 0, At, B0); PG8_MMA(0, 1, At, B1); PG8_BAR; PG8_SCHED;
            PG8_LDA(At, 1, 1); PG8_STAGE(PG8_SB(1, 0), b3, voffB); PG8_STAGE(PG8_SB(1, 1), b3 + hstep, voffB); PG8_STAGE(PG8_SA(1, 0), a3, voffA);
            PG8_WAIT_V(8); PG8_WAIT_L(0); PG8_BAR; PG8_MMA(1, 0, At, B0); PG8_MMA(1, 1, At, B1); PG8_BAR; PG8_SCHED;
            } else {
            PG8_LDB(B0, 0, 0); PG8_SCHED; PG8_LDA(At, 0, 0); PG8_STAGE(PG8_SA(1, 1), a1 + hstep, voffA);
            PG8_WAIT_L(8); PG8_BAR; PG8_WAIT_L(0); PG8_MMA(0, 0, At, B0); PG8_BAR; PG8_SCHED;
            PG8_LDB(B1, 0, 1); PG8_STAGE(PG8_SB(0, 0), b2, voffB);
            PG8_BAR; PG8_WAIT_L(0); PG8_MMA(0, 1, At, B1); PG8_BAR;
            PG8_LDA(At, 0, 1); PG8_STAGE(PG8_SA(0, 0), a2, voffA);
            PG8_BAR; PG8_WAIT_L(0); PG8_MMA(1, 0, At, B0); PG8_BAR; PG8_SCHED;
            PG8_STAGE(PG8_SB(0, 1), b2 + hstep, voffB);
            PG8_WAIT_V(6); PG8_BAR; PG8_MMA(1, 1, At, B1); PG8_BAR;
            PG8_LDB(B0, 1, 0); PG8_SCHED; PG8_LDA(At, 1, 0); PG8_STAGE(PG8_SA(0, 1), a2 + hstep, voffA);
            PG8_WAIT_L(8); PG8_BAR; PG8_WAIT_L(0); PG8_MMA(0, 0, At, B0); PG8_BAR; PG8_SCHED;
            PG8_LDB(B1, 1, 1); PG8_STAGE(PG8_SB(1, 0), b3, voffB);
            PG8_BAR; PG8_WAIT_L(0); PG8_MMA(0, 1, At, B1); PG8_BAR;
            PG8_LDA(At, 1, 1); PG8_STAGE(PG8_SA(1, 0), a3, voffA);
            PG8_BAR; PG8_WAIT_L(0); PG8_MMA(1, 0, At, B0); PG8_BAR; PG8_SCHED;
            PG8_STAGE(PG8_SB(1, 1), b3 + hstep, voffB);
            PG8_WAIT_V(6); PG8_BAR; PG8_MMA(1, 1, At, B1); PG8_BAR;
            }
        }
        if constexpr (ALIGN_EPI) { if (wr == 0) PG8_BAR; }
        if constexpr (!Epi::AFTER_DRAIN) { E(acc, cur, wr, wc, fr, fq); S.done(cur); }
        if (!has_next) break;
#pragma unroll
        for (int a = 0; a < 2; ++a)
#pragma unroll
            for (int b = 0; b < 2; ++b)
#pragma unroll
                for (int m = 0; m < 4; ++m)
#pragma unroll
                    for (int n = 0; n < 2; ++n) acc[a][b][m][n] = (f32x4){0.f, 0.f, 0.f, 0.f};
        cur = nxt; cA = nA; cB = nB; ++ui;
        if constexpr (ALIGN_EPI) { if (wr == 1) PG8_BAR; }
    }
    PG8_WAIT_V(0);
    if constexpr (!ALIGN_EPI) { if (wr == 0) PG8_BAR; }
    PG8_BAR;
    if constexpr (Epi::AFTER_DRAIN) { E.fused(acc, cur, wr, wc, fr, fq, lds, wid, lane); S.done(cur); }
#undef PG8_SA
#undef PG8_SB
#undef PG8_STAGE
#undef PG8_LDA
#undef PG8_LDB
#undef PG8_MMA
#undef PG8_WAIT_V
#undef PG8_WAIT_L
#undef PG8_BAR
#undef PG8_SCHED
}

struct UnitW { int pm, cn; const float* w0; const float* w1; };
struct GemmW { const bf16_t* A; int K, ldw; const int* rowtok; int tokmask; const PG8_LAS int* rowbase; };
__device__ __forceinline__ void wload1(f32x4& r0, unsigned voff, const char* sbase) { asm volatile("global_load_dwordx4 %0, %1, %2" : "=&v"(r0) : "v"(voff), "s"(sbase) : "memory"); }
template <class Epi, class Sched, bool ALIGN_EPI, bool GATHER>
__device__ __forceinline__ void gemm_phase_wf32(PG8_LAS unsigned char* lds, const GemmW g, const Sched& S, const Epi& E) {
    static_assert(Epi::PERM && !Epi::AFTER_DRAIN, "gemm_phase_wf32: PERM epilogues that run inside the unit loop only");
    const int tid = threadIdx.x, wid = __builtin_amdgcn_readfirstlane(tid >> 6), lane = tid & 63, wr = wid >> 2, wc = wid & 3, fr = lane & 15, fq = lane >> 4;
    const int K = g.K, nt = K / BK;
    const size_t kstep = (size_t)(BK * 2), hstep = (size_t)HALF * K * 2, tstep = 2 * hstep;
    const unsigned ldsw = (unsigned)wid * 1024u;
    const int aoff = lds_byte(wr * 64 + fr, fq * 8), boff = lds_byte(wc * 32 + fr, fq * 8);
    const int cq = lane & 7, sj = lane >> 3;
    #if defined(PROBE_HOT) && (PROBE_HOT == 2 || PROBE_HOT == 4)
    const size_t wrow = (size_t)g.ldw * 4u, wkt = S.hot ? 0 : wrow * BK;
#else
    const size_t wrow = (size_t)g.ldw * 4u, wkt = wrow * BK;
#endif
#if defined(PROBE_HOT) && PROBE_HOT == 5
    const int cqg = S.hot ? (lane & 7) : cq, sjg = S.hot ? (lane >> 3) : sj;
    const size_t wsrc = (size_t)(8 * sjg) * wrow + (size_t)(32 * (wid & 3) + 4 * cqg) * 4u;
#else
    const size_t wsrc = (size_t)(8 * sj) * wrow + (size_t)(32 * (wid & 3) + 4 * cq) * 4u;
#endif
    const int wrho = 16 * (cq & 1) + 4 * (cq >> 1);
    const int wdst = (4 + (wid >> 2)) * HTB + lds_byte(32 * (wid & 3) + wrho, 8 * sj);
#define PG8_SA(b, h) (((b) * 2 + (h)) * HTB)
#define PG8_SB(b, h) ((4 + (b) * 2 + (h)) * HTB)
#define PG8_STAGE(bufoff, gbase, voff) do { _Pragma("unroll") for (int _i = 0; _i < 2; ++_i) \
        __builtin_amdgcn_global_load_lds((const unsigned*)((const char*)(gbase) + (voff)[_i]), (PG8_LAS unsigned*)(lds + (bufoff) + ldsw + _i * 8192), 16, 0, 0); } while (0)
#define PG8_STAGEA(bufoff, h, kb, nx) do { const char* b_ = ((nx) ? nAb : cAb) + (kb); unsigned v_[2]; v_[0] = (nx) ? voN[h][0] : voC[h][0]; v_[1] = (nx) ? voN[h][1] : voC[h][1]; PG8_STAGE(bufoff, b_, v_); } while (0)
#define PG8_LDA(dst, b, h) do { _Pragma("unroll") for (int m = 0; m < 4; ++m) _Pragma("unroll") for (int k = 0; k < 2; ++k) dst[m][k] = *(const PG8_LAS bf16x8*)(lds + PG8_SA(b, h) + aoff + m * 2048 + k * 1024); } while (0)
#define PG8_LDB(dst, b, h) do { _Pragma("unroll") for (int n = 0; n < 2; ++n) _Pragma("unroll") for (int k = 0; k < 2; ++k) dst[n][k] = *(const PG8_LAS bf16x8*)(lds + PG8_SB(b, h) + boff + n * 2048 + k * 1024); } while (0)
#define PG8_MMA(ai, bj, At, Bt) do { __builtin_amdgcn_s_setprio(1); _Pragma("unroll") for (int m = 0; m < 4; ++m) _Pragma("unroll") for (int n = 0; n < 2; ++n) _Pragma("unroll") for (int k = 0; k < 2; ++k) \
        acc[ai][bj][m][n] = __builtin_amdgcn_mfma_f32_16x16x32_bf16(Bt[n][k], At[m][k], acc[ai][bj][m][n], 0, 0, 0); __builtin_amdgcn_s_setprio(0); } while (0)
#define PG8_WAIT_V(n) asm volatile("s_waitcnt vmcnt(" #n ")" ::: "memory")
#define PG8_WAIT_L(n) asm volatile("s_waitcnt lgkmcnt(" #n ")" ::: "memory")
#define PG8_BAR __builtin_amdgcn_s_barrier()
#define PG8_SCHED __builtin_amdgcn_sched_barrier(0)
#define PG8_WLOAD(kk) do { const int kk_ = (kk); const bool in_ = kk_ < nt; const char* q_ = (in_ ? cW : nW) + (size_t)(in_ ? kk_ : kk_ - nt) * wkt; \
        _Pragma("unroll") for (int r_ = 0; r_ < 8; ++r_) wload1(RB[r_], (unsigned)wsrc, q_ + (size_t)r_ * wrow); } while (0)
#define PG8_WWAIT(n) asm volatile("s_waitcnt vmcnt(" #n ")" : "+v"(RB[0]), "+v"(RB[1]), "+v"(RB[2]), "+v"(RB[3]), "+v"(RB[4]), "+v"(RB[5]), "+v"(RB[6]), "+v"(RB[7]) :: "memory")
#define PG8_WWRITE(b) do { _Pragma("unroll") for (int i_ = 0; i_ < 4; ++i_) { u32x4 w_; \
        w_.x = cvt_pk_bf16(RB[0][i_], RB[1][i_]); w_.y = cvt_pk_bf16(RB[2][i_], RB[3][i_]); w_.z = cvt_pk_bf16(RB[4][i_], RB[5][i_]); w_.w = cvt_pk_bf16(RB[6][i_], RB[7][i_]); \
        *(PG8_LAS u32x4*)(lds + (b) * 2 * HTB + wdst + i_ * 64) = w_; } } while (0)
#ifdef PROBE_ABL
    const int abl = S.hot ? PROBE_ABL : 0;
#define PG8_ABL(bit, stmt) do { if (!(abl & (bit))) { stmt; } } while (0)
#else
#define PG8_ABL(bit, stmt) do { stmt; } while (0)
#endif
    UnitW cur, nxt; int ui = 0;
    if (!S.next(0, cur)) return;
    f32x4 acc[2][2][4][2];
#pragma unroll
    for (int a = 0; a < 2; ++a)
#pragma unroll
        for (int b = 0; b < 2; ++b)
#pragma unroll
            for (int m = 0; m < 4; ++m)
#pragma unroll
                for (int n = 0; n < 2; ++n) acc[a][b][m][n] = (f32x4){0.f, 0.f, 0.f, 0.f};
    bf16x8 At[4][2], B0[2][2], B1[2][2]; f32x4 RB[8];
    const bool whalf = wid >= 4;
    const char* cAb; const char* nAb; unsigned voC[2][2], voN[2][2];
#define PG8_UNIT_A(base, vo, pm_) do { int t_ = tid; asm volatile("" : "+v"(t_)); int R_[2], C_[2]; stage_rc(t_ * 16, R_[0], C_[0]); stage_rc(t_ * 16 + 8192, R_[1], C_[1]); \
        if constexpr (GATHER) { base = (const char*)g.A; const int rb_ = __builtin_amdgcn_readfirstlane(g.rowbase[pm_]), nr_ = __builtin_amdgcn_readfirstlane(g.rowbase[(pm_) + 256]);     \
            _Pragma("unroll") for (int h_ = 0; h_ < 2; ++h_) _Pragma("unroll") for (int i_ = 0; i_ < 2; ++i_) { const int rt_ = h_ * HALF + R_[i_]; const int tk_ = g.rowtok[rb_ + (pm_) * BM + (rt_ < nr_ ? rt_ : 0)] & g.tokmask; \
            vo[h_][i_] = (unsigned)(rt_ < nr_ ? tk_ : g.tokmask + 1) * (unsigned)(K * 2) + (unsigned)C_[i_] * 2u; } } \
        else { base = (const char*)g.A + (size_t)(pm_) * tstep; _Pragma("unroll") for (int h_ = 0; h_ < 2; ++h_) _Pragma("unroll") for (int i_ = 0; i_ < 2; ++i_) vo[h_][i_] = (unsigned)(h_ * HALF + R_[i_]) * (unsigned)(K * 2) + (unsigned)C_[i_] * 2u; } } while (0)
    PG8_UNIT_A(cAb, voC, cur.pm); nAb = cAb;
#pragma unroll
    for (int h_ = 0; h_ < 2; ++h_) { voN[h_][0] = voC[h_][0]; voN[h_][1] = voC[h_][1]; }
    const char* cW = (const char*)(whalf ? cur.w1 : cur.w0);
    const char* nW = cW;
    PG8_WLOAD(0); PG8_STAGEA(PG8_SA(0, 0), 0, 0, false); PG8_STAGEA(PG8_SA(0, 1), 1, 0, false);
    PG8_WWAIT(4); PG8_WWRITE(0);
    PG8_WLOAD(1);
    PG8_WWAIT(0); PG8_WWRITE(1);
    PG8_STAGEA(PG8_SA(1, 0), 0, kstep, false);
    PG8_WLOAD(2);
    PG8_WAIT_L(0);
    if (wr == 1) PG8_BAR;
    PG8_BAR; PG8_BAR;
    for (;;) {
        const bool has_next = S.next(ui + 1, nxt);
        if (has_next) PG8_UNIT_A(nAb, voN, nxt.pm);
        nW = has_next ? (const char*)(whalf ? nxt.w1 : nxt.w0) : cW;
        for (int t = 0; t < nt; t += 2) {
            const bool last = (t == nt - 2);
            const size_t k1 = (size_t)(t + 1) * kstep, k2 = last ? 0 : (size_t)(t + 2) * kstep, k3 = k2 + kstep;
            PG8_LDB(B0, 0, 0); PG8_LDB(B1, 0, 1); PG8_SCHED; PG8_LDA(At, 0, 0); PG8_STAGEA(PG8_SA(1, 1), 1, k1, false);
            PG8_WAIT_V(12); PG8_WAIT_L(0); PG8_BAR; PG8_MMA(0, 0, At, B0); PG8_MMA(0, 1, At, B1); PG8_BAR; PG8_SCHED;
            PG8_WWAIT(2); PG8_ABL(1, PG8_WWRITE(0)); PG8_LDA(At, 0, 1); PG8_STAGEA(PG8_SA(0, 0), 0, k2, last); PG8_ABL(2, PG8_WLOAD(t + 3));
            PG8_WAIT_L(0); PG8_BAR; PG8_MMA(1, 0, At, B0); PG8_MMA(1, 1, At, B1); PG8_BAR; PG8_SCHED;
            PG8_LDB(B0, 1, 0); PG8_LDB(B1, 1, 1); PG8_SCHED; PG8_LDA(At, 1, 0); PG8_STAGEA(PG8_SA(0, 1), 1, k2, last);
            PG8_WAIT_V(12); PG8_WAIT_L(0); PG8_BAR; PG8_MMA(0, 0, At, B0); PG8_MMA(0, 1, At, B1); PG8_BAR; PG8_SCHED;
            PG8_WWAIT(2); PG8_ABL(1, PG8_WWRITE(1)); PG8_LDA(At, 1, 1); PG8_STAGEA(PG8_SA(1, 0), 0, k3, last); PG8_ABL(2, PG8_WLOAD(t + 4));
            PG8_WAIT_L(0); PG8_BAR; PG8_MMA(1, 0, At, B0); PG8_MMA(1, 1, At, B1); PG8_BAR; PG8_SCHED;
        }
        if (!has_next) PG8_WWAIT(0);
        if constexpr (ALIGN_EPI) { if (wr == 0) PG8_BAR; }
        { Unit eu; eu.pm = cur.pm; eu.pn = cur.cn; E(acc, eu, wr, wc, fr, fq); }
        if (!has_next) break;
#pragma unroll
        for (int a = 0; a < 2; ++a)
#pragma unroll
            for (int b = 0; b < 2; ++b)
#pragma unroll
                for (int m = 0; m < 4; ++m)
#pragma unroll
                    for (int n = 0; n < 2; ++n) acc[a][b][m][n] = (f32x4){0.f, 0.f, 0.f, 0.f};
        cur = nxt; cAb = nAb; cW = nW; ++ui;
#pragma unroll
        for (int h_ = 0; h_ < 2; ++h_) { voC[h_][0] = voN[h_][0]; voC[h_][1] = voN[h_][1]; }
        if constexpr (ALIGN_EPI) { if (wr == 1) PG8_BAR; }
    }
    PG8_WAIT_V(0);
    if constexpr (!ALIGN_EPI) { if (wr == 0) PG8_BAR; }
    PG8_BAR;
#undef PG8_SA
#undef PG8_SB
#undef PG8_STAGE
#undef PG8_LDA
#undef PG8_STAGEA
#undef PG8_UNIT_A
#undef PG8_LDB
#undef PG8_MMA
#undef PG8_WAIT_V
#undef PG8_WAIT_L
#undef PG8_BAR
#undef PG8_SCHED
#undef PG8_WLOAD
#undef PG8_ABL
#undef PG8_WWAIT
#undef PG8_WWRITE
}
template <int MODE> struct GroupedOrderW {
    int total, G, c; const PG8_LAS int* tile_e; const float* wa; const float* wb; int hot;
    __device__ __forceinline__ bool next(int i, UnitW& u) const {
        int L = i * G + c;
        if (G == 256) {
            const int x = c & 7, j = c >> 3;
            L = (32 * i + 8 * (x >> 1) + (j & 7)) * 8 + 4 * (x & 1) + (j >> 3);
        }
        if (L >= total) return false;
        int e = __builtin_amdgcn_readfirstlane(tile_e[L >> 3]), nt = L & 7;
        u.pm = L >> 3; u.cn = nt;
#if defined(PROBE_HOT) && PROBE_HOT == 1
        if (hot) { e = 0; nt = 0; }
#endif
        if (MODE == 0) { u.w0 = wa + (size_t)e * 2048 * 1024 + 128 * nt; u.w1 = wb + (size_t)e * 2048 * 1024 + 128 * nt; }
        else { u.w0 = wa + (size_t)e * 1024 * 2048 + 256 * nt; u.w1 = u.w0 + 128; }
        return true;
    }
};
}

namespace att {
using TIN = __hip_bfloat16; using TOUT = __hip_bfloat16;
constexpr int B = 2, H = 1, HKV = 1, SQ = 8192, SKV = 8192, D = 128, QOFF = 0, WINDOW = SKV;
constexpr float THR = 8.f;
constexpr bool WSKIP = false;
constexpr int LDQ = 6144, LDO = 2048;
constexpr int W_INF = 1 << 30;
#ifdef PROF_SECT
#define PROF_T0(sect) unsigned long long pt0_##sect = 0; if (PROF_SECT == (sect) && blockIdx.x == 0) pt0_##sect = __builtin_amdgcn_s_memtime()
#define PROF_T1(sect) do { if (PROF_SECT == (sect) && blockIdx.x == 0) { const unsigned long long d_ = __builtin_amdgcn_s_memtime() - pt0_##sect; if (threadIdx.x == 0) { PROFW[0] += (unsigned)d_; } } } while (0)
#else
#define PROF_T0(sect) do {} while (0)
#define PROF_T1(sect) do {} while (0)
#endif
constexpr float SCALE = 0.08838834764831845f;
constexpr int NW = 8, QBLK = 32, KVBLK = 64, QB = NW * QBLK;
constexpr int SHM_V = KVBLK * D * 2, SHM_K = KVBLK * D * 2;
constexpr int OFF_WS = 2 * SHM_V + 2 * SHM_K, OFF_CB = OFF_WS + NW * 64 * 4, LDS_BYTES = OFF_CB + 2 * 64 * 4;
static_assert(D == 128 && SQ % QB == 0 && SKV % KVBLK == 0 && H % HKV == 0 && QOFF >= 0 && QOFF + SQ <= SKV && WINDOW >= 1, "geometry");

using bf16 = __hip_bfloat16;
typedef short bf16x8 __attribute__((ext_vector_type(8)));
typedef short s16x4 __attribute__((ext_vector_type(4)));
typedef float f32x16 __attribute__((ext_vector_type(16)));
typedef float f32x4 __attribute__((ext_vector_type(4)));
typedef unsigned u32x4 __attribute__((ext_vector_type(4)));
template <class A, class Bt> struct same_t { static constexpr bool v = false; };
template <class A> struct same_t<A, A> { static constexpr bool v = true; };

#define KSWZ(row, colB) ((row) * 256 + ((colB) ^ (((row) & 7) << 4)))
#define SBAR() __builtin_amdgcn_sched_barrier(0)
__device__ __forceinline__ int v_st(int k, int c) { const int kk = (k & ~0xC) | ((k & 4) << 1) | ((k & 8) >> 1); return ((kk >> 3) * 4 + (c >> 5)) * 512 + ((kk & 7) * 32 + (c & 31)) * 2; }
__device__ __forceinline__ int v_rd_base(int lane) { return ((lane & 3) << 3) | (((lane >> 2) & 3) << 6) | (((lane >> 4) & 1) << 5) | (((lane >> 5) & 1) << 8); }
constexpr int v_rd_off(int d0, int ks, int half) { return d0 * 512 + ks * 4096 + half * 2048; }
__device__ __forceinline__ int crow(int r, int hi) { return (r & 3) + 8 * (r >> 2) + 4 * hi; }
__device__ __forceinline__ unsigned cvtpk(float lo, float hi) {
    unsigned r; asm volatile("v_cvt_pk_bf16_f32 %0, %1, %2" : "=v"(r) : "v"(lo), "v"(hi)); return r;
}
__device__ __forceinline__ bf16x8 pack8(f32x4 a, f32x4 b) {
    u32x4 w = {cvtpk(a[0], a[1]), cvtpk(a[2], a[3]), cvtpk(b[0], b[1]), cvtpk(b[2], b[3])};
    return *reinterpret_cast<bf16x8*>(&w);
}
template <class T> __device__ __forceinline__ bf16x8 load8(const T* p) {
    if constexpr (same_t<T, float>::v) { return pack8(*(const f32x4*)p, *(const f32x4*)(p + 4)); }
    else { return *reinterpret_cast<const bf16x8*>(p); }
}
__device__ __forceinline__ void mask_tile(f32x16& p0, f32x16& p1, int dq, unsigned W) {
    const float NEG = -__builtin_inff();
#pragma unroll
    for (int r = 0; r < 16; ++r) {
        const int c = (r & 3) + 8 * (r >> 2);
        if ((unsigned)(dq - c) >= W) p0[r] = NEG;
        if ((unsigned)(dq - c - 32) >= W) p1[r] = NEG;
    }
}
__device__ __forceinline__ void partialSM(f32x16& p0, f32x16& p1, float& m_reg, float& mn, float& alpha) {
    constexpr float C2 = 1.4426950408889634f * SCALE;
    mn = m_reg; alpha = 1.f;
    const float mnL = -m_reg * C2;
    for (int r = 0; r < 16; ++r) p0[r] = fmaf(p0[r], C2, mnL); for (int r = 0; r < 16; ++r) p1[r] = fmaf(p1[r], C2, mnL);
    for (int r = 0; r < 16; ++r) p0[r] = __builtin_amdgcn_exp2f(p0[r]);
}
__device__ __forceinline__ void finishSM(f32x16& p0, f32x16& p1, float alpha, float& l_reg, bf16x8& pa0, bf16x8& pa1, bf16x8& pa2, bf16x8& pa3) {
    for (int r = 0; r < 16; ++r) p1[r] = __builtin_amdgcn_exp2f(p1[r]);
    float ps = 0; for (int r = 0; r < 16; ++r) ps += p0[r]; for (int r = 0; r < 16; ++r) ps += p1[r];
    { auto rr = __builtin_amdgcn_permlane32_swap(__float_as_uint(ps), __float_as_uint(ps), false, false);
      ps = __uint_as_float(rr[0]) + __uint_as_float(rr[1]); }
    l_reg += ps; (void)alpha;
#define PK4(P, B_, OUT) do { unsigned a0 = cvtpk(P[B_+0], P[B_+1]), a1 = cvtpk(P[B_+2], P[B_+3]);                          \
        unsigned b0 = cvtpk(P[B_+4], P[B_+5]), b1 = cvtpk(P[B_+6], P[B_+7]);                                             \
        auto r0 = __builtin_amdgcn_permlane32_swap(a0, b0, false, false); auto r1 = __builtin_amdgcn_permlane32_swap(a1, b1, false, false); \
        u32x4 w = {r0[0], r1[0], r0[1], r1[1]}; OUT = *reinterpret_cast<bf16x8*>(&w); } while (0)
    PK4(p0, 0, pa0); PK4(p0, 8, pa1); PK4(p1, 0, pa2); PK4(p1, 8, pa3);
#undef PK4
}
template <int KB, bool SK>
__device__ __forceinline__ void qkt(f32x16& p0, f32x16& p1, const char* K_lds, int r32, int hi, const bf16x8* qr, bool act, const float* cbt, float cqs) {
    if (SK && !act) { const float NEG = -__builtin_inff();
#pragma unroll
        for (int r = 0; r < 16; ++r) { p0[r] = NEG; p1[r] = NEG; } return; }
    { const f32x4* c4 = (const f32x4*)(cbt + KB * 64);
#pragma unroll
      for (int g = 0; g < 4; ++g) { const f32x4 a = c4[2 * g], b = c4[8 + 2 * g];
#pragma unroll
          for (int i = 0; i < 4; ++i) { p0[4 * g + i] = cqs - a[i]; p1[4 * g + i] = cqs - b[i]; } } }
    const char* kb[4];
#pragma unroll
    for (int dd = 0; dd < 4; ++dd) kb[dd] = K_lds + KB * SHM_K + KSWZ(r32, (dd * 16 + hi * 8) * 2);
#pragma unroll
    for (int d0 = 0; d0 < 8; ++d0) { const char* a = kb[d0 & 3] + (d0 >> 2) * 128;
        bf16x8 b0 = *reinterpret_cast<const bf16x8*>(a);
        bf16x8 b1 = *reinterpret_cast<const bf16x8*>(a + 32 * 256);
        p0 = __builtin_amdgcn_mfma_f32_32x32x16_bf16(b0, qr[d0], p0, 0, 0, 0);
        p1 = __builtin_amdgcn_mfma_f32_32x32x16_bf16(b1, qr[d0], p1, 0, 0, 0); }
}
template <int VB, bool SK>
__device__ __forceinline__ void pv_tile(f32x16* o, int vb0, bf16x8 pa0, bf16x8 pa1, bf16x8 pa2, bf16x8 pa3, bool act) {
    if (SK && !act) return;
#define TRRD(dst, off) asm volatile("ds_read_b64_tr_b16 %0, %1 offset:%2" : "=&v"(dst) : "v"(vb0), "i"(off) : "memory")
#define PV_D0(d0) do { s16x4 l0, l1, l2, l3, h0, h1, h2, h3; constexpr int b_ = VB * SHM_V + v_rd_off(d0, 0, 0);     \
        TRRD(l0, b_); TRRD(h0, b_ + 2048); TRRD(l1, b_ + 4096); TRRD(h1, b_ + 6144); TRRD(l2, b_ + 8192); TRRD(h2, b_ + 10240); TRRD(l3, b_ + 12288); TRRD(h3, b_ + 14336); \
        asm volatile("s_waitcnt lgkmcnt(0)" ::: "memory"); SBAR();                 \
        o[d0] = __builtin_amdgcn_mfma_f32_32x32x16_bf16(pa0, (bf16x8){l0[0], l0[1], l0[2], l0[3], h0[0], h0[1], h0[2], h0[3]}, o[d0], 0, 0, 0);   \
        o[d0] = __builtin_amdgcn_mfma_f32_32x32x16_bf16(pa1, (bf16x8){l1[0], l1[1], l1[2], l1[3], h1[0], h1[1], h1[2], h1[3]}, o[d0], 0, 0, 0);   \
        o[d0] = __builtin_amdgcn_mfma_f32_32x32x16_bf16(pa2, (bf16x8){l2[0], l2[1], l2[2], l2[3], h2[0], h2[1], h2[2], h2[3]}, o[d0], 0, 0, 0);   \
        o[d0] = __builtin_amdgcn_mfma_f32_32x32x16_bf16(pa3, (bf16x8){l3[0], l3[1], l3[2], l3[3], h3[0], h3[1], h3[2], h3[3]}, o[d0], 0, 0, 0); } while (0)
    PV_D0(0); PV_D0(1); PV_D0(2); PV_D0(3);
#undef PV_D0
#undef TRRD
}
template <class TIn, class TOut> struct BlockRef { const TIn* Q; const TIn* K; const TIn* V; TOut* O; const float* C; int P0, jlo; float mref; };
template <class TIn> struct Seam {
    bf16x8 qr[8];
    bf16x8 st_v0, st_v1, st_k0, st_k1; f32x4 sf0, sf1, sf2, sf3;
    float cq, st_c;
    f32x4 tq[16];
};
__device__ __forceinline__ int swa_jlo(int P0, int W) { const int lowk = P0 - W + 1; return lowk > 0 ? lowk / KVBLK : 0; }
#define ROW(p, k0, rr) ((p) + (size_t)((k0) + (rr)) * LDQ + sc)
#define VMW() asm volatile("s_waitcnt vmcnt(0)" ::: "memory")
#define VMWN(n) asm volatile("s_waitcnt vmcnt(%0)" :: "i"(n) : "memory")
#define SLOAD_H(Kp, Vp, Cp, k0) do { S.st_v0 = load8<TIn>(ROW(Vp, k0, sr)); S.st_v1 = load8<TIn>(ROW(Vp, k0, 32 + sr));              \
                         S.st_k0 = load8<TIn>(ROW(Kp, k0, sr)); S.st_k1 = load8<TIn>(ROW(Kp, k0, 32 + sr)); S.st_c = (Cp)[(k0) + (tid & 63)]; } while (0)
#define SWRITE_HK(bf) do { *(bf16x8*)(K_lds + (bf) * SHM_K + kws) = S.st_k0; *(bf16x8*)(K_lds + (bf) * SHM_K + kws + 32 * 256) = S.st_k1; \
                           if (tid < 64) cbw[(bf) * 64 + tid] = S.st_c; } while (0)
#define SWRITE_HV(bf) do { *(bf16x8*)(V_lds + (bf) * SHM_V + vst0) = S.st_v0; *(bf16x8*)(V_lds + (bf) * SHM_V + vst1) = S.st_v1; } while (0)
#define SWRITE_H(bf) do { SWRITE_HV(bf); SWRITE_HK(bf); } while (0)
#define SLOAD_F(p, k0) do { S.sf0 = *(const f32x4*)ROW(p, k0, sr); S.sf1 = *(const f32x4*)(ROW(p, k0, sr) + 4);                \
                            S.sf2 = *(const f32x4*)ROW(p, k0, 32 + sr); S.sf3 = *(const f32x4*)(ROW(p, k0, 32 + sr) + 4); } while (0)
#define SWRITE_KF(bf) do { *(bf16x8*)(K_lds + (bf) * SHM_K + kws) = pack8(S.sf0, S.sf1); *(bf16x8*)(K_lds + (bf) * SHM_K + kws + 32 * 256) = pack8(S.sf2, S.sf3); } while (0)
#define SWRITE_VF(bf) do { *(bf16x8*)(V_lds + (bf) * SHM_V + vst0) = pack8(S.sf0, S.sf1); *(bf16x8*)(V_lds + (bf) * SHM_V + vst1) = pack8(S.sf2, S.sf3); } while (0)
template <class TIn, class TOut>
__device__ __forceinline__ void causal_swa_prime(const BlockRef<TIn, TOut>& cur, int W, char* lds, Seam<TIn>& S) {
    constexpr bool F32 = same_t<TIn, float>::v;
    const int tid = threadIdx.x, wid = __builtin_amdgcn_readfirstlane(tid >> 6), lane = tid & 63, r32 = lane & 31, hi = lane >> 5;
    const int sr = tid >> 4, sc = (tid & 15) * 8, kws = KSWZ(sr, sc * 2); char* K_lds = lds + 2 * SHM_V; float* cbw = (float*)(lds + OFF_CB);
    const int kb0 = cur.jlo * KVBLK;
    for (int d0 = 0; d0 < 8; ++d0) S.qr[d0] = load8<TIn>(cur.Q + (size_t)(wid * QBLK + r32) * LDQ + d0 * 16 + hi * 8);
    S.cq = cur.C[cur.P0 + wid * QBLK + r32];
    if constexpr (F32) { SLOAD_F((const float*)cur.K, kb0); VMW(); SWRITE_KF(0); SBAR(); SLOAD_F((const float*)cur.V, kb0); }
    else { SLOAD_H(cur.K, cur.V, cur.C, kb0); VMW(); SWRITE_HK(0); }
    __syncthreads();
}
template <class TIn, class TOut>
__device__ __forceinline__ void causal_swa_block(const BlockRef<TIn, TOut>& cur, const BlockRef<TIn, TOut>& nxt, int skv, int W, char* lds, Seam<TIn>& S, unsigned* qhead, volatile __attribute__((address_space(3))) int* qw, bool qmore) {
    constexpr bool F32 = same_t<TIn, float>::v;
    const int tid = threadIdx.x, wid = __builtin_amdgcn_readfirstlane(tid >> 6), lane = tid & 63, r32 = lane & 31, hi = lane >> 5;
    int pop_ = 1 << 30; if (threadIdx.x == 0 && qmore) pop_ = (int)atomicAdd(qhead, 1u);
    const int j_lo = cur.jlo;
    int j_hi = (cur.P0 + QB - 1) / KVBLK + 1; if (j_hi > skv / KVBLK) j_hi = skv / KVBLK;
    const int NT = j_hi - j_lo;
    const int kbn = nxt.jlo * KVBLK;
    const int qlo = cur.P0 + wid * QBLK, qm = qlo + r32 - 4 * hi;
    char* V_lds = lds; char* K_lds = lds + 2 * SHM_V; float* cbw = (float*)(lds + OFF_CB); const float* cbt = cbw + 4 * hi; const float* Ch = cur.C;
    float* ws = (float*)(lds + 2 * SHM_V + 2 * SHM_K) + wid * 64; float* li_l = ws, * al_l = ws + 32;
    float m_reg = cur.mref, l_reg = 0; f32x16 o[4] = {};
    const int sr = tid >> 4, sc = (tid & 15) * 8, vst0 = v_st(sr, sc), vst1 = v_st(32 + sr, sc), kws = KSWZ(sr, sc * 2);
    const int vb0 = (int)(uintptr_t)V_lds + v_rd_base(lane);
    const TIn* Kh = cur.K; const TIn* Vh = cur.V;
#define RESC(a) do { (void)(a); (void)al_l; } while (0)
#define KBASE(t) ((j_lo + (t)) * KVBLK)
#define ACT(t) (KBASE(t) <= qlo + QBLK - 1 && KBASE(t) + KVBLK - 1 >= qlo - W + 1)
#define MASKT(P0_, P1_, t) do { const int kb_ = KBASE(t); if ((!SK || ACT(t)) && (kb_ + KVBLK - 1 > qlo || kb_ <= qlo + QBLK - 1 - W)) mask_tile(P0_, P1_, qm - kb_, (unsigned)W); } while (0)
    constexpr int NQL = F32 ? 16 : 9;
    constexpr bool SK = WSKIP && !F32;
#define SEAM_K0() do { VMWN(NQL); if constexpr (F32) { SWRITE_KF(0); SBAR(); SLOAD_F((const float*)nxt.V, kbn); } else { SWRITE_HK(0); } SBAR(); } while (0)
    f32x16 pA0, pA1, pB0, pB1; float mnA, mnB, alA, alB; bf16x8 pa0, pa1, pa2, pa3;
    if constexpr (F32) { VMW(); SWRITE_VF(0); SBAR(); } else { SWRITE_HV(0); SBAR(); }
    if (NT > 1) { if constexpr (F32) SLOAD_F((const float*)Kh, KBASE(1)); else SLOAD_H(Kh, Vh, Ch, KBASE(1)); }
    SBAR(); qkt<0, SK>(pA0, pA1, K_lds, r32, hi, S.qr, ACT(0), cbt, S.cq);
    if constexpr (F32) { if (NT > 1) { VMW(); SWRITE_KF(1); SBAR(); SLOAD_F((const float*)Vh, KBASE(1)); } }
    MASKT(pA0, pA1, 0); partialSM(pA0, pA1, m_reg, mnA, alA);
    if (NT > 1) { VMW(); if constexpr (F32) { SWRITE_VF(1); SBAR(); if (NT > 2) SLOAD_F((const float*)Kh, KBASE(2)); } else SWRITE_H(1); }
    if (tid == 0) qw[0] = pop_;
    __syncthreads();
#define HALF_STEP(PX0, PX1, mnX, alX, PY0, PY1, alY, t, KB, VB, SB) do {                                                      \
        SBAR(); qkt<KB, SK>(PX0, PX1, K_lds, r32, hi, S.qr, ACT(t), cbt, S.cq);                                  \
        finishSM(PY0, PY1, alY, l_reg, pa0, pa1, pa2, pa3); SBAR();                                                           \
        if ((t) + 1 < NT) { if constexpr (F32) { VMW(); SWRITE_KF(SB); SBAR(); SLOAD_F((const float*)Vh, KBASE((t) + 1)); }  \
                            else { SLOAD_H(Kh, Vh, Ch, KBASE((t) + 1)); } SBAR(); }                                           \
        pv_tile<VB, SK>(o, vb0, pa0, pa1, pa2, pa3, ACT((t) - 1)); MASKT(PX0, PX1, (t)); partialSM(PX0, PX1, m_reg, mnX, alX);                                        \
        __syncthreads();                                                                                                      \
        if ((t) + 1 < NT) { VMW(); if constexpr (F32) { SWRITE_VF(SB); SBAR(); if ((t) + 2 < NT) SLOAD_F((const float*)Kh, KBASE((t) + 2)); } \
                            else { SWRITE_H(SB); } }                                                                          \
        RESC(alX); __syncthreads(); } while (0)
    for (int t = 1; t + 1 < NT; t += 2) {
        HALF_STEP(pB0, pB1, mnB, alB, pA0, pA1, alA, t, 1, 0, 0);
        HALF_STEP(pA0, pA1, mnA, alA, pB0, pB1, alB, t + 1, 0, 1, 1);
    }
    int r32s = r32, his = hi; asm volatile("" : "+v"(r32s), "+v"(his));
    const bool even = (NT & 1) == 0;
    if (even) { SBAR(); qkt<1, SK>(pB0, pB1, K_lds, r32, hi, S.qr, ACT(NT - 1), cbt, S.cq); SBAR(); }
#define QROW(e) (nxt.Q + (size_t)(wid * QBLK + r32) * LDQ + ((e) >> 1) * 16 + hi * 8 + ((e) & 1) * 4)
    if constexpr (F32) { SLOAD_F((const float*)nxt.K, kbn); SBAR();
#pragma unroll
        for (int e = 0; e < 8; ++e) S.tq[e] = *(const f32x4*)QROW(e); }
    else { SLOAD_H(nxt.K, nxt.V, nxt.C, kbn); SBAR();
#pragma unroll
        for (int d0 = 0; d0 < 8; ++d0) S.qr[d0] = load8<TIn>(nxt.Q + (size_t)(wid * QBLK + r32s) * LDQ + d0 * 16 + his * 8);
        S.cq = nxt.C[nxt.P0 + wid * QBLK + r32s]; }
    SBAR();
    finishSM(pA0, pA1, alA, l_reg, pa0, pa1, pa2, pa3); SBAR();
    if constexpr (F32) {
#pragma unroll
        for (int e = 8; e < 16; ++e) S.tq[e] = *(const f32x4*)QROW(e); SBAR(); }
#undef QROW
    pv_tile<0, SK>(o, vb0, pa0, pa1, pa2, pa3, ACT(even ? NT - 2 : NT - 1));
    if (even) { MASKT(pB0, pB1, NT - 1); partialSM(pB0, pB1, m_reg, mnB, alB); __syncthreads(); RESC(alB);
        finishSM(pB0, pB1, alB, l_reg, pa0, pa1, pa2, pa3); SBAR(); pv_tile<1, SK>(o, vb0, pa0, pa1, pa2, pa3, ACT(NT - 1)); }
    SBAR(); SEAM_K0();
    if (his == 0) li_l[r32s] = l_reg; asm volatile("s_waitcnt lgkmcnt(0)" ::: "memory");
    float rli[16];
#pragma unroll
    for (int r = 0; r < 16; ++r) rli[r] = __builtin_amdgcn_rcpf(li_l[crow(r, his)]);
    TOut* Ow = cur.O + (size_t)(wid * QBLK) * LDO;
#pragma unroll
    for (int r = 0; r < 16; ++r) { const int orow = crow(r, his);
#pragma unroll
        for (int d0 = 0; d0 < 4; ++d0) { const float v = o[d0][r] * rli[r];
            if constexpr (same_t<TOut, float>::v) { Ow[(size_t)orow * LDO + d0 * 32 + r32] = v; }
            else { const float vn = __shfl_xor(v, 1);
                   if ((r32s & 1) == 0) *(unsigned*)(Ow + (size_t)orow * LDO + d0 * 32 + r32s) = cvtpk(v, vn); } } }
    if constexpr (F32) {
#pragma unroll
        for (int d0 = 0; d0 < 8; ++d0) S.qr[d0] = pack8(S.tq[2 * d0], S.tq[2 * d0 + 1]); }
    __syncthreads();
#undef RESC
#undef KBASE
#undef ACT
#undef MASKT
#undef SEAM_K0
#undef HALF_STEP
}
#undef ROW
#undef VMW
#undef VMWN
#undef SLOAD_H
#undef SWRITE_HK
#undef SWRITE_HV
#undef SWRITE_H
#undef SLOAD_F
#undef SWRITE_KF
#undef SWRITE_VF


constexpr int QB2 = 128, NQB2 = SQ / QB2, SHM_V2 = 2 * SHM_V;
constexpr int P_OFF_K = 2 * SHM_V2, P_OFF_X = P_OFF_K + 2 * SHM_K, PAIR_RING = P_OFF_X + 2 * NW * 2048;
constexpr int P_OFF_L = PAIR_RING + 2048, P_OFF_CB = P_OFF_L + NW * 64 * 4, PAIR_LDS = P_OFF_CB + 2 * 64 * 4;
struct PRef { const bf16* Q; const bf16* K; const bf16* V; bf16* O; const float* C; int P0, jlo; float mref; };
template <int BUF, int NV>
__device__ __forceinline__ void pair_pv(f32x16* o, int vb0, bf16x8 pa0, bf16x8 pa1, bf16x8 pa2, bf16x8 pa3) {
#define TRRD(dst, off) asm volatile("ds_read_b64_tr_b16 %0, %1 offset:%2" : "=&v"(dst) : "v"(vb0), "i"(off) : "memory")
#define PV_D0(d0) do { s16x4 l0, l1, l2, l3, h0, h1, h2, h3; constexpr int b_ = BUF * SHM_V2 + v_rd_off(d0, 0, 0); \
        TRRD(l0, b_); TRRD(h0, b_ + 2048); TRRD(l1, b_ + 4096); TRRD(h1, b_ + 6144); TRRD(l2, b_ + 8192); TRRD(h2, b_ + 10240); TRRD(l3, b_ + 12288); TRRD(h3, b_ + 14336); \
        asm volatile("s_waitcnt lgkmcnt(0)" ::: "memory"); SBAR(); \
        o[d0] = __builtin_amdgcn_mfma_f32_32x32x16_bf16(pa0, (bf16x8){l0[0], l0[1], l0[2], l0[3], h0[0], h0[1], h0[2], h0[3]}, o[d0], 0, 0, 0); \
        o[d0] = __builtin_amdgcn_mfma_f32_32x32x16_bf16(pa1, (bf16x8){l1[0], l1[1], l1[2], l1[3], h1[0], h1[1], h1[2], h1[3]}, o[d0], 0, 0, 0); \
        o[d0] = __builtin_amdgcn_mfma_f32_32x32x16_bf16(pa2, (bf16x8){l2[0], l2[1], l2[2], l2[3], h2[0], h2[1], h2[2], h2[3]}, o[d0], 0, 0, 0); \
        o[d0] = __builtin_amdgcn_mfma_f32_32x32x16_bf16(pa3, (bf16x8){l3[0], l3[1], l3[2], l3[3], h3[0], h3[1], h3[2], h3[3]}, o[d0], 0, 0, 0); } while (0)
    PV_D0(0); PV_D0(1); if constexpr (NV == 4) { PV_D0(2); PV_D0(3); }
#undef PV_D0
#undef TRRD
}
struct PStage { bf16x8 k0, k1, v0, v1, v2, v3; float c; };
template <int NV>
__device__ __forceinline__ void pair_block(const PRef& B, char* lds, volatile __attribute__((address_space(3))) unsigned* PROFW) {
    PROF_T0(2);
    PROF_T0(8);
    const int tid = threadIdx.x, wid = __builtin_amdgcn_readfirstlane(tid >> 6), lane = tid & 63, r32 = lane & 31, hi = lane >> 5, pr = wid & 3, kh = wid >> 2;
    char* V_lds = lds; char* K_lds = lds + P_OFF_K; char* X_lds = lds + P_OFF_X; float* L_lds = (float*)(lds + P_OFF_L); float* cbw = (float*)(lds + P_OFF_CB);
    const int j_lo = B.jlo, NT = (B.P0 >> 6) + 2 - j_lo;
    const int sr = tid >> 4, sc = (tid & 15) * 8, vst0 = v_st(sr, sc), vst1 = v_st(32 + sr, sc), kws = KSWZ(sr, sc * 2);
    const int vb0 = (int)(uintptr_t)V_lds + kh * (NV == 4 ? SHM_V : 1024) + v_rd_base(lane);
    int ka[4];
#pragma unroll
    for (int dd = 0; dd < 4; ++dd) ka[dd] = (int)(uintptr_t)K_lds + kh * (32 * 256) + KSWZ(r32, (dd * 16 + hi * 8) * 2);
    constexpr float C2 = 1.4426950408889634f * SCALE;
    const float mnL = -B.mref * C2;
    const int qrow = B.P0 + pr * 32 + r32;
    bf16x8 qr[8];
#pragma unroll
    for (int d0 = 0; d0 < 8; ++d0) qr[d0] = load8<bf16>(B.Q + (size_t)(pr * 32 + r32) * LDQ + d0 * 16 + hi * 8);
    const float cq = B.C[qrow];
    f32x16 o[NV] = {}; float l_reg = 0.f;
    PStage stA, stB;
#define TCL(t) ((t) < NT ? (t) : NT - 1)
#define PLOADK(st, t) do { const int k0_ = (j_lo + TCL(t)) * KVBLK; const bf16* kp_ = B.K + (size_t)(k0_ + sr) * LDQ + sc; st.k0 = load8<bf16>(kp_); st.k1 = load8<bf16>(kp_ + (size_t)32 * LDQ); st.c = B.C[k0_ + (tid & 63)]; } while (0)
#define PLOADV(st, t) do { const int k0_ = (j_lo + TCL(t)) * KVBLK; const bf16* vp_ = B.V + (size_t)(k0_ + sr) * LDQ + sc; st.v0 = load8<bf16>(vp_); st.v1 = load8<bf16>(vp_ + (size_t)32 * LDQ); \
        if constexpr (NV == 4) { st.v2 = load8<bf16>(vp_ + 128); st.v3 = load8<bf16>(vp_ + (size_t)32 * LDQ + 128); } } while (0)
#define PWRITEK(st, bf) do { *(bf16x8*)(K_lds + (bf) * SHM_K + kws) = st.k0; *(bf16x8*)(K_lds + (bf) * SHM_K + kws + 32 * 256) = st.k1; if (tid < 64) cbw[(bf) * 64 + tid] = st.c; } while (0)
#define PWRITEV(st, bf) do { *(bf16x8*)(V_lds + (bf) * SHM_V2 + vst0) = st.v0; *(bf16x8*)(V_lds + (bf) * SHM_V2 + vst1) = st.v1; \
        if constexpr (NV == 4) { *(bf16x8*)(V_lds + (bf) * SHM_V2 + SHM_V + vst0) = st.v2; *(bf16x8*)(V_lds + (bf) * SHM_V2 + SHM_V + vst1) = st.v3; } } while (0)
#define KRD_(dst, d0, KB) asm volatile("ds_read_b128 %0, %1 offset:%2" : "=&v"(dst) : "v"(ka[(d0) & 3]), "i"((KB) * SHM_K + ((d0) >> 2) * 128) : "memory")
#define KWT_(n, r) asm volatile("s_waitcnt lgkmcnt(" #n ")" : "+v"(r) :: "memory")
#define ASTAGE(t, KB, XB) do { \
        f32x16 p; { const f32x4* c4 = (const f32x4*)(cbw + (KB) * 64 + 32 * kh + 4 * hi); \
            _Pragma("unroll") for (int g = 0; g < 4; ++g) { const f32x4 a = c4[2 * g]; _Pragma("unroll") for (int i = 0; i < 4; ++i) p[4 * g + i] = cq - a[i]; } } \
        { bf16x8 kf0, kf1, kf2, kf3;     \
          KRD_(kf0, 0, KB); KRD_(kf1, 1, KB); KRD_(kf2, 2, KB); KRD_(kf3, 3, KB); \
          KWT_(3, kf0); p = __builtin_amdgcn_mfma_f32_32x32x16_bf16(kf0, qr[0], p, 0, 0, 0); KRD_(kf0, 4, KB); \
          KWT_(3, kf1); p = __builtin_amdgcn_mfma_f32_32x32x16_bf16(kf1, qr[1], p, 0, 0, 0); KRD_(kf1, 5, KB); \
          KWT_(3, kf2); p = __builtin_amdgcn_mfma_f32_32x32x16_bf16(kf2, qr[2], p, 0, 0, 0); KRD_(kf2, 6, KB); \
          KWT_(3, kf3); p = __builtin_amdgcn_mfma_f32_32x32x16_bf16(kf3, qr[3], p, 0, 0, 0); KRD_(kf3, 7, KB); \
          KWT_(3, kf0); p = __builtin_amdgcn_mfma_f32_32x32x16_bf16(kf0, qr[4], p, 0, 0, 0); \
          KWT_(2, kf1); p = __builtin_amdgcn_mfma_f32_32x32x16_bf16(kf1, qr[5], p, 0, 0, 0); \
          KWT_(1, kf2); p = __builtin_amdgcn_mfma_f32_32x32x16_bf16(kf2, qr[6], p, 0, 0, 0); \
          KWT_(0, kf3); p = __builtin_amdgcn_mfma_f32_32x32x16_bf16(kf3, qr[7], p, 0, 0, 0); } \
        { const int kb = (j_lo + (t)) * KVBLK + 32 * kh; if (kb + 31 > B.P0 + pr * 32) { const int dq = qrow - kb - 4 * hi; const float NEG = -__builtin_inff(); \
            _Pragma("unroll") for (int r = 0; r < 16; ++r) { const int c = (r & 3) + 8 * (r >> 2); if (dq - c < 0) p[r] = NEG; } } } \
        _Pragma("unroll") for (int r = 0; r < 16; ++r) p[r] = __builtin_amdgcn_exp2f(fmaf(p[r], C2, mnL)); \
        { float ps = 0.f; _Pragma("unroll") for (int r = 0; r < 16; ++r) ps += p[r]; \
          auto rr = __builtin_amdgcn_permlane32_swap(__float_as_uint(ps), __float_as_uint(ps), false, false); l_reg += __uint_as_float(rr[0]) + __uint_as_float(rr[1]); } \
        { unsigned a0 = cvtpk(p[0], p[1]), a1 = cvtpk(p[2], p[3]), b0 = cvtpk(p[4], p[5]), b1 = cvtpk(p[6], p[7]); \
          auto r0 = __builtin_amdgcn_permlane32_swap(a0, b0, false, false); auto r1 = __builtin_amdgcn_permlane32_swap(a1, b1, false, false); u32x4 w = {r0[0], r1[0], r0[1], r1[1]}; \
          *(u32x4*)(X_lds + (XB) * (NW * 2048) + wid * 2048 + lane * 16) = w; } \
        { unsigned a0 = cvtpk(p[8], p[9]), a1 = cvtpk(p[10], p[11]), b0 = cvtpk(p[12], p[13]), b1 = cvtpk(p[14], p[15]); \
          auto r0 = __builtin_amdgcn_permlane32_swap(a0, b0, false, false); auto r1 = __builtin_amdgcn_permlane32_swap(a1, b1, false, false); u32x4 w = {r0[0], r1[0], r0[1], r1[1]}; \
          *(u32x4*)(X_lds + (XB) * (NW * 2048) + wid * 2048 + 1024 + lane * 16) = w; } } while (0)
#define BSTAGE(VB, XB) do { const char* xo_ = X_lds + (XB) * (NW * 2048) + wid * 2048 + lane * 16; const char* xp_ = X_lds + (XB) * (NW * 2048) + (wid ^ 4) * 2048 + lane * 16; \
        const bf16x8 own0 = *(const bf16x8*)xo_, own1 = *(const bf16x8*)(xo_ + 1024), oth0 = *(const bf16x8*)xp_, oth1 = *(const bf16x8*)(xp_ + 1024); \
        pair_pv<VB, NV>(o, vb0, kh ? oth0 : own0, kh ? oth1 : own1, kh ? own0 : oth0, kh ? own1 : oth1); } while (0)
    PLOADK(stA, 0); PLOADV(stA, 0); PLOADK(stB, 1); PLOADV(stB, 1);
    __syncthreads();
    PWRITEK(stA, 0); PWRITEV(stA, 0);
    PLOADK(stA, 2);
    __syncthreads();
    PROF_T1(8);
    PROF_T0(9);
    ASTAGE(0, 0, 0);
    PWRITEK(stB, 1);
    PLOADV(stA, 2); PLOADK(stB, 3);
    __syncthreads();
#define PITER(t, P, SV, SK) do {     \
        BSTAGE(P, P); \
        if ((t) + 1 < NT) { ASTAGE((t) + 1, (P) ^ 1, (P) ^ 1); PWRITEV(SV, (P) ^ 1); PWRITEK(SK, P); PLOADV(SV, (t) + 3); PLOADK(SK, (t) + 4); } \
        __syncthreads(); } while (0)
    PROF_T1(9);
    PROF_T1(2);
    { PROF_T0(3);
    int t = 0;
    for (; t + 1 < NT; t += 2) { PITER(t, 0, stB, stA); PITER(t + 1, 1, stA, stB); }
    if (t < NT) PITER(t, 0, stB, stA);
    PROF_T1(3); }
    { PROF_T0(4);
    { PROF_T0(6);
    if (hi == 0) L_lds[wid * 64 + r32] = l_reg;
    __syncthreads();
    PROF_T1(6); }
    PROF_T0(7);
    if (hi == 0) L_lds[wid * 64 + 32 + r32] = l_reg + L_lds[(wid ^ 4) * 64 + r32];
    asm volatile("s_waitcnt lgkmcnt(0)" ::: "memory");
    float rli[16];
#pragma unroll
    for (int r = 0; r < 16; ++r) rli[r] = __builtin_amdgcn_rcpf(L_lds[wid * 64 + 32 + crow(r, hi)]);
    constexpr int OROW = NV * 64 + 16;
    char* ot = lds + wid * (32 * (4 * 64 + 16));
    const bool odd = (r32 & 1) != 0;
#pragma unroll
    for (int r = 0; r < 16; ++r) { const int orow = crow(r, hi);
#pragma unroll
        for (int d0 = 0; d0 < NV; d0 += 2) { const float va = o[d0][r] * rli[r], vb = o[d0 + 1][r] * rli[r];
            const float snd = odd ? va : vb;
            const float rcv = __uint_as_float((unsigned)__builtin_amdgcn_update_dpp(0, (int)__float_as_uint(snd), 0xB1, 0xF, 0xF, true));
            const unsigned pk = cvtpk(odd ? rcv : va, odd ? vb : rcv);
            *(unsigned*)(ot + orow * OROW + ((odd ? d0 + 1 : d0) * 32 + (r32 & ~1)) * 2) = pk; } }
    asm volatile("s_waitcnt lgkmcnt(0)" ::: "memory");
    PROF_T0(10);
    bf16* Ow = B.O + (size_t)(pr * 32) * LDO + kh * (NV * 32);
    constexpr int CPR = NV * 4;
#pragma unroll
    for (int i = 0; i < (32 * CPR) / 64; ++i) { const int idx = i * 64 + lane, row = idx / CPR, ch = idx % CPR;
        const u32x4 w = *(const u32x4*)(ot + row * OROW + ch * 16);
        *(u32x4*)(Ow + (size_t)row * LDO + ch * 8) = w; }
    PROF_T1(10);
    PROF_T1(7);
    PROF_T1(4); }
#undef TCL
#undef PLOADK
#undef PLOADV
#undef PWRITEK
#undef PWRITEV
#undef KRD_
#undef KWT_
#undef ASTAGE
#undef BSTAGE
#undef PITER
}

constexpr float SKIP_T = 16.f;
constexpr int NDIFF = 16 * NQB2, NFOX = 16 * NQB2;
struct Tensors { const bf16* QKV; bf16* A2; bf16* DT; const float* BIAS; const unsigned* NRM; };
__host__ __device__ constexpr int est_diff(int h, int qb2) { const int full = 2 * (qb2 + 1), cap = h == 0 ? 5 : (h == 1 ? 12 : (h == 2 ? 38 : 128)); return full < cap ? full : cap; }
__host__ __device__ constexpr int est_fox(int qb2) { const int full = 2 * (qb2 + 1); return full < 14 ? full : 14; }
struct OrderTab2 { unsigned short v[NDIFF]; };
template <bool FOX> __host__ __device__ constexpr OrderTab2 make_order2() {
    OrderTab2 t{}; int start[130] = {};
    for (int pp = 0; pp < 16; ++pp) for (int qb = 0; qb < NQB2; ++qb) start[128 - (FOX ? est_fox(qb) : est_diff((pp >> 1) & 3, qb)) + 1]++;
    for (int i = 1; i < 130; ++i) start[i] += start[i - 1];
    for (int pp = 0; pp < 16; ++pp) for (int qb = NQB2 - 1; qb >= 0; --qb) { const int b = 128 - (FOX ? est_fox(qb) : est_diff((pp >> 1) & 3, qb)); t.v[start[b]++] = (unsigned short)(pp * 64 + qb); }
    return t;
}
__device__ const OrderTab2 ORDER_D = make_order2<false>();
__device__ const OrderTab2 ORDER_F = make_order2<true>();
constexpr int ORD_OFF = PAIR_LDS, NRMW_OFF = ORD_OFF + NDIFF * 2, DG_OFF = NRMW_OFF + 256;
template <bool FOX>
__device__ __forceinline__ PRef make_pref(const Tensors& T, const char* lds, int o, int lane) {
    const int code = __builtin_amdgcn_readfirstlane((int)((const unsigned short*)(lds + ORD_OFF))[o]), pp = code >> 6, qb = code & 63, b = pp >> 3;
    PRef r; int sq, sk;
    const bf16* base = T.QKV + (size_t)b * S * LDQ; r.P0 = qb * QB2;
    if (FOX) { const int h = pp & 7; r.Q = base + (size_t)qb * QB2 * LDQ + C_FQ + h * 128; r.K = base + C_FK + h * 128; r.V = base + C_FV + h * 128; sq = h; sk = 8 + h;
        r.O = T.A2 + ((size_t)b * S + (size_t)qb * QB2) * LDO + h * 128; r.C = T.BIAS + (size_t)(b * 8 + h) * S; }
    else { const int h = (pp >> 1) & 3, mp = pp & 1; r.Q = base + (size_t)qb * QB2 * LDQ + C_DQ + h * 256 + mp * 128; r.K = base + C_DK + h * 256 + mp * 128; r.V = base + C_DV + h * 256; sq = 16 + 2 * h + mp; sk = 24 + 2 * h + mp;
        r.O = T.DT + ((size_t)b * S + (size_t)qb * QB2) * LDO + h * 512 + mp * 256; r.C = T.BIAS + (size_t)(16 + h) * S; }
    const int jd = r.P0 >> 6;
    int ln = lane; asm volatile("" : "+v"(ln));
    const int j0 = ln < jd ? ln : jd, j1 = ln + 64 < jd ? ln + 64 : jd;
    const float cp = r.C[r.P0], c0 = r.C[64 * j0 + 63], c1 = r.C[64 * j1 + 63];
    const float nq = ((const float*)(lds + NRMW_OFF))[b * 32 + sq], nk = ((const float*)(lds + NRMW_OFF))[b * 32 + sk];
    const float qk = 1.015f * sqrtf(nq * nk);
    float bw;
    { const int tid = (int)threadIdx.x; int tt = tid; asm volatile("" : "+v"(tt));
      const int row = tt >> 2, part = tt & 3;
      const bf16* qp = r.Q + (size_t)row * LDQ + part * 32; const bf16* kp = r.K + (size_t)(r.P0 + row) * LDQ + part * 32;
      bf16x8 qa[4], ka[4];
#pragma unroll
      for (int i = 0; i < 4; ++i) { qa[i] = load8<bf16>(qp + 8 * i); ka[i] = load8<bf16>(kp + 8 * i); }
      float d = 0.f, qq = 0.f;
#pragma unroll
      for (int i = 0; i < 4; ++i)
#pragma unroll
          for (int e = 0; e < 8; ++e) { const float fa = __uint_as_float((unsigned)(unsigned short)qa[i][e] << 16), fb = __uint_as_float((unsigned)(unsigned short)ka[i][e] << 16); d = fmaf(fa, fb, d); qq = fmaf(fa, fa, qq); }
      d += __shfl_xor(d, 1); qq += __shfl_xor(qq, 1); d += __shfl_xor(d, 2); qq += __shfl_xor(qq, 2);
      bw = 1.015f * sqrtf(qq * nk) - d;
#pragma unroll
      for (int o_ = 4; o_ < 64; o_ <<= 1) bw = fmaxf(bw, __shfl_xor(bw, o_));
      float* dg = (float*)(lds + DG_OFF) + (o & 1) * 8;
      if ((tt & 63) == 0) dg[tt >> 6] = bw;
      __syncthreads();
      bw = fmaxf(fmaxf(fmaxf(dg[0], dg[1]), fmaxf(dg[2], dg[3])), fmaxf(fmaxf(dg[4], dg[5]), fmaxf(dg[6], dg[7])));
      bw = fminf(bw, 2.f * qk); }
    const float th = SKIP_T * (1.0f / SCALE) + bw, lim = cp + th; r.mref = qk;
    const bool k0 = (ln >= jd) | (c0 <= lim), k1 = (ln + 64 >= jd) | (c1 <= lim);
    const unsigned long long b0 = __ballot(k0), b1 = __ballot(k1);
    r.jlo = b0 ? (int)__builtin_ctzll(b0) : 64 + (int)__builtin_ctzll(b1);
    return r;
}
template <bool FOX>
__device__ __forceinline__ void attn_part(char* lds, const Tensors& T, unsigned* head, volatile __attribute__((address_space(3))) int* qw) {
    volatile __attribute__((address_space(3))) unsigned* PROFW = (volatile __attribute__((address_space(3))) unsigned*)(qw + 8);
    PROF_T0(5);
    const int tid = threadIdx.x, lane = tid & 63;
    if (tid == 0) qw[0] = (int)atomicAdd(head, 1u);
    ((unsigned*)(lds + ORD_OFF))[tid] = ((const unsigned*)(FOX ? ORDER_F.v : ORDER_D.v))[tid];
    if (tid < 64) ((unsigned*)(lds + NRMW_OFF))[tid] = T.NRM[tid];
    __syncthreads();
    int k = __builtin_amdgcn_readfirstlane(qw[0]);
    while (k < NDIFF) {
        int kn = 0; if (tid == 0) kn = (int)atomicAdd(head, 1u);
        PROF_T0(1);
        const PRef B = make_pref<FOX>(T, lds, k, lane);
        PROF_T1(1);
        pair_block<FOX ? 2 : 4>(B, lds, PROFW);
        if (tid == 0) qw[1] = kn;
        __syncthreads();
        k = __builtin_amdgcn_readfirstlane(qw[1]);
    }
    __syncthreads();
    PROF_T1(5);
}
#undef KSWZ
#undef SBAR
}

#define GAS __attribute__((address_space(1)))
#define LAS __attribute__((address_space(3)))
typedef unsigned short bf16;
typedef unsigned v4u __attribute__((ext_vector_type(4)));
typedef float f32x4 __attribute__((ext_vector_type(4)));
typedef short bf16x8 __attribute__((ext_vector_type(8)));
typedef GAS unsigned gu32;
typedef GAS unsigned long long gu64;
#define RLX_AGENT __ATOMIC_RELAXED, __HIP_MEMORY_SCOPE_AGENT
#define LDS_WAIT() asm volatile("s_waitcnt lgkmcnt(0)" ::: "memory")
#define VM_WAIT() asm volatile("s_waitcnt vmcnt(0)" ::: "memory")
__device__ __forceinline__ unsigned long long rt() { return __builtin_amdgcn_s_memrealtime(); }
__device__ __forceinline__ unsigned f2bf(float f) { unsigned u = __builtin_bit_cast(unsigned, f); return (u + 0x7fffu + ((u >> 16) & 1u)) >> 16; }
__device__ __forceinline__ unsigned pk2(float lo, float hi) { return f2bf(lo) | (f2bf(hi) << 16); }

#define XB_TMO      128
#define XB_XCNT(j)  (256  + 64 * (j))
#define XB_XSUB(j)  (1280 + 64 * (j))
#define XB_XGEN(j)  (2304 + 64 * (j))
#define XB_TOP      3328
#define XB_TOPGEN   3392
#define XCD_BAR_WORDS 3456
#define XB_SPIN_CAP (1u << 18)

__device__ __forceinline__ unsigned xb_ld(unsigned* p)              { return __hip_atomic_load(p, __ATOMIC_RELAXED, __HIP_MEMORY_SCOPE_AGENT); }
__device__ __forceinline__ unsigned xb_add(unsigned* p, unsigned v) { return __hip_atomic_fetch_add(p, v, __ATOMIC_RELAXED, __HIP_MEMORY_SCOPE_AGENT); }
__device__ __forceinline__ unsigned xb_xcc_id() { return (unsigned)__builtin_amdgcn_s_getreg((3 << 11) | 20) & 0xFu; }
#define XB_SPIN(cond, bar) do { unsigned _sp = 0; while (cond) { __builtin_amdgcn_s_sleep(1); \
    if ((++_sp & 255u) == 0u) { if (xb_ld(&(bar)[XB_TMO])) break; if (_sp > XB_SPIN_CAP) { atomicAdd(&(bar)[XB_TMO], 1u); break; } } } } while (0)

struct XcdBarrier {
    unsigned* bar; unsigned x;
    volatile LAS unsigned* st;
};

__device__ __forceinline__ XcdBarrier xcd_barrier_post(unsigned* bar, volatile LAS unsigned* st) {
    XcdBarrier b; b.bar = bar; b.x = xb_xcc_id(); b.st = st;
    if (threadIdx.x == 0) (void)xb_add(&bar[XB_XCNT(b.x)], 1u);
    return b;
}
__device__ __forceinline__ void xcd_barrier_complete(unsigned* bar, unsigned x, unsigned& nloc, unsigned& nx) {
    const unsigned G = gridDim.x * gridDim.y * gridDim.z;
    unsigned sum, cnt, mine, sp = 0u;
    for (;;) {
        sum = 0u; cnt = 0u; mine = 0u;
#pragma unroll
        for (unsigned j = 0; j < 16; ++j) { const unsigned c = xb_ld(&bar[XB_XCNT(j)]); sum += c; cnt += (c > 0u) ? 1u : 0u; mine = (j == x) ? c : mine; }
        if (sum == G) break;
        __builtin_amdgcn_s_sleep(1);
        if ((++sp & 255u) == 0u) { if (xb_ld(&bar[XB_TMO])) break; if (sp > XB_SPIN_CAP) { atomicAdd(&bar[XB_TMO], 1u); break; } }
    }
    nloc = mine > 0u ? mine : 1u; nx = cnt > 0u ? cnt : 1u;
}

__device__ __forceinline__ void xcd_barrier(const XcdBarrier& b) {
    asm volatile("s_waitcnt vmcnt(0)" ::: "memory");
    __syncthreads();
    if (threadIdx.x == 0) {
        unsigned* bar = b.bar;
        __builtin_amdgcn_s_waitcnt(0);
        unsigned nloc = b.st[0], nx = b.st[1];
        if (nloc == 0u) { xcd_barrier_complete(bar, b.x, nloc, nx); b.st[0] = nloc; b.st[1] = nx; }
        const unsigned old = xb_add(&bar[XB_XSUB(b.x)], 1u);
        const unsigned gen = old / nloc;
        if (old + 1u == (gen + 1u) * nloc) {
            __builtin_amdgcn_fence(__ATOMIC_RELEASE, "agent");
            asm volatile("s_waitcnt vmcnt(0)" ::: "memory");
            const unsigned og = xb_add(&bar[XB_TOP], 1u);
            const unsigned tg = og / nx;
            if (og + 1u == (tg + 1u) * nx) xb_add(&bar[XB_TOPGEN], 1u);
            else XB_SPIN(xb_ld(&bar[XB_TOPGEN]) == tg, bar);
            __builtin_amdgcn_fence(__ATOMIC_ACQUIRE, "agent");
            xb_add(&bar[XB_XGEN(b.x)], 1u);
            asm volatile("s_waitcnt vmcnt(0)" ::: "memory");
        } else {
            XB_SPIN(xb_ld(&bar[XB_XGEN(b.x)]) == gen, bar);
            __builtin_amdgcn_fence(__ATOMIC_ACQUIRE, "agent");
            asm volatile("s_waitcnt vmcnt(0)" ::: "memory");
        }
    }
    __syncthreads();
}

constexpr int NWAVES = 8;
constexpr int RING_OFF = 0, RING_BYTES = 131072;
constexpr int LDSCTL_OFF = RING_BYTES, MISC_OFF = LDSCTL_OFF + 320;
constexpr int SEG_OFF = LDSCTL_OFF + 1024;
constexpr int TILE_E_OFF = LDSCTL_OFF + 2048;
constexpr int CNTL_OFF = LDSCTL_OFF + 1536;
constexpr int TILE_NR_OFF = TILE_E_OFF + 2048;
constexpr int TILE_RB_OFF = TILE_E_OFF + 1024;
constexpr int ECAP = M;
constexpr int NRMP_OFF = LDSCTL_OFF + 4096;
constexpr int LDS_BYTES = 147456;
constexpr int ATT_QW_OFF = LDSCTL_OFF + 512;
static_assert(att::PAIR_RING == RING_BYTES && att::PAIR_LDS <= LDS_BYTES && att::P_OFF_L >= ATT_QW_OFF + 64 && att::LDS_BYTES <= RING_BYTES && TILE_E_OFF + NTILE_MAX * 4 <= LDS_BYTES, "LDS map");

struct Args { const float* in[19]; float* out; unsigned char* ws; int ph_lo, ph_hi, li, pad; };

struct Ctx {
    LAS unsigned char* lds; int tid, lane, wave, G, gw, NGW;
    const float *x, *attn_g, *w_in, *fbias, *lq1, *lk1, *lq2, *lk2, *subg, *w_out, *ffn_g, *wg, *bg, *we, *be, *wgate, *wup, *wdown, *fin_g;
    float* out;
    bf16* A1; bf16* WIN; bf16* WOUT; float* BIAS; bf16* QKV; bf16* A2; bf16* DT; bf16* H1;
    int* tok_e; int* tok_pos; float* tok_gate; float* rstd; float* rowgate; int* rowtok; int* etok; float* egate; float* WR; bf16* XG; bf16* HB; bf16* Y; bf16* WGU; bf16* WD; unsigned* cnt; unsigned* nrm;
};
__device__ __forceinline__ float wave_sum(float v) {
#pragma unroll
    for (int o = 1; o < 64; o <<= 1) v += __shfl_xor(v, o);
    return v;
}
typedef unsigned v2u __attribute__((ext_vector_type(2)));

__device__ __forceinline__ void p0_row2(const Ctx& C, int t0, int t1, const LAS float* wf) {
    const int lane = C.lane; const float* xr0 = C.x + (size_t)t0 * DM; const float* xr1 = C.x + (size_t)t1 * DM;
    f32x4 v0[8], v1[8]; float ss0 = 0.f, ss1 = 0.f;
#pragma unroll
    for (int j = 0; j < 8; ++j) { v0[j] = *(const f32x4*)(xr0 + j * 256 + lane * 4); v1[j] = *(const f32x4*)(xr1 + j * 256 + lane * 4); }
#pragma unroll
    for (int j = 0; j < 8; ++j) { ss0 += (v0[j].x * v0[j].x + v0[j].y * v0[j].y) + (v0[j].z * v0[j].z + v0[j].w * v0[j].w); ss1 += (v1[j].x * v1[j].x + v1[j].y * v1[j].y) + (v1[j].z * v1[j].z + v1[j].w * v1[j].w); }
    const float r0 = 1.f / sqrtf(wave_sum(ss0) * (1.f / DM) + 1e-6f), r1 = 1.f / sqrtf(wave_sum(ss1) * (1.f / DM) + 1e-6f);
    float fl0[8] = {0.f, 0.f, 0.f, 0.f, 0.f, 0.f, 0.f, 0.f}, fl1[8] = {0.f, 0.f, 0.f, 0.f, 0.f, 0.f, 0.f, 0.f};
#pragma unroll
    for (int j = 0; j < 8; ++j) {
        const f32x4 gg = *(const f32x4*)(C.attn_g + j * 256 + lane * 4);
        v0[j] = v0[j] * r0 * gg; v1[j] = v1[j] * r1 * gg;
        v2u o; o.x = pk2(v0[j].x, v0[j].y); o.y = pk2(v0[j].z, v0[j].w);
        *(v2u*)(C.A1 + (size_t)t0 * DM + j * 256 + lane * 4) = o;
        o.x = pk2(v1[j].x, v1[j].y); o.y = pk2(v1[j].z, v1[j].w);
        *(v2u*)(C.A1 + (size_t)t1 * DM + j * 256 + lane * 4) = o;
#pragma unroll
        for (int h = 0; h < 8; ++h) { const f32x4 w4 = *(const LAS f32x4*)(wf + h * DM + j * 256 + lane * 4);
            fl0[h] += (v0[j].x * w4.x + v0[j].y * w4.y) + (v0[j].z * w4.z + v0[j].w * w4.w); fl1[h] += (v1[j].x * w4.x + v1[j].y * w4.y) + (v1[j].z * w4.z + v1[j].w * w4.w); }
        asm volatile("" ::: "memory");
    }
#pragma unroll
    for (int h = 0; h < 8; ++h) { fl0[h] = wave_sum(fl0[h]); fl1[h] = wave_sum(fl1[h]); }
    float z0 = fl0[0], z1 = fl1[0];
#pragma unroll
    for (int h = 1; h < 8; ++h) { z0 = (lane == h) ? fl0[h] : z0; z1 = (lane == h) ? fl1[h] : z1; }
    if (lane < 8) { z0 += C.fbias[lane]; z1 += C.fbias[lane];
        C.BIAS[(size_t)((t0 / S) * 8 + lane) * S + (t0 % S)] = fminf(z0, 0.f) - log1pf(expf(-fabsf(z0)));
        C.BIAS[(size_t)((t1 / S) * 8 + lane) * S + (t1 % S)] = fminf(z1, 0.f) - log1pf(expf(-fabsf(z1))); }
}
__device__ __forceinline__ void tr_item(const float* src, int ld, int k0, int c0, bf16* dst, int K, int r0, LAS float* scr, int lane) {
    { f32x4 v[8];
#pragma unroll
      for (int i = 0; i < 8; ++i) v[i] = *(const f32x4*)(src + (size_t)(k0 + 8 * i + (lane >> 3)) * ld + c0 + 4 * (lane & 7));
#pragma unroll
      for (int i = 0; i < 8; ++i) { LAS float* d = scr + (8 * i + (lane >> 3)) * 33 + 4 * (lane & 7); d[0] = v[i].x; d[1] = v[i].y; d[2] = v[i].z; d[3] = v[i].w; } }
    LDS_WAIT(); asm volatile("" ::: "memory");
    const int c = lane & 7;
#pragma unroll
    for (int j = 0; j < 4; ++j) { const int n = (lane >> 3) + 8 * j; const LAS float* s = scr + (8 * c) * 33 + n;
        v4u o; o.x = pk2(s[0 * 33], s[1 * 33]); o.y = pk2(s[2 * 33], s[3 * 33]); o.z = pk2(s[4 * 33], s[5 * 33]); o.w = pk2(s[6 * 33], s[7 * 33]);
        *(GAS v4u*)(dst + (size_t)(r0 + n) * K + k0 + 8 * c) = o; }
    LDS_WAIT(); asm volatile("" ::: "memory");
}
__device__ __forceinline__ void p0_prologue(const Ctx& C) {
    LAS float* scr = (LAS float*)(C.lds + RING_OFF + C.wave * 16384);
    constexpr int I_WIN = 32 * 192, I_WOUT = 32 * 64, I_ALL = I_WIN + I_WOUT;
    for (int it = C.gw; it < I_ALL; it += C.NGW) {
        int r = it;
        if (r < I_WIN) { const int kb = r / 192, nb = r % 192; tr_item(C.w_in, NCOL, 64 * kb, nb < 96 ? 32 * nb : 32 * nb + 8, C.WIN, DM, 32 * nb, scr, C.lane); continue; } r -= I_WIN;
        { const int kb = r / 64, nb = r % 64; tr_item(C.w_out, DM, 64 * kb, 32 * nb, C.WOUT, DM, 32 * nb, scr, C.lane); }
    }
    __syncthreads();
    { LAS float* wf = (LAS float*)(C.lds + RING_OFF);
      for (int k = C.tid; k < DM; k += NWAVES * 64) { const float* wr = C.w_in + (size_t)k * NCOL + FCOL; const f32x4 w0 = *(const f32x4*)wr, w1 = *(const f32x4*)(wr + 4);
          wf[0 * DM + k] = w0.x; wf[1 * DM + k] = w0.y; wf[2 * DM + k] = w0.z; wf[3 * DM + k] = w0.w; wf[4 * DM + k] = w1.x; wf[5 * DM + k] = w1.y; wf[6 * DM + k] = w1.z; wf[7 * DM + k] = w1.w; }
      __syncthreads();
      for (int t = C.gw; t < M; t += 2 * C.NGW) { const int t1 = t + C.NGW; p0_row2(C, t, t1 < M ? t1 : t, wf); } }
    const int gt = C.gw * 64 + C.lane, NGT = C.NGW * 64;
    for (int i = gt; i < 4 * S; i += NGT) { const int h = i / S, s = i % S; C.BIAS[(size_t)(16 + h) * S + s] = -exp2f(-2.f * (float)(h + 1)) * (float)s * ATT_ISCALE; }
    for (int i = gt; i < 64 * 5 * 2 * 64; i += NGT) { const int ln = i & 63, hl = (i >> 6) & 1, b = (i >> 7) % 5, kk = (i >> 7) / 5, c = 16 * b + (ln & 15);
        unsigned w[4];
#pragma unroll
        for (int jp = 0; jp < 4; ++jp) { unsigned pk = 0;
#pragma unroll
            for (int q = 0; q < 2; ++q) { const int k = 32 * kk + 8 * (ln >> 4) + 2 * jp + q;
                const float v = (c < 8 ? C.wg[(size_t)k * 8 + c] : (c < 72 ? C.we[(size_t)k * NE + c - 8] : 0.f)) * C.ffn_g[k];
                const unsigned h = f2bf(v); const unsigned l = f2bf(v - __uint_as_float(h << 16));
                pk |= (hl ? l : h) << (16 * q); }
            w[jp] = pk; }
        ((v4u*)C.WR)[i] = (v4u){w[0], w[1], w[2], w[3]}; }
}
__device__ __forceinline__ void p1_cumsum(const Ctx& C) {
    if (blockIdx.x >= 16) return;
    float* p = C.BIAS + (size_t)blockIdx.x * S + C.tid * 16; LAS float* wt = (LAS float*)(C.lds + RING_OFF);
    float loc[16]; float s = 0.f;
    { const f32x4 a = *(const f32x4*)p, b = *(const f32x4*)(p + 4), c = *(const f32x4*)(p + 8), d = *(const f32x4*)(p + 12);
      loc[0] = a.x; loc[1] = a.y; loc[2] = a.z; loc[3] = a.w; loc[4] = b.x; loc[5] = b.y; loc[6] = b.z; loc[7] = b.w; loc[8] = c.x; loc[9] = c.y; loc[10] = c.z; loc[11] = c.w; loc[12] = d.x; loc[13] = d.y; loc[14] = d.z; loc[15] = d.w; }
#pragma unroll
    for (int i = 0; i < 16; ++i) { s += loc[i]; loc[i] = s; }
    float inc = s;
#pragma unroll
    for (int o = 1; o < 64; o <<= 1) { const float q = __shfl_up(inc, o); if (C.lane >= o) inc += q; }
    if (C.lane == 63) wt[C.wave] = inc;
    __syncthreads();
    float base = inc - s;
    for (int w = 0; w < C.wave; ++w) base += wt[w];
#pragma unroll
    for (int i = 0; i < 16; ++i) loc[i] = (base + loc[i]) * ATT_ISCALE;
    *(f32x4*)p = (f32x4){loc[0], loc[1], loc[2], loc[3]}; *(f32x4*)(p + 4) = (f32x4){loc[4], loc[5], loc[6], loc[7]};
    *(f32x4*)(p + 8) = (f32x4){loc[8], loc[9], loc[10], loc[11]}; *(f32x4*)(p + 12) = (f32x4){loc[12], loc[13], loc[14], loc[15]};
    __syncthreads();
}
__device__ __forceinline__ void p_norms(const Ctx& C) {
    const int lane = C.lane, b = C.gw & 1;
    float mx[8] = {0.f, 0.f, 0.f, 0.f, 0.f, 0.f, 0.f, 0.f};
    for (int rr = C.gw >> 1; rr < S; rr += C.NGW >> 1) {
        const bf16* row = C.QKV + (size_t)(b * S + rr) * NQKV + 8 * lane;
#pragma unroll
        for (int i = 0; i < 8; ++i) { const v4u w = *(const v4u*)(row + (i < 4 ? 512 * i : 1024 + 512 * i));
            float ss = 0.f;
#pragma unroll
            for (int c = 0; c < 4; ++c) { const float lo = __uint_as_float(w[c] << 16), hi = __uint_as_float(w[c] & 0xffff0000u); ss += lo * lo + hi * hi; }
            ss += __shfl_xor(ss, 1); ss += __shfl_xor(ss, 2); ss += __shfl_xor(ss, 4); ss += __shfl_xor(ss, 8);
            mx[i] = fmaxf(mx[i], ss); }
    }
    if ((lane & 15) == 0) {
#pragma unroll
        for (int i = 0; i < 8; ++i) atomicMax(C.nrm + b * 32 + 4 * i + (lane >> 4), __float_as_uint(mx[i]));
    }
}
__device__ __forceinline__ void p3_combine(const Ctx& C) {
    const int lane = C.lane;
    const float s1 = wave_sum(C.lq1[lane] * C.lk1[lane] + C.lq1[lane + 64] * C.lk1[lane + 64]);
    const float s2 = wave_sum(C.lq2[lane] * C.lk2[lane] + C.lq2[lane + 64] * C.lk2[lane + 64]);
    const float lam = expf(s1) - expf(s2) + 0.2f;
    const f32x4 gg = *(const f32x4*)(C.subg + lane * 4);
    for (int idx = C.gw; idx < M * 4; idx += C.NGW) {
        const int t = idx >> 2, h = idx & 3;
        const bf16* p = C.DT + (size_t)t * DM + h * 512 + lane * 4;
        const v2u a = *(const v2u*)p, b = *(const v2u*)(p + 256);
        f32x4 d;
        d.x = __uint_as_float(a.x << 16) - lam * __uint_as_float(b.x << 16); d.y = __uint_as_float(a.x & 0xffff0000u) - lam * __uint_as_float(b.x & 0xffff0000u);
        d.z = __uint_as_float(a.y << 16) - lam * __uint_as_float(b.y << 16); d.w = __uint_as_float(a.y & 0xffff0000u) - lam * __uint_as_float(b.y & 0xffff0000u);
        const float ss = wave_sum((d.x * d.x + d.y * d.y) + (d.z * d.z + d.w * d.w));
        const float r = 0.8f / sqrtf(ss * (1.f / 256.f) + 1e-5f);
        v2u o; o.x = pk2(d.x * r * gg.x, d.y * r * gg.y); o.y = pk2(d.z * r * gg.z, d.w * r * gg.w);
        *(v2u*)(C.A2 + (size_t)t * DM + 1024 + h * 256 + lane * 4) = o;
    }
}
__device__ __forceinline__ void p5a_router(const Ctx& C) {
    const int w = C.wave, th = w & 1, ks = w >> 1;
    LAS float* R1 = (LAS float*)(C.lds + RING_OFF);
    LAS float* SS = (LAS float*)(C.lds + RING_OFF + 81920);
    LAS float* RS = SS + 512;
    LAS float* lg = (LAS float*)(C.lds + RING_OFF + 86016);
    for (int tl = (int)blockIdx.x; tl < M / 64; tl += C.G) {
        int lane = C.lane; asm volatile("" : "+v"(lane));
        const int r = lane & 15, g = lane >> 4;
        const int t0 = tl * 64;
        f32x4 acc[2][5];
#pragma unroll
        for (int T = 0; T < 2; ++T)
#pragma unroll
            for (int b = 0; b < 5; ++b) acc[T][b] = (f32x4){0.f, 0.f, 0.f, 0.f};
        float ss[2] = {0.f, 0.f};
        const bf16* hb = C.H1 + (size_t)(t0 + 32 * th) * DM + 512 * ks; const unsigned ho = (unsigned)(r * DM + 8 * g);
        const v4u* wp = (const v4u*)C.WR + (size_t)(16 * ks) * 10 * 64 + lane;
        v4u a[4][2], tb[10];
#define RT_LA(slot, j_) do { _Pragma("unroll") for (int T = 0; T < 2; ++T) a[slot][T] = *(const v4u*)(hb + (ho + (unsigned)(16 * T * DM + 32 * (j_)))); } while (0)
        RT_LA(0, 0);
#pragma unroll
        for (int q = 0; q < 10; ++q) tb[q] = wp[q * 64];
        RT_LA(1, 1); RT_LA(2, 2); RT_LA(3, 3);
#pragma unroll
        for (int j = 0; j < 16; ++j) {
            __builtin_amdgcn_sched_barrier(0);
#pragma unroll
            for (int T = 0; T < 2; ++T)
#pragma unroll
                for (int c = 0; c < 4; ++c) { const unsigned x = a[j & 3][T][c]; const float lo = __uint_as_float(x << 16), hi = __uint_as_float(x & 0xffff0000u); ss[T] += lo * lo + hi * hi; }
#pragma unroll
            for (int b = 0; b < 5; ++b) {
#pragma unroll
                for (int T = 0; T < 2; ++T) acc[T][b] = __builtin_amdgcn_mfma_f32_16x16x32_bf16(__builtin_bit_cast(bf16x8, a[j & 3][T]), __builtin_bit_cast(bf16x8, tb[2 * b]), acc[T][b], 0, 0, 0);
#pragma unroll
                for (int T = 0; T < 2; ++T) acc[T][b] = __builtin_amdgcn_mfma_f32_16x16x32_bf16(__builtin_bit_cast(bf16x8, a[j & 3][T]), __builtin_bit_cast(bf16x8, tb[2 * b + 1]), acc[T][b], 0, 0, 0);
                __builtin_amdgcn_sched_barrier(0);
                if (j + 1 < 16) { tb[2 * b] = wp[((j + 1) * 10 + 2 * b) * 64]; tb[2 * b + 1] = wp[((j + 1) * 10 + 2 * b + 1) * 64]; }
                __builtin_amdgcn_sched_barrier(0);
            }
            if (j + 4 < 16) RT_LA(j & 3, j + 4);
        }
#undef RT_LA
        asm volatile("" ::: "memory");
#pragma unroll
        for (int T = 0; T < 2; ++T) { ss[T] += __int_as_float(__builtin_amdgcn_ds_bpermute((lane ^ 16) << 2, __float_as_int(ss[T]))); ss[T] += __int_as_float(__builtin_amdgcn_ds_bpermute((lane ^ 32) << 2, __float_as_int(ss[T])));
            if (lane < 16) SS[ks * 64 + 16 * (2 * th + T) + lane] = ss[T]; }
        if (ks >= 2) {
#pragma unroll
            for (int T = 0; T < 2; ++T)
#pragma unroll
                for (int b = 0; b < 5; ++b)
#pragma unroll
                    for (int i = 0; i < 4; ++i) R1[((th * 2 + (ks - 2)) * 40 + (T * 5 + b) * 4 + i) * 64 + lane] = acc[T][b][i];
        }
        __syncthreads();
        if (ks < 2) {
#pragma unroll
            for (int T = 0; T < 2; ++T)
#pragma unroll
                for (int b = 0; b < 5; ++b)
#pragma unroll
                    for (int i = 0; i < 4; ++i) { LAS float* q = R1 + ((th * 2 + ks) * 40 + (T * 5 + b) * 4 + i) * 64 + lane; *q = acc[T][b][i] + *q; }
            if (w == 0) { const float s = (SS[lane] + SS[64 + lane]) + (SS[128 + lane] + SS[192 + lane]);
                const float rs = 1.f / sqrtf(s * (1.f / DM) + 1e-6f); RS[lane] = rs; C.rstd[t0 + lane] = rs; }
        }
        __syncthreads();
#pragma unroll
        for (int m = 0; m < 10; ++m) { const int sl = w + 8 * m, T = sl / 20, b = (sl % 20) >> 2, i = sl & 3, tok = 16 * T + 4 * g + i, s2 = sl % 40, hh = sl / 40;
            const float v = R1[((hh * 2 + 0) * 40 + s2) * 64 + lane] + R1[((hh * 2 + 1) * 40 + s2) * 64 + lane];
            lg[tok * 81 + 16 * b + r] = v * RS[tok]; }
        __syncthreads();
        if (w == 0) {
            const int t = t0 + lane; const LAS float* row = lg + lane * 81;
            float gmax = -__builtin_inff(); int gi = 0; float gl[8];
#pragma unroll
            for (int j = 0; j < 8; ++j) { gl[j] = row[j] + C.bg[j]; if (gl[j] > gmax) { gmax = gl[j]; gi = j; } }
            float gs = 0.f;
#pragma unroll
            for (int j = 0; j < 8; ++j) gs += expf(gl[j] - gmax);
            const float gprob = 1.f / gs;
            float l1 = -__builtin_inff(), l2 = -__builtin_inff(); int i1 = 0, i2 = 0;
#pragma unroll
            for (int j = 0; j < 8; ++j) { const float q = row[8 + gi * 8 + j] + C.be[gi * 8 + j];
                if (q > l1) { l2 = l1; i2 = i1; l1 = q; i1 = j; } else if (q > l2) { l2 = q; i2 = j; } }
            const float e2 = expf(l2 - l1), g1 = gprob / (1.f + e2), g2 = gprob * e2 / (1.f + e2);
            const int ea = gi * 8 + i1, eb = gi * 8 + i2;
            LAS unsigned* lc = (LAS unsigned*)(C.lds + RING_OFF + 110592); LAS unsigned* gb = lc + 64;
            lc[lane] = 0u; asm volatile("" ::: "memory");
            const unsigned la = __hip_atomic_fetch_add(lc + ea, 1u, __ATOMIC_RELAXED, __HIP_MEMORY_SCOPE_WORKGROUP); asm volatile("" ::: "memory");
            const unsigned lb = __hip_atomic_fetch_add(lc + eb, 1u, __ATOMIC_RELAXED, __HIP_MEMORY_SCOPE_WORKGROUP); asm volatile("" ::: "memory");
            const unsigned ne = lc[lane]; unsigned gbase = 0u; if (ne) gbase = atomicAdd(C.cnt + lane * CNT_STRIDE, ne);
            gb[lane] = gbase; asm volatile("" ::: "memory");
            const unsigned pa = gb[ea] + la, pb = gb[eb] + lb;
            C.tok_e[t * 2] = ea; C.tok_e[t * 2 + 1] = eb; C.tok_pos[t * 2] = (int)pa; C.tok_pos[t * 2 + 1] = (int)pb; C.etok[ea * ECAP + (int)pa] = t; C.etok[eb * ECAP + (int)pb] = t; C.tok_gate[t * 2] = g1; C.tok_gate[t * 2 + 1] = g2;
        }
        { asm volatile("" ::: "memory"); f32x4 gg[4][2];
#pragma unroll
            for (int j = 0; j < 4; ++j) { gg[j][0] = *(const f32x4*)(C.ffn_g + j * 512 + lane * 8); gg[j][1] = *(const f32x4*)(C.ffn_g + j * 512 + lane * 8 + 4); }
            const int r0 = w ? 9 * (w - 1) : 63, nr = w ? 9 : 1;
#pragma unroll 3
            for (int i = 0; i < nr; ++i) { const int rr = r0 + i; const float rsr = RS[rr]; const bf16* src = C.H1 + (size_t)(t0 + rr) * DM + lane * 8; bf16* dst = C.A1 + (size_t)(t0 + rr) * DM + lane * 8;
#pragma unroll
                for (int j = 0; j < 4; ++j) { const v4u x = *(const v4u*)(src + j * 512); const f32x4 g0 = gg[j][0], g1 = gg[j][1];
                    v4u o; o.x = pk2(__uint_as_float(x.x << 16) * rsr * g0.x, __uint_as_float(x.x & 0xffff0000u) * rsr * g0.y); o.y = pk2(__uint_as_float(x.y << 16) * rsr * g0.z, __uint_as_float(x.y & 0xffff0000u) * rsr * g0.w);
                    o.z = pk2(__uint_as_float(x.z << 16) * rsr * g1.x, __uint_as_float(x.z & 0xffff0000u) * rsr * g1.y); o.w = pk2(__uint_as_float(x.w << 16) * rsr * g1.z, __uint_as_float(x.w & 0xffff0000u) * rsr * g1.w);
                    *(v4u*)(dst + j * 512) = o; } } }
        __syncthreads();
    }
}
__device__ __forceinline__ void build_seg(const Ctx& C) {
    LAS int* seg = (LAS int*)(C.lds + SEG_OFF); LAS int* tile_e = (LAS int*)(C.lds + TILE_E_OFF);
    if (C.wave == 0) { const unsigned cn = C.cnt[C.lane * CNT_STRIDE]; ((LAS int*)(C.lds + CNTL_OFF))[C.lane] = (int)cn; const int p = (int)((cn + 255u) & ~255u); int inc = p;
#pragma unroll
        for (int o = 1; o < 64; o <<= 1) { const int q = __shfl_up(inc, o); if (C.lane >= o) inc += q; }
        seg[C.lane] = inc - p; if (C.lane == 63) seg[NE] = inc; }
    __syncthreads();
    if (C.tid < NTILE_MAX) { const int row = C.tid * 256; int e = 0; for (int j = 1; j < NE; ++j) if (seg[j] <= row) e = j; tile_e[C.tid] = e; ((LAS int*)(C.lds + TILE_RB_OFF))[C.tid] = e * ECAP - seg[e];
        const int left = ((LAS int*)(C.lds + CNTL_OFF))[e] - (row - seg[e]); ((LAS int*)(C.lds + TILE_NR_OFF))[C.tid] = left < 0 ? 0 : (left > 256 ? 256 : left); }
    __syncthreads();
}
__device__ __forceinline__ void p5b_dispatch(const Ctx& C) {
    const LAS int* seg = (const LAS int*)(C.lds + SEG_OFF);
    for (int t = C.gw * 64 + C.lane; t < M; t += C.NGW * 64) {
        const int ra = seg[C.tok_e[t * 2]] + C.tok_pos[t * 2], rb = seg[C.tok_e[t * 2 + 1]] + C.tok_pos[t * 2 + 1];
        C.rowgate[ra] = C.tok_gate[t * 2]; C.rowgate[rb] = C.tok_gate[t * 2 + 1]; C.rowtok[ra] = t; C.rowtok[rb] = t;
    }
}
__device__ __forceinline__ void p8_final(const Ctx& C) {
    const LAS int* seg = (const LAS int*)(C.lds + SEG_OFF); const int lane = C.lane;
    for (int t0 = C.gw * 2; t0 < M; t0 += C.NGW * 2) {
        int ra[2], rb[2]; float ga[2], gb[2];
#pragma unroll
        for (int u = 0; u < 2; ++u) { const int t = t0 + u; ra[u] = seg[C.tok_e[t * 2]] + C.tok_pos[t * 2]; rb[u] = seg[C.tok_e[t * 2 + 1]] + C.tok_pos[t * 2 + 1]; ga[u] = C.tok_gate[t * 2]; gb[u] = C.tok_gate[t * 2 + 1]; }
        f32x4 v[2][8]; float ss[2] = {0.f, 0.f};
#pragma unroll
        for (int u = 0; u < 2; ++u) { const bf16* xr = C.H1 + (size_t)(t0 + u) * DM; const bf16* ya = C.Y + (size_t)ra[u] * DM; const bf16* yb = C.Y + (size_t)rb[u] * DM;
#pragma unroll
            for (int j = 0; j < 8; ++j) { const v2u h = *(const v2u*)(xr + j * 256 + lane * 4), a = *(const v2u*)(ya + j * 256 + lane * 4), b = *(const v2u*)(yb + j * 256 + lane * 4);
                v[u][j].x = __uint_as_float(h.x << 16) + (ga[u] * __uint_as_float(a.x << 16) + gb[u] * __uint_as_float(b.x << 16)); v[u][j].y = __uint_as_float(h.x & 0xffff0000u) + (ga[u] * __uint_as_float(a.x & 0xffff0000u) + gb[u] * __uint_as_float(b.x & 0xffff0000u));
                v[u][j].z = __uint_as_float(h.y << 16) + (ga[u] * __uint_as_float(a.y << 16) + gb[u] * __uint_as_float(b.y << 16)); v[u][j].w = __uint_as_float(h.y & 0xffff0000u) + (ga[u] * __uint_as_float(a.y & 0xffff0000u) + gb[u] * __uint_as_float(b.y & 0xffff0000u));
                ss[u] += (v[u][j].x * v[u][j].x + v[u][j].y * v[u][j].y) + (v[u][j].z * v[u][j].z + v[u][j].w * v[u][j].w); } }
#pragma unroll
        for (int u = 0; u < 2; ++u) { const float r = 1.f / sqrtf(wave_sum(ss[u]) * (1.f / DM) + 1e-6f);
#pragma unroll
            for (int j = 0; j < 8; ++j) *(f32x4*)(C.out + (size_t)(t0 + u) * DM + j * 256 + lane * 4) = v[u][j] * r * *(const f32x4*)(C.fin_g + j * 256 + lane * 4); }
    }
}

__global__ void __launch_bounds__(NWAVES * 64, 2) mk_fwd(Args args) {
    extern __shared__ __attribute__((aligned(16))) unsigned char lds[];
    Ctx C;
    C.lds = (LAS unsigned char*)lds; C.tid = threadIdx.x; C.lane = C.tid & 63; C.wave = __builtin_amdgcn_readfirstlane(C.tid >> 6);
    C.G = gridDim.x; C.gw = (int)blockIdx.x * NWAVES + C.wave; C.NGW = C.G * NWAVES;
    C.x = args.in[0]; C.attn_g = args.in[1]; C.w_in = args.in[2]; C.fbias = args.in[3]; C.lq1 = args.in[4]; C.lk1 = args.in[5]; C.lq2 = args.in[6]; C.lk2 = args.in[7];
    C.subg = args.in[8]; C.w_out = args.in[9]; C.ffn_g = args.in[10]; C.wg = args.in[11]; C.bg = args.in[12]; C.we = args.in[13]; C.be = args.in[14];
    C.wgate = args.in[15]; C.wup = args.in[16]; C.wdown = args.in[17]; C.fin_g = args.in[18]; C.out = args.out;
    unsigned char* ws = args.ws;
    C.A1 = (bf16*)(ws + WS_A1); C.WIN = (bf16*)(ws + WS_WIN); C.WOUT = (bf16*)(ws + WS_WOUT); C.BIAS = (float*)(ws + WS_BIAS); C.QKV = (bf16*)(ws + WS_QKV);
    C.A2 = (bf16*)(ws + WS_A2); C.DT = (bf16*)(ws + WS_DT); C.H1 = (bf16*)(ws + WS_H1);
    C.tok_e = (int*)(ws + WS_ROUTE); C.tok_pos = C.tok_e + 2 * M; C.tok_gate = (float*)(C.tok_pos + 2 * M); C.rstd = C.tok_gate + 2 * M; C.rowgate = C.rstd + M; C.rowtok = (int*)(C.rowgate + YROWS);
    C.etok = (int*)(ws + WS_XG); C.egate = (float*)(ws + WS_XG) + (size_t)NE * ECAP;
    C.WR = (float*)(ws + WS_WR); C.XG = (bf16*)(ws + WS_XG); C.HB = (bf16*)(ws + WS_HBUF); C.Y = (bf16*)(ws + WS_Y); C.WGU = (bf16*)(ws + WS_WGU); C.WD = (bf16*)(ws + WS_WD);
    C.cnt = (unsigned*)(ws + WS_CTL) + CW_CNT; C.nrm = (unsigned*)(ws + WS_CTL) + CW_NRM;
    volatile LAS unsigned* MISC = (volatile LAS unsigned*)(C.lds + MISC_OFF);
    for (int u = C.tid; u < (LDS_BYTES - LDSCTL_OFF) / 4; u += NWAVES * 64) ((LAS unsigned*)(C.lds + LDSCTL_OFF))[u] = 0u;
    __syncthreads();
    XcdBarrier bar = xcd_barrier_post((unsigned*)(ws + WS_CTL) + CW_BAR + args.li * XCD_BAR_WORDS, MISC + 8);
    const int lo = args.ph_lo, hi = args.ph_hi;
#define IN(k) (lo <= (k) && (k) < hi)
#define SEAM(k) do { if (IN(k) && IN((k) + 1)) xcd_barrier(bar); } while (0)
#ifndef PROBE_MASK
#define PROBE_MASK 0u
#endif
#ifndef PROBE_REP
#define PROBE_REP 0
#endif
#define TWICE(k) (((PROBE_MASK) >> (k)) & 1u)
#ifdef PROBE_TS
    volatile LAS unsigned long long* TSW = (volatile LAS unsigned long long*)(C.lds + LDSCTL_OFF + 15360);
#define TS(k) do { if (blockIdx.x == 0 && C.tid == 0) TSW[k] = __builtin_amdgcn_s_memrealtime(); } while (0)
#else
#define TS(k) do { } while (0)
#endif
    TS(0);

    if (IN(0)) { p0_prologue(C); if (TWICE(0)) { xcd_barrier(bar); p0_prologue(C); } } SEAM(0); TS(1);
    if (IN(1)) {
        p1_cumsum(C);
        pg8::Gemm g{C.A1, C.WIN, M, NQKV, DM}; pg8::StaticOrder So; So.init(M, NQKV, C.G, (int)blockIdx.x);
        pg8::EpiQKV E{C.QKV, NQKV, (PG8_LAS float*)(C.lds + NRMP_OFF), C.nrm};
        pg8::gemm_phase<pg8::EpiQKV, pg8::StaticOrder, true, true>(C.lds + RING_OFF, g, So, E);
        if (TWICE(1)) { xcd_barrier(bar); pg8::gemm_phase<pg8::EpiQKV, pg8::StaticOrder, true, true>(C.lds + RING_OFF, g, So, E); }
    } SEAM(1); TS(2);
    if (IN(3)) { const att::Tensors T{(const att::bf16*)C.QKV, (att::bf16*)C.A2, (att::bf16*)C.DT, C.BIAS, C.nrm};
        unsigned* qh = (unsigned*)(ws + WS_CTL) + CW_QHEAD; volatile __attribute__((address_space(3))) int* qw = (volatile __attribute__((address_space(3))) int*)(C.lds + RING_OFF + ATT_QW_OFF);
        att::attn_part<false>((char*)lds + RING_OFF, T, qh, qw); TS(3); att::attn_part<true>((char*)lds + RING_OFF, T, qh + 64, qw); if (TWICE(3)) { xcd_barrier(bar); att::attn_part<false>((char*)lds + RING_OFF, T, qh + 128, qw); att::attn_part<true>((char*)lds + RING_OFF, T, qh + 192, qw); } } SEAM(3); TS(4);
    if (IN(4)) { p3_combine(C); if (TWICE(4)) { xcd_barrier(bar); p3_combine(C); } } SEAM(4); TS(5);
    if (IN(5)) {
        pg8::Gemm g{C.A2, C.WOUT, M, DM, DM}; pg8::StaticOrder So; So.init(M, DM, C.G, (int)blockIdx.x);
        pg8::EpiResBf16 E{C.x, C.H1, DM};
        pg8::gemm_phase<pg8::EpiResBf16, pg8::StaticOrder, true, true>(C.lds + RING_OFF, g, So, E);
        if (TWICE(5)) { xcd_barrier(bar); pg8::gemm_phase<pg8::EpiResBf16, pg8::StaticOrder, true, true>(C.lds + RING_OFF, g, So, E); }
    } SEAM(5); TS(6);
    if (IN(6)) { if (blockIdx.x == 0) ((v4u*)C.WIN)[C.tid] = (v4u){0u, 0u, 0u, 0u};
        p5a_router(C); } SEAM(6); TS(7);
#ifdef PROBE_IDLE
    { const unsigned long long t0 = __builtin_amdgcn_s_memrealtime(); while (__builtin_amdgcn_s_memrealtime() - t0 < (unsigned long long)(PROBE_IDLE) * 100ull) __builtin_amdgcn_s_sleep(32); }
#endif
    if (hi > 7) build_seg(C);
#ifdef PROBE_CLK
    unsigned long long ck0 = 0, cr0 = 0, ckd = 0, crd = 1;
    if (IN(PROBE_CLK)) { ck0 = __builtin_amdgcn_s_memtime(); cr0 = __builtin_amdgcn_s_memrealtime(); }
#endif
    if (IN(8)) {
        const PG8_LAS int* tile_e = (const PG8_LAS int*)(C.lds + TILE_E_OFF); const int ntile = ((const LAS int*)(C.lds + SEG_OFF))[NE] >> 8;
        #if defined(PROBE_HOT) && PROBE_HOT >= 3
        pg8::GemmW g{C.A1, DM, DFF, C.etok, args.li > 0 ? 255 : M - 1, (const PG8_LAS int*)(C.lds + TILE_RB_OFF)};
#else
        pg8::GemmW g{C.A1, DM, DFF, C.etok, M - 1, (const PG8_LAS int*)(C.lds + TILE_RB_OFF)};
#endif
        pg8::GroupedOrderW<0> So{ntile * 8, C.G, (int)blockIdx.x, tile_e, C.wgate, C.wup, args.li > 0};
        pg8::EpiSwiglu E{args.li > 0 ? C.XG : C.HB};
        pg8::gemm_phase_wf32<pg8::EpiSwiglu, pg8::GroupedOrderW<0>, true, true>(C.lds + RING_OFF, g, So, E);
    } SEAM(8); TS(8);
    if (IN(9)) {
        const PG8_LAS int* tile_e = (const PG8_LAS int*)(C.lds + TILE_E_OFF); const int ntile = ((const LAS int*)(C.lds + SEG_OFF))[NE] >> 8;
        pg8::GemmW g{C.HB, DFF, DM, nullptr, 0, nullptr}; pg8::GroupedOrderW<1> So{ntile * 8, C.G, (int)blockIdx.x, tile_e, C.wdown, nullptr};
        pg8::EpiDown E{C.Y};
        pg8::gemm_phase_wf32<pg8::EpiDown, pg8::GroupedOrderW<1>, true, false>(C.lds + RING_OFF, g, So, E);
    } SEAM(9); TS(9);
#ifdef PROBE_CLK
    if (IN(PROBE_CLK)) { ckd = __builtin_amdgcn_s_memtime() - ck0; crd = __builtin_amdgcn_s_memrealtime() - cr0; }
#endif
    if (IN(10)) { p8_final(C); if (TWICE(10)) { xcd_barrier(bar); p8_final(C); } }
#ifdef PROBE_CLK
    if (blockIdx.x == 0) { const unsigned long long want = ckd * 100ull / (crd ? crd : 1);
        const unsigned long long t0 = __builtin_amdgcn_s_memrealtime(); while (__builtin_amdgcn_s_memrealtime() - t0 < want) __builtin_amdgcn_s_sleep(8); }
#endif
#ifdef PROBE_TS
    if (blockIdx.x == 0 && C.tid == 0) { const unsigned long long dA = TSW[(PROBE_TS >> 4) & 15] - TSW[(PROBE_TS >> 8) & 15], dB = TSW[PROBE_TS & 15] - TSW[(PROBE_TS >> 12) & 15];
        const unsigned long long want = ((dA + 1000ull) / 2000ull) * 100000ull + dB;
        const unsigned long long t0 = __builtin_amdgcn_s_memrealtime(); while (__builtin_amdgcn_s_memrealtime() - t0 < want) __builtin_amdgcn_s_sleep(8); }
#endif
#ifdef PROBE_NT
    if (blockIdx.x == 0) { const int ntile_ = ((const LAS int*)(C.lds + SEG_OFF))[NE] >> 8; const unsigned long long want = (unsigned long long)(ntile_ > 150 ? ntile_ - 150 : 0) * 2000ull;
        const unsigned long long t0 = __builtin_amdgcn_s_memrealtime(); while (__builtin_amdgcn_s_memrealtime() - t0 < want) __builtin_amdgcn_s_sleep(8); }
#endif
#ifdef PROF_SECT
    if (blockIdx.x == 0) { __syncthreads(); const unsigned want = ((volatile LAS unsigned*)(C.lds + ATT_QW_OFF + 32))[0]; const unsigned long long t0 = __builtin_amdgcn_s_memtime(); while (__builtin_amdgcn_s_memtime() - t0 < (unsigned long long)want) __builtin_amdgcn_s_sleep(8); }
#endif
#undef IN
#undef SEAM
#undef TWICE
}

#if NAIVE_MASK
namespace nv {
__device__ __forceinline__ float bf2f(bf16_t v) { return __uint_as_float((unsigned)v << 16); }
__device__ __forceinline__ bf16_t f2b(float f) { return (bf16_t)f2bf(f); }
__global__ void __launch_bounds__(256) k_cumsum(float* __restrict__ bias) {
    __shared__ float part[256];
    float* p = bias + (size_t)blockIdx.x * S; const int tid = threadIdx.x;
    float loc[32]; float s = 0.f;
#pragma unroll
    for (int i = 0; i < 32; ++i) { s += p[tid * 32 + i]; loc[i] = s; }
    part[tid] = s; __syncthreads();
    if (tid == 0) { float a = 0.f; for (int i = 0; i < 256; ++i) { const float q = part[i]; part[i] = a; a += q; } }
    __syncthreads();
    const float base = part[tid];
#pragma unroll
    for (int i = 0; i < 32; ++i) p[tid * 32 + i] = (base + loc[i]) * ATT_ISCALE;
}
template <class FA, class FB>
__device__ __forceinline__ void ngemm_tile(int K, FA fa, FB fb, float (&acc)[4][4], float (*As)[65], float (*Bs)[65]) {
    const int tid = threadIdx.x, tx = tid & 15, ty = tid >> 4;
#pragma unroll
    for (int r = 0; r < 4; ++r)
#pragma unroll
        for (int c = 0; c < 4; ++c) acc[r][c] = 0.f;
    for (int k0 = 0; k0 < K; k0 += 16) {
        for (int e = tid; e < 1024; e += 256) { const int i = e >> 4, kk = e & 15; As[kk][i] = fa(i, k0 + kk); Bs[kk][i] = fb(k0 + kk, i); }
        __syncthreads();
#pragma unroll
        for (int kk = 0; kk < 16; ++kk) { float a[4], b[4];
#pragma unroll
            for (int r = 0; r < 4; ++r) a[r] = As[kk][ty * 4 + r];
#pragma unroll
            for (int c = 0; c < 4; ++c) b[c] = Bs[kk][tx * 4 + c];
#pragma unroll
            for (int r = 0; r < 4; ++r)
#pragma unroll
                for (int c = 0; c < 4; ++c) acc[r][c] += a[r] * b[c]; }
        __syncthreads();
    }
}
__global__ void __launch_bounds__(256) k_inproj(const bf16_t* __restrict__ A, const bf16_t* __restrict__ Bt, bf16_t* __restrict__ Cq) {
    __shared__ float As[16][65], Bs[16][65];
    const int m0 = blockIdx.y * 64, n0 = blockIdx.x * 64; float acc[4][4];
    ngemm_tile(DM, [&](int i, int k) { return bf2f(A[(size_t)(m0 + i) * DM + k]); }, [&](int k, int j) { return bf2f(Bt[(size_t)(n0 + j) * DM + k]); }, acc, As, Bs);
    const int tx = threadIdx.x & 15, ty = threadIdx.x >> 4;
#pragma unroll
    for (int r = 0; r < 4; ++r)
#pragma unroll
        for (int c = 0; c < 4; ++c) Cq[(size_t)(m0 + ty * 4 + r) * NQKV + n0 + tx * 4 + c] = f2b(acc[r][c]);
}
__global__ void __launch_bounds__(256) k_outproj(const bf16_t* __restrict__ A, const bf16_t* __restrict__ Bt, const float* __restrict__ x, float* __restrict__ H1) {
    __shared__ float As[16][65], Bs[16][65];
    const int m0 = blockIdx.y * 64, n0 = blockIdx.x * 64; float acc[4][4];
    ngemm_tile(DM, [&](int i, int k) { return bf2f(A[(size_t)(m0 + i) * DM + k]); }, [&](int k, int j) { return bf2f(Bt[(size_t)(n0 + j) * DM + k]); }, acc, As, Bs);
    const int tx = threadIdx.x & 15, ty = threadIdx.x >> 4;
#pragma unroll
    for (int r = 0; r < 4; ++r)
#pragma unroll
        for (int c = 0; c < 4; ++c) { const size_t o = (size_t)(m0 + ty * 4 + r) * DM + n0 + tx * 4 + c; H1[o] = x[o] + acc[r][c]; }
}
__global__ void __launch_bounds__(256) k_attn(const bf16_t* __restrict__ QKV, const float* __restrict__ bias, bf16_t* __restrict__ A2, bf16_t* __restrict__ DT) {
    __shared__ bf16_t Qs[64][130];
    __shared__ float Ks[32][129];
    __shared__ float Vs[32][128];
    __shared__ float Ps[64][33];
    const int tid = threadIdx.x, r = tid >> 2, c4 = tid & 3;
    const int qb = (int)gridDim.x - 1 - (int)blockIdx.x, p = blockIdx.y;
    int b, qcol, kcol, vcol, h, map = 0, vh = 0; const float* cc; const bool fox = p < 16;
    if (fox) { b = p >> 3; h = p & 7; qcol = C_FQ + h * 128; kcol = C_FK + h * 128; vcol = C_FV + h * 128; cc = bias + ((size_t)b * 8 + h) * S; }
    else { const int q = p - 16; b = q >> 4; h = (q >> 2) & 3; map = (q >> 1) & 1; vh = q & 1; qcol = C_DQ + h * 256 + map * 128; kcol = C_DK + h * 256 + map * 128; vcol = C_DV + h * 256 + vh * 128; cc = bias + (size_t)(16 + h) * S; }
    const int q0 = qb * 64; const size_t rowb = (size_t)b * S;
    for (int e = tid; e < 64 * 128; e += 256) { const int i = e >> 7, d = e & 127; Qs[i][d] = QKV[(rowb + q0 + i) * NQKV + qcol + d]; }
    const int t = q0 + r; const float ct = cc[t];
    float m = -1e30f, l = 0.f; float o[32];
#pragma unroll
    for (int j = 0; j < 32; ++j) o[j] = 0.f;
    const int nkt = (q0 + 63) / 32 + 1;
    for (int kt = 0; kt < nkt; ++kt) {
        const int k0 = kt * 32;
        __syncthreads();
        for (int e = tid; e < 32 * 128; e += 256) { const int i = e >> 7, d = e & 127; const size_t ro = (rowb + k0 + i) * NQKV; Ks[i][d] = bf2f(QKV[ro + kcol + d]); Vs[i][d] = bf2f(QKV[ro + vcol + d]); }
        __syncthreads();
        float sc[8];
#pragma unroll
        for (int j = 0; j < 8; ++j) sc[j] = 0.f;
        for (int d = 0; d < 128; ++d) { const float qv = bf2f(Qs[r][d]);
#pragma unroll
            for (int j = 0; j < 8; ++j) sc[j] += qv * Ks[c4 * 8 + j][d]; }
        float tmax = -__builtin_inff();
#pragma unroll
        for (int j = 0; j < 8; ++j) { const int s = k0 + c4 * 8 + j; float v = (sc[j] + (ct - cc[s])) * ATT_SCALE;
            if (s > t) v = -__builtin_inff();
            sc[j] = v; tmax = fmaxf(tmax, v); }
        tmax = fmaxf(tmax, __shfl_xor(tmax, 1)); tmax = fmaxf(tmax, __shfl_xor(tmax, 2));
        const float mn = fmaxf(m, tmax), alpha = __expf(m - mn); m = mn;
        float ps = 0.f;
#pragma unroll
        for (int j = 0; j < 8; ++j) { const float pv = __expf(sc[j] - mn); ps += pv; Ps[r][c4 * 8 + j] = pv; }
        ps += __shfl_xor(ps, 1); ps += __shfl_xor(ps, 2);
        l = l * alpha + ps;
        __syncthreads();
#pragma unroll
        for (int j = 0; j < 32; ++j) o[j] *= alpha;
        for (int kk = 0; kk < 32; ++kk) { const float pv = Ps[r][kk];
#pragma unroll
            for (int j = 0; j < 32; ++j) o[j] += pv * Vs[kk][c4 + 4 * j]; }
    }
    const float il = 1.f / l;
    bf16_t* op = fox ? A2 + (rowb + t) * DM + h * 128 : DT + (rowb + t) * DM + h * 512 + map * 256 + vh * 128;
#pragma unroll
    for (int j = 0; j < 32; ++j) op[c4 + 4 * j] = f2b(o[j] * il);
}
__global__ void __launch_bounds__(256) k_diff_combine(const bf16_t* __restrict__ DT, const float* __restrict__ lq1, const float* __restrict__ lk1, const float* __restrict__ lq2,
                                                      const float* __restrict__ lk2, const float* __restrict__ sg, bf16_t* __restrict__ A2) {
    const int lane = threadIdx.x & 63, wv = threadIdx.x >> 6;
    const int idx = blockIdx.x * 4 + wv, t = idx >> 2, h = idx & 3;
    const float s1 = wave_sum(lq1[lane] * lk1[lane] + lq1[lane + 64] * lk1[lane + 64]);
    const float s2 = wave_sum(lq2[lane] * lk2[lane] + lq2[lane + 64] * lk2[lane + 64]);
    const float lam = expf(s1) - expf(s2) + 0.2f;
    const bf16_t* p = DT + (size_t)t * DM + h * 512;
    float d[4]; float ss = 0.f;
#pragma unroll
    for (int c = 0; c < 4; ++c) { d[c] = bf2f(p[lane * 4 + c]) - lam * bf2f(p[256 + lane * 4 + c]); ss += d[c] * d[c]; }
    ss = wave_sum(ss);
    const float r = rsqrtf(ss * (1.f / 256.f) + 1e-5f) * 0.8f;
    bf16_t* o = A2 + (size_t)t * DM + 1024 + h * 256 + lane * 4;
#pragma unroll
    for (int c = 0; c < 4; ++c) o[c] = f2b(d[c] * r * sg[lane * 4 + c]);
}
__global__ void __launch_bounds__(256) k_route(const float* __restrict__ H1, const float* __restrict__ g, const float* __restrict__ wg, const float* __restrict__ bg,
                                               const float* __restrict__ we, const float* __restrict__ be, int* __restrict__ tok_e, int* __restrict__ tok_pos,
                                               float* __restrict__ tok_gate, float* __restrict__ rstd, unsigned* __restrict__ cnt) {
    __shared__ float xs[4][DM];
    const int lane = threadIdx.x & 63, wv = threadIdx.x >> 6;
    const int t = blockIdx.x * 4 + wv;
    const float* xr = H1 + (size_t)t * DM;
    f32x4 v[8]; float ss = 0.f;
#pragma unroll
    for (int j = 0; j < 8; ++j) { v[j] = *(const f32x4*)(xr + j * 256 + lane * 4); ss += v[j].x * v[j].x + v[j].y * v[j].y + v[j].z * v[j].z + v[j].w * v[j].w; }
    ss = wave_sum(ss);
    const float r = 1.f / sqrtf(ss * (1.f / DM) + 1e-6f);
#pragma unroll
    for (int j = 0; j < 8; ++j) { const f32x4 gg = *(const f32x4*)(g + j * 256 + lane * 4); *(f32x4*)(&xs[wv][j * 256 + lane * 4]) = v[j] * r * gg; }
    __syncthreads();
    float el = 0.f;
    for (int k = 0; k < DM; ++k) el += xs[wv][k] * we[(size_t)k * NE + lane];
    el += be[lane];
    float gl = 0.f;
    for (int k = (lane >> 3); k < DM; k += 8) gl += xs[wv][k] * wg[(size_t)k * 8 + (lane & 7)];
    gl += __shfl_xor(gl, 8); gl += __shfl_xor(gl, 16); gl += __shfl_xor(gl, 32);
    gl += bg[lane & 7];
    float gmax = -__builtin_inff(); int gi = 0;
#pragma unroll
    for (int j = 0; j < 8; ++j) { const float q = __shfl(gl, j); if (q > gmax) { gmax = q; gi = j; } }
    float gs = 0.f;
#pragma unroll
    for (int j = 0; j < 8; ++j) gs += expf(__shfl(gl, j) - gmax);
    const float gprob = 1.f / gs;
    float l1 = -__builtin_inff(), l2 = -__builtin_inff(); int i1 = 0, i2 = 0;
#pragma unroll
    for (int j = 0; j < 8; ++j) { const float q = __shfl(el, gi * 8 + j);
        if (q > l1) { l2 = l1; i2 = i1; l1 = q; i1 = j; } else if (q > l2) { l2 = q; i2 = j; } }
    const float e2 = expf(l2 - l1), g1 = gprob / (1.f + e2), g2 = gprob * e2 / (1.f + e2);
    if (lane == 0) {
        const int ea = gi * 8 + i1, eb = gi * 8 + i2;
        const unsigned pa = atomicAdd(cnt + ea, 1u), pb = atomicAdd(cnt + eb, 1u);
        tok_e[t * 2] = ea; tok_e[t * 2 + 1] = eb; tok_pos[t * 2] = (int)pa; tok_pos[t * 2 + 1] = (int)pb; tok_gate[t * 2] = g1; tok_gate[t * 2 + 1] = g2; rstd[t] = r;
    }
}
__device__ __forceinline__ int seg_off(const unsigned* cnt, int e) { int o = 0; for (int i = 0; i < e; ++i) o += (int)((cnt[i] + 255u) & ~255u); return o; }
__global__ void __launch_bounds__(256) k_dispatch(const float* __restrict__ H1, const float* __restrict__ g, const float* __restrict__ rstd, const int* __restrict__ tok_e,
                                                  const int* __restrict__ tok_pos, const float* __restrict__ tok_gate, const unsigned* __restrict__ cnt, bf16_t* __restrict__ XG, float* __restrict__ rowgate) {
    const int lane = threadIdx.x & 63, wv = threadIdx.x >> 6; const int t = blockIdx.x * 4 + wv;
    const int ra = seg_off(cnt, tok_e[t * 2]) + tok_pos[t * 2], rb = seg_off(cnt, tok_e[t * 2 + 1]) + tok_pos[t * 2 + 1];
    const float rs = rstd[t];
    for (int k = lane; k < DM; k += 64) { const bf16_t v = f2b(H1[(size_t)t * DM + k] * rs * g[k]); XG[(size_t)ra * DM + k] = v; XG[(size_t)rb * DM + k] = v; }
    if (lane == 0) { rowgate[ra] = tok_gate[t * 2]; rowgate[rb] = tok_gate[t * 2 + 1]; }
}
__global__ void __launch_bounds__(256) k_moe_up(const bf16_t* __restrict__ XG, const bf16_t* __restrict__ WGU, const unsigned* __restrict__ cnt, bf16_t* __restrict__ HB) {
    __shared__ float As[16][65], Bs[16][65];
    const int m0 = blockIdx.y * 64, n0 = blockIdx.x * 64;
    int e = 0, tot = 0; { int o = 0; for (int i = 0; i < NE; ++i) { if (o <= m0) e = i; o += (int)((cnt[i] + 255u) & ~255u); } tot = o; }
    if (m0 >= tot) return;
    const bf16_t* W = WGU + (size_t)e * 2048 * DM; const int rg = 256 * (n0 >> 7) + (n0 & 127), ru = rg + 128;
    float ag[4][4], au[4][4];
    ngemm_tile(DM, [&](int i, int k) { return bf2f(XG[(size_t)(m0 + i) * DM + k]); }, [&](int k, int j) { return bf2f(W[(size_t)(rg + j) * DM + k]); }, ag, As, Bs);
    ngemm_tile(DM, [&](int i, int k) { return bf2f(XG[(size_t)(m0 + i) * DM + k]); }, [&](int k, int j) { return bf2f(W[(size_t)(ru + j) * DM + k]); }, au, As, Bs);
    const int tx = threadIdx.x & 15, ty = threadIdx.x >> 4;
#pragma unroll
    for (int r = 0; r < 4; ++r)
#pragma unroll
        for (int c = 0; c < 4; ++c) { const float gv = ag[r][c]; HB[(size_t)(m0 + ty * 4 + r) * DFF + n0 + tx * 4 + c] = f2b(gv / (1.f + expf(-gv)) * au[r][c]); }
}
__global__ void __launch_bounds__(256) k_moe_down(const bf16_t* __restrict__ HB, const bf16_t* __restrict__ WD, const unsigned* __restrict__ cnt, const float* __restrict__ rowgate, bf16_t* __restrict__ Y) {
    __shared__ float As[16][65], Bs[16][65];
    const int m0 = blockIdx.y * 64, n0 = blockIdx.x * 64;
    int e = 0, tot = 0; { int o = 0; for (int i = 0; i < NE; ++i) { if (o <= m0) e = i; o += (int)((cnt[i] + 255u) & ~255u); } tot = o; }
    if (m0 >= tot) return;
    const bf16_t* W = WD + (size_t)e * DM * DFF; float acc[4][4];
    ngemm_tile(DFF, [&](int i, int k) { return bf2f(HB[(size_t)(m0 + i) * DFF + k]); }, [&](int k, int j) { return bf2f(W[(size_t)(n0 + j) * DFF + k]); }, acc, As, Bs);
    const int tx = threadIdx.x & 15, ty = threadIdx.x >> 4;
#pragma unroll
    for (int r = 0; r < 4; ++r) { const int row = m0 + ty * 4 + r; const float gt = rowgate[row];
#pragma unroll
        for (int c = 0; c < 4; ++c) Y[(size_t)row * DM + n0 + tx * 4 + c] = f2b(acc[r][c] * gt); }
}
__global__ void __launch_bounds__(256) k_final(const float* __restrict__ H1, const bf16_t* __restrict__ Y, const unsigned* __restrict__ cnt, const int* __restrict__ tok_e,
                                               const int* __restrict__ tok_pos, const float* __restrict__ g, float* __restrict__ out) {
    const int lane = threadIdx.x & 63, wv = threadIdx.x >> 6; const int t = blockIdx.x * 4 + wv;
    const int ra = seg_off(cnt, tok_e[t * 2]) + tok_pos[t * 2], rb = seg_off(cnt, tok_e[t * 2 + 1]) + tok_pos[t * 2 + 1];
    float v[32]; float ss = 0.f;
#pragma unroll
    for (int i = 0; i < 32; ++i) { const int k = lane + 64 * i; v[i] = H1[(size_t)t * DM + k] + bf2f(Y[(size_t)ra * DM + k]) + bf2f(Y[(size_t)rb * DM + k]); ss += v[i] * v[i]; }
    ss = wave_sum(ss);
    const float r = 1.f / sqrtf(ss * (1.f / DM) + 1e-6f);
#pragma unroll
    for (int i = 0; i < 32; ++i) { const int k = lane + 64 * i; out[(size_t)t * DM + k] = v[i] * r * g[k]; }
}
}
static void naive_phase(int k, const Args& a, hipStream_t stream) {
    unsigned char* ws = a.ws;
    bf16_t* A1 = (bf16_t*)(ws + WS_A1); bf16_t* WIN = (bf16_t*)(ws + WS_WIN); bf16_t* WOUT = (bf16_t*)(ws + WS_WOUT); float* BIAS = (float*)(ws + WS_BIAS); bf16_t* QKV = (bf16_t*)(ws + WS_QKV);
    bf16_t* A2 = (bf16_t*)(ws + WS_A2); bf16_t* DT = (bf16_t*)(ws + WS_DT); float* H1 = (float*)(ws + WS_H1);
    int* tok_e = (int*)(ws + WS_ROUTE); int* tok_pos = tok_e + 2 * M; float* tok_gate = (float*)(tok_pos + 2 * M); float* rstd = tok_gate + 2 * M; float* rowgate = rstd + M;
    bf16_t* XG = (bf16_t*)(ws + WS_XG); bf16_t* HB = (bf16_t*)(ws + WS_HBUF); bf16_t* Y = (bf16_t*)(ws + WS_Y); bf16_t* WGU = (bf16_t*)(ws + WS_WGU); bf16_t* WD = (bf16_t*)(ws + WS_WD);
    unsigned* cnt = (unsigned*)(ws + WS_CTL) + CW_CNT;
    switch (k) {
    case 1: nv::k_cumsum<<<16, 256, 0, stream>>>(BIAS); nv::k_inproj<<<dim3(NQKV / 64, M / 64), 256, 0, stream>>>(A1, WIN, QKV); break;
    case 3: nv::k_attn<<<dim3(S / 64, 48), 256, 0, stream>>>(QKV, BIAS, A2, DT); break;
    case 4: nv::k_diff_combine<<<M, 256, 0, stream>>>(DT, a.in[4], a.in[5], a.in[6], a.in[7], a.in[8], A2); break;
    case 5: nv::k_outproj<<<dim3(DM / 64, M / 64), 256, 0, stream>>>(A2, WOUT, a.in[0], H1); break;
    case 6: nv::k_route<<<M / 4, 256, 0, stream>>>(H1, a.in[10], a.in[11], a.in[12], a.in[13], a.in[14], tok_e, tok_pos, tok_gate, rstd, cnt); break;
    case 7: nv::k_dispatch<<<M / 4, 256, 0, stream>>>(H1, a.in[10], rstd, tok_e, tok_pos, tok_gate, cnt, XG, rowgate); break;
    case 8: nv::k_moe_up<<<dim3(DFF / 64, YROWS / 64), 256, 0, stream>>>(XG, WGU, cnt, HB); break;
    case 9: nv::k_moe_down<<<dim3(DM / 64, YROWS / 64), 256, 0, stream>>>(HB, WD, cnt, rowgate, Y); break;
    case 10: nv::k_final<<<M / 4, 256, 0, stream>>>(H1, Y, cnt, tok_e, tok_pos, a.in[18], a.out); break;
    default: break;
    }
}
#endif


extern "C" void kernel_launch(void* const* d_in, const int* in_sizes, int n_in, void* d_out, int out_size, void* d_ws, size_t ws_size, hipStream_t stream) {
    static int grid = 0;
    if (grid == 0) {
        if (n_in != 19 || in_sizes[0] != M * DM || out_size != M * DM || ws_size < WS_END) {
            fprintf(stderr, "kernel_launch: built for 19 inputs, x and out of %d floats, >= %zu bytes of workspace; got n_in %d, in0 %d, out %d, ws %zu; nothing launched\n", M * DM, (size_t)WS_END, n_in, n_in > 0 ? in_sizes[0] : -1, out_size, ws_size); grid = -1; return; }
        int dev = 0, cus = 0, per_cu = 0;
        if (hipGetDevice(&dev) != hipSuccess || hipDeviceGetAttribute(&cus, hipDeviceAttributeMultiprocessorCount, dev) != hipSuccess) { fprintf(stderr, "kernel_launch: device query failed\n"); grid = -1; return; }
        if (hipFuncSetAttribute((const void*)mk_fwd, hipFuncAttributeMaxDynamicSharedMemorySize, LDS_BYTES) != hipSuccess) { fprintf(stderr, "kernel_launch: hipFuncSetAttribute failed\n"); grid = -1; return; }
        if (hipOccupancyMaxActiveBlocksPerMultiprocessor(&per_cu, (const void*)mk_fwd, NWAVES * 64, LDS_BYTES) != hipSuccess || per_cu < 1)
            fprintf(stderr, "kernel_launch: note: occupancy query reports %d workgroups per CU\n", per_cu);
        (void)hipGetLastError();
        grid = cus;
    }
    if (grid < 0) return;
    if (hipMemsetAsync((char*)d_ws + WS_CTL, 0, CTL_ZERO_BYTES, stream) != hipSuccess) { fprintf(stderr, "kernel_launch: memset failed\n"); return; }
    Args a{};
    for (int i = 0; i < 19; ++i) a.in[i] = (const float*)d_in[i];
    a.out = (float*)d_out; a.ws = (unsigned char*)d_ws;
    int k = 0, li = 0;
    while (k < NPHASE) {
#if NAIVE_MASK
        if (k > 0 && ((NAIVE_MASK >> k) & 1u)) { naive_phase(k, a, stream); ++k; continue; }
#endif
        const int lo = k; ++k;
        while (k < NPHASE && !((NAIVE_MASK >> k) & 1u)) ++k;
        a.ph_lo = lo; a.ph_hi = k; a.li = li++;
        hipLaunchKernelGGL(mk_fwd, dim3(grid), dim3(NWAVES * 64), LDS_BYTES, stream, a);
        const hipError_t le = hipPeekAtLastError();
        if (le != hipSuccess) { fprintf(stderr, "kernel_launch: launch failed: %s\n", hipGetErrorName(le)); break; }
    }
#if PROBE_REP
    a.ph_lo = PROBE_REP; a.ph_hi = PROBE_REP + 1; a.li = li++;
    hipLaunchKernelGGL(mk_fwd, dim3(grid), dim3(NWAVES * 64), LDS_BYTES, stream, a);
#endif
}
```

```cpp
#include <hip/hip_runtime.h>
#include <hip/hip_bf16.h>
#include <cstdio>
#include <cstdint>
#include <cmath>

#ifndef NAIVE_MASK
#define NAIVE_MASK 0u
#endif

typedef unsigned short bf16_t;
constexpr int NB = 2, S = 8192, DM = 2048, M = NB * S;
constexpr int NCOL = 6152, NQKV = 6144;
constexpr int FCOL = 3072;
constexpr int NE = 64, DFF = 1024;
constexpr int YROWS = 49152, NTILE_MAX = YROWS / 256;
constexpr int C_FQ = 0, C_FK = 1024, C_FV = 2048, C_DQ = 3072, C_DK = 4096, C_DV = 5120;
constexpr float ATT_SCALE = 0.08838834764831845f, ATT_ISCALE = 11.313708498984761f;
constexpr int NPHASE = 11;

constexpr size_t MiB = 1u << 20;
constexpr size_t WS_CTL = 0, CTL_ZERO_BYTES = 1 * MiB;
constexpr size_t WS_A1 = 1 * MiB;
constexpr size_t WS_WIN = 65 * MiB;
constexpr size_t WS_WOUT = 89 * MiB;
constexpr size_t WS_BIAS = 97 * MiB;
constexpr size_t WS_QKV = 98 * MiB;
constexpr size_t WS_A2 = 290 * MiB;
constexpr size_t WS_DT = 354 * MiB;
constexpr size_t WS_H1 = 418 * MiB;
constexpr size_t WS_ROUTE = 546 * MiB;
constexpr size_t WS_WR = 547 * MiB;
constexpr size_t WS_XG = 548 * MiB;
constexpr size_t WS_HBUF = 740 * MiB;
constexpr size_t WS_Y = 836 * MiB;
constexpr size_t WS_WGU = 1028 * MiB;
constexpr size_t WS_WD = 1540 * MiB;
constexpr size_t WS_END = 1796 * MiB;
constexpr int CW_CNT = 65536, CNT_STRIDE = 1056;
constexpr int CW_NRM = 2048;
constexpr int CW_QHEAD = 3072;
constexpr int CW_BAR = 4096;

namespace pg8 {
#define PG8_LAS __attribute__((address_space(3)))
typedef unsigned short bf16_t;
typedef short bf16x8 __attribute__((ext_vector_type(8)));
typedef float f32x4 __attribute__((ext_vector_type(4)));
typedef unsigned u32x4 __attribute__((ext_vector_type(4)));
constexpr int BM = 256, BK = 64, HALF = 128, HTB = HALF * BK * 2  , STAGE_BYTES = 8 * HTB, NXCD = 8, WGM = 8;

__host__ __device__ __forceinline__ int lds_byte(int r, int c) { const int st = (r >> 4) * 2 + (c >> 5), rr = r & 15, cc = c & 31, ob = rr * 64 + cc * 2; return st * 1024 + (ob ^ (((ob >> 9) & 1) << 5)); }
__host__ __device__ __forceinline__ void stage_rc(int b, int& R, int& C) { const int st = b / 1024, sb = b % 1024, swz = sb ^ (((sb >> 9) & 1) << 5); R = (st >> 1) * 16 + swz / 64; C = (st & 1) * 32 + (swz % 64) / 2; }
__host__ __device__ __forceinline__ int perm32(int rho) { const int n = rho >> 4, i = rho & 15; return 8 * (i >> 2) + 4 * n + (i & 3); }

struct Unit { int pm, pn; };
struct Gemm { const bf16_t* A; const bf16_t* Bt; int M, N, K; };

struct StaticOrder {
    int nM, nN, nwg, G, c;
    __host__ __device__ void init(int M, int N, int G_, int c_) { nM = M / BM; nN = N / BM; nwg = nM * nN; G = G_; c = c_; }
    __host__ __device__ bool next(int i, Unit& u) const {
        const long L = (long)i * G + c; if (L >= nwg) return false;
        int wgid = (int)L; { const int q = nwg / NXCD, r = nwg % NXCD, xcd = wgid % NXCD, off = wgid / NXCD; wgid = (xcd < r ? xcd * (q + 1) : r * (q + 1) + (xcd - r) * q) + off; }
        const int nig = WGM * nN, gid = wgid / nig, fm = gid * WGM, gsz = (nM - fm) < WGM ? (nM - fm) : WGM;
        u.pm = fm + ((wgid % nig) % gsz); u.pn = (wgid % nig) / gsz; return true;
    }
    __device__ __forceinline__ void a_ready(const Unit&) const {}
    __device__ __forceinline__ void done(const Unit&) const {}
};

__device__ __forceinline__ unsigned cvt_pk_bf16(float lo, float hi) { unsigned r; asm volatile("v_cvt_pk_bf16_f32 %0, %1, %2" : "=v"(r) : "v"(lo), "v"(hi)); return r; }
typedef float f32x2 __attribute__((ext_vector_type(2)));
__device__ __forceinline__ f32x2 gelu_pk(f32x2 v) {
    const f32x2 av = __builtin_elementwise_abs(v), d = av * 0.2316418882f + 1.0f;
    f32x2 t; t.x = __builtin_amdgcn_rcpf(d.x); t.y = __builtin_amdgcn_rcpf(d.y);
    f32x2 q = t * 0.5307027145f + (-0.7265760135f); q = q * t + 0.7107068705f; q = q * t + (-0.142248368f); q = q * t + 0.127414796f; q = q * t;
    const f32x2 s = (v * v) * (-0.72134752044f);
    f32x2 e; e.x = __builtin_amdgcn_exp2f(s.x); e.y = __builtin_amdgcn_exp2f(s.y);
    const f32x2 m = v * (q * e), r = v - m;
    f32x2 o; o.x = v.x < 0.f ? m.x : r.x; o.y = v.y < 0.f ? m.y : r.y; return o;
}

template <int ACT  > struct EpiBf16 {
    static constexpr bool PERM = true, AFTER_DRAIN = false; static_assert(ACT == 0 || ACT == 1, "EpiBf16: ACT is 0 (none) or 1 (gelu_pk)");
    bf16_t* O; int ldc; const float* bias; int split_cols; size_t split_stride; float scale0;
    __device__ __forceinline__ void operator()(const f32x4 (&acc)[2][2][4][2], const Unit& u, int wr, int wc, int fr, int fq) const {
        const int row0 = u.pm * BM + wr * 64 + fr; int colt = u.pn * BM; bf16_t* base = O;
        float sc = 1.f; if (split_cols) { const int t = colt / split_cols; base += (size_t)t * split_stride; colt -= t * split_cols; if (t == 0) sc = scale0; }
        const int col0 = colt + wc * 32 + 8 * fq, bcol0 = u.pn * BM + wc * 32 + 8 * fq;
        f32x4 bv[2][2];
#pragma unroll
        for (int bj = 0; bj < 2; ++bj)
#pragma unroll
            for (int n = 0; n < 2; ++n) bv[bj][n] = bias ? *(const f32x4*)(bias + bcol0 + bj * HALF + 4 * n) : (f32x4){0.f, 0.f, 0.f, 0.f};
#pragma unroll
        for (int ai = 0; ai < 2; ++ai)
#pragma unroll
            for (int m = 0; m < 4; ++m) { bf16_t* rowp = base + (size_t)(row0 + ai * HALF + m * 16) * ldc + col0;
#pragma unroll
                for (int bj = 0; bj < 2; ++bj) { f32x4 v0 = acc[ai][bj][m][0] + bv[bj][0], v1 = acc[ai][bj][m][1] + bv[bj][1];
                    if (ACT == 1) { f32x2 a = gelu_pk((f32x2){v0[0], v0[1]}), b = gelu_pk((f32x2){v0[2], v0[3]}), c = gelu_pk((f32x2){v1[0], v1[1]}), d = gelu_pk((f32x2){v1[2], v1[3]});
                        v0 = (f32x4){a.x, a.y, b.x, b.y}; v1 = (f32x4){c.x, c.y, d.x, d.y}; }
                    v0 = v0 * sc; v1 = v1 * sc; u32x4 w; w.x = cvt_pk_bf16(v0[0], v0[1]); w.y = cvt_pk_bf16(v0[2], v0[3]); w.z = cvt_pk_bf16(v1[0], v1[1]); w.w = cvt_pk_bf16(v1[2], v1[3]);
                    *(u32x4*)(rowp + bj * HALF) = w; } }
    }
};

struct EpiResF32 {
    static constexpr bool PERM = false, AFTER_DRAIN = false;
    const float* base; float* out; int ldc;
    __device__ __forceinline__ void operator()(const f32x4 (&acc)[2][2][4][2], const Unit& u, int wr, int wc, int fr, int fq) const {
        const int col0 = u.pn * BM + wc * 32 + 4 * fq;
#pragma unroll
        for (int ai = 0; ai < 2; ++ai)
#pragma unroll
            for (int m = 0; m < 4; ++m) { const size_t off = (size_t)(u.pm * BM + ai * HALF + wr * 64 + m * 16 + fr) * ldc + col0;
#pragma unroll
                for (int bj = 0; bj < 2; ++bj)
#pragma unroll
                    for (int n = 0; n < 2; ++n) { const f32x4 bs = *(const f32x4*)(base + off + bj * HALF + n * 16); *(f32x4*)(out + off + bj * HALF + n * 16) = bs + acc[ai][bj][m][n]; }
                if (m & 1) asm volatile("" ::: "memory"); }
    }
};
struct EpiResBf16 {
    static constexpr bool PERM = true, AFTER_DRAIN = false;
    const float* base; bf16_t* out; int ldc;
    __device__ __forceinline__ void operator()(const f32x4 (&acc)[2][2][4][2], const Unit& u, int wr, int wc, int fr, int fq) const {
        const int col0 = u.pn * BM + wc * 32 + 8 * fq;
#pragma unroll
        for (int ai = 0; ai < 2; ++ai)
#pragma unroll
            for (int m = 0; m < 4; ++m) { const size_t off = (size_t)(u.pm * BM + ai * HALF + wr * 64 + m * 16 + fr) * ldc + col0;
#pragma unroll
                for (int bj = 0; bj < 2; ++bj) { const f32x4 v0 = *(const f32x4*)(base + off + bj * HALF) + acc[ai][bj][m][0], v1 = *(const f32x4*)(base + off + bj * HALF + 4) + acc[ai][bj][m][1];
                    u32x4 w; w.x = cvt_pk_bf16(v0[0], v0[1]); w.y = cvt_pk_bf16(v0[2], v0[3]); w.z = cvt_pk_bf16(v1[0], v1[1]); w.w = cvt_pk_bf16(v1[2], v1[3]);
                    *(u32x4*)(out + off + bj * HALF) = w; }
                if (m & 1) asm volatile("" ::: "memory"); }
    }
};
struct EpiQKV {
    static constexpr bool PERM = true, AFTER_DRAIN = false;
    bf16_t* O; int ldc; PG8_LAS float* part; unsigned* nrm;
    __device__ __forceinline__ void operator()(const f32x4 (&acc)[2][2][4][2], const Unit& u, int wr, int wc, int fr, int fq) const {
        const int row0 = u.pm * BM + wr * 64 + fr, col0 = u.pn * BM + wc * 32 + 8 * fq;
        const bool track = u.pn < 8 || (u.pn >= 12 && u.pn < 20);
#pragma unroll
        for (int ai = 0; ai < 2; ++ai)
#pragma unroll
            for (int m = 0; m < 4; ++m) { bf16_t* rowp = O + (size_t)(row0 + ai * HALF + m * 16) * ldc + col0;
#pragma unroll
                for (int bj = 0; bj < 2; ++bj) { const f32x4 v0 = acc[ai][bj][m][0], v1 = acc[ai][bj][m][1];
                    u32x4 w; w.x = cvt_pk_bf16(v0[0], v0[1]); w.y = cvt_pk_bf16(v0[2], v0[3]); w.z = cvt_pk_bf16(v1[0], v1[1]); w.w = cvt_pk_bf16(v1[2], v1[3]);
                    *(u32x4*)(rowp + bj * HALF) = w;
                    if (track) { float ss = ((v0[0] * v0[0] + v0[1] * v0[1]) + (v0[2] * v0[2] + v0[3] * v0[3])) + ((v1[0] * v1[0] + v1[1] * v1[1]) + (v1[2] * v1[2] + v1[3] * v1[3]));
                        ss += __shfl_xor(ss, 16); ss += __shfl_xor(ss, 32);
                        if (fq == 0) part[(wc * 2 + bj) * 256 + ai * HALF + wr * 64 + m * 16 + fr] = ss; } } }
        if (track) {
            asm volatile("s_waitcnt lgkmcnt(0)" ::: "memory"); __builtin_amdgcn_s_barrier(); asm volatile("" ::: "memory");
            const int tid = threadIdx.x, row = tid & 255, bj = tid >> 8;
            float v = (part[(0 * 2 + bj) * 256 + row] + part[(1 * 2 + bj) * 256 + row]) + (part[(2 * 2 + bj) * 256 + row] + part[(3 * 2 + bj) * 256 + row]);
#pragma unroll
            for (int o = 1; o < 64; o <<= 1) v = fmaxf(v, __shfl_xor(v, o));
            const int slice = (u.pn < 8 ? 2 * u.pn : 16 + 2 * (u.pn - 12)) + bj;
            if ((tid & 63) == 0) atomicMax(nrm + (u.pm >> 5) * 32 + slice, __float_as_uint(v));
            asm volatile("s_waitcnt lgkmcnt(0)" ::: "memory");
        }
    }
};
struct EpiSwiglu {
    static constexpr bool PERM = true, AFTER_DRAIN = false;
    bf16_t* H;
    __device__ __forceinline__ void operator()(const f32x4 (&acc)[2][2][4][2], const Unit& u, int wr, int wc, int fr, int fq) const {
        const int col0 = (u.pn & 7) * HALF + wc * 32 + 8 * fq;
#pragma unroll
        for (int ai = 0; ai < 2; ++ai)
#pragma unroll
            for (int m = 0; m < 4; ++m) { bf16_t* rowp = H + (size_t)(u.pm * BM + ai * HALF + wr * 64 + m * 16 + fr) * 1024 + col0;
                float hv[8];
#pragma unroll
                for (int n = 0; n < 2; ++n)
#pragma unroll
                    for (int c = 0; c < 4; ++c) { const float g = acc[ai][0][m][n][c], uu = acc[ai][1][m][n][c];
                        hv[n * 4 + c] = g * __builtin_amdgcn_rcpf(1.f + __builtin_amdgcn_exp2f(-1.4426950408889634f * g)) * uu; }
                u32x4 w; w.x = cvt_pk_bf16(hv[0], hv[1]); w.y = cvt_pk_bf16(hv[2], hv[3]); w.z = cvt_pk_bf16(hv[4], hv[5]); w.w = cvt_pk_bf16(hv[6], hv[7]);
                *(u32x4*)rowp = w; }
    }
};
struct EpiDown {
    static constexpr bool PERM = true, AFTER_DRAIN = false;
    bf16_t* Y;
    __device__ __forceinline__ void operator()(const f32x4 (&acc)[2][2][4][2], const Unit& u, int wr, int wc, int fr, int fq) const {
        const int col0 = (u.pn & 7) * BM + wc * 32 + 8 * fq;
#pragma unroll
        for (int ai = 0; ai < 2; ++ai)
#pragma unroll
            for (int m = 0; m < 4; ++m) { const int row = u.pm * BM + ai * HALF + wr * 64 + m * 16 + fr; bf16_t* rowp = Y + (size_t)row * 2048 + col0;
#pragma unroll
                for (int bj = 0; bj < 2; ++bj) { const f32x4 v0 = acc[ai][bj][m][0], v1 = acc[ai][bj][m][1];
                    u32x4 w; w.x = cvt_pk_bf16(v0[0], v0[1]); w.y = cvt_pk_bf16(v0[2], v0[3]); w.z = cvt_pk_bf16(v1[0], v1[1]); w.w = cvt_pk_bf16(v1[2], v1[3]);
                    *(u32x4*)(rowp + bj * HALF) = w; } }
    }
};
struct GroupedOrder {
    int total, G, c; const PG8_LAS int* tile_e;
    __device__ __forceinline__ bool next(int i, Unit& u) const {
        const int L = i * G + c; if (L >= total) return false;
        u.pm = L >> 3; u.pn = __builtin_amdgcn_readfirstlane(tile_e[L >> 3]) * 8 + (L & 7); return true;
    }
    __device__ __forceinline__ void a_ready(const Unit&) const {}
    __device__ __forceinline__ void done(const Unit&) const {}
};

template <class Epi, class Sched, bool ALIGN_EPI = false, bool SP2 = false>
__device__ __forceinline__ void gemm_phase(PG8_LAS unsigned char* lds, const Gemm g, const Sched& S, const Epi& E) {
    const int tid = threadIdx.x, wid = __builtin_amdgcn_readfirstlane(tid >> 6), lane = tid & 63, wr = wid >> 2, wc = wid & 3, fr = lane & 15, fq = lane >> 4;
    const int K = g.K, nt = K / BK;
    unsigned voffA[2], voffB[2];
#pragma unroll
    for (int i = 0; i < 2; ++i) { int R, C; stage_rc(tid * 16 + i * 8192, R, C); const int Rb = Epi::PERM ? ((R & ~31) + perm32(R & 31)) : R;
        voffA[i] = (unsigned)(R * K + C) * 2u; voffB[i] = (unsigned)(Rb * K + C) * 2u; }
    const size_t kstep = (size_t)(BK * 2);
    const size_t hstep = (size_t)HALF * K * 2;
    const size_t tstep = 2 * hstep;
    const unsigned ldsw = (unsigned)wid * 1024u;
    const int aoff = lds_byte(wr * 64 + fr, fq * 8), boff = lds_byte(wc * 32 + fr, fq * 8);
#define PG8_SA(b, h) (((b) * 2 + (h)) * HTB)
#define PG8_SB(b, h) ((4 + (b) * 2 + (h)) * HTB)
#define PG8_STAGE(bufoff, gbase, voff) do { _Pragma("unroll") for (int _i = 0; _i < 2; ++_i) \
        __builtin_amdgcn_global_load_lds((const unsigned*)((const char*)(gbase) + (voff)[_i]), (PG8_LAS unsigned*)(lds + (bufoff) + ldsw + _i * 8192), 16, 0, 0); } while (0)
#define PG8_LDA(dst, b, h) do { _Pragma("unroll") for (int m = 0; m < 4; ++m) _Pragma("unroll") for (int k = 0; k < 2; ++k) dst[m][k] = *(const PG8_LAS bf16x8*)(lds + PG8_SA(b, h) + aoff + m * 2048 + k * 1024); } while (0)
#define PG8_LDB(dst, b, h) do { _Pragma("unroll") for (int n = 0; n < 2; ++n) _Pragma("unroll") for (int k = 0; k < 2; ++k) dst[n][k] = *(const PG8_LAS bf16x8*)(lds + PG8_SB(b, h) + boff + n * 2048 + k * 1024); } while (0)
#define PG8_MMA(ai, bj, At, Bt) do { __builtin_amdgcn_s_setprio(1); _Pragma("unroll") for (int m = 0; m < 4; ++m) _Pragma("unroll") for (int n = 0; n < 2; ++n) _Pragma("unroll") for (int k = 0; k < 2; ++k) \
        acc[ai][bj][m][n] = __builtin_amdgcn_mfma_f32_16x16x32_bf16(Bt[n][k], At[m][k], acc[ai][bj][m][n], 0, 0, 0); __builtin_amdgcn_s_setprio(0); } while (0)
#define PG8_WAIT_V(n) asm volatile("s_waitcnt vmcnt(" #n ")" ::: "memory")
#define PG8_WAIT_L(n) asm volatile("s_waitcnt lgkmcnt(" #n ")" ::: "memory")
#define PG8_BAR __builtin_amdgcn_s_barrier()
#define PG8_SCHED __builtin_amdgcn_sched_barrier(0)
    Unit cur, nxt; int ui = 0;
    if (!S.next(0, cur)) return;
    f32x4 acc[2][2][4][2];
#pragma unroll
    for (int a = 0; a < 2; ++a)
#pragma unroll
        for (int b = 0; b < 2; ++b)
#pragma unroll
            for (int m = 0; m < 4; ++m)
#pragma unroll
                for (int n = 0; n < 2; ++n) acc[a][b][m][n] = (f32x4){0.f, 0.f, 0.f, 0.f};
    bf16x8 At[4][2], B0[2][2], B1[2][2];
    const char* cA = (const char*)g.A + (size_t)cur.pm * tstep; const char* cB = (const char*)g.Bt + (size_t)cur.pn * tstep;
    S.a_ready(cur);
    if constexpr (SP2) {
        PG8_STAGE(PG8_SB(0, 0), cB, voffB); PG8_STAGE(PG8_SB(0, 1), cB + hstep, voffB); PG8_STAGE(PG8_SA(0, 0), cA, voffA); PG8_STAGE(PG8_SA(0, 1), cA + hstep, voffA);
        if (wr == 1) PG8_BAR;
        PG8_WAIT_V(2); PG8_BAR;
        PG8_STAGE(PG8_SB(1, 0), cB + kstep, voffB); PG8_STAGE(PG8_SA(1, 0), cA + kstep, voffA); PG8_STAGE(PG8_SB(1, 1), cB + hstep + kstep, voffB);
        PG8_WAIT_V(6); PG8_BAR;
    } else {
        PG8_STAGE(PG8_SB(0, 0), cB, voffB); PG8_STAGE(PG8_SA(0, 0), cA, voffA); PG8_STAGE(PG8_SB(0, 1), cB + hstep, voffB); PG8_STAGE(PG8_SA(0, 1), cA + hstep, voffA);
        if (wr == 1) PG8_BAR;
        PG8_WAIT_V(4); PG8_BAR;
        PG8_STAGE(PG8_SB(1, 0), cB + kstep, voffB); PG8_STAGE(PG8_SA(1, 0), cA + kstep, voffA); PG8_STAGE(PG8_SB(1, 1), cB + hstep + kstep, voffB);
        PG8_WAIT_V(6); PG8_BAR;
    }
    for (;;) {
        const bool has_next = S.next(ui + 1, nxt);
        const char* nA = has_next ? (const char*)g.A + (size_t)nxt.pm * tstep : cA; const char* nB = has_next ? (const char*)g.Bt + (size_t)nxt.pn * tstep : cB;
        for (int t = 0; t < nt; t += 2) {
            const bool last = (t == nt - 2);
            const char* a1 = cA + (size_t)(t + 1) * kstep;
            const char* a2 = last ? nA : cA + (size_t)(t + 2) * kstep; const char* b2 = last ? nB : cB + (size_t)(t + 2) * kstep;
            const char* a3 = a2 + kstep; const char* b3 = b2 + kstep;
            if (last && has_next) S.a_ready(nxt);
            if constexpr (SP2) {
            PG8_LDB(B0, 0, 0); PG8_LDB(B1, 0, 1); PG8_SCHED; PG8_LDA(At, 0, 0); PG8_STAGE(PG8_SA(1, 1), a1 + hstep, voffA);
            PG8_WAIT_V(8); PG8_WAIT_L(0); PG8_BAR; PG8_MMA(0, 0, At, B0); PG8_MMA(0, 1, At, B1); PG8_BAR; PG8_SCHED;
            PG8_LDA(At, 0, 1); PG8_STAGE(PG8_SB(0, 0), b2, voffB); PG8_STAGE(PG8_SB(0, 1), b2 + hstep, voffB); PG8_STAGE(PG8_SA(0, 0), a2, voffA);
            PG8_WAIT_V(8); PG8_WAIT_L(0); PG8_BAR; PG8_MMA(1, 0, At, B0); PG8_MMA(1, 1, At, B1); PG8_BAR; PG8_SCHED;
            PG8_LDB(B0, 1, 0); PG8_LDB(B1, 1, 1); PG8_SCHED; PG8_LDA(At, 1, 0); PG8_STAGE(PG8_SA(0, 1), a2 + hstep, voffA);
            PG8_WAIT_V(8); PG8_WAIT_L(0); PG8_BAR; PG8_MMA(0, 0, At, B0); PG8_MMA(0, 1, At, B1); PG8_BAR; PG8_SCHED;
            PG8_LDA(At, 1, 1); PG8_STAGE(PG8_SB(1, 0), b3, voffB); PG8_STAGE(PG8_SB(1, 1), b3 + hstep, voffB); PG8_STAGE(PG8_SA(1, 0), a3, voffA);
            PG8_WAIT_V(8); PG8_WAIT_L(0); PG8_BAR; PG8_MMA(1, 0, At, B0); PG8_MMA(1, 1, At, B1); PG8_BAR; PG8_SCHED;
            } else {
            PG8_LDB(B0, 0, 0); PG8_SCHED; PG8_LDA(At, 0, 0); PG8_STAGE(PG8_SA(1, 1), a1 + hstep, voffA);
            PG8_WAIT_L(8); PG8_BAR; PG8_WAIT_L(0); PG8_MMA(0, 0, At, B0); PG8_BAR; PG8_SCHED;
            PG8_LDB(B1, 0, 1); PG8_STAGE(PG8_SB(0, 0), b2, voffB);
            PG8_BAR; PG8_WAIT_L(0); PG8_MMA(0, 1, At, B1); PG8_BAR;
            PG8_LDA(At, 0, 1); PG8_STAGE(PG8_SA(0, 0), a2, voffA);
            PG8_BAR; PG8_WAIT_L(0); PG8_MMA(1, 0, At, B0); PG8_BAR; PG8_SCHED;
            PG8_STAGE(PG8_SB(0, 1), b2 + hstep, voffB);
            PG8_WAIT_V(6); PG8_BAR; PG8_MMA(1, 1, At, B1); PG8_BAR;
            PG8_LDB(B0, 1, 0); PG8_SCHED; PG8_LDA(At, 1, 0); PG8_STAGE(PG8_SA(0, 1), a2 + hstep, voffA);
            PG8_WAIT_L(8); PG8_BAR; PG8_WAIT_L(0); PG8_MMA(0, 0, At, B0); PG8_BAR; PG8_SCHED;
            PG8_LDB(B1, 1, 1); PG8_STAGE(PG8_SB(1, 0), b3, voffB);
            PG8_BAR; PG8_WAIT_L(0); PG8_MMA(0, 1, At, B1); PG8_BAR;
            PG8_LDA(At, 1, 1); PG8_STAGE(PG8_SA(1, 0), a3, voffA);
            PG8_BAR; PG8_WAIT_L(0); PG8_MMA(1, 0, At, B0); PG8_BAR; PG8_SCHED;
            PG8_STAGE(PG8_SB(1, 1), b3 + hstep, voffB);
            PG8_WAIT_V(6); PG8_BAR; PG8_MMA(1, 1, At, B1); PG8_BAR;
            }
        }
        if constexpr (ALIGN_EPI) { if (wr == 0) PG8_BAR; }
        if constexpr (!Epi::AFTER_DRAIN) { E(acc, cur, wr, wc, fr, fq); S.done(cur); }
        if (!has_next) break;
#pragma unroll
        for (int a = 0; a < 2; ++a)
#pragma unroll
            for (int b = 0; b < 2; ++b)
#pragma unroll
                for (int m = 0; m < 4; ++m)
#pragma unroll
                    for (int n = 0; n < 2; ++n) acc[a][b][m][n] = (f32x4){0.f, 0.f, 0.f, 0.f};
        cur = nxt; cA = nA; cB = nB; ++ui;
        if constexpr (ALIGN_EPI) { if (wr == 1) PG8_BAR; }
    }
    PG8_WAIT_V(0);
    if constexpr (!ALIGN_EPI) { if (wr == 0) PG8_BAR; }
    PG8_BAR;
    if constexpr (Epi::AFTER_DRAIN) { E.fused(acc, cur, wr, wc, fr, fq, lds, wid, lane); S.done(cur); }
#undef PG8_SA
#undef PG8_SB
#undef PG8_STAGE
#undef PG8_LDA
#undef PG8_LDB
#undef PG8_MMA
#undef PG8_WAIT_V
#undef PG8_WAIT_L
#undef PG8_BAR
#undef PG8_SCHED
}

struct UnitW { int pm, cn; const float* w0; const float* w1; };
struct GemmW { const bf16_t* A; int K, ldw; const int* rowtok; int tokmask; const PG8_LAS int* rowbase; };
__device__ __forceinline__ void wload1(f32x4& r0, unsigned voff, const char* sbase) { asm volatile("global_load_dwordx4 %0, %1, %2" : "=&v"(r0) : "v"(voff), "s"(sbase) : "memory"); }
template <class Epi, class Sched, bool ALIGN_EPI, bool GATHER>
__device__ __forceinline__ void gemm_phase_wf32(PG8_LAS unsigned char* lds, const GemmW g, const Sched& S, const Epi& E) {
    static_assert(Epi::PERM && !Epi::AFTER_DRAIN, "gemm_phase_wf32: PERM epilogues that run inside the unit loop only");
    const int tid = threadIdx.x, wid = __builtin_amdgcn_readfirstlane(tid >> 6), lane = tid & 63, wr = wid >> 2, wc = wid & 3, fr = lane & 15, fq = lane >> 4;
    const int K = g.K, nt = K / BK;
    const size_t kstep = (size_t)(BK * 2), hstep = (size_t)HALF * K * 2, tstep = 2 * hstep;
    const unsigned ldsw = (unsigned)wid * 1024u;
    const int aoff = lds_byte(wr * 64 + fr, fq * 8), boff = lds_byte(wc * 32 + fr, fq * 8);
    const int cq = lane & 7, sj = lane >> 3;
    #if defined(PROBE_HOT) && (PROBE_HOT == 2 || PROBE_HOT == 4)
    const size_t wrow = (size_t)g.ldw * 4u, wkt = S.hot ? 0 : wrow * BK;
#else
    const size_t wrow = (size_t)g.ldw * 4u, wkt = wrow * BK;
#endif
#if defined(PROBE_HOT) && PROBE_HOT == 5
    const int cqg = S.hot ? (lane & 7) : cq, sjg = S.hot ? (lane >> 3) : sj;
    const size_t wsrc = (size_t)(8 * sjg) * wrow + (size_t)(32 * (wid & 3) + 4 * cqg) * 4u;
#else
    const size_t wsrc = (size_t)(8 * sj) * wrow + (size_t)(32 * (wid & 3) + 4 * cq) * 4u;
#endif
    const int wrho = 16 * (cq & 1) + 4 * (cq >> 1);
    const int wdst = (4 + (wid >> 2)) * HTB + lds_byte(32 * (wid & 3) + wrho, 8 * sj);
#define PG8_SA(b, h) (((b) * 2 + (h)) * HTB)
#define PG8_SB(b, h) ((4 + (b) * 2 + (h)) * HTB)
#define PG8_STAGE(bufoff, gbase, voff) do { _Pragma("unroll") for (int _i = 0; _i < 2; ++_i) \
        __builtin_amdgcn_global_load_lds((const unsigned*)((const char*)(gbase) + (voff)[_i]), (PG8_LAS unsigned*)(lds + (bufoff) + ldsw + _i * 8192), 16, 0, 0); } while (0)
#define PG8_STAGEA(bufoff, h, kb, nx) do { const char* b_ = ((nx) ? nAb : cAb) + (kb); unsigned v_[2]; v_[0] = (nx) ? voN[h][0] : voC[h][0]; v_[1] = (nx) ? voN[h][1] : voC[h][1]; PG8_STAGE(bufoff, b_, v_); } while (0)
#define PG8_LDA(dst, b, h) do { _Pragma("unroll") for (int m = 0; m < 4; ++m) _Pragma("unroll") for (int k = 0; k < 2; ++k) dst[m][k] = *(const PG8_LAS bf16x8*)(lds + PG8_SA(b, h) + aoff + m * 2048 + k * 1024); } while (0)
#define PG8_LDB(dst, b, h) do { _Pragma("unroll") for (int n = 0; n < 2; ++n) _Pragma("unroll") for (int k = 0; k < 2; ++k) dst[n][k] = *(const PG8_LAS bf16x8*)(lds + PG8_SB(b, h) + boff + n * 2048 + k * 1024); } while (0)
#define PG8_MMA(ai, bj, At, Bt) do { __builtin_amdgcn_s_setprio(1); _Pragma("unroll") for (int m = 0; m < 4; ++m) _Pragma("unroll") for (int n = 0; n < 2; ++n) _Pragma("unroll") for (int k = 0; k < 2; ++k) \
        acc[ai][bj][m][n] = __builtin_amdgcn_mfma_f32_16x16x32_bf16(Bt[n][k], At[m][k], acc[ai][bj][m][n], 0, 0, 0); __builtin_amdgcn_s_setprio(0); } while (0)
#define PG8_WAIT_V(n) asm volatile("s_waitcnt vmcnt(" #n ")" ::: "memory")
#define PG8_WAIT_L(n) asm volatile("s_waitcnt lgkmcnt(" #n ")" ::: "memory")
#define PG8_BAR __builtin_amdgcn_s_barrier()
#define PG8_SCHED __builtin_amdgcn_sched_barrier(0)
#define PG8_WLOAD(kk) do { const int kk_ = (kk); const bool in_ = kk_ < nt; const char* q_ = (in_ ? cW : nW) + (size_t)(in_ ? kk_ : kk_ - nt) * wkt; \
        _Pragma("unroll") for (int r_ = 0; r_ < 8; ++r_) wload1(RB[r_], (unsigned)wsrc, q_ + (size_t)r_ * wrow); } while (0)
#define PG8_WWAIT(n) asm volatile("s_waitcnt vmcnt(" #n ")" : "+v"(RB[0]), "+v"(RB[1]), "+v"(RB[2]), "+v"(RB[3]), "+v"(RB[4]), "+v"(RB[5]), "+v"(RB[6]), "+v"(RB[7]) :: "memory")
#define PG8_WWRITE(b) do { _Pragma("unroll") for (int i_ = 0; i_ < 4; ++i_) { u32x4 w_; \
        w_.x = cvt_pk_bf16(RB[0][i_], RB[1][i_]); w_.y = cvt_pk_bf16(RB[2][i_], RB[3][i_]); w_.z = cvt_pk_bf16(RB[4][i_], RB[5][i_]); w_.w = cvt_pk_bf16(RB[6][i_], RB[7][i_]); \
        *(PG8_LAS u32x4*)(lds + (b) * 2 * HTB + wdst + i_ * 64) = w_; } } while (0)
#ifdef PROBE_ABL
    const int abl = S.hot ? PROBE_ABL : 0;
#define PG8_ABL(bit, stmt) do { if (!(abl & (bit))) { stmt; } } while (0)
#else
#define PG8_ABL(bit, stmt) do { stmt; } while (0)
#endif
    UnitW cur, nxt; int ui = 0;
    if (!S.next(0, cur)) return;
    f32x4 acc[2][2][4][2];
#pragma unroll
    for (int a = 0; a < 2; ++a)
#pragma unroll
        for (int b = 0; b < 2; ++b)
#pragma unroll
            for (int m = 0; m < 4; ++m)
#pragma unroll
                for (int n = 0; n < 2; ++n) acc[a][b][m][n] = (f32x4){0.f, 0.f, 0.f, 0.f};
    bf16x8 At[4][2], B0[2][2], B1[2][2]; f32x4 RB[8];
    const bool whalf = wid >= 4;
    const char* cAb; const char* nAb; unsigned voC[2][2], voN[2][2];
#define PG8_UNIT_A(base, vo, pm_) do { int t_ = tid; asm volatile("" : "+v"(t_)); int R_[2], C_[2]; stage_rc(t_ * 16, R_[0], C_[0]); stage_rc(t_ * 16 + 8192, R_[1], C_[1]); \
        if constexpr (GATHER) { base = (const char*)g.A; const int rb_ = __builtin_amdgcn_readfirstlane(g.rowbase[pm_]), nr_ = __builtin_amdgcn_readfirstlane(g.rowbase[(pm_) + 256]);     \
            _Pragma("unroll") for (int h_ = 0; h_ < 2; ++h_) _Pragma("unroll") for (int i_ = 0; i_ < 2; ++i_) { const int rt_ = h_ * HALF + R_[i_]; const int tk_ = g.rowtok[rb_ + (pm_) * BM + (rt_ < nr_ ? rt_ : 0)] & g.tokmask; \
            vo[h_][i_] = (unsigned)(rt_ < nr_ ? tk_ : g.tokmask + 1) * (unsigned)(K * 2) + (unsigned)C_[i_] * 2u; } } \
        else { base = (const char*)g.A + (size_t)(pm_) * tstep; _Pragma("unroll") for (int h_ = 0; h_ < 2; ++h_) _Pragma("unroll") for (int i_ = 0; i_ < 2; ++i_) vo[h_][i_] = (unsigned)(h_ * HALF + R_[i_]) * (unsigned)(K * 2) + (unsigned)C_[i_] * 2u; } } while (0)
    PG8_UNIT_A(cAb, voC, cur.pm); nAb = cAb;
#pragma unroll
    for (int h_ = 0; h_ < 2; ++h_) { voN[h_][0] = voC[h_][0]; voN[h_][1] = voC[h_][1]; }
    const char* cW = (const char*)(whalf ? cur.w1 : cur.w0);
    const char* nW = cW;
    PG8_WLOAD(0); PG8_STAGEA(PG8_SA(0, 0), 0, 0, false); PG8_STAGEA(PG8_SA(0, 1), 1, 0, false);
    PG8_WWAIT(4); PG8_WWRITE(0);
    PG8_WLOAD(1);
    PG8_WWAIT(0); PG8_WWRITE(1);
    PG8_STAGEA(PG8_SA(1, 0), 0, kstep, false);
    PG8_WLOAD(2);
    PG8_WAIT_L(0);
    if (wr == 1) PG8_BAR;
    PG8_BAR; PG8_BAR;
    for (;;) {
        const bool has_next = S.next(ui + 1, nxt);
        if (has_next) PG8_UNIT_A(nAb, voN, nxt.pm);
        nW = has_next ? (const char*)(whalf ? nxt.w1 : nxt.w0) : cW;
        for (int t = 0; t < nt; t += 2) {
            const bool last = (t == nt - 2);
            const size_t k1 = (size_t)(t + 1) * kstep, k2 = last ? 0 : (size_t)(t + 2) * kstep, k3 = k2 + kstep;
            PG8_LDB(B0, 0, 0); PG8_LDB(B1, 0, 1); PG8_SCHED; PG8_LDA(At, 0, 0); PG8_STAGEA(PG8_SA(1, 1), 1, k1, false);
            PG8_WAIT_V(12); PG8_WAIT_L(0); PG8_BAR; PG8_MMA(0, 0, At, B0); PG8_MMA(0, 1, At, B1); PG8_BAR; PG8_SCHED;
            PG8_WWAIT(2); PG8_ABL(1, PG8_WWRITE(0)); PG8_LDA(At, 0, 1); PG8_STAGEA(PG8_SA(0, 0), 0, k2, last); PG8_ABL(2, PG8_WLOAD(t + 3));
            PG8_WAIT_L(0); PG8_BAR; PG8_MMA(1, 0, At, B0); PG8_MMA(1, 1, At, B1); PG8_BAR; PG8_SCHED;
            PG8_LDB(B0, 1, 0); PG8_LDB(B1, 1, 1); PG8_SCHED; PG8_LDA(At, 1, 0); PG8_STAGEA(PG8_SA(0, 1), 1, k2, last);
            PG8_WAIT_V(12); PG8_WAIT_L(0); PG8_BAR; PG8_MMA(0, 0, At, B0); PG8_MMA(0, 1, At, B1); PG8_BAR; PG8_SCHED;
            PG8_WWAIT(2); PG8_ABL(1, PG8_WWRITE(1)); PG8_LDA(At, 1, 1); PG8_STAGEA(PG8_SA(1, 0), 0, k3, last); PG8_ABL(2, PG8_WLOAD(t + 4));
            PG8_WAIT_L(0); PG8_BAR; PG8_MMA(1, 0, At, B0); PG8_MMA(1, 1, At, B1); PG8_BAR; PG8_SCHED;
        }
        if (!has_next) PG8_WWAIT(0);
        if constexpr (ALIGN_EPI) { if (wr == 0) PG8_BAR; }
        { Unit eu; eu.pm = cur.pm; eu.pn = cur.cn; E(acc, eu, wr, wc, fr, fq); }
        if (!has_next) break;
#pragma unroll
        for (int a = 0; a < 2; ++a)
#pragma unroll
            for (int b = 0; b < 2; ++b)
#pragma unroll
                for (int m = 0; m < 4; ++m)
#pragma unroll
                    for (int n = 0; n < 2; ++n) acc[a][b][m][n] = (f32x4){0.f, 0.f, 0.f, 0.f};
        cur = nxt; cAb = nAb; cW = nW; ++ui;
#pragma unroll
        for (int h_ = 0; h_ < 2; ++h_) { voC[h_][0] = voN[h_][0]; voC[h_][1] = voN[h_][1]; }
        if constexpr (ALIGN_EPI) { if (wr == 1) PG8_BAR; }
    }
    PG8_WAIT_V(0);
    if constexpr (!ALIGN_EPI) { if (wr == 0) PG8_BAR; }
    PG8_BAR;
#undef PG8_SA
#undef PG8_SB
#undef PG8_STAGE
#undef PG8_LDA
#undef PG8_STAGEA
#undef PG8_UNIT_A
#undef PG8_LDB
#undef PG8_MMA
#undef PG8_WAIT_V
#undef PG8_WAIT_L
#undef PG8_BAR
#undef PG8_SCHED
#undef PG8_WLOAD
#undef PG8_ABL
#undef PG8_WWAIT
#undef PG8_WWRITE
}
template <int MODE> struct GroupedOrderW {
    int total, G, c; const PG8_LAS int* tile_e; const float* wa; const float* wb; int hot;
    __device__ __forceinline__ bool next(int i, UnitW& u) const {
        int L = i * G + c;
        if (G == 256) {
            const int x = c & 7, j = c >> 3;
            L = (32 * i + 8 * (x >> 1) + (j & 7)) * 8 + 4 * (x & 1) + (j >> 3);
        }
        if (L >= total) return false;
        int e = __builtin_amdgcn_readfirstlane(tile_e[L >> 3]), nt = L & 7;
        u.pm = L >> 3; u.cn = nt;
#if defined(PROBE_HOT) && PROBE_HOT == 1
        if (hot) { e = 0; nt = 0; }
#endif
        if (MODE == 0) { u.w0 = wa + (size_t)e * 2048 * 1024 + 128 * nt; u.w1 = wb + (size_t)e * 2048 * 1024 + 128 * nt; }
        else { u.w0 = wa + (size_t)e * 1024 * 2048 + 256 * nt; u.w1 = u.w0 + 128; }
        return true;
    }
};
}

namespace att {
using TIN = __hip_bfloat16; using TOUT = __hip_bfloat16;
constexpr int B = 2, H = 1, HKV = 1, SQ = 8192, SKV = 8192, D = 128, QOFF = 0, WINDOW = SKV;
constexpr float THR = 8.f;
constexpr bool WSKIP = false;
constexpr int LDQ = 6144, LDO = 2048;
constexpr int W_INF = 1 << 30;
#ifdef PROF_SECT
#define PROF_T0(sect) unsigned long long pt0_##sect = 0; if (PROF_SECT == (sect) && blockIdx.x == 0) pt0_##sect = __builtin_amdgcn_s_memtime()
#define PROF_T1(sect) do { if (PROF_SECT == (sect) && blockIdx.x == 0) { const unsigned long long d_ = __builtin_amdgcn_s_memtime() - pt0_##sect; if (threadIdx.x == 0) { PROFW[0] += (unsigned)d_; } } } while (0)
#else
#define PROF_T0(sect) do {} while (0)
#define PROF_T1(sect) do {} while (0)
#endif
constexpr float SCALE = 0.08838834764831845f;
constexpr int NW = 8, QBLK = 32, KVBLK = 64, QB = NW * QBLK;
constexpr int SHM_V = KVBLK * D * 2, SHM_K = KVBLK * D * 2;
constexpr int OFF_WS = 2 * SHM_V + 2 * SHM_K, OFF_CB = OFF_WS + NW * 64 * 4, LDS_BYTES = OFF_CB + 2 * 64 * 4;
static_assert(D == 128 && SQ % QB == 0 && SKV % KVBLK == 0 && H % HKV == 0 && QOFF >= 0 && QOFF + SQ <= SKV && WINDOW >= 1, "geometry");

using bf16 = __hip_bfloat16;
typedef short bf16x8 __attribute__((ext_vector_type(8)));
typedef short s16x4 __attribute__((ext_vector_type(4)));
typedef float f32x16 __attribute__((ext_vector_type(16)));
typedef float f32x4 __attribute__((ext_vector_type(4)));
typedef unsigned u32x4 __attribute__((ext_vector_type(4)));
template <class A, class Bt> struct same_t { static constexpr bool v = false; };
template <class A> struct same_t<A, A> { static constexpr bool v = true; };

#define KSWZ(row, colB) ((row) * 256 + ((colB) ^ (((row) & 7) << 4)))
#define SBAR() __builtin_amdgcn_sched_barrier(0)
__device__ __forceinline__ int v_st(int k, int c) { const int kk = (k & ~0xC) | ((k & 4) << 1) | ((k & 8) >> 1); return ((kk >> 3) * 4 + (c >> 5)) * 512 + ((kk & 7) * 32 + (c & 31)) * 2; }
__device__ __forceinline__ int v_rd_base(int lane) { return ((lane & 3) << 3) | (((lane >> 2) & 3) << 6) | (((lane >> 4) & 1) << 5) | (((lane >> 5) & 1) << 8); }
constexpr int v_rd_off(int d0, int ks, int half) { return d0 * 512 + ks * 4096 + half * 2048; }
__device__ __forceinline__ int crow(int r, int hi) { return (r & 3) + 8 * (r >> 2) + 4 * hi; }
__device__ __forceinline__ unsigned cvtpk(float lo, float hi) {
    unsigned r; asm volatile("v_cvt_pk_bf16_f32 %0, %1, %2" : "=v"(r) : "v"(lo), "v"(hi)); return r;
}
__device__ __forceinline__ bf16x8 pack8(f32x4 a, f32x4 b) {
    u32x4 w = {cvtpk(a[0], a[1]), cvtpk(a[2], a[3]), cvtpk(b[0], b[1]), cvtpk(b[2], b[3])};
    return *reinterpret_cast<bf16x8*>(&w);
}
template <class T> __device__ __forceinline__ bf16x8 load8(const T* p) {
    if constexpr (same_t<T, float>::v) { return pack8(*(const f32x4*)p, *(const f32x4*)(p + 4)); }
    else { return *reinterpret_cast<const bf16x8*>(p); }
}
__device__ __forceinline__ void mask_tile(f32x16& p0, f32x16& p1, int dq, unsigned W) {
    const float NEG = -__builtin_inff();
#pragma unroll
    for (int r = 0; r < 16; ++r) {
        const int c = (r & 3) + 8 * (r >> 2);
        if ((unsigned)(dq - c) >= W) p0[r] = NEG;
        if ((unsigned)(dq - c - 32) >= W) p1[r] = NEG;
    }
}
__device__ __forceinline__ void partialSM(f32x16& p0, f32x16& p1, float& m_reg, float& mn, float& alpha) {
    constexpr float C2 = 1.4426950408889634f * SCALE;
    mn = m_reg; alpha = 1.f;
    const float mnL = -m_reg * C2;
    for (int r = 0; r < 16; ++r) p0[r] = fmaf(p0[r], C2, mnL); for (int r = 0; r < 16; ++r) p1[r] = fmaf(p1[r], C2, mnL);
    for (int r = 0; r < 16; ++r) p0[r] = __builtin_amdgcn_exp2f(p0[r]);
}
__device__ __forceinline__ void finishSM(f32x16& p0, f32x16& p1, float alpha, float& l_reg, bf16x8& pa0, bf16x8& pa1, bf16x8& pa2, bf16x8& pa3) {
    for (int r = 0; r < 16; ++r) p1[r] = __builtin_amdgcn_exp2f(p1[r]);
    float ps = 0; for (int r = 0; r < 16; ++r) ps += p0[r]; for (int r = 0; r < 16; ++r) ps += p1[r];
    { auto rr = __builtin_amdgcn_permlane32_swap(__float_as_uint(ps), __float_as_uint(ps), false, false);
      ps = __uint_as_float(rr[0]) + __uint_as_float(rr[1]); }
    l_reg += ps; (void)alpha;
#define PK4(P, B_, OUT) do { unsigned a0 = cvtpk(P[B_+0], P[B_+1]), a1 = cvtpk(P[B_+2], P[B_+3]);                          \
        unsigned b0 = cvtpk(P[B_+4], P[B_+5]), b1 = cvtpk(P[B_+6], P[B_+7]);                                             \
        auto r0 = __builtin_amdgcn_permlane32_swap(a0, b0, false, false); auto r1 = __builtin_amdgcn_permlane32_swap(a1, b1, false, false); \
        u32x4 w = {r0[0], r1[0], r0[1], r1[1]}; OUT = *reinterpret_cast<bf16x8*>(&w); } while (0)
    PK4(p0, 0, pa0); PK4(p0, 8, pa1); PK4(p1, 0, pa2); PK4(p1, 8, pa3);
#undef PK4
}
template <int KB, bool SK>
__device__ __forceinline__ void qkt(f32x16& p0, f32x16& p1, const char* K_lds, int r32, int hi, const bf16x8* qr, bool act, const float* cbt, float cqs) {
    if (SK && !act) { const float NEG = -__builtin_inff();
#pragma unroll
        for (int r = 0; r < 16; ++r) { p0[r] = NEG; p1[r] = NEG; } return; }
    { const f32x4* c4 = (const f32x4*)(cbt + KB * 64);
#pragma unroll
      for (int g = 0; g < 4; ++g) { const f32x4 a = c4[2 * g], b = c4[8 + 2 * g];
#pragma unroll
          for (int i = 0; i < 4; ++i) { p0[4 * g + i] = cqs - a[i]; p1[4 * g + i] = cqs - b[i]; } } }
    const char* kb[4];
#pragma unroll
    for (int dd = 0; dd < 4; ++dd) kb[dd] = K_lds + KB * SHM_K + KSWZ(r32, (dd * 16 + hi * 8) * 2);
#pragma unroll
    for (int d0 = 0; d0 < 8; ++d0) { const char* a = kb[d0 & 3] + (d0 >> 2) * 128;
        bf16x8 b0 = *reinterpret_cast<const bf16x8*>(a);
        bf16x8 b1 = *reinterpret_cast<const bf16x8*>(a + 32 * 256);
        p0 = __builtin_amdgcn_mfma_f32_32x32x16_bf16(b0, qr[d0], p0, 0, 0, 0);
        p1 = __builtin_amdgcn_mfma_f32_32x32x16_bf16(b1, qr[d0], p1, 0, 0, 0); }
}
template <int VB, bool SK>
__device__ __forceinline__ void pv_tile(f32x16* o, int vb0, bf16x8 pa0, bf16x8 pa1, bf16x8 pa2, bf16x8 pa3, bool act) {
    if (SK && !act) return;
#define TRRD(dst, off) asm volatile("ds_read_b64_tr_b16 %0, %1 offset:%2" : "=&v"(dst) : "v"(vb0), "i"(off) : "memory")
#define PV_D0(d0) do { s16x4 l0, l1, l2, l3, h0, h1, h2, h3; constexpr int b_ = VB * SHM_V + v_rd_off(d0, 0, 0);     \
        TRRD(l0, b_); TRRD(h0, b_ + 2048); TRRD(l1, b_ + 4096); TRRD(h1, b_ + 6144); TRRD(l2, b_ + 8192); TRRD(h2, b_ + 10240); TRRD(l3, b_ + 12288); TRRD(h3, b_ + 14336); \
        asm volatile("s_waitcnt lgkmcnt(0)" ::: "memory"); SBAR();                 \
        o[d0] = __builtin_amdgcn_mfma_f32_32x32x16_bf16(pa0, (bf16x8){l0[0], l0[1], l0[2], l0[3], h0[0], h0[1], h0[2], h0[3]}, o[d0], 0, 0, 0);   \
        o[d0] = __builtin_amdgcn_mfma_f32_32x32x16_bf16(pa1, (bf16x8){l1[0], l1[1], l1[2], l1[3], h1[0], h1[1], h1[2], h1[3]}, o[d0], 0, 0, 0);   \
        o[d0] = __builtin_amdgcn_mfma_f32_32x32x16_bf16(pa2, (bf16x8){l2[0], l2[1], l2[2], l2[3], h2[0], h2[1], h2[2], h2[3]}, o[d0], 0, 0, 0);   \
        o[d0] = __builtin_amdgcn_mfma_f32_32x32x16_bf16(pa3, (bf16x8){l3[0], l3[1], l3[2], l3[3], h3[0], h3[1], h3[2], h3[3]}, o[d0], 0, 0, 0); } while (0)
    PV_D0(0); PV_D0(1); PV_D0(2); PV_D0(3);
#undef PV_D0
#undef TRRD
}
template <class TIn, class TOut> struct BlockRef { const TIn* Q; const TIn* K; const TIn* V; TOut* O; const float* C; int P0, jlo; float mref; };
template <class TIn> struct Seam {
    bf16x8 qr[8];
    bf16x8 st_v0, st_v1, st_k0, st_k1; f32x4 sf0, sf1, sf2, sf3;
    float cq, st_c;
    f32x4 tq[16];
};
__device__ __forceinline__ int swa_jlo(int P0, int W) { const int lowk = P0 - W + 1; return lowk > 0 ? lowk / KVBLK : 0; }
#define ROW(p, k0, rr) ((p) + (size_t)((k0) + (rr)) * LDQ + sc)
#define VMW() asm volatile("s_waitcnt vmcnt(0)" ::: "memory")
#define VMWN(n) asm volatile("s_waitcnt vmcnt(%0)" :: "i"(n) : "memory")
#define SLOAD_H(Kp, Vp, Cp, k0) do { S.st_v0 = load8<TIn>(ROW(Vp, k0, sr)); S.st_v1 = load8<TIn>(ROW(Vp, k0, 32 + sr));              \
                         S.st_k0 = load8<TIn>(ROW(Kp, k0, sr)); S.st_k1 = load8<TIn>(ROW(Kp, k0, 32 + sr)); S.st_c = (Cp)[(k0) + (tid & 63)]; } while (0)
#define SWRITE_HK(bf) do { *(bf16x8*)(K_lds + (bf) * SHM_K + kws) = S.st_k0; *(bf16x8*)(K_lds + (bf) * SHM_K + kws + 32 * 256) = S.st_k1; \
                           if (tid < 64) cbw[(bf) * 64 + tid] = S.st_c; } while (0)
#define SWRITE_HV(bf) do { *(bf16x8*)(V_lds + (bf) * SHM_V + vst0) = S.st_v0; *(bf16x8*)(V_lds + (bf) * SHM_V + vst1) = S.st_v1; } while (0)
#define SWRITE_H(bf) do { SWRITE_HV(bf); SWRITE_HK(bf); } while (0)
#define SLOAD_F(p, k0) do { S.sf0 = *(const f32x4*)ROW(p, k0, sr); S.sf1 = *(const f32x4*)(ROW(p, k0, sr) + 4);                \
                            S.sf2 = *(const f32x4*)ROW(p, k0, 32 + sr); S.sf3 = *(const f32x4*)(ROW(p, k0, 32 + sr) + 4); } while (0)
#define SWRITE_KF(bf) do { *(bf16x8*)(K_lds + (bf) * SHM_K + kws) = pack8(S.sf0, S.sf1); *(bf16x8*)(K_lds + (bf) * SHM_K + kws + 32 * 256) = pack8(S.sf2, S.sf3); } while (0)
#define SWRITE_VF(bf) do { *(bf16x8*)(V_lds + (bf) * SHM_V + vst0) = pack8(S.sf0, S.sf1); *(bf16x8*)(V_lds + (bf) * SHM_V + vst1) = pack8(S.sf2, S.sf3); } while (0)
template <class TIn, class TOut>
__device__ __forceinline__ void causal_swa_prime(const BlockRef<TIn, TOut>& cur, int W, char* lds, Seam<TIn>& S) {
    constexpr bool F32 = same_t<TIn, float>::v;
    const int tid = threadIdx.x, wid = __builtin_amdgcn_readfirstlane(tid >> 6), lane = tid & 63, r32 = lane & 31, hi = lane >> 5;
    const int sr = tid >> 4, sc = (tid & 15) * 8, kws = KSWZ(sr, sc * 2); char* K_lds = lds + 2 * SHM_V; float* cbw = (float*)(lds + OFF_CB);
    const int kb0 = cur.jlo * KVBLK;
    for (int d0 = 0; d0 < 8; ++d0) S.qr[d0] = load8<TIn>(cur.Q + (size_t)(wid * QBLK + r32) * LDQ + d0 * 16 + hi * 8);
    S.cq = cur.C[cur.P0 + wid * QBLK + r32];
    if constexpr (F32) { SLOAD_F((const float*)cur.K, kb0); VMW(); SWRITE_KF(0); SBAR(); SLOAD_F((const float*)cur.V, kb0); }
    else { SLOAD_H(cur.K, cur.V, cur.C, kb0); VMW(); SWRITE_HK(0); }
    __syncthreads();
}
template <class TIn, class TOut>
__device__ __forceinline__ void causal_swa_block(const BlockRef<TIn, TOut>& cur, const BlockRef<TIn, TOut>& nxt, int skv, int W, char* lds, Seam<TIn>& S, unsigned* qhead, volatile __attribute__((address_space(3))) int* qw, bool qmore) {
    constexpr bool F32 = same_t<TIn, float>::v;
    const int tid = threadIdx.x, wid = __builtin_amdgcn_readfirstlane(tid >> 6), lane = tid & 63, r32 = lane & 31, hi = lane >> 5;
    int pop_ = 1 << 30; if (threadIdx.x == 0 && qmore) pop_ = (int)atomicAdd(qhead, 1u);
    const int j_lo = cur.jlo;
    int j_hi = (cur.P0 + QB - 1) / KVBLK + 1; if (j_hi > skv / KVBLK) j_hi = skv / KVBLK;
    const int NT = j_hi - j_lo;
    const int kbn = nxt.jlo * KVBLK;
    const int qlo = cur.P0 + wid * QBLK, qm = qlo + r32 - 4 * hi;
    char* V_lds = lds; char* K_lds = lds + 2 * SHM_V; float* cbw = (float*)(lds + OFF_CB); const float* cbt = cbw + 4 * hi; const float* Ch = cur.C;
    float* ws = (float*)(lds + 2 * SHM_V + 2 * SHM_K) + wid * 64; float* li_l = ws, * al_l = ws + 32;
    float m_reg = cur.mref, l_reg = 0; f32x16 o[4] = {};
    const int sr = tid >> 4, sc = (tid & 15) * 8, vst0 = v_st(sr, sc), vst1 = v_st(32 + sr, sc), kws = KSWZ(sr, sc * 2);
    const int vb0 = (int)(uintptr_t)V_lds + v_rd_base(lane);
    const TIn* Kh = cur.K; const TIn* Vh = cur.V;
#define RESC(a) do { (void)(a); (void)al_l; } while (0)
#define KBASE(t) ((j_lo + (t)) * KVBLK)
#define ACT(t) (KBASE(t) <= qlo + QBLK - 1 && KBASE(t) + KVBLK - 1 >= qlo - W + 1)
#define MASKT(P0_, P1_, t) do { const int kb_ = KBASE(t); if ((!SK || ACT(t)) && (kb_ + KVBLK - 1 > qlo || kb_ <= qlo + QBLK - 1 - W)) mask_tile(P0_, P1_, qm - kb_, (unsigned)W); } while (0)
    constexpr int NQL = F32 ? 16 : 9;
    constexpr bool SK = WSKIP && !F32;
#define SEAM_K0() do { VMWN(NQL); if constexpr (F32) { SWRITE_KF(0); SBAR(); SLOAD_F((const float*)nxt.V, kbn); } else { SWRITE_HK(0); } SBAR(); } while (0)
    f32x16 pA0, pA1, pB0, pB1; float mnA, mnB, alA, alB; bf16x8 pa0, pa1, pa2, pa3;
    if constexpr (F32) { VMW(); SWRITE_VF(0); SBAR(); } else { SWRITE_HV(0); SBAR(); }
    if (NT > 1) { if constexpr (F32) SLOAD_F((const float*)Kh, KBASE(1)); else SLOAD_H(Kh, Vh, Ch, KBASE(1)); }
    SBAR(); qkt<0, SK>(pA0, pA1, K_lds, r32, hi, S.qr, ACT(0), cbt, S.cq);
    if constexpr (F32) { if (NT > 1) { VMW(); SWRITE_KF(1); SBAR(); SLOAD_F((const float*)Vh, KBASE(1)); } }
    MASKT(pA0, pA1, 0); partialSM(pA0, pA1, m_reg, mnA, alA);
    if (NT > 1) { VMW(); if constexpr (F32) { SWRITE_VF(1); SBAR(); if (NT > 2) SLOAD_F((const float*)Kh, KBASE(2)); } else SWRITE_H(1); }
    if (tid == 0) qw[0] = pop_;
    __syncthreads();
#define HALF_STEP(PX0, PX1, mnX, alX, PY0, PY1, alY, t, KB, VB, SB) do {                                                      \
        SBAR(); qkt<KB, SK>(PX0, PX1, K_lds, r32, hi, S.qr, ACT(t), cbt, S.cq);                                  \
        finishSM(PY0, PY1, alY, l_reg, pa0, pa1, pa2, pa3); SBAR();                                                           \
        if ((t) + 1 < NT) { if constexpr (F32) { VMW(); SWRITE_KF(SB); SBAR(); SLOAD_F((const float*)Vh, KBASE((t) + 1)); }  \
                            else { SLOAD_H(Kh, Vh, Ch, KBASE((t) + 1)); } SBAR(); }                                           \
        pv_tile<VB, SK>(o, vb0, pa0, pa1, pa2, pa3, ACT((t) - 1)); MASKT(PX0, PX1, (t)); partialSM(PX0, PX1, m_reg, mnX, alX);                                        \
        __syncthreads();                                                                                                      \
        if ((t) + 1 < NT) { VMW(); if constexpr (F32) { SWRITE_VF(SB); SBAR(); if ((t) + 2 < NT) SLOAD_F((const float*)Kh, KBASE((t) + 2)); } \
                            else { SWRITE_H(SB); } }                                                                          \
        RESC(alX); __syncthreads(); } while (0)
    for (int t = 1; t + 1 < NT; t += 2) {
        HALF_STEP(pB0, pB1, mnB, alB, pA0, pA1, alA, t, 1, 0, 0);
        HALF_STEP(pA0, pA1, mnA, alA, pB0, pB1, alB, t + 1, 0, 1, 1);
    }
    int r32s = r32, his = hi; asm volatile("" : "+v"(r32s), "+v"(his));
    const bool even = (NT & 1) == 0;
    if (even) { SBAR(); qkt<1, SK>(pB0, pB1, K_lds, r32, hi, S.qr, ACT(NT - 1), cbt, S.cq); SBAR(); }
#define QROW(e) (nxt.Q + (size_t)(wid * QBLK + r32) * LDQ + ((e) >> 1) * 16 + hi * 8 + ((e) & 1) * 4)
    if constexpr (F32) { SLOAD_F((const float*)nxt.K, kbn); SBAR();
#pragma unroll
        for (int e = 0; e < 8; ++e) S.tq[e] = *(const f32x4*)QROW(e); }
    else { SLOAD_H(nxt.K, nxt.V, nxt.C, kbn); SBAR();
#pragma unroll
        for (int d0 = 0; d0 < 8; ++d0) S.qr[d0] = load8<TIn>(nxt.Q + (size_t)(wid * QBLK + r32s) * LDQ + d0 * 16 + his * 8);
        S.cq = nxt.C[nxt.P0 + wid * QBLK + r32s]; }
    SBAR();
    finishSM(pA0, pA1, alA, l_reg, pa0, pa1, pa2, pa3); SBAR();
    if constexpr (F32) {
#pragma unroll
        for (int e = 8; e < 16; ++e) S.tq[e] = *(const f32x4*)QROW(e); SBAR(); }
#undef QROW
    pv_tile<0, SK>(o, vb0, pa0, pa1, pa2, pa3, ACT(even ? NT - 2 : NT - 1));
    if (even) { MASKT(pB0, pB1, NT - 1); partialSM(pB0, pB1, m_reg, mnB, alB); __syncthreads(); RESC(alB);
        finishSM(pB0, pB1, alB, l_reg, pa0, pa1, pa2, pa3); SBAR(); pv_tile<1, SK>(o, vb0, pa0, pa1, pa2, pa3, ACT(NT - 1)); }
    SBAR(); SEAM_K0();
    if (his == 0) li_l[r32s] = l_reg; asm volatile("s_waitcnt lgkmcnt(0)" ::: "memory");
    float rli[16];
#pragma unroll
    for (int r = 0; r < 16; ++r) rli[r] = __builtin_amdgcn_rcpf(li_l[crow(r, his)]);
    TOut* Ow = cur.O + (size_t)(wid * QBLK) * LDO;
#pragma unroll
    for (int r = 0; r < 16; ++r) { const int orow = crow(r, his);
#pragma unroll
        for (int d0 = 0; d0 < 4; ++d0) { const float v = o[d0][r] * rli[r];
            if constexpr (same_t<TOut, float>::v) { Ow[(size_t)orow * LDO + d0 * 32 + r32] = v; }
            else { const float vn = __shfl_xor(v, 1);
                   if ((r32s & 1) == 0) *(unsigned*)(Ow + (size_t)orow * LDO + d0 * 32 + r32s) = cvtpk(v, vn); } } }
    if constexpr (F32) {
#pragma unroll
        for (int d0 = 0; d0 < 8; ++d0) S.qr[d0] = pack8(S.tq[2 * d0], S.tq[2 * d0 + 1]); }
    __syncthreads();
#undef RESC
#undef KBASE
#undef ACT
#undef MASKT
#undef SEAM_K0
#undef HALF_STEP
}
#undef ROW
#undef VMW
#undef VMWN
#undef SLOAD_H
#undef SWRITE_HK
#undef SWRITE_HV
#undef SWRITE_H
#undef SLOAD_F
#undef SWRITE_KF
#undef SWRITE_VF


constexpr int QB2 = 128, NQB2 = SQ / QB2, SHM_V2 = 2 * SHM_V;
constexpr int P_OFF_K = 2 * SHM_V2, P_OFF_X = P_OFF_K + 2 * SHM_K, PAIR_RING = P_OFF_X + 2 * NW * 2048;
constexpr int P_OFF_L = PAIR_RING + 2048, P_OFF_CB = P_OFF_L + NW * 64 * 4, PAIR_LDS = P_OFF_CB + 2 * 64 * 4;
struct PRef { const bf16* Q; const bf16* K; const bf16* V; bf16* O; const float* C; int P0, jlo; float mref; };
template <int BUF, int NV>
__device__ __forceinline__ void pair_pv(f32x16* o, int vb0, bf16x8 pa0, bf16x8 pa1, bf16x8 pa2, bf16x8 pa3) {
#define TRRD(dst, off) asm volatile("ds_read_b64_tr_b16 %0, %1 offset:%2" : "=&v"(dst) : "v"(vb0), "i"(off) : "memory")
#define PV_D0(d0) do { s16x4 l0, l1, l2, l3, h0, h1, h2, h3; constexpr int b_ = BUF * SHM_V2 + v_rd_off(d0, 0, 0); \
        TRRD(l0, b_); TRRD(h0, b_ + 2048); TRRD(l1, b_ + 4096); TRRD(h1, b_ + 6144); TRRD(l2, b_ + 8192); TRRD(h2, b_ + 10240); TRRD(l3, b_ + 12288); TRRD(h3, b_ + 14336); \
        asm volatile("s_waitcnt lgkmcnt(0)" ::: "memory"); SBAR(); \
        o[d0] = __builtin_amdgcn_mfma_f32_32x32x16_bf16(pa0, (bf16x8){l0[0], l0[1], l0[2], l0[3], h0[0], h0[1], h0[2], h0[3]}, o[d0], 0, 0, 0); \
        o[d0] = __builtin_amdgcn_mfma_f32_32x32x16_bf16(pa1, (bf16x8){l1[0], l1[1], l1[2], l1[3], h1[0], h1[1], h1[2], h1[3]}, o[d0], 0, 0, 0); \
        o[d0] = __builtin_amdgcn_mfma_f32_32x32x16_bf16(pa2, (bf16x8){l2[0], l2[1], l2[2], l2[3], h2[0], h2[1], h2[2], h2[3]}, o[d0], 0, 0, 0); \
        o[d0] = __builtin_amdgcn_mfma_f32_32x32x16_bf16(pa3, (bf16x8){l3[0], l3[1], l3[2], l3[3], h3[0], h3[1], h3[2], h3[3]}, o[d0], 0, 0, 0); } while (0)
    PV_D0(0); PV_D0(1); if constexpr (NV == 4) { PV_D0(2); PV_D0(3); }
#undef PV_D0
#undef TRRD
}
struct PStage { bf16x8 k0, k1, v0, v1, v2, v3; float c; };
template <int NV>
__device__ __forceinline__ void pair_block(const PRef& B, char* lds, volatile __attribute__((address_space(3))) unsigned* PROFW) {
    PROF_T0(2);
    PROF_T0(8);
    const int tid = threadIdx.x, wid = __builtin_amdgcn_readfirstlane(tid >> 6), lane = tid & 63, r32 = lane & 31, hi = lane >> 5, pr = wid & 3, kh = wid >> 2;
    char* V_lds = lds; char* K_lds = lds + P_OFF_K; char* X_lds = lds + P_OFF_X; float* L_lds = (float*)(lds + P_OFF_L); float* cbw = (float*)(lds + P_OFF_CB);
    const int j_lo = B.jlo, NT = (B.P0 >> 6) + 2 - j_lo;
    const int sr = tid >> 4, sc = (tid & 15) * 8, vst0 = v_st(sr, sc), vst1 = v_st(32 + sr, sc), kws = KSWZ(sr, sc * 2);
    const int vb0 = (int)(uintptr_t)V_lds + kh * (NV == 4 ? SHM_V : 1024) + v_rd_base(lane);
    int ka[4];
#pragma unroll
    for (int dd = 0; dd < 4; ++dd) ka[dd] = (int)(uintptr_t)K_lds + kh * (32 * 256) + KSWZ(r32, (dd * 16 + hi * 8) * 2);
    constexpr float C2 = 1.4426950408889634f * SCALE;
    const float mnL = -B.mref * C2;
    const int qrow = B.P0 + pr * 32 + r32;
    bf16x8 qr[8];
#pragma unroll
    for (int d0 = 0; d0 < 8; ++d0) qr[d0] = load8<bf16>(B.Q + (size_t)(pr * 32 + r32) * LDQ + d0 * 16 + hi * 8);
    const float cq = B.C[qrow];
    f32x16 o[NV] = {}; float l_reg = 0.f;
    PStage stA, stB;
#define TCL(t) ((t) < NT ? (t) : NT - 1)
#define PLOADK(st, t) do { const int k0_ = (j_lo + TCL(t)) * KVBLK; const bf16* kp_ = B.K + (size_t)(k0_ + sr) * LDQ + sc; st.k0 = load8<bf16>(kp_); st.k1 = load8<bf16>(kp_ + (size_t)32 * LDQ); st.c = B.C[k0_ + (tid & 63)]; } while (0)
#define PLOADV(st, t) do { const int k0_ = (j_lo + TCL(t)) * KVBLK; const bf16* vp_ = B.V + (size_t)(k0_ + sr) * LDQ + sc; st.v0 = load8<bf16>(vp_); st.v1 = load8<bf16>(vp_ + (size_t)32 * LDQ); \
        if constexpr (NV == 4) { st.v2 = load8<bf16>(vp_ + 128); st.v3 = load8<bf16>(vp_ + (size_t)32 * LDQ + 128); } } while (0)
#define PWRITEK(st, bf) do { *(bf16x8*)(K_lds + (bf) * SHM_K + kws) = st.k0; *(bf16x8*)(K_lds + (bf) * SHM_K + kws + 32 * 256) = st.k1; if (tid < 64) cbw[(bf) * 64 + tid] = st.c; } while (0)
#define PWRITEV(st, bf) do { *(bf16x8*)(V_lds + (bf) * SHM_V2 + vst0) = st.v0; *(bf16x8*)(V_lds + (bf) * SHM_V2 + vst1) = st.v1; \
        if constexpr (NV == 4) { *(bf16x8*)(V_lds + (bf) * SHM_V2 + SHM_V + vst0) = st.v2; *(bf16x8*)(V_lds + (bf) * SHM_V2 + SHM_V + vst1) = st.v3; } } while (0)
#define KRD_(dst, d0, KB) asm volatile("ds_read_b128 %0, %1 offset:%2" : "=&v"(dst) : "v"(ka[(d0) & 3]), "i"((KB) * SHM_K + ((d0) >> 2) * 128) : "memory")
#define KWT_(n, r) asm volatile("s_waitcnt lgkmcnt(" #n ")" : "+v"(r) :: "memory")
#define ASTAGE(t, KB, XB) do { \
        f32x16 p; { const f32x4* c4 = (const f32x4*)(cbw + (KB) * 64 + 32 * kh + 4 * hi); \
            _Pragma("unroll") for (int g = 0; g < 4; ++g) { const f32x4 a = c4[2 * g]; _Pragma("unroll") for (int i = 0; i < 4; ++i) p[4 * g + i] = cq - a[i]; } } \
        { bf16x8 kf0, kf1, kf2, kf3;     \
          KRD_(kf0, 0, KB); KRD_(kf1, 1, KB); KRD_(kf2, 2, KB); KRD_(kf3, 3, KB); \
          KWT_(3, kf0); p = __builtin_amdgcn_mfma_f32_32x32x16_bf16(kf0, qr[0], p, 0, 0, 0); KRD_(kf0, 4, KB); \
          KWT_(3, kf1); p = __builtin_amdgcn_mfma_f32_32x32x16_bf16(kf1, qr[1], p, 0, 0, 0); KRD_(kf1, 5, KB); \
          KWT_(3, kf2); p = __builtin_amdgcn_mfma_f32_32x32x16_bf16(kf2, qr[2], p, 0, 0, 0); KRD_(kf2, 6, KB); \
          KWT_(3, kf3); p = __builtin_amdgcn_mfma_f32_32x32x16_bf16(kf3, qr[3], p, 0, 0, 0); KRD_(kf3, 7, KB); \
          KWT_(3, kf0); p = __builtin_amdgcn_mfma_f32_32x32x16_bf16(kf0, qr[4], p, 0, 0, 0); \
          KWT_(2, kf1); p = __builtin_amdgcn_mfma_f32_32x32x16_bf16(kf1, qr[5], p, 0, 0, 0); \
          KWT_(1, kf2); p = __builtin_amdgcn_mfma_f32_32x32x16_bf16(kf2, qr[6], p, 0, 0, 0); \
          KWT_(0, kf3); p = __builtin_amdgcn_mfma_f32_32x32x16_bf16(kf3, qr[7], p, 0, 0, 0); } \
        { const int kb = (j_lo + (t)) * KVBLK + 32 * kh; if (kb + 31 > B.P0 + pr * 32) { const int dq = qrow - kb - 4 * hi; const float NEG = -__builtin_inff(); \
            _Pragma("unroll") for (int r = 0; r < 16; ++r) { const int c = (r & 3) + 8 * (r >> 2); if (dq - c < 0) p[r] = NEG; } } } \
        _Pragma("unroll") for (int r = 0; r < 16; ++r) p[r] = __builtin_amdgcn_exp2f(fmaf(p[r], C2, mnL)); \
        { float ps = 0.f; _Pragma("unroll") for (int r = 0; r < 16; ++r) ps += p[r]; \
          auto rr = __builtin_amdgcn_permlane32_swap(__float_as_uint(ps), __float_as_uint(ps), false, false); l_reg += __uint_as_float(rr[0]) + __uint_as_float(rr[1]); } \
        { unsigned a0 = cvtpk(p[0], p[1]), a1 = cvtpk(p[2], p[3]), b0 = cvtpk(p[4], p[5]), b1 = cvtpk(p[6], p[7]); \
          auto r0 = __builtin_amdgcn_permlane32_swap(a0, b0, false, false); auto r1 = __builtin_amdgcn_permlane32_swap(a1, b1, false, false); u32x4 w = {r0[0], r1[0], r0[1], r1[1]}; \
          *(u32x4*)(X_lds + (XB) * (NW * 2048) + wid * 2048 + lane * 16) = w; } \
        { unsigned a0 = cvtpk(p[8], p[9]), a1 = cvtpk(p[10], p[11]), b0 = cvtpk(p[12], p[13]), b1 = cvtpk(p[14], p[15]); \
          auto r0 = __builtin_amdgcn_permlane32_swap(a0, b0, false, false); auto r1 = __builtin_amdgcn_permlane32_swap(a1, b1, false, false); u32x4 w = {r0[0], r1[0], r0[1], r1[1]}; \
          *(u32x4*)(X_lds + (XB) * (NW * 2048) + wid * 2048 + 1024 + lane * 16) = w; } } while (0)
#define BSTAGE(VB, XB) do { const char* xo_ = X_lds + (XB) * (NW * 2048) + wid * 2048 + lane * 16; const char* xp_ = X_lds + (XB) * (NW * 2048) + (wid ^ 4) * 2048 + lane * 16; \
        const bf16x8 own0 = *(const bf16x8*)xo_, own1 = *(const bf16x8*)(xo_ + 1024), oth0 = *(const bf16x8*)xp_, oth1 = *(const bf16x8*)(xp_ + 1024); \
        pair_pv<VB, NV>(o, vb0, kh ? oth0 : own0, kh ? oth1 : own1, kh ? own0 : oth0, kh ? own1 : oth1); } while (0)
    PLOADK(stA, 0); PLOADV(stA, 0); PLOADK(stB, 1); PLOADV(stB, 1);
    __syncthreads();
    PWRITEK(stA, 0); PWRITEV(stA, 0);
    PLOADK(stA, 2);
    __syncthreads();
    PROF_T1(8);
    PROF_T0(9);
    ASTAGE(0, 0, 0);
    PWRITEK(stB, 1);
    PLOADV(stA, 2); PLOADK(stB, 3);
    __syncthreads();
#define PITER(t, P, SV, SK) do {     \
        BSTAGE(P, P); \
        if ((t) + 1 < NT) { ASTAGE((t) + 1, (P) ^ 1, (P) ^ 1); PWRITEV(SV, (P) ^ 1); PWRITEK(SK, P); PLOADV(SV, (t) + 3); PLOADK(SK, (t) + 4); } \
        __syncthreads(); } while (0)
    PROF_T1(9);
    PROF_T1(2);
    { PROF_T0(3);
    int t = 0;
    for (; t + 1 < NT; t += 2) { PITER(t, 0, stB, stA); PITER(t + 1, 1, stA, stB); }
    if (t < NT) PITER(t, 0, stB, stA);
    PROF_T1(3); }
    { PROF_T0(4);
    { PROF_T0(6);
    if (hi == 0) L_lds[wid * 64 + r32] = l_reg;
    __syncthreads();
    PROF_T1(6); }
    PROF_T0(7);
    if (hi == 0) L_lds[wid * 64 + 32 + r32] = l_reg + L_lds[(wid ^ 4) * 64 + r32];
    asm volatile("s_waitcnt lgkmcnt(0)" ::: "memory");
    float rli[16];
#pragma unroll
    for (int r = 0; r < 16; ++r) rli[r] = __builtin_amdgcn_rcpf(L_lds[wid * 64 + 32 + crow(r, hi)]);
    constexpr int OROW = NV * 64 + 16;
    char* ot = lds + wid * (32 * (4 * 64 + 16));
    const bool odd = (r32 & 1) != 0;
#pragma unroll
    for (int r = 0; r < 16; ++r) { const int orow = crow(r, hi);
#pragma unroll
        for (int d0 = 0; d0 < NV; d0 += 2) { const float va = o[d0][r] * rli[r], vb = o[d0 + 1][r] * rli[r];
            const float snd = odd ? va : vb;
            const float rcv = __uint_as_float((unsigned)__builtin_amdgcn_update_dpp(0, (int)__float_as_uint(snd), 0xB1, 0xF, 0xF, true));
            const unsigned pk = cvtpk(odd ? rcv : va, odd ? vb : rcv);
            *(unsigned*)(ot + orow * OROW + ((odd ? d0 + 1 : d0) * 32 + (r32 & ~1)) * 2) = pk; } }
    asm volatile("s_waitcnt lgkmcnt(0)" ::: "memory");
    PROF_T0(10);
    bf16* Ow = B.O + (size_t)(pr * 32) * LDO + kh * (NV * 32);
    constexpr int CPR = NV * 4;
#pragma unroll
    for (int i = 0; i < (32 * CPR) / 64; ++i) { const int idx = i * 64 + lane, row = idx / CPR, ch = idx % CPR;
        const u32x4 w = *(const u32x4*)(ot + row * OROW + ch * 16);
        *(u32x4*)(Ow + (size_t)row * LDO + ch * 8) = w; }
    PROF_T1(10);
    PROF_T1(7);
    PROF_T1(4); }
#undef TCL
#undef PLOADK
#undef PLOADV
#undef PWRITEK
#undef PWRITEV
#undef KRD_
#undef KWT_
#undef ASTAGE
#undef BSTAGE
#undef PITER
}

constexpr float SKIP_T = 16.f;
constexpr int NDIFF = 16 * NQB2, NFOX = 16 * NQB2;
struct Tensors { const bf16* QKV; bf16* A2; bf16* DT; const float* BIAS; const unsigned* NRM; };
__host__ __device__ constexpr int est_diff(int h, int qb2) { const int full = 2 * (qb2 + 1), cap = h == 0 ? 5 : (h == 1 ? 12 : (h == 2 ? 38 : 128)); return full < cap ? full : cap; }
__host__ __device__ constexpr int est_fox(int qb2) { const int full = 2 * (qb2 + 1); return full < 14 ? full : 14; }
struct OrderTab2 { unsigned short v[NDIFF]; };
template <bool FOX> __host__ __device__ constexpr OrderTab2 make_order2() {
    OrderTab2 t{}; int start[130] = {};
    for (int pp = 0; pp < 16; ++pp) for (int qb = 0; qb < NQB2; ++qb) start[128 - (FOX ? est_fox(qb) : est_diff((pp >> 1) & 3, qb)) + 1]++;
    for (int i = 1; i < 130; ++i) start[i] += start[i - 1];
    for (int pp = 0; pp < 16; ++pp) for (int qb = NQB2 - 1; qb >= 0; --qb) { const int b = 128 - (FOX ? est_fox(qb) : est_diff((pp >> 1) & 3, qb)); t.v[start[b]++] = (unsigned short)(pp * 64 + qb); }
    return t;
}
__device__ const OrderTab2 ORDER_D = make_order2<false>();
__device__ const OrderTab2 ORDER_F = make_order2<true>();
constexpr int ORD_OFF = PAIR_LDS, NRMW_OFF = ORD_OFF + NDIFF * 2, DG_OFF = NRMW_OFF + 256;
template <bool FOX>
__device__ __forceinline__ PRef make_pref(const Tensors& T, const char* lds, int o, int lane) {
    const int code = __builtin_amdgcn_readfirstlane((int)((const unsigned short*)(lds + ORD_OFF))[o]), pp = code >> 6, qb = code & 63, b = pp >> 3;
    PRef r; int sq, sk;
    const bf16* base = T.QKV + (size_t)b * S * LDQ; r.P0 = qb * QB2;
    if (FOX) { const int h = pp & 7; r.Q = base + (size_t)qb * QB2 * LDQ + C_FQ + h * 128; r.K = base + C_FK + h * 128; r.V = base + C_FV + h * 128; sq = h; sk = 8 + h;
        r.O = T.A2 + ((size_t)b * S + (size_t)qb * QB2) * LDO + h * 128; r.C = T.BIAS + (size_t)(b * 8 + h) * S; }
    else { const int h = (pp >> 1) & 3, mp = pp & 1; r.Q = base + (size_t)qb * QB2 * LDQ + C_DQ + h * 256 + mp * 128; r.K = base + C_DK + h * 256 + mp * 128; r.V = base + C_DV + h * 256; sq = 16 + 2 * h + mp; sk = 24 + 2 * h + mp;
        r.O = T.DT + ((size_t)b * S + (size_t)qb * QB2) * LDO + h * 512 + mp * 256; r.C = T.BIAS + (size_t)(16 + h) * S; }
    const int jd = r.P0 >> 6;
    int ln = lane; asm volatile("" : "+v"(ln));
    const int j0 = ln < jd ? ln : jd, j1 = ln + 64 < jd ? ln + 64 : jd;
    const float cp = r.C[r.P0], c0 = r.C[64 * j0 + 63], c1 = r.C[64 * j1 + 63];
    const float nq = ((const float*)(lds + NRMW_OFF))[b * 32 + sq], nk = ((const float*)(lds + NRMW_OFF))[b * 32 + sk];
    const float qk = 1.015f * sqrtf(nq * nk);
    float bw;
    { const int tid = (int)threadIdx.x; int tt = tid; asm volatile("" : "+v"(tt));
      const int row = tt >> 2, part = tt & 3;
      const bf16* qp = r.Q + (size_t)row * LDQ + part * 32; const bf16* kp = r.K + (size_t)(r.P0 + row) * LDQ + part * 32;
      bf16x8 qa[4], ka[4];
#pragma unroll
      for (int i = 0; i < 4; ++i) { qa[i] = load8<bf16>(qp + 8 * i); ka[i] = load8<bf16>(kp + 8 * i); }
      float d = 0.f, qq = 0.f;
#pragma unroll
      for (int i = 0; i < 4; ++i)
#pragma unroll
          for (int e = 0; e < 8; ++e) { const float fa = __uint_as_float((unsigned)(unsigned short)qa[i][e] << 16), fb = __uint_as_float((unsigned)(unsigned short)ka[i][e] << 16); d = fmaf(fa, fb, d); qq = fmaf(fa, fa, qq); }
      d += __shfl_xor(d, 1); qq += __shfl_xor(qq, 1); d += __shfl_xor(d, 2); qq += __shfl_xor(qq, 2);
      bw = 1.015f * sqrtf(qq * nk) - d;
#pragma unroll
      for (int o_ = 4; o_ < 64; o_ <<= 1) bw = fmaxf(bw, __shfl_xor(bw, o_));
      float* dg = (float*)(lds + DG_OFF) + (o & 1) * 8;
      if ((tt & 63) == 0) dg[tt >> 6] = bw;
      __syncthreads();
      bw = fmaxf(fmaxf(fmaxf(dg[0], dg[1]), fmaxf(dg[2], dg[3])), fmaxf(fmaxf(dg[4], dg[5]), fmaxf(dg[6], dg[7])));
      bw = fminf(bw, 2.f * qk); }
    const float th = SKIP_T * (1.0f / SCALE) + bw, lim = cp + th; r.mref = qk;
    const bool k0 = (ln >= jd) | (c0 <= lim), k1 = (ln + 64 >= jd) | (c1 <= lim);
    const unsigned long long b0 = __ballot(k0), b1 = __ballot(k1);
    r.jlo = b0 ? (int)__builtin_ctzll(b0) : 64 + (int)__builtin_ctzll(b1);
    return r;
}
template <bool FOX>
__device__ __forceinline__ void attn_part(char* lds, const Tensors& T, unsigned* head, volatile __attribute__((address_space(3))) int* qw) {
    volatile __attribute__((address_space(3))) unsigned* PROFW = (volatile __attribute__((address_space(3))) unsigned*)(qw + 8);
    PROF_T0(5);
    const int tid = threadIdx.x, lane = tid & 63;
    if (tid == 0) qw[0] = (int)atomicAdd(head, 1u);
    ((unsigned*)(lds + ORD_OFF))[tid] = ((const unsigned*)(FOX ? ORDER_F.v : ORDER_D.v))[tid];
    if (tid < 64) ((unsigned*)(lds + NRMW_OFF))[tid] = T.NRM[tid];
    __syncthreads();
    int k = __builtin_amdgcn_readfirstlane(qw[0]);
    while (k < NDIFF) {
        int kn = 0; if (tid == 0) kn = (int)atomicAdd(head, 1u);
        PROF_T0(1);
        const PRef B = make_pref<FOX>(T, lds, k, lane);
        PROF_T1(1);
        pair_block<FOX ? 2 : 4>(B, lds, PROFW);
        if (tid == 0) qw[1] = kn;
        __syncthreads();
        k = __builtin_amdgcn_readfirstlane(qw[1]);
    }
    __syncthreads();
    PROF_T1(5);
}
#undef KSWZ
#undef SBAR
}

#define GAS __attribute__((address_space(1)))
#define LAS __attribute__((address_space(3)))
typedef unsigned short bf16;
typedef unsigned v4u __attribute__((ext_vector_type(4)));
typedef float f32x4 __attribute__((ext_vector_type(4)));
typedef short bf16x8 __attribute__((ext_vector_type(8)));
typedef GAS unsigned gu32;
typedef GAS unsigned long long gu64;
#define RLX_AGENT __ATOMIC_RELAXED, __HIP_MEMORY_SCOPE_AGENT
#define LDS_WAIT() asm volatile("s_waitcnt lgkmcnt(0)" ::: "memory")
#define VM_WAIT() asm volatile("s_waitcnt vmcnt(0)" ::: "memory")
__device__ __forceinline__ unsigned long long rt() { return __builtin_amdgcn_s_memrealtime(); }
__device__ __forceinline__ unsigned f2bf(float f) { unsigned u = __builtin_bit_cast(unsigned, f); return (u + 0x7fffu + ((u >> 16) & 1u)) >> 16; }
__device__ __forceinline__ unsigned pk2(float lo, float hi) { return f2bf(lo) | (f2bf(hi) << 16); }

#define XB_TMO      128
#define XB_XCNT(j)  (256  + 64 * (j))
#define XB_XSUB(j)  (1280 + 64 * (j))
#define XB_XGEN(j)  (2304 + 64 * (j))
#define XB_TOP      3328
#define XB_TOPGEN   3392
#define XCD_BAR_WORDS 3456
#define XB_SPIN_CAP (1u << 18)

__device__ __forceinline__ unsigned xb_ld(unsigned* p)              { return __hip_atomic_load(p, __ATOMIC_RELAXED, __HIP_MEMORY_SCOPE_AGENT); }
__device__ __forceinline__ unsigned xb_add(unsigned* p, unsigned v) { return __hip_atomic_fetch_add(p, v, __ATOMIC_RELAXED, __HIP_MEMORY_SCOPE_AGENT); }
__device__ __forceinline__ unsigned xb_xcc_id() { return (unsigned)__builtin_amdgcn_s_getreg((3 << 11) | 20) & 0xFu; }
#define XB_SPIN(cond, bar) do { unsigned _sp = 0; while (cond) { __builtin_amdgcn_s_sleep(1); \
    if ((++_sp & 255u) == 0u) { if (xb_ld(&(bar)[XB_TMO])) break; if (_sp > XB_SPIN_CAP) { atomicAdd(&(bar)[XB_TMO], 1u); break; } } } } while (0)

struct XcdBarrier {
    unsigned* bar; unsigned x;
    volatile LAS unsigned* st;
};

__device__ __forceinline__ XcdBarrier xcd_barrier_post(unsigned* bar, volatile LAS unsigned* st) {
    XcdBarrier b; b.bar = bar; b.x = xb_xcc_id(); b.st = st;
    if (threadIdx.x == 0) (void)xb_add(&bar[XB_XCNT(b.x)], 1u);
    return b;
}
__device__ __forceinline__ void xcd_barrier_complete(unsigned* bar, unsigned x, unsigned& nloc, unsigned& nx) {
    const unsigned G = gridDim.x * gridDim.y * gridDim.z;
    unsigned sum, cnt, mine, sp = 0u;
    for (;;) {
        sum = 0u; cnt = 0u; mine = 0u;
#pragma unroll
        for (unsigned j = 0; j < 16; ++j) { const unsigned c = xb_ld(&bar[XB_XCNT(j)]); sum += c; cnt += (c > 0u) ? 1u : 0u; mine = (j == x) ? c : mine; }
        if (sum == G) break;
        __builtin_amdgcn_s_sleep(1);
        if ((++sp & 255u) == 0u) { if (xb_ld(&bar[XB_TMO])) break; if (sp > XB_SPIN_CAP) { atomicAdd(&bar[XB_TMO], 1u); break; } }
    }
    nloc = mine > 0u ? mine : 1u; nx = cnt > 0u ? cnt : 1u;
}

__device__ __forceinline__ void xcd_barrier(const XcdBarrier& b) {
    asm volatile("s_waitcnt vmcnt(0)" ::: "memory");
    __syncthreads();
    if (threadIdx.x == 0) {
        unsigned* bar = b.bar;
        __builtin_amdgcn_s_waitcnt(0);
        unsigned nloc = b.st[0], nx = b.st[1];
        if (nloc == 0u) { xcd_barrier_complete(bar, b.x, nloc, nx); b.st[0] = nloc; b.st[1] = nx; }
        const unsigned old = xb_add(&bar[XB_XSUB(b.x)], 1u);
        const unsigned gen = old / nloc;
        if (old + 1u == (gen + 1u) * nloc) {
            __builtin_amdgcn_fence(__ATOMIC_RELEASE, "agent");
            asm volatile("s_waitcnt vmcnt(0)" ::: "memory");
            const unsigned og = xb_add(&bar[XB_TOP], 1u);
            const unsigned tg = og / nx;
            if (og + 1u == (tg + 1u) * nx) xb_add(&bar[XB_TOPGEN], 1u);
            else XB_SPIN(xb_ld(&bar[XB_TOPGEN]) == tg, bar);
            __builtin_amdgcn_fence(__ATOMIC_ACQUIRE, "agent");
            xb_add(&bar[XB_XGEN(b.x)], 1u);
            asm volatile("s_waitcnt vmcnt(0)" ::: "memory");
        } else {
            XB_SPIN(xb_ld(&bar[XB_XGEN(b.x)]) == gen, bar);
            __builtin_amdgcn_fence(__ATOMIC_ACQUIRE, "agent");
            asm volatile("s_waitcnt vmcnt(0)" ::: "memory");
        }
    }
    __syncthreads();
}

constexpr int NWAVES = 8;
constexpr int RING_OFF = 0, RING_BYTES = 131072;
constexpr int LDSCTL_OFF = RING_BYTES, MISC_OFF = LDSCTL_OFF + 320;
constexpr int SEG_OFF = LDSCTL_OFF + 1024;
constexpr int TILE_E_OFF = LDSCTL_OFF + 2048;
constexpr int CNTL_OFF = LDSCTL_OFF + 1536;
constexpr int TILE_NR_OFF = TILE_E_OFF + 2048;
constexpr int TILE_RB_OFF = TILE_E_OFF + 1024;
constexpr int ECAP = M;
constexpr int NRMP_OFF = LDSCTL_OFF + 4096;
constexpr int LDS_BYTES = 147456;
constexpr int ATT_QW_OFF = LDSCTL_OFF + 512;
static_assert(att::PAIR_RING == RING_BYTES && att::PAIR_LDS <= LDS_BYTES && att::P_OFF_L >= ATT_QW_OFF + 64 && att::LDS_BYTES <= RING_BYTES && TILE_E_OFF + NTILE_MAX * 4 <= LDS_BYTES, "LDS map");

struct Args { const float* in[19]; float* out; unsigned char* ws; int ph_lo, ph_hi, li, pad; };

struct Ctx {
    LAS unsigned char* lds; int tid, lane, wave, G, gw, NGW;
    const float *x, *attn_g, *w_in, *fbias, *lq1, *lk1, *lq2, *lk2, *subg, *w_out, *ffn_g, *wg, *bg, *we, *be, *wgate, *wup, *wdown, *fin_g;
    float* out;
    bf16* A1; bf16* WIN; bf16* WOUT; float* BIAS; bf16* QKV; bf16* A2; bf16* DT; bf16* H1;
    int* tok_e; int* tok_pos; float* tok_gate; float* rstd; float* rowgate; int* rowtok; int* etok; float* egate; float* WR; bf16* XG; bf16* HB; bf16* Y; bf16* WGU; bf16* WD; unsigned* cnt; unsigned* nrm;
};
__device__ __forceinline__ float wave_sum(float v) {
#pragma unroll
    for (int o = 1; o < 64; o <<= 1) v += __shfl_xor(v, o);
    return v;
}
typedef unsigned v2u __attribute__((ext_vector_type(2)));

__device__ __forceinline__ void p0_row2(const Ctx& C, int t0, int t1, const LAS float* wf) {
    const int lane = C.lane; const float* xr0 = C.x + (size_t)t0 * DM; const float* xr1 = C.x + (size_t)t1 * DM;
    f32x4 v0[8], v1[8]; float ss0 = 0.f, ss1 = 0.f;
#pragma unroll
    for (int j = 0; j < 8; ++j) { v0[j] = *(const f32x4*)(xr0 + j * 256 + lane * 4); v1[j] = *(const f32x4*)(xr1 + j * 256 + lane * 4); }
#pragma unroll
    for (int j = 0; j < 8; ++j) { ss0 += (v0[j].x * v0[j].x + v0[j].y * v0[j].y) + (v0[j].z * v0[j].z + v0[j].w * v0[j].w); ss1 += (v1[j].x * v1[j].x + v1[j].y * v1[j].y) + (v1[j].z * v1[j].z + v1[j].w * v1[j].w); }
    const float r0 = 1.f / sqrtf(wave_sum(ss0) * (1.f / DM) + 1e-6f), r1 = 1.f / sqrtf(wave_sum(ss1) * (1.f / DM) + 1e-6f);
    float fl0[8] = {0.f, 0.f, 0.f, 0.f, 0.f, 0.f, 0.f, 0.f}, fl1[8] = {0.f, 0.f, 0.f, 0.f, 0.f, 0.f, 0.f, 0.f};
#pragma unroll
    for (int j = 0; j < 8; ++j) {
        const f32x4 gg = *(const f32x4*)(C.attn_g + j * 256 + lane * 4);
        v0[j] = v0[j] * r0 * gg; v1[j] = v1[j] * r1 * gg;
        v2u o; o.x = pk2(v0[j].x, v0[j].y); o.y = pk2(v0[j].z, v0[j].w);
        *(v2u*)(C.A1 + (size_t)t0 * DM + j * 256 + lane * 4) = o;
        o.x = pk2(v1[j].x, v1[j].y); o.y = pk2(v1[j].z, v1[j].w);
        *(v2u*)(C.A1 + (size_t)t1 * DM + j * 256 + lane * 4) = o;
#pragma unroll
        for (int h = 0; h < 8; ++h) { const f32x4 w4 = *(const LAS f32x4*)(wf + h * DM + j * 256 + lane * 4);
            fl0[h] += (v0[j].x * w4.x + v0[j].y * w4.y) + (v0[j].z * w4.z + v0[j].w * w4.w); fl1[h] += (v1[j].x * w4.x + v1[j].y * w4.y) + (v1[j].z * w4.z + v1[j].w * w4.w); }
        asm volatile("" ::: "memory");
    }
#pragma unroll
    for (int h = 0; h < 8; ++h) { fl0[h] = wave_sum(fl0[h]); fl1[h] = wave_sum(fl1[h]); }
    float z0 = fl0[0], z1 = fl1[0];
#pragma unroll
    for (int h = 1; h < 8; ++h) { z0 = (lane == h) ? fl0[h] : z0; z1 = (lane == h) ? fl1[h] : z1; }
    if (lane < 8) { z0 += C.fbias[lane]; z1 += C.fbias[lane];
        C.BIAS[(size_t)((t0 / S) * 8 + lane) * S + (t0 % S)] = fminf(z0, 0.f) - log1pf(expf(-fabsf(z0)));
        C.BIAS[(size_t)((t1 / S) * 8 + lane) * S + (t1 % S)] = fminf(z1, 0.f) - log1pf(expf(-fabsf(z1))); }
}
__device__ __forceinline__ void tr_item(const float* src, int ld, int k0, int c0, bf16* dst, int K, int r0, LAS float* scr, int lane) {
    { f32x4 v[8];
#pragma unroll
      for (int i = 0; i < 8; ++i) v[i] = *(const f32x4*)(src + (size_t)(k0 + 8 * i + (lane >> 3)) * ld + c0 + 4 * (lane & 7));
#pragma unroll
      for (int i = 0; i < 8; ++i) { LAS float* d = scr + (8 * i + (lane >> 3)) * 33 + 4 * (lane & 7); d[0] = v[i].x; d[1] = v[i].y; d[2] = v[i].z; d[3] = v[i].w; } }
    LDS_WAIT(); asm volatile("" ::: "memory");
    const int c = lane & 7;
#pragma unroll
    for (int j = 0; j < 4; ++j) { const int n = (lane >> 3) + 8 * j; const LAS float* s = scr + (8 * c) * 33 + n;
        v4u o; o.x = pk2(s[0 * 33], s[1 * 33]); o.y = pk2(s[2 * 33], s[3 * 33]); o.z = pk2(s[4 * 33], s[5 * 33]); o.w = pk2(s[6 * 33], s[7 * 33]);
        *(GAS v4u*)(dst + (size_t)(r0 + n) * K + k0 + 8 * c) = o; }
    LDS_WAIT(); asm volatile("" ::: "memory");
}
__device__ __forceinline__ void p0_prologue(const Ctx& C) {
    LAS float* scr = (LAS float*)(C.lds + RING_OFF + C.wave * 16384);
    constexpr int I_WIN = 32 * 192, I_WOUT = 32 * 64, I_ALL = I_WIN + I_WOUT;
    for (int it = C.gw; it < I_ALL; it += C.NGW) {
        int r = it;
        if (r < I_WIN) { const int kb = r / 192, nb = r % 192; tr_item(C.w_in, NCOL, 64 * kb, nb < 96 ? 32 * nb : 32 * nb + 8, C.WIN, DM, 32 * nb, scr, C.lane); continue; } r -= I_WIN;
        { const int kb = r / 64, nb = r % 64; tr_item(C.w_out, DM, 64 * kb, 32 * nb, C.WOUT, DM, 32 * nb, scr, C.lane); }
    }
    __syncthreads();
    { LAS float* wf = (LAS float*)(C.lds + RING_OFF);
      for (int k = C.tid; k < DM; k += NWAVES * 64) { const float* wr = C.w_in + (size_t)k * NCOL + FCOL; const f32x4 w0 = *(const f32x4*)wr, w1 = *(const f32x4*)(wr + 4);
          wf[0 * DM + k] = w0.x; wf[1 * DM + k] = w0.y; wf[2 * DM + k] = w0.z; wf[3 * DM + k] = w0.w; wf[4 * DM + k] = w1.x; wf[5 * DM + k] = w1.y; wf[6 * DM + k] = w1.z; wf[7 * DM + k] = w1.w; }
      __syncthreads();
      for (int t = C.gw; t < M; t += 2 * C.NGW) { const int t1 = t + C.NGW; p0_row2(C, t, t1 < M ? t1 : t, wf); } }
    const int gt = C.gw * 64 + C.lane, NGT = C.NGW * 64;
    for (int i = gt; i < 4 * S; i += NGT) { const int h = i / S, s = i % S; C.BIAS[(size_t)(16 + h) * S + s] = -exp2f(-2.f * (float)(h + 1)) * (float)s * ATT_ISCALE; }
    for (int i = gt; i < 64 * 5 * 2 * 64; i += NGT) { const int ln = i & 63, hl = (i >> 6) & 1, b = (i >> 7) % 5, kk = (i >> 7) / 5, c = 16 * b + (ln & 15);
        unsigned w[4];
#pragma unroll
        for (int jp = 0; jp < 4; ++jp) { unsigned pk = 0;
#pragma unroll
            for (int q = 0; q < 2; ++q) { const int k = 32 * kk + 8 * (ln >> 4) + 2 * jp + q;
                const float v = (c < 8 ? C.wg[(size_t)k * 8 + c] : (c < 72 ? C.we[(size_t)k * NE + c - 8] : 0.f)) * C.ffn_g[k];
                const unsigned h = f2bf(v); const unsigned l = f2bf(v - __uint_as_float(h << 16));
                pk |= (hl ? l : h) << (16 * q); }
            w[jp] = pk; }
        ((v4u*)C.WR)[i] = (v4u){w[0], w[1], w[2], w[3]}; }
}
__device__ __forceinline__ void p1_cumsum(const Ctx& C) {
    if (blockIdx.x >= 16) return;
    float* p = C.BIAS + (size_t)blockIdx.x * S + C.tid * 16; LAS float* wt = (LAS float*)(C.lds + RING_OFF);
    float loc[16]; float s = 0.f;
    { const f32x4 a = *(const f32x4*)p, b = *(const f32x4*)(p + 4), c = *(const f32x4*)(p + 8), d = *(const f32x4*)(p + 12);
      loc[0] = a.x; loc[1] = a.y; loc[2] = a.z; loc[3] = a.w; loc[4] = b.x; loc[5] = b.y; loc[6] = b.z; loc[7] = b.w; loc[8] = c.x; loc[9] = c.y; loc[10] = c.z; loc[11] = c.w; loc[12] = d.x; loc[13] = d.y; loc[14] = d.z; loc[15] = d.w; }
#pragma unroll
    for (int i = 0; i < 16; ++i) { s += loc[i]; loc[i] = s; }
    float inc = s;
#pragma unroll
    for (int o = 1; o < 64; o <<= 1) { const float q = __shfl_up(inc, o); if (C.lane >= o) inc += q; }
    if (C.lane == 63) wt[C.wave] = inc;
    __syncthreads();
    float base = inc - s;
    for (int w = 0; w < C.wave; ++w) base += wt[w];
#pragma unroll
    for (int i = 0; i < 16; ++i) loc[i] = (base + loc[i]) * ATT_ISCALE;
    *(f32x4*)p = (f32x4){loc[0], loc[1], loc[2], loc[3]}; *(f32x4*)(p + 4) = (f32x4){loc[4], loc[5], loc[6], loc[7]};
    *(f32x4*)(p + 8) = (f32x4){loc[8], loc[9], loc[10], loc[11]}; *(f32x4*)(p + 12) = (f32x4){loc[12], loc[13], loc[14], loc[15]};
    __syncthreads();
}
__device__ __forceinline__ void p_norms(const Ctx& C) {
    const int lane = C.lane, b = C.gw & 1;
    float mx[8] = {0.f, 0.f, 0.f, 0.f, 0.f, 0.f, 0.f, 0.f};
    for (int rr = C.gw >> 1; rr < S; rr += C.NGW >> 1) {
        const bf16* row = C.QKV + (size_t)(b * S + rr) * NQKV + 8 * lane;
#pragma unroll
        for (int i = 0; i < 8; ++i) { const v4u w = *(const v4u*)(row + (i < 4 ? 512 * i : 1024 + 512 * i));
            float ss = 0.f;
#pragma unroll
            for (int c = 0; c < 4; ++c) { const float lo = __uint_as_float(w[c] << 16), hi = __uint_as_float(w[c] & 0xffff0000u); ss += lo * lo + hi * hi; }
            ss += __shfl_xor(ss, 1); ss += __shfl_xor(ss, 2); ss += __shfl_xor(ss, 4); ss += __shfl_xor(ss, 8);
            mx[i] = fmaxf(mx[i], ss); }
    }
    if ((lane & 15) == 0) {
#pragma unroll
        for (int i = 0; i < 8; ++i) atomicMax(C.nrm + b * 32 + 4 * i + (lane >> 4), __float_as_uint(mx[i]));
    }
}
__device__ __forceinline__ void p3_combine(const Ctx& C) {
    const int lane = C.lane;
    const float s1 = wave_sum(C.lq1[lane] * C.lk1[lane] + C.lq1[lane + 64] * C.lk1[lane + 64]);
    const float s2 = wave_sum(C.lq2[lane] * C.lk2[lane] + C.lq2[lane + 64] * C.lk2[lane + 64]);
    const float lam = expf(s1) - expf(s2) + 0.2f;
    const f32x4 gg = *(const f32x4*)(C.subg + lane * 4);
    for (int idx = C.gw; idx < M * 4; idx += C.NGW) {
        const int t = idx >> 2, h = idx & 3;
        const bf16* p = C.DT + (size_t)t * DM + h * 512 + lane * 4;
        const v2u a = *(const v2u*)p, b = *(const v2u*)(p + 256);
        f32x4 d;
        d.x = __uint_as_float(a.x << 16) - lam * __uint_as_float(b.x << 16); d.y = __uint_as_float(a.x & 0xffff0000u) - lam * __uint_as_float(b.x & 0xffff0000u);
        d.z = __uint_as_float(a.y << 16) - lam * __uint_as_float(b.y << 16); d.w = __uint_as_float(a.y & 0xffff0000u) - lam * __uint_as_float(b.y & 0xffff0000u);
        const float ss = wave_sum((d.x * d.x + d.y * d.y) + (d.z * d.z + d.w * d.w));
        const float r = 0.8f / sqrtf(ss * (1.f / 256.f) + 1e-5f);
        v2u o; o.x = pk2(d.x * r * gg.x, d.y * r * gg.y); o.y = pk2(d.z * r * gg.z, d.w * r * gg.w);
        *(v2u*)(C.A2 + (size_t)t * DM + 1024 + h * 256 + lane * 4) = o;
    }
}
__device__ __forceinline__ void p5a_router(const Ctx& C) {
    const int w = C.wave, th = w & 1, ks = w >> 1;
    LAS float* R1 = (LAS float*)(C.lds + RING_OFF);
    LAS float* SS = (LAS float*)(C.lds + RING_OFF + 81920);
    LAS float* RS = SS + 512;
    LAS float* lg = (LAS float*)(C.lds + RING_OFF + 86016);
    for (int tl = (int)blockIdx.x; tl < M / 64; tl += C.G) {
        int lane = C.lane; asm volatile("" : "+v"(lane));
        const int r = lane & 15, g = lane >> 4;
        const int t0 = tl * 64;
        f32x4 acc[2][5];
#pragma unroll
        for (int T = 0; T < 2; ++T)
#pragma unroll
            for (int b = 0; b < 5; ++b) acc[T][b] = (f32x4){0.f, 0.f, 0.f, 0.f};
        float ss[2] = {0.f, 0.f};
        const bf16* hb = C.H1 + (size_t)(t0 + 32 * th) * DM + 512 * ks; const unsigned ho = (unsigned)(r * DM + 8 * g);
        const v4u* wp = (const v4u*)C.WR + (size_t)(16 * ks) * 10 * 64 + lane;
        v4u a[4][2], tb[10];
#define RT_LA(slot, j_) do { _Pragma("unroll") for (int T = 0; T < 2; ++T) a[slot][T] = *(const v4u*)(hb + (ho + (unsigned)(16 * T * DM + 32 * (j_)))); } while (0)
        RT_LA(0, 0);
#pragma unroll
        for (int q = 0; q < 10; ++q) tb[q] = wp[q * 64];
        RT_LA(1, 1); RT_LA(2, 2); RT_LA(3, 3);
#pragma unroll
        for (int j = 0; j < 16; ++j) {
            __builtin_amdgcn_sched_barrier(0);
#pragma unroll
            for (int T = 0; T < 2; ++T)
#pragma unroll
                for (int c = 0; c < 4; ++c) { const unsigned x = a[j & 3][T][c]; const float lo = __uint_as_float(x << 16), hi = __uint_as_float(x & 0xffff0000u); ss[T] += lo * lo + hi * hi; }
#pragma unroll
            for (int b = 0; b < 5; ++b) {
#pragma unroll
                for (int T = 0; T < 2; ++T) acc[T][b] = __builtin_amdgcn_mfma_f32_16x16x32_bf16(__builtin_bit_cast(bf16x8, a[j & 3][T]), __builtin_bit_cast(bf16x8, tb[2 * b]), acc[T][b], 0, 0, 0);
#pragma unroll
                for (int T = 0; T < 2; ++T) acc[T][b] = __builtin_amdgcn_mfma_f32_16x16x32_bf16(__builtin_bit_cast(bf16x8, a[j & 3][T]), __builtin_bit_cast(bf16x8, tb[2 * b + 1]), acc[T][b], 0, 0, 0);
                __builtin_amdgcn_sched_barrier(0);
                if (j + 1 < 16) { tb[2 * b] = wp[((j + 1) * 10 + 2 * b) * 64]; tb[2 * b + 1] = wp[((j + 1) * 10 + 2 * b + 1) * 64]; }
                __builtin_amdgcn_sched_barrier(0);
            }
            if (j + 4 < 16) RT_LA(j & 3, j + 4);
        }
#undef RT_LA
        asm volatile("" ::: "memory");
#pragma unroll
        for (int T = 0; T < 2; ++T) { ss[T] += __int_as_float(__builtin_amdgcn_ds_bpermute((lane ^ 16) << 2, __float_as_int(ss[T]))); ss[T] += __int_as_float(__builtin_amdgcn_ds_bpermute((lane ^ 32) << 2, __float_as_int(ss[T])));
            if (lane < 16) SS[ks * 64 + 16 * (2 * th + T) + lane] = ss[T]; }
        if (ks >= 2) {
#pragma unroll
            for (int T = 0; T < 2; ++T)
#pragma unroll
                for (int b = 0; b < 5; ++b)
#pragma unroll
                    for (int i = 0; i < 4; ++i) R1[((th * 2 + (ks - 2)) * 40 + (T * 5 + b) * 4 + i) * 64 + lane] = acc[T][b][i];
        }
        __syncthreads();
        if (ks < 2) {
#pragma unroll
            for (int T = 0; T < 2; ++T)
#pragma unroll
                for (int b = 0; b < 5; ++b)
#pragma unroll
                    for (int i = 0; i < 4; ++i) { LAS float* q = R1 + ((th * 2 + ks) * 40 + (T * 5 + b) * 4 + i) * 64 + lane; *q = acc[T][b][i] + *q; }
            if (w == 0) { const float s = (SS[lane] + SS[64 + lane]) + (SS[128 + lane] + SS[192 + lane]);
                const float rs = 1.f / sqrtf(s * (1.f / DM) + 1e-6f); RS[lane] = rs; C.rstd[t0 + lane] = rs; }
        }
        __syncthreads();
#pragma unroll
        for (int m = 0; m < 10; ++m) { const int sl = w + 8 * m, T = sl / 20, b = (sl % 20) >> 2, i = sl & 3, tok = 16 * T + 4 * g + i, s2 = sl % 40, hh = sl / 40;
            const float v = R1[((hh * 2 + 0) * 40 + s2) * 64 + lane] + R1[((hh * 2 + 1) * 40 + s2) * 64 + lane];
            lg[tok * 81 + 16 * b + r] = v * RS[tok]; }
        __syncthreads();
        if (w == 0) {
            const int t = t0 + lane; const LAS float* row = lg + lane * 81;
            float gmax = -__builtin_inff(); int gi = 0; float gl[8];
#pragma unroll
            for (int j = 0; j < 8; ++j) { gl[j] = row[j] + C.bg[j]; if (gl[j] > gmax) { gmax = gl[j]; gi = j; } }
            float gs = 0.f;
#pragma unroll
            for (int j = 0; j < 8; ++j) gs += expf(gl[j] - gmax);
            const float gprob = 1.f / gs;
            float l1 = -__builtin_inff(), l2 = -__builtin_inff(); int i1 = 0, i2 = 0;
#pragma unroll
            for (int j = 0; j < 8; ++j) { const float q = row[8 + gi * 8 + j] + C.be[gi * 8 + j];
                if (q > l1) { l2 = l1; i2 = i1; l1 = q; i1 = j; } else if (q > l2) { l2 = q; i2 = j; } }
            const float e2 = expf(l2 - l1), g1 = gprob / (1.f + e2), g2 = gprob * e2 / (1.f + e2);
            const int ea = gi * 8 + i1, eb = gi * 8 + i2;
            LAS unsigned* lc = (LAS unsigned*)(C.lds + RING_OFF + 110592); LAS unsigned* gb = lc + 64;
            lc[lane] = 0u; asm volatile("" ::: "memory");
            const unsigned la = __hip_atomic_fetch_add(lc + ea, 1u, __ATOMIC_RELAXED, __HIP_MEMORY_SCOPE_WORKGROUP); asm volatile("" ::: "memory");
            const unsigned lb = __hip_atomic_fetch_add(lc + eb, 1u, __ATOMIC_RELAXED, __HIP_MEMORY_SCOPE_WORKGROUP); asm volatile("" ::: "memory");
            const unsigned ne = lc[lane]; unsigned gbase = 0u; if (ne) gbase = atomicAdd(C.cnt + lane * CNT_STRIDE, ne);
            gb[lane] = gbase; asm volatile("" ::: "memory");
            const unsigned pa = gb[ea] + la, pb = gb[eb] + lb;
            C.tok_e[t * 2] = ea; C.tok_e[t * 2 + 1] = eb; C.tok_pos[t * 2] = (int)pa; C.tok_pos[t * 2 + 1] = (int)pb; C.etok[ea * ECAP + (int)pa] = t; C.etok[eb * ECAP + (int)pb] = t; C.tok_gate[t * 2] = g1; C.tok_gate[t * 2 + 1] = g2;
        }
        { asm volatile("" ::: "memory"); f32x4 gg[4][2];
#pragma unroll
            for (int j = 0; j < 4; ++j) { gg[j][0] = *(const f32x4*)(C.ffn_g + j * 512 + lane * 8); gg[j][1] = *(const f32x4*)(C.ffn_g + j * 512 + lane * 8 + 4); }
            const int r0 = w ? 9 * (w - 1) : 63, nr = w ? 9 : 1;
#pragma unroll 3
            for (int i = 0; i < nr; ++i) { const int rr = r0 + i; const float rsr = RS[rr]; const bf16* src = C.H1 + (size_t)(t0 + rr) * DM + lane * 8; bf16* dst = C.A1 + (size_t)(t0 + rr) * DM + lane * 8;
#pragma unroll
                for (int j = 0; j < 4; ++j) { const v4u x = *(const v4u*)(src + j * 512); const f32x4 g0 = gg[j][0], g1 = gg[j][1];
                    v4u o; o.x = pk2(__uint_as_float(x.x << 16) * rsr * g0.x, __uint_as_float(x.x & 0xffff0000u) * rsr * g0.y); o.y = pk2(__uint_as_float(x.y << 16) * rsr * g0.z, __uint_as_float(x.y & 0xffff0000u) * rsr * g0.w);
                    o.z = pk2(__uint_as_float(x.z << 16) * rsr * g1.x, __uint_as_float(x.z & 0xffff0000u) * rsr * g1.y); o.w = pk2(__uint_as_float(x.w << 16) * rsr * g1.z, __uint_as_float(x.w & 0xffff0000u) * rsr * g1.w);
                    *(v4u*)(dst + j * 512) = o; } } }
        __syncthreads();
    }
}
__device__ __forceinline__ void build_seg(const Ctx& C) {
    LAS int* seg = (LAS int*)(C.lds + SEG_OFF); LAS int* tile_e = (LAS int*)(C.lds + TILE_E_OFF);
    if (C.wave == 0) { const unsigned cn = C.cnt[C.lane * CNT_STRIDE]; ((LAS int*)(C.lds + CNTL_OFF))[C.lane] = (int)cn; const int p = (int)((cn + 255u) & ~255u); int inc = p;
#pragma unroll
        for (int o = 1; o < 64; o <<= 1) { const int q = __shfl_up(inc, o); if (C.lane >= o) inc += q; }
        seg[C.lane] = inc - p; if (C.lane == 63) seg[NE] = inc; }
    __syncthreads();
    if (C.tid < NTILE_MAX) { const int row = C.tid * 256; int e = 0; for (int j = 1; j < NE; ++j) if (seg[j] <= row) e = j; tile_e[C.tid] = e; ((LAS int*)(C.lds + TILE_RB_OFF))[C.tid] = e * ECAP - seg[e];
        const int left = ((LAS int*)(C.lds + CNTL_OFF))[e] - (row - seg[e]); ((LAS int*)(C.lds + TILE_NR_OFF))[C.tid] = left < 0 ? 0 : (left > 256 ? 256 : left); }
    __syncthreads();
}
__device__ __forceinline__ void p5b_dispatch(const Ctx& C) {
    const LAS int* seg = (const LAS int*)(C.lds + SEG_OFF);
    for (int t = C.gw * 64 + C.lane; t < M; t += C.NGW * 64) {
        const int ra = seg[C.tok_e[t * 2]] + C.tok_pos[t * 2], rb = seg[C.tok_e[t * 2 + 1]] + C.tok_pos[t * 2 + 1];
        C.rowgate[ra] = C.tok_gate[t * 2]; C.rowgate[rb] = C.tok_gate[t * 2 + 1]; C.rowtok[ra] = t; C.rowtok[rb] = t;
    }
}
__device__ __forceinline__ void p8_final(const Ctx& C) {
    const LAS int* seg = (const LAS int*)(C.lds + SEG_OFF); const int lane = C.lane;
    for (int t0 = C.gw * 2; t0 < M; t0 += C.NGW * 2) {
        int ra[2], rb[2]; float ga[2], gb[2];
#pragma unroll
        for (int u = 0; u < 2; ++u) { const int t = t0 + u; ra[u] = seg[C.tok_e[t * 2]] + C.tok_pos[t * 2]; rb[u] = seg[C.tok_e[t * 2 + 1]] + C.tok_pos[t * 2 + 1]; ga[u] = C.tok_gate[t * 2]; gb[u] = C.tok_gate[t * 2 + 1]; }
        f32x4 v[2][8]; float ss[2] = {0.f, 0.f};
#pragma unroll
        for (int u = 0; u < 2; ++u) { const bf16* xr = C.H1 + (size_t)(t0 + u) * DM; const bf16* ya = C.Y + (size_t)ra[u] * DM; const bf16* yb = C.Y + (size_t)rb[u] * DM;
#pragma unroll
            for (int j = 0; j < 8; ++j) { const v2u h = *(const v2u*)(xr + j * 256 + lane * 4), a = *(const v2u*)(ya + j * 256 + lane * 4), b = *(const v2u*)(yb + j * 256 + lane * 4);
                v[u][j].x = __uint_as_float(h.x << 16) + (ga[u] * __uint_as_float(a.x << 16) + gb[u] * __uint_as_float(b.x << 16)); v[u][j].y = __uint_as_float(h.x & 0xffff0000u) + (ga[u] * __uint_as_float(a.x & 0xffff0000u) + gb[u] * __uint_as_float(b.x & 0xffff0000u));
                v[u][j].z = __uint_as_float(h.y << 16) + (ga[u] * __uint_as_float(a.y << 16) + gb[u] * __uint_as_float(b.y << 16)); v[u][j].w = __uint_as_float(h.y & 0xffff0000u) + (ga[u] * __uint_as_float(a.y & 0xffff0000u) + gb[u] * __uint_as_float(b.y & 0xffff0000u));
                ss[u] += (v[u][j].x * v[u][j].x + v[u][j].y * v[u][j].y) + (v[u][j].z * v[u][j].z + v[u][j].w * v[u][j].w); } }
#pragma unroll
        for (int u = 0; u < 2; ++u) { const float r = 1.f / sqrtf(wave_sum(ss[u]) * (1.f / DM) + 1e-6f);
#pragma unroll
            for (int j = 0; j < 8; ++j) *(f32x4*)(C.out + (size_t)(t0 + u) * DM + j * 256 + lane * 4) = v[u][j] * r * *(const f32x4*)(C.fin_g + j * 256 + lane * 4); }
    }
}

__global__ void __launch_bounds__(NWAVES * 64, 2) mk_fwd(Args args) {
    extern __shared__ __attribute__((aligned(16))) unsigned char lds[];
    Ctx C;
    C.lds = (LAS unsigned char*)lds; C.tid = threadIdx.x; C.lane = C.tid & 63; C.wave = __builtin_amdgcn_readfirstlane(C.tid >> 6);
    C.G = gridDim.x; C.gw = (int)blockIdx.x * NWAVES + C.wave; C.NGW = C.G * NWAVES;
    C.x = args.in[0]; C.attn_g = args.in[1]; C.w_in = args.in[2]; C.fbias = args.in[3]; C.lq1 = args.in[4]; C.lk1 = args.in[5]; C.lq2 = args.in[6]; C.lk2 = args.in[7];
    C.subg = args.in[8]; C.w_out = args.in[9]; C.ffn_g = args.in[10]; C.wg = args.in[11]; C.bg = args.in[12]; C.we = args.in[13]; C.be = args.in[14];
    C.wgate = args.in[15]; C.wup = args.in[16]; C.wdown = args.in[17]; C.fin_g = args.in[18]; C.out = args.out;
    unsigned char* ws = args.ws;
    C.A1 = (bf16*)(ws + WS_A1); C.WIN = (bf16*)(ws + WS_WIN); C.WOUT = (bf16*)(ws + WS_WOUT); C.BIAS = (float*)(ws + WS_BIAS); C.QKV = (bf16*)(ws + WS_QKV);
    C.A2 = (bf16*)(ws + WS_A2); C.DT = (bf16*)(ws + WS_DT); C.H1 = (bf16*)(ws + WS_H1);
    C.tok_e = (int*)(ws + WS_ROUTE); C.tok_pos = C.tok_e + 2 * M; C.tok_gate = (float*)(C.tok_pos + 2 * M); C.rstd = C.tok_gate + 2 * M; C.rowgate = C.rstd + M; C.rowtok = (int*)(C.rowgate + YROWS);
    C.etok = (int*)(ws + WS_XG); C.egate = (float*)(ws + WS_XG) + (size_t)NE * ECAP;
    C.WR = (float*)(ws + WS_WR); C.XG = (bf16*)(ws + WS_XG); C.HB = (bf16*)(ws + WS_HBUF); C.Y = (bf16*)(ws + WS_Y); C.WGU = (bf16*)(ws + WS_WGU); C.WD = (bf16*)(ws + WS_WD);
    C.cnt = (unsigned*)(ws + WS_CTL) + CW_CNT; C.nrm = (unsigned*)(ws + WS_CTL) + CW_NRM;
    volatile LAS unsigned* MISC = (volatile LAS unsigned*)(C.lds + MISC_OFF);
    for (int u = C.tid; u < (LDS_BYTES - LDSCTL_OFF) / 4; u += NWAVES * 64) ((LAS unsigned*)(C.lds + LDSCTL_OFF))[u] = 0u;
    __syncthreads();
    XcdBarrier bar = xcd_barrier_post((unsigned*)(ws + WS_CTL) + CW_BAR + args.li * XCD_BAR_WORDS, MISC + 8);
    const int lo = args.ph_lo, hi = args.ph_hi;
#define IN(k) (lo <= (k) && (k) < hi)
#define SEAM(k) do { if (IN(k) && IN((k) + 1)) xcd_barrier(bar); } while (0)
#ifndef PROBE_MASK
#define PROBE_MASK 0u
#endif
#ifndef PROBE_REP
#define PROBE_REP 0
#endif
#define TWICE(k) (((PROBE_MASK) >> (k)) & 1u)
#ifdef PROBE_TS
    volatile LAS unsigned long long* TSW = (volatile LAS unsigned long long*)(C.lds + LDSCTL_OFF + 15360);
#define TS(k) do { if (blockIdx.x == 0 && C.tid == 0) TSW[k] = __builtin_amdgcn_s_memrealtime(); } while (0)
#else
#define TS(k) do { } while (0)
#endif
    TS(0);

    if (IN(0)) { p0_prologue(C); if (TWICE(0)) { xcd_barrier(bar); p0_prologue(C); } } SEAM(0); TS(1);
    if (IN(1)) {
        p1_cumsum(C);
        pg8::Gemm g{C.A1, C.WIN, M, NQKV, DM}; pg8::StaticOrder So; So.init(M, NQKV, C.G, (int)blockIdx.x);
        pg8::EpiQKV E{C.QKV, NQKV, (PG8_LAS float*)(C.lds + NRMP_OFF), C.nrm};
        pg8::gemm_phase<pg8::EpiQKV, pg8::StaticOrder, true, true>(C.lds + RING_OFF, g, So, E);
        if (TWICE(1)) { xcd_barrier(bar); pg8::gemm_phase<pg8::EpiQKV, pg8::StaticOrder, true, true>(C.lds + RING_OFF, g, So, E); }
    } SEAM(1); TS(2);
    if (IN(3)) { const att::Tensors T{(const att::bf16*)C.QKV, (att::bf16*)C.A2, (att::bf16*)C.DT, C.BIAS, C.nrm};
        unsigned* qh = (unsigned*)(ws + WS_CTL) + CW_QHEAD; volatile __attribute__((address_space(3))) int* qw = (volatile __attribute__((address_space(3))) int*)(C.lds + RING_OFF + ATT_QW_OFF);
        att::attn_part<false>((char*)lds + RING_OFF, T, qh, qw); TS(3); att::attn_part<true>((char*)lds + RING_OFF, T, qh + 64, qw); if (TWICE(3)) { xcd_barrier(bar); att::attn_part<false>((char*)lds + RING_OFF, T, qh + 128, qw); att::attn_part<true>((char*)lds + RING_OFF, T, qh + 192, qw); } } SEAM(3); TS(4);
    if (IN(4)) { p3_combine(C); if (TWICE(4)) { xcd_barrier(bar); p3_combine(C); } } SEAM(4); TS(5);
#ifdef PROBE_BAR
    for (int i_ = 0; i_ < PROBE_BAR; ++i_) xcd_barrier(bar);
#endif
    if (IN(5)) {
        pg8::Gemm g{C.A2, C.WOUT, M, DM, DM}; pg8::StaticOrder So; So.init(M, DM, C.G, (int)blockIdx.x);
        pg8::EpiResBf16 E{C.x, C.H1, DM};
        pg8::gemm_phase<pg8::EpiResBf16, pg8::StaticOrder, true, true>(C.lds + RING_OFF, g, So, E);
        if (TWICE(5)) { xcd_barrier(bar); pg8::gemm_phase<pg8::EpiResBf16, pg8::StaticOrder, true, true>(C.lds + RING_OFF, g, So, E); }
    } SEAM(5); TS(6);
    if (IN(6)) { if (blockIdx.x == 0) ((v4u*)C.WIN)[C.tid] = (v4u){0u, 0u, 0u, 0u};
        p5a_router(C); } SEAM(6); TS(7);
#ifdef PROBE_IDLE
    { const unsigned long long t0 = __builtin_amdgcn_s_memrealtime(); while (__builtin_amdgcn_s_memrealtime() - t0 < (unsigned long long)(PROBE_IDLE) * 100ull) __builtin_amdgcn_s_sleep(32); }
#endif
    if (hi > 7) build_seg(C);
#ifdef PROBE_CLK
    unsigned long long ck0 = 0, cr0 = 0, ckd = 0, crd = 1;
    if (IN(PROBE_CLK)) { ck0 = __builtin_amdgcn_s_memtime(); cr0 = __builtin_amdgcn_s_memrealtime(); }
#endif
    if (IN(8)) {
        const PG8_LAS int* tile_e = (const PG8_LAS int*)(C.lds + TILE_E_OFF); const int ntile = ((const LAS int*)(C.lds + SEG_OFF))[NE] >> 8;
        #if defined(PROBE_HOT) && PROBE_HOT >= 3
        pg8::GemmW g{C.A1, DM, DFF, C.etok, args.li > 0 ? 255 : M - 1, (const PG8_LAS int*)(C.lds + TILE_RB_OFF)};
#else
        pg8::GemmW g{C.A1, DM, DFF, C.etok, M - 1, (const PG8_LAS int*)(C.lds + TILE_RB_OFF)};
#endif
        pg8::GroupedOrderW<0> So{ntile * 8, C.G, (int)blockIdx.x, tile_e, C.wgate, C.wup, args.li > 0};
        pg8::EpiSwiglu E{args.li > 0 ? C.XG : C.HB};
        pg8::gemm_phase_wf32<pg8::EpiSwiglu, pg8::GroupedOrderW<0>, true, true>(C.lds + RING_OFF, g, So, E);
    } SEAM(8); TS(8);
    if (IN(9)) {
        const PG8_LAS int* tile_e = (const PG8_LAS int*)(C.lds + TILE_E_OFF); const int ntile = ((const LAS int*)(C.lds + SEG_OFF))[NE] >> 8;
        pg8::GemmW g{C.HB, DFF, DM, nullptr, 0, nullptr}; pg8::GroupedOrderW<1> So{ntile * 8, C.G, (int)blockIdx.x, tile_e, C.wdown, nullptr};
        pg8::EpiDown E{C.Y};
        pg8::gemm_phase_wf32<pg8::EpiDown, pg8::GroupedOrderW<1>, true, false>(C.lds + RING_OFF, g, So, E);
    } SEAM(9); TS(9);
#ifdef PROBE_CLK
    if (IN(PROBE_CLK)) { ckd = __builtin_amdgcn_s_memtime() - ck0; crd = __builtin_amdgcn_s_memrealtime() - cr0; }
#endif
    if (IN(10)) { p8_final(C); if (TWICE(10)) { xcd_barrier(bar); p8_final(C); } }
#ifdef PROBE_CLK
    if (blockIdx.x == 0) { const unsigned long long want = ckd * 100ull / (crd ? crd : 1);
        const unsigned long long t0 = __builtin_amdgcn_s_memrealtime(); while (__builtin_amdgcn_s_memrealtime() - t0 < want) __builtin_amdgcn_s_sleep(8); }
#endif
#ifdef PROBE_TS
    if (blockIdx.x == 0 && C.tid == 0) { const unsigned long long dA = TSW[(PROBE_TS >> 4) & 15] - TSW[(PROBE_TS >> 8) & 15], dB = TSW[PROBE_TS & 15] - TSW[(PROBE_TS >> 12) & 15];
        const unsigned long long want = ((dA + 1000ull) / 2000ull) * 100000ull + dB;
        const unsigned long long t0 = __builtin_amdgcn_s_memrealtime(); while (__builtin_amdgcn_s_memrealtime() - t0 < want) __builtin_amdgcn_s_sleep(8); }
#endif
#ifdef PROBE_NT
    if (blockIdx.x == 0) { const int ntile_ = ((const LAS int*)(C.lds + SEG_OFF))[NE] >> 8; const unsigned long long want = (unsigned long long)(ntile_ > 150 ? ntile_ - 150 : 0) * 2000ull;
        const unsigned long long t0 = __builtin_amdgcn_s_memrealtime(); while (__builtin_amdgcn_s_memrealtime() - t0 < want) __builtin_amdgcn_s_sleep(8); }
#endif
#ifdef PROF_SECT
    if (blockIdx.x == 0) { __syncthreads(); const unsigned want = ((volatile LAS unsigned*)(C.lds + ATT_QW_OFF + 32))[0]; const unsigned long long t0 = __builtin_amdgcn_s_memtime(); while (__builtin_amdgcn_s_memtime() - t0 < (unsigned long long)want) __builtin_amdgcn_s_sleep(8); }
#endif
#undef IN
#undef SEAM
#undef TWICE
}

#if NAIVE_MASK
namespace nv {
__device__ __forceinline__ float bf2f(bf16_t v) { return __uint_as_float((unsigned)v << 16); }
__device__ __forceinline__ bf16_t f2b(float f) { return (bf16_t)f2bf(f); }
__global__ void __launch_bounds__(256) k_cumsum(float* __restrict__ bias) {
    __shared__ float part[256];
    float* p = bias + (size_t)blockIdx.x * S; const int tid = threadIdx.x;
    float loc[32]; float s = 0.f;
#pragma unroll
    for (int i = 0; i < 32; ++i) { s += p[tid * 32 + i]; loc[i] = s; }
    part[tid] = s; __syncthreads();
    if (tid == 0) { float a = 0.f; for (int i = 0; i < 256; ++i) { const float q = part[i]; part[i] = a; a += q; } }
    __syncthreads();
    const float base = part[tid];
#pragma unroll
    for (int i = 0; i < 32; ++i) p[tid * 32 + i] = (base + loc[i]) * ATT_ISCALE;
}
template <class FA, class FB>
__device__ __forceinline__ void ngemm_tile(int K, FA fa, FB fb, float (&acc)[4][4], float (*As)[65], float (*Bs)[65]) {
    const int tid = threadIdx.x, tx = tid & 15, ty = tid >> 4;
#pragma unroll
    for (int r = 0; r < 4; ++r)
#pragma unroll
        for (int c = 0; c < 4; ++c) acc[r][c] = 0.f;
    for (int k0 = 0; k0 < K; k0 += 16) {
        for (int e = tid; e < 1024; e += 256) { const int i = e >> 4, kk = e & 15; As[kk][i] = fa(i, k0 + kk); Bs[kk][i] = fb(k0 + kk, i); }
        __syncthreads();
#pragma unroll
        for (int kk = 0; kk < 16; ++kk) { float a[4], b[4];
#pragma unroll
            for (int r = 0; r < 4; ++r) a[r] = As[kk][ty * 4 + r];
#pragma unroll
            for (int c = 0; c < 4; ++c) b[c] = Bs[kk][tx * 4 + c];
#pragma unroll
            for (int r = 0; r < 4; ++r)
#pragma unroll
                for (int c = 0; c < 4; ++c) acc[r][c] += a[r] * b[c]; }
        __syncthreads();
    }
}
__global__ void __launch_bounds__(256) k_inproj(const bf16_t* __restrict__ A, const bf16_t* __restrict__ Bt, bf16_t* __restrict__ Cq) {
    __shared__ float As[16][65], Bs[16][65];
    const int m0 = blockIdx.y * 64, n0 = blockIdx.x * 64; float acc[4][4];
    ngemm_tile(DM, [&](int i, int k) { return bf2f(A[(size_t)(m0 + i) * DM + k]); }, [&](int k, int j) { return bf2f(Bt[(size_t)(n0 + j) * DM + k]); }, acc, As, Bs);
    const int tx = threadIdx.x & 15, ty = threadIdx.x >> 4;
#pragma unroll
    for (int r = 0; r < 4; ++r)
#pragma unroll
        for (int c = 0; c < 4; ++c) Cq[(size_t)(m0 + ty * 4 + r) * NQKV + n0 + tx * 4 + c] = f2b(acc[r][c]);
}
__global__ void __launch_bounds__(256) k_outproj(const bf16_t* __restrict__ A, const bf16_t* __restrict__ Bt, const float* __restrict__ x, float* __restrict__ H1) {
    __shared__ float As[16][65], Bs[16][65];
    const int m0 = blockIdx.y * 64, n0 = blockIdx.x * 64; float acc[4][4];
    ngemm_tile(DM, [&](int i, int k) { return bf2f(A[(size_t)(m0 + i) * DM + k]); }, [&](int k, int j) { return bf2f(Bt[(size_t)(n0 + j) * DM + k]); }, acc, As, Bs);
    const int tx = threadIdx.x & 15, ty = threadIdx.x >> 4;
#pragma unroll
    for (int r = 0; r < 4; ++r)
#pragma unroll
        for (int c = 0; c < 4; ++c) { const size_t o = (size_t)(m0 + ty * 4 + r) * DM + n0 + tx * 4 + c; H1[o] = x[o] + acc[r][c]; }
}
__global__ void __launch_bounds__(256) k_attn(const bf16_t* __restrict__ QKV, const float* __restrict__ bias, bf16_t* __restrict__ A2, bf16_t* __restrict__ DT) {
    __shared__ bf16_t Qs[64][130];
    __shared__ float Ks[32][129];
    __shared__ float Vs[32][128];
    __shared__ float Ps[64][33];
    const int tid = threadIdx.x, r = tid >> 2, c4 = tid & 3;
    const int qb = (int)gridDim.x - 1 - (int)blockIdx.x, p = blockIdx.y;
    int b, qcol, kcol, vcol, h, map = 0, vh = 0; const float* cc; const bool fox = p < 16;
    if (fox) { b = p >> 3; h = p & 7; qcol = C_FQ + h * 128; kcol = C_FK + h * 128; vcol = C_FV + h * 128; cc = bias + ((size_t)b * 8 + h) * S; }
    else { const int q = p - 16; b = q >> 4; h = (q >> 2) & 3; map = (q >> 1) & 1; vh = q & 1; qcol = C_DQ + h * 256 + map * 128; kcol = C_DK + h * 256 + map * 128; vcol = C_DV + h * 256 + vh * 128; cc = bias + (size_t)(16 + h) * S; }
    const int q0 = qb * 64; const size_t rowb = (size_t)b * S;
    for (int e = tid; e < 64 * 128; e += 256) { const int i = e >> 7, d = e & 127; Qs[i][d] = QKV[(rowb + q0 + i) * NQKV + qcol + d]; }
    const int t = q0 + r; const float ct = cc[t];
    float m = -1e30f, l = 0.f; float o[32];
#pragma unroll
    for (int j = 0; j < 32; ++j) o[j] = 0.f;
    const int nkt = (q0 + 63) / 32 + 1;
    for (int kt = 0; kt < nkt; ++kt) {
        const int k0 = kt * 32;
        __syncthreads();
        for (int e = tid; e < 32 * 128; e += 256) { const int i = e >> 7, d = e & 127; const size_t ro = (rowb + k0 + i) * NQKV; Ks[i][d] = bf2f(QKV[ro + kcol + d]); Vs[i][d] = bf2f(QKV[ro + vcol + d]); }
        __syncthreads();
        float sc[8];
#pragma unroll
        for (int j = 0; j < 8; ++j) sc[j] = 0.f;
        for (int d = 0; d < 128; ++d) { const float qv = bf2f(Qs[r][d]);
#pragma unroll
            for (int j = 0; j < 8; ++j) sc[j] += qv * Ks[c4 * 8 + j][d]; }
        float tmax = -__builtin_inff();
#pragma unroll
        for (int j = 0; j < 8; ++j) { const int s = k0 + c4 * 8 + j; float v = (sc[j] + (ct - cc[s])) * ATT_SCALE;
            if (s > t) v = -__builtin_inff();
            sc[j] = v; tmax = fmaxf(tmax, v); }
        tmax = fmaxf(tmax, __shfl_xor(tmax, 1)); tmax = fmaxf(tmax, __shfl_xor(tmax, 2));
        const float mn = fmaxf(m, tmax), alpha = __expf(m - mn); m = mn;
        float ps = 0.f;
#pragma unroll
        for (int j = 0; j < 8; ++j) { const float pv = __expf(sc[j] - mn); ps += pv; Ps[r][c4 * 8 + j] = pv; }
        ps += __shfl_xor(ps, 1); ps += __shfl_xor(ps, 2);
        l = l * alpha + ps;
        __syncthreads();
#pragma unroll
        for (int j = 0; j < 32; ++j) o[j] *= alpha;
        for (int kk = 0; kk < 32; ++kk) { const float pv = Ps[r][kk];
#pragma unroll
            for (int j = 0; j < 32; ++j) o[j] += pv * Vs[kk][c4 + 4 * j]; }
    }
    const float il = 1.f / l;
    bf16_t* op = fox ? A2 + (rowb + t) * DM + h * 128 : DT + (rowb + t) * DM + h * 512 + map * 256 + vh * 128;
#pragma unroll
    for (int j = 0; j < 32; ++j) op[c4 + 4 * j] = f2b(o[j] * il);
}
__global__ void __launch_bounds__(256) k_diff_combine(const bf16_t* __restrict__ DT, const float* __restrict__ lq1, const float* __restrict__ lk1, const float* __restrict__ lq2,
                                                      const float* __restrict__ lk2, const float* __restrict__ sg, bf16_t* __restrict__ A2) {
    const int lane = threadIdx.x & 63, wv = threadIdx.x >> 6;
    const int idx = blockIdx.x * 4 + wv, t = idx >> 2, h = idx & 3;
    const float s1 = wave_sum(lq1[lane] * lk1[lane] + lq1[lane + 64] * lk1[lane + 64]);
    const float s2 = wave_sum(lq2[lane] * lk2[lane] + lq2[lane + 64] * lk2[lane + 64]);
    const float lam = expf(s1) - expf(s2) + 0.2f;
    const bf16_t* p = DT + (size_t)t * DM + h * 512;
    float d[4]; float ss = 0.f;
#pragma unroll
    for (int c = 0; c < 4; ++c) { d[c] = bf2f(p[lane * 4 + c]) - lam * bf2f(p[256 + lane * 4 + c]); ss += d[c] * d[c]; }
    ss = wave_sum(ss);
    const float r = rsqrtf(ss * (1.f / 256.f) + 1e-5f) * 0.8f;
    bf16_t* o = A2 + (size_t)t * DM + 1024 + h * 256 + lane * 4;
#pragma unroll
    for (int c = 0; c < 4; ++c) o[c] = f2b(d[c] * r * sg[lane * 4 + c]);
}
__global__ void __launch_bounds__(256) k_route(const float* __restrict__ H1, const float* __restrict__ g, const float* __restrict__ wg, const float* __restrict__ bg,
                                               const float* __restrict__ we, const float* __restrict__ be, int* __restrict__ tok_e, int* __restrict__ tok_pos,
                                               float* __restrict__ tok_gate, float* __restrict__ rstd, unsigned* __restrict__ cnt) {
    __shared__ float xs[4][DM];
    const int lane = threadIdx.x & 63, wv = threadIdx.x >> 6;
    const int t = blockIdx.x * 4 + wv;
    const float* xr = H1 + (size_t)t * DM;
    f32x4 v[8]; float ss = 0.f;
#pragma unroll
    for (int j = 0; j < 8; ++j) { v[j] = *(const f32x4*)(xr + j * 256 + lane * 4); ss += v[j].x * v[j].x + v[j].y * v[j].y + v[j].z * v[j].z + v[j].w * v[j].w; }
    ss = wave_sum(ss);
    const float r = 1.f / sqrtf(ss * (1.f / DM) + 1e-6f);
#pragma unroll
    for (int j = 0; j < 8; ++j) { const f32x4 gg = *(const f32x4*)(g + j * 256 + lane * 4); *(f32x4*)(&xs[wv][j * 256 + lane * 4]) = v[j] * r * gg; }
    __syncthreads();
    float el = 0.f;
    for (int k = 0; k < DM; ++k) el += xs[wv][k] * we[(size_t)k * NE + lane];
    el += be[lane];
    float gl = 0.f;
    for (int k = (lane >> 3); k < DM; k += 8) gl += xs[wv][k] * wg[(size_t)k * 8 + (lane & 7)];
    gl += __shfl_xor(gl, 8); gl += __shfl_xor(gl, 16); gl += __shfl_xor(gl, 32);
    gl += bg[lane & 7];
    float gmax = -__builtin_inff(); int gi = 0;
#pragma unroll
    for (int j = 0; j < 8; ++j) { const float q = __shfl(gl, j); if (q > gmax) { gmax = q; gi = j; } }
    float gs = 0.f;
#pragma unroll
    for (int j = 0; j < 8; ++j) gs += expf(__shfl(gl, j) - gmax);
    const float gprob = 1.f / gs;
    float l1 = -__builtin_inff(), l2 = -__builtin_inff(); int i1 = 0, i2 = 0;
#pragma unroll
    for (int j = 0; j < 8; ++j) { const float q = __shfl(el, gi * 8 + j);
        if (q > l1) { l2 = l1; i2 = i1; l1 = q; i1 = j; } else if (q > l2) { l2 = q; i2 = j; } }
    const float e2 = expf(l2 - l1), g1 = gprob / (1.f + e2), g2 = gprob * e2 / (1.f + e2);
    if (lane == 0) {
        const int ea = gi * 8 + i1, eb = gi * 8 + i2;
        const unsigned pa = atomicAdd(cnt + ea, 1u), pb = atomicAdd(cnt + eb, 1u);
        tok_e[t * 2] = ea; tok_e[t * 2 + 1] = eb; tok_pos[t * 2] = (int)pa; tok_pos[t * 2 + 1] = (int)pb; tok_gate[t * 2] = g1; tok_gate[t * 2 + 1] = g2; rstd[t] = r;
    }
}
__device__ __forceinline__ int seg_off(const unsigned* cnt, int e) { int o = 0; for (int i = 0; i < e; ++i) o += (int)((cnt[i] + 255u) & ~255u); return o; }
__global__ void __launch_bounds__(256) k_dispatch(const float* __restrict__ H1, const float* __restrict__ g, const float* __restrict__ rstd, const int* __restrict__ tok_e,
                                                  const int* __restrict__ tok_pos, const float* __restrict__ tok_gate, const unsigned* __restrict__ cnt, bf16_t* __restrict__ XG, float* __restrict__ rowgate) {
    const int lane = threadIdx.x & 63, wv = threadIdx.x >> 6; const int t = blockIdx.x * 4 + wv;
    const int ra = seg_off(cnt, tok_e[t * 2]) + tok_pos[t * 2], rb = seg_off(cnt, tok_e[t * 2 + 1]) + tok_pos[t * 2 + 1];
    const float rs = rstd[t];
    for (int k = lane; k < DM; k += 64) { const bf16_t v = f2b(H1[(size_t)t * DM + k] * rs * g[k]); XG[(size_t)ra * DM + k] = v; XG[(size_t)rb * DM + k] = v; }
    if (lane == 0) { rowgate[ra] = tok_gate[t * 2]; rowgate[rb] = tok_gate[t * 2 + 1]; }
}
__global__ void __launch_bounds__(256) k_moe_up(const bf16_t* __restrict__ XG, const bf16_t* __restrict__ WGU, const unsigned* __restrict__ cnt, bf16_t* __restrict__ HB) {
    __shared__ float As[16][65], Bs[16][65];
    const int m0 = blockIdx.y * 64, n0 = blockIdx.x * 64;
    int e = 0, tot = 0; { int o = 0; for (int i = 0; i < NE; ++i) { if (o <= m0) e = i; o += (int)((cnt[i] + 255u) & ~255u); } tot = o; }
    if (m0 >= tot) return;
    const bf16_t* W = WGU + (size_t)e * 2048 * DM; const int rg = 256 * (n0 >> 7) + (n0 & 127), ru = rg + 128;
    float ag[4][4], au[4][4];
    ngemm_tile(DM, [&](int i, int k) { return bf2f(XG[(size_t)(m0 + i) * DM + k]); }, [&](int k, int j) { return bf2f(W[(size_t)(rg + j) * DM + k]); }, ag, As, Bs);
    ngemm_tile(DM, [&](int i, int k) { return bf2f(XG[(size_t)(m0 + i) * DM + k]); }, [&](int k, int j) { return bf2f(W[(size_t)(ru + j) * DM + k]); }, au, As, Bs);
    const int tx = threadIdx.x & 15, ty = threadIdx.x >> 4;
#pragma unroll
    for (int r = 0; r < 4; ++r)
#pragma unroll
        for (int c = 0; c < 4; ++c) { const float gv = ag[r][c]; HB[(size_t)(m0 + ty * 4 + r) * DFF + n0 + tx * 4 + c] = f2b(gv / (1.f + expf(-gv)) * au[r][c]); }
}
__global__ void __launch_bounds__(256) k_moe_down(const bf16_t* __restrict__ HB, const bf16_t* __restrict__ WD, const unsigned* __restrict__ cnt, const float* __restrict__ rowgate, bf16_t* __restrict__ Y) {
    __shared__ float As[16][65], Bs[16][65];
    const int m0 = blockIdx.y * 64, n0 = blockIdx.x * 64;
    int e = 0, tot = 0; { int o = 0; for (int i = 0; i < NE; ++i) { if (o <= m0) e = i; o += (int)((cnt[i] + 255u) & ~255u); } tot = o; }
    if (m0 >= tot) return;
    const bf16_t* W = WD + (size_t)e * DM * DFF; float acc[4][4];
    ngemm_tile(DFF, [&](int i, int k) { return bf2f(HB[(size_t)(m0 + i) * DFF + k]); }, [&](int k, int j) { return bf2f(W[(size_t)(n0 + j) * DFF + k]); }, acc, As, Bs);
    const int tx = threadIdx.x & 15, ty = threadIdx.x >> 4;
#pragma unroll
    for (int r = 0; r < 4; ++r) { const int row = m0 + ty * 4 + r; const float gt = rowgate[row];
#pragma unroll
        for (int c = 0; c < 4; ++c) Y[(size_t)row * DM + n0 + tx * 4 + c] = f2b(acc[r][c] * gt); }
}
__global__ void __launch_bounds__(256) k_final(const float* __restrict__ H1, const bf16_t* __restrict__ Y, const unsigned* __restrict__ cnt, const int* __restrict__ tok_e,
                                               const int* __restrict__ tok_pos, const float* __restrict__ g, float* __restrict__ out) {
    const int lane = threadIdx.x & 63, wv = threadIdx.x >> 6; const int t = blockIdx.x * 4 + wv;
    const int ra = seg_off(cnt, tok_e[t * 2]) + tok_pos[t * 2], rb = seg_off(cnt, tok_e[t * 2 + 1]) + tok_pos[t * 2 + 1];
    float v[32]; float ss = 0.f;
#pragma unroll
    for (int i = 0; i < 32; ++i) { const int k = lane + 64 * i; v[i] = H1[(size_t)t * DM + k] + bf2f(Y[(size_t)ra * DM + k]) + bf2f(Y[(size_t)rb * DM + k]); ss += v[i] * v[i]; }
    ss = wave_sum(ss);
    const float r = 1.f / sqrtf(ss * (1.f / DM) + 1e-6f);
#pragma unroll
    for (int i = 0; i < 32; ++i) { const int k = lane + 64 * i; out[(size_t)t * DM + k] = v[i] * r * g[k]; }
}
}
static void naive_phase(int k, const Args& a, hipStream_t stream) {
    unsigned char* ws = a.ws;
    bf16_t* A1 = (bf16_t*)(ws + WS_A1); bf16_t* WIN = (bf16_t*)(ws + WS_WIN); bf16_t* WOUT = (bf16_t*)(ws + WS_WOUT); float* BIAS = (float*)(ws + WS_BIAS); bf16_t* QKV = (bf16_t*)(ws + WS_QKV);
    bf16_t* A2 = (bf16_t*)(ws + WS_A2); bf16_t* DT = (bf16_t*)(ws + WS_DT); float* H1 = (float*)(ws + WS_H1);
    int* tok_e = (int*)(ws + WS_ROUTE); int* tok_pos = tok_e + 2 * M; float* tok_gate = (float*)(tok_pos + 2 * M); float* rstd = tok_gate + 2 * M; float* rowgate = rstd + M;
    bf16_t* XG = (bf16_t*)(ws + WS_XG); bf16_t* HB = (bf16_t*)(ws + WS_HBUF); bf16_t* Y = (bf16_t*)(ws + WS_Y); bf16_t* WGU = (bf16_t*)(ws + WS_WGU); bf16_t* WD = (bf16_t*)(ws + WS_WD);
    unsigned* cnt = (unsigned*)(ws + WS_CTL) + CW_CNT;
    switch (k) {
    case 1: nv::k_cumsum<<<16, 256, 0, stream>>>(BIAS); nv::k_inproj<<<dim3(NQKV / 64, M / 64), 256, 0, stream>>>(A1, WIN, QKV); break;
    case 3: nv::k_attn<<<dim3(S / 64, 48), 256, 0, stream>>>(QKV, BIAS, A2, DT); break;
    case 4: nv::k_diff_combine<<<M, 256, 0, stream>>>(DT, a.in[4], a.in[5], a.in[6], a.in[7], a.in[8], A2); break;
    case 5: nv::k_outproj<<<dim3(DM / 64, M / 64), 256, 0, stream>>>(A2, WOUT, a.in[0], H1); break;
    case 6: nv::k_route<<<M / 4, 256, 0, stream>>>(H1, a.in[10], a.in[11], a.in[12], a.in[13], a.in[14], tok_e, tok_pos, tok_gate, rstd, cnt); break;
    case 7: nv::k_dispatch<<<M / 4, 256, 0, stream>>>(H1, a.in[10], rstd, tok_e, tok_pos, tok_gate, cnt, XG, rowgate); break;
    case 8: nv::k_moe_up<<<dim3(DFF / 64, YROWS / 64), 256, 0, stream>>>(XG, WGU, cnt, HB); break;
    case 9: nv::k_moe_down<<<dim3(DM / 64, YROWS / 64), 256, 0, stream>>>(HB, WD, cnt, rowgate, Y); break;
    case 10: nv::k_final<<<M / 4, 256, 0, stream>>>(H1, Y, cnt, tok_e, tok_pos, a.in[18], a.out); break;
    default: break;
    }
}
#endif


extern "C" void kernel_launch(void* const* d_in, const int* in_sizes, int n_in, void* d_out, int out_size, void* d_ws, size_t ws_size, hipStream_t stream) {
    static int grid = 0;
    if (grid == 0) {
        if (n_in != 19 || in_sizes[0] != M * DM || out_size != M * DM || ws_size < WS_END) {
            fprintf(stderr, "kernel_launch: built for 19 inputs, x and out of %d floats, >= %zu bytes of workspace; got n_in %d, in0 %d, out %d, ws %zu; nothing launched\n", M * DM, (size_t)WS_END, n_in, n_in > 0 ? in_sizes[0] : -1, out_size, ws_size); grid = -1; return; }
        int dev = 0, cus = 0, per_cu = 0;
        if (hipGetDevice(&dev) != hipSuccess || hipDeviceGetAttribute(&cus, hipDeviceAttributeMultiprocessorCount, dev) != hipSuccess) { fprintf(stderr, "kernel_launch: device query failed\n"); grid = -1; return; }
        if (hipFuncSetAttribute((const void*)mk_fwd, hipFuncAttributeMaxDynamicSharedMemorySize, LDS_BYTES) != hipSuccess) { fprintf(stderr, "kernel_launch: hipFuncSetAttribute failed\n"); grid = -1; return; }
        if (hipOccupancyMaxActiveBlocksPerMultiprocessor(&per_cu, (const void*)mk_fwd, NWAVES * 64, LDS_BYTES) != hipSuccess || per_cu < 1)
            fprintf(stderr, "kernel_launch: note: occupancy query reports %d workgroups per CU\n", per_cu);
        (void)hipGetLastError();
        grid = cus;
    }
    if (grid < 0) return;
    if (hipMemsetAsync((char*)d_ws + WS_CTL, 0, CTL_ZERO_BYTES, stream) != hipSuccess) { fprintf(stderr, "kernel_launch: memset failed\n"); return; }
    Args a{};
    for (int i = 0; i < 19; ++i) a.in[i] = (const float*)d_in[i];
    a.out = (float*)d_out; a.ws = (unsigned char*)d_ws;
    int k = 0, li = 0;
    while (k < NPHASE) {
#if NAIVE_MASK
        if (k > 0 && ((NAIVE_MASK >> k) & 1u)) { naive_phase(k, a, stream); ++k; continue; }
#endif
        const int lo = k; ++k;
        while (k < NPHASE && !((NAIVE_MASK >> k) & 1u)) ++k;
        a.ph_lo = lo; a.ph_hi = k; a.li = li++;
        hipLaunchKernelGGL(mk_fwd, dim3(grid), dim3(NWAVES * 64), LDS_BYTES, stream, a);
        const hipError_t le = hipPeekAtLastError();
        if (le != hipSuccess) { fprintf(stderr, "kernel_launch: launch failed: %s\n", hipGetErrorName(le)); break; }
    }
#if PROBE_REP
    a.ph_lo = PROBE_REP; a.ph_hi = PROBE_REP + 1; a.li = li++;
    hipLaunchKernelGGL(mk_fwd, dim3(grid), dim3(NWAVES * 64), LDS_BYTES, stream, a);
#endif
}
```
